# Optimizing an MI355X kernel written in HIP

```python
import jax
import jax.numpy as jnp
from jax import lax
import numpy as np

D_MODEL = 2048
BATCH = 2
SEQ = 16384
DEPTH = 2

N_A_LAYERS = DEPTH // 2
N_B_LAYERS = DEPTH - N_A_LAYERS
RMS_EPS = 1e-6

RET_HEADS = 8
RET_QK_DIM = D_MODEL // RET_HEADS
RET_V_DIM = 2 * RET_QK_DIM
RET_CHUNK = 128
ROPE_BASE = 10000.0
RET_PROJ = 2 * RET_HEADS * RET_QK_DIM + 2 * RET_HEADS * RET_V_DIM

NSA_Q_HEADS = 16
NSA_KV_HEADS = 4
NSA_GROUP = NSA_Q_HEADS // NSA_KV_HEADS
NSA_HEAD_DIM = 128
N_BRANCH = 3
CMP_BLOCK = 32
CMP_STRIDE = 16
CMP_HIDDEN = 256
SLC_BLOCK = 64
SLC_TOPK = 16
WIN = 512
NSA_Q_BLOCK = 64
CMP_RATIO = CMP_BLOCK // CMP_STRIDE
SLC_RATIO = SLC_BLOCK // CMP_STRIDE
NSA_Q_PROJ = NSA_Q_HEADS * NSA_HEAD_DIM + N_BRANCH * NSA_Q_HEADS
NSA_KV_PROJ = 2 * N_BRANCH * NSA_KV_HEADS * NSA_HEAD_DIM
NEG = -1e30
SEL_FORCE = 1e30

D_FF = 4096
CONV_W = 3

kernel_name = "retention_nsa_yoco_convffn"


def rmsnorm(x, gain):
    xf = x.astype(jnp.float32)
    y = xf * lax.rsqrt(jnp.mean(xf * xf, axis=-1, keepdims=True) + RMS_EPS)
    return (y * gain.astype(jnp.float32)).astype(x.dtype)


def rotary(x, pos):
    half = x.shape[-1] // 2
    freqs = ROPE_BASE ** (-jnp.arange(half, dtype=jnp.float32) / half)
    ang = pos[:, None] * freqs[None, :]
    cos = jnp.cos(ang)[None, :, None, :]
    sin = jnp.sin(ang)[None, :, None, :]
    x1 = x[..., :half].astype(jnp.float32)
    x2 = x[..., half:].astype(jnp.float32)
    return jnp.concatenate([x1 * cos - x2 * sin, x1 * sin + x2 * cos], axis=-1).astype(x.dtype)


def retention(xn, w_in, gn_gain, w_out):
    B, S, _ = xn.shape
    H, dk, dv, C = RET_HEADS, RET_QK_DIM, RET_V_DIM, RET_CHUNK
    nC = S // C
    proj = xn @ w_in
    q, k, v, g = jnp.split(proj, [H * dk, 2 * H * dk, 2 * H * dk + H * dv], axis=-1)
    pos = jnp.arange(S, dtype=jnp.float32)
    q = rotary(q.reshape(B, S, H, dk), pos)
    k = rotary(k.reshape(B, S, H, dk), pos) * (dk ** -0.5)
    v = v.reshape(B, S, H, dv)

    def chunks(t):
        return t.reshape(B, nC, C, H, t.shape[-1]).transpose(0, 3, 1, 2, 4)

    qc, kc, vc = chunks(q), chunks(k), chunks(v)
    log_gamma = jnp.log(1.0 - 2.0 ** (-5.0 - jnp.arange(H, dtype=jnp.float32)))
    idx = jnp.arange(C, dtype=jnp.float32)
    diff = idx[:, None] - idx[None, :]
    decay_in = jnp.where(diff >= 0, jnp.exp(jnp.maximum(diff, 0.0)[None] * log_gamma[:, None, None]), 0.0)
    scores = jnp.einsum('bhnqd,bhnkd->bhnqk', qc, kc) * decay_in[None, :, None]
    inner = jnp.einsum('bhnqk,bhnke->bhnqe', scores, vc)

    q_decay = jnp.exp((idx[None, :] + 1.0) * log_gamma[:, None])
    k_decay = jnp.exp((C - 1.0 - idx[None, :]) * log_gamma[:, None])
    chunk_decay = jnp.exp(C * log_gamma)

    def step(state, inp):
        q_i, k_i, v_i = inp
        cross = jnp.einsum('bhqd,bhde->bhqe', q_i, state) * q_decay[None, :, :, None]
        state = state * chunk_decay[None, :, None, None] + jnp.einsum(
            'bhkd,bhke->bhde', k_i * k_decay[None, :, :, None], v_i)
        return state, cross

    state0 = jnp.zeros((B, H, dk, dv), jnp.float32)
    xs = (qc.transpose(2, 0, 1, 3, 4), kc.transpose(2, 0, 1, 3, 4), vc.transpose(2, 0, 1, 3, 4))
    _, cross = lax.scan(step, state0, xs)
    out = inner + cross.transpose(1, 2, 0, 3, 4)
    out = out.transpose(0, 2, 3, 1, 4).reshape(B, S, H, dv).astype(jnp.float32)
    mu = jnp.mean(out, axis=-1, keepdims=True)
    var = jnp.mean(jnp.square(out - mu), axis=-1, keepdims=True)
    out = ((out - mu) * lax.rsqrt(var + RMS_EPS)).reshape(B, S, H * dv) * gn_gain.astype(jnp.float32)
    y = jax.nn.silu(g.astype(jnp.float32)) * out
    return y.astype(xn.dtype) @ w_out


def conv_ffn(xn, w_in, conv_w, conv_b, w_out):
    S = xn.shape[1]
    u = xn @ w_in
    up = jnp.pad(u, ((0, 0), (CONV_W - 1, 0), (0, 0)))
    c = conv_b
    for tap in range(CONV_W):
        c = c + up[:, tap:tap + S] * conv_w[tap]
    a, b = jnp.split(c, 2, axis=-1)
    return (jax.nn.silu(a) * b) @ w_out


def compress_blocks(t, pe, w1, w2):
    B, S, H, d = t.shape
    n = S // CMP_STRIDE
    n_cmp = n - CMP_RATIO + 1
    ch = t.reshape(B, n, CMP_STRIDE, H, d)
    blocks = jnp.concatenate([ch[:, r:r + n_cmp] for r in range(CMP_RATIO)], axis=2)
    blocks = blocks + pe[None, None, :, None, :]
    blocks = blocks.transpose(0, 1, 3, 2, 4).reshape(B, n_cmp, H, CMP_BLOCK * d)
    return jax.nn.gelu(blocks @ w1) @ w2


def nsa_shared_kv(hn, w_kv, cmp_pe_k, cmp_w1_k, cmp_w2_k, cmp_pe_v, cmp_w1_v, cmp_w2_v):
    B, S, _ = hn.shape
    kv = (hn @ w_kv).reshape(B, S, 2 * N_BRANCH, NSA_KV_HEADS, NSA_HEAD_DIM)
    k_cmp = compress_blocks(kv[:, :, 0], cmp_pe_k, cmp_w1_k, cmp_w2_k)
    v_cmp = compress_blocks(kv[:, :, 1], cmp_pe_v, cmp_w1_v, cmp_w2_v)
    return (k_cmp, v_cmp, kv[:, :, 2], kv[:, :, 3], kv[:, :, 4], kv[:, :, 5])


def nsa_attention(xn, w_q, w_o, k_cmp, v_cmp, k_slc, v_slc, k_win, v_win):
    B, S, _ = xn.shape
    Hkv, G, d, Qb = NSA_KV_HEADS, NSA_GROUP, NSA_HEAD_DIM, NSA_Q_BLOCK
    proj = xn @ w_q
    q = proj[..., :NSA_Q_HEADS * d].reshape(B, S, Hkv, G, d) * (d ** -0.5)
    gates = jax.nn.sigmoid(proj[..., NSA_Q_HEADS * d:].astype(jnp.float32)).reshape(B, S, Hkv, G, N_BRANCH)
    n_cmp = k_cmp.shape[1]
    n_sel = S // SLC_BLOCK
    top_k = min(SLC_TOPK, n_sel)
    cmp_end = jnp.arange(n_cmp) * CMP_STRIDE + CMP_BLOCK - 1
    ks_blk = k_slc.reshape(B, n_sel, SLC_BLOCK, Hkv, d).transpose(0, 3, 1, 2, 4)
    vs_blk = v_slc.reshape(B, n_sel, SLC_BLOCK, Hkv, d).transpose(0, 3, 1, 2, 4)
    kw_pad = jnp.pad(k_win, ((0, 0), (WIN, 0), (0, 0), (0, 0)))
    vw_pad = jnp.pad(v_win, ((0, 0), (WIN, 0), (0, 0), (0, 0)))
    bi = jnp.arange(B)[:, None, None, None]
    hi = jnp.arange(Hkv)[None, None, :, None]
    j_sel = jnp.arange(n_sel)

    def block(start):
        qb = lax.dynamic_slice_in_dim(q, start, Qb, axis=1)
        gb = lax.dynamic_slice_in_dim(gates, start, Qb, axis=1)
        t = start + jnp.arange(Qb)
        s = jnp.einsum('bqhgd,bchd->bhgqc', qb, k_cmp).astype(jnp.float32)
        m_cmp = cmp_end[None, :] <= t[:, None]
        p_cmp = jax.nn.softmax(jnp.where(m_cmp, s, NEG), axis=-1) * m_cmp
        o_cmp = jnp.einsum('bhgqc,bchd->bqhgd', p_cmp.astype(v_cmp.dtype), v_cmp)
        imp = p_cmp.sum(axis=2)
        imp = jnp.pad(imp, ((0, 0), (0, 0), (0, 0), (CMP_RATIO - 1, CMP_RATIO - 1)))
        p_slc = imp[..., 0:SLC_RATIO * n_sel:SLC_RATIO]
        for r in range(1, SLC_RATIO + CMP_RATIO - 1):
            p_slc = p_slc + imp[..., r:r + SLC_RATIO * n_sel:SLC_RATIO]
        cur = t // SLC_BLOCK
        forced = (j_sel[None, :] == 0) | (j_sel[None, :] == cur[:, None]) | (j_sel[None, :] == cur[:, None] - 1)
        valid = j_sel[None, :] <= cur[:, None]
        sel_score = jnp.where(forced, SEL_FORCE, jnp.where(valid, p_slc, NEG))
        _, idx = lax.top_k(sel_score.transpose(0, 2, 1, 3), top_k)
        kg = ks_blk[bi, hi, idx].reshape(B, Qb, Hkv, top_k * SLC_BLOCK, d)
        vg = vs_blk[bi, hi, idx].reshape(B, Qb, Hkv, top_k * SLC_BLOCK, d)
        tok = (idx[..., None] * SLC_BLOCK + jnp.arange(SLC_BLOCK)).reshape(B, Qb, Hkv, top_k * SLC_BLOCK)
        m_slc = (tok <= t[None, :, None, None])[:, :, :, None, :]
        s = jnp.einsum('bqhgd,bqhkd->bqhgk', qb, kg).astype(jnp.float32)
        p = jax.nn.softmax(jnp.where(m_slc, s, NEG), axis=-1)
        o_slc = jnp.einsum('bqhgk,bqhkd->bqhgd', p.astype(vg.dtype), vg)
        kw = lax.dynamic_slice_in_dim(kw_pad, start, WIN + Qb, axis=1)
        vw = lax.dynamic_slice_in_dim(vw_pad, start, WIN + Qb, axis=1)
        pos = start - WIN + jnp.arange(WIN + Qb)
        m_win = (pos[None, :] <= t[:, None]) & (pos[None, :] > t[:, None] - WIN) & (pos[None, :] >= 0)
        s = jnp.einsum('bqhgd,bkhd->bhgqk', qb, kw).astype(jnp.float32)
        p = jax.nn.softmax(jnp.where(m_win, s, NEG), axis=-1)
        o_win = jnp.einsum('bhgqk,bkhd->bqhgd', p.astype(vw.dtype), vw)
        o = gb[..., 0:1] * o_cmp + gb[..., 1:2] * o_slc + gb[..., 2:3] * o_win
        return o.astype(xn.dtype)

    starts = jnp.arange(S // Qb) * Qb
    out = lax.map(block, starts)
    out = out.transpose(1, 0, 2, 3, 4, 5).reshape(B, S, NSA_Q_HEADS * d)
    return out @ w_o


def setup_inputs(seed: int = 0) -> dict:
    key = jax.random.key(seed)
    ks = jax.random.split(key, 24)
    f32 = jnp.float32
    d = NSA_HEAD_DIM

    def nrm(k, shape, scale):
        return jax.random.normal(k, shape, f32) * scale

    return {
        "x": nrm(ks[0], (BATCH, SEQ, D_MODEL), 1.0),
        "norm_mix_gain": 1.0 + nrm(ks[1], (DEPTH, D_MODEL), 0.02),
        "norm_ffn_gain": 1.0 + nrm(ks[2], (DEPTH, D_MODEL), 0.02),
        "ret_w_in": nrm(ks[3], (N_A_LAYERS, D_MODEL, RET_PROJ), D_MODEL ** -0.5),
        "ret_gn_gain": 1.0 + nrm(ks[4], (N_A_LAYERS, RET_HEADS * RET_V_DIM), 0.02),
        "ret_w_out": nrm(ks[5], (N_A_LAYERS, RET_HEADS * RET_V_DIM, D_MODEL), (RET_HEADS * RET_V_DIM) ** -0.5),
        "nsa_kv_norm_gain": 1.0 + nrm(ks[6], (D_MODEL,), 0.02),
        "nsa_w_kv": nrm(ks[7], (D_MODEL, NSA_KV_PROJ), D_MODEL ** -0.5),
        "cmp_pe_k": nrm(ks[8], (CMP_BLOCK, d), 0.1),
        "cmp_w1_k": nrm(ks[9], (CMP_BLOCK * d, CMP_HIDDEN), (CMP_BLOCK * d) ** -0.5),
        "cmp_w2_k": nrm(ks[10], (CMP_HIDDEN, d), CMP_HIDDEN ** -0.5),
        "cmp_pe_v": nrm(ks[11], (CMP_BLOCK, d), 0.1),
        "cmp_w1_v": nrm(ks[12], (CMP_BLOCK * d, CMP_HIDDEN), (CMP_BLOCK * d) ** -0.5),
        "cmp_w2_v": nrm(ks[13], (CMP_HIDDEN, d), CMP_HIDDEN ** -0.5),
        "nsa_w_q": nrm(ks[14], (N_B_LAYERS, D_MODEL, NSA_Q_PROJ), D_MODEL ** -0.5),
        "nsa_w_o": nrm(ks[15], (N_B_LAYERS, NSA_Q_HEADS * d, D_MODEL), (NSA_Q_HEADS * d) ** -0.5),
        "ffn_w_in": nrm(ks[16], (DEPTH, D_MODEL, 2 * D_FF), D_MODEL ** -0.5),
        "ffn_conv_w": nrm(ks[17], (DEPTH, CONV_W, 2 * D_FF), CONV_W ** -0.5),
        "ffn_conv_b": nrm(ks[18], (DEPTH, 2 * D_FF), 0.01),
        "ffn_w_out": nrm(ks[19], (DEPTH, D_FF, D_MODEL), D_FF ** -0.5),
        "final_norm_gain": 1.0 + nrm(ks[20], (D_MODEL,), 0.02),
    }


def reference(x, norm_mix_gain, norm_ffn_gain, ret_w_in, ret_gn_gain, ret_w_out, nsa_kv_norm_gain, nsa_w_kv,
              cmp_pe_k, cmp_w1_k, cmp_w2_k, cmp_pe_v, cmp_w1_v, cmp_w2_v, nsa_w_q, nsa_w_o,
              ffn_w_in, ffn_conv_w, ffn_conv_b, ffn_w_out, final_norm_gain):
    h = x
    shared = None
    for layer in range(DEPTH):
        xn = rmsnorm(h, norm_mix_gain[layer])
        if layer < N_A_LAYERS:
            h = h + retention(xn, ret_w_in[layer], ret_gn_gain[layer], ret_w_out[layer])
        else:
            if layer == N_A_LAYERS:
                shared = nsa_shared_kv(rmsnorm(h, nsa_kv_norm_gain), nsa_w_kv, cmp_pe_k, cmp_w1_k, cmp_w2_k,
                                       cmp_pe_v, cmp_w1_v, cmp_w2_v)
            b = layer - N_A_LAYERS
            h = h + nsa_attention(xn, nsa_w_q[b], nsa_w_o[b], *shared)
        h = h + conv_ffn(rmsnorm(h, norm_ffn_gain[layer]), ffn_w_in[layer], ffn_conv_w[layer],
                         ffn_conv_b[layer], ffn_w_out[layer])
    return rmsnorm(h, final_norm_gain)
```

```cpp
#include <hip/hip_runtime.h>
#include <hip/hip_cooperative_groups.h>
#include <cstdio>
namespace cg = cooperative_groups;

#ifndef MULTI
#define MULTI 0
#endif

#define LAS __attribute__((address_space(3)))
typedef unsigned short bf16_t;
typedef short bf16x8 __attribute__((ext_vector_type(8)));
typedef float f32x4 __attribute__((ext_vector_type(4)));
typedef unsigned u32x2 __attribute__((ext_vector_type(2)));
typedef unsigned u32x4 __attribute__((ext_vector_type(4)));

constexpr int S_ = 16384, D_ = 2048;
constexpr size_t MiB = 1048576;
constexpr size_t OFF_W_RIN = 0, OFF_W_ROUT = 48 * MiB, OFF_W_KV = 64 * MiB, OFF_W_C1K = 76 * MiB, OFF_W_C1V = 78 * MiB,
                 OFF_W_C2K = 80 * MiB, OFF_W_C2V = 80 * MiB + 131072, OFF_W_Q = 81 * MiB, OFF_W_O = 90 * MiB,
                 OFF_W_FIN = 98 * MiB  , OFF_W_FOUT = 162 * MiB  , OFF_ROPE = 194 * MiB, OFF_PEB = 210 * MiB,
                 OFF_XN = 211 * MiB, OFF_ACT = 275 * MiB;
constexpr size_t OFF_Q = OFF_ACT, OFF_K = OFF_ACT + 64 * MiB, OFF_KTD = OFF_ACT + 128 * MiB, OFF_VT = OFF_ACT + 192 * MiB,
                 OFF_ST = OFF_ACT + 320 * MiB, OFF_SD = OFF_ACT + 448 * MiB, OFF_Y = OFF_ACT + 512 * MiB, WS_NEED = OFF_ACT + 640 * MiB;
constexpr size_t OFF_U = OFF_ACT, OFF_AB = OFF_ACT + 256 * MiB;
constexpr size_t OFF_HN = OFF_ACT, OFF_KVTOK = OFF_ACT + 64 * MiB, OFF_KVT = OFF_ACT + 129 * MiB, OFF_QB = OFF_ACT + 161 * MiB,
                 OFF_GATES = OFF_ACT + 225 * MiB, OFF_H1 = OFF_ACT + 229 * MiB, OFF_KCMP = OFF_ACT + 233 * MiB, OFF_VCMPT = OFF_ACT + 234 * MiB,
                 OFF_ATT = OFF_ACT + 235 * MiB, OFF_OACC = OFF_ACT + 299 * MiB;

struct Params {
    const float* x; const float* norm_mix; const float* norm_ffn; const float* ret_w_in; const float* ret_gn; const float* ret_w_out;
    const float* kv_gain; const float* w_kv; const float* pe_k; const float* w1_k; const float* w2_k; const float* pe_v; const float* w1_v;
    const float* w2_v; const float* w_q; const float* w_o; const float* ffn_w_in; const float* ffn_conv_w; const float* ffn_conv_b;
    const float* ffn_w_out; const float* final_gain; float* out; unsigned char* ws;
};

typedef const __attribute__((address_space(4))) Params* CP;
__device__ __forceinline__ int ltid() { int t = threadIdx.x; asm volatile("" : "+v"(t)); return t; }
__device__ __forceinline__ unsigned pk_bf16(float lo, float hi) { unsigned r; asm("v_cvt_pk_bf16_f32 %0, %1, %2" : "=v"(r) : "v"(lo), "v"(hi)); return r; }
__device__ __forceinline__ float bflo(unsigned v) { return __uint_as_float(v << 16); }
__device__ __forceinline__ float bfhi(unsigned v) { return __uint_as_float(v & 0xffff0000u); }
__device__ __forceinline__ float fexp2(float x) { return __builtin_amdgcn_exp2f(x); }
__device__ __forceinline__ float frcp(float x) { return __builtin_amdgcn_rcpf(x); }
__device__ __forceinline__ float log2gamma(int h) { return log2f(1.0f - exp2f(-5.0f - (float)h)); }
__device__ __forceinline__ float sigmoidf_(float x) { return frcp(1.0f + fexp2(-1.4426950408889634f * x)); }

constexpr int HTB = 128 * 64 * 2;
__device__ __forceinline__ int lds_byte(int r, int c) { const int st = (r >> 4) * 2 + (c >> 5), rr = r & 15, cc = c & 31, ob = rr * 64 + cc * 2; return st * 1024 + (ob ^ (((ob >> 9) & 1) << 5)); }
__device__ __forceinline__ void stage_rc(int b, int& R, int& C) { const int st = b / 1024, sb = b % 1024, swz = sb ^ (((sb >> 9) & 1) << 5); R = (st >> 1) * 16 + swz / 64; C = (st & 1) * 32 + (swz % 64) / 2; }
__device__ __forceinline__ void tile_order(int L, int nM, int nN, int& pm, int& pn) {
    const int nwg = nM * nN; int wgid = L;
    { const int q = nwg / 8, r = nwg % 8, xcd = wgid % 8, off = wgid / 8; wgid = (xcd < r ? xcd * (q + 1) : r * (q + 1) + (xcd - r) * q) + off; }
    const int nig = 8 * nN, gid = wgid / nig, fm = gid * 8, gsz = (nM - fm) < 8 ? (nM - fm) : 8;
    pm = fm + ((wgid % nig) % gsz); pn = (wgid % nig) / gsz;
}
struct UInfo { const char* a; const char* b; int r0, c0, x0, x1; };
typedef f32x4 AccT[2][2][4][2];

template <class P>
__device__ __forceinline__ void gemm_phase(LAS unsigned char* lds, const P& pb) {
    const int tid = ltid(), wid = __builtin_amdgcn_readfirstlane(tid >> 6), lane = tid & 63, wr = wid >> 2, wc = wid & 3, fr = lane & 15, fq = lane >> 4;
    const int nt = pb.nt, G = gridDim.x, c = blockIdx.x; const long nun = pb.nunits();
    if (c >= nun) return;
    unsigned voffA[2], voffB[2];
#pragma unroll
    for (int i = 0; i < 2; ++i) { int R, C; stage_rc(tid * 16 + i * 8192, R, C); voffA[i] = pb.rowA(R) + (unsigned)C * 2u; voffB[i] = (unsigned)R * pb.ldb + (unsigned)C * 2u; }
    const size_t hsA = pb.rowA(128), hsB = (size_t)128 * pb.ldb;
    const unsigned ldsw = (unsigned)wid * 1024u;
    const int aoff = lds_byte(wr * 64 + fr, fq * 8), boff = lds_byte(wc * 32 + fr, fq * 8);
#define G_SA(b, h) (((b) * 2 + (h)) * HTB)
#define G_SB(b, h) ((4 + (b) * 2 + (h)) * HTB)
#define G_STAGE(bufoff, gbase, voff) do { _Pragma("unroll") for (int _i = 0; _i < 2; ++_i) \
        __builtin_amdgcn_global_load_lds((const unsigned*)((const char*)(gbase) + (voff)[_i]), (LAS unsigned*)(lds + (bufoff) + ldsw + _i * 8192), 16, 0, 0); } while (0)
#define G_LDA(dst, b, h) do { _Pragma("unroll") for (int m = 0; m < 4; ++m) _Pragma("unroll") for (int k = 0; k < 2; ++k) dst[m][k] = *(const LAS bf16x8*)(lds + G_SA(b, h) + aoff + m * 2048 + k * 1024); } while (0)
#define G_LDB(dst, b, h) do { _Pragma("unroll") for (int n = 0; n < 2; ++n) _Pragma("unroll") for (int k = 0; k < 2; ++k) dst[n][k] = *(const LAS bf16x8*)(lds + G_SB(b, h) + boff + n * 2048 + k * 1024); } while (0)
#define G_MMA(ai, bj, At, Bt) do { __builtin_amdgcn_s_setprio(1); _Pragma("unroll") for (int m = 0; m < 4; ++m) _Pragma("unroll") for (int n = 0; n < 2; ++n) _Pragma("unroll") for (int k = 0; k < 2; ++k) \
        acc[ai][bj][m][n] = __builtin_amdgcn_mfma_f32_16x16x32_bf16(Bt[n][k], At[m][k], acc[ai][bj][m][n], 0, 0, 0); __builtin_amdgcn_s_setprio(0); } while (0)
#define G_WAIT_V(n) asm volatile("s_waitcnt vmcnt(" #n ")" ::: "memory")
#define G_WAIT_L(n) asm volatile("s_waitcnt lgkmcnt(" #n ")" ::: "memory")
#define G_BAR __builtin_amdgcn_s_barrier()
#define G_SCHED __builtin_amdgcn_sched_barrier(0)
    UInfo cur, nxt; int ui = 0;
    pb.unit(c, cur);
    AccT acc;
#pragma unroll
    for (int a = 0; a < 2; ++a)
#pragma unroll
        for (int b = 0; b < 2; ++b)
#pragma unroll
            for (int m = 0; m < 4; ++m)
#pragma unroll
                for (int n = 0; n < 2; ++n) acc[a][b][m][n] = (f32x4){0.f, 0.f, 0.f, 0.f};
    bf16x8 At[4][2], B0[2][2], B1[2][2];
    const char* cA = cur.a; const char* cB = cur.b;
    G_STAGE(G_SB(0, 0), cB + pb.bK(0), voffB); G_STAGE(G_SA(0, 0), cA + pb.aK(0), voffA); G_STAGE(G_SB(0, 1), cB + hsB + pb.bK(0), voffB); G_STAGE(G_SA(0, 1), cA + hsA + pb.aK(0), voffA);
    if (wr == 1) G_BAR;
    G_WAIT_V(4); G_BAR;
    G_STAGE(G_SB(1, 0), cB + pb.bK(1), voffB); G_STAGE(G_SA(1, 0), cA + pb.aK(1), voffA); G_STAGE(G_SB(1, 1), cB + hsB + pb.bK(1), voffB);
    G_WAIT_V(6); G_BAR;
    for (;;) {
        const long Ln = (long)(ui + 1) * G + c; const bool has_next = Ln < nun;
        if (has_next) pb.unit(Ln, nxt);
        const char* nA = has_next ? nxt.a : cA; const char* nB = has_next ? nxt.b : cB;
        for (int t = 0; t < nt; t += 2) {
            const bool last = (t == nt - 2);
            const char* a1 = cA + pb.aK(t + 1);
            const char* a2 = last ? nA + pb.aK(0) : cA + pb.aK(t + 2); const char* b2 = last ? nB + pb.bK(0) : cB + pb.bK(t + 2);
            const char* a3 = last ? nA + pb.aK(1) : cA + pb.aK(t + 3); const char* b3 = last ? nB + pb.bK(1) : cB + pb.bK(t + 3);
            G_LDB(B0, 0, 0); G_SCHED; G_LDA(At, 0, 0); G_STAGE(G_SA(1, 1), a1 + hsA, voffA);
            G_WAIT_L(8); G_BAR; G_WAIT_L(0); G_MMA(0, 0, At, B0); G_BAR; G_SCHED;
            G_LDB(B1, 0, 1); G_STAGE(G_SB(0, 0), b2, voffB);
            G_BAR; G_WAIT_L(0); G_MMA(0, 1, At, B1); G_BAR;
            G_LDA(At, 0, 1); G_STAGE(G_SA(0, 0), a2, voffA);
            G_BAR; G_WAIT_L(0); G_MMA(1, 0, At, B0); G_BAR; G_SCHED;
            G_STAGE(G_SB(0, 1), b2 + hsB, voffB);
            G_WAIT_V(6); G_BAR; G_MMA(1, 1, At, B1); G_BAR;
            G_LDB(B0, 1, 0); G_SCHED; G_LDA(At, 1, 0); G_STAGE(G_SA(0, 1), a2 + hsA, voffA);
            G_WAIT_L(8); G_BAR; G_WAIT_L(0); G_MMA(0, 0, At, B0); G_BAR; G_SCHED;
            G_LDB(B1, 1, 1); G_STAGE(G_SB(1, 0), b3, voffB);
            G_BAR; G_WAIT_L(0); G_MMA(0, 1, At, B1); G_BAR;
            G_LDA(At, 1, 1); G_STAGE(G_SA(1, 0), a3, voffA);
            G_BAR; G_WAIT_L(0); G_MMA(1, 0, At, B0); G_BAR; G_SCHED;
            G_STAGE(G_SB(1, 1), b3 + hsB, voffB);
            G_WAIT_V(6); G_BAR; G_MMA(1, 1, At, B1); G_BAR;
        }
        { const int l2 = ltid() & 63; pb.epi(acc, cur, wr, wc, l2 & 15, l2 >> 4); }
        if (!has_next) break;
#pragma unroll
        for (int a = 0; a < 2; ++a)
#pragma unroll
            for (int b = 0; b < 2; ++b)
#pragma unroll
                for (int m = 0; m < 4; ++m)
#pragma unroll
                    for (int n = 0; n < 2; ++n) acc[a][b][m][n] = (f32x4){0.f, 0.f, 0.f, 0.f};
        cur = nxt; cA = nA; cB = nB; ++ui;
    }
    G_WAIT_V(0);
    if (wr == 0) G_BAR;
    G_BAR;
}

#define EPI_ROWS for (int ai = 0; ai < 2; ++ai) for (int m = 0; m < 4; ++m)
#define EPI_COLS for (int bj = 0; bj < 2; ++bj) for (int n = 0; n < 2; ++n)
#define EPI_ROW (128 * ai + 64 * wr + 16 * m + fr)
#define EPI_COL (128 * bj + 32 * wc + 16 * n + 4 * fq)

template <class Epi> struct Prob2D {
    const char* A; const char* B; unsigned lda, ldb; int nt, nM, nN; Epi e;
    __device__ __forceinline__ long nunits() const { return (long)nM * nN; }
    __device__ __forceinline__ unsigned rowA(int R) const { return (unsigned)R * lda; }
    __device__ __forceinline__ void unit(long L, UInfo& u) const { int pm, pn; tile_order((int)L, nM, nN, pm, pn); u.a = A + (size_t)pm * 256 * lda; u.b = B + (size_t)pn * 256 * ldb; u.r0 = pm * 256; u.c0 = pn * 256; u.x0 = 0; u.x1 = 0; }
    __device__ __forceinline__ size_t aK(int kt) const { return (size_t)kt * 128; }
    __device__ __forceinline__ size_t bK(int kt) const { return (size_t)kt * 128; }
    __device__ __forceinline__ void epi(const AccT& acc, const UInfo& u, int wr, int wc, int fr, int fq) const { e(acc, u, wr, wc, fr, fq); }
};
struct EpiStore { bf16_t* O; size_t ldc;
    __device__ __forceinline__ void operator()(const AccT& acc, const UInfo& u, int wr, int wc, int fr, int fq) const {
#pragma unroll
        EPI_ROWS { bf16_t* rp = O + (size_t)(u.r0 + EPI_ROW) * ldc + u.c0;
#pragma unroll
            EPI_COLS { const f32x4 v = acc[ai][bj][m][n]; *(u32x2*)(rp + EPI_COL) = (u32x2){pk_bf16(v[0], v[1]), pk_bf16(v[2], v[3])}; } }
    } };
struct EpiRes { const float* R; float* O;
    __device__ __forceinline__ void operator()(const AccT& acc, const UInfo& u, int wr, int wc, int fr, int fq) const {
#pragma unroll
        EPI_ROWS { const size_t ro = (size_t)(u.r0 + EPI_ROW) * 2048 + u.c0;
#pragma unroll
            EPI_COLS { const f32x4 r = *(const f32x4*)(R + ro + EPI_COL); *(f32x4*)(O + ro + EPI_COL) = r + acc[ai][bj][m][n]; } }
    } };
struct EpiGate { bf16_t* Y;
    __device__ __forceinline__ void operator()(const AccT& acc, const UInfo& u, int wr, int wc, int fr, int fq) const {
#pragma unroll
        EPI_ROWS { bf16_t* rp = Y + (size_t)(u.r0 + EPI_ROW) * 4096 + u.c0;
#pragma unroll
            EPI_COLS { const f32x4 g = acc[ai][bj][m][n]; const u32x2 y = *(const u32x2*)(rp + EPI_COL);
                const float o0 = g[0] * sigmoidf_(g[0]) * bflo(y[0]), o1 = g[1] * sigmoidf_(g[1]) * bfhi(y[0]), o2 = g[2] * sigmoidf_(g[2]) * bflo(y[1]), o3 = g[3] * sigmoidf_(g[3]) * bfhi(y[1]);
                *(u32x2*)(rp + EPI_COL) = (u32x2){pk_bf16(o0, o1), pk_bf16(o2, o3)}; } }
    } };
struct EpiQK { bf16_t* Q; bf16_t* K; bf16_t* KTD; const float2* rope;
    __device__ __forceinline__ void operator()(const AccT& acc, const UInfo& u, int wr, int wc, int fr, int fq) const {
        const int hidx = u.c0 >> 8; const bool isk = hidx >= 8; const int hh = hidx & 7; const float l2g = log2gamma(hh);
        bf16_t* dst = (isk ? K : Q) + hh * 256; const float sc = isk ? 0.0625f : 1.0f;
#pragma unroll
        EPI_ROWS { const int t = u.r0 + EPI_ROW; const float kd = fexp2((float)(255 - (t & 255)) * l2g);
#pragma unroll
            for (int n = 0; n < 2; ++n) { const int dd = 32 * wc + 16 * n + 4 * fq;
                const f32x4 x1 = acc[ai][0][m][n], x2 = acc[ai][1][m][n]; const f32x4 cs0 = *(const f32x4*)(rope + (size_t)t * 128 + dd), cs1 = *(const f32x4*)(rope + (size_t)t * 128 + dd + 2);
                float y1[4], y2[4];
                y1[0] = (x1[0] * cs0[0] - x2[0] * cs0[1]) * sc; y2[0] = (x1[0] * cs0[1] + x2[0] * cs0[0]) * sc;
                y1[1] = (x1[1] * cs0[2] - x2[1] * cs0[3]) * sc; y2[1] = (x1[1] * cs0[3] + x2[1] * cs0[2]) * sc;
                y1[2] = (x1[2] * cs1[0] - x2[2] * cs1[1]) * sc; y2[2] = (x1[2] * cs1[1] + x2[2] * cs1[0]) * sc;
                y1[3] = (x1[3] * cs1[2] - x2[3] * cs1[3]) * sc; y2[3] = (x1[3] * cs1[3] + x2[3] * cs1[2]) * sc;
                *(u32x2*)(dst + (size_t)t * 2048 + dd) = (u32x2){pk_bf16(y1[0], y1[1]), pk_bf16(y1[2], y1[3])};
                *(u32x2*)(dst + (size_t)t * 2048 + 128 + dd) = (u32x2){pk_bf16(y2[0], y2[1]), pk_bf16(y2[2], y2[3])};
                if (isk) {
#pragma unroll
                    for (int j = 0; j < 4; ++j) { KTD[(size_t)(hh * 256 + dd + j) * S_ + t] = (bf16_t)(pk_bf16(y1[j] * kd, 0.f) & 0xffffu); KTD[(size_t)(hh * 256 + 128 + dd + j) * S_ + t] = (bf16_t)(pk_bf16(y2[j] * kd, 0.f) & 0xffffu); }
                } } }
    } };
struct EpiQproj { bf16_t* QB; float* gates;
    __device__ __forceinline__ void operator()(const AccT& acc, const UInfo& u, int wr, int wc, int fr, int fq) const {
#pragma unroll
        EPI_ROWS { const int t = u.r0 + EPI_ROW;
#pragma unroll
            EPI_COLS { const int col = u.c0 + EPI_COL; const f32x4 v = acc[ai][bj][m][n];
                if (col < 2048) *(u32x2*)(QB + (size_t)t * 2048 + col) = (u32x2){pk_bf16(v[0] * 0.08838834764831845f, v[1] * 0.08838834764831845f), pk_bf16(v[2] * 0.08838834764831845f, v[3] * 0.08838834764831845f)};
                else if (col < 2096) *(f32x4*)(gates + (size_t)t * 48 + (col - 2048)) = (f32x4){sigmoidf_(v[0]), sigmoidf_(v[1]), sigmoidf_(v[2]), sigmoidf_(v[3])}; } }
    } };
__device__ __forceinline__ float gelu_tanh(float x) { const float y = 0.7978845608028654f * (x + 0.044715f * x * x * x); const float e = fexp2(2.0f * 1.4426950408889634f * y); const float th = 1.0f - 2.0f * frcp(e + 1.0f); return 0.5f * x * (1.0f + th); }
struct EpiGelu { bf16_t* H; const float* bias;
    __device__ __forceinline__ void operator()(const AccT& acc, const UInfo& u, int wr, int wc, int fr, int fq) const {
#pragma unroll
        EPI_ROWS { bf16_t* rp = H + (size_t)(u.r0 + EPI_ROW) * 256;
#pragma unroll
            EPI_COLS { const int col = EPI_COL; const f32x4 v = acc[ai][bj][m][n]; const f32x4 bb = *(const f32x4*)(bias + col);
                *(u32x2*)(rp + col) = (u32x2){pk_bf16(gelu_tanh(v[0] + bb[0]), gelu_tanh(v[1] + bb[1])), pk_bf16(gelu_tanh(v[2] + bb[2]), gelu_tanh(v[3] + bb[3]))}; } }
    } };
struct EpiKcmp { bf16_t* KC;
    __device__ __forceinline__ void operator()(const AccT& acc, const UInfo& u, int wr, int wc, int fr, int fq) const {
#pragma unroll
        EPI_ROWS { const int r = u.r0 + EPI_ROW, i = r >> 2, h = r & 3;
#pragma unroll
            for (int n = 0; n < 2; ++n) { const int col = 32 * wc + 16 * n + 4 * fq; f32x4 v = acc[ai][0][m][n]; if (i == 1023) v = (f32x4){0.f, 0.f, 0.f, 0.f};
                *(u32x2*)(KC + ((size_t)h * 1024 + i) * 128 + col) = (u32x2){pk_bf16(v[0], v[1]), pk_bf16(v[2], v[3])}; } }
    } };
struct EpiVcmp { bf16_t* VC;
    __device__ __forceinline__ void operator()(const AccT& acc, const UInfo& u, int wr, int wc, int fr, int fq) const {
#pragma unroll
        for (int m = 0; m < 4; ++m) { const int d = 64 * wr + 16 * m + fr;
#pragma unroll
            EPI_COLS { const int col = u.c0 + EPI_COL, i = col >> 2; f32x4 v = acc[0][bj][m][n]; if (i == 1023) v = (f32x4){0.f, 0.f, 0.f, 0.f};
#pragma unroll
                for (int h = 0; h < 4; ++h) VC[((size_t)h * 128 + d) * 1024 + i] = (bf16_t)(pk_bf16(v[h], 0.f) & 0xffffu); } }
    } };
struct ProbCmp1 {
    const char* A; const char* B; unsigned ldb; int nt, nM; EpiGelu e;
    __device__ __forceinline__ long nunits() const { return nM; }
    __device__ __forceinline__ unsigned rowA(int R) const { return (unsigned)(R >> 2) * 65536u + (unsigned)(R & 3) * 256u; }
    __device__ __forceinline__ void unit(long L, UInfo& u) const { u.a = A + (size_t)L * 64 * 65536; u.b = B; u.r0 = (int)L * 256; u.c0 = 0; u.x0 = 0; u.x1 = 0; }
    __device__ __forceinline__ size_t aK(int kt) const { return (size_t)(kt >> 1) * 4096 + (size_t)(kt & 1) * 128; }
    __device__ __forceinline__ size_t bK(int kt) const { return (size_t)kt * 128; }
    __device__ __forceinline__ void epi(const AccT& acc, const UInfo& u, int wr, int wc, int fr, int fq) const { e(acc, u, wr, wc, fr, fq); }
};
struct ProbKV {
    const char* VT; const char* KTD; bf16_t* ST; int nt;
    __device__ __forceinline__ long nunits() const { return 8 * 64 * 2; }
    __device__ __forceinline__ unsigned rowA(int R) const { return (unsigned)R * 32768u; }
    static constexpr unsigned ldb = 32768u;
    __device__ __forceinline__ void unit(long L, UInfo& u) const { const int pm = (int)L & 1, c = ((int)L >> 1) & 63, h = (int)L >> 7;
        u.a = VT + ((size_t)(h * 512 + pm * 256) * S_ + c * 256) * 2; u.b = KTD + ((size_t)(h * 256) * S_ + c * 256) * 2; u.r0 = h * 512 + pm * 256; u.c0 = c * 256; u.x0 = 0; u.x1 = 0; }
    __device__ __forceinline__ size_t aK(int kt) const { return (size_t)kt * 128; }
    __device__ __forceinline__ size_t bK(int kt) const { return (size_t)kt * 128; }
    __device__ __forceinline__ void epi(const AccT& acc, const UInfo& u, int wr, int wc, int fr, int fq) const { EpiStore e{ST, (size_t)S_}; e(acc, u, wr, wc, fr, fq); }
};
struct ProbS {
    const char* Q; const char* K; bf16_t* SD; int nt;
    __device__ __forceinline__ long nunits() const { return 8 * 64; }
    __device__ __forceinline__ unsigned rowA(int R) const { return (unsigned)R * 4096u; }
    static constexpr unsigned ldb = 4096u;
    __device__ __forceinline__ void unit(long L, UInfo& u) const { const int c = (int)L & 63, h = (int)L >> 6; const size_t o = ((size_t)(c * 256) * 2048 + h * 256) * 2;
        u.a = Q + o; u.b = K + o; u.r0 = c * 256; u.c0 = h * 256; u.x0 = h; u.x1 = 0; }
    __device__ __forceinline__ size_t aK(int kt) const { return (size_t)kt * 128; }
    __device__ __forceinline__ size_t bK(int kt) const { return (size_t)kt * 128; }
    __device__ __forceinline__ void epi(const AccT& acc, const UInfo& u, int wr, int wc, int fr, int fq) const {
        const float l2g = log2gamma(u.x0);
#pragma unroll
        EPI_ROWS { const int i = EPI_ROW; bf16_t* rp = SD + (size_t)(u.r0 + i) * 2048 + u.c0;
#pragma unroll
            EPI_COLS { const int s = EPI_COL; const f32x4 v = acc[ai][bj][m][n]; float o[4];
#pragma unroll
                for (int j = 0; j < 4; ++j) o[j] = (s + j <= i) ? v[j] * fexp2(-(float)(s + j + 1) * l2g) : 0.f;
                *(u32x2*)(rp + s) = (u32x2){pk_bf16(o[0], o[1]), pk_bf16(o[2], o[3])}; } }
    }
};
struct ProbOut {
    const char* Q; const char* ST; long dA, dB; bf16_t* Y; int nt;
    __device__ __forceinline__ long nunits() const { return 8 * 64 * 2; }
    __device__ __forceinline__ unsigned rowA(int R) const { return (unsigned)R * 4096u; }
    static constexpr unsigned ldb = 32768u;
    __device__ __forceinline__ void unit(long L, UInfo& u) const { const int pn = (int)L & 1, c = ((int)L >> 1) & 63, h = (int)L >> 7;
        u.a = Q + ((size_t)(c * 256) * 2048 + h * 256) * 2; u.b = ST + ((size_t)(h * 512 + pn * 256) * S_ + c * 256) * 2; u.r0 = c * 256; u.c0 = h * 512 + pn * 256; u.x0 = h; u.x1 = 0; }
    __device__ __forceinline__ size_t aK(int kt) const { return kt < 4 ? (size_t)kt * 128 : (size_t)(dA + (long)(kt - 4) * 128); }
    __device__ __forceinline__ size_t bK(int kt) const { return kt < 4 ? (size_t)kt * 128 : (size_t)(dB + (long)(kt - 4) * 128); }
    __device__ __forceinline__ void epi(const AccT& acc, const UInfo& u, int wr, int wc, int fr, int fq) const {
        const float l2g = log2gamma(u.x0);
#pragma unroll
        EPI_ROWS { const int i = EPI_ROW; const float qd = fexp2((float)(i + 1) * l2g); bf16_t* rp = Y + (size_t)(u.r0 + i) * 4096 + u.c0;
#pragma unroll
            EPI_COLS { const f32x4 v = acc[ai][bj][m][n] * qd; *(u32x2*)(rp + EPI_COL) = (u32x2){pk_bf16(v[0], v[1]), pk_bf16(v[2], v[3])}; } }
    }
};

__device__ __forceinline__ float shx(float v, int m, int lane) { return __int_as_float(__builtin_amdgcn_ds_bpermute((lane ^ m) << 2, __float_as_int(v))); }
__device__ __forceinline__ unsigned long long shx64(unsigned long long v, int m, int lane) {
    const unsigned lo = (unsigned)__builtin_amdgcn_ds_bpermute((lane ^ m) << 2, (int)(unsigned)v), hi = (unsigned)__builtin_amdgcn_ds_bpermute((lane ^ m) << 2, (int)(unsigned)(v >> 32));
    return ((unsigned long long)hi << 32) | lo; }
__device__ __forceinline__ float wave_sum(float v, int lane) {
#pragma unroll
    for (int o = 32; o >= 1; o >>= 1) v += shx(v, o, lane);
    return v;
}
__device__ __forceinline__ void transpose_job(const float* __restrict__ src, bf16_t* __restrict__ dst, int K, int N, int Npad, int kvperm, LAS float* tile) {
    const int tk = K / 64, tn = Npad / 64, ntile = tk * tn; const int tid = ltid();
    for (int t = blockIdx.x; t < ntile; t += gridDim.x) {
        const int k0 = (t % tk) * 64, n0 = (t / tk) * 64;
        { const int r0 = tid >> 6, cc = tid & 63;
#pragma unroll
          for (int i = 0; i < 8; ++i) { const int r = r0 + 8 * i, n = n0 + cc; tile[r * 65 + cc] = (n < N) ? src[(size_t)(k0 + r) * N + n] : 0.f; } }
        __syncthreads();
        { const int rr = tid >> 3, cc = (tid & 7) * 8; float v[8];
#pragma unroll
          for (int j = 0; j < 8; ++j) v[j] = tile[(cc + j) * 65 + rr];
          int n = n0 + rr; if (kvperm) { const int j = n >> 9; const int jp = (j == 3) ? 4 : ((j == 4) ? 3 : j); n = jp * 512 + (n & 511); }
          *(u32x4*)(dst + (size_t)n * K + k0 + cc) = (u32x4){pk_bf16(v[0], v[1]), pk_bf16(v[2], v[3]), pk_bf16(v[4], v[5]), pk_bf16(v[6], v[7])}; }
        __syncthreads();
    }
}
__device__ __forceinline__ void prep_phase(CP p, LAS unsigned char* lds) {
    LAS float* tile = (LAS float*)lds; unsigned char* ws = p->ws;
    transpose_job(p->ret_w_in, (bf16_t*)(ws + OFF_W_RIN), 2048, 12288, 12288, 0, tile);
    transpose_job(p->ret_w_out, (bf16_t*)(ws + OFF_W_ROUT), 4096, 2048, 2048, 0, tile);
    transpose_job(p->w_kv, (bf16_t*)(ws + OFF_W_KV), 2048, 3072, 3072, 1, tile);
    transpose_job(p->w1_k, (bf16_t*)(ws + OFF_W_C1K), 4096, 256, 256, 0, tile);
    transpose_job(p->w1_v, (bf16_t*)(ws + OFF_W_C1V), 4096, 256, 256, 0, tile);
    transpose_job(p->w2_k, (bf16_t*)(ws + OFF_W_C2K), 256, 128, 256, 0, tile);
    transpose_job(p->w2_v, (bf16_t*)(ws + OFF_W_C2V), 256, 128, 256, 0, tile);
    transpose_job(p->w_q, (bf16_t*)(ws + OFF_W_Q), 2048, 2096, 2304, 0, tile);
    transpose_job(p->w_o, (bf16_t*)(ws + OFF_W_O), 2048, 2048, 2048, 0, tile);
    transpose_job(p->ffn_w_in, (bf16_t*)(ws + OFF_W_FIN), 2048, 8192, 8192, 0, tile);
    transpose_job(p->ffn_w_in + (size_t)2048 * 8192, (bf16_t*)(ws + OFF_W_FIN + 32 * MiB), 2048, 8192, 8192, 0, tile);
    transpose_job(p->ffn_w_out, (bf16_t*)(ws + OFF_W_FOUT), 4096, 2048, 2048, 0, tile);
    transpose_job(p->ffn_w_out + (size_t)4096 * 2048, (bf16_t*)(ws + OFF_W_FOUT + 16 * MiB), 4096, 2048, 2048, 0, tile);
    { float2* rope = (float2*)(ws + OFF_ROPE); const int gsz = gridDim.x * 512;
      for (int i = blockIdx.x * 512 + ltid(); i < S_ * 128; i += gsz) { const int t = i >> 7, dd = i & 127;
          const float freq = exp2f(-(float)dd * (13.287712379549449f / 128.0f)); const double rev = (double)t * (double)freq * 0.15915494309189535;
          const float fx = (float)(rev - rint(rev)); rope[i] = make_float2(__builtin_amdgcn_cosf(fx), __builtin_amdgcn_sinf(fx)); } }
    if (blockIdx.x < 2) { const float* pe = blockIdx.x ? p->pe_v : p->pe_k; const float* w1 = blockIdx.x ? p->w1_v : p->w1_k; float* peb = (float*)(ws + OFF_PEB) + blockIdx.x * 256;
        const int n = ltid() & 255, half = ltid() >> 8; float s = 0.f;
        for (int k = half * 2048; k < half * 2048 + 2048; ++k) s += pe[k] * w1[(size_t)k * 256 + n];
        __syncthreads(); tile[ltid()] = s; __syncthreads();
        if (ltid() < 256) peb[n] = tile[ltid()] + tile[ltid() + 256];
        __syncthreads(); }
}
__device__ __forceinline__ void rmsnorm_phase(const float* h, const float* g1, bf16_t* o1, const float* g2, bf16_t* o2) {
    const int w = ltid() >> 6, lane = ltid() & 63;
    for (int row = blockIdx.x * 8 + w; row < S_; row += gridDim.x * 8) {
        const f32x4* p = (const f32x4*)(h + (size_t)row * 2048); f32x4 v[8]; float ss = 0.f;
#pragma unroll
        for (int i = 0; i < 8; ++i) { v[i] = p[lane + 64 * i]; ss += v[i][0] * v[i][0] + v[i][1] * v[i][1] + v[i][2] * v[i][2] + v[i][3] * v[i][3]; }
        ss = wave_sum(ss, lane); const float r = rsqrtf(ss * (1.0f / 2048.0f) + 1e-6f);
#pragma unroll
        for (int i = 0; i < 8; ++i) { const int col = (lane + 64 * i) * 4; const f32x4 g = *(const f32x4*)(g1 + col);
            *(u32x2*)(o1 + (size_t)row * 2048 + col) = (u32x2){pk_bf16(v[i][0] * r * g[0], v[i][1] * r * g[1]), pk_bf16(v[i][2] * r * g[2], v[i][3] * r * g[3])};
            if (o2) { const f32x4 gg = *(const f32x4*)(g2 + col);
                *(u32x2*)(o2 + (size_t)row * 2048 + col) = (u32x2){pk_bf16(v[i][0] * r * gg[0], v[i][1] * r * gg[1]), pk_bf16(v[i][2] * r * gg[2], v[i][3] * r * gg[3])}; } }
    }
}
__device__ __forceinline__ void finalnorm_phase(float* h, const float* g1) {
    const int w = ltid() >> 6, lane = ltid() & 63;
    for (int row = blockIdx.x * 8 + w; row < S_; row += gridDim.x * 8) {
        f32x4* p = (f32x4*)(h + (size_t)row * 2048); f32x4 v[8]; float ss = 0.f;
#pragma unroll
        for (int i = 0; i < 8; ++i) { v[i] = p[lane + 64 * i]; ss += v[i][0] * v[i][0] + v[i][1] * v[i][1] + v[i][2] * v[i][2] + v[i][3] * v[i][3]; }
        ss = wave_sum(ss, lane); const float r = rsqrtf(ss * (1.0f / 2048.0f) + 1e-6f);
#pragma unroll
        for (int i = 0; i < 8; ++i) { const f32x4 g = *(const f32x4*)(g1 + (lane + 64 * i) * 4); p[lane + 64 * i] = v[i] * r * g; }
    }
}
__device__ __forceinline__ void scan_phase(bf16_t* ST) {
    for (int it = blockIdx.x * 512 + ltid(); it < 4096 * 32; it += gridDim.x * 512) {
        const int r = it >> 5, d8 = it & 31; const float cd = fexp2(256.0f * log2gamma(r >> 9));
        bf16_t* p = ST + (size_t)r * S_ + d8 * 8; float s[8];
#pragma unroll
        for (int j = 0; j < 8; ++j) s[j] = 0.f;
        for (int c = 0; c < 64; ++c) { const u32x4 v = *(const u32x4*)(p + c * 256);
            *(u32x4*)(p + c * 256) = (u32x4){pk_bf16(s[0], s[1]), pk_bf16(s[2], s[3]), pk_bf16(s[4], s[5]), pk_bf16(s[6], s[7])};
#pragma unroll
            for (int j = 0; j < 4; ++j) { s[2 * j] = s[2 * j] * cd + bflo(v[j]); s[2 * j + 1] = s[2 * j + 1] * cd + bfhi(v[j]); } }
    }
}
__device__ __forceinline__ void gn_phase(bf16_t* Y, const float* gain) {
    const int w = ltid() >> 6, lane = ltid() & 63;
    for (int g = blockIdx.x * 8 + w; g < S_ * 8; g += gridDim.x * 8) {
        bf16_t* p = Y + (size_t)g * 512 + lane * 8; const u32x4 v = *(const u32x4*)p; float x[8];
#pragma unroll
        for (int j = 0; j < 4; ++j) { x[2 * j] = bflo(v[j]); x[2 * j + 1] = bfhi(v[j]); }
        float s = 0.f;
#pragma unroll
        for (int j = 0; j < 8; ++j) s += x[j];
        const float mu = wave_sum(s, lane) * (1.0f / 512.0f); float q = 0.f;
#pragma unroll
        for (int j = 0; j < 8; ++j) { x[j] -= mu; q += x[j] * x[j]; }
        const float r = rsqrtf(wave_sum(q, lane) * (1.0f / 512.0f) + 1e-6f); const float* gp = gain + (g & 7) * 512 + lane * 8;
        const f32x4 g0 = *(const f32x4*)gp, g1 = *(const f32x4*)(gp + 4);
        *(u32x4*)p = (u32x4){pk_bf16(x[0] * r * g0[0], x[1] * r * g0[1]), pk_bf16(x[2] * r * g0[2], x[3] * r * g0[3]), pk_bf16(x[4] * r * g1[0], x[5] * r * g1[1]), pk_bf16(x[6] * r * g1[2], x[7] * r * g1[3])};
    }
}
__device__ __forceinline__ void conv_phase(const bf16_t* U, bf16_t* AB, const float* cw, const float* cb) {
    for (int it = blockIdx.x * 512 + ltid(); it < 2048 * 512; it += gridDim.x * 512) {
        const int n8 = (it & 511) * 8, t0 = (it >> 9) * 8;
        float wa[3][8], wb[3][8], ba[8], bb[8];
#pragma unroll
        for (int tp = 0; tp < 3; ++tp)
#pragma unroll
            for (int j = 0; j < 8; ++j) { wa[tp][j] = cw[tp * 8192 + n8 + j]; wb[tp][j] = cw[tp * 8192 + 4096 + n8 + j]; }
#pragma unroll
        for (int j = 0; j < 8; ++j) { ba[j] = cb[n8 + j]; bb[j] = cb[4096 + n8 + j]; }
        float pa[2][8], pb[2][8];
#pragma unroll
        for (int k = 0; k < 2; ++k) { const int t = t0 - 2 + k; u32x4 va = (u32x4){0, 0, 0, 0}, vb = (u32x4){0, 0, 0, 0};
            if (t >= 0) { va = *(const u32x4*)(U + (size_t)t * 8192 + n8); vb = *(const u32x4*)(U + (size_t)t * 8192 + 4096 + n8); }
#pragma unroll
            for (int j = 0; j < 4; ++j) { pa[k][2 * j] = bflo(va[j]); pa[k][2 * j + 1] = bfhi(va[j]); pb[k][2 * j] = bflo(vb[j]); pb[k][2 * j + 1] = bfhi(vb[j]); } }
#pragma unroll
        for (int k = 0; k < 8; ++k) { const int t = t0 + k; const u32x4 va = *(const u32x4*)(U + (size_t)t * 8192 + n8), vb = *(const u32x4*)(U + (size_t)t * 8192 + 4096 + n8);
            float xa[8], xb[8], o[8];
#pragma unroll
            for (int j = 0; j < 4; ++j) { xa[2 * j] = bflo(va[j]); xa[2 * j + 1] = bfhi(va[j]); xb[2 * j] = bflo(vb[j]); xb[2 * j + 1] = bfhi(vb[j]); }
#pragma unroll
            for (int j = 0; j < 8; ++j) { const float a = ba[j] + wa[0][j] * pa[0][j] + wa[1][j] * pa[1][j] + wa[2][j] * xa[j]; const float b = bb[j] + wb[0][j] * pb[0][j] + wb[1][j] * pb[1][j] + wb[2][j] * xb[j];
                o[j] = a * sigmoidf_(a) * b; pa[0][j] = pa[1][j]; pa[1][j] = xa[j]; pb[0][j] = pb[1][j]; pb[1][j] = xb[j]; }
            *(u32x4*)(AB + (size_t)t * 4096 + n8) = (u32x4){pk_bf16(o[0], o[1]), pk_bf16(o[2], o[3]), pk_bf16(o[4], o[5]), pk_bf16(o[6], o[7])}; }
    }
}

constexpr int A_KT = 0, A_VT = 17408, A_PSL = 34816, A_SEL = 34816 + 65536;
constexpr float LOG2E = 1.4426950408889634f;
struct AttnState { f32x4 ot[8][2]; float m[2], l[2]; };

template <int MODE>
__device__ __forceinline__ void attn_tiles(LAS unsigned char* lds, const bf16_t* kp, size_t kstride, const bf16_t* vp, size_t vstride, int tile_lo, int tile_hi,
                                           const bf16x8 (&qf)[2][4], AttnState& st, const int (&tpos)[2], int qb, int w, int lane, const float (&mfin)[2], const float (&linv)[2]) {
    int tid = w * 64 + lane; asm volatile("" : "+v"(tid)); const int l16 = lane & 15, g4 = lane >> 4;
    const int krow = tid >> 3, kc = (tid & 7) * 16, vrow = tid >> 2, vc = (tid & 3) * 16;
    u32x4 kr0, kr1, vr0 = (u32x4){0, 0, 0, 0}, vr1 = (u32x4){0, 0, 0, 0};
    if (tile_lo < tile_hi) {
        const bf16_t* kg = kp + (size_t)(tile_lo * 64 + krow) * kstride + kc; kr0 = *(const u32x4*)kg; kr1 = *(const u32x4*)(kg + 8);
        if (MODE != 0) { const bf16_t* vg = vp + (size_t)vrow * vstride + tile_lo * 64 + vc; vr0 = *(const u32x4*)vg; vr1 = *(const u32x4*)(vg + 8); }
    }
    for (int tile = tile_lo; tile < tile_hi; ++tile) {
        __syncthreads();
        { LAS unsigned char* kd = lds + A_KT + krow * 272 + kc * 2; *(LAS u32x4*)kd = kr0; *(LAS u32x4*)(kd + 16) = kr1;
          if (MODE != 0) { LAS unsigned char* vd = lds + A_VT + vrow * 136 + vc * 2; *(LAS u32x2*)vd = (u32x2){vr0[0], vr0[1]}; *(LAS u32x2*)(vd + 8) = (u32x2){vr0[2], vr0[3]}; *(LAS u32x2*)(vd + 16) = (u32x2){vr1[0], vr1[1]}; *(LAS u32x2*)(vd + 24) = (u32x2){vr1[2], vr1[3]}; } }
        __syncthreads();
        if (tile + 1 < tile_hi) {
            const bf16_t* kg = kp + (size_t)((tile + 1) * 64 + krow) * kstride + kc; kr0 = *(const u32x4*)kg; kr1 = *(const u32x4*)(kg + 8);
            if (MODE != 0) { const bf16_t* vg = vp + (size_t)vrow * vstride + (tile + 1) * 64 + vc; vr0 = *(const u32x4*)vg; vr1 = *(const u32x4*)(vg + 8); }
        }
        f32x4 s[4][2];
#pragma unroll
        for (int mt = 0; mt < 4; ++mt) { s[mt][0] = (f32x4){0.f, 0.f, 0.f, 0.f}; s[mt][1] = (f32x4){0.f, 0.f, 0.f, 0.f}; }
#pragma unroll
        for (int ks = 0; ks < 4; ++ks)
#pragma unroll
            for (int mt = 0; mt < 4; ++mt) { const bf16x8 kf = *(const LAS bf16x8*)(lds + A_KT + (16 * mt + l16) * 272 + ks * 64 + g4 * 16);
                s[mt][0] = __builtin_amdgcn_mfma_f32_16x16x32_bf16(kf, qf[0][ks], s[mt][0], 0, 0, 0);
                s[mt][1] = __builtin_amdgcn_mfma_f32_16x16x32_bf16(kf, qf[1][ks], s[mt][1], 0, 0, 0);
                if (mt == 3) __builtin_amdgcn_sched_barrier(0); }
        bf16x8 pf[2][2];
#pragma unroll
        for (int nt = 0; nt < 2; ++nt) {
            const int t = tpos[nt]; const int tl = w * 8 + nt * 4 + (l16 >> 2);
            bool rowsel = true;
            if (MODE == 2) { const unsigned wd = *(const LAS unsigned*)(lds + A_SEL + ((w * 8 + nt * 4 + (l16 >> 2)) * 8 + (tile >> 5)) * 4); rowsel = (wd >> (tile & 31)) & 1u; }
            float mx = -1e30f;
#pragma unroll
            for (int mt = 0; mt < 4; ++mt)
#pragma unroll
                for (int j = 0; j < 4; ++j) { const int kl = 16 * mt + 4 * g4 + j; const int key = tile * 64 + kl; bool v;
                    if (MODE == 0 || MODE == 1) v = key <= ((t - 31) >> 4);
                    else if (MODE == 2) v = rowsel && (tile < qb || kl <= tl);
                    else v = (key <= t) && (key > t - 512);
                    const float sv = v ? s[mt][nt][j] * LOG2E : -__builtin_inff(); s[mt][nt][j] = sv; mx = fmaxf(mx, sv); }
            float mnew, alpha = 1.f;
            if (MODE == 1) mnew = mfin[nt];
            else { mx = fmaxf(mx, shx(mx, 16, lane)); mx = fmaxf(mx, shx(mx, 32, lane)); mnew = fmaxf(st.m[nt], mx); alpha = fexp2(st.m[nt] - mnew); st.m[nt] = mnew; }
            float ps = 0.f;
#pragma unroll
            for (int mt = 0; mt < 4; ++mt)
#pragma unroll
                for (int j = 0; j < 4; ++j) { float pv = fexp2(s[mt][nt][j] - mnew); if (MODE == 1) pv *= linv[nt]; s[mt][nt][j] = pv; ps += pv; }
            if (MODE != 1) st.l[nt] = st.l[nt] * alpha + ps;
            if (MODE == 2 || MODE == 3) {
#pragma unroll
                for (int md = 0; md < 8; ++md) st.ot[md][nt] = st.ot[md][nt] * alpha;
            }
            if (MODE == 1) {
#pragma unroll
                for (int mt = 0; mt < 4; ++mt) { float a = s[mt][nt][0] + s[mt][nt][1] + s[mt][nt][2] + s[mt][nt][3], lst = s[mt][nt][3];
                    a += shx(a, 1, lane); a += shx(a, 2, lane); lst += shx(lst, 1, lane); lst += shx(lst, 2, lane);
                    if ((l16 & 3) == 0) { const int jb = tile * 16 + 4 * mt + g4; LAS float* pp = (LAS float*)(lds + A_PSL) + (w * 8 + nt * 4 + (l16 >> 2)) * 256;
                        atomicAdd((float*)(pp + jb), a); if (jb + 1 < 256) atomicAdd((float*)(pp + jb + 1), lst); } }
            }
            if (MODE != 0) {
#pragma unroll
                for (int kk = 0; kk < 2; ++kk) { const u32x4 pk = (u32x4){pk_bf16(s[2 * kk][nt][0], s[2 * kk][nt][1]), pk_bf16(s[2 * kk][nt][2], s[2 * kk][nt][3]), pk_bf16(s[2 * kk + 1][nt][0], s[2 * kk + 1][nt][1]), pk_bf16(s[2 * kk + 1][nt][2], s[2 * kk + 1][nt][3])};
                    pf[nt][kk] = __builtin_bit_cast(bf16x8, pk); }
            }
        }
        if (MODE != 0) {
#pragma unroll
            for (int kk = 0; kk < 2; ++kk)
#pragma unroll
                for (int md = 0; md < 8; ++md) { const LAS unsigned char* vb = lds + A_VT + (16 * md + l16) * 136 + kk * 64 + g4 * 8;
                    const u32x2 v0 = *(const LAS u32x2*)vb, v1 = *(const LAS u32x2*)(vb + 32); const bf16x8 vf = __builtin_bit_cast(bf16x8, ((u32x4){v0[0], v0[1], v1[0], v1[1]}));
                    st.ot[md][0] = __builtin_amdgcn_mfma_f32_16x16x32_bf16(vf, pf[0][kk], st.ot[md][0], 0, 0, 0);
                    st.ot[md][1] = __builtin_amdgcn_mfma_f32_16x16x32_bf16(vf, pf[1][kk], st.ot[md][1], 0, 0, 0);
                    if ((md & 3) == 3) __builtin_amdgcn_sched_barrier(0); }
        }
    }
}
template <int BR>
__device__ __forceinline__ void attn_finish(AttnState& st, const float* gates, float* oacc, bf16_t* att, const int (&tpos)[2], int hkv, int lane) {
    const int l16 = lane & 15, g4 = lane >> 4, g = l16 & 3;
#pragma unroll
    for (int nt = 0; nt < 2; ++nt) {
        const int t = tpos[nt]; float sc = gates[(size_t)t * 48 + (hkv * 4 + g) * 3 + BR];
        if (BR != 0) { float l = st.l[nt]; l += shx(l, 16, lane); l += shx(l, 32, lane); sc = (l > 0.f) ? sc / l : 0.f; }
        const size_t base = (size_t)t * 2048 + (hkv * 4 + g) * 128 + 4 * g4;
#pragma unroll
        for (int md = 0; md < 8; ++md) { f32x4 v = st.ot[md][nt] * sc; float* op = oacc + base + 16 * md;
            if (BR == 0) *(f32x4*)op = v;
            else if (BR == 1) *(f32x4*)op = *(const f32x4*)op + v;
            else { v = v + *(const f32x4*)op; *(u32x2*)(att + base + 16 * md) = (u32x2){pk_bf16(v[0], v[1]), pk_bf16(v[2], v[3])}; } }
    }
}
__device__ __forceinline__ void attn_reset(AttnState& st) {
#pragma unroll
    for (int md = 0; md < 8; ++md) { st.ot[md][0] = (f32x4){0.f, 0.f, 0.f, 0.f}; st.ot[md][1] = (f32x4){0.f, 0.f, 0.f, 0.f}; }
    st.m[0] = st.m[1] = -1e30f; st.l[0] = st.l[1] = 0.f;
}
__device__ __forceinline__ void attn_item(unsigned char* ws, LAS unsigned char* lds, int hkv, int qb) {
    int tid = ltid(); asm volatile("" : "+v"(tid)); const int w = tid >> 6, lane = tid & 63, l16 = lane & 15, g4 = lane >> 4;
    const bf16_t* QB = (const bf16_t*)(ws + OFF_QB); const bf16_t* KVTOK = (const bf16_t*)(ws + OFF_KVTOK); const bf16_t* KVT = (const bf16_t*)(ws + OFF_KVT);
    const bf16_t* KC = (const bf16_t*)(ws + OFF_KCMP); const bf16_t* VC = (const bf16_t*)(ws + OFF_VCMPT);
    const float* gates = (const float*)(ws + OFF_GATES); float* oacc = (float*)(ws + OFF_OACC); bf16_t* att = (bf16_t*)(ws + OFF_ATT);
    int tpos[2]; bf16x8 qf[2][4];
#pragma unroll
    for (int nt = 0; nt < 2; ++nt) { tpos[nt] = qb * 64 + w * 8 + nt * 4 + (l16 >> 2); const bf16_t* qp = QB + (size_t)tpos[nt] * 2048 + (hkv * 4 + (l16 & 3)) * 128 + g4 * 8;
#pragma unroll
        for (int ks = 0; ks < 4; ++ks) qf[nt][ks] = *(const bf16x8*)(qp + ks * 32); }
    __syncthreads();
    { LAS float* pp = (LAS float*)(lds + A_PSL) + w * 2048;
#pragma unroll
      for (int i = 0; i < 32; ++i) pp[lane + 64 * i] = 0.f; }
    AttnState st; float mfin[2] = {0.f, 0.f}, linv[2] = {0.f, 0.f};
    const int ncmp_tiles = (4 * qb + 3 + 63) >> 6;
    attn_reset(st);
    attn_tiles<0>(lds, KC + (size_t)hkv * 1024 * 128, 128, VC, 1024, 0, ncmp_tiles, qf, st, tpos, qb, w, lane, mfin, linv);
#pragma unroll
    for (int nt = 0; nt < 2; ++nt) { float l = st.l[nt]; l += shx(l, 16, lane); l += shx(l, 32, lane); mfin[nt] = st.m[nt]; linv[nt] = (l > 0.f) ? 1.0f / l : 0.f; }
    attn_reset(st);
    attn_tiles<1>(lds, KC + (size_t)hkv * 1024 * 128, 128, VC + (size_t)hkv * 128 * 1024, 1024, 0, ncmp_tiles, qf, st, tpos, qb, w, lane, mfin, linv);
    attn_finish<0>(st, gates, oacc, att, tpos, hkv, lane);
    __syncthreads();
    {
        LAS unsigned* sel = (LAS unsigned*)(lds + A_SEL) + w * 64;
        if (qb < 16) {
            if (lane < 8) { for (int tk = 0; tk < 8; ++tk) { const int lo = lane * 32; unsigned wd = 0; if (qb >= lo + 31) wd = 0xffffffffu; else if (qb >= lo) wd = (2u << (qb - lo)) - 1u; sel[tk * 8 + lane] = wd; } }
        } else {
            for (int tk = 0; tk < 8; ++tk) {
                const LAS float* pp = (const LAS float*)(lds + A_PSL) + (w * 8 + tk) * 256;
                unsigned long long key[4]; bool taken[4];
#pragma unroll
                for (int i = 0; i < 4; ++i) { const int j = lane + 64 * i; const float sc = pp[j]; const bool elig = (j >= 1) && (j <= qb - 2);
                    taken[i] = (j == 0) || (j == qb) || (j == qb - 1);
                    key[i] = elig ? (((unsigned long long)__float_as_uint(sc) << 32) | (unsigned long long)(0x1000 - j)) : 0ull; }
                for (int r = 0; r < 13; ++r) {
                    unsigned long long best = key[0];
#pragma unroll
                    for (int i = 1; i < 4; ++i) best = key[i] > best ? key[i] : best;
#pragma unroll
                    for (int o = 32; o >= 1; o >>= 1) { const unsigned long long ot = shx64(best, o, lane); best = ot > best ? ot : best; }
#pragma unroll
                    for (int i = 0; i < 4; ++i) if (key[i] == best && best != 0ull) { taken[i] = true; key[i] = 0ull; }
                }
#pragma unroll
                for (int i = 0; i < 4; ++i) { const unsigned long long bal = __ballot(taken[i]); if (lane == 0) { sel[tk * 8 + 2 * i] = (unsigned)bal; sel[tk * 8 + 2 * i + 1] = (unsigned)(bal >> 32); } }
            }
        }
    }
    __syncthreads();
    attn_reset(st);
    attn_tiles<2>(lds, KVTOK + 2 * 512 + hkv * 128, 2048, KVT + (size_t)(hkv * 128) * S_, S_, 0, qb + 1, qf, st, tpos, qb, w, lane, mfin, linv);
    attn_finish<1>(st, gates, oacc, att, tpos, hkv, lane);
    attn_reset(st);
    attn_tiles<3>(lds, KVTOK + 3 * 512 + hkv * 128, 2048, KVT + (size_t)(512 + hkv * 128) * S_, S_, (qb - 8) > 0 ? (qb - 8) : 0, qb + 1, qf, st, tpos, qb, w, lane, mfin, linv);
    attn_finish<2>(st, gates, oacc, att, tpos, hkv, lane);
}
__device__ __forceinline__ void attn_phase(unsigned char* ws, LAS unsigned char* lds) {
#pragma nounroll
    for (int it = blockIdx.x; it < 1024; it += gridDim.x) {
        const int c = it & 255, r = it >> 8;
        attn_item(ws, lds, r, (r & 1) ? 255 - c : c);
    }
}

constexpr int NPH = 23;
__device__ __forceinline__ void run_phase(CP p, int ph, int b, LAS unsigned char* lds) {
    asm volatile("" : "+s"(p));
    unsigned char* ws = p->ws;
    const float* xb = p->x + (size_t)b * S_ * D_; float* hb = p->out + (size_t)b * S_ * D_;
    bf16_t* XN = (bf16_t*)(ws + OFF_XN);
    const int layer = (ph >= 13) ? 1 : 0;
    switch (ph) {
    case 0: prep_phase(p, lds); break;
    case 1: rmsnorm_phase(xb, p->norm_mix, XN, nullptr, nullptr); break;
    case 2: {
        Prob2D<EpiQK> g1{(const char*)XN, (const char*)(ws + OFF_W_RIN), 4096u, 4096u, 32, 64, 16, EpiQK{(bf16_t*)(ws + OFF_Q), (bf16_t*)(ws + OFF_K), (bf16_t*)(ws + OFF_KTD), (const float2*)(ws + OFF_ROPE)}};
        gemm_phase(lds, g1);
        Prob2D<EpiStore> g2{(const char*)(ws + OFF_W_RIN) + (size_t)4096 * 4096, (const char*)XN, 4096u, 4096u, 32, 16, 64, EpiStore{(bf16_t*)(ws + OFF_VT), (size_t)S_}};
        gemm_phase(lds, g2);
    } break;
    case 3: {
        ProbKV g3{(const char*)(ws + OFF_VT), (const char*)(ws + OFF_KTD), (bf16_t*)(ws + OFF_ST), 4};
        gemm_phase(lds, g3);
        ProbS g4{(const char*)(ws + OFF_Q), (const char*)(ws + OFF_K), (bf16_t*)(ws + OFF_SD), 4};
        gemm_phase(lds, g4);
    } break;
    case 4: scan_phase((bf16_t*)(ws + OFF_ST)); break;
    case 5: {
        ProbOut g5{(const char*)(ws + OFF_Q), (const char*)(ws + OFF_ST), (long)OFF_SD - (long)OFF_Q, (long)OFF_VT - (long)OFF_ST, (bf16_t*)(ws + OFF_Y), 8};
        gemm_phase(lds, g5);
    } break;
    case 6: gn_phase((bf16_t*)(ws + OFF_Y), p->ret_gn); break;
    case 7: {
        Prob2D<EpiGate> g6{(const char*)XN, (const char*)(ws + OFF_W_RIN) + (size_t)8192 * 4096, 4096u, 4096u, 32, 64, 16, EpiGate{(bf16_t*)(ws + OFF_Y)}};
        gemm_phase(lds, g6);
    } break;
    case 8: {
        Prob2D<EpiRes> g7{(const char*)(ws + OFF_Y), (const char*)(ws + OFF_W_ROUT), 8192u, 8192u, 64, 64, 8, EpiRes{xb, hb}};
        gemm_phase(lds, g7);
    } break;
    case 9: case 19: rmsnorm_phase(hb, p->norm_ffn + layer * 2048, XN, nullptr, nullptr); break;
    case 10: case 20: {
        Prob2D<EpiStore> g8{(const char*)XN, (const char*)(ws + OFF_W_FIN + (size_t)layer * 32 * MiB), 4096u, 4096u, 32, 64, 32, EpiStore{(bf16_t*)(ws + OFF_U), (size_t)8192}};
        gemm_phase(lds, g8);
    } break;
    case 11: case 21: conv_phase((const bf16_t*)(ws + OFF_U), (bf16_t*)(ws + OFF_AB), p->ffn_conv_w + (size_t)layer * 3 * 8192, p->ffn_conv_b + (size_t)layer * 8192); break;
    case 12: case 22: {
        Prob2D<EpiRes> g9{(const char*)(ws + OFF_AB), (const char*)(ws + OFF_W_FOUT + (size_t)layer * 16 * MiB), 8192u, 8192u, 64, 64, 8, EpiRes{hb, hb}};
        gemm_phase(lds, g9);
    } break;
    case 13: rmsnorm_phase(hb, p->norm_mix + 2048, XN, p->kv_gain, (bf16_t*)(ws + OFF_HN)); break;
    case 14: {
        Prob2D<EpiStore> g10{(const char*)(ws + OFF_HN), (const char*)(ws + OFF_W_KV), 4096u, 4096u, 32, 64, 8, EpiStore{(bf16_t*)(ws + OFF_KVTOK), (size_t)2048}};
        gemm_phase(lds, g10);
        Prob2D<EpiStore> g11{(const char*)(ws + OFF_W_KV) + (size_t)2048 * 4096, (const char*)(ws + OFF_HN), 4096u, 4096u, 32, 4, 64, EpiStore{(bf16_t*)(ws + OFF_KVT), (size_t)S_}};
        gemm_phase(lds, g11);
        Prob2D<EpiQproj> g12{(const char*)XN, (const char*)(ws + OFF_W_Q), 4096u, 4096u, 32, 64, 9, EpiQproj{(bf16_t*)(ws + OFF_QB), (float*)(ws + OFF_GATES)}};
        gemm_phase(lds, g12);
    } break;
    case 15: {
        ProbCmp1 a{(const char*)(ws + OFF_KVTOK), (const char*)(ws + OFF_W_C1K), 8192u, 64, 16, EpiGelu{(bf16_t*)(ws + OFF_H1), (const float*)(ws + OFF_PEB)}};
        gemm_phase(lds, a);
        ProbCmp1 v{(const char*)(ws + OFF_KVTOK) + 1024, (const char*)(ws + OFF_W_C1V), 8192u, 64, 16, EpiGelu{(bf16_t*)(ws + OFF_H1) + 4096 * 256, (const float*)(ws + OFF_PEB) + 256}};
        gemm_phase(lds, v);
    } break;
    case 16: {
        Prob2D<EpiKcmp> a{(const char*)(ws + OFF_H1), (const char*)(ws + OFF_W_C2K), 512u, 512u, 4, 16, 1, EpiKcmp{(bf16_t*)(ws + OFF_KCMP)}};
        gemm_phase(lds, a);
        Prob2D<EpiVcmp> v{(const char*)(ws + OFF_W_C2V), (const char*)(ws + OFF_H1) + (size_t)4096 * 256 * 2, 512u, 512u, 4, 1, 16, EpiVcmp{(bf16_t*)(ws + OFF_VCMPT)}};
        gemm_phase(lds, v);
    } break;
    case 17: attn_phase(ws, lds); break;
    case 18: {
        Prob2D<EpiRes> g{(const char*)(ws + OFF_ATT), (const char*)(ws + OFF_W_O), 4096u, 4096u, 32, 64, 8, EpiRes{hb, hb}};
        gemm_phase(lds, g);
    } break;
    case 23: finalnorm_phase(hb, p->final_gain); break;
    default: break;
    }
}

#if MULTI
__global__ void __launch_bounds__(512) phase_kernel(Params p, int ph, int b) {
    extern __shared__ __attribute__((aligned(16))) unsigned char shm[];
    run_phase((CP)__builtin_amdgcn_kernarg_segment_ptr(), ph, b, (LAS unsigned char*)shm);
}
#else
__global__ void __launch_bounds__(512) mega_kernel(Params p) {
    extern __shared__ __attribute__((aligned(16))) unsigned char shm[];
    cg::grid_group grid = cg::this_grid();
    CP cp = (CP)__builtin_amdgcn_kernarg_segment_ptr();
    run_phase(cp, 0, 0, (LAS unsigned char*)shm);
    grid.sync();
    for (int b = 0; b < 2; ++b)
        for (int ph = 1; ph <= NPH; ++ph) { run_phase(cp, ph, b, (LAS unsigned char*)shm); grid.sync(); }
}
#endif

constexpr int LDS_BYTES = 131072;
extern "C" void kernel_launch(void* const* d_in, const int* in_sizes, int n_in, void* d_out, int out_size, void* d_ws, size_t ws_size, hipStream_t stream) {
    static int grid = 0;
    if (grid == 0) {
        if (n_in != 21 || out_size != 2 * S_ * D_ || ws_size < WS_NEED) { fprintf(stderr, "kernel_launch: unexpected shapes/ws (n_in %d out %d ws %zu need %zu)\n", n_in, out_size, ws_size, (size_t)WS_NEED); grid = -1; return; }
#if MULTI
        if (hipFuncSetAttribute((const void*)phase_kernel, hipFuncAttributeMaxDynamicSharedMemorySize, LDS_BYTES) != hipSuccess) { fprintf(stderr, "hipFuncSetAttribute failed\n"); grid = -1; return; }
#else
        if (hipFuncSetAttribute((const void*)mega_kernel, hipFuncAttributeMaxDynamicSharedMemorySize, LDS_BYTES) != hipSuccess) { fprintf(stderr, "hipFuncSetAttribute failed\n"); grid = -1; return; }
#endif
        int dev = 0, cus = 0; hipGetDevice(&dev); hipDeviceGetAttribute(&cus, hipDeviceAttributeMultiprocessorCount, dev);
        grid = cus > 0 ? cus : 256;
    }
    if (grid < 0) return;
    Params p{};
    const float** pp = (const float**)&p;
    for (int i = 0; i < 21; ++i) pp[i] = (const float*)d_in[i];
    p.out = (float*)d_out; p.ws = (unsigned char*)d_ws;
#if MULTI
    hipLaunchKernelGGL(phase_kernel, dim3(grid), dim3(512), LDS_BYTES, stream, p, 0, 0);
    for (int b = 0; b < 2; ++b)
        for (int ph = 1; ph <= NPH; ++ph) hipLaunchKernelGGL(phase_kernel, dim3(grid), dim3(512), LDS_BYTES, stream, p, ph, b);
#else
    void* args[] = {&p};
    hipError_t e = hipLaunchCooperativeKernel((const void*)mega_kernel, dim3(grid), dim3(512), args, LDS_BYTES, stream);
    if (e != hipSuccess) fprintf(stderr, "cooperative launch failed: %s (grid %d)\n", hipGetErrorString(e), grid);
#endif
}
```

```cpp
#include <hip/hip_runtime.h>
#include <hip/hip_cooperative_groups.h>
#include <cstdio>
namespace cg = cooperative_groups;

#ifndef MULTI
#define MULTI 0
#endif

#define LAS __attribute__((address_space(3)))
typedef unsigned short bf16_t;
typedef short bf16x8 __attribute__((ext_vector_type(8)));
typedef float f32x4 __attribute__((ext_vector_type(4)));
typedef unsigned u32x2 __attribute__((ext_vector_type(2)));
typedef unsigned u32x4 __attribute__((ext_vector_type(4)));

constexpr int S_ = 16384, D_ = 2048;
constexpr size_t MiB = 1048576;
constexpr size_t OFF_W_RIN = 0, OFF_W_ROUT = 48 * MiB, OFF_W_KV = 64 * MiB, OFF_W_C1K = 76 * MiB, OFF_W_C1V = 78 * MiB,
                 OFF_W_C2K = 80 * MiB, OFF_W_C2V = 80 * MiB + 131072, OFF_W_Q = 81 * MiB, OFF_W_O = 90 * MiB,
                 OFF_W_FIN = 98 * MiB  , OFF_W_FOUT = 162 * MiB  , OFF_ROPE = 194 * MiB, OFF_PEB = 210 * MiB, OFF_BAR = 210 * MiB + 65536,
                 OFF_XN = 211 * MiB, OFF_ACT = 275 * MiB;
constexpr size_t OFF_Q = OFF_ACT, OFF_K = OFF_ACT + 64 * MiB, OFF_KTD = OFF_ACT + 128 * MiB, OFF_VT = OFF_ACT + 192 * MiB,
                 OFF_ST = OFF_ACT + 320 * MiB, OFF_SD = OFF_ACT + 448 * MiB, OFF_Y = OFF_ACT + 512 * MiB, WS_NEED = OFF_ACT + 640 * MiB;
constexpr size_t OFF_U = OFF_ACT, OFF_AB = OFF_ACT + 256 * MiB;
constexpr size_t OFF_HN = OFF_ACT, OFF_KVTOK = OFF_ACT + 64 * MiB, OFF_KVT = OFF_ACT + 129 * MiB, OFF_QB = OFF_ACT + 161 * MiB,
                 OFF_GATES = OFF_ACT + 225 * MiB, OFF_H1 = OFF_ACT + 229 * MiB, OFF_KCMP = OFF_ACT + 233 * MiB, OFF_VCMPT = OFF_ACT + 234 * MiB,
                 OFF_ATT = OFF_ACT + 235 * MiB, OFF_OACC = OFF_ACT + 299 * MiB;

struct Params {
    const float* x; const float* norm_mix; const float* norm_ffn; const float* ret_w_in; const float* ret_gn; const float* ret_w_out;
    const float* kv_gain; const float* w_kv; const float* pe_k; const float* w1_k; const float* w2_k; const float* pe_v; const float* w1_v;
    const float* w2_v; const float* w_q; const float* w_o; const float* ffn_w_in; const float* ffn_conv_w; const float* ffn_conv_b;
    const float* ffn_w_out; const float* final_gain; float* out; unsigned char* ws;
};

typedef const __attribute__((address_space(4))) Params* CP;
__device__ __forceinline__ int ltid() { int t = threadIdx.x; asm volatile("" : "+v"(t)); return t; }
__device__ __forceinline__ unsigned pk_bf16(float lo, float hi) { unsigned r; asm("v_cvt_pk_bf16_f32 %0, %1, %2" : "=v"(r) : "v"(lo), "v"(hi)); return r; }
__device__ __forceinline__ float bflo(unsigned v) { return __uint_as_float(v << 16); }
__device__ __forceinline__ float bfhi(unsigned v) { return __uint_as_float(v & 0xffff0000u); }
__device__ __forceinline__ float fexp2(float x) { return __builtin_amdgcn_exp2f(x); }
__device__ __forceinline__ float frcp(float x) { return __builtin_amdgcn_rcpf(x); }
__device__ __forceinline__ float log2gamma(int h) { return log2f(1.0f - exp2f(-5.0f - (float)h)); }
__device__ __forceinline__ float sigmoidf_(float x) { return frcp(1.0f + fexp2(-1.4426950408889634f * x)); }

constexpr int HTB = 128 * 64 * 2;
__device__ __forceinline__ int lds_byte(int r, int c) { const int st = (r >> 4) * 2 + (c >> 5), rr = r & 15, cc = c & 31, ob = rr * 64 + cc * 2; return st * 1024 + (ob ^ (((ob >> 9) & 1) << 5)); }
__device__ __forceinline__ void stage_rc(int b, int& R, int& C) { const int st = b / 1024, sb = b % 1024, swz = sb ^ (((sb >> 9) & 1) << 5); R = (st >> 1) * 16 + swz / 64; C = (st & 1) * 32 + (swz % 64) / 2; }
__device__ __forceinline__ void tile_order(int L, int nM, int nN, int& pm, int& pn) {
    const int nwg = nM * nN; int wgid = L;
    { const int q = nwg / 8, r = nwg % 8, xcd = wgid % 8, off = wgid / 8; wgid = (xcd < r ? xcd * (q + 1) : r * (q + 1) + (xcd - r) * q) + off; }
    const int nig = 8 * nN, gid = wgid / nig, fm = gid * 8, gsz = (nM - fm) < 8 ? (nM - fm) : 8;
    pm = fm + ((wgid % nig) % gsz); pn = (wgid % nig) / gsz;
}
struct UInfo { const char* a; const char* b; int r0, c0, x0, x1; };
typedef f32x4 AccT[2][2][4][2];

template <class P>
__device__ __forceinline__ void gemm_phase(LAS unsigned char* lds, const P& pb) {
    const int tid = ltid(), wid = __builtin_amdgcn_readfirstlane(tid >> 6), lane = tid & 63, wr = wid >> 2, wc = wid & 3, fr = lane & 15, fq = lane >> 4;
    const int nt = pb.nt, G = gridDim.x, c = blockIdx.x; const long nun = pb.nunits();
    if (c >= nun) return;
    unsigned voffA[2], voffB[2];
#pragma unroll
    for (int i = 0; i < 2; ++i) { int R, C; stage_rc(tid * 16 + i * 8192, R, C); voffA[i] = pb.rowA(R) + (unsigned)C * 2u; voffB[i] = (unsigned)R * pb.ldb + (unsigned)C * 2u; }
    const size_t hsA = pb.rowA(128), hsB = (size_t)128 * pb.ldb;
    const unsigned ldsw = (unsigned)wid * 1024u;
    const int aoff = lds_byte(wr * 64 + fr, fq * 8), boff = lds_byte(wc * 32 + fr, fq * 8);
#define G_SA(b, h) (((b) * 2 + (h)) * HTB)
#define G_SB(b, h) ((4 + (b) * 2 + (h)) * HTB)
#define G_STAGE(bufoff, gbase, voff) do { _Pragma("unroll") for (int _i = 0; _i < 2; ++_i) \
        __builtin_amdgcn_global_load_lds((const unsigned*)((const char*)(gbase) + (voff)[_i]), (LAS unsigned*)(lds + (bufoff) + ldsw + _i * 8192), 16, 0, 0); } while (0)
#define G_LDA(dst, b, h) do { _Pragma("unroll") for (int m = 0; m < 4; ++m) _Pragma("unroll") for (int k = 0; k < 2; ++k) dst[m][k] = *(const LAS bf16x8*)(lds + G_SA(b, h) + aoff + m * 2048 + k * 1024); } while (0)
#define G_LDB(dst, b, h) do { _Pragma("unroll") for (int n = 0; n < 2; ++n) _Pragma("unroll") for (int k = 0; k < 2; ++k) dst[n][k] = *(const LAS bf16x8*)(lds + G_SB(b, h) + boff + n * 2048 + k * 1024); } while (0)
#define G_MMA(ai, bj, At, Bt) do { __builtin_amdgcn_s_setprio(1); _Pragma("unroll") for (int m = 0; m < 4; ++m) _Pragma("unroll") for (int n = 0; n < 2; ++n) _Pragma("unroll") for (int k = 0; k < 2; ++k) \
        acc[ai][bj][m][n] = __builtin_amdgcn_mfma_f32_16x16x32_bf16(Bt[n][k], At[m][k], acc[ai][bj][m][n], 0, 0, 0); __builtin_amdgcn_s_setprio(0); } while (0)
#define G_WAIT_V(n) asm volatile("s_waitcnt vmcnt(" #n ")" ::: "memory")
#define G_WAIT_L(n) asm volatile("s_waitcnt lgkmcnt(" #n ")" ::: "memory")
#define G_BAR __builtin_amdgcn_s_barrier()
#define G_SCHED __builtin_amdgcn_sched_barrier(0)
    UInfo cur, nxt; int ui = 0;
    pb.unit(c, cur);
    AccT acc;
#pragma unroll
    for (int a = 0; a < 2; ++a)
#pragma unroll
        for (int b = 0; b < 2; ++b)
#pragma unroll
            for (int m = 0; m < 4; ++m)
#pragma unroll
                for (int n = 0; n < 2; ++n) acc[a][b][m][n] = (f32x4){0.f, 0.f, 0.f, 0.f};
    bf16x8 At[4][2], B0[2][2], B1[2][2];
    const char* cA = cur.a; const char* cB = cur.b;
    G_STAGE(G_SB(0, 0), cB + pb.bK(0), voffB); G_STAGE(G_SA(0, 0), cA + pb.aK(0), voffA); G_STAGE(G_SB(0, 1), cB + hsB + pb.bK(0), voffB); G_STAGE(G_SA(0, 1), cA + hsA + pb.aK(0), voffA);
    if (wr == 1) G_BAR;
    G_WAIT_V(4); G_BAR;
    G_STAGE(G_SB(1, 0), cB + pb.bK(1), voffB); G_STAGE(G_SA(1, 0), cA + pb.aK(1), voffA); G_STAGE(G_SB(1, 1), cB + hsB + pb.bK(1), voffB);
    G_WAIT_V(6); G_BAR;
    for (;;) {
        const long Ln = (long)(ui + 1) * G + c; const bool has_next = Ln < nun;
        if (has_next) pb.unit(Ln, nxt);
        const char* nA = has_next ? nxt.a : cA; const char* nB = has_next ? nxt.b : cB;
        for (int t = 0; t < nt; t += 2) {
            const bool last = (t == nt - 2);
            const char* a1 = cA + pb.aK(t + 1);
            const char* a2 = last ? nA + pb.aK(0) : cA + pb.aK(t + 2); const char* b2 = last ? nB + pb.bK(0) : cB + pb.bK(t + 2);
            const char* a3 = last ? nA + pb.aK(1) : cA + pb.aK(t + 3); const char* b3 = last ? nB + pb.bK(1) : cB + pb.bK(t + 3);
            G_LDB(B0, 0, 0); G_SCHED; G_LDA(At, 0, 0); G_STAGE(G_SA(1, 1), a1 + hsA, voffA);
            G_WAIT_L(8); G_BAR; G_WAIT_L(0); G_MMA(0, 0, At, B0); G_BAR; G_SCHED;
            G_LDB(B1, 0, 1); G_STAGE(G_SB(0, 0), b2, voffB);
            G_BAR; G_WAIT_L(0); G_MMA(0, 1, At, B1); G_BAR;
            G_LDA(At, 0, 1); G_STAGE(G_SA(0, 0), a2, voffA);
            G_BAR; G_WAIT_L(0); G_MMA(1, 0, At, B0); G_BAR; G_SCHED;
            G_STAGE(G_SB(0, 1), b2 + hsB, voffB);
            G_WAIT_V(6); G_BAR; G_MMA(1, 1, At, B1); G_BAR;
            G_LDB(B0, 1, 0); G_SCHED; G_LDA(At, 1, 0); G_STAGE(G_SA(0, 1), a2 + hsA, voffA);
            G_WAIT_L(8); G_BAR; G_WAIT_L(0); G_MMA(0, 0, At, B0); G_BAR; G_SCHED;
            G_LDB(B1, 1, 1); G_STAGE(G_SB(1, 0), b3, voffB);
            G_BAR; G_WAIT_L(0); G_MMA(0, 1, At, B1); G_BAR;
            G_LDA(At, 1, 1); G_STAGE(G_SA(1, 0), a3, voffA);
            G_BAR; G_WAIT_L(0); G_MMA(1, 0, At, B0); G_BAR; G_SCHED;
            G_STAGE(G_SB(1, 1), b3 + hsB, voffB);
            G_WAIT_V(6); G_BAR; G_MMA(1, 1, At, B1); G_BAR;
        }
        { const int l2 = ltid() & 63; pb.epi(acc, cur, wr, wc, l2 & 15, l2 >> 4); }
        if (!has_next) break;
#pragma unroll
        for (int a = 0; a < 2; ++a)
#pragma unroll
            for (int b = 0; b < 2; ++b)
#pragma unroll
                for (int m = 0; m < 4; ++m)
#pragma unroll
                    for (int n = 0; n < 2; ++n) acc[a][b][m][n] = (f32x4){0.f, 0.f, 0.f, 0.f};
        cur = nxt; cA = nA; cB = nB; ++ui;
    }
    G_WAIT_V(0);
    if (wr == 0) G_BAR;
    G_BAR;
}

#define EPI_ROWS for (int ai = 0; ai < 2; ++ai) for (int m = 0; m < 4; ++m)
#define EPI_COLS for (int bj = 0; bj < 2; ++bj) for (int n = 0; n < 2; ++n)
#define EPI_ROW (128 * ai + 64 * wr + 16 * m + fr)
#define EPI_COL (128 * bj + 32 * wc + 16 * n + 4 * fq)

template <class Epi> struct Prob2D {
    const char* A; const char* B; unsigned lda, ldb; int nt, nM, nN; Epi e;
    __device__ __forceinline__ long nunits() const { return (long)nM * nN; }
    __device__ __forceinline__ unsigned rowA(int R) const { return (unsigned)R * lda; }
    __device__ __forceinline__ void unit(long L, UInfo& u) const { int pm, pn; tile_order((int)L, nM, nN, pm, pn); u.a = A + (size_t)pm * 256 * lda; u.b = B + (size_t)pn * 256 * ldb; u.r0 = pm * 256; u.c0 = pn * 256; u.x0 = 0; u.x1 = 0; }
    __device__ __forceinline__ size_t aK(int kt) const { return (size_t)kt * 128; }
    __device__ __forceinline__ size_t bK(int kt) const { return (size_t)kt * 128; }
    __device__ __forceinline__ void epi(const AccT& acc, const UInfo& u, int wr, int wc, int fr, int fq) const { e(acc, u, wr, wc, fr, fq); }
};
struct EpiStore { bf16_t* O; size_t ldc;
    __device__ __forceinline__ void operator()(const AccT& acc, const UInfo& u, int wr, int wc, int fr, int fq) const {
#pragma unroll
        EPI_ROWS { bf16_t* rp = O + (size_t)(u.r0 + EPI_ROW) * ldc + u.c0;
#pragma unroll
            EPI_COLS { const f32x4 v = acc[ai][bj][m][n]; *(u32x2*)(rp + EPI_COL) = (u32x2){pk_bf16(v[0], v[1]), pk_bf16(v[2], v[3])}; } }
    } };
struct EpiRes { const float* R; float* O;
    __device__ __forceinline__ void operator()(const AccT& acc, const UInfo& u, int wr, int wc, int fr, int fq) const {
#pragma unroll
        EPI_ROWS { const size_t ro = (size_t)(u.r0 + EPI_ROW) * 2048 + u.c0;
#pragma unroll
            EPI_COLS { const f32x4 r = *(const f32x4*)(R + ro + EPI_COL); *(f32x4*)(O + ro + EPI_COL) = r + acc[ai][bj][m][n]; } }
    } };
struct EpiGate { bf16_t* Y;
    __device__ __forceinline__ void operator()(const AccT& acc, const UInfo& u, int wr, int wc, int fr, int fq) const {
#pragma unroll
        EPI_ROWS { bf16_t* rp = Y + (size_t)(u.r0 + EPI_ROW) * 4096 + u.c0;
#pragma unroll
            EPI_COLS { const f32x4 g = acc[ai][bj][m][n]; const u32x2 y = *(const u32x2*)(rp + EPI_COL);
                const float o0 = g[0] * sigmoidf_(g[0]) * bflo(y[0]), o1 = g[1] * sigmoidf_(g[1]) * bfhi(y[0]), o2 = g[2] * sigmoidf_(g[2]) * bflo(y[1]), o3 = g[3] * sigmoidf_(g[3]) * bfhi(y[1]);
                *(u32x2*)(rp + EPI_COL) = (u32x2){pk_bf16(o0, o1), pk_bf16(o2, o3)}; } }
    } };
struct EpiQK { bf16_t* Q; bf16_t* K; bf16_t* KTD; const float2* rope;
    __device__ __forceinline__ void operator()(const AccT& acc, const UInfo& u, int wr, int wc, int fr, int fq) const {
        const int hidx = u.c0 >> 8; const bool isk = hidx >= 8; const int hh = hidx & 7; const float l2g = log2gamma(hh);
        bf16_t* dst = (isk ? K : Q) + hh * 256; const float sc = isk ? 0.0625f : 1.0f;
#pragma unroll
        EPI_ROWS { const int t = u.r0 + EPI_ROW; const float kd = fexp2((float)(255 - (t & 255)) * l2g);
#pragma unroll
            for (int n = 0; n < 2; ++n) { const int dd = 32 * wc + 16 * n + 4 * fq;
                const f32x4 x1 = acc[ai][0][m][n], x2 = acc[ai][1][m][n]; const f32x4 cs0 = *(const f32x4*)(rope + (size_t)t * 128 + dd), cs1 = *(const f32x4*)(rope + (size_t)t * 128 + dd + 2);
                float y1[4], y2[4];
                y1[0] = (x1[0] * cs0[0] - x2[0] * cs0[1]) * sc; y2[0] = (x1[0] * cs0[1] + x2[0] * cs0[0]) * sc;
                y1[1] = (x1[1] * cs0[2] - x2[1] * cs0[3]) * sc; y2[1] = (x1[1] * cs0[3] + x2[1] * cs0[2]) * sc;
                y1[2] = (x1[2] * cs1[0] - x2[2] * cs1[1]) * sc; y2[2] = (x1[2] * cs1[1] + x2[2] * cs1[0]) * sc;
                y1[3] = (x1[3] * cs1[2] - x2[3] * cs1[3]) * sc; y2[3] = (x1[3] * cs1[3] + x2[3] * cs1[2]) * sc;
                *(u32x2*)(dst + (size_t)t * 2048 + dd) = (u32x2){pk_bf16(y1[0], y1[1]), pk_bf16(y1[2], y1[3])};
                *(u32x2*)(dst + (size_t)t * 2048 + 128 + dd) = (u32x2){pk_bf16(y2[0], y2[1]), pk_bf16(y2[2], y2[3])};
                if (isk) {
#pragma unroll
                    for (int j = 0; j < 4; ++j) { KTD[(size_t)(hh * 256 + dd + j) * S_ + t] = (bf16_t)(pk_bf16(y1[j] * kd, 0.f) & 0xffffu); KTD[(size_t)(hh * 256 + 128 + dd + j) * S_ + t] = (bf16_t)(pk_bf16(y2[j] * kd, 0.f) & 0xffffu); }
                } } }
    } };
struct EpiQproj { bf16_t* QB; float* gates;
    __device__ __forceinline__ void operator()(const AccT& acc, const UInfo& u, int wr, int wc, int fr, int fq) const {
#pragma unroll
        EPI_ROWS { const int t = u.r0 + EPI_ROW;
#pragma unroll
            EPI_COLS { const int col = u.c0 + EPI_COL; const f32x4 v = acc[ai][bj][m][n];
                if (col < 2048) *(u32x2*)(QB + (size_t)t * 2048 + col) = (u32x2){pk_bf16(v[0] * 0.08838834764831845f, v[1] * 0.08838834764831845f), pk_bf16(v[2] * 0.08838834764831845f, v[3] * 0.08838834764831845f)};
                else if (col < 2096) *(f32x4*)(gates + (size_t)t * 48 + (col - 2048)) = (f32x4){sigmoidf_(v[0]), sigmoidf_(v[1]), sigmoidf_(v[2]), sigmoidf_(v[3])}; } }
    } };
__device__ __forceinline__ float gelu_tanh(float x) { const float y = 0.7978845608028654f * (x + 0.044715f * x * x * x); const float e = fexp2(2.0f * 1.4426950408889634f * y); const float th = 1.0f - 2.0f * frcp(e + 1.0f); return 0.5f * x * (1.0f + th); }
struct EpiGelu { bf16_t* H; const float* bias;
    __device__ __forceinline__ void operator()(const AccT& acc, const UInfo& u, int wr, int wc, int fr, int fq) const {
#pragma unroll
        EPI_ROWS { bf16_t* rp = H + (size_t)(u.r0 + EPI_ROW) * 256;
#pragma unroll
            EPI_COLS { const int col = EPI_COL; const f32x4 v = acc[ai][bj][m][n]; const f32x4 bb = *(const f32x4*)(bias + col);
                *(u32x2*)(rp + col) = (u32x2){pk_bf16(gelu_tanh(v[0] + bb[0]), gelu_tanh(v[1] + bb[1])), pk_bf16(gelu_tanh(v[2] + bb[2]), gelu_tanh(v[3] + bb[3]))}; } }
    } };
struct EpiKcmp { bf16_t* KC;
    __device__ __forceinline__ void operator()(const AccT& acc, const UInfo& u, int wr, int wc, int fr, int fq) const {
#pragma unroll
        EPI_ROWS { const int r = u.r0 + EPI_ROW, i = r >> 2, h = r & 3;
#pragma unroll
            for (int n = 0; n < 2; ++n) { const int col = 32 * wc + 16 * n + 4 * fq; f32x4 v = acc[ai][0][m][n]; if (i == 1023) v = (f32x4){0.f, 0.f, 0.f, 0.f};
                *(u32x2*)(KC + ((size_t)h * 1024 + i) * 128 + col) = (u32x2){pk_bf16(v[0], v[1]), pk_bf16(v[2], v[3])}; } }
    } };
struct EpiVcmp { bf16_t* VC;
    __device__ __forceinline__ void operator()(const AccT& acc, const UInfo& u, int wr, int wc, int fr, int fq) const {
#pragma unroll
        for (int m = 0; m < 4; ++m) { const int d = 64 * wr + 16 * m + fr;
#pragma unroll
            EPI_COLS { const int col = u.c0 + EPI_COL, i = col >> 2; f32x4 v = acc[0][bj][m][n]; if (i == 1023) v = (f32x4){0.f, 0.f, 0.f, 0.f};
#pragma unroll
                for (int h = 0; h < 4; ++h) VC[((size_t)h * 128 + d) * 1024 + i] = (bf16_t)(pk_bf16(v[h], 0.f) & 0xffffu); } }
    } };
struct ProbCmp1 {
    const char* A; const char* B; unsigned ldb; int nt, nM; EpiGelu e;
    __device__ __forceinline__ long nunits() const { return nM; }
    __device__ __forceinline__ unsigned rowA(int R) const { return (unsigned)(R >> 2) * 65536u + (unsigned)(R & 3) * 256u; }
    __device__ __forceinline__ void unit(long L, UInfo& u) const { u.a = A + (size_t)L * 64 * 65536; u.b = B; u.r0 = (int)L * 256; u.c0 = 0; u.x0 = 0; u.x1 = 0; }
    __device__ __forceinline__ size_t aK(int kt) const { return (size_t)(kt >> 1) * 4096 + (size_t)(kt & 1) * 128; }
    __device__ __forceinline__ size_t bK(int kt) const { return (size_t)kt * 128; }
    __device__ __forceinline__ void epi(const AccT& acc, const UInfo& u, int wr, int wc, int fr, int fq) const { e(acc, u, wr, wc, fr, fq); }
};
struct ProbKV {
    const char* VT; const char* KTD; bf16_t* ST; int nt;
    __device__ __forceinline__ long nunits() const { return 8 * 64 * 2; }
    __device__ __forceinline__ unsigned rowA(int R) const { return (unsigned)R * 32768u; }
    static constexpr unsigned ldb = 32768u;
    __device__ __forceinline__ void unit(long L, UInfo& u) const { const int pm = (int)L & 1, c = ((int)L >> 1) & 63, h = (int)L >> 7;
        u.a = VT + ((size_t)(h * 512 + pm * 256) * S_ + c * 256) * 2; u.b = KTD + ((size_t)(h * 256) * S_ + c * 256) * 2; u.r0 = h * 512 + pm * 256; u.c0 = c * 256; u.x0 = 0; u.x1 = 0; }
    __device__ __forceinline__ size_t aK(int kt) const { return (size_t)kt * 128; }
    __device__ __forceinline__ size_t bK(int kt) const { return (size_t)kt * 128; }
    __device__ __forceinline__ void epi(const AccT& acc, const UInfo& u, int wr, int wc, int fr, int fq) const { EpiStore e{ST, (size_t)S_}; e(acc, u, wr, wc, fr, fq); }
};
struct ProbS {
    const char* Q; const char* K; bf16_t* SD; int nt;
    __device__ __forceinline__ long nunits() const { return 8 * 64; }
    __device__ __forceinline__ unsigned rowA(int R) const { return (unsigned)R * 4096u; }
    static constexpr unsigned ldb = 4096u;
    __device__ __forceinline__ void unit(long L, UInfo& u) const { const int c = (int)L & 63, h = (int)L >> 6; const size_t o = ((size_t)(c * 256) * 2048 + h * 256) * 2;
        u.a = Q + o; u.b = K + o; u.r0 = c * 256; u.c0 = h * 256; u.x0 = h; u.x1 = 0; }
    __device__ __forceinline__ size_t aK(int kt) const { return (size_t)kt * 128; }
    __device__ __forceinline__ size_t bK(int kt) const { return (size_t)kt * 128; }
    __device__ __forceinline__ void epi(const AccT& acc, const UInfo& u, int wr, int wc, int fr, int fq) const {
        const float l2g = log2gamma(u.x0);
#pragma unroll
        EPI_ROWS { const int i = EPI_ROW; bf16_t* rp = SD + (size_t)(u.r0 + i) * 2048 + u.c0;
#pragma unroll
            EPI_COLS { const int s = EPI_COL; const f32x4 v = acc[ai][bj][m][n]; float o[4];
#pragma unroll
                for (int j = 0; j < 4; ++j) o[j] = (s + j <= i) ? v[j] * fexp2(-(float)(s + j + 1) * l2g) : 0.f;
                *(u32x2*)(rp + s) = (u32x2){pk_bf16(o[0], o[1]), pk_bf16(o[2], o[3])}; } }
    }
};
struct ProbOut {
    const char* Q; const char* ST; long dA, dB; bf16_t* Y; int nt;
    __device__ __forceinline__ long nunits() const { return 8 * 64 * 2; }
    __device__ __forceinline__ unsigned rowA(int R) const { return (unsigned)R * 4096u; }
    static constexpr unsigned ldb = 32768u;
    __device__ __forceinline__ void unit(long L, UInfo& u) const { const int pn = (int)L & 1, c = ((int)L >> 1) & 63, h = (int)L >> 7;
        u.a = Q + ((size_t)(c * 256) * 2048 + h * 256) * 2; u.b = ST + ((size_t)(h * 512 + pn * 256) * S_ + c * 256) * 2; u.r0 = c * 256; u.c0 = h * 512 + pn * 256; u.x0 = h; u.x1 = 0; }
    __device__ __forceinline__ size_t aK(int kt) const { return kt < 4 ? (size_t)kt * 128 : (size_t)(dA + (long)(kt - 4) * 128); }
    __device__ __forceinline__ size_t bK(int kt) const { return kt < 4 ? (size_t)kt * 128 : (size_t)(dB + (long)(kt - 4) * 128); }
    __device__ __forceinline__ void epi(const AccT& acc, const UInfo& u, int wr, int wc, int fr, int fq) const {
        const float l2g = log2gamma(u.x0);
#pragma unroll
        EPI_ROWS { const int i = EPI_ROW; const float qd = fexp2((float)(i + 1) * l2g); bf16_t* rp = Y + (size_t)(u.r0 + i) * 4096 + u.c0;
#pragma unroll
            EPI_COLS { const f32x4 v = acc[ai][bj][m][n] * qd; *(u32x2*)(rp + EPI_COL) = (u32x2){pk_bf16(v[0], v[1]), pk_bf16(v[2], v[3])}; } }
    }
};

__device__ __forceinline__ float shx(float v, int m, int lane) { return __int_as_float(__builtin_amdgcn_ds_bpermute((lane ^ m) << 2, __float_as_int(v))); }
__device__ __forceinline__ unsigned long long shx64(unsigned long long v, int m, int lane) {
    const unsigned lo = (unsigned)__builtin_amdgcn_ds_bpermute((lane ^ m) << 2, (int)(unsigned)v), hi = (unsigned)__builtin_amdgcn_ds_bpermute((lane ^ m) << 2, (int)(unsigned)(v >> 32));
    return ((unsigned long long)hi << 32) | lo; }
__device__ __forceinline__ float wave_sum(float v, int lane) {
#pragma unroll
    for (int o = 32; o >= 1; o >>= 1) v += shx(v, o, lane);
    return v;
}
__device__ __forceinline__ void transpose_job(const float* __restrict__ src, bf16_t* __restrict__ dst, int K, int N, int Npad, int kvperm, LAS float* tile) {
    const int tk = K / 64, tn = Npad / 64, ntile = tk * tn; const int tid = ltid();
    for (int t = blockIdx.x; t < ntile; t += gridDim.x) {
        const int k0 = (t % tk) * 64, n0 = (t / tk) * 64;
        { const int r0 = tid >> 6, cc = tid & 63;
#pragma unroll
          for (int i = 0; i < 8; ++i) { const int r = r0 + 8 * i, n = n0 + cc; tile[r * 65 + cc] = (n < N) ? src[(size_t)(k0 + r) * N + n] : 0.f; } }
        __syncthreads();
        { const int rr = tid >> 3, cc = (tid & 7) * 8; float v[8];
#pragma unroll
          for (int j = 0; j < 8; ++j) v[j] = tile[(cc + j) * 65 + rr];
          int n = n0 + rr; if (kvperm) { const int j = n >> 9; const int jp = (j == 3) ? 4 : ((j == 4) ? 3 : j); n = jp * 512 + (n & 511); }
          *(u32x4*)(dst + (size_t)n * K + k0 + cc) = (u32x4){pk_bf16(v[0], v[1]), pk_bf16(v[2], v[3]), pk_bf16(v[4], v[5]), pk_bf16(v[6], v[7])}; }
        __syncthreads();
    }
}
__device__ __forceinline__ void prep_phase(CP p, LAS unsigned char* lds) {
    LAS float* tile = (LAS float*)lds; unsigned char* ws = p->ws;
    transpose_job(p->ret_w_in, (bf16_t*)(ws + OFF_W_RIN), 2048, 12288, 12288, 0, tile);
    transpose_job(p->ret_w_out, (bf16_t*)(ws + OFF_W_ROUT), 4096, 2048, 2048, 0, tile);
    transpose_job(p->w_kv, (bf16_t*)(ws + OFF_W_KV), 2048, 3072, 3072, 1, tile);
    transpose_job(p->w1_k, (bf16_t*)(ws + OFF_W_C1K), 4096, 256, 256, 0, tile);
    transpose_job(p->w1_v, (bf16_t*)(ws + OFF_W_C1V), 4096, 256, 256, 0, tile);
    transpose_job(p->w2_k, (bf16_t*)(ws + OFF_W_C2K), 256, 128, 256, 0, tile);
    transpose_job(p->w2_v, (bf16_t*)(ws + OFF_W_C2V), 256, 128, 256, 0, tile);
    transpose_job(p->w_q, (bf16_t*)(ws + OFF_W_Q), 2048, 2096, 2304, 0, tile);
    transpose_job(p->w_o, (bf16_t*)(ws + OFF_W_O), 2048, 2048, 2048, 0, tile);
    transpose_job(p->ffn_w_in, (bf16_t*)(ws + OFF_W_FIN), 2048, 8192, 8192, 0, tile);
    transpose_job(p->ffn_w_in + (size_t)2048 * 8192, (bf16_t*)(ws + OFF_W_FIN + 32 * MiB), 2048, 8192, 8192, 0, tile);
    transpose_job(p->ffn_w_out, (bf16_t*)(ws + OFF_W_FOUT), 4096, 2048, 2048, 0, tile);
    transpose_job(p->ffn_w_out + (size_t)4096 * 2048, (bf16_t*)(ws + OFF_W_FOUT + 16 * MiB), 4096, 2048, 2048, 0, tile);
    { float2* rope = (float2*)(ws + OFF_ROPE); const int gsz = gridDim.x * 512;
      for (int i = blockIdx.x * 512 + ltid(); i < S_ * 128; i += gsz) { const int t = i >> 7, dd = i & 127;
          const float freq = exp2f(-(float)dd * (13.287712379549449f / 128.0f)); const double rev = (double)t * (double)freq * 0.15915494309189535;
          const float fx = (float)(rev - rint(rev)); rope[i] = make_float2(__builtin_amdgcn_cosf(fx), __builtin_amdgcn_sinf(fx)); } }
    if (blockIdx.x < 2) { const float* pe = blockIdx.x ? p->pe_v : p->pe_k; const float* w1 = blockIdx.x ? p->w1_v : p->w1_k; float* peb = (float*)(ws + OFF_PEB) + blockIdx.x * 256;
        const int n = ltid() & 255, half = ltid() >> 8; float s = 0.f;
        for (int k = half * 2048; k < half * 2048 + 2048; ++k) s += pe[k] * w1[(size_t)k * 256 + n];
        __syncthreads(); tile[ltid()] = s; __syncthreads();
        if (ltid() < 256) peb[n] = tile[ltid()] + tile[ltid() + 256];
        __syncthreads(); }
}
__device__ __forceinline__ void rmsnorm_phase(const float* h, const float* g1, bf16_t* o1, const float* g2, bf16_t* o2) {
    const int w = ltid() >> 6, lane = ltid() & 63;
    for (int row = blockIdx.x * 8 + w; row < S_; row += gridDim.x * 8) {
        const f32x4* p = (const f32x4*)(h + (size_t)row * 2048); f32x4 v[8]; float ss = 0.f;
#pragma unroll
        for (int i = 0; i < 8; ++i) { v[i] = p[lane + 64 * i]; ss += v[i][0] * v[i][0] + v[i][1] * v[i][1] + v[i][2] * v[i][2] + v[i][3] * v[i][3]; }
        ss = wave_sum(ss, lane); const float r = rsqrtf(ss * (1.0f / 2048.0f) + 1e-6f);
#pragma unroll
        for (int i = 0; i < 8; ++i) { const int col = (lane + 64 * i) * 4; const f32x4 g = *(const f32x4*)(g1 + col);
            *(u32x2*)(o1 + (size_t)row * 2048 + col) = (u32x2){pk_bf16(v[i][0] * r * g[0], v[i][1] * r * g[1]), pk_bf16(v[i][2] * r * g[2], v[i][3] * r * g[3])};
            if (o2) { const f32x4 gg = *(const f32x4*)(g2 + col);
                *(u32x2*)(o2 + (size_t)row * 2048 + col) = (u32x2){pk_bf16(v[i][0] * r * gg[0], v[i][1] * r * gg[1]), pk_bf16(v[i][2] * r * gg[2], v[i][3] * r * gg[3])}; } }
    }
}
__device__ __forceinline__ void finalnorm_phase(float* h, const float* g1) {
    const int w = ltid() >> 6, lane = ltid() & 63;
    for (int row = blockIdx.x * 8 + w; row < S_; row += gridDim.x * 8) {
        f32x4* p = (f32x4*)(h + (size_t)row * 2048); f32x4 v[8]; float ss = 0.f;
#pragma unroll
        for (int i = 0; i < 8; ++i) { v[i] = p[lane + 64 * i]; ss += v[i][0] * v[i][0] + v[i][1] * v[i][1] + v[i][2] * v[i][2] + v[i][3] * v[i][3]; }
        ss = wave_sum(ss, lane); const float r = rsqrtf(ss * (1.0f / 2048.0f) + 1e-6f);
#pragma unroll
        for (int i = 0; i < 8; ++i) { const f32x4 g = *(const f32x4*)(g1 + (lane + 64 * i) * 4); p[lane + 64 * i] = v[i] * r * g; }
    }
}
__device__ __forceinline__ void scan_phase(bf16_t* ST) {
    for (int it = blockIdx.x * 512 + ltid(); it < 4096 * 32; it += gridDim.x * 512) {
        const int r = it >> 5, d8 = it & 31; const float cd = fexp2(256.0f * log2gamma(r >> 9));
        bf16_t* p = ST + (size_t)r * S_ + d8 * 8; float s[8];
#pragma unroll
        for (int j = 0; j < 8; ++j) s[j] = 0.f;
        for (int c = 0; c < 64; ++c) { const u32x4 v = *(const u32x4*)(p + c * 256);
            *(u32x4*)(p + c * 256) = (u32x4){pk_bf16(s[0], s[1]), pk_bf16(s[2], s[3]), pk_bf16(s[4], s[5]), pk_bf16(s[6], s[7])};
#pragma unroll
            for (int j = 0; j < 4; ++j) { s[2 * j] = s[2 * j] * cd + bflo(v[j]); s[2 * j + 1] = s[2 * j + 1] * cd + bfhi(v[j]); } }
    }
}
__device__ __forceinline__ void gn_phase(bf16_t* Y, const float* gain) {
    const int w = ltid() >> 6, lane = ltid() & 63;
    for (int g = blockIdx.x * 8 + w; g < S_ * 8; g += gridDim.x * 8) {
        bf16_t* p = Y + (size_t)g * 512 + lane * 8; const u32x4 v = *(const u32x4*)p; float x[8];
#pragma unroll
        for (int j = 0; j < 4; ++j) { x[2 * j] = bflo(v[j]); x[2 * j + 1] = bfhi(v[j]); }
        float s = 0.f;
#pragma unroll
        for (int j = 0; j < 8; ++j) s += x[j];
        const float mu = wave_sum(s, lane) * (1.0f / 512.0f); float q = 0.f;
#pragma unroll
        for (int j = 0; j < 8; ++j) { x[j] -= mu; q += x[j] * x[j]; }
        const float r = rsqrtf(wave_sum(q, lane) * (1.0f / 512.0f) + 1e-6f); const float* gp = gain + (g & 7) * 512 + lane * 8;
        const f32x4 g0 = *(const f32x4*)gp, g1 = *(const f32x4*)(gp + 4);
        *(u32x4*)p = (u32x4){pk_bf16(x[0] * r * g0[0], x[1] * r * g0[1]), pk_bf16(x[2] * r * g0[2], x[3] * r * g0[3]), pk_bf16(x[4] * r * g1[0], x[5] * r * g1[1]), pk_bf16(x[6] * r * g1[2], x[7] * r * g1[3])};
    }
}
__device__ __forceinline__ void conv_phase(const bf16_t* U, bf16_t* AB, const float* cw, const float* cb) {
    for (int it = blockIdx.x * 512 + ltid(); it < 2048 * 512; it += gridDim.x * 512) {
        const int n8 = (it & 511) * 8, t0 = (it >> 9) * 8;
        float wa[3][8], wb[3][8], ba[8], bb[8];
#pragma unroll
        for (int tp = 0; tp < 3; ++tp)
#pragma unroll
            for (int j = 0; j < 8; ++j) { wa[tp][j] = cw[tp * 8192 + n8 + j]; wb[tp][j] = cw[tp * 8192 + 4096 + n8 + j]; }
#pragma unroll
        for (int j = 0; j < 8; ++j) { ba[j] = cb[n8 + j]; bb[j] = cb[4096 + n8 + j]; }
        float pa[2][8], pb[2][8];
#pragma unroll
        for (int k = 0; k < 2; ++k) { const int t = t0 - 2 + k; u32x4 va = (u32x4){0, 0, 0, 0}, vb = (u32x4){0, 0, 0, 0};
            if (t >= 0) { va = *(const u32x4*)(U + (size_t)t * 8192 + n8); vb = *(const u32x4*)(U + (size_t)t * 8192 + 4096 + n8); }
#pragma unroll
            for (int j = 0; j < 4; ++j) { pa[k][2 * j] = bflo(va[j]); pa[k][2 * j + 1] = bfhi(va[j]); pb[k][2 * j] = bflo(vb[j]); pb[k][2 * j + 1] = bfhi(vb[j]); } }
#pragma unroll
        for (int k = 0; k < 8; ++k) { const int t = t0 + k; const u32x4 va = *(const u32x4*)(U + (size_t)t * 8192 + n8), vb = *(const u32x4*)(U + (size_t)t * 8192 + 4096 + n8);
            float xa[8], xb[8], o[8];
#pragma unroll
            for (int j = 0; j < 4; ++j) { xa[2 * j] = bflo(va[j]); xa[2 * j + 1] = bfhi(va[j]); xb[2 * j] = bflo(vb[j]); xb[2 * j + 1] = bfhi(vb[j]); }
#pragma unroll
            for (int j = 0; j < 8; ++j) { const float a = ba[j] + wa[0][j] * pa[0][j] + wa[1][j] * pa[1][j] + wa[2][j] * xa[j]; const float b = bb[j] + wb[0][j] * pb[0][j] + wb[1][j] * pb[1][j] + wb[2][j] * xb[j];
                o[j] = a * sigmoidf_(a) * b; pa[0][j] = pa[1][j]; pa[1][j] = xa[j]; pb[0][j] = pb[1][j]; pb[1][j] = xb[j]; }
            *(u32x4*)(AB + (size_t)t * 4096 + n8) = (u32x4){pk_bf16(o[0], o[1]), pk_bf16(o[2], o[3]), pk_bf16(o[4], o[5]), pk_bf16(o[6], o[7])}; }
    }
}

constexpr int A_KT = 0, A_VT = 17408, A_PSL = 34816, A_SEL = 34816 + 65536;
constexpr float LOG2E = 1.4426950408889634f;
struct AttnState { f32x4 ot[8][2]; float m[2], l[2]; };

template <int MODE>
__device__ __forceinline__ void attn_tiles(LAS unsigned char* lds, const bf16_t* kp, size_t kstride, const bf16_t* vp, size_t vstride, int tile_lo, int tile_hi,
                                           const bf16x8 (&qf)[2][4], AttnState& st, const int (&tpos)[2], int qb, int w, int lane, const float (&mfin)[2], const float (&linv)[2]) {
    int tid = w * 64 + lane; asm volatile("" : "+v"(tid)); const int l16 = lane & 15, g4 = lane >> 4;
    const int krow = tid >> 3, kc = (tid & 7) * 16, vrow = tid >> 2, vc = (tid & 3) * 16;
    u32x4 kr0, kr1, vr0 = (u32x4){0, 0, 0, 0}, vr1 = (u32x4){0, 0, 0, 0};
    if (tile_lo < tile_hi) {
        const bf16_t* kg = kp + (size_t)(tile_lo * 64 + krow) * kstride + kc; kr0 = *(const u32x4*)kg; kr1 = *(const u32x4*)(kg + 8);
        if (MODE != 0) { const bf16_t* vg = vp + (size_t)vrow * vstride + tile_lo * 64 + vc; vr0 = *(const u32x4*)vg; vr1 = *(const u32x4*)(vg + 8); }
    }
    for (int tile = tile_lo; tile < tile_hi; ++tile) {
        __syncthreads();
        { LAS unsigned char* kd = lds + A_KT + krow * 272 + kc * 2; *(LAS u32x4*)kd = kr0; *(LAS u32x4*)(kd + 16) = kr1;
          if (MODE != 0) { LAS unsigned char* vd = lds + A_VT + vrow * 136 + vc * 2; *(LAS u32x2*)vd = (u32x2){vr0[0], vr0[1]}; *(LAS u32x2*)(vd + 8) = (u32x2){vr0[2], vr0[3]}; *(LAS u32x2*)(vd + 16) = (u32x2){vr1[0], vr1[1]}; *(LAS u32x2*)(vd + 24) = (u32x2){vr1[2], vr1[3]}; } }
        __syncthreads();
        if (tile + 1 < tile_hi) {
            const bf16_t* kg = kp + (size_t)((tile + 1) * 64 + krow) * kstride + kc; kr0 = *(const u32x4*)kg; kr1 = *(const u32x4*)(kg + 8);
            if (MODE != 0) { const bf16_t* vg = vp + (size_t)vrow * vstride + (tile + 1) * 64 + vc; vr0 = *(const u32x4*)vg; vr1 = *(const u32x4*)(vg + 8); }
        }
        f32x4 s[4][2];
#pragma unroll
        for (int mt = 0; mt < 4; ++mt) { s[mt][0] = (f32x4){0.f, 0.f, 0.f, 0.f}; s[mt][1] = (f32x4){0.f, 0.f, 0.f, 0.f}; }
#pragma unroll
        for (int ks = 0; ks < 4; ++ks)
#pragma unroll
            for (int mt = 0; mt < 4; ++mt) { const bf16x8 kf = *(const LAS bf16x8*)(lds + A_KT + (16 * mt + l16) * 272 + ks * 64 + g4 * 16);
                s[mt][0] = __builtin_amdgcn_mfma_f32_16x16x32_bf16(kf, qf[0][ks], s[mt][0], 0, 0, 0);
                s[mt][1] = __builtin_amdgcn_mfma_f32_16x16x32_bf16(kf, qf[1][ks], s[mt][1], 0, 0, 0);
                if (mt == 3) __builtin_amdgcn_sched_barrier(0); }
        bf16x8 pf[2][2];
#pragma unroll
        for (int nt = 0; nt < 2; ++nt) {
            const int t = tpos[nt]; const int tl = w * 8 + nt * 4 + (l16 >> 2);
            bool rowsel = true;
            if (MODE == 2) { const unsigned wd = *(const LAS unsigned*)(lds + A_SEL + ((w * 8 + nt * 4 + (l16 >> 2)) * 8 + (tile >> 5)) * 4); rowsel = (wd >> (tile & 31)) & 1u; }
            float mx = -1e30f;
#pragma unroll
            for (int mt = 0; mt < 4; ++mt)
#pragma unroll
                for (int j = 0; j < 4; ++j) { const int kl = 16 * mt + 4 * g4 + j; const int key = tile * 64 + kl; bool v;
                    if (MODE == 0 || MODE == 1) v = key <= ((t - 31) >> 4);
                    else if (MODE == 2) v = rowsel && (tile < qb || kl <= tl);
                    else v = (key <= t) && (key > t - 512);
                    const float sv = v ? s[mt][nt][j] * LOG2E : -__builtin_inff(); s[mt][nt][j] = sv; mx = fmaxf(mx, sv); }
            float mnew, alpha = 1.f;
            if (MODE == 1) mnew = mfin[nt];
            else { mx = fmaxf(mx, shx(mx, 16, lane)); mx = fmaxf(mx, shx(mx, 32, lane)); mnew = fmaxf(st.m[nt], mx); alpha = fexp2(st.m[nt] - mnew); st.m[nt] = mnew; }
            float ps = 0.f;
#pragma unroll
            for (int mt = 0; mt < 4; ++mt)
#pragma unroll
                for (int j = 0; j < 4; ++j) { float pv = fexp2(s[mt][nt][j] - mnew); if (MODE == 1) pv *= linv[nt]; s[mt][nt][j] = pv; ps += pv; }
            if (MODE != 1) st.l[nt] = st.l[nt] * alpha + ps;
            if (MODE == 2 || MODE == 3) {
#pragma unroll
                for (int md = 0; md < 8; ++md) st.ot[md][nt] = st.ot[md][nt] * alpha;
            }
            if (MODE == 1) {
#pragma unroll
                for (int mt = 0; mt < 4; ++mt) { float a = s[mt][nt][0] + s[mt][nt][1] + s[mt][nt][2] + s[mt][nt][3], lst = s[mt][nt][3];
                    a += shx(a, 1, lane); a += shx(a, 2, lane); lst += shx(lst, 1, lane); lst += shx(lst, 2, lane);
                    if ((l16 & 3) == 0) { const int jb = tile * 16 + 4 * mt + g4; LAS float* pp = (LAS float*)(lds + A_PSL) + (w * 8 + nt * 4 + (l16 >> 2)) * 256;
                        atomicAdd((float*)(pp + jb), a); if (jb + 1 < 256) atomicAdd((float*)(pp + jb + 1), lst); } }
            }
            if (MODE != 0) {
#pragma unroll
                for (int kk = 0; kk < 2; ++kk) { const u32x4 pk = (u32x4){pk_bf16(s[2 * kk][nt][0], s[2 * kk][nt][1]), pk_bf16(s[2 * kk][nt][2], s[2 * kk][nt][3]), pk_bf16(s[2 * kk + 1][nt][0], s[2 * kk + 1][nt][1]), pk_bf16(s[2 * kk + 1][nt][2], s[2 * kk + 1][nt][3])};
                    pf[nt][kk] = __builtin_bit_cast(bf16x8, pk); }
            }
        }
        if (MODE != 0) {
#pragma unroll
            for (int kk = 0; kk < 2; ++kk)
#pragma unroll
                for (int md = 0; md < 8; ++md) { const LAS unsigned char* vb = lds + A_VT + (16 * md + l16) * 136 + kk * 64 + g4 * 8;
                    const u32x2 v0 = *(const LAS u32x2*)vb, v1 = *(const LAS u32x2*)(vb + 32); const bf16x8 vf = __builtin_bit_cast(bf16x8, ((u32x4){v0[0], v0[1], v1[0], v1[1]}));
                    st.ot[md][0] = __builtin_amdgcn_mfma_f32_16x16x32_bf16(vf, pf[0][kk], st.ot[md][0], 0, 0, 0);
                    st.ot[md][1] = __builtin_amdgcn_mfma_f32_16x16x32_bf16(vf, pf[1][kk], st.ot[md][1], 0, 0, 0);
                    if ((md & 3) == 3) __builtin_amdgcn_sched_barrier(0); }
        }
    }
}
template <int BR>
__device__ __forceinline__ void attn_finish(AttnState& st, const float* gates, float* oacc, bf16_t* att, const int (&tpos)[2], int hkv, int lane) {
    const int l16 = lane & 15, g4 = lane >> 4, g = l16 & 3;
#pragma unroll
    for (int nt = 0; nt < 2; ++nt) {
        const int t = tpos[nt]; float sc = gates[(size_t)t * 48 + (hkv * 4 + g) * 3 + BR];
        if (BR != 0) { float l = st.l[nt]; l += shx(l, 16, lane); l += shx(l, 32, lane); sc = (l > 0.f) ? sc / l : 0.f; }
        const size_t base = (size_t)t * 2048 + (hkv * 4 + g) * 128 + 4 * g4;
#pragma unroll
        for (int md = 0; md < 8; ++md) { f32x4 v = st.ot[md][nt] * sc; float* op = oacc + base + 16 * md;
            if (BR == 0) *(f32x4*)op = v;
            else if (BR == 1) *(f32x4*)op = *(const f32x4*)op + v;
            else { v = v + *(const f32x4*)op; *(u32x2*)(att + base + 16 * md) = (u32x2){pk_bf16(v[0], v[1]), pk_bf16(v[2], v[3])}; } }
    }
}
__device__ __forceinline__ void attn_reset(AttnState& st) {
#pragma unroll
    for (int md = 0; md < 8; ++md) { st.ot[md][0] = (f32x4){0.f, 0.f, 0.f, 0.f}; st.ot[md][1] = (f32x4){0.f, 0.f, 0.f, 0.f}; }
    st.m[0] = st.m[1] = -1e30f; st.l[0] = st.l[1] = 0.f;
}
__device__ __forceinline__ void attn_item(unsigned char* ws, LAS unsigned char* lds, int hkv, int qb) {
    int tid = ltid(); asm volatile("" : "+v"(tid)); const int w = tid >> 6, lane = tid & 63, l16 = lane & 15, g4 = lane >> 4;
    const bf16_t* QB = (const bf16_t*)(ws + OFF_QB); const bf16_t* KVTOK = (const bf16_t*)(ws + OFF_KVTOK); const bf16_t* KVT = (const bf16_t*)(ws + OFF_KVT);
    const bf16_t* KC = (const bf16_t*)(ws + OFF_KCMP); const bf16_t* VC = (const bf16_t*)(ws + OFF_VCMPT);
    const float* gates = (const float*)(ws + OFF_GATES); float* oacc = (float*)(ws + OFF_OACC); bf16_t* att = (bf16_t*)(ws + OFF_ATT);
    int tpos[2]; bf16x8 qf[2][4];
#pragma unroll
    for (int nt = 0; nt < 2; ++nt) { tpos[nt] = qb * 64 + w * 8 + nt * 4 + (l16 >> 2); const bf16_t* qp = QB + (size_t)tpos[nt] * 2048 + (hkv * 4 + (l16 & 3)) * 128 + g4 * 8;
#pragma unroll
        for (int ks = 0; ks < 4; ++ks) qf[nt][ks] = *(const bf16x8*)(qp + ks * 32); }
    __syncthreads();
    { LAS float* pp = (LAS float*)(lds + A_PSL) + w * 2048;
#pragma unroll
      for (int i = 0; i < 32; ++i) pp[lane + 64 * i] = 0.f; }
    AttnState st; float mfin[2] = {0.f, 0.f}, linv[2] = {0.f, 0.f};
    const int ncmp_tiles = (4 * qb + 3 + 63) >> 6;
    attn_reset(st);
    attn_tiles<0>(lds, KC + (size_t)hkv * 1024 * 128, 128, VC, 1024, 0, ncmp_tiles, qf, st, tpos, qb, w, lane, mfin, linv);
#pragma unroll
    for (int nt = 0; nt < 2; ++nt) { float l = st.l[nt]; l += shx(l, 16, lane); l += shx(l, 32, lane); mfin[nt] = st.m[nt]; linv[nt] = (l > 0.f) ? 1.0f / l : 0.f; }
    attn_reset(st);
    attn_tiles<1>(lds, KC + (size_t)hkv * 1024 * 128, 128, VC + (size_t)hkv * 128 * 1024, 1024, 0, ncmp_tiles, qf, st, tpos, qb, w, lane, mfin, linv);
    attn_finish<0>(st, gates, oacc, att, tpos, hkv, lane);
    __syncthreads();
    {
        LAS unsigned* sel = (LAS unsigned*)(lds + A_SEL) + w * 64;
        if (qb < 16) {
            if (lane < 8) { for (int tk = 0; tk < 8; ++tk) { const int lo = lane * 32; unsigned wd = 0; if (qb >= lo + 31) wd = 0xffffffffu; else if (qb >= lo) wd = (2u << (qb - lo)) - 1u; sel[tk * 8 + lane] = wd; } }
        } else {
            for (int tk = 0; tk < 8; ++tk) {
                const LAS float* pp = (const LAS float*)(lds + A_PSL) + (w * 8 + tk) * 256;
                unsigned long long key[4]; bool taken[4];
#pragma unroll
                for (int i = 0; i < 4; ++i) { const int j = lane + 64 * i; const float sc = pp[j]; const bool elig = (j >= 1) && (j <= qb - 2);
                    taken[i] = (j == 0) || (j == qb) || (j == qb - 1);
                    key[i] = elig ? (((unsigned long long)__float_as_uint(sc) << 32) | (unsigned long long)(0x1000 - j)) : 0ull; }
                for (int r = 0; r < 13; ++r) {
                    unsigned long long best = key[0];
#pragma unroll
                    for (int i = 1; i < 4; ++i) best = key[i] > best ? key[i] : best;
#pragma unroll
                    for (int o = 32; o >= 1; o >>= 1) { const unsigned long long ot = shx64(best, o, lane); best = ot > best ? ot : best; }
#pragma unroll
                    for (int i = 0; i < 4; ++i) if (key[i] == best && best != 0ull) { taken[i] = true; key[i] = 0ull; }
                }
#pragma unroll
                for (int i = 0; i < 4; ++i) { const unsigned long long bal = __ballot(taken[i]); if (lane == 0) { sel[tk * 8 + 2 * i] = (unsigned)bal; sel[tk * 8 + 2 * i + 1] = (unsigned)(bal >> 32); } }
            }
        }
    }
    __syncthreads();
    attn_reset(st);
    attn_tiles<2>(lds, KVTOK + 2 * 512 + hkv * 128, 2048, KVT + (size_t)(hkv * 128) * S_, S_, 0, qb + 1, qf, st, tpos, qb, w, lane, mfin, linv);
    attn_finish<1>(st, gates, oacc, att, tpos, hkv, lane);
    attn_reset(st);
    attn_tiles<3>(lds, KVTOK + 3 * 512 + hkv * 128, 2048, KVT + (size_t)(512 + hkv * 128) * S_, S_, (qb - 8) > 0 ? (qb - 8) : 0, qb + 1, qf, st, tpos, qb, w, lane, mfin, linv);
    attn_finish<2>(st, gates, oacc, att, tpos, hkv, lane);
}
__device__ __forceinline__ void attn_phase(unsigned char* ws, LAS unsigned char* lds) {
#pragma nounroll
    for (int it = blockIdx.x; it < 1024; it += gridDim.x) {
        const int c = it & 255, r = it >> 8;
        attn_item(ws, lds, r, (r & 1) ? 255 - c : c);
    }
}


#define XB_TMO      128
#define XB_XCNT(j)  (256  + 64 * (j))
#define XB_XSUB(j)  (1280 + 64 * (j))
#define XB_XGEN(j)  (2304 + 64 * (j))
#define XB_TOP      3328
#define XB_TOPGEN   3392
#define XCD_BAR_WORDS 3456
#define XB_SPIN_CAP (1u << 22)
__device__ __forceinline__ unsigned xb_ld(unsigned* p)              { return __hip_atomic_load(p, __ATOMIC_RELAXED, __HIP_MEMORY_SCOPE_AGENT); }
__device__ __forceinline__ unsigned xb_add(unsigned* p, unsigned v) { return __hip_atomic_fetch_add(p, v, __ATOMIC_RELAXED, __HIP_MEMORY_SCOPE_AGENT); }
__device__ __forceinline__ unsigned xb_xcc_id() { return (unsigned)__builtin_amdgcn_s_getreg((3 << 11) | 20) & 0xFu; }
#define XB_SPIN(cond, bar) do { unsigned _sp = 0; while (cond) { __builtin_amdgcn_s_sleep(1); \
    if ((++_sp & 255u) == 0u) { if (xb_ld(&(bar)[XB_TMO])) break; if (_sp > XB_SPIN_CAP) { atomicAdd(&(bar)[XB_TMO], 1u); break; } } } } while (0)
struct XcdBarrier { unsigned* bar; unsigned x; volatile LAS unsigned* st; };
__device__ __forceinline__ XcdBarrier xcd_barrier_post(unsigned* bar, volatile LAS unsigned* st) {
    XcdBarrier b; b.bar = bar; b.x = xb_xcc_id(); b.st = st;
    if (threadIdx.x == 0) (void)xb_add(&bar[XB_XCNT(b.x)], 1u);
    return b;
}
__device__ __forceinline__ void xcd_barrier_complete(unsigned* bar, unsigned x, unsigned& nloc, unsigned& nx) {
    const unsigned G = gridDim.x * gridDim.y * gridDim.z;
    unsigned sum, cnt, mine, sp = 0u;
    for (;;) {
        sum = 0u; cnt = 0u; mine = 0u;
#pragma unroll
        for (unsigned j = 0; j < 16; ++j) { const unsigned c = xb_ld(&bar[XB_XCNT(j)]); sum += c; cnt += (c > 0u) ? 1u : 0u; mine = (j == x) ? c : mine; }
        if (sum == G) break;
        __builtin_amdgcn_s_sleep(1);
        if ((++sp & 255u) == 0u) { if (xb_ld(&bar[XB_TMO])) break; if (sp > XB_SPIN_CAP) { atomicAdd(&bar[XB_TMO], 1u); break; } }
    }
    nloc = mine > 0u ? mine : 1u; nx = cnt > 0u ? cnt : 1u;
}
__device__ __forceinline__ void xcd_barrier(const XcdBarrier& b) {
    asm volatile("s_waitcnt vmcnt(0)" ::: "memory");
    __syncthreads();
    if (threadIdx.x == 0) {
        unsigned* bar = b.bar;
        __builtin_amdgcn_s_waitcnt(0);
        unsigned nloc = b.st[0], nx = b.st[1];
        if (nloc == 0u) { xcd_barrier_complete(bar, b.x, nloc, nx); b.st[0] = nloc; b.st[1] = nx; }
        const unsigned old = xb_add(&bar[XB_XSUB(b.x)], 1u);
        const unsigned gen = old / nloc;
        if (old + 1u == (gen + 1u) * nloc) {
            __builtin_amdgcn_fence(__ATOMIC_RELEASE, "agent");
            asm volatile("s_waitcnt vmcnt(0)" ::: "memory");
            const unsigned og = xb_add(&bar[XB_TOP], 1u);
            const unsigned tg = og / nx;
            if (og + 1u == (tg + 1u) * nx) xb_add(&bar[XB_TOPGEN], 1u);
            else XB_SPIN(xb_ld(&bar[XB_TOPGEN]) == tg, bar);
            __builtin_amdgcn_fence(__ATOMIC_ACQUIRE, "agent");
            xb_add(&bar[XB_XGEN(b.x)], 1u);
            asm volatile("s_waitcnt vmcnt(0)" ::: "memory");
        } else {
            XB_SPIN(xb_ld(&bar[XB_XGEN(b.x)]) == gen, bar);
            __builtin_amdgcn_fence(__ATOMIC_ACQUIRE, "agent");
            asm volatile("s_waitcnt vmcnt(0)" ::: "memory");
        }
    }
    __syncthreads();
}

constexpr int NPH = 23;
__device__ __forceinline__ void run_phase(CP p, int ph, int b, LAS unsigned char* lds) {
    asm volatile("" : "+s"(p));
    unsigned char* ws = p->ws;
    const float* xb = p->x + (size_t)b * S_ * D_; float* hb = p->out + (size_t)b * S_ * D_;
    bf16_t* XN = (bf16_t*)(ws + OFF_XN);
    const int layer = (ph >= 13) ? 1 : 0;
    switch (ph) {
    case 0: prep_phase(p, lds); break;
    case 1: rmsnorm_phase(xb, p->norm_mix, XN, nullptr, nullptr); break;
    case 2: {
        Prob2D<EpiQK> g1{(const char*)XN, (const char*)(ws + OFF_W_RIN), 4096u, 4096u, 32, 64, 16, EpiQK{(bf16_t*)(ws + OFF_Q), (bf16_t*)(ws + OFF_K), (bf16_t*)(ws + OFF_KTD), (const float2*)(ws + OFF_ROPE)}};
        gemm_phase(lds, g1);
        Prob2D<EpiStore> g2{(const char*)(ws + OFF_W_RIN) + (size_t)4096 * 4096, (const char*)XN, 4096u, 4096u, 32, 16, 64, EpiStore{(bf16_t*)(ws + OFF_VT), (size_t)S_}};
        gemm_phase(lds, g2);
    } break;
    case 3: {
        ProbKV g3{(const char*)(ws + OFF_VT), (const char*)(ws + OFF_KTD), (bf16_t*)(ws + OFF_ST), 4};
        gemm_phase(lds, g3);
        ProbS g4{(const char*)(ws + OFF_Q), (const char*)(ws + OFF_K), (bf16_t*)(ws + OFF_SD), 4};
        gemm_phase(lds, g4);
    } break;
    case 4: scan_phase((bf16_t*)(ws + OFF_ST)); break;
    case 5: {
        ProbOut g5{(const char*)(ws + OFF_Q), (const char*)(ws + OFF_ST), (long)OFF_SD - (long)OFF_Q, (long)OFF_VT - (long)OFF_ST, (bf16_t*)(ws + OFF_Y), 8};
        gemm_phase(lds, g5);
    } break;
    case 6: gn_phase((bf16_t*)(ws + OFF_Y), p->ret_gn); break;
    case 7: {
        Prob2D<EpiGate> g6{(const char*)XN, (const char*)(ws + OFF_W_RIN) + (size_t)8192 * 4096, 4096u, 4096u, 32, 64, 16, EpiGate{(bf16_t*)(ws + OFF_Y)}};
        gemm_phase(lds, g6);
    } break;
    case 8: {
        Prob2D<EpiRes> g7{(const char*)(ws + OFF_Y), (const char*)(ws + OFF_W_ROUT), 8192u, 8192u, 64, 64, 8, EpiRes{xb, hb}};
        gemm_phase(lds, g7);
    } break;
    case 9: case 19: rmsnorm_phase(hb, p->norm_ffn + layer * 2048, XN, nullptr, nullptr); break;
    case 10: case 20: {
        Prob2D<EpiStore> g8{(const char*)XN, (const char*)(ws + OFF_W_FIN + (size_t)layer * 32 * MiB), 4096u, 4096u, 32, 64, 32, EpiStore{(bf16_t*)(ws + OFF_U), (size_t)8192}};
        gemm_phase(lds, g8);
    } break;
    case 11: case 21: conv_phase((const bf16_t*)(ws + OFF_U), (bf16_t*)(ws + OFF_AB), p->ffn_conv_w + (size_t)layer * 3 * 8192, p->ffn_conv_b + (size_t)layer * 8192); break;
    case 12: case 22: {
        Prob2D<EpiRes> g9{(const char*)(ws + OFF_AB), (const char*)(ws + OFF_W_FOUT + (size_t)layer * 16 * MiB), 8192u, 8192u, 64, 64, 8, EpiRes{hb, hb}};
        gemm_phase(lds, g9);
    } break;
    case 13: rmsnorm_phase(hb, p->norm_mix + 2048, XN, p->kv_gain, (bf16_t*)(ws + OFF_HN)); break;
    case 14: {
        Prob2D<EpiStore> g10{(const char*)(ws + OFF_HN), (const char*)(ws + OFF_W_KV), 4096u, 4096u, 32, 64, 8, EpiStore{(bf16_t*)(ws + OFF_KVTOK), (size_t)2048}};
        gemm_phase(lds, g10);
        Prob2D<EpiStore> g11{(const char*)(ws + OFF_W_KV) + (size_t)2048 * 4096, (const char*)(ws + OFF_HN), 4096u, 4096u, 32, 4, 64, EpiStore{(bf16_t*)(ws + OFF_KVT), (size_t)S_}};
        gemm_phase(lds, g11);
        Prob2D<EpiQproj> g12{(const char*)XN, (const char*)(ws + OFF_W_Q), 4096u, 4096u, 32, 64, 9, EpiQproj{(bf16_t*)(ws + OFF_QB), (float*)(ws + OFF_GATES)}};
        gemm_phase(lds, g12);
    } break;
    case 15: {
        ProbCmp1 a{(const char*)(ws + OFF_KVTOK), (const char*)(ws + OFF_W_C1K), 8192u, 64, 16, EpiGelu{(bf16_t*)(ws + OFF_H1), (const float*)(ws + OFF_PEB)}};
        gemm_phase(lds, a);
        ProbCmp1 v{(const char*)(ws + OFF_KVTOK) + 1024, (const char*)(ws + OFF_W_C1V), 8192u, 64, 16, EpiGelu{(bf16_t*)(ws + OFF_H1) + 4096 * 256, (const float*)(ws + OFF_PEB) + 256}};
        gemm_phase(lds, v);
    } break;
    case 16: {
        Prob2D<EpiKcmp> a{(const char*)(ws + OFF_H1), (const char*)(ws + OFF_W_C2K), 512u, 512u, 4, 16, 1, EpiKcmp{(bf16_t*)(ws + OFF_KCMP)}};
        gemm_phase(lds, a);
        Prob2D<EpiVcmp> v{(const char*)(ws + OFF_W_C2V), (const char*)(ws + OFF_H1) + (size_t)4096 * 256 * 2, 512u, 512u, 4, 1, 16, EpiVcmp{(bf16_t*)(ws + OFF_VCMPT)}};
        gemm_phase(lds, v);
    } break;
    case 17: attn_phase(ws, lds); break;
    case 18: {
        Prob2D<EpiRes> g{(const char*)(ws + OFF_ATT), (const char*)(ws + OFF_W_O), 4096u, 4096u, 32, 64, 8, EpiRes{hb, hb}};
        gemm_phase(lds, g);
    } break;
    case 23: finalnorm_phase(hb, p->final_gain); break;
    default: break;
    }
}

#if MULTI
__global__ void __launch_bounds__(512) phase_kernel(Params p, int ph, int b) {
    extern __shared__ __attribute__((aligned(16))) unsigned char shm[];
    run_phase((CP)__builtin_amdgcn_kernarg_segment_ptr(), ph, b, (LAS unsigned char*)shm);
}
#else
__global__ void __launch_bounds__(512) mega_kernel(Params p) {
    extern __shared__ __attribute__((aligned(16))) unsigned char shm[];
    cg::grid_group grid = cg::this_grid();
    CP cp = (CP)__builtin_amdgcn_kernarg_segment_ptr();
    volatile LAS unsigned* st = (volatile LAS unsigned*)((LAS unsigned char*)shm + 131072);
    if (threadIdx.x == 0) { st[0] = 0u; st[1] = 0u; st[2] = 0u; st[3] = 0u; }
    __syncthreads();
    XcdBarrier xb = xcd_barrier_post((unsigned*)(cp->ws + OFF_BAR), st);
    run_phase(cp, 0, 0, (LAS unsigned char*)shm);
    grid.sync();
    for (int b = 0; b < 2; ++b)
        for (int ph = 1; ph <= NPH; ++ph) {
#ifdef PROBE_PH
            const int reps = (ph == PROBE_PH || ph == PROBE_PH2) ? 2 : 1;
#else
            const int reps = 1;
#endif
            for (int rep = 0; rep < reps; ++rep) { run_phase(cp, ph, b, (LAS unsigned char*)shm); xcd_barrier(xb); } }
}
#endif

constexpr int LDS_BYTES = 131072 + 16;
extern "C" void kernel_launch(void* const* d_in, const int* in_sizes, int n_in, void* d_out, int out_size, void* d_ws, size_t ws_size, hipStream_t stream) {
    static int grid = 0;
    if (grid == 0) {
        if (n_in != 21 || out_size != 2 * S_ * D_ || ws_size < WS_NEED) { fprintf(stderr, "kernel_launch: unexpected shapes/ws (n_in %d out %d ws %zu need %zu)\n", n_in, out_size, ws_size, (size_t)WS_NEED); grid = -1; return; }
#if MULTI
        if (hipFuncSetAttribute((const void*)phase_kernel, hipFuncAttributeMaxDynamicSharedMemorySize, LDS_BYTES) != hipSuccess) { fprintf(stderr, "hipFuncSetAttribute failed\n"); grid = -1; return; }
#else
        if (hipFuncSetAttribute((const void*)mega_kernel, hipFuncAttributeMaxDynamicSharedMemorySize, LDS_BYTES) != hipSuccess) { fprintf(stderr, "hipFuncSetAttribute failed\n"); grid = -1; return; }
#endif
        int dev = 0, cus = 0; hipGetDevice(&dev); hipDeviceGetAttribute(&cus, hipDeviceAttributeMultiprocessorCount, dev);
        grid = cus > 0 ? cus : 256;
    }
    if (grid < 0) return;
    Params p{};
    const float** pp = (const float**)&p;
    for (int i = 0; i < 21; ++i) pp[i] = (const float*)d_in[i];
    p.out = (float*)d_out; p.ws = (unsigned char*)d_ws;
#if MULTI
    hipLaunchKernelGGL(phase_kernel, dim3(grid), dim3(512), LDS_BYTES, stream, p, 0, 0);
    for (int b = 0; b < 2; ++b)
        for (int ph = 1; ph <= NPH; ++ph) hipLaunchKernelGGL(phase_kernel, dim3(grid), dim3(512), LDS_BYTES, stream, p, ph, b);
#else
    if (hipMemsetAsync((unsigned char*)d_ws + OFF_BAR, 0, XCD_BAR_WORDS * 4, stream) != hipSuccess) { fprintf(stderr, "memset failed\n"); return; }
    void* args[] = {&p};
    hipError_t e = hipLaunchCooperativeKernel((const void*)mega_kernel, dim3(grid), dim3(512), args, LDS_BYTES, stream);
    if (e != hipSuccess) fprintf(stderr, "cooperative launch failed: %s (grid %d)\n", hipGetErrorString(e), grid);
#endif
}
```

```cpp
#include <hip/hip_runtime.h>
#include <hip/hip_cooperative_groups.h>
#include <cstdio>
namespace cg = cooperative_groups;

#ifndef MULTI
#define MULTI 0
#endif

#define LAS __attribute__((address_space(3)))
typedef unsigned short bf16_t;
typedef short bf16x8 __attribute__((ext_vector_type(8)));
typedef float f32x4 __attribute__((ext_vector_type(4)));
typedef unsigned u32x2 __attribute__((ext_vector_type(2)));
typedef unsigned u32x4 __attribute__((ext_vector_type(4)));

constexpr int S_ = 16384, D_ = 2048;
constexpr size_t MiB = 1048576;
constexpr size_t OFF_W_RIN = 0, OFF_W_ROUT = 48 * MiB, OFF_W_KV = 64 * MiB, OFF_W_C1K = 76 * MiB, OFF_W_C1V = 78 * MiB,
                 OFF_W_C2K = 80 * MiB, OFF_W_C2V = 80 * MiB + 131072, OFF_W_Q = 81 * MiB, OFF_W_O = 90 * MiB,
                 OFF_W_FIN = 98 * MiB  , OFF_W_FOUT = 162 * MiB  , OFF_ROPE = 194 * MiB, OFF_PEB = 210 * MiB, OFF_BAR = 210 * MiB + 65536,
                 OFF_XN = 211 * MiB, OFF_ACT = 275 * MiB;
constexpr size_t OFF_Q = OFF_ACT, OFF_K = OFF_ACT + 64 * MiB, OFF_KTD = OFF_ACT + 128 * MiB, OFF_VT = OFF_ACT + 192 * MiB,
                 OFF_ST = OFF_ACT + 320 * MiB, OFF_SD = OFF_ACT + 448 * MiB, OFF_Y = OFF_ACT + 512 * MiB, WS_NEED = OFF_ACT + 640 * MiB;
constexpr size_t OFF_U = OFF_ACT, OFF_AB = OFF_ACT + 256 * MiB;
constexpr size_t OFF_HN = OFF_ACT, OFF_KVTOK = OFF_ACT + 64 * MiB, OFF_KVT = OFF_ACT + 129 * MiB, OFF_QB = OFF_ACT + 161 * MiB,
                 OFF_GATES = OFF_ACT + 225 * MiB, OFF_H1 = OFF_ACT + 229 * MiB, OFF_KCMP = OFF_ACT + 233 * MiB, OFF_VCMPT = OFF_ACT + 234 * MiB,
                 OFF_ATT = OFF_ACT + 235 * MiB, OFF_OACC = OFF_ACT + 299 * MiB;

struct Params {
    const float* x; const float* norm_mix; const float* norm_ffn; const float* ret_w_in; const float* ret_gn; const float* ret_w_out;
    const float* kv_gain; const float* w_kv; const float* pe_k; const float* w1_k; const float* w2_k; const float* pe_v; const float* w1_v;
    const float* w2_v; const float* w_q; const float* w_o; const float* ffn_w_in; const float* ffn_conv_w; const float* ffn_conv_b;
    const float* ffn_w_out; const float* final_gain; float* out; unsigned char* ws;
};

typedef const __attribute__((address_space(4))) Params* CP;
__device__ __forceinline__ int ltid() { int t = threadIdx.x; asm volatile("" : "+v"(t)); return t; }
__device__ __forceinline__ unsigned pk_bf16(float lo, float hi) { unsigned r; asm("v_cvt_pk_bf16_f32 %0, %1, %2" : "=v"(r) : "v"(lo), "v"(hi)); return r; }
__device__ __forceinline__ float bflo(unsigned v) { return __uint_as_float(v << 16); }
__device__ __forceinline__ float bfhi(unsigned v) { return __uint_as_float(v & 0xffff0000u); }
__device__ __forceinline__ float fexp2(float x) { return __builtin_amdgcn_exp2f(x); }
__device__ __forceinline__ float frcp(float x) { return __builtin_amdgcn_rcpf(x); }
__device__ __forceinline__ float log2gamma(int h) { return log2f(1.0f - exp2f(-5.0f - (float)h)); }
__device__ __forceinline__ float sigmoidf_(float x) { return frcp(1.0f + fexp2(-1.4426950408889634f * x)); }

constexpr int HTB = 128 * 64 * 2;
__device__ __forceinline__ int lds_byte(int r, int c) { const int st = (r >> 4) * 2 + (c >> 5), rr = r & 15, cc = c & 31, ob = rr * 64 + cc * 2; return st * 1024 + (ob ^ (((ob >> 9) & 1) << 5)); }
__device__ __forceinline__ void stage_rc(int b, int& R, int& C) { const int st = b / 1024, sb = b % 1024, swz = sb ^ (((sb >> 9) & 1) << 5); R = (st >> 1) * 16 + swz / 64; C = (st & 1) * 32 + (swz % 64) / 2; }
__device__ __forceinline__ void tile_order(int L, int nM, int nN, int& pm, int& pn) {
    const int nwg = nM * nN; int wgid = L;
    { const int q = nwg / 8, r = nwg % 8, xcd = wgid % 8, off = wgid / 8; wgid = (xcd < r ? xcd * (q + 1) : r * (q + 1) + (xcd - r) * q) + off; }
    const int nig = 8 * nN, gid = wgid / nig, fm = gid * 8, gsz = (nM - fm) < 8 ? (nM - fm) : 8;
    pm = fm + ((wgid % nig) % gsz); pn = (wgid % nig) / gsz;
}
struct UInfo { const char* a; const char* b; int r0, c0, x0, x1; };
typedef f32x4 AccT[2][2][4][2];

template <class P>
__device__ __forceinline__ void gemm_phase(LAS unsigned char* lds, const P& pb) {
    const int tid = ltid(), wid = __builtin_amdgcn_readfirstlane(tid >> 6), lane = tid & 63, wr = wid >> 2, wc = wid & 3, fr = lane & 15, fq = lane >> 4;
    const int nt = pb.nt, G = gridDim.x, c = blockIdx.x; const long nun = pb.nunits();
    if (c >= nun) return;
    unsigned voffA[2], voffB[2];
#pragma unroll
    for (int i = 0; i < 2; ++i) { int R, C; stage_rc(tid * 16 + i * 8192, R, C); voffA[i] = pb.rowA(R) + (unsigned)C * 2u; voffB[i] = (unsigned)R * pb.ldb + (unsigned)C * 2u; }
    const size_t hsA = pb.rowA(128), hsB = (size_t)128 * pb.ldb;
    const unsigned ldsw = (unsigned)wid * 1024u;
    const int aoff = lds_byte(wr * 64 + fr, fq * 8), boff = lds_byte(wc * 32 + fr, fq * 8);
#define G_SA(b, h) (((b) * 2 + (h)) * HTB)
#define G_SB(b, h) ((4 + (b) * 2 + (h)) * HTB)
#define G_STAGE(bufoff, gbase, voff) do { _Pragma("unroll") for (int _i = 0; _i < 2; ++_i) \
        __builtin_amdgcn_global_load_lds((const unsigned*)((const char*)(gbase) + (voff)[_i]), (LAS unsigned*)(lds + (bufoff) + ldsw + _i * 8192), 16, 0, 0); } while (0)
#define G_LDA(dst, b, h) do { _Pragma("unroll") for (int m = 0; m < 4; ++m) _Pragma("unroll") for (int k = 0; k < 2; ++k) dst[m][k] = *(const LAS bf16x8*)(lds + G_SA(b, h) + aoff + m * 2048 + k * 1024); } while (0)
#define G_LDB(dst, b, h) do { _Pragma("unroll") for (int n = 0; n < 2; ++n) _Pragma("unroll") for (int k = 0; k < 2; ++k) dst[n][k] = *(const LAS bf16x8*)(lds + G_SB(b, h) + boff + n * 2048 + k * 1024); } while (0)
#define G_MMA(ai, bj, At, Bt) do { __builtin_amdgcn_s_setprio(1); _Pragma("unroll") for (int m = 0; m < 4; ++m) _Pragma("unroll") for (int n = 0; n < 2; ++n) _Pragma("unroll") for (int k = 0; k < 2; ++k) \
        acc[ai][bj][m][n] = __builtin_amdgcn_mfma_f32_16x16x32_bf16(Bt[n][k], At[m][k], acc[ai][bj][m][n], 0, 0, 0); __builtin_amdgcn_s_setprio(0); } while (0)
#define G_WAIT_V(n) asm volatile("s_waitcnt vmcnt(" #n ")" ::: "memory")
#define G_WAIT_L(n) asm volatile("s_waitcnt lgkmcnt(" #n ")" ::: "memory")
#define G_BAR __builtin_amdgcn_s_barrier()
#define G_SCHED __builtin_amdgcn_sched_barrier(0)
    UInfo cur, nxt; int ui = 0;
    pb.unit(c, cur);
    AccT acc;
#pragma unroll
    for (int a = 0; a < 2; ++a)
#pragma unroll
        for (int b = 0; b < 2; ++b)
#pragma unroll
            for (int m = 0; m < 4; ++m)
#pragma unroll
                for (int n = 0; n < 2; ++n) acc[a][b][m][n] = (f32x4){0.f, 0.f, 0.f, 0.f};
    bf16x8 At[4][2], B0[2][2], B1[2][2];
    const char* cA = cur.a; const char* cB = cur.b;
    G_STAGE(G_SB(0, 0), cB + pb.bK(0), voffB); G_STAGE(G_SA(0, 0), cA + pb.aK(0), voffA); G_STAGE(G_SB(0, 1), cB + hsB + pb.bK(0), voffB); G_STAGE(G_SA(0, 1), cA + hsA + pb.aK(0), voffA);
    if (wr == 1) G_BAR;
    G_WAIT_V(4); G_BAR;
    G_STAGE(G_SB(1, 0), cB + pb.bK(1), voffB); G_STAGE(G_SA(1, 0), cA + pb.aK(1), voffA); G_STAGE(G_SB(1, 1), cB + hsB + pb.bK(1), voffB);
    G_WAIT_V(6); G_BAR;
    for (;;) {
        const long Ln = (long)(ui + 1) * G + c; const bool has_next = Ln < nun;
        if (has_next) pb.unit(Ln, nxt);
        const char* nA = has_next ? nxt.a : cA; const char* nB = has_next ? nxt.b : cB;
        for (int t = 0; t < nt; t += 2) {
            const bool last = (t == nt - 2);
            const char* a1 = cA + pb.aK(t + 1);
            const char* a2 = last ? nA + pb.aK(0) : cA + pb.aK(t + 2); const char* b2 = last ? nB + pb.bK(0) : cB + pb.bK(t + 2);
            const char* a3 = last ? nA + pb.aK(1) : cA + pb.aK(t + 3); const char* b3 = last ? nB + pb.bK(1) : cB + pb.bK(t + 3);
            G_LDB(B0, 0, 0); G_SCHED; G_LDA(At, 0, 0); G_STAGE(G_SA(1, 1), a1 + hsA, voffA);
            G_WAIT_L(8); G_BAR; G_WAIT_L(0); G_MMA(0, 0, At, B0); G_BAR; G_SCHED;
            G_LDB(B1, 0, 1); G_STAGE(G_SB(0, 0), b2, voffB);
            G_BAR; G_WAIT_L(0); G_MMA(0, 1, At, B1); G_BAR;
            G_LDA(At, 0, 1); G_STAGE(G_SA(0, 0), a2, voffA);
            G_BAR; G_WAIT_L(0); G_MMA(1, 0, At, B0); G_BAR; G_SCHED;
            G_STAGE(G_SB(0, 1), b2 + hsB, voffB);
            G_WAIT_V(6); G_BAR; G_MMA(1, 1, At, B1); G_BAR;
            G_LDB(B0, 1, 0); G_SCHED; G_LDA(At, 1, 0); G_STAGE(G_SA(0, 1), a2 + hsA, voffA);
            G_WAIT_L(8); G_BAR; G_WAIT_L(0); G_MMA(0, 0, At, B0); G_BAR; G_SCHED;
            G_LDB(B1, 1, 1); G_STAGE(G_SB(1, 0), b3, voffB);
            G_BAR; G_WAIT_L(0); G_MMA(0, 1, At, B1); G_BAR;
            G_LDA(At, 1, 1); G_STAGE(G_SA(1, 0), a3, voffA);
            G_BAR; G_WAIT_L(0); G_MMA(1, 0, At, B0); G_BAR; G_SCHED;
            G_STAGE(G_SB(1, 1), b3 + hsB, voffB);
            G_WAIT_V(6); G_BAR; G_MMA(1, 1, At, B1); G_BAR;
        }
        { const int l2 = ltid() & 63; pb.epi(acc, cur, wr, wc, l2 & 15, l2 >> 4); }
        if (!has_next) break;
#pragma unroll
        for (int a = 0; a < 2; ++a)
#pragma unroll
            for (int b = 0; b < 2; ++b)
#pragma unroll
                for (int m = 0; m < 4; ++m)
#pragma unroll
                    for (int n = 0; n < 2; ++n) acc[a][b][m][n] = (f32x4){0.f, 0.f, 0.f, 0.f};
        cur = nxt; cA = nA; cB = nB; ++ui;
    }
    G_WAIT_V(0);
    if (wr == 0) G_BAR;
    G_BAR;
}

#define EPI_ROWS for (int ai = 0; ai < 2; ++ai) for (int m = 0; m < 4; ++m)
#define EPI_COLS for (int bj = 0; bj < 2; ++bj) for (int n = 0; n < 2; ++n)
#define EPI_ROW (128 * ai + 64 * wr + 16 * m + fr)
#define EPI_COL (128 * bj + 32 * wc + 16 * n + 4 * fq)

template <class Epi> struct Prob2D {
    const char* A; const char* B; unsigned lda, ldb; int nt, nM, nN; Epi e;
    __device__ __forceinline__ long nunits() const { return (long)nM * nN; }
    __device__ __forceinline__ unsigned rowA(int R) const { return (unsigned)R * lda; }
    __device__ __forceinline__ void unit(long L, UInfo& u) const { int pm, pn; tile_order((int)L, nM, nN, pm, pn); u.a = A + (size_t)pm * 256 * lda; u.b = B + (size_t)pn * 256 * ldb; u.r0 = pm * 256; u.c0 = pn * 256; u.x0 = 0; u.x1 = 0; }
    __device__ __forceinline__ size_t aK(int kt) const { return (size_t)kt * 128; }
    __device__ __forceinline__ size_t bK(int kt) const { return (size_t)kt * 128; }
    __device__ __forceinline__ void epi(const AccT& acc, const UInfo& u, int wr, int wc, int fr, int fq) const { e(acc, u, wr, wc, fr, fq); }
};
struct EpiStore { bf16_t* O; size_t ldc;
    __device__ __forceinline__ void operator()(const AccT& acc, const UInfo& u, int wr, int wc, int fr, int fq) const {
#pragma unroll
        EPI_ROWS { bf16_t* rp = O + (size_t)(u.r0 + EPI_ROW) * ldc + u.c0;
#pragma unroll
            EPI_COLS { const f32x4 v = acc[ai][bj][m][n]; *(u32x2*)(rp + EPI_COL) = (u32x2){pk_bf16(v[0], v[1]), pk_bf16(v[2], v[3])}; } }
    } };
struct EpiRes { const float* R; float* O;
    __device__ __forceinline__ void operator()(const AccT& acc, const UInfo& u, int wr, int wc, int fr, int fq) const {
#pragma unroll
        EPI_ROWS { const size_t ro = (size_t)(u.r0 + EPI_ROW) * 2048 + u.c0;
#pragma unroll
            EPI_COLS { const f32x4 r = *(const f32x4*)(R + ro + EPI_COL); *(f32x4*)(O + ro + EPI_COL) = r + acc[ai][bj][m][n]; } }
    } };
struct EpiGate { bf16_t* Y;
    __device__ __forceinline__ void operator()(const AccT& acc, const UInfo& u, int wr, int wc, int fr, int fq) const {
#pragma unroll
        EPI_ROWS { bf16_t* rp = Y + (size_t)(u.r0 + EPI_ROW) * 4096 + u.c0;
#pragma unroll
            EPI_COLS { const f32x4 g = acc[ai][bj][m][n]; const u32x2 y = *(const u32x2*)(rp + EPI_COL);
                const float o0 = g[0] * sigmoidf_(g[0]) * bflo(y[0]), o1 = g[1] * sigmoidf_(g[1]) * bfhi(y[0]), o2 = g[2] * sigmoidf_(g[2]) * bflo(y[1]), o3 = g[3] * sigmoidf_(g[3]) * bfhi(y[1]);
                *(u32x2*)(rp + EPI_COL) = (u32x2){pk_bf16(o0, o1), pk_bf16(o2, o3)}; } }
    } };
struct EpiQK { bf16_t* Q; bf16_t* K; bf16_t* KTD; const float2* rope;
    __device__ __forceinline__ void operator()(const AccT& acc, const UInfo& u, int wr, int wc, int fr, int fq) const {
        const int hidx = u.c0 >> 8; const bool isk = hidx >= 8; const int hh = hidx & 7; const float l2g = log2gamma(hh);
        bf16_t* dst = (isk ? K : Q) + hh * 256; const float sc = isk ? 0.0625f : 1.0f;
#pragma unroll
        EPI_ROWS { const int t = u.r0 + EPI_ROW; const float kd = fexp2((float)(255 - (t & 255)) * l2g);
#pragma unroll
            for (int n = 0; n < 2; ++n) { const int dd = 32 * wc + 16 * n + 4 * fq;
                const f32x4 x1 = acc[ai][0][m][n], x2 = acc[ai][1][m][n]; const f32x4 cs0 = *(const f32x4*)(rope + (size_t)t * 128 + dd), cs1 = *(const f32x4*)(rope + (size_t)t * 128 + dd + 2);
                float y1[4], y2[4];
                y1[0] = (x1[0] * cs0[0] - x2[0] * cs0[1]) * sc; y2[0] = (x1[0] * cs0[1] + x2[0] * cs0[0]) * sc;
                y1[1] = (x1[1] * cs0[2] - x2[1] * cs0[3]) * sc; y2[1] = (x1[1] * cs0[3] + x2[1] * cs0[2]) * sc;
                y1[2] = (x1[2] * cs1[0] - x2[2] * cs1[1]) * sc; y2[2] = (x1[2] * cs1[1] + x2[2] * cs1[0]) * sc;
                y1[3] = (x1[3] * cs1[2] - x2[3] * cs1[3]) * sc; y2[3] = (x1[3] * cs1[3] + x2[3] * cs1[2]) * sc;
                *(u32x2*)(dst + (size_t)t * 2048 + dd) = (u32x2){pk_bf16(y1[0], y1[1]), pk_bf16(y1[2], y1[3])};
                *(u32x2*)(dst + (size_t)t * 2048 + 128 + dd) = (u32x2){pk_bf16(y2[0], y2[1]), pk_bf16(y2[2], y2[3])};
                if (isk) {
#pragma unroll
                    for (int j = 0; j < 4; ++j) { KTD[(size_t)(hh * 256 + dd + j) * S_ + t] = (bf16_t)(pk_bf16(y1[j] * kd, 0.f) & 0xffffu); KTD[(size_t)(hh * 256 + 128 + dd + j) * S_ + t] = (bf16_t)(pk_bf16(y2[j] * kd, 0.f) & 0xffffu); }
                } } }
    } };
struct EpiQproj { bf16_t* QB; float* gates;
    __device__ __forceinline__ void operator()(const AccT& acc, const UInfo& u, int wr, int wc, int fr, int fq) const {
#pragma unroll
        EPI_ROWS { const int t = u.r0 + EPI_ROW;
#pragma unroll
            EPI_COLS { const int col = u.c0 + EPI_COL; const f32x4 v = acc[ai][bj][m][n];
                if (col < 2048) *(u32x2*)(QB + (size_t)t * 2048 + col) = (u32x2){pk_bf16(v[0] * 0.08838834764831845f, v[1] * 0.08838834764831845f), pk_bf16(v[2] * 0.08838834764831845f, v[3] * 0.08838834764831845f)};
                else if (col < 2096) *(f32x4*)(gates + (size_t)t * 48 + (col - 2048)) = (f32x4){sigmoidf_(v[0]), sigmoidf_(v[1]), sigmoidf_(v[2]), sigmoidf_(v[3])}; } }
    } };
__device__ __forceinline__ float gelu_tanh(float x) { const float y = 0.7978845608028654f * (x + 0.044715f * x * x * x); const float e = fexp2(2.0f * 1.4426950408889634f * y); const float th = 1.0f - 2.0f * frcp(e + 1.0f); return 0.5f * x * (1.0f + th); }
struct EpiGelu { bf16_t* H; const float* bias;
    __device__ __forceinline__ void operator()(const AccT& acc, const UInfo& u, int wr, int wc, int fr, int fq) const {
#pragma unroll
        EPI_ROWS { bf16_t* rp = H + (size_t)(u.r0 + EPI_ROW) * 256;
#pragma unroll
            EPI_COLS { const int col = EPI_COL; const f32x4 v = acc[ai][bj][m][n]; const f32x4 bb = *(const f32x4*)(bias + col);
                *(u32x2*)(rp + col) = (u32x2){pk_bf16(gelu_tanh(v[0] + bb[0]), gelu_tanh(v[1] + bb[1])), pk_bf16(gelu_tanh(v[2] + bb[2]), gelu_tanh(v[3] + bb[3]))}; } }
    } };
struct EpiKcmp { bf16_t* KC;
    __device__ __forceinline__ void operator()(const AccT& acc, const UInfo& u, int wr, int wc, int fr, int fq) const {
#pragma unroll
        EPI_ROWS { const int r = u.r0 + EPI_ROW, i = r >> 2, h = r & 3;
#pragma unroll
            for (int n = 0; n < 2; ++n) { const int col = 32 * wc + 16 * n + 4 * fq; f32x4 v = acc[ai][0][m][n]; if (i == 1023) v = (f32x4){0.f, 0.f, 0.f, 0.f};
                *(u32x2*)(KC + ((size_t)h * 1024 + i) * 128 + col) = (u32x2){pk_bf16(v[0], v[1]), pk_bf16(v[2], v[3])}; } }
    } };
struct EpiVcmp { bf16_t* VC;
    __device__ __forceinline__ void operator()(const AccT& acc, const UInfo& u, int wr, int wc, int fr, int fq) const {
#pragma unroll
        for (int m = 0; m < 4; ++m) { const int d = 64 * wr + 16 * m + fr;
#pragma unroll
            EPI_COLS { const int col = u.c0 + EPI_COL, i = col >> 2; f32x4 v = acc[0][bj][m][n]; if (i == 1023) v = (f32x4){0.f, 0.f, 0.f, 0.f};
#pragma unroll
                for (int h = 0; h < 4; ++h) VC[((size_t)h * 128 + d) * 1024 + i] = (bf16_t)(pk_bf16(v[h], 0.f) & 0xffffu); } }
    } };
struct ProbCmp1 {
    const char* A; const char* B; unsigned ldb; int nt, nM; EpiGelu e;
    __device__ __forceinline__ long nunits() const { return nM; }
    __device__ __forceinline__ unsigned rowA(int R) const { return (unsigned)(R >> 2) * 65536u + (unsigned)(R & 3) * 256u; }
    __device__ __forceinline__ void unit(long L, UInfo& u) const { u.a = A + (size_t)L * 64 * 65536; u.b = B; u.r0 = (int)L * 256; u.c0 = 0; u.x0 = 0; u.x1 = 0; }
    __device__ __forceinline__ size_t aK(int kt) const { return (size_t)(kt >> 1) * 4096 + (size_t)(kt & 1) * 128; }
    __device__ __forceinline__ size_t bK(int kt) const { return (size_t)kt * 128; }
    __device__ __forceinline__ void epi(const AccT& acc, const UInfo& u, int wr, int wc, int fr, int fq) const { e(acc, u, wr, wc, fr, fq); }
};
struct ProbKV {
    const char* VT; const char* KTD; bf16_t* ST; int nt;
    __device__ __forceinline__ long nunits() const { return 8 * 64 * 2; }
    __device__ __forceinline__ unsigned rowA(int R) const { return (unsigned)R * 32768u; }
    static constexpr unsigned ldb = 32768u;
    __device__ __forceinline__ void unit(long L, UInfo& u) const { const int pm = (int)L & 1, c = ((int)L >> 1) & 63, h = (int)L >> 7;
        u.a = VT + ((size_t)(h * 512 + pm * 256) * S_ + c * 256) * 2; u.b = KTD + ((size_t)(h * 256) * S_ + c * 256) * 2; u.r0 = h * 512 + pm * 256; u.c0 = c * 256; u.x0 = 0; u.x1 = 0; }
    __device__ __forceinline__ size_t aK(int kt) const { return (size_t)kt * 128; }
    __device__ __forceinline__ size_t bK(int kt) const { return (size_t)kt * 128; }
    __device__ __forceinline__ void epi(const AccT& acc, const UInfo& u, int wr, int wc, int fr, int fq) const { EpiStore e{ST, (size_t)S_}; e(acc, u, wr, wc, fr, fq); }
};
struct ProbS {
    const char* Q; const char* K; bf16_t* SD; int nt;
    __device__ __forceinline__ long nunits() const { return 8 * 64; }
    __device__ __forceinline__ unsigned rowA(int R) const { return (unsigned)R * 4096u; }
    static constexpr unsigned ldb = 4096u;
    __device__ __forceinline__ void unit(long L, UInfo& u) const { const int c = (int)L & 63, h = (int)L >> 6; const size_t o = ((size_t)(c * 256) * 2048 + h * 256) * 2;
        u.a = Q + o; u.b = K + o; u.r0 = c * 256; u.c0 = h * 256; u.x0 = h; u.x1 = 0; }
    __device__ __forceinline__ size_t aK(int kt) const { return (size_t)kt * 128; }
    __device__ __forceinline__ size_t bK(int kt) const { return (size_t)kt * 128; }
    __device__ __forceinline__ void epi(const AccT& acc, const UInfo& u, int wr, int wc, int fr, int fq) const {
        const float l2g = log2gamma(u.x0);
#pragma unroll
        EPI_ROWS { const int i = EPI_ROW; bf16_t* rp = SD + (size_t)(u.r0 + i) * 2048 + u.c0;
#pragma unroll
            EPI_COLS { const int s = EPI_COL; const f32x4 v = acc[ai][bj][m][n]; float o[4];
#pragma unroll
                for (int j = 0; j < 4; ++j) o[j] = (s + j <= i) ? v[j] * fexp2(-(float)(s + j + 1) * l2g) : 0.f;
                *(u32x2*)(rp + s) = (u32x2){pk_bf16(o[0], o[1]), pk_bf16(o[2], o[3])}; } }
    }
};
struct ProbOut {
    const char* Q; const char* ST; long dA, dB; bf16_t* Y; int nt;
    __device__ __forceinline__ long nunits() const { return 8 * 64 * 2; }
    __device__ __forceinline__ unsigned rowA(int R) const { return (unsigned)R * 4096u; }
    static constexpr unsigned ldb = 32768u;
    __device__ __forceinline__ void unit(long L, UInfo& u) const { const int pn = (int)L & 1, c = ((int)L >> 1) & 63, h = (int)L >> 7;
        u.a = Q + ((size_t)(c * 256) * 2048 + h * 256) * 2; u.b = ST + ((size_t)(h * 512 + pn * 256) * S_ + c * 256) * 2; u.r0 = c * 256; u.c0 = h * 512 + pn * 256; u.x0 = h; u.x1 = 0; }
    __device__ __forceinline__ size_t aK(int kt) const { return kt < 4 ? (size_t)kt * 128 : (size_t)(dA + (long)(kt - 4) * 128); }
    __device__ __forceinline__ size_t bK(int kt) const { return kt < 4 ? (size_t)kt * 128 : (size_t)(dB + (long)(kt - 4) * 128); }
    __device__ __forceinline__ void epi(const AccT& acc, const UInfo& u, int wr, int wc, int fr, int fq) const {
        const float l2g = log2gamma(u.x0);
#pragma unroll
        EPI_ROWS { const int i = EPI_ROW; const float qd = fexp2((float)(i + 1) * l2g); bf16_t* rp = Y + (size_t)(u.r0 + i) * 4096 + u.c0;
#pragma unroll
            EPI_COLS { const f32x4 v = acc[ai][bj][m][n] * qd; *(u32x2*)(rp + EPI_COL) = (u32x2){pk_bf16(v[0], v[1]), pk_bf16(v[2], v[3])}; } }
    }
};

__device__ __forceinline__ float shx(float v, int m, int lane) { return __int_as_float(__builtin_amdgcn_ds_bpermute((lane ^ m) << 2, __float_as_int(v))); }
__device__ __forceinline__ unsigned long long shx64(unsigned long long v, int m, int lane) {
    const unsigned lo = (unsigned)__builtin_amdgcn_ds_bpermute((lane ^ m) << 2, (int)(unsigned)v), hi = (unsigned)__builtin_amdgcn_ds_bpermute((lane ^ m) << 2, (int)(unsigned)(v >> 32));
    return ((unsigned long long)hi << 32) | lo; }
__device__ __forceinline__ float wave_sum(float v, int lane) {
#pragma unroll
    for (int o = 32; o >= 1; o >>= 1) v += shx(v, o, lane);
    return v;
}
__device__ __forceinline__ void transpose_job(const float* __restrict__ src, bf16_t* __restrict__ dst, int K, int N, int Npad, int kvperm, LAS float* tile) {
    const int tk = K / 64, tn = Npad / 64, ntile = tk * tn; const int tid = ltid();
    for (int t = blockIdx.x; t < ntile; t += gridDim.x) {
        const int k0 = (t % tk) * 64, n0 = (t / tk) * 64;
        { const int r0 = tid >> 6, cc = tid & 63;
#pragma unroll
          for (int i = 0; i < 8; ++i) { const int r = r0 + 8 * i, n = n0 + cc; tile[r * 65 + cc] = (n < N) ? src[(size_t)(k0 + r) * N + n] : 0.f; } }
        __syncthreads();
        { const int rr = tid >> 3, cc = (tid & 7) * 8; float v[8];
#pragma unroll
          for (int j = 0; j < 8; ++j) v[j] = tile[(cc + j) * 65 + rr];
          int n = n0 + rr; if (kvperm) { const int j = n >> 9; const int jp = (j == 3) ? 4 : ((j == 4) ? 3 : j); n = jp * 512 + (n & 511); }
          *(u32x4*)(dst + (size_t)n * K + k0 + cc) = (u32x4){pk_bf16(v[0], v[1]), pk_bf16(v[2], v[3]), pk_bf16(v[4], v[5]), pk_bf16(v[6], v[7])}; }
        __syncthreads();
    }
}
__device__ __forceinline__ void prep_phase(CP p, LAS unsigned char* lds) {
    LAS float* tile = (LAS float*)lds; unsigned char* ws = p->ws;
    transpose_job(p->ret_w_in, (bf16_t*)(ws + OFF_W_RIN), 2048, 12288, 12288, 0, tile);
    transpose_job(p->ret_w_out, (bf16_t*)(ws + OFF_W_ROUT), 4096, 2048, 2048, 0, tile);
    transpose_job(p->w_kv, (bf16_t*)(ws + OFF_W_KV), 2048, 3072, 3072, 1, tile);
    transpose_job(p->w1_k, (bf16_t*)(ws + OFF_W_C1K), 4096, 256, 256, 0, tile);
    transpose_job(p->w1_v, (bf16_t*)(ws + OFF_W_C1V), 4096, 256, 256, 0, tile);
    transpose_job(p->w2_k, (bf16_t*)(ws + OFF_W_C2K), 256, 128, 256, 0, tile);
    transpose_job(p->w2_v, (bf16_t*)(ws + OFF_W_C2V), 256, 128, 256, 0, tile);
    transpose_job(p->w_q, (bf16_t*)(ws + OFF_W_Q), 2048, 2096, 2304, 0, tile);
    transpose_job(p->w_o, (bf16_t*)(ws + OFF_W_O), 2048, 2048, 2048, 0, tile);
    transpose_job(p->ffn_w_in, (bf16_t*)(ws + OFF_W_FIN), 2048, 8192, 8192, 0, tile);
    transpose_job(p->ffn_w_in + (size_t)2048 * 8192, (bf16_t*)(ws + OFF_W_FIN + 32 * MiB), 2048, 8192, 8192, 0, tile);
    transpose_job(p->ffn_w_out, (bf16_t*)(ws + OFF_W_FOUT), 4096, 2048, 2048, 0, tile);
    transpose_job(p->ffn_w_out + (size_t)4096 * 2048, (bf16_t*)(ws + OFF_W_FOUT + 16 * MiB), 4096, 2048, 2048, 0, tile);
    { float2* rope = (float2*)(ws + OFF_ROPE); const int gsz = gridDim.x * 512;
      for (int i = blockIdx.x * 512 + ltid(); i < S_ * 128; i += gsz) { const int t = i >> 7, dd = i & 127;
          const float freq = exp2f(-(float)dd * (13.287712379549449f / 128.0f)); const double rev = (double)t * (double)freq * 0.15915494309189535;
          const float fx = (float)(rev - rint(rev)); rope[i] = make_float2(__builtin_amdgcn_cosf(fx), __builtin_amdgcn_sinf(fx)); } }
    if (blockIdx.x < 2) { const float* pe = blockIdx.x ? p->pe_v : p->pe_k; const float* w1 = blockIdx.x ? p->w1_v : p->w1_k; float* peb = (float*)(ws + OFF_PEB) + blockIdx.x * 256;
        const int n = ltid() & 255, half = ltid() >> 8; float s = 0.f;
        for (int k = half * 2048; k < half * 2048 + 2048; ++k) s += pe[k] * w1[(size_t)k * 256 + n];
        __syncthreads(); tile[ltid()] = s; __syncthreads();
        if (ltid() < 256) peb[n] = tile[ltid()] + tile[ltid() + 256];
        __syncthreads(); }
}
__device__ __forceinline__ void rmsnorm_phase(const float* h, const float* g1, bf16_t* o1, const float* g2, bf16_t* o2) {
    const int w = ltid() >> 6, lane = ltid() & 63;
    for (int row = blockIdx.x * 8 + w; row < S_; row += gridDim.x * 8) {
        const f32x4* p = (const f32x4*)(h + (size_t)row * 2048); f32x4 v[8]; float ss = 0.f;
#pragma unroll
        for (int i = 0; i < 8; ++i) { v[i] = p[lane + 64 * i]; ss += v[i][0] * v[i][0] + v[i][1] * v[i][1] + v[i][2] * v[i][2] + v[i][3] * v[i][3]; }
        ss = wave_sum(ss, lane); const float r = rsqrtf(ss * (1.0f / 2048.0f) + 1e-6f);
#pragma unroll
        for (int i = 0; i < 8; ++i) { const int col = (lane + 64 * i) * 4; const f32x4 g = *(const f32x4*)(g1 + col);
            *(u32x2*)(o1 + (size_t)row * 2048 + col) = (u32x2){pk_bf16(v[i][0] * r * g[0], v[i][1] * r * g[1]), pk_bf16(v[i][2] * r * g[2], v[i][3] * r * g[3])};
            if (o2) { const f32x4 gg = *(const f32x4*)(g2 + col);
                *(u32x2*)(o2 + (size_t)row * 2048 + col) = (u32x2){pk_bf16(v[i][0] * r * gg[0], v[i][1] * r * gg[1]), pk_bf16(v[i][2] * r * gg[2], v[i][3] * r * gg[3])}; } }
    }
}
__device__ __forceinline__ void finalnorm_phase(float* h, const float* g1) {
    const int w = ltid() >> 6, lane = ltid() & 63;
    for (int row = blockIdx.x * 8 + w; row < S_; row += gridDim.x * 8) {
        f32x4* p = (f32x4*)(h + (size_t)row * 2048); f32x4 v[8]; float ss = 0.f;
#pragma unroll
        for (int i = 0; i < 8; ++i) { v[i] = p[lane + 64 * i]; ss += v[i][0] * v[i][0] + v[i][1] * v[i][1] + v[i][2] * v[i][2] + v[i][3] * v[i][3]; }
        ss = wave_sum(ss, lane); const float r = rsqrtf(ss * (1.0f / 2048.0f) + 1e-6f);
#pragma unroll
        for (int i = 0; i < 8; ++i) { const f32x4 g = *(const f32x4*)(g1 + (lane + 64 * i) * 4); p[lane + 64 * i] = v[i] * r * g; }
    }
}
__device__ __forceinline__ void scan_phase(bf16_t* ST) {
    for (int it = blockIdx.x * 512 + ltid(); it < 4096 * 32; it += gridDim.x * 512) {
        const int r = it >> 5, d8 = it & 31; const float cd = fexp2(256.0f * log2gamma(r >> 9));
        bf16_t* p = ST + (size_t)r * S_ + d8 * 8; float s[8];
#pragma unroll
        for (int j = 0; j < 8; ++j) s[j] = 0.f;
        for (int c = 0; c < 64; ++c) { const u32x4 v = *(const u32x4*)(p + c * 256);
            *(u32x4*)(p + c * 256) = (u32x4){pk_bf16(s[0], s[1]), pk_bf16(s[2], s[3]), pk_bf16(s[4], s[5]), pk_bf16(s[6], s[7])};
#pragma unroll
            for (int j = 0; j < 4; ++j) { s[2 * j] = s[2 * j] * cd + bflo(v[j]); s[2 * j + 1] = s[2 * j + 1] * cd + bfhi(v[j]); } }
    }
}
__device__ __forceinline__ void gn_phase(bf16_t* Y, const float* gain) {
    const int w = ltid() >> 6, lane = ltid() & 63;
    for (int g = blockIdx.x * 8 + w; g < S_ * 8; g += gridDim.x * 8) {
        bf16_t* p = Y + (size_t)g * 512 + lane * 8; const u32x4 v = *(const u32x4*)p; float x[8];
#pragma unroll
        for (int j = 0; j < 4; ++j) { x[2 * j] = bflo(v[j]); x[2 * j + 1] = bfhi(v[j]); }
        float s = 0.f;
#pragma unroll
        for (int j = 0; j < 8; ++j) s += x[j];
        const float mu = wave_sum(s, lane) * (1.0f / 512.0f); float q = 0.f;
#pragma unroll
        for (int j = 0; j < 8; ++j) { x[j] -= mu; q += x[j] * x[j]; }
        const float r = rsqrtf(wave_sum(q, lane) * (1.0f / 512.0f) + 1e-6f); const float* gp = gain + (g & 7) * 512 + lane * 8;
        const f32x4 g0 = *(const f32x4*)gp, g1 = *(const f32x4*)(gp + 4);
        *(u32x4*)p = (u32x4){pk_bf16(x[0] * r * g0[0], x[1] * r * g0[1]), pk_bf16(x[2] * r * g0[2], x[3] * r * g0[3]), pk_bf16(x[4] * r * g1[0], x[5] * r * g1[1]), pk_bf16(x[6] * r * g1[2], x[7] * r * g1[3])};
    }
}
__device__ __forceinline__ void conv_phase(const bf16_t* U, bf16_t* AB, const float* cw, const float* cb) {
    for (int it = blockIdx.x * 512 + ltid(); it < 2048 * 512; it += gridDim.x * 512) {
        const int n8 = (it & 511) * 8, t0 = (it >> 9) * 8;
        float wa[3][8], wb[3][8], ba[8], bb[8];
#pragma unroll
        for (int tp = 0; tp < 3; ++tp)
#pragma unroll
            for (int j = 0; j < 8; ++j) { wa[tp][j] = cw[tp * 8192 + n8 + j]; wb[tp][j] = cw[tp * 8192 + 4096 + n8 + j]; }
#pragma unroll
        for (int j = 0; j < 8; ++j) { ba[j] = cb[n8 + j]; bb[j] = cb[4096 + n8 + j]; }
        float pa[2][8], pb[2][8];
#pragma unroll
        for (int k = 0; k < 2; ++k) { const int t = t0 - 2 + k; u32x4 va = (u32x4){0, 0, 0, 0}, vb = (u32x4){0, 0, 0, 0};
            if (t >= 0) { va = *(const u32x4*)(U + (size_t)t * 8192 + n8); vb = *(const u32x4*)(U + (size_t)t * 8192 + 4096 + n8); }
#pragma unroll
            for (int j = 0; j < 4; ++j) { pa[k][2 * j] = bflo(va[j]); pa[k][2 * j + 1] = bfhi(va[j]); pb[k][2 * j] = bflo(vb[j]); pb[k][2 * j + 1] = bfhi(vb[j]); } }
#pragma unroll
        for (int k = 0; k < 8; ++k) { const int t = t0 + k; const u32x4 va = *(const u32x4*)(U + (size_t)t * 8192 + n8), vb = *(const u32x4*)(U + (size_t)t * 8192 + 4096 + n8);
            float xa[8], xb[8], o[8];
#pragma unroll
            for (int j = 0; j < 4; ++j) { xa[2 * j] = bflo(va[j]); xa[2 * j + 1] = bfhi(va[j]); xb[2 * j] = bflo(vb[j]); xb[2 * j + 1] = bfhi(vb[j]); }
#pragma unroll
            for (int j = 0; j < 8; ++j) { const float a = ba[j] + wa[0][j] * pa[0][j] + wa[1][j] * pa[1][j] + wa[2][j] * xa[j]; const float b = bb[j] + wb[0][j] * pb[0][j] + wb[1][j] * pb[1][j] + wb[2][j] * xb[j];
                o[j] = a * sigmoidf_(a) * b; pa[0][j] = pa[1][j]; pa[1][j] = xa[j]; pb[0][j] = pb[1][j]; pb[1][j] = xb[j]; }
            *(u32x4*)(AB + (size_t)t * 4096 + n8) = (u32x4){pk_bf16(o[0], o[1]), pk_bf16(o[2], o[3]), pk_bf16(o[4], o[5]), pk_bf16(o[6], o[7])}; }
    }
}

constexpr int A_KT = 0, A_VT = 17408, A_BUFSZ = 34816, A_PSL = 69632, A_SEL = 69632 + 65536, LDS_ST = 139264;
constexpr float LOG2E = 1.4426950408889634f;
struct AttnState { f32x4 ot[8][2]; float m[2], l[2]; };

template <int MODE>
__device__ __forceinline__ void attn_compute(LAS unsigned char* lds, int boff, int tile, const bf16x8 (&qf)[2][4], AttnState& st, const int (&tpos)[2], int qb, int w, int lane,
                                             const float (&mfin)[2], const float (&linv)[2], bool rs0, bool rs1, bool masked) {
    const int l16 = lane & 15, g4 = lane >> 4;
    f32x4 s[4][2];
#pragma unroll
    for (int mt = 0; mt < 4; ++mt) { s[mt][0] = (f32x4){0.f, 0.f, 0.f, 0.f}; s[mt][1] = (f32x4){0.f, 0.f, 0.f, 0.f}; }
#pragma unroll
    for (int ks = 0; ks < 4; ++ks)
#pragma unroll
        for (int mt = 0; mt < 4; ++mt) { const bf16x8 kf = *(const LAS bf16x8*)(lds + boff + A_KT + (16 * mt + l16) * 272 + ks * 64 + g4 * 16);
            s[mt][0] = __builtin_amdgcn_mfma_f32_16x16x32_bf16(kf, qf[0][ks], s[mt][0], 0, 0, 0);
            s[mt][1] = __builtin_amdgcn_mfma_f32_16x16x32_bf16(kf, qf[1][ks], s[mt][1], 0, 0, 0);
            if (mt == 3 && (ks & 1)) __builtin_amdgcn_sched_barrier(0); }
    if (masked) {
#pragma unroll
        for (int nt = 0; nt < 2; ++nt) { const int t = tpos[nt]; const int tl = w * 8 + nt * 4 + (l16 >> 2);
#pragma unroll
            for (int mt = 0; mt < 4; ++mt)
#pragma unroll
                for (int j = 0; j < 4; ++j) { const int kl = 16 * mt + 4 * g4 + j; const int key = tile * 64 + kl; bool v;
                    if (MODE == 0 || MODE == 1) v = key <= ((t - 31) >> 4);
                    else if (MODE == 2) v = (kl <= tl);
                    else v = (key <= t) && (key > t - 512);
                    s[mt][nt][j] = v ? s[mt][nt][j] : -__builtin_inff(); } }
    }
    bf16x8 pf[2][2];
#pragma unroll
    for (int nt = 0; nt < 2; ++nt) {
        const bool rowsel = nt ? rs1 : rs0;
        const float bias = (MODE == 2 && !rowsel) ? -__builtin_inff() : 0.f;
        float mx = -1e30f;
#pragma unroll
        for (int mt = 0; mt < 4; ++mt)
#pragma unroll
            for (int j = 0; j < 4; ++j) {
                const float sv = s[mt][nt][j] * LOG2E + bias;
                s[mt][nt][j] = sv; mx = fmaxf(mx, sv); }
        float mnew, alpha = 1.f;
        if (MODE == 1) mnew = mfin[nt];
        else { mx = fmaxf(mx, shx(mx, 16, lane)); mx = fmaxf(mx, shx(mx, 32, lane)); mnew = fmaxf(st.m[nt], mx); alpha = fexp2(st.m[nt] - mnew); st.m[nt] = mnew; }
        float ps = 0.f;
#pragma unroll
        for (int mt = 0; mt < 4; ++mt)
#pragma unroll
            for (int j = 0; j < 4; ++j) { float pv = fexp2(s[mt][nt][j] - mnew); if (MODE == 1) pv *= linv[nt]; s[mt][nt][j] = pv; ps += pv; }
        if (MODE != 1) st.l[nt] = st.l[nt] * alpha + ps;
        if (MODE == 2 || MODE == 3) {
#pragma unroll
            for (int md = 0; md < 8; ++md) st.ot[md][nt] = st.ot[md][nt] * alpha;
        }
        if (MODE == 1) {
#pragma unroll
            for (int mt = 0; mt < 4; ++mt) { float a = s[mt][nt][0] + s[mt][nt][1] + s[mt][nt][2] + s[mt][nt][3], lst = s[mt][nt][3];
                a += shx(a, 1, lane); a += shx(a, 2, lane); lst += shx(lst, 1, lane); lst += shx(lst, 2, lane);
                if ((l16 & 3) == 0) { const int jb = tile * 16 + 4 * mt + g4; LAS float* pp = (LAS float*)(lds + A_PSL) + (w * 8 + nt * 4 + (l16 >> 2)) * 256;
                    atomicAdd((float*)(pp + jb), a); if (jb + 1 < 256) atomicAdd((float*)(pp + jb + 1), lst); } }
        }
        if (MODE != 0) {
#pragma unroll
            for (int kk = 0; kk < 2; ++kk) { const u32x4 pk = (u32x4){pk_bf16(s[2 * kk][nt][0], s[2 * kk][nt][1]), pk_bf16(s[2 * kk][nt][2], s[2 * kk][nt][3]), pk_bf16(s[2 * kk + 1][nt][0], s[2 * kk + 1][nt][1]), pk_bf16(s[2 * kk + 1][nt][2], s[2 * kk + 1][nt][3])};
                pf[nt][kk] = __builtin_bit_cast(bf16x8, pk); }
        }
    }
    if (MODE != 0) {
#pragma unroll
        for (int kk = 0; kk < 2; ++kk)
#pragma unroll
            for (int md = 0; md < 8; ++md) { const LAS unsigned char* vb = lds + boff + A_VT + (16 * md + l16) * 136 + kk * 64 + g4 * 8;
                const u32x2 v0 = *(const LAS u32x2*)vb, v1 = *(const LAS u32x2*)(vb + 32); const bf16x8 vf = __builtin_bit_cast(bf16x8, ((u32x4){v0[0], v0[1], v1[0], v1[1]}));
                st.ot[md][0] = __builtin_amdgcn_mfma_f32_16x16x32_bf16(vf, pf[0][kk], st.ot[md][0], 0, 0, 0);
                st.ot[md][1] = __builtin_amdgcn_mfma_f32_16x16x32_bf16(vf, pf[1][kk], st.ot[md][1], 0, 0, 0);
                if (md == 7) __builtin_amdgcn_sched_barrier(0); }
    }
}
template <int MODE>
__device__ __forceinline__ void attn_tiles(LAS unsigned char* lds, const bf16_t* kp, size_t kstride, const bf16_t* vp, size_t vstride, int tile_lo, int tile_hi,
                                           const bf16x8 (&qf)[2][4], AttnState& st, const int (&tpos)[2], int qb, int w, int lane, const float (&mfin)[2], const float (&linv)[2]) {
    if (tile_lo >= tile_hi) return;
    int tid = w * 64 + lane; asm volatile("" : "+v"(tid)); const int l16 = lane & 15;
    const int krow = tid >> 3, kc = (tid & 7) * 16, vrow = tid >> 2, vc = (tid & 3) * 16;
    u32x4 kr0, kr1, vr0 = (u32x4){0, 0, 0, 0}, vr1 = (u32x4){0, 0, 0, 0};
#define A_LOAD(T) do { const bf16_t* kg = kp + (size_t)((T) * 64 + krow) * kstride + kc; kr0 = *(const u32x4*)kg; kr1 = *(const u32x4*)(kg + 8); \
        if (MODE != 0) { const bf16_t* vg = vp + (size_t)vrow * vstride + (T) * 64 + vc; vr0 = *(const u32x4*)vg; vr1 = *(const u32x4*)(vg + 8); } } while (0)
#define A_WRITE(BO) do { LAS unsigned char* kd = lds + (BO) + A_KT + krow * 272 + kc * 2; *(LAS u32x4*)kd = kr0; *(LAS u32x4*)(kd + 16) = kr1; \
        if (MODE != 0) { LAS unsigned char* vd = lds + (BO) + A_VT + vrow * 136 + vc * 2; *(LAS u32x2*)vd = (u32x2){vr0[0], vr0[1]}; *(LAS u32x2*)(vd + 8) = (u32x2){vr0[2], vr0[3]}; *(LAS u32x2*)(vd + 16) = (u32x2){vr1[0], vr1[1]}; *(LAS u32x2*)(vd + 24) = (u32x2){vr1[2], vr1[3]}; } } while (0)
    A_LOAD(tile_lo);
    __syncthreads();
    A_WRITE(0);
    if (tile_lo + 1 < tile_hi) A_LOAD(tile_lo + 1);
    __syncthreads();
    for (int tile = tile_lo; tile < tile_hi; ++tile) {
        const int boff = ((tile - tile_lo) & 1) * A_BUFSZ;
        if (tile + 1 < tile_hi) { A_WRITE(boff ^ A_BUFSZ); if (tile + 2 < tile_hi) A_LOAD(tile + 2); }
        bool rs0 = true, rs1 = true, active = true;
        if (MODE == 2) { const int tw = tile >> 5; const unsigned bit = 1u << (tile & 31);
            const unsigned w0 = *(const LAS unsigned*)(lds + A_SEL + ((w * 8 + (l16 >> 2)) * 8 + tw) * 4), w1 = *(const LAS unsigned*)(lds + A_SEL + ((w * 8 + 4 + (l16 >> 2)) * 8 + tw) * 4);
            rs0 = (w0 & bit) != 0u; rs1 = (w1 & bit) != 0u; active = __ballot(rs0 || rs1) != 0ull; }
        if (active) {
            bool masked;
            if (MODE == 0 || MODE == 1) masked = (tile * 64 + 63 > 4 * qb - 2);
            else if (MODE == 2) masked = (tile == qb);
            else masked = (tile == qb) || (tile <= qb - 8);
            attn_compute<MODE>(lds, boff, tile, qf, st, tpos, qb, w, lane, mfin, linv, rs0, rs1, masked);
        }
        __syncthreads();
    }
#undef A_LOAD
#undef A_WRITE
}
template <int BR>
__device__ __forceinline__ void attn_finish(AttnState& st, const float* gates, float* oacc, bf16_t* att, const int (&tpos)[2], int hkv, int lane) {
    const int l16 = lane & 15, g4 = lane >> 4, g = l16 & 3;
#pragma unroll
    for (int nt = 0; nt < 2; ++nt) {
        const int t = tpos[nt]; float sc = gates[(size_t)t * 48 + (hkv * 4 + g) * 3 + BR];
        if (BR != 0) { float l = st.l[nt]; l += shx(l, 16, lane); l += shx(l, 32, lane); sc = (l > 0.f) ? sc / l : 0.f; }
        const size_t base = (size_t)t * 2048 + (hkv * 4 + g) * 128 + 4 * g4;
#pragma unroll
        for (int md = 0; md < 8; ++md) { f32x4 v = st.ot[md][nt] * sc; float* op = oacc + base + 16 * md;
            if (BR == 0) *(f32x4*)op = v;
            else if (BR == 1) *(f32x4*)op = *(const f32x4*)op + v;
            else { v = v + *(const f32x4*)op; *(u32x2*)(att + base + 16 * md) = (u32x2){pk_bf16(v[0], v[1]), pk_bf16(v[2], v[3])}; } }
    }
}
__device__ __forceinline__ void attn_reset(AttnState& st) {
#pragma unroll
    for (int md = 0; md < 8; ++md) { st.ot[md][0] = (f32x4){0.f, 0.f, 0.f, 0.f}; st.ot[md][1] = (f32x4){0.f, 0.f, 0.f, 0.f}; }
    st.m[0] = st.m[1] = -1e30f; st.l[0] = st.l[1] = 0.f;
}
__device__ __forceinline__ void attn_item(unsigned char* ws, LAS unsigned char* lds, int hkv, int qb) {
    int tid = ltid(); asm volatile("" : "+v"(tid)); const int w = tid >> 6, lane = tid & 63, l16 = lane & 15, g4 = lane >> 4;
    const bf16_t* QB = (const bf16_t*)(ws + OFF_QB); const bf16_t* KVTOK = (const bf16_t*)(ws + OFF_KVTOK); const bf16_t* KVT = (const bf16_t*)(ws + OFF_KVT);
    const bf16_t* KC = (const bf16_t*)(ws + OFF_KCMP); const bf16_t* VC = (const bf16_t*)(ws + OFF_VCMPT);
    const float* gates = (const float*)(ws + OFF_GATES); float* oacc = (float*)(ws + OFF_OACC); bf16_t* att = (bf16_t*)(ws + OFF_ATT);
    int tpos[2]; bf16x8 qf[2][4];
#pragma unroll
    for (int nt = 0; nt < 2; ++nt) { tpos[nt] = qb * 64 + w * 8 + nt * 4 + (l16 >> 2); const bf16_t* qp = QB + (size_t)tpos[nt] * 2048 + (hkv * 4 + (l16 & 3)) * 128 + g4 * 8;
#pragma unroll
        for (int ks = 0; ks < 4; ++ks) qf[nt][ks] = *(const bf16x8*)(qp + ks * 32); }
    __syncthreads();
    { LAS float* pp = (LAS float*)(lds + A_PSL) + w * 2048;
#pragma unroll
      for (int i = 0; i < 32; ++i) pp[lane + 64 * i] = 0.f; }
    AttnState st; float mfin[2] = {0.f, 0.f}, linv[2] = {0.f, 0.f};
    const int ncmp_tiles = (4 * qb + 3 + 63) >> 6;
    attn_reset(st);
    attn_tiles<0>(lds, KC + (size_t)hkv * 1024 * 128, 128, VC, 1024, 0, ncmp_tiles, qf, st, tpos, qb, w, lane, mfin, linv);
#pragma unroll
    for (int nt = 0; nt < 2; ++nt) { float l = st.l[nt]; l += shx(l, 16, lane); l += shx(l, 32, lane); mfin[nt] = st.m[nt]; linv[nt] = (l > 0.f) ? 1.0f / l : 0.f; }
    attn_reset(st);
    attn_tiles<1>(lds, KC + (size_t)hkv * 1024 * 128, 128, VC + (size_t)hkv * 128 * 1024, 1024, 0, ncmp_tiles, qf, st, tpos, qb, w, lane, mfin, linv);
    attn_finish<0>(st, gates, oacc, att, tpos, hkv, lane);
    __syncthreads();
    {
        LAS unsigned* sel = (LAS unsigned*)(lds + A_SEL) + w * 64;
        if (qb < 16) {
            if (lane < 8) { for (int tk = 0; tk < 8; ++tk) { const int lo = lane * 32; unsigned wd = 0; if (qb >= lo + 31) wd = 0xffffffffu; else if (qb >= lo) wd = (2u << (qb - lo)) - 1u; sel[tk * 8 + lane] = wd; } }
        } else {
            for (int tk = 0; tk < 8; ++tk) {
                const LAS float* pp = (const LAS float*)(lds + A_PSL) + (w * 8 + tk) * 256;
                unsigned long long key[4]; bool taken[4];
#pragma unroll
                for (int i = 0; i < 4; ++i) { const int j = lane + 64 * i; const float sc = pp[j]; const bool elig = (j >= 1) && (j <= qb - 2);
                    taken[i] = (j == 0) || (j == qb) || (j == qb - 1);
                    key[i] = elig ? (((unsigned long long)__float_as_uint(sc) << 32) | (unsigned long long)(0x1000 - j)) : 0ull; }
                for (int r = 0; r < 13; ++r) {
                    unsigned long long best = key[0];
#pragma unroll
                    for (int i = 1; i < 4; ++i) best = key[i] > best ? key[i] : best;
#pragma unroll
                    for (int o = 32; o >= 1; o >>= 1) { const unsigned long long ot = shx64(best, o, lane); best = ot > best ? ot : best; }
#pragma unroll
                    for (int i = 0; i < 4; ++i) if (key[i] == best && best != 0ull) { taken[i] = true; key[i] = 0ull; }
                }
#pragma unroll
                for (int i = 0; i < 4; ++i) { const unsigned long long bal = __ballot(taken[i]); if (lane == 0) { sel[tk * 8 + 2 * i] = (unsigned)bal; sel[tk * 8 + 2 * i + 1] = (unsigned)(bal >> 32); } }
            }
        }
    }
    __syncthreads();
    attn_reset(st);
    attn_tiles<2>(lds, KVTOK + 2 * 512 + hkv * 128, 2048, KVT + (size_t)(hkv * 128) * S_, S_, 0, qb + 1, qf, st, tpos, qb, w, lane, mfin, linv);
    attn_finish<1>(st, gates, oacc, att, tpos, hkv, lane);
    attn_reset(st);
    attn_tiles<3>(lds, KVTOK + 3 * 512 + hkv * 128, 2048, KVT + (size_t)(512 + hkv * 128) * S_, S_, (qb - 8) > 0 ? (qb - 8) : 0, qb + 1, qf, st, tpos, qb, w, lane, mfin, linv);
    attn_finish<2>(st, gates, oacc, att, tpos, hkv, lane);
}
__device__ __forceinline__ void attn_phase(unsigned char* ws, LAS unsigned char* lds) {
#pragma nounroll
    for (int it = blockIdx.x; it < 1024; it += gridDim.x) {
        const int c = it & 255, r = it >> 8;
        attn_item(ws, lds, r, (r & 1) ? 255 - c : c);
    }
}


#define XB_TMO      128
#define XB_XCNT(j)  (256  + 64 * (j))
#define XB_XSUB(j)  (1280 + 64 * (j))
#define XB_XGEN(j)  (2304 + 64 * (j))
#define XB_TOP      3328
#define XB_TOPGEN   3392
#define XCD_BAR_WORDS 3456
#define XB_SPIN_CAP (1u << 22)
__device__ __forceinline__ unsigned xb_ld(unsigned* p)              { return __hip_atomic_load(p, __ATOMIC_RELAXED, __HIP_MEMORY_SCOPE_AGENT); }
__device__ __forceinline__ unsigned xb_add(unsigned* p, unsigned v) { return __hip_atomic_fetch_add(p, v, __ATOMIC_RELAXED, __HIP_MEMORY_SCOPE_AGENT); }
__device__ __forceinline__ unsigned xb_xcc_id() { return (unsigned)__builtin_amdgcn_s_getreg((3 << 11) | 20) & 0xFu; }
#define XB_SPIN(cond, bar) do { unsigned _sp = 0; while (cond) { __builtin_amdgcn_s_sleep(1); \
    if ((++_sp & 255u) == 0u) { if (xb_ld(&(bar)[XB_TMO])) break; if (_sp > XB_SPIN_CAP) { atomicAdd(&(bar)[XB_TMO], 1u); break; } } } } while (0)
struct XcdBarrier { unsigned* bar; unsigned x; volatile LAS unsigned* st; };
__device__ __forceinline__ XcdBarrier xcd_barrier_post(unsigned* bar, volatile LAS unsigned* st) {
    XcdBarrier b; b.bar = bar; b.x = xb_xcc_id(); b.st = st;
    if (threadIdx.x == 0) (void)xb_add(&bar[XB_XCNT(b.x)], 1u);
    return b;
}
__device__ __forceinline__ void xcd_barrier_complete(unsigned* bar, unsigned x, unsigned& nloc, unsigned& nx) {
    const unsigned G = gridDim.x * gridDim.y * gridDim.z;
    unsigned sum, cnt, mine, sp = 0u;
    for (;;) {
        sum = 0u; cnt = 0u; mine = 0u;
#pragma unroll
        for (unsigned j = 0; j < 16; ++j) { const unsigned c = xb_ld(&bar[XB_XCNT(j)]); sum += c; cnt += (c > 0u) ? 1u : 0u; mine = (j == x) ? c : mine; }
        if (sum == G) break;
        __builtin_amdgcn_s_sleep(1);
        if ((++sp & 255u) == 0u) { if (xb_ld(&bar[XB_TMO])) break; if (sp > XB_SPIN_CAP) { atomicAdd(&bar[XB_TMO], 1u); break; } }
    }
    nloc = mine > 0u ? mine : 1u; nx = cnt > 0u ? cnt : 1u;
}
__device__ __forceinline__ void xcd_barrier(const XcdBarrier& b) {
    asm volatile("s_waitcnt vmcnt(0)" ::: "memory");
    __syncthreads();
    if (threadIdx.x == 0) {
        unsigned* bar = b.bar;
        __builtin_amdgcn_s_waitcnt(0);
        unsigned nloc = b.st[0], nx = b.st[1];
        if (nloc == 0u) { xcd_barrier_complete(bar, b.x, nloc, nx); b.st[0] = nloc; b.st[1] = nx; }
        const unsigned old = xb_add(&bar[XB_XSUB(b.x)], 1u);
        const unsigned gen = old / nloc;
        if (old + 1u == (gen + 1u) * nloc) {
            __builtin_amdgcn_fence(__ATOMIC_RELEASE, "agent");
            asm volatile("s_waitcnt vmcnt(0)" ::: "memory");
            const unsigned og = xb_add(&bar[XB_TOP], 1u);
            const unsigned tg = og / nx;
            if (og + 1u == (tg + 1u) * nx) xb_add(&bar[XB_TOPGEN], 1u);
            else XB_SPIN(xb_ld(&bar[XB_TOPGEN]) == tg, bar);
            __builtin_amdgcn_fence(__ATOMIC_ACQUIRE, "agent");
            xb_add(&bar[XB_XGEN(b.x)], 1u);
            asm volatile("s_waitcnt vmcnt(0)" ::: "memory");
        } else {
            XB_SPIN(xb_ld(&bar[XB_XGEN(b.x)]) == gen, bar);
            __builtin_amdgcn_fence(__ATOMIC_ACQUIRE, "agent");
            asm volatile("s_waitcnt vmcnt(0)" ::: "memory");
        }
    }
    __syncthreads();
}

constexpr int NPH = 23;
__device__ __forceinline__ void run_phase(CP p, int ph, int b, LAS unsigned char* lds) {
    asm volatile("" : "+s"(p));
    unsigned char* ws = p->ws;
    const float* xb = p->x + (size_t)b * S_ * D_; float* hb = p->out + (size_t)b * S_ * D_;
    bf16_t* XN = (bf16_t*)(ws + OFF_XN);
    const int layer = (ph >= 13) ? 1 : 0;
    switch (ph) {
    case 0: prep_phase(p, lds); break;
    case 1: rmsnorm_phase(xb, p->norm_mix, XN, nullptr, nullptr); break;
    case 2: {
        Prob2D<EpiQK> g1{(const char*)XN, (const char*)(ws + OFF_W_RIN), 4096u, 4096u, 32, 64, 16, EpiQK{(bf16_t*)(ws + OFF_Q), (bf16_t*)(ws + OFF_K), (bf16_t*)(ws + OFF_KTD), (const float2*)(ws + OFF_ROPE)}};
        gemm_phase(lds, g1);
        Prob2D<EpiStore> g2{(const char*)(ws + OFF_W_RIN) + (size_t)4096 * 4096, (const char*)XN, 4096u, 4096u, 32, 16, 64, EpiStore{(bf16_t*)(ws + OFF_VT), (size_t)S_}};
        gemm_phase(lds, g2);
    } break;
    case 3: {
        ProbKV g3{(const char*)(ws + OFF_VT), (const char*)(ws + OFF_KTD), (bf16_t*)(ws + OFF_ST), 4};
        gemm_phase(lds, g3);
        ProbS g4{(const char*)(ws + OFF_Q), (const char*)(ws + OFF_K), (bf16_t*)(ws + OFF_SD), 4};
        gemm_phase(lds, g4);
    } break;
    case 4: scan_phase((bf16_t*)(ws + OFF_ST)); break;
    case 5: {
        ProbOut g5{(const char*)(ws + OFF_Q), (const char*)(ws + OFF_ST), (long)OFF_SD - (long)OFF_Q, (long)OFF_VT - (long)OFF_ST, (bf16_t*)(ws + OFF_Y), 8};
        gemm_phase(lds, g5);
    } break;
    case 6: gn_phase((bf16_t*)(ws + OFF_Y), p->ret_gn); break;
    case 7: {
        Prob2D<EpiGate> g6{(const char*)XN, (const char*)(ws + OFF_W_RIN) + (size_t)8192 * 4096, 4096u, 4096u, 32, 64, 16, EpiGate{(bf16_t*)(ws + OFF_Y)}};
        gemm_phase(lds, g6);
    } break;
    case 8: {
        Prob2D<EpiRes> g7{(const char*)(ws + OFF_Y), (const char*)(ws + OFF_W_ROUT), 8192u, 8192u, 64, 64, 8, EpiRes{xb, hb}};
        gemm_phase(lds, g7);
    } break;
    case 9: case 19: rmsnorm_phase(hb, p->norm_ffn + layer * 2048, XN, nullptr, nullptr); break;
    case 10: case 20: {
        Prob2D<EpiStore> g8{(const char*)XN, (const char*)(ws + OFF_W_FIN + (size_t)layer * 32 * MiB), 4096u, 4096u, 32, 64, 32, EpiStore{(bf16_t*)(ws + OFF_U), (size_t)8192}};
        gemm_phase(lds, g8);
    } break;
    case 11: case 21: conv_phase((const bf16_t*)(ws + OFF_U), (bf16_t*)(ws + OFF_AB), p->ffn_conv_w + (size_t)layer * 3 * 8192, p->ffn_conv_b + (size_t)layer * 8192); break;
    case 12: case 22: {
        Prob2D<EpiRes> g9{(const char*)(ws + OFF_AB), (const char*)(ws + OFF_W_FOUT + (size_t)layer * 16 * MiB), 8192u, 8192u, 64, 64, 8, EpiRes{hb, hb}};
        gemm_phase(lds, g9);
    } break;
    case 13: rmsnorm_phase(hb, p->norm_mix + 2048, XN, p->kv_gain, (bf16_t*)(ws + OFF_HN)); break;
    case 14: {
        Prob2D<EpiStore> g10{(const char*)(ws + OFF_HN), (const char*)(ws + OFF_W_KV), 4096u, 4096u, 32, 64, 8, EpiStore{(bf16_t*)(ws + OFF_KVTOK), (size_t)2048}};
        gemm_phase(lds, g10);
        Prob2D<EpiStore> g11{(const char*)(ws + OFF_W_KV) + (size_t)2048 * 4096, (const char*)(ws + OFF_HN), 4096u, 4096u, 32, 4, 64, EpiStore{(bf16_t*)(ws + OFF_KVT), (size_t)S_}};
        gemm_phase(lds, g11);
        Prob2D<EpiQproj> g12{(const char*)XN, (const char*)(ws + OFF_W_Q), 4096u, 4096u, 32, 64, 9, EpiQproj{(bf16_t*)(ws + OFF_QB), (float*)(ws + OFF_GATES)}};
        gemm_phase(lds, g12);
    } break;
    case 15: {
        ProbCmp1 a{(const char*)(ws + OFF_KVTOK), (const char*)(ws + OFF_W_C1K), 8192u, 64, 16, EpiGelu{(bf16_t*)(ws + OFF_H1), (const float*)(ws + OFF_PEB)}};
        gemm_phase(lds, a);
        ProbCmp1 v{(const char*)(ws + OFF_KVTOK) + 1024, (const char*)(ws + OFF_W_C1V), 8192u, 64, 16, EpiGelu{(bf16_t*)(ws + OFF_H1) + 4096 * 256, (const float*)(ws + OFF_PEB) + 256}};
        gemm_phase(lds, v);
    } break;
    case 16: {
        Prob2D<EpiKcmp> a{(const char*)(ws + OFF_H1), (const char*)(ws + OFF_W_C2K), 512u, 512u, 4, 16, 1, EpiKcmp{(bf16_t*)(ws + OFF_KCMP)}};
        gemm_phase(lds, a);
        Prob2D<EpiVcmp> v{(const char*)(ws + OFF_W_C2V), (const char*)(ws + OFF_H1) + (size_t)4096 * 256 * 2, 512u, 512u, 4, 1, 16, EpiVcmp{(bf16_t*)(ws + OFF_VCMPT)}};
        gemm_phase(lds, v);
    } break;
    case 17: attn_phase(ws, lds); break;
    case 18: {
        Prob2D<EpiRes> g{(const char*)(ws + OFF_ATT), (const char*)(ws + OFF_W_O), 4096u, 4096u, 32, 64, 8, EpiRes{hb, hb}};
        gemm_phase(lds, g);
    } break;
    case 23: finalnorm_phase(hb, p->final_gain); break;
    default: break;
    }
}

#if MULTI
__global__ void __launch_bounds__(512) phase_kernel(Params p, int ph, int b) {
    extern __shared__ __attribute__((aligned(16))) unsigned char shm[];
    run_phase((CP)__builtin_amdgcn_kernarg_segment_ptr(), ph, b, (LAS unsigned char*)shm);
}
#else
__global__ void __launch_bounds__(512) mega_kernel(Params p) {
    extern __shared__ __attribute__((aligned(16))) unsigned char shm[];
    cg::grid_group grid = cg::this_grid();
    CP cp = (CP)__builtin_amdgcn_kernarg_segment_ptr();
    volatile LAS unsigned* st = (volatile LAS unsigned*)((LAS unsigned char*)shm + LDS_ST);
    if (threadIdx.x == 0) { st[0] = 0u; st[1] = 0u; st[2] = 0u; st[3] = 0u; }
    __syncthreads();
    XcdBarrier xb = xcd_barrier_post((unsigned*)(cp->ws + OFF_BAR), st);
    run_phase(cp, 0, 0, (LAS unsigned char*)shm);
    grid.sync();
    for (int b = 0; b < 2; ++b)
        for (int ph = 1; ph <= NPH; ++ph) {
#ifdef PROBE_PH
            const int reps = (ph == PROBE_PH || ph == PROBE_PH2) ? 2 : 1;
#else
            const int reps = 1;
#endif
            for (int rep = 0; rep < reps; ++rep) { run_phase(cp, ph, b, (LAS unsigned char*)shm); xcd_barrier(xb); } }
}
#endif

constexpr int LDS_BYTES = LDS_ST + 16;
extern "C" void kernel_launch(void* const* d_in, const int* in_sizes, int n_in, void* d_out, int out_size, void* d_ws, size_t ws_size, hipStream_t stream) {
    static int grid = 0;
    if (grid == 0) {
        if (n_in != 21 || out_size != 2 * S_ * D_ || ws_size < WS_NEED) { fprintf(stderr, "kernel_launch: unexpected shapes/ws (n_in %d out %d ws %zu need %zu)\n", n_in, out_size, ws_size, (size_t)WS_NEED); grid = -1; return; }
#if MULTI
        if (hipFuncSetAttribute((const void*)phase_kernel, hipFuncAttributeMaxDynamicSharedMemorySize, LDS_BYTES) != hipSuccess) { fprintf(stderr, "hipFuncSetAttribute failed\n"); grid = -1; return; }
#else
        if (hipFuncSetAttribute((const void*)mega_kernel, hipFuncAttributeMaxDynamicSharedMemorySize, LDS_BYTES) != hipSuccess) { fprintf(stderr, "hipFuncSetAttribute failed\n"); grid = -1; return; }
#endif
        int dev = 0, cus = 0; hipGetDevice(&dev); hipDeviceGetAttribute(&cus, hipDeviceAttributeMultiprocessorCount, dev);
        grid = cus > 0 ? cus : 256;
    }
    if (grid < 0) return;
    Params p{};
    const float** pp = (const float**)&p;
    for (int i = 0; i < 21; ++i) pp[i] = (const float*)d_in[i];
    p.out = (float*)d_out; p.ws = (unsigned char*)d_ws;
#if MULTI
    hipLaunchKernelGGL(phase_kernel, dim3(grid), dim3(512), LDS_BYTES, stream, p, 0, 0);
    for (int b = 0; b < 2; ++b)
        for (int ph = 1; ph <= NPH; ++ph) hipLaunchKernelGGL(phase_kernel, dim3(grid), dim3(512), LDS_BYTES, stream, p, ph, b);
#else
    if (hipMemsetAsync((unsigned char*)d_ws + OFF_BAR, 0, XCD_BAR_WORDS * 4, stream) != hipSuccess) { fprintf(stderr, "memset failed\n"); return; }
    void* args[] = {&p};
    hipError_t e = hipLaunchCooperativeKernel((const void*)mega_kernel, dim3(grid), dim3(512), args, LDS_BYTES, stream);
    if (e != hipSuccess) fprintf(stderr, "cooperative launch failed: %s (grid %d)\n", hipGetErrorString(e), grid);
#endif
}
```

```cpp
#include <hip/hip_runtime.h>
#include <hip/hip_cooperative_groups.h>
#include <cstdio>
namespace cg = cooperative_groups;

#ifndef MULTI
#define MULTI 0
#endif

#define LAS __attribute__((address_space(3)))
typedef unsigned short bf16_t;
typedef short bf16x8 __attribute__((ext_vector_type(8)));
typedef float f32x4 __attribute__((ext_vector_type(4)));
typedef unsigned u32x2 __attribute__((ext_vector_type(2)));
typedef unsigned u32x4 __attribute__((ext_vector_type(4)));

constexpr int S_ = 16384, D_ = 2048;
constexpr size_t MiB = 1048576;
constexpr size_t OFF_W_RIN = 0, OFF_W_ROUT = 48 * MiB, OFF_W_KV = 64 * MiB, OFF_W_C1K = 76 * MiB, OFF_W_C1V = 78 * MiB,
                 OFF_W_C2K = 80 * MiB, OFF_W_C2V = 80 * MiB + 131072, OFF_W_Q = 81 * MiB, OFF_W_O = 90 * MiB,
                 OFF_W_FIN = 98 * MiB  , OFF_W_FOUT = 162 * MiB  , OFF_ROPE = 194 * MiB, OFF_PEB = 210 * MiB, OFF_BAR = 210 * MiB + 65536,
                 OFF_XN = 211 * MiB, OFF_ACT = 275 * MiB;
constexpr size_t OFF_Q = OFF_ACT, OFF_K = OFF_ACT + 64 * MiB, OFF_KTD = OFF_ACT + 128 * MiB, OFF_VT = OFF_ACT + 192 * MiB,
                 OFF_ST = OFF_ACT + 320 * MiB, OFF_SD = OFF_ACT + 448 * MiB, OFF_Y = OFF_ACT + 512 * MiB, WS_NEED = OFF_ACT + 640 * MiB;
constexpr size_t OFF_U = OFF_ACT, OFF_AB = OFF_ACT + 256 * MiB;
constexpr size_t OFF_HN = OFF_ACT, OFF_KVTOK = OFF_ACT + 64 * MiB, OFF_KVT = OFF_ACT + 129 * MiB, OFF_QB = OFF_ACT + 161 * MiB,
                 OFF_GATES = OFF_ACT + 225 * MiB, OFF_H1 = OFF_ACT + 229 * MiB, OFF_KCMP = OFF_ACT + 233 * MiB, OFF_VCMPT = OFF_ACT + 234 * MiB,
                 OFF_ATT = OFF_ACT + 235 * MiB, OFF_OACC = OFF_ACT + 299 * MiB;

struct Params {
    const float* x; const float* norm_mix; const float* norm_ffn; const float* ret_w_in; const float* ret_gn; const float* ret_w_out;
    const float* kv_gain; const float* w_kv; const float* pe_k; const float* w1_k; const float* w2_k; const float* pe_v; const float* w1_v;
    const float* w2_v; const float* w_q; const float* w_o; const float* ffn_w_in; const float* ffn_conv_w; const float* ffn_conv_b;
    const float* ffn_w_out; const float* final_gain; float* out; unsigned char* ws;
};

typedef const __attribute__((address_space(4))) Params* CP;
__device__ __forceinline__ int ltid() { int t = threadIdx.x; asm volatile("" : "+v"(t)); return t; }
__device__ __forceinline__ unsigned pk_bf16(float lo, float hi) { unsigned r; asm("v_cvt_pk_bf16_f32 %0, %1, %2" : "=v"(r) : "v"(lo), "v"(hi)); return r; }
__device__ __forceinline__ float bflo(unsigned v) { return __uint_as_float(v << 16); }
__device__ __forceinline__ float bfhi(unsigned v) { return __uint_as_float(v & 0xffff0000u); }
__device__ __forceinline__ float fexp2(float x) { return __builtin_amdgcn_exp2f(x); }
__device__ __forceinline__ float frcp(float x) { return __builtin_amdgcn_rcpf(x); }
__device__ __forceinline__ float log2gamma(int h) { return log2f(1.0f - exp2f(-5.0f - (float)h)); }
__device__ __forceinline__ float sigmoidf_(float x) { return frcp(1.0f + fexp2(-1.4426950408889634f * x)); }

constexpr int HTB = 128 * 64 * 2;
__device__ __forceinline__ int lds_byte(int r, int c) { const int st = (r >> 4) * 2 + (c >> 5), rr = r & 15, cc = c & 31, ob = rr * 64 + cc * 2; return st * 1024 + (ob ^ (((ob >> 9) & 1) << 5)); }
__device__ __forceinline__ void stage_rc(int b, int& R, int& C) { const int st = b / 1024, sb = b % 1024, swz = sb ^ (((sb >> 9) & 1) << 5); R = (st >> 1) * 16 + swz / 64; C = (st & 1) * 32 + (swz % 64) / 2; }
__device__ __forceinline__ void tile_order(int L, int nM, int nN, int& pm, int& pn) {
    const int nwg = nM * nN; int wgid = L;
    { const int q = nwg / 8, r = nwg % 8, xcd = wgid % 8, off = wgid / 8; wgid = (xcd < r ? xcd * (q + 1) : r * (q + 1) + (xcd - r) * q) + off; }
    const int nig = 8 * nN, gid = wgid / nig, fm = gid * 8, gsz = (nM - fm) < 8 ? (nM - fm) : 8;
    pm = fm + ((wgid % nig) % gsz); pn = (wgid % nig) / gsz;
}
struct UInfo { const char* a; const char* b; int r0, c0, x0, x1; };
typedef f32x4 AccT[2][2][4][2];

template <class P>
__device__ __forceinline__ void gemm_phase(LAS unsigned char* lds, const P& pb) {
    const int tid = ltid(), wid = __builtin_amdgcn_readfirstlane(tid >> 6), lane = tid & 63, wr = wid >> 2, wc = wid & 3, fr = lane & 15, fq = lane >> 4;
    const int nt = pb.nt, G = gridDim.x, c = blockIdx.x; const long nun = pb.nunits();
    if (c >= nun) return;
    unsigned voffA[2], voffB[2];
#pragma unroll
    for (int i = 0; i < 2; ++i) { int R, C; stage_rc(tid * 16 + i * 8192, R, C); voffA[i] = pb.rowA(R) + (unsigned)C * 2u; voffB[i] = (unsigned)R * pb.ldb + (unsigned)C * 2u; }
    const size_t hsA = pb.rowA(128), hsB = (size_t)128 * pb.ldb;
    const unsigned ldsw = (unsigned)wid * 1024u;
    const int aoff = lds_byte(wr * 64 + fr, fq * 8), boff = lds_byte(wc * 32 + fr, fq * 8);
#define G_SA(b, h) (((b) * 2 + (h)) * HTB)
#define G_SB(b, h) ((4 + (b) * 2 + (h)) * HTB)
#define G_STAGE(bufoff, gbase, voff) do { _Pragma("unroll") for (int _i = 0; _i < 2; ++_i) \
        __builtin_amdgcn_global_load_lds((const unsigned*)((const char*)(gbase) + (voff)[_i]), (LAS unsigned*)(lds + (bufoff) + ldsw + _i * 8192), 16, 0, 0); } while (0)
#define G_LDA(dst, b, h) do { _Pragma("unroll") for (int m = 0; m < 4; ++m) _Pragma("unroll") for (int k = 0; k < 2; ++k) dst[m][k] = *(const LAS bf16x8*)(lds + G_SA(b, h) + aoff + m * 2048 + k * 1024); } while (0)
#define G_LDB(dst, b, h) do { _Pragma("unroll") for (int n = 0; n < 2; ++n) _Pragma("unroll") for (int k = 0; k < 2; ++k) dst[n][k] = *(const LAS bf16x8*)(lds + G_SB(b, h) + boff + n * 2048 + k * 1024); } while (0)
#define G_MMA(ai, bj, At, Bt) do { __builtin_amdgcn_s_setprio(1); _Pragma("unroll") for (int m = 0; m < 4; ++m) _Pragma("unroll") for (int n = 0; n < 2; ++n) _Pragma("unroll") for (int k = 0; k < 2; ++k) \
        acc[ai][bj][m][n] = __builtin_amdgcn_mfma_f32_16x16x32_bf16(Bt[n][k], At[m][k], acc[ai][bj][m][n], 0, 0, 0); __builtin_amdgcn_s_setprio(0); } while (0)
#define G_WAIT_V(n) asm volatile("s_waitcnt vmcnt(" #n ")" ::: "memory")
#define G_WAIT_L(n) asm volatile("s_waitcnt lgkmcnt(" #n ")" ::: "memory")
#define G_BAR __builtin_amdgcn_s_barrier()
#define G_SCHED __builtin_amdgcn_sched_barrier(0)
    UInfo cur, nxt; int ui = 0;
    pb.unit(c, cur);
    AccT acc;
#pragma unroll
    for (int a = 0; a < 2; ++a)
#pragma unroll
        for (int b = 0; b < 2; ++b)
#pragma unroll
            for (int m = 0; m < 4; ++m)
#pragma unroll
                for (int n = 0; n < 2; ++n) acc[a][b][m][n] = (f32x4){0.f, 0.f, 0.f, 0.f};
    bf16x8 At[4][2], B0[2][2], B1[2][2];
    const char* cA = cur.a; const char* cB = cur.b;
    G_STAGE(G_SB(0, 0), cB + pb.bK(0), voffB); G_STAGE(G_SA(0, 0), cA + pb.aK(0), voffA); G_STAGE(G_SB(0, 1), cB + hsB + pb.bK(0), voffB); G_STAGE(G_SA(0, 1), cA + hsA + pb.aK(0), voffA);
    if (wr == 1) G_BAR;
    G_WAIT_V(4); G_BAR;
    G_STAGE(G_SB(1, 0), cB + pb.bK(1), voffB); G_STAGE(G_SA(1, 0), cA + pb.aK(1), voffA); G_STAGE(G_SB(1, 1), cB + hsB + pb.bK(1), voffB);
    G_WAIT_V(6); G_BAR;
    for (;;) {
        const long Ln = (long)(ui + 1) * G + c; const bool has_next = Ln < nun;
        if (has_next) pb.unit(Ln, nxt);
        const char* nA = has_next ? nxt.a : cA; const char* nB = has_next ? nxt.b : cB;
        for (int t = 0; t < nt; t += 2) {
            const bool last = (t == nt - 2);
            const char* a1 = cA + pb.aK(t + 1);
            const char* a2 = last ? nA + pb.aK(0) : cA + pb.aK(t + 2); const char* b2 = last ? nB + pb.bK(0) : cB + pb.bK(t + 2);
            const char* a3 = last ? nA + pb.aK(1) : cA + pb.aK(t + 3); const char* b3 = last ? nB + pb.bK(1) : cB + pb.bK(t + 3);
            G_LDB(B0, 0, 0); G_SCHED; G_LDA(At, 0, 0); G_STAGE(G_SA(1, 1), a1 + hsA, voffA);
            G_WAIT_L(8); G_BAR; G_WAIT_L(0); G_MMA(0, 0, At, B0); G_BAR; G_SCHED;
            G_LDB(B1, 0, 1); G_STAGE(G_SB(0, 0), b2, voffB);
            G_BAR; G_WAIT_L(0); G_MMA(0, 1, At, B1); G_BAR;
            G_LDA(At, 0, 1); G_STAGE(G_SA(0, 0), a2, voffA);
            G_BAR; G_WAIT_L(0); G_MMA(1, 0, At, B0); G_BAR; G_SCHED;
            G_STAGE(G_SB(0, 1), b2 + hsB, voffB);
            G_WAIT_V(6); G_BAR; G_MMA(1, 1, At, B1); G_BAR;
            G_LDB(B0, 1, 0); G_SCHED; G_LDA(At, 1, 0); G_STAGE(G_SA(0, 1), a2 + hsA, voffA);
            G_WAIT_L(8); G_BAR; G_WAIT_L(0); G_MMA(0, 0, At, B0); G_BAR; G_SCHED;
            G_LDB(B1, 1, 1); G_STAGE(G_SB(1, 0), b3, voffB);
            G_BAR; G_WAIT_L(0); G_MMA(0, 1, At, B1); G_BAR;
            G_LDA(At, 1, 1); G_STAGE(G_SA(1, 0), a3, voffA);
            G_BAR; G_WAIT_L(0); G_MMA(1, 0, At, B0); G_BAR; G_SCHED;
            G_STAGE(G_SB(1, 1), b3 + hsB, voffB);
            G_WAIT_V(6); G_BAR; G_MMA(1, 1, At, B1); G_BAR;
        }
        { const int l2 = ltid() & 63; pb.epi(acc, cur, wr, wc, l2 & 15, l2 >> 4); }
        if (!has_next) break;
#pragma unroll
        for (int a = 0; a < 2; ++a)
#pragma unroll
            for (int b = 0; b < 2; ++b)
#pragma unroll
                for (int m = 0; m < 4; ++m)
#pragma unroll
                    for (int n = 0; n < 2; ++n) acc[a][b][m][n] = (f32x4){0.f, 0.f, 0.f, 0.f};
        cur = nxt; cA = nA; cB = nB; ++ui;
    }
    G_WAIT_V(0);
    if (wr == 0) G_BAR;
    G_BAR;
}

#define EPI_ROWS for (int ai = 0; ai < 2; ++ai) for (int m = 0; m < 4; ++m)
#define EPI_COLS for (int bj = 0; bj < 2; ++bj) for (int n = 0; n < 2; ++n)
#define EPI_ROW (128 * ai + 64 * wr + 16 * m + fr)
#define EPI_COL (128 * bj + 32 * wc + 16 * n + 4 * fq)

template <class Epi> struct Prob2D {
    const char* A; const char* B; unsigned lda, ldb; int nt, nM, nN; Epi e;
    __device__ __forceinline__ long nunits() const { return (long)nM * nN; }
    __device__ __forceinline__ unsigned rowA(int R) const { return (unsigned)R * lda; }
    __device__ __forceinline__ void unit(long L, UInfo& u) const { int pm, pn; tile_order((int)L, nM, nN, pm, pn); u.a = A + (size_t)pm * 256 * lda; u.b = B + (size_t)pn * 256 * ldb; u.r0 = pm * 256; u.c0 = pn * 256; u.x0 = 0; u.x1 = 0; }
    __device__ __forceinline__ size_t aK(int kt) const { return (size_t)kt * 128; }
    __device__ __forceinline__ size_t bK(int kt) const { return (size_t)kt * 128; }
    __device__ __forceinline__ void epi(const AccT& acc, const UInfo& u, int wr, int wc, int fr, int fq) const { e(acc, u, wr, wc, fr, fq); }
};
struct EpiStore { bf16_t* O; size_t ldc;
    __device__ __forceinline__ void operator()(const AccT& acc, const UInfo& u, int wr, int wc, int fr, int fq) const {
#pragma unroll
        EPI_ROWS { bf16_t* rp = O + (size_t)(u.r0 + EPI_ROW) * ldc + u.c0;
#pragma unroll
            EPI_COLS { const f32x4 v = acc[ai][bj][m][n]; *(u32x2*)(rp + EPI_COL) = (u32x2){pk_bf16(v[0], v[1]), pk_bf16(v[2], v[3])}; } }
    } };
struct EpiRes { const float* R; float* O;
    __device__ __forceinline__ void operator()(const AccT& acc, const UInfo& u, int wr, int wc, int fr, int fq) const {
#pragma unroll
        EPI_ROWS { const size_t ro = (size_t)(u.r0 + EPI_ROW) * 2048 + u.c0;
#pragma unroll
            EPI_COLS { const f32x4 r = *(const f32x4*)(R + ro + EPI_COL); *(f32x4*)(O + ro + EPI_COL) = r + acc[ai][bj][m][n]; } }
    } };
struct EpiGate { bf16_t* Y;
    __device__ __forceinline__ void operator()(const AccT& acc, const UInfo& u, int wr, int wc, int fr, int fq) const {
#pragma unroll
        EPI_ROWS { bf16_t* rp = Y + (size_t)(u.r0 + EPI_ROW) * 4096 + u.c0;
#pragma unroll
            EPI_COLS { const f32x4 g = acc[ai][bj][m][n]; const u32x2 y = *(const u32x2*)(rp + EPI_COL);
                const float o0 = g[0] * sigmoidf_(g[0]) * bflo(y[0]), o1 = g[1] * sigmoidf_(g[1]) * bfhi(y[0]), o2 = g[2] * sigmoidf_(g[2]) * bflo(y[1]), o3 = g[3] * sigmoidf_(g[3]) * bfhi(y[1]);
                *(u32x2*)(rp + EPI_COL) = (u32x2){pk_bf16(o0, o1), pk_bf16(o2, o3)}; } }
    } };
struct EpiQK { bf16_t* Q; bf16_t* K; bf16_t* KTD; const float2* rope;
    __device__ __forceinline__ void operator()(const AccT& acc, const UInfo& u, int wr, int wc, int fr, int fq) const {
        const int hidx = u.c0 >> 8; const bool isk = hidx >= 8; const int hh = hidx & 7; const float l2g = log2gamma(hh);
        bf16_t* dst = (isk ? K : Q) + hh * 256; const float sc = isk ? 0.0625f : 1.0f;
#pragma unroll
        EPI_ROWS { const int t = u.r0 + EPI_ROW; const float kd = fexp2((float)(255 - (t & 255)) * l2g);
#pragma unroll
            for (int n = 0; n < 2; ++n) { const int dd = 32 * wc + 16 * n + 4 * fq;
                const f32x4 x1 = acc[ai][0][m][n], x2 = acc[ai][1][m][n]; const f32x4 cs0 = *(const f32x4*)(rope + (size_t)t * 128 + dd), cs1 = *(const f32x4*)(rope + (size_t)t * 128 + dd + 2);
                float y1[4], y2[4];
                y1[0] = (x1[0] * cs0[0] - x2[0] * cs0[1]) * sc; y2[0] = (x1[0] * cs0[1] + x2[0] * cs0[0]) * sc;
                y1[1] = (x1[1] * cs0[2] - x2[1] * cs0[3]) * sc; y2[1] = (x1[1] * cs0[3] + x2[1] * cs0[2]) * sc;
                y1[2] = (x1[2] * cs1[0] - x2[2] * cs1[1]) * sc; y2[2] = (x1[2] * cs1[1] + x2[2] * cs1[0]) * sc;
                y1[3] = (x1[3] * cs1[2] - x2[3] * cs1[3]) * sc; y2[3] = (x1[3] * cs1[3] + x2[3] * cs1[2]) * sc;
                *(u32x2*)(dst + (size_t)t * 2048 + dd) = (u32x2){pk_bf16(y1[0], y1[1]), pk_bf16(y1[2], y1[3])};
                *(u32x2*)(dst + (size_t)t * 2048 + 128 + dd) = (u32x2){pk_bf16(y2[0], y2[1]), pk_bf16(y2[2], y2[3])};
                if (isk) {
#pragma unroll
                    for (int j = 0; j < 4; ++j) { KTD[(size_t)(hh * 256 + dd + j) * S_ + t] = (bf16_t)(pk_bf16(y1[j] * kd, 0.f) & 0xffffu); KTD[(size_t)(hh * 256 + 128 + dd + j) * S_ + t] = (bf16_t)(pk_bf16(y2[j] * kd, 0.f) & 0xffffu); }
                } } }
    } };
struct EpiQproj { bf16_t* QB; float* gates;
    __device__ __forceinline__ void operator()(const AccT& acc, const UInfo& u, int wr, int wc, int fr, int fq) const {
#pragma unroll
        EPI_ROWS { const int t = u.r0 + EPI_ROW;
#pragma unroll
            EPI_COLS { const int col = u.c0 + EPI_COL; const f32x4 v = acc[ai][bj][m][n];
                if (col < 2048) *(u32x2*)(QB + (size_t)t * 2048 + col) = (u32x2){pk_bf16(v[0] * 0.08838834764831845f, v[1] * 0.08838834764831845f), pk_bf16(v[2] * 0.08838834764831845f, v[3] * 0.08838834764831845f)};
                else if (col < 2096) *(f32x4*)(gates + (size_t)t * 48 + (col - 2048)) = (f32x4){sigmoidf_(v[0]), sigmoidf_(v[1]), sigmoidf_(v[2]), sigmoidf_(v[3])}; } }
    } };
__device__ __forceinline__ float gelu_tanh(float x) { const float y = 0.7978845608028654f * (x + 0.044715f * x * x * x); const float e = fexp2(2.0f * 1.4426950408889634f * y); const float th = 1.0f - 2.0f * frcp(e + 1.0f); return 0.5f * x * (1.0f + th); }
struct EpiGelu { bf16_t* H; const float* bias;
    __device__ __forceinline__ void operator()(const AccT& acc, const UInfo& u, int wr, int wc, int fr, int fq) const {
#pragma unroll
        EPI_ROWS { bf16_t* rp = H + (size_t)(u.r0 + EPI_ROW) * 256;
#pragma unroll
            EPI_COLS { const int col = EPI_COL; const f32x4 v = acc[ai][bj][m][n]; const f32x4 bb = *(const f32x4*)(bias + col);
                *(u32x2*)(rp + col) = (u32x2){pk_bf16(gelu_tanh(v[0] + bb[0]), gelu_tanh(v[1] + bb[1])), pk_bf16(gelu_tanh(v[2] + bb[2]), gelu_tanh(v[3] + bb[3]))}; } }
    } };
struct EpiKcmp { bf16_t* KC;
    __device__ __forceinline__ void operator()(const AccT& acc, const UInfo& u, int wr, int wc, int fr, int fq) const {
#pragma unroll
        EPI_ROWS { const int r = u.r0 + EPI_ROW, i = r >> 2, h = r & 3;
#pragma unroll
            for (int n = 0; n < 2; ++n) { const int col = 32 * wc + 16 * n + 4 * fq; f32x4 v = acc[ai][0][m][n]; if (i == 1023) v = (f32x4){0.f, 0.f, 0.f, 0.f};
                *(u32x2*)(KC + ((size_t)h * 1024 + i) * 128 + col) = (u32x2){pk_bf16(v[0], v[1]), pk_bf16(v[2], v[3])}; } }
    } };
struct EpiVcmp { bf16_t* VC;
    __device__ __forceinline__ void operator()(const AccT& acc, const UInfo& u, int wr, int wc, int fr, int fq) const {
#pragma unroll
        for (int m = 0; m < 4; ++m) { const int d = 64 * wr + 16 * m + fr;
#pragma unroll
            EPI_COLS { const int col = u.c0 + EPI_COL, i = col >> 2; f32x4 v = acc[0][bj][m][n]; if (i == 1023) v = (f32x4){0.f, 0.f, 0.f, 0.f};
#pragma unroll
                for (int h = 0; h < 4; ++h) VC[((size_t)h * 128 + d) * 1024 + i] = (bf16_t)(pk_bf16(v[h], 0.f) & 0xffffu); } }
    } };
struct ProbCmp1 {
    const char* A; const char* B; unsigned ldb; int nt, nM; EpiGelu e;
    __device__ __forceinline__ long nunits() const { return nM; }
    __device__ __forceinline__ unsigned rowA(int R) const { return (unsigned)(R >> 2) * 65536u + (unsigned)(R & 3) * 256u; }
    __device__ __forceinline__ void unit(long L, UInfo& u) const { u.a = A + (size_t)L * 64 * 65536; u.b = B; u.r0 = (int)L * 256; u.c0 = 0; u.x0 = 0; u.x1 = 0; }
    __device__ __forceinline__ size_t aK(int kt) const { return (size_t)(kt >> 1) * 4096 + (size_t)(kt & 1) * 128; }
    __device__ __forceinline__ size_t bK(int kt) const { return (size_t)kt * 128; }
    __device__ __forceinline__ void epi(const AccT& acc, const UInfo& u, int wr, int wc, int fr, int fq) const { e(acc, u, wr, wc, fr, fq); }
};
struct ProbKV {
    const char* VT; const char* KTD; bf16_t* ST; int nt;
    __device__ __forceinline__ long nunits() const { return 8 * 64 * 2; }
    __device__ __forceinline__ unsigned rowA(int R) const { return (unsigned)R * 32768u; }
    static constexpr unsigned ldb = 32768u;
    __device__ __forceinline__ void unit(long L, UInfo& u) const { const int pm = (int)L & 1, c = ((int)L >> 1) & 63, h = (int)L >> 7;
        u.a = VT + ((size_t)(h * 512 + pm * 256) * S_ + c * 256) * 2; u.b = KTD + ((size_t)(h * 256) * S_ + c * 256) * 2; u.r0 = h * 512 + pm * 256; u.c0 = c * 256; u.x0 = 0; u.x1 = 0; }
    __device__ __forceinline__ size_t aK(int kt) const { return (size_t)kt * 128; }
    __device__ __forceinline__ size_t bK(int kt) const { return (size_t)kt * 128; }
    __device__ __forceinline__ void epi(const AccT& acc, const UInfo& u, int wr, int wc, int fr, int fq) const { EpiStore e{ST, (size_t)S_}; e(acc, u, wr, wc, fr, fq); }
};
struct ProbS {
    const char* Q; const char* K; bf16_t* SD; int nt;
    __device__ __forceinline__ long nunits() const { return 8 * 64; }
    __device__ __forceinline__ unsigned rowA(int R) const { return (unsigned)R * 4096u; }
    static constexpr unsigned ldb = 4096u;
    __device__ __forceinline__ void unit(long L, UInfo& u) const { const int c = (int)L & 63, h = (int)L >> 6; const size_t o = ((size_t)(c * 256) * 2048 + h * 256) * 2;
        u.a = Q + o; u.b = K + o; u.r0 = c * 256; u.c0 = h * 256; u.x0 = h; u.x1 = 0; }
    __device__ __forceinline__ size_t aK(int kt) const { return (size_t)kt * 128; }
    __device__ __forceinline__ size_t bK(int kt) const { return (size_t)kt * 128; }
    __device__ __forceinline__ void epi(const AccT& acc, const UInfo& u, int wr, int wc, int fr, int fq) const {
        const float l2g = log2gamma(u.x0);
#pragma unroll
        EPI_ROWS { const int i = EPI_ROW; bf16_t* rp = SD + (size_t)(u.r0 + i) * 2048 + u.c0;
#pragma unroll
            EPI_COLS { const int s = EPI_COL; const f32x4 v = acc[ai][bj][m][n]; float o[4];
#pragma unroll
                for (int j = 0; j < 4; ++j) o[j] = (s + j <= i) ? v[j] * fexp2(-(float)(s + j + 1) * l2g) : 0.f;
                *(u32x2*)(rp + s) = (u32x2){pk_bf16(o[0], o[1]), pk_bf16(o[2], o[3])}; } }
    }
};
struct ProbOut {
    const char* Q; const char* ST; long dA, dB; bf16_t* Y; int nt;
    __device__ __forceinline__ long nunits() const { return 8 * 64 * 2; }
    __device__ __forceinline__ unsigned rowA(int R) const { return (unsigned)R * 4096u; }
    static constexpr unsigned ldb = 32768u;
    __device__ __forceinline__ void unit(long L, UInfo& u) const { const int pn = (int)L & 1, c = ((int)L >> 1) & 63, h = (int)L >> 7;
        u.a = Q + ((size_t)(c * 256) * 2048 + h * 256) * 2; u.b = ST + ((size_t)(h * 512 + pn * 256) * S_ + c * 256) * 2; u.r0 = c * 256; u.c0 = h * 512 + pn * 256; u.x0 = h; u.x1 = 0; }
    __device__ __forceinline__ size_t aK(int kt) const { return kt < 4 ? (size_t)kt * 128 : (size_t)(dA + (long)(kt - 4) * 128); }
    __device__ __forceinline__ size_t bK(int kt) const { return kt < 4 ? (size_t)kt * 128 : (size_t)(dB + (long)(kt - 4) * 128); }
    __device__ __forceinline__ void epi(const AccT& acc, const UInfo& u, int wr, int wc, int fr, int fq) const {
        const float l2g = log2gamma(u.x0);
#pragma unroll
        EPI_ROWS { const int i = EPI_ROW; const float qd = fexp2((float)(i + 1) * l2g); bf16_t* rp = Y + (size_t)(u.r0 + i) * 4096 + u.c0;
#pragma unroll
            EPI_COLS { const f32x4 v = acc[ai][bj][m][n] * qd; *(u32x2*)(rp + EPI_COL) = (u32x2){pk_bf16(v[0], v[1]), pk_bf16(v[2], v[3])}; } }
    }
};

__device__ __forceinline__ float shx(float v, int m, int lane) { return __int_as_float(__builtin_amdgcn_ds_bpermute((lane ^ m) << 2, __float_as_int(v))); }
__device__ __forceinline__ unsigned long long shx64(unsigned long long v, int m, int lane) {
    const unsigned lo = (unsigned)__builtin_amdgcn_ds_bpermute((lane ^ m) << 2, (int)(unsigned)v), hi = (unsigned)__builtin_amdgcn_ds_bpermute((lane ^ m) << 2, (int)(unsigned)(v >> 32));
    return ((unsigned long long)hi << 32) | lo; }
__device__ __forceinline__ float wave_sum(float v, int lane) {
#pragma unroll
    for (int o = 32; o >= 1; o >>= 1) v += shx(v, o, lane);
    return v;
}
__device__ __forceinline__ void transpose_job(const float* __restrict__ src, bf16_t* __restrict__ dst, int K, int N, int Npad, int kvperm, LAS float* tile) {
    const int tk = K / 64, tn = Npad / 64, ntile = tk * tn; const int tid = ltid();
    for (int t = blockIdx.x; t < ntile; t += gridDim.x) {
        const int k0 = (t % tk) * 64, n0 = (t / tk) * 64;
        { const int r0 = tid >> 6, cc = tid & 63;
#pragma unroll
          for (int i = 0; i < 8; ++i) { const int r = r0 + 8 * i, n = n0 + cc; tile[r * 65 + cc] = (n < N) ? src[(size_t)(k0 + r) * N + n] : 0.f; } }
        __syncthreads();
        { const int rr = tid >> 3, cc = (tid & 7) * 8; float v[8];
#pragma unroll
          for (int j = 0; j < 8; ++j) v[j] = tile[(cc + j) * 65 + rr];
          int n = n0 + rr; if (kvperm) { const int j = n >> 9; const int jp = (j == 3) ? 4 : ((j == 4) ? 3 : j); n = jp * 512 + (n & 511); }
          *(u32x4*)(dst + (size_t)n * K + k0 + cc) = (u32x4){pk_bf16(v[0], v[1]), pk_bf16(v[2], v[3]), pk_bf16(v[4], v[5]), pk_bf16(v[6], v[7])}; }
        __syncthreads();
    }
}
__device__ __forceinline__ void prep_phase(CP p, LAS unsigned char* lds) {
    LAS float* tile = (LAS float*)lds; unsigned char* ws = p->ws;
    transpose_job(p->ret_w_in, (bf16_t*)(ws + OFF_W_RIN), 2048, 12288, 12288, 0, tile);
    transpose_job(p->ret_w_out, (bf16_t*)(ws + OFF_W_ROUT), 4096, 2048, 2048, 0, tile);
    transpose_job(p->w_kv, (bf16_t*)(ws + OFF_W_KV), 2048, 3072, 3072, 1, tile);
    transpose_job(p->w1_k, (bf16_t*)(ws + OFF_W_C1K), 4096, 256, 256, 0, tile);
    transpose_job(p->w1_v, (bf16_t*)(ws + OFF_W_C1V), 4096, 256, 256, 0, tile);
    transpose_job(p->w2_k, (bf16_t*)(ws + OFF_W_C2K), 256, 128, 256, 0, tile);
    transpose_job(p->w2_v, (bf16_t*)(ws + OFF_W_C2V), 256, 128, 256, 0, tile);
    transpose_job(p->w_q, (bf16_t*)(ws + OFF_W_Q), 2048, 2096, 2304, 0, tile);
    transpose_job(p->w_o, (bf16_t*)(ws + OFF_W_O), 2048, 2048, 2048, 0, tile);
    transpose_job(p->ffn_w_in, (bf16_t*)(ws + OFF_W_FIN), 2048, 8192, 8192, 0, tile);
    transpose_job(p->ffn_w_in + (size_t)2048 * 8192, (bf16_t*)(ws + OFF_W_FIN + 32 * MiB), 2048, 8192, 8192, 0, tile);
    transpose_job(p->ffn_w_out, (bf16_t*)(ws + OFF_W_FOUT), 4096, 2048, 2048, 0, tile);
    transpose_job(p->ffn_w_out + (size_t)4096 * 2048, (bf16_t*)(ws + OFF_W_FOUT + 16 * MiB), 4096, 2048, 2048, 0, tile);
    { float2* rope = (float2*)(ws + OFF_ROPE); const int gsz = gridDim.x * 512;
      for (int i = blockIdx.x * 512 + ltid(); i < S_ * 128; i += gsz) { const int t = i >> 7, dd = i & 127;
          const float freq = exp2f(-(float)dd * (13.287712379549449f / 128.0f)); const double rev = (double)t * (double)freq * 0.15915494309189535;
          const float fx = (float)(rev - rint(rev)); rope[i] = make_float2(__builtin_amdgcn_cosf(fx), __builtin_amdgcn_sinf(fx)); } }
    if (blockIdx.x < 128) { const int kv = blockIdx.x >> 6, oc = blockIdx.x & 63; const float* pe = kv ? p->pe_v : p->pe_k; const float* w1 = kv ? p->w1_v : p->w1_k; float* peb = (float*)(ws + OFF_PEB) + kv * 256;
        const int tid = ltid(), g = tid >> 7, r = tid & 127, n = 4 * oc + g; float s = 0.f;
#pragma unroll 8
        for (int j = 0; j < 32; ++j) { const int k = r + 128 * j; s += pe[k] * w1[(size_t)k * 256 + n]; }
        s = wave_sum(s, tid & 63);
        __syncthreads(); if ((tid & 63) == 0) tile[tid >> 6] = s; __syncthreads();
        if (tid < 4) peb[4 * oc + tid] = tile[2 * tid] + tile[2 * tid + 1];
        __syncthreads(); }
}
__device__ __forceinline__ void rmsnorm_phase(const float* h, const float* g1, bf16_t* o1, const float* g2, bf16_t* o2) {
    const int w = ltid() >> 6, lane = ltid() & 63;
    for (int row = blockIdx.x * 8 + w; row < S_; row += gridDim.x * 8) {
        const f32x4* p = (const f32x4*)(h + (size_t)row * 2048); f32x4 v[8]; float ss = 0.f;
#pragma unroll
        for (int i = 0; i < 8; ++i) { v[i] = p[lane + 64 * i]; ss += v[i][0] * v[i][0] + v[i][1] * v[i][1] + v[i][2] * v[i][2] + v[i][3] * v[i][3]; }
        ss = wave_sum(ss, lane); const float r = rsqrtf(ss * (1.0f / 2048.0f) + 1e-6f);
#pragma unroll
        for (int i = 0; i < 8; ++i) { const int col = (lane + 64 * i) * 4; const f32x4 g = *(const f32x4*)(g1 + col);
            *(u32x2*)(o1 + (size_t)row * 2048 + col) = (u32x2){pk_bf16(v[i][0] * r * g[0], v[i][1] * r * g[1]), pk_bf16(v[i][2] * r * g[2], v[i][3] * r * g[3])};
            if (o2) { const f32x4 gg = *(const f32x4*)(g2 + col);
                *(u32x2*)(o2 + (size_t)row * 2048 + col) = (u32x2){pk_bf16(v[i][0] * r * gg[0], v[i][1] * r * gg[1]), pk_bf16(v[i][2] * r * gg[2], v[i][3] * r * gg[3])}; } }
    }
}
__device__ __forceinline__ void finalnorm_phase(float* h, const float* g1) {
    const int w = ltid() >> 6, lane = ltid() & 63;
    for (int row = blockIdx.x * 8 + w; row < S_; row += gridDim.x * 8) {
        f32x4* p = (f32x4*)(h + (size_t)row * 2048); f32x4 v[8]; float ss = 0.f;
#pragma unroll
        for (int i = 0; i < 8; ++i) { v[i] = p[lane + 64 * i]; ss += v[i][0] * v[i][0] + v[i][1] * v[i][1] + v[i][2] * v[i][2] + v[i][3] * v[i][3]; }
        ss = wave_sum(ss, lane); const float r = rsqrtf(ss * (1.0f / 2048.0f) + 1e-6f);
#pragma unroll
        for (int i = 0; i < 8; ++i) { const f32x4 g = *(const f32x4*)(g1 + (lane + 64 * i) * 4); p[lane + 64 * i] = v[i] * r * g; }
    }
}
__device__ __forceinline__ void scan_phase(bf16_t* ST) {
    for (int it = blockIdx.x * 512 + ltid(); it < 4096 * 32; it += gridDim.x * 512) {
        const int r = it >> 5, d8 = it & 31; const float cd = fexp2(256.0f * log2gamma(r >> 9));
        bf16_t* p = ST + (size_t)r * S_ + d8 * 8; float s[8];
#pragma unroll
        for (int j = 0; j < 8; ++j) s[j] = 0.f;
        for (int c = 0; c < 64; ++c) { const u32x4 v = *(const u32x4*)(p + c * 256);
            *(u32x4*)(p + c * 256) = (u32x4){pk_bf16(s[0], s[1]), pk_bf16(s[2], s[3]), pk_bf16(s[4], s[5]), pk_bf16(s[6], s[7])};
#pragma unroll
            for (int j = 0; j < 4; ++j) { s[2 * j] = s[2 * j] * cd + bflo(v[j]); s[2 * j + 1] = s[2 * j + 1] * cd + bfhi(v[j]); } }
    }
}
__device__ __forceinline__ void gn_phase(bf16_t* Y, const float* gain) {
    const int w = ltid() >> 6, lane = ltid() & 63;
    for (int g = blockIdx.x * 8 + w; g < S_ * 8; g += gridDim.x * 8) {
        bf16_t* p = Y + (size_t)g * 512 + lane * 8; const u32x4 v = *(const u32x4*)p; float x[8];
#pragma unroll
        for (int j = 0; j < 4; ++j) { x[2 * j] = bflo(v[j]); x[2 * j + 1] = bfhi(v[j]); }
        float s = 0.f;
#pragma unroll
        for (int j = 0; j < 8; ++j) s += x[j];
        const float mu = wave_sum(s, lane) * (1.0f / 512.0f); float q = 0.f;
#pragma unroll
        for (int j = 0; j < 8; ++j) { x[j] -= mu; q += x[j] * x[j]; }
        const float r = rsqrtf(wave_sum(q, lane) * (1.0f / 512.0f) + 1e-6f); const float* gp = gain + (g & 7) * 512 + lane * 8;
        const f32x4 g0 = *(const f32x4*)gp, g1 = *(const f32x4*)(gp + 4);
        *(u32x4*)p = (u32x4){pk_bf16(x[0] * r * g0[0], x[1] * r * g0[1]), pk_bf16(x[2] * r * g0[2], x[3] * r * g0[3]), pk_bf16(x[4] * r * g1[0], x[5] * r * g1[1]), pk_bf16(x[6] * r * g1[2], x[7] * r * g1[3])};
    }
}
__device__ __forceinline__ void conv_phase(const bf16_t* U, bf16_t* AB, const float* cw, const float* cb) {
    for (int it = blockIdx.x * 512 + ltid(); it < 2048 * 512; it += gridDim.x * 512) {
        const int n8 = (it & 511) * 8, t0 = (it >> 9) * 8;
        float wa[3][8], wb[3][8], ba[8], bb[8];
#pragma unroll
        for (int tp = 0; tp < 3; ++tp)
#pragma unroll
            for (int j = 0; j < 8; ++j) { wa[tp][j] = cw[tp * 8192 + n8 + j]; wb[tp][j] = cw[tp * 8192 + 4096 + n8 + j]; }
#pragma unroll
        for (int j = 0; j < 8; ++j) { ba[j] = cb[n8 + j]; bb[j] = cb[4096 + n8 + j]; }
        float pa[2][8], pb[2][8];
#pragma unroll
        for (int k = 0; k < 2; ++k) { const int t = t0 - 2 + k; u32x4 va = (u32x4){0, 0, 0, 0}, vb = (u32x4){0, 0, 0, 0};
            if (t >= 0) { va = *(const u32x4*)(U + (size_t)t * 8192 + n8); vb = *(const u32x4*)(U + (size_t)t * 8192 + 4096 + n8); }
#pragma unroll
            for (int j = 0; j < 4; ++j) { pa[k][2 * j] = bflo(va[j]); pa[k][2 * j + 1] = bfhi(va[j]); pb[k][2 * j] = bflo(vb[j]); pb[k][2 * j + 1] = bfhi(vb[j]); } }
#pragma unroll
        for (int k = 0; k < 8; ++k) { const int t = t0 + k; const u32x4 va = *(const u32x4*)(U + (size_t)t * 8192 + n8), vb = *(const u32x4*)(U + (size_t)t * 8192 + 4096 + n8);
            float xa[8], xb[8], o[8];
#pragma unroll
            for (int j = 0; j < 4; ++j) { xa[2 * j] = bflo(va[j]); xa[2 * j + 1] = bfhi(va[j]); xb[2 * j] = bflo(vb[j]); xb[2 * j + 1] = bfhi(vb[j]); }
#pragma unroll
            for (int j = 0; j < 8; ++j) { const float a = ba[j] + wa[0][j] * pa[0][j] + wa[1][j] * pa[1][j] + wa[2][j] * xa[j]; const float b = bb[j] + wb[0][j] * pb[0][j] + wb[1][j] * pb[1][j] + wb[2][j] * xb[j];
                o[j] = a * sigmoidf_(a) * b; pa[0][j] = pa[1][j]; pa[1][j] = xa[j]; pb[0][j] = pb[1][j]; pb[1][j] = xb[j]; }
            *(u32x4*)(AB + (size_t)t * 4096 + n8) = (u32x4){pk_bf16(o[0], o[1]), pk_bf16(o[2], o[3]), pk_bf16(o[4], o[5]), pk_bf16(o[6], o[7])}; }
    }
}

constexpr int A_KT = 0, A_VT = 17408, A_BUFSZ = 34816, A_PSL = 69632, A_SEL = 69632 + 65536, LDS_ST = 139264;
constexpr float LOG2E = 1.4426950408889634f;
struct AttnState { f32x4 ot[8][2]; float m[2], l[2]; };

template <int MODE>
__device__ __forceinline__ void attn_compute(LAS unsigned char* lds, int boff, int tile, const bf16x8 (&qf)[2][4], AttnState& st, const int (&tpos)[2], int qb, int w, int lane,
                                             const float (&mfin)[2], const float (&linv)[2], bool rs0, bool rs1, bool masked) {
    const int l16 = lane & 15, g4 = lane >> 4;
    f32x4 s[4][2];
#pragma unroll
    for (int mt = 0; mt < 4; ++mt) { s[mt][0] = (f32x4){0.f, 0.f, 0.f, 0.f}; s[mt][1] = (f32x4){0.f, 0.f, 0.f, 0.f}; }
#pragma unroll
    for (int ks = 0; ks < 4; ++ks)
#pragma unroll
        for (int mt = 0; mt < 4; ++mt) { const bf16x8 kf = *(const LAS bf16x8*)(lds + boff + A_KT + (16 * mt + l16) * 272 + ks * 64 + g4 * 16);
            s[mt][0] = __builtin_amdgcn_mfma_f32_16x16x32_bf16(kf, qf[0][ks], s[mt][0], 0, 0, 0);
            s[mt][1] = __builtin_amdgcn_mfma_f32_16x16x32_bf16(kf, qf[1][ks], s[mt][1], 0, 0, 0);
            if (mt == 3 && (ks & 1)) __builtin_amdgcn_sched_barrier(0); }
    if (masked) {
#pragma unroll
        for (int nt = 0; nt < 2; ++nt) { const int t = tpos[nt]; const int tl = w * 8 + nt * 4 + (l16 >> 2);
#pragma unroll
            for (int mt = 0; mt < 4; ++mt)
#pragma unroll
                for (int j = 0; j < 4; ++j) { const int kl = 16 * mt + 4 * g4 + j; const int key = tile * 64 + kl; bool v;
                    if (MODE == 0 || MODE == 1) v = key <= ((t - 31) >> 4);
                    else if (MODE == 2) v = (kl <= tl);
                    else v = (key <= t) && (key > t - 512);
                    s[mt][nt][j] = v ? s[mt][nt][j] : -__builtin_inff(); } }
    }
    bf16x8 pf[2][2];
#pragma unroll
    for (int nt = 0; nt < 2; ++nt) {
        const bool rowsel = nt ? rs1 : rs0;
        const float bias = (MODE == 2 && !rowsel) ? -__builtin_inff() : 0.f;
        float mx = -1e30f;
#pragma unroll
        for (int mt = 0; mt < 4; ++mt)
#pragma unroll
            for (int j = 0; j < 4; ++j) {
                const float sv = s[mt][nt][j] * LOG2E + bias;
                s[mt][nt][j] = sv; mx = fmaxf(mx, sv); }
        float mnew, alpha = 1.f;
        if (MODE == 1) mnew = mfin[nt];
        else { mx = fmaxf(mx, shx(mx, 16, lane)); mx = fmaxf(mx, shx(mx, 32, lane)); mnew = fmaxf(st.m[nt], mx); alpha = fexp2(st.m[nt] - mnew); st.m[nt] = mnew; }
        float ps = 0.f;
#pragma unroll
        for (int mt = 0; mt < 4; ++mt)
#pragma unroll
            for (int j = 0; j < 4; ++j) { float pv = fexp2(s[mt][nt][j] - mnew); if (MODE == 1) pv *= linv[nt]; s[mt][nt][j] = pv; ps += pv; }
        if (MODE != 1) st.l[nt] = st.l[nt] * alpha + ps;
        if (MODE == 2 || MODE == 3) {
#pragma unroll
            for (int md = 0; md < 8; ++md) st.ot[md][nt] = st.ot[md][nt] * alpha;
        }
        if (MODE == 1) {
#pragma unroll
            for (int mt = 0; mt < 4; ++mt) { float a = s[mt][nt][0] + s[mt][nt][1] + s[mt][nt][2] + s[mt][nt][3], lst = s[mt][nt][3];
                a += shx(a, 1, lane); a += shx(a, 2, lane); lst += shx(lst, 1, lane); lst += shx(lst, 2, lane);
                if ((l16 & 3) == 0) { const int jb = tile * 16 + 4 * mt + g4; LAS float* pp = (LAS float*)(lds + A_PSL) + (w * 8 + nt * 4 + (l16 >> 2)) * 256;
                    atomicAdd((float*)(pp + jb), a); if (jb + 1 < 256) atomicAdd((float*)(pp + jb + 1), lst); } }
        }
        if (MODE != 0) {
#pragma unroll
            for (int kk = 0; kk < 2; ++kk) { const u32x4 pk = (u32x4){pk_bf16(s[2 * kk][nt][0], s[2 * kk][nt][1]), pk_bf16(s[2 * kk][nt][2], s[2 * kk][nt][3]), pk_bf16(s[2 * kk + 1][nt][0], s[2 * kk + 1][nt][1]), pk_bf16(s[2 * kk + 1][nt][2], s[2 * kk + 1][nt][3])};
                pf[nt][kk] = __builtin_bit_cast(bf16x8, pk); }
        }
    }
    if (MODE != 0) {
#pragma unroll
        for (int kk = 0; kk < 2; ++kk)
#pragma unroll
            for (int md = 0; md < 8; ++md) { const LAS unsigned char* vb = lds + boff + A_VT + (16 * md + l16) * 136 + kk * 64 + g4 * 8;
                const u32x2 v0 = *(const LAS u32x2*)vb, v1 = *(const LAS u32x2*)(vb + 32); const bf16x8 vf = __builtin_bit_cast(bf16x8, ((u32x4){v0[0], v0[1], v1[0], v1[1]}));
                st.ot[md][0] = __builtin_amdgcn_mfma_f32_16x16x32_bf16(vf, pf[0][kk], st.ot[md][0], 0, 0, 0);
                st.ot[md][1] = __builtin_amdgcn_mfma_f32_16x16x32_bf16(vf, pf[1][kk], st.ot[md][1], 0, 0, 0);
                if (md == 7) __builtin_amdgcn_sched_barrier(0); }
    }
}
template <int MODE>
__device__ __forceinline__ void attn_tiles(LAS unsigned char* lds, const bf16_t* kp, size_t kstride, const bf16_t* vp, size_t vstride, int tile_lo, int tile_hi,
                                           const bf16x8 (&qf)[2][4], AttnState& st, const int (&tpos)[2], int qb, int w, int lane, const float (&mfin)[2], const float (&linv)[2]) {
    if (tile_lo >= tile_hi) return;
    int tid = w * 64 + lane; asm volatile("" : "+v"(tid)); const int l16 = lane & 15;
    const int krow = tid >> 3, kc = (tid & 7) * 16, vrow = tid >> 2, vc = (tid & 3) * 16;
    u32x4 kr0, kr1, vr0 = (u32x4){0, 0, 0, 0}, vr1 = (u32x4){0, 0, 0, 0};
#define A_LOAD(T) do { const bf16_t* kg = kp + (size_t)((T) * 64 + krow) * kstride + kc; kr0 = *(const u32x4*)kg; kr1 = *(const u32x4*)(kg + 8); \
        if (MODE != 0) { const bf16_t* vg = vp + (size_t)vrow * vstride + (T) * 64 + vc; vr0 = *(const u32x4*)vg; vr1 = *(const u32x4*)(vg + 8); } } while (0)
#define A_WRITE(BO) do { LAS unsigned char* kd = lds + (BO) + A_KT + krow * 272 + kc * 2; *(LAS u32x4*)kd = kr0; *(LAS u32x4*)(kd + 16) = kr1; \
        if (MODE != 0) { LAS unsigned char* vd = lds + (BO) + A_VT + vrow * 136 + vc * 2; *(LAS u32x2*)vd = (u32x2){vr0[0], vr0[1]}; *(LAS u32x2*)(vd + 8) = (u32x2){vr0[2], vr0[3]}; *(LAS u32x2*)(vd + 16) = (u32x2){vr1[0], vr1[1]}; *(LAS u32x2*)(vd + 24) = (u32x2){vr1[2], vr1[3]}; } } while (0)
    A_LOAD(tile_lo);
    __syncthreads();
    A_WRITE(0);
    if (tile_lo + 1 < tile_hi) A_LOAD(tile_lo + 1);
    __syncthreads();
    for (int tile = tile_lo; tile < tile_hi; ++tile) {
        const int boff = ((tile - tile_lo) & 1) * A_BUFSZ;
        if (tile + 1 < tile_hi) { A_WRITE(boff ^ A_BUFSZ); if (tile + 2 < tile_hi) A_LOAD(tile + 2); }
        bool rs0 = true, rs1 = true, active = true;
        if (MODE == 2) { const int tw = tile >> 5; const unsigned bit = 1u << (tile & 31);
            const unsigned w0 = *(const LAS unsigned*)(lds + A_SEL + ((w * 8 + (l16 >> 2)) * 8 + tw) * 4), w1 = *(const LAS unsigned*)(lds + A_SEL + ((w * 8 + 4 + (l16 >> 2)) * 8 + tw) * 4);
            rs0 = (w0 & bit) != 0u; rs1 = (w1 & bit) != 0u; active = __ballot(rs0 || rs1) != 0ull; }
        if (active) {
            bool masked;
            if (MODE == 0 || MODE == 1) masked = (tile * 64 + 63 > 4 * qb - 2);
            else if (MODE == 2) masked = (tile == qb);
            else masked = (tile == qb) || (tile <= qb - 8);
            attn_compute<MODE>(lds, boff, tile, qf, st, tpos, qb, w, lane, mfin, linv, rs0, rs1, masked);
        }
        __syncthreads();
    }
#undef A_LOAD
#undef A_WRITE
}
template <int BR>
__device__ __forceinline__ void attn_finish(AttnState& st, const float* gates, float* oacc, bf16_t* att, const int (&tpos)[2], int hkv, int lane) {
    const int l16 = lane & 15, g4 = lane >> 4, g = l16 & 3;
#pragma unroll
    for (int nt = 0; nt < 2; ++nt) {
        const int t = tpos[nt]; float sc = gates[(size_t)t * 48 + (hkv * 4 + g) * 3 + BR];
        if (BR != 0) { float l = st.l[nt]; l += shx(l, 16, lane); l += shx(l, 32, lane); sc = (l > 0.f) ? sc / l : 0.f; }
        const size_t base = (size_t)t * 2048 + (hkv * 4 + g) * 128 + 4 * g4;
#pragma unroll
        for (int md = 0; md < 8; ++md) { f32x4 v = st.ot[md][nt] * sc; float* op = oacc + base + 16 * md;
            if (BR == 0) *(f32x4*)op = v;
            else if (BR == 1) *(f32x4*)op = *(const f32x4*)op + v;
            else { v = v + *(const f32x4*)op; *(u32x2*)(att + base + 16 * md) = (u32x2){pk_bf16(v[0], v[1]), pk_bf16(v[2], v[3])}; } }
    }
}
__device__ __forceinline__ void attn_reset(AttnState& st) {
#pragma unroll
    for (int md = 0; md < 8; ++md) { st.ot[md][0] = (f32x4){0.f, 0.f, 0.f, 0.f}; st.ot[md][1] = (f32x4){0.f, 0.f, 0.f, 0.f}; }
    st.m[0] = st.m[1] = -1e30f; st.l[0] = st.l[1] = 0.f;
}
__device__ __forceinline__ void attn_item(unsigned char* ws, LAS unsigned char* lds, int hkv, int qb) {
    int tid = ltid(); asm volatile("" : "+v"(tid)); const int w = tid >> 6, lane = tid & 63, l16 = lane & 15, g4 = lane >> 4;
    const bf16_t* QB = (const bf16_t*)(ws + OFF_QB); const bf16_t* KVTOK = (const bf16_t*)(ws + OFF_KVTOK); const bf16_t* KVT = (const bf16_t*)(ws + OFF_KVT);
    const bf16_t* KC = (const bf16_t*)(ws + OFF_KCMP); const bf16_t* VC = (const bf16_t*)(ws + OFF_VCMPT);
    const float* gates = (const float*)(ws + OFF_GATES); float* oacc = (float*)(ws + OFF_OACC); bf16_t* att = (bf16_t*)(ws + OFF_ATT);
    int tpos[2]; bf16x8 qf[2][4];
#pragma unroll
    for (int nt = 0; nt < 2; ++nt) { tpos[nt] = qb * 64 + w * 8 + nt * 4 + (l16 >> 2); const bf16_t* qp = QB + (size_t)tpos[nt] * 2048 + (hkv * 4 + (l16 & 3)) * 128 + g4 * 8;
#pragma unroll
        for (int ks = 0; ks < 4; ++ks) qf[nt][ks] = *(const bf16x8*)(qp + ks * 32); }
    __syncthreads();
    { LAS float* pp = (LAS float*)(lds + A_PSL) + w * 2048;
#pragma unroll
      for (int i = 0; i < 32; ++i) pp[lane + 64 * i] = 0.f; }
    AttnState st; float mfin[2] = {0.f, 0.f}, linv[2] = {0.f, 0.f};
    const int ncmp_tiles = (4 * qb + 3 + 63) >> 6;
    attn_reset(st);
    attn_tiles<0>(lds, KC + (size_t)hkv * 1024 * 128, 128, VC, 1024, 0, ncmp_tiles, qf, st, tpos, qb, w, lane, mfin, linv);
#pragma unroll
    for (int nt = 0; nt < 2; ++nt) { float l = st.l[nt]; l += shx(l, 16, lane); l += shx(l, 32, lane); mfin[nt] = st.m[nt]; linv[nt] = (l > 0.f) ? 1.0f / l : 0.f; }
    attn_reset(st);
    attn_tiles<1>(lds, KC + (size_t)hkv * 1024 * 128, 128, VC + (size_t)hkv * 128 * 1024, 1024, 0, ncmp_tiles, qf, st, tpos, qb, w, lane, mfin, linv);
    attn_finish<0>(st, gates, oacc, att, tpos, hkv, lane);
    __syncthreads();
    {
        LAS unsigned* sel = (LAS unsigned*)(lds + A_SEL) + w * 64;
        if (qb < 16) {
            if (lane < 8) { for (int tk = 0; tk < 8; ++tk) { const int lo = lane * 32; unsigned wd = 0; if (qb >= lo + 31) wd = 0xffffffffu; else if (qb >= lo) wd = (2u << (qb - lo)) - 1u; sel[tk * 8 + lane] = wd; } }
        } else {
            for (int tk = 0; tk < 8; ++tk) {
                const LAS float* pp = (const LAS float*)(lds + A_PSL) + (w * 8 + tk) * 256;
                unsigned long long key[4]; bool taken[4];
#pragma unroll
                for (int i = 0; i < 4; ++i) { const int j = lane + 64 * i; const float sc = pp[j]; const bool elig = (j >= 1) && (j <= qb - 2);
                    taken[i] = (j == 0) || (j == qb) || (j == qb - 1);
                    key[i] = elig ? (((unsigned long long)__float_as_uint(sc) << 32) | (unsigned long long)(0x1000 - j)) : 0ull; }
                for (int r = 0; r < 13; ++r) {
                    unsigned long long best = key[0];
#pragma unroll
                    for (int i = 1; i < 4; ++i) best = key[i] > best ? key[i] : best;
#pragma unroll
                    for (int o = 32; o >= 1; o >>= 1) { const unsigned long long ot = shx64(best, o, lane); best = ot > best ? ot : best; }
#pragma unroll
                    for (int i = 0; i < 4; ++i) if (key[i] == best && best != 0ull) { taken[i] = true; key[i] = 0ull; }
                }
#pragma unroll
                for (int i = 0; i < 4; ++i) { const unsigned long long bal = __ballot(taken[i]); if (lane == 0) { sel[tk * 8 + 2 * i] = (unsigned)bal; sel[tk * 8 + 2 * i + 1] = (unsigned)(bal >> 32); } }
            }
        }
    }
    __syncthreads();
    attn_reset(st);
    attn_tiles<2>(lds, KVTOK + 2 * 512 + hkv * 128, 2048, KVT + (size_t)(hkv * 128) * S_, S_, 0, qb + 1, qf, st, tpos, qb, w, lane, mfin, linv);
    attn_finish<1>(st, gates, oacc, att, tpos, hkv, lane);
    attn_reset(st);
    attn_tiles<3>(lds, KVTOK + 3 * 512 + hkv * 128, 2048, KVT + (size_t)(512 + hkv * 128) * S_, S_, (qb - 8) > 0 ? (qb - 8) : 0, qb + 1, qf, st, tpos, qb, w, lane, mfin, linv);
    attn_finish<2>(st, gates, oacc, att, tpos, hkv, lane);
}
__device__ __forceinline__ void attn_phase(unsigned char* ws, LAS unsigned char* lds) {
#pragma nounroll
    for (int it = blockIdx.x; it < 1024; it += gridDim.x) {
        const int c = it & 255, r = it >> 8;
        attn_item(ws, lds, r, (r & 1) ? 255 - c : c);
    }
}


#define XB_TMO      128
#define XB_XCNT(j)  (256  + 64 * (j))
#define XB_XSUB(j)  (1280 + 64 * (j))
#define XB_XGEN(j)  (2304 + 64 * (j))
#define XB_TOP      3328
#define XB_TOPGEN   3392
#define XCD_BAR_WORDS 3456
#define XB_SPIN_CAP (1u << 22)
__device__ __forceinline__ unsigned xb_ld(unsigned* p)              { return __hip_atomic_load(p, __ATOMIC_RELAXED, __HIP_MEMORY_SCOPE_AGENT); }
__device__ __forceinline__ unsigned xb_add(unsigned* p, unsigned v) { return __hip_atomic_fetch_add(p, v, __ATOMIC_RELAXED, __HIP_MEMORY_SCOPE_AGENT); }
__device__ __forceinline__ unsigned xb_xcc_id() { return (unsigned)__builtin_amdgcn_s_getreg((3 << 11) | 20) & 0xFu; }
#define XB_SPIN(cond, bar) do { unsigned _sp = 0; while (cond) { __builtin_amdgcn_s_sleep(1); \
    if ((++_sp & 255u) == 0u) { if (xb_ld(&(bar)[XB_TMO])) break; if (_sp > XB_SPIN_CAP) { atomicAdd(&(bar)[XB_TMO], 1u); break; } } } } while (0)
struct XcdBarrier { unsigned* bar; unsigned x; volatile LAS unsigned* st; };
__device__ __forceinline__ XcdBarrier xcd_barrier_post(unsigned* bar, volatile LAS unsigned* st) {
    XcdBarrier b; b.bar = bar; b.x = xb_xcc_id(); b.st = st;
    if (threadIdx.x == 0) (void)xb_add(&bar[XB_XCNT(b.x)], 1u);
    return b;
}
__device__ __forceinline__ void xcd_barrier_complete(unsigned* bar, unsigned x, unsigned& nloc, unsigned& nx) {
    const unsigned G = gridDim.x * gridDim.y * gridDim.z;
    unsigned sum, cnt, mine, sp = 0u;
    for (;;) {
        sum = 0u; cnt = 0u; mine = 0u;
#pragma unroll
        for (unsigned j = 0; j < 16; ++j) { const unsigned c = xb_ld(&bar[XB_XCNT(j)]); sum += c; cnt += (c > 0u) ? 1u : 0u; mine = (j == x) ? c : mine; }
        if (sum == G) break;
        __builtin_amdgcn_s_sleep(1);
        if ((++sp & 255u) == 0u) { if (xb_ld(&bar[XB_TMO])) break; if (sp > XB_SPIN_CAP) { atomicAdd(&bar[XB_TMO], 1u); break; } }
    }
    nloc = mine > 0u ? mine : 1u; nx = cnt > 0u ? cnt : 1u;
}
__device__ __forceinline__ void xcd_barrier(const XcdBarrier& b) {
    asm volatile("s_waitcnt vmcnt(0)" ::: "memory");
    __syncthreads();
    if (threadIdx.x == 0) {
        unsigned* bar = b.bar;
        __builtin_amdgcn_s_waitcnt(0);
        unsigned nloc = b.st[0], nx = b.st[1];
        if (nloc == 0u) { xcd_barrier_complete(bar, b.x, nloc, nx); b.st[0] = nloc; b.st[1] = nx; }
        const unsigned old = xb_add(&bar[XB_XSUB(b.x)], 1u);
        const unsigned gen = old / nloc;
        if (old + 1u == (gen + 1u) * nloc) {
            __builtin_amdgcn_fence(__ATOMIC_RELEASE, "agent");
            asm volatile("s_waitcnt vmcnt(0)" ::: "memory");
            const unsigned og = xb_add(&bar[XB_TOP], 1u);
            const unsigned tg = og / nx;
            if (og + 1u == (tg + 1u) * nx) xb_add(&bar[XB_TOPGEN], 1u);
            else XB_SPIN(xb_ld(&bar[XB_TOPGEN]) == tg, bar);
            __builtin_amdgcn_fence(__ATOMIC_ACQUIRE, "agent");
            xb_add(&bar[XB_XGEN(b.x)], 1u);
            asm volatile("s_waitcnt vmcnt(0)" ::: "memory");
        } else {
            XB_SPIN(xb_ld(&bar[XB_XGEN(b.x)]) == gen, bar);
            __builtin_amdgcn_fence(__ATOMIC_ACQUIRE, "agent");
            asm volatile("s_waitcnt vmcnt(0)" ::: "memory");
        }
    }
    __syncthreads();
}

constexpr int NPH = 23;
__device__ __forceinline__ void run_phase(CP p, int ph, int b, LAS unsigned char* lds) {
    asm volatile("" : "+s"(p));
    unsigned char* ws = p->ws;
    const float* xb = p->x + (size_t)b * S_ * D_; float* hb = p->out + (size_t)b * S_ * D_;
    bf16_t* XN = (bf16_t*)(ws + OFF_XN);
    const int layer = (ph >= 13) ? 1 : 0;
    switch (ph) {
    case 0: prep_phase(p, lds); break;
    case 1: rmsnorm_phase(xb, p->norm_mix, XN, nullptr, nullptr); break;
    case 2: {
        Prob2D<EpiQK> g1{(const char*)XN, (const char*)(ws + OFF_W_RIN), 4096u, 4096u, 32, 64, 16, EpiQK{(bf16_t*)(ws + OFF_Q), (bf16_t*)(ws + OFF_K), (bf16_t*)(ws + OFF_KTD), (const float2*)(ws + OFF_ROPE)}};
        gemm_phase(lds, g1);
        Prob2D<EpiStore> g2{(const char*)(ws + OFF_W_RIN) + (size_t)4096 * 4096, (const char*)XN, 4096u, 4096u, 32, 16, 64, EpiStore{(bf16_t*)(ws + OFF_VT), (size_t)S_}};
        gemm_phase(lds, g2);
    } break;
    case 3: {
        ProbKV g3{(const char*)(ws + OFF_VT), (const char*)(ws + OFF_KTD), (bf16_t*)(ws + OFF_ST), 4};
        gemm_phase(lds, g3);
        ProbS g4{(const char*)(ws + OFF_Q), (const char*)(ws + OFF_K), (bf16_t*)(ws + OFF_SD), 4};
        gemm_phase(lds, g4);
    } break;
    case 4: scan_phase((bf16_t*)(ws + OFF_ST)); break;
    case 5: {
        ProbOut g5{(const char*)(ws + OFF_Q), (const char*)(ws + OFF_ST), (long)OFF_SD - (long)OFF_Q, (long)OFF_VT - (long)OFF_ST, (bf16_t*)(ws + OFF_Y), 8};
        gemm_phase(lds, g5);
    } break;
    case 6: gn_phase((bf16_t*)(ws + OFF_Y), p->ret_gn); break;
    case 7: {
        Prob2D<EpiGate> g6{(const char*)XN, (const char*)(ws + OFF_W_RIN) + (size_t)8192 * 4096, 4096u, 4096u, 32, 64, 16, EpiGate{(bf16_t*)(ws + OFF_Y)}};
        gemm_phase(lds, g6);
    } break;
    case 8: {
        Prob2D<EpiRes> g7{(const char*)(ws + OFF_Y), (const char*)(ws + OFF_W_ROUT), 8192u, 8192u, 64, 64, 8, EpiRes{xb, hb}};
        gemm_phase(lds, g7);
    } break;
    case 9: case 19: rmsnorm_phase(hb, p->norm_ffn + layer * 2048, XN, nullptr, nullptr); break;
    case 10: case 20: {
        Prob2D<EpiStore> g8{(const char*)XN, (const char*)(ws + OFF_W_FIN + (size_t)layer * 32 * MiB), 4096u, 4096u, 32, 64, 32, EpiStore{(bf16_t*)(ws + OFF_U), (size_t)8192}};
        gemm_phase(lds, g8);
    } break;
    case 11: case 21: conv_phase((const bf16_t*)(ws + OFF_U), (bf16_t*)(ws + OFF_AB), p->ffn_conv_w + (size_t)layer * 3 * 8192, p->ffn_conv_b + (size_t)layer * 8192); break;
    case 12: case 22: {
        Prob2D<EpiRes> g9{(const char*)(ws + OFF_AB), (const char*)(ws + OFF_W_FOUT + (size_t)layer * 16 * MiB), 8192u, 8192u, 64, 64, 8, EpiRes{hb, hb}};
        gemm_phase(lds, g9);
    } break;
    case 13: rmsnorm_phase(hb, p->norm_mix + 2048, XN, p->kv_gain, (bf16_t*)(ws + OFF_HN)); break;
    case 14: {
        Prob2D<EpiStore> g10{(const char*)(ws + OFF_HN), (const char*)(ws + OFF_W_KV), 4096u, 4096u, 32, 64, 8, EpiStore{(bf16_t*)(ws + OFF_KVTOK), (size_t)2048}};
        gemm_phase(lds, g10);
        Prob2D<EpiStore> g11{(const char*)(ws + OFF_W_KV) + (size_t)2048 * 4096, (const char*)(ws + OFF_HN), 4096u, 4096u, 32, 4, 64, EpiStore{(bf16_t*)(ws + OFF_KVT), (size_t)S_}};
        gemm_phase(lds, g11);
        Prob2D<EpiQproj> g12{(const char*)XN, (const char*)(ws + OFF_W_Q), 4096u, 4096u, 32, 64, 9, EpiQproj{(bf16_t*)(ws + OFF_QB), (float*)(ws + OFF_GATES)}};
        gemm_phase(lds, g12);
    } break;
    case 15: {
        ProbCmp1 a{(const char*)(ws + OFF_KVTOK), (const char*)(ws + OFF_W_C1K), 8192u, 64, 16, EpiGelu{(bf16_t*)(ws + OFF_H1), (const float*)(ws + OFF_PEB)}};
        gemm_phase(lds, a);
        ProbCmp1 v{(const char*)(ws + OFF_KVTOK) + 1024, (const char*)(ws + OFF_W_C1V), 8192u, 64, 16, EpiGelu{(bf16_t*)(ws + OFF_H1) + 4096 * 256, (const float*)(ws + OFF_PEB) + 256}};
        gemm_phase(lds, v);
    } break;
    case 16: {
        Prob2D<EpiKcmp> a{(const char*)(ws + OFF_H1), (const char*)(ws + OFF_W_C2K), 512u, 512u, 4, 16, 1, EpiKcmp{(bf16_t*)(ws + OFF_KCMP)}};
        gemm_phase(lds, a);
        Prob2D<EpiVcmp> v{(const char*)(ws + OFF_W_C2V), (const char*)(ws + OFF_H1) + (size_t)4096 * 256 * 2, 512u, 512u, 4, 1, 16, EpiVcmp{(bf16_t*)(ws + OFF_VCMPT)}};
        gemm_phase(lds, v);
    } break;
    case 17: attn_phase(ws, lds); break;
    case 18: {
        Prob2D<EpiRes> g{(const char*)(ws + OFF_ATT), (const char*)(ws + OFF_W_O), 4096u, 4096u, 32, 64, 8, EpiRes{hb, hb}};
        gemm_phase(lds, g);
    } break;
    case 23: finalnorm_phase(hb, p->final_gain); break;
    default: break;
    }
}

#if MULTI
__global__ void __launch_bounds__(512) phase_kernel(Params p, int ph, int b) {
    extern __shared__ __attribute__((aligned(16))) unsigned char shm[];
    run_phase((CP)__builtin_amdgcn_kernarg_segment_ptr(), ph, b, (LAS unsigned char*)shm);
}
#else
__global__ void __launch_bounds__(512) mega_kernel(Params p) {
    extern __shared__ __attribute__((aligned(16))) unsigned char shm[];
    cg::grid_group grid = cg::this_grid();
    CP cp = (CP)__builtin_amdgcn_kernarg_segment_ptr();
    volatile LAS unsigned* st = (volatile LAS unsigned*)((LAS unsigned char*)shm + LDS_ST);
    if (threadIdx.x == 0) { st[0] = 0u; st[1] = 0u; st[2] = 0u; st[3] = 0u; }
    __syncthreads();
    XcdBarrier xb = xcd_barrier_post((unsigned*)(cp->ws + OFF_BAR), st);
    run_phase(cp, 0, 0, (LAS unsigned char*)shm);
    grid.sync();
    for (int b = 0; b < 2; ++b)
        for (int ph = 1; ph <= NPH; ++ph) {
#ifdef PROBE_PH
            const int reps = (ph == PROBE_PH || ph == PROBE_PH2) ? 2 : 1;
#else
            const int reps = 1;
#endif
            for (int rep = 0; rep < reps; ++rep) { run_phase(cp, ph, b, (LAS unsigned char*)shm); xcd_barrier(xb); } }
}
#endif

constexpr int LDS_BYTES = LDS_ST + 16;
extern "C" void kernel_launch(void* const* d_in, const int* in_sizes, int n_in, void* d_out, int out_size, void* d_ws, size_t ws_size, hipStream_t stream) {
    static int grid = 0;
    if (grid == 0) {
        if (n_in != 21 || out_size != 2 * S_ * D_ || ws_size < WS_NEED) { fprintf(stderr, "kernel_launch: unexpected shapes/ws (n_in %d out %d ws %zu need %zu)\n", n_in, out_size, ws_size, (size_t)WS_NEED); grid = -1; return; }
#if MULTI
        if (hipFuncSetAttribute((const void*)phase_kernel, hipFuncAttributeMaxDynamicSharedMemorySize, LDS_BYTES) != hipSuccess) { fprintf(stderr, "hipFuncSetAttribute failed\n"); grid = -1; return; }
#else
        if (hipFuncSetAttribute((const void*)mega_kernel, hipFuncAttributeMaxDynamicSharedMemorySize, LDS_BYTES) != hipSuccess) { fprintf(stderr, "hipFuncSetAttribute failed\n"); grid = -1; return; }
#endif
        int dev = 0, cus = 0; hipGetDevice(&dev); hipDeviceGetAttribute(&cus, hipDeviceAttributeMultiprocessorCount, dev);
        grid = cus > 0 ? cus : 256;
    }
    if (grid < 0) return;
    Params p{};
    const float** pp = (const float**)&p;
    for (int i = 0; i < 21; ++i) pp[i] = (const float*)d_in[i];
    p.out = (float*)d_out; p.ws = (unsigned char*)d_ws;
#if MULTI
    hipLaunchKernelGGL(phase_kernel, dim3(grid), dim3(512), LDS_BYTES, stream, p, 0, 0);
    for (int b = 0; b < 2; ++b)
        for (int ph = 1; ph <= NPH; ++ph) hipLaunchKernelGGL(phase_kernel, dim3(grid), dim3(512), LDS_BYTES, stream, p, ph, b);
#else
    if (hipMemsetAsync((unsigned char*)d_ws + OFF_BAR, 0, XCD_BAR_WORDS * 4, stream) != hipSuccess) { fprintf(stderr, "memset failed\n"); return; }
    void* args[] = {&p};
    hipError_t e = hipLaunchCooperativeKernel((const void*)mega_kernel, dim3(grid), dim3(512), args, LDS_BYTES, stream);
    if (e != hipSuccess) fprintf(stderr, "cooperative launch failed: %s (grid %d)\n", hipGetErrorString(e), grid);
#endif
}
```

```cpp
#include <hip/hip_runtime.h>
#include <hip/hip_cooperative_groups.h>
#include <cstdio>
namespace cg = cooperative_groups;

#ifndef MULTI
#define MULTI 0
#endif

#define LAS __attribute__((address_space(3)))
typedef unsigned short bf16_t;
typedef short bf16x8 __attribute__((ext_vector_type(8)));
typedef float f32x4 __attribute__((ext_vector_type(4)));
typedef unsigned u32x2 __attribute__((ext_vector_type(2)));
typedef unsigned u32x4 __attribute__((ext_vector_type(4)));

constexpr int S_ = 16384, D_ = 2048;
constexpr size_t MiB = 1048576;
constexpr size_t OFF_W_RIN = 0, OFF_W_ROUT = 48 * MiB, OFF_W_KV = 64 * MiB, OFF_W_C1K = 76 * MiB, OFF_W_C1V = 78 * MiB,
                 OFF_W_C2K = 80 * MiB, OFF_W_C2V = 80 * MiB + 131072, OFF_W_Q = 81 * MiB, OFF_W_O = 90 * MiB,
                 OFF_W_FIN = 98 * MiB  , OFF_W_FOUT = 162 * MiB  , OFF_ROPE = 194 * MiB, OFF_PEB = 210 * MiB, OFF_BAR = 210 * MiB + 65536,
                 OFF_XN = 211 * MiB, OFF_ACT = 275 * MiB;
constexpr size_t OFF_Q = OFF_ACT, OFF_K = OFF_ACT + 64 * MiB, OFF_KTD = OFF_ACT + 128 * MiB, OFF_VT = OFF_ACT + 192 * MiB,
                 OFF_ST = OFF_ACT + 320 * MiB, OFF_SD = OFF_ACT + 448 * MiB, OFF_Y = OFF_ACT + 512 * MiB, WS_NEED = OFF_ACT + 640 * MiB;
constexpr size_t OFF_U = OFF_ACT, OFF_AB = OFF_ACT + 256 * MiB;
constexpr size_t OFF_HN = OFF_ACT, OFF_KVTOK = OFF_ACT + 64 * MiB, OFF_KVT = OFF_ACT + 129 * MiB, OFF_QB = OFF_ACT + 161 * MiB,
                 OFF_GATES = OFF_ACT + 225 * MiB, OFF_H1 = OFF_ACT + 229 * MiB, OFF_KCMP = OFF_ACT + 233 * MiB, OFF_VCMPT = OFF_ACT + 234 * MiB,
                 OFF_ATT = OFF_ACT + 235 * MiB, OFF_OACC = OFF_ACT + 299 * MiB;

struct Params {
    const float* x; const float* norm_mix; const float* norm_ffn; const float* ret_w_in; const float* ret_gn; const float* ret_w_out;
    const float* kv_gain; const float* w_kv; const float* pe_k; const float* w1_k; const float* w2_k; const float* pe_v; const float* w1_v;
    const float* w2_v; const float* w_q; const float* w_o; const float* ffn_w_in; const float* ffn_conv_w; const float* ffn_conv_b;
    const float* ffn_w_out; const float* final_gain; float* out; unsigned char* ws;
};

typedef const __attribute__((address_space(4))) Params* CP;
__device__ __forceinline__ int ltid() { int t = threadIdx.x; asm volatile("" : "+v"(t)); return t; }
__device__ __forceinline__ unsigned pk_bf16(float lo, float hi) { unsigned r; asm("v_cvt_pk_bf16_f32 %0, %1, %2" : "=v"(r) : "v"(lo), "v"(hi)); return r; }
__device__ __forceinline__ float bflo(unsigned v) { return __uint_as_float(v << 16); }
__device__ __forceinline__ float bfhi(unsigned v) { return __uint_as_float(v & 0xffff0000u); }
__device__ __forceinline__ float fexp2(float x) { return __builtin_amdgcn_exp2f(x); }
__device__ __forceinline__ float frcp(float x) { return __builtin_amdgcn_rcpf(x); }
__device__ __forceinline__ float log2gamma(int h) { return log2f(1.0f - exp2f(-5.0f - (float)h)); }
__device__ __forceinline__ float sigmoidf_(float x) { return frcp(1.0f + fexp2(-1.4426950408889634f * x)); }

constexpr int HTB = 128 * 64 * 2;
__device__ __forceinline__ int lds_byte(int r, int c) { const int st = (r >> 4) * 2 + (c >> 5), rr = r & 15, cc = c & 31, ob = rr * 64 + cc * 2; return st * 1024 + (ob ^ (((ob >> 9) & 1) << 5)); }
__device__ __forceinline__ void stage_rc(int b, int& R, int& C) { const int st = b / 1024, sb = b % 1024, swz = sb ^ (((sb >> 9) & 1) << 5); R = (st >> 1) * 16 + swz / 64; C = (st & 1) * 32 + (swz % 64) / 2; }
__device__ __forceinline__ void tile_order(int L, int nM, int nN, int& pm, int& pn) {
    const int nwg = nM * nN; int wgid = L;
    { const int q = nwg / 8, r = nwg % 8, xcd = wgid % 8, off = wgid / 8; wgid = (xcd < r ? xcd * (q + 1) : r * (q + 1) + (xcd - r) * q) + off; }
    const int nig = 8 * nN, gid = wgid / nig, fm = gid * 8, gsz = (nM - fm) < 8 ? (nM - fm) : 8;
    pm = fm + ((wgid % nig) % gsz); pn = (wgid % nig) / gsz;
}
struct UInfo { const char* a; const char* b; int r0, c0, x0, x1; };
typedef f32x4 AccT[2][2][4][2];

template <class P>
__device__ __forceinline__ void gemm_phase(LAS unsigned char* lds, const P& pb) {
    const int tid = ltid(), wid = __builtin_amdgcn_readfirstlane(tid >> 6), lane = tid & 63, wr = wid >> 2, wc = wid & 3, fr = lane & 15, fq = lane >> 4;
    const int nt = pb.nt, G = gridDim.x, c = blockIdx.x; const long nun = pb.nunits();
    if (c >= nun) return;
    unsigned voffA[2], voffB[2];
#pragma unroll
    for (int i = 0; i < 2; ++i) { int R, C; stage_rc(tid * 16 + i * 8192, R, C); voffA[i] = pb.rowA(R) + (unsigned)C * 2u; const int rho = R & 31; const int Rb = P::PERM ? ((R & ~31) + 8 * ((rho & 15) >> 2) + 4 * (rho >> 4) + (rho & 3)) : R; voffB[i] = (unsigned)Rb * pb.ldb + (unsigned)C * 2u; }
    const size_t hsA = pb.rowA(128), hsB = (size_t)128 * pb.ldb;
    const unsigned ldsw = (unsigned)wid * 1024u;
    const int aoff = lds_byte(wr * 64 + fr, fq * 8), boff = lds_byte(wc * 32 + fr, fq * 8);
#define G_SA(b, h) (((b) * 2 + (h)) * HTB)
#define G_SB(b, h) ((4 + (b) * 2 + (h)) * HTB)
#define G_STAGE(bufoff, gbase, voff) do { _Pragma("unroll") for (int _i = 0; _i < 2; ++_i) \
        __builtin_amdgcn_global_load_lds((const unsigned*)((const char*)(gbase) + (voff)[_i]), (LAS unsigned*)(lds + (bufoff) + ldsw + _i * 8192), 16, 0, 0); } while (0)
#define G_LDA(dst, b, h) do { _Pragma("unroll") for (int m = 0; m < 4; ++m) _Pragma("unroll") for (int k = 0; k < 2; ++k) dst[m][k] = *(const LAS bf16x8*)(lds + G_SA(b, h) + aoff + m * 2048 + k * 1024); } while (0)
#define G_LDB(dst, b, h) do { _Pragma("unroll") for (int n = 0; n < 2; ++n) _Pragma("unroll") for (int k = 0; k < 2; ++k) dst[n][k] = *(const LAS bf16x8*)(lds + G_SB(b, h) + boff + n * 2048 + k * 1024); } while (0)
#define G_MMA(ai, bj, At, Bt) do { __builtin_amdgcn_s_setprio(1); _Pragma("unroll") for (int m = 0; m < 4; ++m) _Pragma("unroll") for (int n = 0; n < 2; ++n) _Pragma("unroll") for (int k = 0; k < 2; ++k) \
        acc[ai][bj][m][n] = __builtin_amdgcn_mfma_f32_16x16x32_bf16(Bt[n][k], At[m][k], acc[ai][bj][m][n], 0, 0, 0); __builtin_amdgcn_s_setprio(0); } while (0)
#define G_WAIT_V(n) asm volatile("s_waitcnt vmcnt(" #n ")" ::: "memory")
#define G_WAIT_L(n) asm volatile("s_waitcnt lgkmcnt(" #n ")" ::: "memory")
#define G_BAR __builtin_amdgcn_s_barrier()
#define G_SCHED __builtin_amdgcn_sched_barrier(0)
    UInfo cur, nxt; int ui = 0;
    pb.unit(c, cur);
    AccT acc;
#pragma unroll
    for (int a = 0; a < 2; ++a)
#pragma unroll
        for (int b = 0; b < 2; ++b)
#pragma unroll
            for (int m = 0; m < 4; ++m)
#pragma unroll
                for (int n = 0; n < 2; ++n) acc[a][b][m][n] = (f32x4){0.f, 0.f, 0.f, 0.f};
    bf16x8 At[4][2], B0[2][2], B1[2][2];
    const char* cA = cur.a; const char* cB = cur.b;
    G_STAGE(G_SB(0, 0), cB + pb.bK(0), voffB); G_STAGE(G_SA(0, 0), cA + pb.aK(0), voffA); G_STAGE(G_SB(0, 1), cB + hsB + pb.bK(0), voffB); G_STAGE(G_SA(0, 1), cA + hsA + pb.aK(0), voffA);
    if (wr == 1) G_BAR;
    G_WAIT_V(4); G_BAR;
    G_STAGE(G_SB(1, 0), cB + pb.bK(1), voffB); G_STAGE(G_SA(1, 0), cA + pb.aK(1), voffA); G_STAGE(G_SB(1, 1), cB + hsB + pb.bK(1), voffB);
    G_WAIT_V(6); G_BAR;
    for (;;) {
        const long Ln = (long)(ui + 1) * G + c; const bool has_next = Ln < nun;
        if (has_next) pb.unit(Ln, nxt);
        const char* nA = has_next ? nxt.a : cA; const char* nB = has_next ? nxt.b : cB;
        for (int t = 0; t < nt; t += 2) {
            const bool last = (t == nt - 2);
            const char* a1 = cA + pb.aK(t + 1);
            const char* a2 = last ? nA + pb.aK(0) : cA + pb.aK(t + 2); const char* b2 = last ? nB + pb.bK(0) : cB + pb.bK(t + 2);
            const char* a3 = last ? nA + pb.aK(1) : cA + pb.aK(t + 3); const char* b3 = last ? nB + pb.bK(1) : cB + pb.bK(t + 3);
            G_LDB(B0, 0, 0); G_SCHED; G_LDA(At, 0, 0); G_STAGE(G_SA(1, 1), a1 + hsA, voffA);
            G_WAIT_L(8); G_BAR; G_WAIT_L(0); G_MMA(0, 0, At, B0); G_BAR; G_SCHED;
            G_LDB(B1, 0, 1); G_STAGE(G_SB(0, 0), b2, voffB);
            G_BAR; G_WAIT_L(0); G_MMA(0, 1, At, B1); G_BAR;
            G_LDA(At, 0, 1); G_STAGE(G_SA(0, 0), a2, voffA);
            G_BAR; G_WAIT_L(0); G_MMA(1, 0, At, B0); G_BAR; G_SCHED;
            G_STAGE(G_SB(0, 1), b2 + hsB, voffB);
            G_WAIT_V(6); G_BAR; G_MMA(1, 1, At, B1); G_BAR;
            G_LDB(B0, 1, 0); G_SCHED; G_LDA(At, 1, 0); G_STAGE(G_SA(0, 1), a2 + hsA, voffA);
            G_WAIT_L(8); G_BAR; G_WAIT_L(0); G_MMA(0, 0, At, B0); G_BAR; G_SCHED;
            G_LDB(B1, 1, 1); G_STAGE(G_SB(1, 0), b3, voffB);
            G_BAR; G_WAIT_L(0); G_MMA(0, 1, At, B1); G_BAR;
            G_LDA(At, 1, 1); G_STAGE(G_SA(1, 0), a3, voffA);
            G_BAR; G_WAIT_L(0); G_MMA(1, 0, At, B0); G_BAR; G_SCHED;
            G_STAGE(G_SB(1, 1), b3 + hsB, voffB);
            G_WAIT_V(6); G_BAR; G_MMA(1, 1, At, B1); G_BAR;
        }
        { const int l2 = ltid() & 63; pb.epi(acc, cur, wr, wc, l2 & 15, l2 >> 4); }
        if (!has_next) break;
#pragma unroll
        for (int a = 0; a < 2; ++a)
#pragma unroll
            for (int b = 0; b < 2; ++b)
#pragma unroll
                for (int m = 0; m < 4; ++m)
#pragma unroll
                    for (int n = 0; n < 2; ++n) acc[a][b][m][n] = (f32x4){0.f, 0.f, 0.f, 0.f};
        cur = nxt; cA = nA; cB = nB; ++ui;
    }
    G_WAIT_V(0);
    if (wr == 0) G_BAR;
    G_BAR;
}

#define EPI_ROWS for (int ai = 0; ai < 2; ++ai) for (int m = 0; m < 4; ++m)
#define EPI_COLS for (int bj = 0; bj < 2; ++bj) for (int n = 0; n < 2; ++n)
#define EPI_ROW (128 * ai + 64 * wr + 16 * m + fr)
#define EPI_COL (128 * bj + 32 * wc + 16 * n + 4 * fq)

template <class Epi> struct Prob2D {
    static constexpr bool PERM = Epi::PERM;
    const char* A; const char* B; unsigned lda, ldb; int nt, nM, nN; Epi e;
    __device__ __forceinline__ long nunits() const { return (long)nM * nN; }
    __device__ __forceinline__ unsigned rowA(int R) const { return (unsigned)R * lda; }
    __device__ __forceinline__ void unit(long L, UInfo& u) const { int pm, pn; tile_order((int)L, nM, nN, pm, pn); u.a = A + (size_t)pm * 256 * lda; u.b = B + (size_t)pn * 256 * ldb; u.r0 = pm * 256; u.c0 = pn * 256; u.x0 = 0; u.x1 = 0; }
    __device__ __forceinline__ size_t aK(int kt) const { return (size_t)kt * 128; }
    __device__ __forceinline__ size_t bK(int kt) const { return (size_t)kt * 128; }
    __device__ __forceinline__ void epi(const AccT& acc, const UInfo& u, int wr, int wc, int fr, int fq) const { e(acc, u, wr, wc, fr, fq); }
};
struct EpiStore { static constexpr bool PERM = true; bf16_t* O; size_t ldc;
    __device__ __forceinline__ void operator()(const AccT& acc, const UInfo& u, int wr, int wc, int fr, int fq) const {
#pragma unroll
        EPI_ROWS { bf16_t* rp = O + (size_t)(u.r0 + EPI_ROW) * ldc + u.c0;
#pragma unroll
            for (int bj = 0; bj < 2; ++bj) { const f32x4 v = acc[ai][bj][m][0], v2 = acc[ai][bj][m][1]; *(u32x4*)(rp + 128 * bj + 32 * wc + 8 * fq) = (u32x4){pk_bf16(v[0], v[1]), pk_bf16(v[2], v[3]), pk_bf16(v2[0], v2[1]), pk_bf16(v2[2], v2[3])}; } }
    } };
struct EpiRes { static constexpr bool PERM = false; const float* R; float* O;
    __device__ __forceinline__ void operator()(const AccT& acc, const UInfo& u, int wr, int wc, int fr, int fq) const {
#pragma unroll
        EPI_ROWS { const size_t ro = (size_t)(u.r0 + EPI_ROW) * 2048 + u.c0;
#pragma unroll
            EPI_COLS { const f32x4 r = *(const f32x4*)(R + ro + EPI_COL); *(f32x4*)(O + ro + EPI_COL) = r + acc[ai][bj][m][n]; } }
    } };
struct EpiGate { static constexpr bool PERM = true; bf16_t* Y;
    __device__ __forceinline__ void operator()(const AccT& acc, const UInfo& u, int wr, int wc, int fr, int fq) const {
#pragma unroll
        EPI_ROWS { bf16_t* rp = Y + (size_t)(u.r0 + EPI_ROW) * 4096 + u.c0;
#pragma unroll
            for (int bj = 0; bj < 2; ++bj) { const f32x4 g = acc[ai][bj][m][0], h = acc[ai][bj][m][1]; bf16_t* cp = rp + 128 * bj + 32 * wc + 8 * fq; const u32x4 y = *(const u32x4*)cp;
                const float o0 = g[0] * sigmoidf_(g[0]) * bflo(y[0]), o1 = g[1] * sigmoidf_(g[1]) * bfhi(y[0]), o2 = g[2] * sigmoidf_(g[2]) * bflo(y[1]), o3 = g[3] * sigmoidf_(g[3]) * bfhi(y[1]);
                const float o4 = h[0] * sigmoidf_(h[0]) * bflo(y[2]), o5 = h[1] * sigmoidf_(h[1]) * bfhi(y[2]), o6 = h[2] * sigmoidf_(h[2]) * bflo(y[3]), o7 = h[3] * sigmoidf_(h[3]) * bfhi(y[3]);
                *(u32x4*)cp = (u32x4){pk_bf16(o0, o1), pk_bf16(o2, o3), pk_bf16(o4, o5), pk_bf16(o6, o7)}; } }
    } };
struct EpiQK { static constexpr bool PERM = false; bf16_t* Q; bf16_t* K; bf16_t* KTD; const float2* rope;
    __device__ __forceinline__ void operator()(const AccT& acc, const UInfo& u, int wr, int wc, int fr, int fq) const {
        const int hidx = u.c0 >> 8; const bool isk = hidx >= 8; const int hh = hidx & 7; const float l2g = log2gamma(hh);
        bf16_t* dst = (isk ? K : Q) + hh * 256; const float sc = isk ? 0.0625f : 1.0f;
#pragma unroll
        EPI_ROWS { const int t = u.r0 + EPI_ROW; const float kd = fexp2((float)(255 - (t & 255)) * l2g);
#pragma unroll
            for (int n = 0; n < 2; ++n) { const int dd = 32 * wc + 16 * n + 4 * fq;
                const f32x4 x1 = acc[ai][0][m][n], x2 = acc[ai][1][m][n]; const f32x4 cs0 = *(const f32x4*)(rope + (size_t)t * 128 + dd), cs1 = *(const f32x4*)(rope + (size_t)t * 128 + dd + 2);
                float y1[4], y2[4];
                y1[0] = (x1[0] * cs0[0] - x2[0] * cs0[1]) * sc; y2[0] = (x1[0] * cs0[1] + x2[0] * cs0[0]) * sc;
                y1[1] = (x1[1] * cs0[2] - x2[1] * cs0[3]) * sc; y2[1] = (x1[1] * cs0[3] + x2[1] * cs0[2]) * sc;
                y1[2] = (x1[2] * cs1[0] - x2[2] * cs1[1]) * sc; y2[2] = (x1[2] * cs1[1] + x2[2] * cs1[0]) * sc;
                y1[3] = (x1[3] * cs1[2] - x2[3] * cs1[3]) * sc; y2[3] = (x1[3] * cs1[3] + x2[3] * cs1[2]) * sc;
                *(u32x2*)(dst + (size_t)t * 2048 + dd) = (u32x2){pk_bf16(y1[0], y1[1]), pk_bf16(y1[2], y1[3])};
                *(u32x2*)(dst + (size_t)t * 2048 + 128 + dd) = (u32x2){pk_bf16(y2[0], y2[1]), pk_bf16(y2[2], y2[3])};
                if (isk) {
#pragma unroll
                    for (int j = 0; j < 4; ++j) { KTD[(size_t)(hh * 256 + dd + j) * S_ + t] = (bf16_t)(pk_bf16(y1[j] * kd, 0.f) & 0xffffu); KTD[(size_t)(hh * 256 + 128 + dd + j) * S_ + t] = (bf16_t)(pk_bf16(y2[j] * kd, 0.f) & 0xffffu); }
                } } }
    } };
struct EpiQproj { static constexpr bool PERM = false; bf16_t* QB; float* gates;
    __device__ __forceinline__ void operator()(const AccT& acc, const UInfo& u, int wr, int wc, int fr, int fq) const {
#pragma unroll
        EPI_ROWS { const int t = u.r0 + EPI_ROW;
#pragma unroll
            EPI_COLS { const int col = u.c0 + EPI_COL; const f32x4 v = acc[ai][bj][m][n];
                if (col < 2048) *(u32x2*)(QB + (size_t)t * 2048 + col) = (u32x2){pk_bf16(v[0] * 0.08838834764831845f, v[1] * 0.08838834764831845f), pk_bf16(v[2] * 0.08838834764831845f, v[3] * 0.08838834764831845f)};
                else if (col < 2096) *(f32x4*)(gates + (size_t)t * 48 + (col - 2048)) = (f32x4){sigmoidf_(v[0]), sigmoidf_(v[1]), sigmoidf_(v[2]), sigmoidf_(v[3])}; } }
    } };
__device__ __forceinline__ float gelu_tanh(float x) { const float y = 0.7978845608028654f * (x + 0.044715f * x * x * x); const float e = fexp2(2.0f * 1.4426950408889634f * y); const float th = 1.0f - 2.0f * frcp(e + 1.0f); return 0.5f * x * (1.0f + th); }
struct EpiGelu { static constexpr bool PERM = false; bf16_t* H; const float* bias;
    __device__ __forceinline__ void operator()(const AccT& acc, const UInfo& u, int wr, int wc, int fr, int fq) const {
#pragma unroll
        EPI_ROWS { bf16_t* rp = H + (size_t)(u.r0 + EPI_ROW) * 256;
#pragma unroll
            EPI_COLS { const int col = EPI_COL; const f32x4 v = acc[ai][bj][m][n]; const f32x4 bb = *(const f32x4*)(bias + col);
                *(u32x2*)(rp + col) = (u32x2){pk_bf16(gelu_tanh(v[0] + bb[0]), gelu_tanh(v[1] + bb[1])), pk_bf16(gelu_tanh(v[2] + bb[2]), gelu_tanh(v[3] + bb[3]))}; } }
    } };
struct EpiKcmp { static constexpr bool PERM = false; bf16_t* KC;
    __device__ __forceinline__ void operator()(const AccT& acc, const UInfo& u, int wr, int wc, int fr, int fq) const {
#pragma unroll
        EPI_ROWS { const int r = u.r0 + EPI_ROW, i = r >> 2, h = r & 3;
#pragma unroll
            for (int n = 0; n < 2; ++n) { const int col = 32 * wc + 16 * n + 4 * fq; f32x4 v = acc[ai][0][m][n]; if (i == 1023) v = (f32x4){0.f, 0.f, 0.f, 0.f};
                *(u32x2*)(KC + ((size_t)h * 1024 + i) * 128 + col) = (u32x2){pk_bf16(v[0], v[1]), pk_bf16(v[2], v[3])}; } }
    } };
struct EpiVcmp { static constexpr bool PERM = false; bf16_t* VC;
    __device__ __forceinline__ void operator()(const AccT& acc, const UInfo& u, int wr, int wc, int fr, int fq) const {
#pragma unroll
        for (int m = 0; m < 4; ++m) { const int d = 64 * wr + 16 * m + fr;
#pragma unroll
            EPI_COLS { const int col = u.c0 + EPI_COL, i = col >> 2; f32x4 v = acc[0][bj][m][n]; if (i == 1023) v = (f32x4){0.f, 0.f, 0.f, 0.f};
#pragma unroll
                for (int h = 0; h < 4; ++h) VC[((size_t)h * 128 + d) * 1024 + i] = (bf16_t)(pk_bf16(v[h], 0.f) & 0xffffu); } }
    } };
struct ProbCmp1 {
    static constexpr bool PERM = false;
    const char* A; const char* B; unsigned ldb; int nt, nM; EpiGelu e;
    __device__ __forceinline__ long nunits() const { return nM; }
    __device__ __forceinline__ unsigned rowA(int R) const { return (unsigned)(R >> 2) * 65536u + (unsigned)(R & 3) * 256u; }
    __device__ __forceinline__ void unit(long L, UInfo& u) const { u.a = A + (size_t)L * 64 * 65536; u.b = B; u.r0 = (int)L * 256; u.c0 = 0; u.x0 = 0; u.x1 = 0; }
    __device__ __forceinline__ size_t aK(int kt) const { return (size_t)(kt >> 1) * 4096 + (size_t)(kt & 1) * 128; }
    __device__ __forceinline__ size_t bK(int kt) const { return (size_t)kt * 128; }
    __device__ __forceinline__ void epi(const AccT& acc, const UInfo& u, int wr, int wc, int fr, int fq) const { e(acc, u, wr, wc, fr, fq); }
};
struct ProbKV {
    static constexpr bool PERM = true;
    const char* VT; const char* KTD; bf16_t* ST; int nt;
    __device__ __forceinline__ long nunits() const { return 8 * 64 * 2; }
    __device__ __forceinline__ unsigned rowA(int R) const { return (unsigned)R * 32768u; }
    static constexpr unsigned ldb = 32768u;
    __device__ __forceinline__ void unit(long L, UInfo& u) const { const int pm = (int)L & 1, c = ((int)L >> 1) & 63, h = (int)L >> 7;
        u.a = VT + ((size_t)(h * 512 + pm * 256) * S_ + c * 256) * 2; u.b = KTD + ((size_t)(h * 256) * S_ + c * 256) * 2; u.r0 = h * 512 + pm * 256; u.c0 = c * 256; u.x0 = 0; u.x1 = 0; }
    __device__ __forceinline__ size_t aK(int kt) const { return (size_t)kt * 128; }
    __device__ __forceinline__ size_t bK(int kt) const { return (size_t)kt * 128; }
    __device__ __forceinline__ void epi(const AccT& acc, const UInfo& u, int wr, int wc, int fr, int fq) const { EpiStore e{ST, (size_t)S_}; e(acc, u, wr, wc, fr, fq); }
};
struct ProbS {
    static constexpr bool PERM = true;
    const char* Q; const char* K; bf16_t* SD; int nt;
    __device__ __forceinline__ long nunits() const { return 8 * 64; }
    __device__ __forceinline__ unsigned rowA(int R) const { return (unsigned)R * 4096u; }
    static constexpr unsigned ldb = 4096u;
    __device__ __forceinline__ void unit(long L, UInfo& u) const { const int c = (int)L & 63, h = (int)L >> 6; const size_t o = ((size_t)(c * 256) * 2048 + h * 256) * 2;
        u.a = Q + o; u.b = K + o; u.r0 = c * 256; u.c0 = h * 256; u.x0 = h; u.x1 = 0; }
    __device__ __forceinline__ size_t aK(int kt) const { return (size_t)kt * 128; }
    __device__ __forceinline__ size_t bK(int kt) const { return (size_t)kt * 128; }
    __device__ __forceinline__ void epi(const AccT& acc, const UInfo& u, int wr, int wc, int fr, int fq) const {
        const float l2g = log2gamma(u.x0);
#pragma unroll
        EPI_ROWS { const int i = EPI_ROW; bf16_t* rp = SD + (size_t)(u.r0 + i) * 2048 + u.c0;
#pragma unroll
            for (int bj = 0; bj < 2; ++bj) { const int s = 128 * bj + 32 * wc + 8 * fq; const f32x4 v = acc[ai][bj][m][0], v2 = acc[ai][bj][m][1]; float o[8];
#pragma unroll
                for (int j = 0; j < 4; ++j) { o[j] = (s + j <= i) ? v[j] * fexp2(-(float)(s + j + 1) * l2g) : 0.f; o[4 + j] = (s + 4 + j <= i) ? v2[j] * fexp2(-(float)(s + 4 + j + 1) * l2g) : 0.f; }
                *(u32x4*)(rp + s) = (u32x4){pk_bf16(o[0], o[1]), pk_bf16(o[2], o[3]), pk_bf16(o[4], o[5]), pk_bf16(o[6], o[7])}; } }
    }
};
struct ProbOut {
    static constexpr bool PERM = true;
    const char* Q; const char* ST; long dA, dB; bf16_t* Y; int nt;
    __device__ __forceinline__ long nunits() const { return 8 * 64 * 2; }
    __device__ __forceinline__ unsigned rowA(int R) const { return (unsigned)R * 4096u; }
    static constexpr unsigned ldb = 32768u;
    __device__ __forceinline__ void unit(long L, UInfo& u) const { const int pn = (int)L & 1, c = ((int)L >> 1) & 63, h = (int)L >> 7;
        u.a = Q + ((size_t)(c * 256) * 2048 + h * 256) * 2; u.b = ST + ((size_t)(h * 512 + pn * 256) * S_ + c * 256) * 2; u.r0 = c * 256; u.c0 = h * 512 + pn * 256; u.x0 = h; u.x1 = 0; }
    __device__ __forceinline__ size_t aK(int kt) const { return kt < 4 ? (size_t)kt * 128 : (size_t)(dA + (long)(kt - 4) * 128); }
    __device__ __forceinline__ size_t bK(int kt) const { return kt < 4 ? (size_t)kt * 128 : (size_t)(dB + (long)(kt - 4) * 128); }
    __device__ __forceinline__ void epi(const AccT& acc, const UInfo& u, int wr, int wc, int fr, int fq) const {
        const float l2g = log2gamma(u.x0);
#pragma unroll
        EPI_ROWS { const int i = EPI_ROW; const float qd = fexp2((float)(i + 1) * l2g); bf16_t* rp = Y + (size_t)(u.r0 + i) * 4096 + u.c0;
#pragma unroll
            for (int bj = 0; bj < 2; ++bj) { const f32x4 v = acc[ai][bj][m][0] * qd, v2 = acc[ai][bj][m][1] * qd; *(u32x4*)(rp + 128 * bj + 32 * wc + 8 * fq) = (u32x4){pk_bf16(v[0], v[1]), pk_bf16(v[2], v[3]), pk_bf16(v2[0], v2[1]), pk_bf16(v2[2], v2[3])}; } }
    }
};

__device__ __forceinline__ float shx(float v, int m, int lane) { return __int_as_float(__builtin_amdgcn_ds_bpermute((lane ^ m) << 2, __float_as_int(v))); }
__device__ __forceinline__ unsigned long long shx64(unsigned long long v, int m, int lane) {
    const unsigned lo = (unsigned)__builtin_amdgcn_ds_bpermute((lane ^ m) << 2, (int)(unsigned)v), hi = (unsigned)__builtin_amdgcn_ds_bpermute((lane ^ m) << 2, (int)(unsigned)(v >> 32));
    return ((unsigned long long)hi << 32) | lo; }
__device__ __forceinline__ float wave_sum(float v, int lane) {
#pragma unroll
    for (int o = 32; o >= 1; o >>= 1) v += shx(v, o, lane);
    return v;
}
__device__ __forceinline__ void transpose_job(const float* __restrict__ src, bf16_t* __restrict__ dst, int K, int N, int Npad, int kvperm, LAS float* tile) {
    const int tk = K / 64, tn = Npad / 64, ntile = tk * tn; const int tid = ltid();
    for (int t = blockIdx.x; t < ntile; t += gridDim.x) {
        const int k0 = (t % tk) * 64, n0 = (t / tk) * 64;
        { const int r0 = tid >> 6, cc = tid & 63;
#pragma unroll
          for (int i = 0; i < 8; ++i) { const int r = r0 + 8 * i, n = n0 + cc; tile[r * 65 + cc] = (n < N) ? src[(size_t)(k0 + r) * N + n] : 0.f; } }
        __syncthreads();
        { const int rr = tid >> 3, cc = (tid & 7) * 8; float v[8];
#pragma unroll
          for (int j = 0; j < 8; ++j) v[j] = tile[(cc + j) * 65 + rr];
          int n = n0 + rr; if (kvperm) { const int j = n >> 9; const int jp = (j == 3) ? 4 : ((j == 4) ? 3 : j); n = jp * 512 + (n & 511); }
          *(u32x4*)(dst + (size_t)n * K + k0 + cc) = (u32x4){pk_bf16(v[0], v[1]), pk_bf16(v[2], v[3]), pk_bf16(v[4], v[5]), pk_bf16(v[6], v[7])}; }
        __syncthreads();
    }
}
__device__ __forceinline__ void prep_phase(CP p, LAS unsigned char* lds) {
    LAS float* tile = (LAS float*)lds; unsigned char* ws = p->ws;
    transpose_job(p->ret_w_in, (bf16_t*)(ws + OFF_W_RIN), 2048, 12288, 12288, 0, tile);
    transpose_job(p->ret_w_out, (bf16_t*)(ws + OFF_W_ROUT), 4096, 2048, 2048, 0, tile);
    transpose_job(p->w_kv, (bf16_t*)(ws + OFF_W_KV), 2048, 3072, 3072, 1, tile);
    transpose_job(p->w1_k, (bf16_t*)(ws + OFF_W_C1K), 4096, 256, 256, 0, tile);
    transpose_job(p->w1_v, (bf16_t*)(ws + OFF_W_C1V), 4096, 256, 256, 0, tile);
    transpose_job(p->w2_k, (bf16_t*)(ws + OFF_W_C2K), 256, 128, 256, 0, tile);
    transpose_job(p->w2_v, (bf16_t*)(ws + OFF_W_C2V), 256, 128, 256, 0, tile);
    transpose_job(p->w_q, (bf16_t*)(ws + OFF_W_Q), 2048, 2096, 2304, 0, tile);
    transpose_job(p->w_o, (bf16_t*)(ws + OFF_W_O), 2048, 2048, 2048, 0, tile);
    transpose_job(p->ffn_w_in, (bf16_t*)(ws + OFF_W_FIN), 2048, 8192, 8192, 0, tile);
    transpose_job(p->ffn_w_in + (size_t)2048 * 8192, (bf16_t*)(ws + OFF_W_FIN + 32 * MiB), 2048, 8192, 8192, 0, tile);
    transpose_job(p->ffn_w_out, (bf16_t*)(ws + OFF_W_FOUT), 4096, 2048, 2048, 0, tile);
    transpose_job(p->ffn_w_out + (size_t)4096 * 2048, (bf16_t*)(ws + OFF_W_FOUT + 16 * MiB), 4096, 2048, 2048, 0, tile);
    { float2* rope = (float2*)(ws + OFF_ROPE); const int gsz = gridDim.x * 512;
      for (int i = blockIdx.x * 512 + ltid(); i < S_ * 128; i += gsz) { const int t = i >> 7, dd = i & 127;
          const float freq = exp2f(-(float)dd * (13.287712379549449f / 128.0f)); const double rev = (double)t * (double)freq * 0.15915494309189535;
          const float fx = (float)(rev - rint(rev)); rope[i] = make_float2(__builtin_amdgcn_cosf(fx), __builtin_amdgcn_sinf(fx)); } }
    if (blockIdx.x < 128) { const int kv = blockIdx.x >> 6, oc = blockIdx.x & 63; const float* pe = kv ? p->pe_v : p->pe_k; const float* w1 = kv ? p->w1_v : p->w1_k; float* peb = (float*)(ws + OFF_PEB) + kv * 256;
        const int tid = ltid(), g = tid >> 7, r = tid & 127, n = 4 * oc + g; float s = 0.f;
#pragma unroll 8
        for (int j = 0; j < 32; ++j) { const int k = r + 128 * j; s += pe[k] * w1[(size_t)k * 256 + n]; }
        s = wave_sum(s, tid & 63);
        __syncthreads(); if ((tid & 63) == 0) tile[tid >> 6] = s; __syncthreads();
        if (tid < 4) peb[4 * oc + tid] = tile[2 * tid] + tile[2 * tid + 1];
        __syncthreads(); }
}
__device__ __forceinline__ void rmsnorm_phase(const float* h, const float* g1, bf16_t* o1, const float* g2, bf16_t* o2) {
    const int w = ltid() >> 6, lane = ltid() & 63;
    for (int row = blockIdx.x * 8 + w; row < S_; row += gridDim.x * 8) {
        const f32x4* p = (const f32x4*)(h + (size_t)row * 2048); f32x4 v[8]; float ss = 0.f;
#pragma unroll
        for (int i = 0; i < 8; ++i) { v[i] = p[lane + 64 * i]; ss += v[i][0] * v[i][0] + v[i][1] * v[i][1] + v[i][2] * v[i][2] + v[i][3] * v[i][3]; }
        ss = wave_sum(ss, lane); const float r = rsqrtf(ss * (1.0f / 2048.0f) + 1e-6f);
#pragma unroll
        for (int i = 0; i < 8; ++i) { const int col = (lane + 64 * i) * 4; const f32x4 g = *(const f32x4*)(g1 + col);
            *(u32x2*)(o1 + (size_t)row * 2048 + col) = (u32x2){pk_bf16(v[i][0] * r * g[0], v[i][1] * r * g[1]), pk_bf16(v[i][2] * r * g[2], v[i][3] * r * g[3])};
            if (o2) { const f32x4 gg = *(const f32x4*)(g2 + col);
                *(u32x2*)(o2 + (size_t)row * 2048 + col) = (u32x2){pk_bf16(v[i][0] * r * gg[0], v[i][1] * r * gg[1]), pk_bf16(v[i][2] * r * gg[2], v[i][3] * r * gg[3])}; } }
    }
}
__device__ __forceinline__ void finalnorm_phase(float* h, const float* g1) {
    const int w = ltid() >> 6, lane = ltid() & 63;
    for (int row = blockIdx.x * 8 + w; row < S_; row += gridDim.x * 8) {
        f32x4* p = (f32x4*)(h + (size_t)row * 2048); f32x4 v[8]; float ss = 0.f;
#pragma unroll
        for (int i = 0; i < 8; ++i) { v[i] = p[lane + 64 * i]; ss += v[i][0] * v[i][0] + v[i][1] * v[i][1] + v[i][2] * v[i][2] + v[i][3] * v[i][3]; }
        ss = wave_sum(ss, lane); const float r = rsqrtf(ss * (1.0f / 2048.0f) + 1e-6f);
#pragma unroll
        for (int i = 0; i < 8; ++i) { const f32x4 g = *(const f32x4*)(g1 + (lane + 64 * i) * 4); p[lane + 64 * i] = v[i] * r * g; }
    }
}
__device__ __forceinline__ void scan_phase(bf16_t* ST) {
    for (int it = blockIdx.x * 512 + ltid(); it < 4096 * 32; it += gridDim.x * 512) {
        const int r = it >> 5, d8 = it & 31; const float cd = fexp2(256.0f * log2gamma(r >> 9));
        bf16_t* p = ST + (size_t)r * S_ + d8 * 8; float s[8];
#pragma unroll
        for (int j = 0; j < 8; ++j) s[j] = 0.f;
        for (int c = 0; c < 64; ++c) { const u32x4 v = *(const u32x4*)(p + c * 256);
            *(u32x4*)(p + c * 256) = (u32x4){pk_bf16(s[0], s[1]), pk_bf16(s[2], s[3]), pk_bf16(s[4], s[5]), pk_bf16(s[6], s[7])};
#pragma unroll
            for (int j = 0; j < 4; ++j) { s[2 * j] = s[2 * j] * cd + bflo(v[j]); s[2 * j + 1] = s[2 * j + 1] * cd + bfhi(v[j]); } }
    }
}
__device__ __forceinline__ void gn_phase(bf16_t* Y, const float* gain) {
    const int w = ltid() >> 6, lane = ltid() & 63;
    for (int g = blockIdx.x * 8 + w; g < S_ * 8; g += gridDim.x * 8) {
        bf16_t* p = Y + (size_t)g * 512 + lane * 8; const u32x4 v = *(const u32x4*)p; float x[8];
#pragma unroll
        for (int j = 0; j < 4; ++j) { x[2 * j] = bflo(v[j]); x[2 * j + 1] = bfhi(v[j]); }
        float s = 0.f;
#pragma unroll
        for (int j = 0; j < 8; ++j) s += x[j];
        const float mu = wave_sum(s, lane) * (1.0f / 512.0f); float q = 0.f;
#pragma unroll
        for (int j = 0; j < 8; ++j) { x[j] -= mu; q += x[j] * x[j]; }
        const float r = rsqrtf(wave_sum(q, lane) * (1.0f / 512.0f) + 1e-6f); const float* gp = gain + (g & 7) * 512 + lane * 8;
        const f32x4 g0 = *(const f32x4*)gp, g1 = *(const f32x4*)(gp + 4);
        *(u32x4*)p = (u32x4){pk_bf16(x[0] * r * g0[0], x[1] * r * g0[1]), pk_bf16(x[2] * r * g0[2], x[3] * r * g0[3]), pk_bf16(x[4] * r * g1[0], x[5] * r * g1[1]), pk_bf16(x[6] * r * g1[2], x[7] * r * g1[3])};
    }
}
__device__ __forceinline__ void conv_phase(const bf16_t* U, bf16_t* AB, const float* cw, const float* cb) {
    for (int it = blockIdx.x * 512 + ltid(); it < 2048 * 512; it += gridDim.x * 512) {
        const int n8 = (it & 511) * 8, t0 = (it >> 9) * 8;
        float wa[3][8], wb[3][8], ba[8], bb[8];
#pragma unroll
        for (int tp = 0; tp < 3; ++tp)
#pragma unroll
            for (int j = 0; j < 8; ++j) { wa[tp][j] = cw[tp * 8192 + n8 + j]; wb[tp][j] = cw[tp * 8192 + 4096 + n8 + j]; }
#pragma unroll
        for (int j = 0; j < 8; ++j) { ba[j] = cb[n8 + j]; bb[j] = cb[4096 + n8 + j]; }
        float pa[2][8], pb[2][8];
#pragma unroll
        for (int k = 0; k < 2; ++k) { const int t = t0 - 2 + k; u32x4 va = (u32x4){0, 0, 0, 0}, vb = (u32x4){0, 0, 0, 0};
            if (t >= 0) { va = *(const u32x4*)(U + (size_t)t * 8192 + n8); vb = *(const u32x4*)(U + (size_t)t * 8192 + 4096 + n8); }
#pragma unroll
            for (int j = 0; j < 4; ++j) { pa[k][2 * j] = bflo(va[j]); pa[k][2 * j + 1] = bfhi(va[j]); pb[k][2 * j] = bflo(vb[j]); pb[k][2 * j + 1] = bfhi(vb[j]); } }
#pragma unroll
        for (int k = 0; k < 8; ++k) { const int t = t0 + k; const u32x4 va = *(const u32x4*)(U + (size_t)t * 8192 + n8), vb = *(const u32x4*)(U + (size_t)t * 8192 + 4096 + n8);
            float xa[8], xb[8], o[8];
#pragma unroll
            for (int j = 0; j < 4; ++j) { xa[2 * j] = bflo(va[j]); xa[2 * j + 1] = bfhi(va[j]); xb[2 * j] = bflo(vb[j]); xb[2 * j + 1] = bfhi(vb[j]); }
#pragma unroll
            for (int j = 0; j < 8; ++j) { const float a = ba[j] + wa[0][j] * pa[0][j] + wa[1][j] * pa[1][j] + wa[2][j] * xa[j]; const float b = bb[j] + wb[0][j] * pb[0][j] + wb[1][j] * pb[1][j] + wb[2][j] * xb[j];
                o[j] = a * sigmoidf_(a) * b; pa[0][j] = pa[1][j]; pa[1][j] = xa[j]; pb[0][j] = pb[1][j]; pb[1][j] = xb[j]; }
            *(u32x4*)(AB + (size_t)t * 4096 + n8) = (u32x4){pk_bf16(o[0], o[1]), pk_bf16(o[2], o[3]), pk_bf16(o[4], o[5]), pk_bf16(o[6], o[7])}; }
    }
}

constexpr int A_KT = 0, A_VT = 17408, A_BUFSZ = 34816, A_PSL = 69632, A_SEL = 69632 + 65536, LDS_ST = 139264;
constexpr float LOG2E = 1.4426950408889634f;
struct AttnState { f32x4 ot[8][2]; float m[2], l[2]; };

template <int MODE>
__device__ __forceinline__ void attn_compute(LAS unsigned char* lds, int boff, int tile, const bf16x8 (&qf)[2][4], AttnState& st, const int (&tpos)[2], int qb, int w, int lane,
                                             const float (&mfin)[2], const float (&linv)[2], bool rs0, bool rs1, bool masked) {
    const int l16 = lane & 15, g4 = lane >> 4;
    f32x4 s[4][2];
#pragma unroll
    for (int mt = 0; mt < 4; ++mt) { s[mt][0] = (f32x4){0.f, 0.f, 0.f, 0.f}; s[mt][1] = (f32x4){0.f, 0.f, 0.f, 0.f}; }
#pragma unroll
    for (int ks = 0; ks < 4; ++ks)
#pragma unroll
        for (int mt = 0; mt < 4; ++mt) { const bf16x8 kf = *(const LAS bf16x8*)(lds + boff + A_KT + (16 * mt + l16) * 272 + ks * 64 + g4 * 16);
            s[mt][0] = __builtin_amdgcn_mfma_f32_16x16x32_bf16(kf, qf[0][ks], s[mt][0], 0, 0, 0);
            s[mt][1] = __builtin_amdgcn_mfma_f32_16x16x32_bf16(kf, qf[1][ks], s[mt][1], 0, 0, 0);
            if (mt == 3 && (ks & 1)) __builtin_amdgcn_sched_barrier(0); }
    if (masked) {
#pragma unroll
        for (int nt = 0; nt < 2; ++nt) { const int t = tpos[nt]; const int tl = w * 8 + nt * 4 + (l16 >> 2);
#pragma unroll
            for (int mt = 0; mt < 4; ++mt)
#pragma unroll
                for (int j = 0; j < 4; ++j) { const int kl = 16 * mt + 4 * g4 + j; const int key = tile * 64 + kl; bool v;
                    if (MODE == 0 || MODE == 1) v = key <= ((t - 31) >> 4);
                    else if (MODE == 2) v = (kl <= tl);
                    else v = (key <= t) && (key > t - 512);
                    s[mt][nt][j] = v ? s[mt][nt][j] : -__builtin_inff(); } }
    }
    bf16x8 pf[2][2];
#pragma unroll
    for (int nt = 0; nt < 2; ++nt) {
        const bool rowsel = nt ? rs1 : rs0;
        const float bias = (MODE == 2 && !rowsel) ? -__builtin_inff() : 0.f;
        float mx = -1e30f;
#pragma unroll
        for (int mt = 0; mt < 4; ++mt)
#pragma unroll
            for (int j = 0; j < 4; ++j) {
                const float sv = s[mt][nt][j] * LOG2E + bias;
                s[mt][nt][j] = sv; mx = fmaxf(mx, sv); }
        float mnew, alpha = 1.f;
        if (MODE == 1) mnew = mfin[nt];
        else { mx = fmaxf(mx, shx(mx, 16, lane)); mx = fmaxf(mx, shx(mx, 32, lane)); mnew = fmaxf(st.m[nt], mx); alpha = fexp2(st.m[nt] - mnew); st.m[nt] = mnew; }
        float ps = 0.f;
#pragma unroll
        for (int mt = 0; mt < 4; ++mt)
#pragma unroll
            for (int j = 0; j < 4; ++j) { float pv = fexp2(s[mt][nt][j] - mnew); if (MODE == 1) pv *= linv[nt]; s[mt][nt][j] = pv; ps += pv; }
        if (MODE != 1) st.l[nt] = st.l[nt] * alpha + ps;
        if (MODE == 2 || MODE == 3) {
#pragma unroll
            for (int md = 0; md < 8; ++md) st.ot[md][nt] = st.ot[md][nt] * alpha;
        }
        if (MODE == 1) {
#pragma unroll
            for (int mt = 0; mt < 4; ++mt) { float a = s[mt][nt][0] + s[mt][nt][1] + s[mt][nt][2] + s[mt][nt][3], lst = s[mt][nt][3];
                a += shx(a, 1, lane); a += shx(a, 2, lane); lst += shx(lst, 1, lane); lst += shx(lst, 2, lane);
                if ((l16 & 3) == 0) { const int jb = tile * 16 + 4 * mt + g4; LAS float* pp = (LAS float*)(lds + A_PSL) + (w * 8 + nt * 4 + (l16 >> 2)) * 256;
                    atomicAdd((float*)(pp + jb), a); if (jb + 1 < 256) atomicAdd((float*)(pp + jb + 1), lst); } }
        }
        if (MODE != 0) {
#pragma unroll
            for (int kk = 0; kk < 2; ++kk) { const u32x4 pk = (u32x4){pk_bf16(s[2 * kk][nt][0], s[2 * kk][nt][1]), pk_bf16(s[2 * kk][nt][2], s[2 * kk][nt][3]), pk_bf16(s[2 * kk + 1][nt][0], s[2 * kk + 1][nt][1]), pk_bf16(s[2 * kk + 1][nt][2], s[2 * kk + 1][nt][3])};
                pf[nt][kk] = __builtin_bit_cast(bf16x8, pk); }
        }
    }
    if (MODE != 0) {
#pragma unroll
        for (int kk = 0; kk < 2; ++kk)
#pragma unroll
            for (int md = 0; md < 8; ++md) { const LAS unsigned char* vb = lds + boff + A_VT + (16 * md + l16) * 136 + kk * 64 + g4 * 8;
                const u32x2 v0 = *(const LAS u32x2*)vb, v1 = *(const LAS u32x2*)(vb + 32); const bf16x8 vf = __builtin_bit_cast(bf16x8, ((u32x4){v0[0], v0[1], v1[0], v1[1]}));
                st.ot[md][0] = __builtin_amdgcn_mfma_f32_16x16x32_bf16(vf, pf[0][kk], st.ot[md][0], 0, 0, 0);
                st.ot[md][1] = __builtin_amdgcn_mfma_f32_16x16x32_bf16(vf, pf[1][kk], st.ot[md][1], 0, 0, 0);
                if (md == 7) __builtin_amdgcn_sched_barrier(0); }
    }
}
template <int MODE>
__device__ __forceinline__ void attn_tiles(LAS unsigned char* lds, const bf16_t* kp, size_t kstride, const bf16_t* vp, size_t vstride, int tile_lo, int tile_hi,
                                           const bf16x8 (&qf)[2][4], AttnState& st, const int (&tpos)[2], int qb, int w, int lane, const float (&mfin)[2], const float (&linv)[2]) {
    if (tile_lo >= tile_hi) return;
    int tid = w * 64 + lane; asm volatile("" : "+v"(tid)); const int l16 = lane & 15;
    const int krow = tid >> 3, kc = (tid & 7) * 16, vrow = tid >> 2, vc = (tid & 3) * 16;
    u32x4 kr0, kr1, vr0 = (u32x4){0, 0, 0, 0}, vr1 = (u32x4){0, 0, 0, 0};
#define A_LOAD(T) do { const bf16_t* kg = kp + (size_t)((T) * 64 + krow) * kstride + kc; kr0 = *(const u32x4*)kg; kr1 = *(const u32x4*)(kg + 8); \
        if (MODE != 0) { const bf16_t* vg = vp + (size_t)vrow * vstride + (T) * 64 + vc; vr0 = *(const u32x4*)vg; vr1 = *(const u32x4*)(vg + 8); } } while (0)
#define A_WRITE(BO) do { LAS unsigned char* kd = lds + (BO) + A_KT + krow * 272 + kc * 2; *(LAS u32x4*)kd = kr0; *(LAS u32x4*)(kd + 16) = kr1; \
        if (MODE != 0) { LAS unsigned char* vd = lds + (BO) + A_VT + vrow * 136 + vc * 2; *(LAS u32x2*)vd = (u32x2){vr0[0], vr0[1]}; *(LAS u32x2*)(vd + 8) = (u32x2){vr0[2], vr0[3]}; *(LAS u32x2*)(vd + 16) = (u32x2){vr1[0], vr1[1]}; *(LAS u32x2*)(vd + 24) = (u32x2){vr1[2], vr1[3]}; } } while (0)
    A_LOAD(tile_lo);
    __syncthreads();
    A_WRITE(0);
    if (tile_lo + 1 < tile_hi) A_LOAD(tile_lo + 1);
    __syncthreads();
    for (int tile = tile_lo; tile < tile_hi; ++tile) {
        const int boff = ((tile - tile_lo) & 1) * A_BUFSZ;
        if (tile + 1 < tile_hi) { A_WRITE(boff ^ A_BUFSZ); if (tile + 2 < tile_hi) A_LOAD(tile + 2); }
        bool rs0 = true, rs1 = true, active = true;
        if (MODE == 2) { const int tw = tile >> 5; const unsigned bit = 1u << (tile & 31);
            const unsigned w0 = *(const LAS unsigned*)(lds + A_SEL + ((w * 8 + (l16 >> 2)) * 8 + tw) * 4), w1 = *(const LAS unsigned*)(lds + A_SEL + ((w * 8 + 4 + (l16 >> 2)) * 8 + tw) * 4);
            rs0 = (w0 & bit) != 0u; rs1 = (w1 & bit) != 0u; active = __ballot(rs0 || rs1) != 0ull; }
        if (active) {
            bool masked;
            if (MODE == 0 || MODE == 1) masked = (tile * 64 + 63 > 4 * qb - 2);
            else if (MODE == 2) masked = (tile == qb);
            else masked = (tile == qb) || (tile <= qb - 8);
            attn_compute<MODE>(lds, boff, tile, qf, st, tpos, qb, w, lane, mfin, linv, rs0, rs1, masked);
        }
        __syncthreads();
    }
#undef A_LOAD
#undef A_WRITE
}
template <int BR>
__device__ __forceinline__ void attn_finish(AttnState& st, const float* gates, float* oacc, bf16_t* att, const int (&tpos)[2], int hkv, int lane) {
    const int l16 = lane & 15, g4 = lane >> 4, g = l16 & 3;
#pragma unroll
    for (int nt = 0; nt < 2; ++nt) {
        const int t = tpos[nt]; float sc = gates[(size_t)t * 48 + (hkv * 4 + g) * 3 + BR];
        if (BR != 0) { float l = st.l[nt]; l += shx(l, 16, lane); l += shx(l, 32, lane); sc = (l > 0.f) ? sc / l : 0.f; }
        const size_t base = (size_t)t * 2048 + (hkv * 4 + g) * 128 + 4 * g4;
#pragma unroll
        for (int md = 0; md < 8; ++md) { f32x4 v = st.ot[md][nt] * sc; float* op = oacc + base + 16 * md;
            if (BR == 0) *(f32x4*)op = v;
            else if (BR == 1) *(f32x4*)op = *(const f32x4*)op + v;
            else { v = v + *(const f32x4*)op; *(u32x2*)(att + base + 16 * md) = (u32x2){pk_bf16(v[0], v[1]), pk_bf16(v[2], v[3])}; } }
    }
}
__device__ __forceinline__ void attn_reset(AttnState& st) {
#pragma unroll
    for (int md = 0; md < 8; ++md) { st.ot[md][0] = (f32x4){0.f, 0.f, 0.f, 0.f}; st.ot[md][1] = (f32x4){0.f, 0.f, 0.f, 0.f}; }
    st.m[0] = st.m[1] = -1e30f; st.l[0] = st.l[1] = 0.f;
}
__device__ __forceinline__ void attn_item(unsigned char* ws, LAS unsigned char* lds, int hkv, int qb) {
    int tid = ltid(); asm volatile("" : "+v"(tid)); const int w = tid >> 6, lane = tid & 63, l16 = lane & 15, g4 = lane >> 4;
    const bf16_t* QB = (const bf16_t*)(ws + OFF_QB); const bf16_t* KVTOK = (const bf16_t*)(ws + OFF_KVTOK); const bf16_t* KVT = (const bf16_t*)(ws + OFF_KVT);
    const bf16_t* KC = (const bf16_t*)(ws + OFF_KCMP); const bf16_t* VC = (const bf16_t*)(ws + OFF_VCMPT);
    const float* gates = (const float*)(ws + OFF_GATES); float* oacc = (float*)(ws + OFF_OACC); bf16_t* att = (bf16_t*)(ws + OFF_ATT);
    int tpos[2]; bf16x8 qf[2][4];
#pragma unroll
    for (int nt = 0; nt < 2; ++nt) { tpos[nt] = qb * 64 + w * 8 + nt * 4 + (l16 >> 2); const bf16_t* qp = QB + (size_t)tpos[nt] * 2048 + (hkv * 4 + (l16 & 3)) * 128 + g4 * 8;
#pragma unroll
        for (int ks = 0; ks < 4; ++ks) qf[nt][ks] = *(const bf16x8*)(qp + ks * 32); }
    __syncthreads();
    { LAS float* pp = (LAS float*)(lds + A_PSL) + w * 2048;
#pragma unroll
      for (int i = 0; i < 32; ++i) pp[lane + 64 * i] = 0.f; }
    AttnState st; float mfin[2] = {0.f, 0.f}, linv[2] = {0.f, 0.f};
    const int ncmp_tiles = (4 * qb + 3 + 63) >> 6;
    attn_reset(st);
    attn_tiles<0>(lds, KC + (size_t)hkv * 1024 * 128, 128, VC, 1024, 0, ncmp_tiles, qf, st, tpos, qb, w, lane, mfin, linv);
#pragma unroll
    for (int nt = 0; nt < 2; ++nt) { float l = st.l[nt]; l += shx(l, 16, lane); l += shx(l, 32, lane); mfin[nt] = st.m[nt]; linv[nt] = (l > 0.f) ? 1.0f / l : 0.f; }
    attn_reset(st);
    attn_tiles<1>(lds, KC + (size_t)hkv * 1024 * 128, 128, VC + (size_t)hkv * 128 * 1024, 1024, 0, ncmp_tiles, qf, st, tpos, qb, w, lane, mfin, linv);
    attn_finish<0>(st, gates, oacc, att, tpos, hkv, lane);
    __syncthreads();
    {
        LAS unsigned* sel = (LAS unsigned*)(lds + A_SEL) + w * 64;
        if (qb < 16) {
            if (lane < 8) { for (int tk = 0; tk < 8; ++tk) { const int lo = lane * 32; unsigned wd = 0; if (qb >= lo + 31) wd = 0xffffffffu; else if (qb >= lo) wd = (2u << (qb - lo)) - 1u; sel[tk * 8 + lane] = wd; } }
        } else {
            for (int tk = 0; tk < 8; ++tk) {
                const LAS float* pp = (const LAS float*)(lds + A_PSL) + (w * 8 + tk) * 256;
                unsigned long long key[4]; bool taken[4];
#pragma unroll
                for (int i = 0; i < 4; ++i) { const int j = lane + 64 * i; const float sc = pp[j]; const bool elig = (j >= 1) && (j <= qb - 2);
                    taken[i] = (j == 0) || (j == qb) || (j == qb - 1);
                    key[i] = elig ? (((unsigned long long)__float_as_uint(sc) << 32) | (unsigned long long)(0x1000 - j)) : 0ull; }
                for (int r = 0; r < 13; ++r) {
                    unsigned long long best = key[0];
#pragma unroll
                    for (int i = 1; i < 4; ++i) best = key[i] > best ? key[i] : best;
#pragma unroll
                    for (int o = 32; o >= 1; o >>= 1) { const unsigned long long ot = shx64(best, o, lane); best = ot > best ? ot : best; }
#pragma unroll
                    for (int i = 0; i < 4; ++i) if (key[i] == best && best != 0ull) { taken[i] = true; key[i] = 0ull; }
                }
#pragma unroll
                for (int i = 0; i < 4; ++i) { const unsigned long long bal = __ballot(taken[i]); if (lane == 0) { sel[tk * 8 + 2 * i] = (unsigned)bal; sel[tk * 8 + 2 * i + 1] = (unsigned)(bal >> 32); } }
            }
        }
    }
    __syncthreads();
    attn_reset(st);
    attn_tiles<2>(lds, KVTOK + 2 * 512 + hkv * 128, 2048, KVT + (size_t)(hkv * 128) * S_, S_, 0, qb + 1, qf, st, tpos, qb, w, lane, mfin, linv);
    attn_finish<1>(st, gates, oacc, att, tpos, hkv, lane);
    attn_reset(st);
    attn_tiles<3>(lds, KVTOK + 3 * 512 + hkv * 128, 2048, KVT + (size_t)(512 + hkv * 128) * S_, S_, (qb - 8) > 0 ? (qb - 8) : 0, qb + 1, qf, st, tpos, qb, w, lane, mfin, linv);
    attn_finish<2>(st, gates, oacc, att, tpos, hkv, lane);
}
__device__ __forceinline__ void attn_phase(unsigned char* ws, LAS unsigned char* lds) {
#pragma nounroll
    for (int it = blockIdx.x; it < 1024; it += gridDim.x) {
        const int c = it & 255, r = it >> 8;
        attn_item(ws, lds, r, (r & 1) ? 255 - c : c);
    }
}


#define XB_TMO      128
#define XB_XCNT(j)  (256  + 64 * (j))
#define XB_XSUB(j)  (1280 + 64 * (j))
#define XB_XGEN(j)  (2304 + 64 * (j))
#define XB_TOP      3328
#define XB_TOPGEN   3392
#define XCD_BAR_WORDS 3456
#define XB_SPIN_CAP (1u << 22)
__device__ __forceinline__ unsigned xb_ld(unsigned* p)              { return __hip_atomic_load(p, __ATOMIC_RELAXED, __HIP_MEMORY_SCOPE_AGENT); }
__device__ __forceinline__ unsigned xb_add(unsigned* p, unsigned v) { return __hip_atomic_fetch_add(p, v, __ATOMIC_RELAXED, __HIP_MEMORY_SCOPE_AGENT); }
__device__ __forceinline__ unsigned xb_xcc_id() { return (unsigned)__builtin_amdgcn_s_getreg((3 << 11) | 20) & 0xFu; }
#define XB_SPIN(cond, bar) do { unsigned _sp = 0; while (cond) { __builtin_amdgcn_s_sleep(1); \
    if ((++_sp & 255u) == 0u) { if (xb_ld(&(bar)[XB_TMO])) break; if (_sp > XB_SPIN_CAP) { atomicAdd(&(bar)[XB_TMO], 1u); break; } } } } while (0)
struct XcdBarrier { unsigned* bar; unsigned x; volatile LAS unsigned* st; };
__device__ __forceinline__ XcdBarrier xcd_barrier_post(unsigned* bar, volatile LAS unsigned* st) {
    XcdBarrier b; b.bar = bar; b.x = xb_xcc_id(); b.st = st;
    if (threadIdx.x == 0) (void)xb_add(&bar[XB_XCNT(b.x)], 1u);
    return b;
}
__device__ __forceinline__ void xcd_barrier_complete(unsigned* bar, unsigned x, unsigned& nloc, unsigned& nx) {
    const unsigned G = gridDim.x * gridDim.y * gridDim.z;
    unsigned sum, cnt, mine, sp = 0u;
    for (;;) {
        sum = 0u; cnt = 0u; mine = 0u;
#pragma unroll
        for (unsigned j = 0; j < 16; ++j) { const unsigned c = xb_ld(&bar[XB_XCNT(j)]); sum += c; cnt += (c > 0u) ? 1u : 0u; mine = (j == x) ? c : mine; }
        if (sum == G) break;
        __builtin_amdgcn_s_sleep(1);
        if ((++sp & 255u) == 0u) { if (xb_ld(&bar[XB_TMO])) break; if (sp > XB_SPIN_CAP) { atomicAdd(&bar[XB_TMO], 1u); break; } }
    }
    nloc = mine > 0u ? mine : 1u; nx = cnt > 0u ? cnt : 1u;
}
__device__ __forceinline__ void xcd_barrier(const XcdBarrier& b) {
    asm volatile("s_waitcnt vmcnt(0)" ::: "memory");
    __syncthreads();
    if (threadIdx.x == 0) {
        unsigned* bar = b.bar;
        __builtin_amdgcn_s_waitcnt(0);
        unsigned nloc = b.st[0], nx = b.st[1];
        if (nloc == 0u) { xcd_barrier_complete(bar, b.x, nloc, nx); b.st[0] = nloc; b.st[1] = nx; }
        const unsigned old = xb_add(&bar[XB_XSUB(b.x)], 1u);
        const unsigned gen = old / nloc;
        if (old + 1u == (gen + 1u) * nloc) {
            __builtin_amdgcn_fence(__ATOMIC_RELEASE, "agent");
            asm volatile("s_waitcnt vmcnt(0)" ::: "memory");
            const unsigned og = xb_add(&bar[XB_TOP], 1u);
            const unsigned tg = og / nx;
            if (og + 1u == (tg + 1u) * nx) xb_add(&bar[XB_TOPGEN], 1u);
            else XB_SPIN(xb_ld(&bar[XB_TOPGEN]) == tg, bar);
            __builtin_amdgcn_fence(__ATOMIC_ACQUIRE, "agent");
            xb_add(&bar[XB_XGEN(b.x)], 1u);
            asm volatile("s_waitcnt vmcnt(0)" ::: "memory");
        } else {
            XB_SPIN(xb_ld(&bar[XB_XGEN(b.x)]) == gen, bar);
            __builtin_amdgcn_fence(__ATOMIC_ACQUIRE, "agent");
            asm volatile("s_waitcnt vmcnt(0)" ::: "memory");
        }
    }
    __syncthreads();
}

constexpr int NPH = 23;
__device__ __forceinline__ void run_phase(CP p, int ph, int b, LAS unsigned char* lds) {
    asm volatile("" : "+s"(p));
    unsigned char* ws = p->ws;
    const float* xb = p->x + (size_t)b * S_ * D_; float* hb = p->out + (size_t)b * S_ * D_;
    bf16_t* XN = (bf16_t*)(ws + OFF_XN);
    const int layer = (ph >= 13) ? 1 : 0;
    switch (ph) {
    case 0: prep_phase(p, lds); break;
    case 1: rmsnorm_phase(xb, p->norm_mix, XN, nullptr, nullptr); break;
    case 2: {
        Prob2D<EpiQK> g1{(const char*)XN, (const char*)(ws + OFF_W_RIN), 4096u, 4096u, 32, 64, 16, EpiQK{(bf16_t*)(ws + OFF_Q), (bf16_t*)(ws + OFF_K), (bf16_t*)(ws + OFF_KTD), (const float2*)(ws + OFF_ROPE)}};
        gemm_phase(lds, g1);
        Prob2D<EpiStore> g2{(const char*)(ws + OFF_W_RIN) + (size_t)4096 * 4096, (const char*)XN, 4096u, 4096u, 32, 16, 64, EpiStore{(bf16_t*)(ws + OFF_VT), (size_t)S_}};
        gemm_phase(lds, g2);
    } break;
    case 3: {
        ProbKV g3{(const char*)(ws + OFF_VT), (const char*)(ws + OFF_KTD), (bf16_t*)(ws + OFF_ST), 4};
        gemm_phase(lds, g3);
        ProbS g4{(const char*)(ws + OFF_Q), (const char*)(ws + OFF_K), (bf16_t*)(ws + OFF_SD), 4};
        gemm_phase(lds, g4);
    } break;
    case 4: scan_phase((bf16_t*)(ws + OFF_ST)); break;
    case 5: {
        ProbOut g5{(const char*)(ws + OFF_Q), (const char*)(ws + OFF_ST), (long)OFF_SD - (long)OFF_Q, (long)OFF_VT - (long)OFF_ST, (bf16_t*)(ws + OFF_Y), 8};
        gemm_phase(lds, g5);
    } break;
    case 6: gn_phase((bf16_t*)(ws + OFF_Y), p->ret_gn); break;
    case 7: {
        Prob2D<EpiGate> g6{(const char*)XN, (const char*)(ws + OFF_W_RIN) + (size_t)8192 * 4096, 4096u, 4096u, 32, 64, 16, EpiGate{(bf16_t*)(ws + OFF_Y)}};
        gemm_phase(lds, g6);
    } break;
    case 8: {
        Prob2D<EpiRes> g7{(const char*)(ws + OFF_Y), (const char*)(ws + OFF_W_ROUT), 8192u, 8192u, 64, 64, 8, EpiRes{xb, hb}};
        gemm_phase(lds, g7);
    } break;
    case 9: case 19: rmsnorm_phase(hb, p->norm_ffn + layer * 2048, XN, nullptr, nullptr); break;
    case 10: case 20: {
        Prob2D<EpiStore> g8{(const char*)XN, (const char*)(ws + OFF_W_FIN + (size_t)layer * 32 * MiB), 4096u, 4096u, 32, 64, 32, EpiStore{(bf16_t*)(ws + OFF_U), (size_t)8192}};
        gemm_phase(lds, g8);
    } break;
    case 11: case 21: conv_phase((const bf16_t*)(ws + OFF_U), (bf16_t*)(ws + OFF_AB), p->ffn_conv_w + (size_t)layer * 3 * 8192, p->ffn_conv_b + (size_t)layer * 8192); break;
    case 12: case 22: {
        Prob2D<EpiRes> g9{(const char*)(ws + OFF_AB), (const char*)(ws + OFF_W_FOUT + (size_t)layer * 16 * MiB), 8192u, 8192u, 64, 64, 8, EpiRes{hb, hb}};
        gemm_phase(lds, g9);
    } break;
    case 13: rmsnorm_phase(hb, p->norm_mix + 2048, XN, p->kv_gain, (bf16_t*)(ws + OFF_HN)); break;
    case 14: {
        Prob2D<EpiStore> g10{(const char*)(ws + OFF_HN), (const char*)(ws + OFF_W_KV), 4096u, 4096u, 32, 64, 8, EpiStore{(bf16_t*)(ws + OFF_KVTOK), (size_t)2048}};
        gemm_phase(lds, g10);
        Prob2D<EpiStore> g11{(const char*)(ws + OFF_W_KV) + (size_t)2048 * 4096, (const char*)(ws + OFF_HN), 4096u, 4096u, 32, 4, 64, EpiStore{(bf16_t*)(ws + OFF_KVT), (size_t)S_}};
        gemm_phase(lds, g11);
        Prob2D<EpiQproj> g12{(const char*)XN, (const char*)(ws + OFF_W_Q), 4096u, 4096u, 32, 64, 9, EpiQproj{(bf16_t*)(ws + OFF_QB), (float*)(ws + OFF_GATES)}};
        gemm_phase(lds, g12);
    } break;
    case 15: {
        ProbCmp1 a{(const char*)(ws + OFF_KVTOK), (const char*)(ws + OFF_W_C1K), 8192u, 64, 16, EpiGelu{(bf16_t*)(ws + OFF_H1), (const float*)(ws + OFF_PEB)}};
        gemm_phase(lds, a);
        ProbCmp1 v{(const char*)(ws + OFF_KVTOK) + 1024, (const char*)(ws + OFF_W_C1V), 8192u, 64, 16, EpiGelu{(bf16_t*)(ws + OFF_H1) + 4096 * 256, (const float*)(ws + OFF_PEB) + 256}};
        gemm_phase(lds, v);
    } break;
    case 16: {
        Prob2D<EpiKcmp> a{(const char*)(ws + OFF_H1), (const char*)(ws + OFF_W_C2K), 512u, 512u, 4, 16, 1, EpiKcmp{(bf16_t*)(ws + OFF_KCMP)}};
        gemm_phase(lds, a);
        Prob2D<EpiVcmp> v{(const char*)(ws + OFF_W_C2V), (const char*)(ws + OFF_H1) + (size_t)4096 * 256 * 2, 512u, 512u, 4, 1, 16, EpiVcmp{(bf16_t*)(ws + OFF_VCMPT)}};
        gemm_phase(lds, v);
    } break;
    case 17: attn_phase(ws, lds); break;
    case 18: {
        Prob2D<EpiRes> g{(const char*)(ws + OFF_ATT), (const char*)(ws + OFF_W_O), 4096u, 4096u, 32, 64, 8, EpiRes{hb, hb}};
        gemm_phase(lds, g);
    } break;
    case 23: finalnorm_phase(hb, p->final_gain); break;
    default: break;
    }
}

#if MULTI
__global__ void __launch_bounds__(512) phase_kernel(Params p, int ph, int b) {
    extern __shared__ __attribute__((aligned(16))) unsigned char shm[];
    run_phase((CP)__builtin_amdgcn_kernarg_segment_ptr(), ph, b, (LAS unsigned char*)shm);
}
#else
__global__ void __launch_bounds__(512) mega_kernel(Params p) {
    extern __shared__ __attribute__((aligned(16))) unsigned char shm[];
    cg::grid_group grid = cg::this_grid();
    CP cp = (CP)__builtin_amdgcn_kernarg_segment_ptr();
    volatile LAS unsigned* st = (volatile LAS unsigned*)((LAS unsigned char*)shm + LDS_ST);
    if (threadIdx.x == 0) { st[0] = 0u; st[1] = 0u; st[2] = 0u; st[3] = 0u; }
    __syncthreads();
    XcdBarrier xb = xcd_barrier_post((unsigned*)(cp->ws + OFF_BAR), st);
    run_phase(cp, 0, 0, (LAS unsigned char*)shm);
    grid.sync();
    for (int b = 0; b < 2; ++b)
        for (int ph = 1; ph <= NPH; ++ph) {
#ifdef PROBE_PH
            const int reps = (ph == PROBE_PH || ph == PROBE_PH2) ? 2 : 1;
#else
            const int reps = 1;
#endif
            for (int rep = 0; rep < reps; ++rep) { run_phase(cp, ph, b, (LAS unsigned char*)shm); xcd_barrier(xb); } }
}
#endif

constexpr int LDS_BYTES = LDS_ST + 16;
extern "C" void kernel_launch(void* const* d_in, const int* in_sizes, int n_in, void* d_out, int out_size, void* d_ws, size_t ws_size, hipStream_t stream) {
    static int grid = 0;
    if (grid == 0) {
        if (n_in != 21 || out_size != 2 * S_ * D_ || ws_size < WS_NEED) { fprintf(stderr, "kernel_launch: unexpected shapes/ws (n_in %d out %d ws %zu need %zu)\n", n_in, out_size, ws_size, (size_t)WS_NEED); grid = -1; return; }
#if MULTI
        if (hipFuncSetAttribute((const void*)phase_kernel, hipFuncAttributeMaxDynamicSharedMemorySize, LDS_BYTES) != hipSuccess) { fprintf(stderr, "hipFuncSetAttribute failed\n"); grid = -1; return; }
#else
        if (hipFuncSetAttribute((const void*)mega_kernel, hipFuncAttributeMaxDynamicSharedMemorySize, LDS_BYTES) != hipSuccess) { fprintf(stderr, "hipFuncSetAttribute failed\n"); grid = -1; return; }
#endif
        int dev = 0, cus = 0; hipGetDevice(&dev); hipDeviceGetAttribute(&cus, hipDeviceAttributeMultiprocessorCount, dev);
        grid = cus > 0 ? cus : 256;
    }
    if (grid < 0) return;
    Params p{};
    const float** pp = (const float**)&p;
    for (int i = 0; i < 21; ++i) pp[i] = (const float*)d_in[i];
    p.out = (float*)d_out; p.ws = (unsigned char*)d_ws;
#if MULTI
    hipLaunchKernelGGL(phase_kernel, dim3(grid), dim3(512), LDS_BYTES, stream, p, 0, 0);
    for (int b = 0; b < 2; ++b)
        for (int ph = 1; ph <= NPH; ++ph) hipLaunchKernelGGL(phase_kernel, dim3(grid), dim3(512), LDS_BYTES, stream, p, ph, b);
#else
    if (hipMemsetAsync((unsigned char*)d_ws + OFF_BAR, 0, XCD_BAR_WORDS * 4, stream) != hipSuccess) { fprintf(stderr, "memset failed\n"); return; }
    void* args[] = {&p};
    hipError_t e = hipLaunchCooperativeKernel((const void*)mega_kernel, dim3(grid), dim3(512), args, LDS_BYTES, stream);
    if (e != hipSuccess) fprintf(stderr, "cooperative launch failed: %s (grid %d)\n", hipGetErrorString(e), grid);
#endif
}
```

```cpp
#include <hip/hip_runtime.h>
#include <hip/hip_cooperative_groups.h>
#include <cstdio>
namespace cg = cooperative_groups;

#ifndef MULTI
#define MULTI 0
#endif

#define LAS __attribute__((address_space(3)))
typedef unsigned short bf16_t;
typedef short bf16x8 __attribute__((ext_vector_type(8)));
typedef float f32x4 __attribute__((ext_vector_type(4)));
typedef unsigned u32x2 __attribute__((ext_vector_type(2)));
typedef unsigned u32x4 __attribute__((ext_vector_type(4)));

constexpr int S_ = 16384, D_ = 2048;
constexpr size_t MiB = 1048576;
constexpr size_t OFF_W_RIN = 0, OFF_W_ROUT = 48 * MiB, OFF_W_KV = 64 * MiB, OFF_W_C1K = 76 * MiB, OFF_W_C1V = 78 * MiB,
                 OFF_W_C2K = 80 * MiB, OFF_W_C2V = 80 * MiB + 131072, OFF_W_Q = 81 * MiB, OFF_W_O = 90 * MiB,
                 OFF_W_FIN = 98 * MiB  , OFF_W_FOUT = 162 * MiB  , OFF_ROPE = 194 * MiB, OFF_PEB = 210 * MiB, OFF_BAR = 210 * MiB + 65536,
                 OFF_XN = 211 * MiB, OFF_ACT = 275 * MiB;
constexpr size_t OFF_Q = OFF_ACT, OFF_K = OFF_ACT + 64 * MiB, OFF_KTD = OFF_ACT + 128 * MiB, OFF_VT = OFF_ACT + 192 * MiB,
                 OFF_ST = OFF_ACT + 320 * MiB, OFF_SD = OFF_ACT + 448 * MiB, OFF_Y = OFF_ACT + 512 * MiB, WS_NEED = OFF_ACT + 640 * MiB;
constexpr size_t OFF_U = OFF_ACT, OFF_AB = OFF_ACT + 256 * MiB;
constexpr size_t OFF_HN = OFF_ACT, OFF_KVTOK = OFF_ACT + 64 * MiB, OFF_KVT = OFF_ACT + 129 * MiB, OFF_QB = OFF_ACT + 161 * MiB,
                 OFF_GATES = OFF_ACT + 225 * MiB, OFF_H1 = OFF_ACT + 229 * MiB, OFF_KCMP = OFF_ACT + 233 * MiB, OFF_VCMPT = OFF_ACT + 234 * MiB,
                 OFF_ATT = OFF_ACT + 235 * MiB, OFF_OACC = OFF_ACT + 299 * MiB;

struct Params {
    const float* x; const float* norm_mix; const float* norm_ffn; const float* ret_w_in; const float* ret_gn; const float* ret_w_out;
    const float* kv_gain; const float* w_kv; const float* pe_k; const float* w1_k; const float* w2_k; const float* pe_v; const float* w1_v;
    const float* w2_v; const float* w_q; const float* w_o; const float* ffn_w_in; const float* ffn_conv_w; const float* ffn_conv_b;
    const float* ffn_w_out; const float* final_gain; float* out; unsigned char* ws;
};

typedef const __attribute__((address_space(4))) Params* CP;
__device__ __forceinline__ int ltid() { int t = threadIdx.x; asm volatile("" : "+v"(t)); return t; }
__device__ __forceinline__ unsigned pk_bf16(float lo, float hi) { unsigned r; asm("v_cvt_pk_bf16_f32 %0, %1, %2" : "=v"(r) : "v"(lo), "v"(hi)); return r; }
__device__ __forceinline__ float bflo(unsigned v) { return __uint_as_float(v << 16); }
__device__ __forceinline__ float bfhi(unsigned v) { return __uint_as_float(v & 0xffff0000u); }
__device__ __forceinline__ float fexp2(float x) { return __builtin_amdgcn_exp2f(x); }
__device__ __forceinline__ float frcp(float x) { return __builtin_amdgcn_rcpf(x); }
__device__ __forceinline__ float log2gamma(int h) { return log2f(1.0f - exp2f(-5.0f - (float)h)); }
__device__ __forceinline__ float sigmoidf_(float x) { return frcp(1.0f + fexp2(-1.4426950408889634f * x)); }

constexpr int HTB = 128 * 64 * 2;
__device__ __forceinline__ int lds_byte(int r, int c) { const int st = (r >> 4) * 2 + (c >> 5), rr = r & 15, cc = c & 31, ob = rr * 64 + cc * 2; return st * 1024 + (ob ^ (((ob >> 9) & 1) << 5)); }
__device__ __forceinline__ void stage_rc(int b, int& R, int& C) { const int st = b / 1024, sb = b % 1024, swz = sb ^ (((sb >> 9) & 1) << 5); R = (st >> 1) * 16 + swz / 64; C = (st & 1) * 32 + (swz % 64) / 2; }
__device__ __forceinline__ void tile_order(int L, int nM, int nN, int& pm, int& pn) {
    const int nwg = nM * nN; int wgid = L;
    { const int q = nwg / 8, r = nwg % 8, xcd = wgid % 8, off = wgid / 8; wgid = (xcd < r ? xcd * (q + 1) : r * (q + 1) + (xcd - r) * q) + off; }
    const int nig = 8 * nN, gid = wgid / nig, fm = gid * 8, gsz = (nM - fm) < 8 ? (nM - fm) : 8;
    pm = fm + ((wgid % nig) % gsz); pn = (wgid % nig) / gsz;
}
struct UInfo { const char* a; const char* b; int r0, c0, x0, x1; };
typedef f32x4 AccT[2][2][4][2];

template <class P>
__device__ __forceinline__ void gemm_phase(LAS unsigned char* lds, const P& pb, int cofs = 0) {
    const int tid = ltid(), wid = __builtin_amdgcn_readfirstlane(tid >> 6), lane = tid & 63, wr = wid >> 2, wc = wid & 3, fr = lane & 15, fq = lane >> 4;
    const int nt = pb.nt, G = gridDim.x, c = (int)blockIdx.x - cofs; const long nun = pb.nunits();
    if (c < 0 || c >= nun) return;
    unsigned voffA[2], voffB[2];
#pragma unroll
    for (int i = 0; i < 2; ++i) { int R, C; stage_rc(tid * 16 + i * 8192, R, C); voffA[i] = pb.rowA(R) + (unsigned)C * 2u; const int rho = R & 31; const int Rb = P::PERM ? ((R & ~31) + 8 * ((rho & 15) >> 2) + 4 * (rho >> 4) + (rho & 3)) : R; voffB[i] = (unsigned)Rb * pb.ldb + (unsigned)C * 2u; }
    const size_t hsA = pb.rowA(128), hsB = (size_t)128 * pb.ldb;
    const unsigned ldsw = (unsigned)wid * 1024u;
    const int aoff = lds_byte(wr * 64 + fr, fq * 8), boff = lds_byte(wc * 32 + fr, fq * 8);
#define G_SA(b, h) (((b) * 2 + (h)) * HTB)
#define G_SB(b, h) ((4 + (b) * 2 + (h)) * HTB)
#define G_STAGE(bufoff, gbase, voff) do { _Pragma("unroll") for (int _i = 0; _i < 2; ++_i) \
        __builtin_amdgcn_global_load_lds((const unsigned*)((const char*)(gbase) + (voff)[_i]), (LAS unsigned*)(lds + (bufoff) + ldsw + _i * 8192), 16, 0, 0); } while (0)
#define G_LDA(dst, b, h) do { _Pragma("unroll") for (int m = 0; m < 4; ++m) _Pragma("unroll") for (int k = 0; k < 2; ++k) dst[m][k] = *(const LAS bf16x8*)(lds + G_SA(b, h) + aoff + m * 2048 + k * 1024); } while (0)
#define G_LDB(dst, b, h) do { _Pragma("unroll") for (int n = 0; n < 2; ++n) _Pragma("unroll") for (int k = 0; k < 2; ++k) dst[n][k] = *(const LAS bf16x8*)(lds + G_SB(b, h) + boff + n * 2048 + k * 1024); } while (0)
#define G_MMA(ai, bj, At, Bt) do { __builtin_amdgcn_s_setprio(1); _Pragma("unroll") for (int m = 0; m < 4; ++m) _Pragma("unroll") for (int n = 0; n < 2; ++n) _Pragma("unroll") for (int k = 0; k < 2; ++k) \
        acc[ai][bj][m][n] = __builtin_amdgcn_mfma_f32_16x16x32_bf16(Bt[n][k], At[m][k], acc[ai][bj][m][n], 0, 0, 0); __builtin_amdgcn_s_setprio(0); } while (0)
#define G_WAIT_V(n) asm volatile("s_waitcnt vmcnt(" #n ")" ::: "memory")
#define G_WAIT_L(n) asm volatile("s_waitcnt lgkmcnt(" #n ")" ::: "memory")
#define G_BAR __builtin_amdgcn_s_barrier()
#define G_SCHED __builtin_amdgcn_sched_barrier(0)
    UInfo cur, nxt; int ui = 0;
    pb.unit(c, cur);
    AccT acc;
#pragma unroll
    for (int a = 0; a < 2; ++a)
#pragma unroll
        for (int b = 0; b < 2; ++b)
#pragma unroll
            for (int m = 0; m < 4; ++m)
#pragma unroll
                for (int n = 0; n < 2; ++n) acc[a][b][m][n] = (f32x4){0.f, 0.f, 0.f, 0.f};
    bf16x8 At[4][2], B0[2][2], B1[2][2];
    const char* cA = cur.a; const char* cB = cur.b;
    G_STAGE(G_SB(0, 0), cB + pb.bK(0), voffB); G_STAGE(G_SA(0, 0), cA + pb.aK(0), voffA); G_STAGE(G_SB(0, 1), cB + hsB + pb.bK(0), voffB); G_STAGE(G_SA(0, 1), cA + hsA + pb.aK(0), voffA);
    if (wr == 1) G_BAR;
    G_WAIT_V(4); G_BAR;
    G_STAGE(G_SB(1, 0), cB + pb.bK(1), voffB); G_STAGE(G_SA(1, 0), cA + pb.aK(1), voffA); G_STAGE(G_SB(1, 1), cB + hsB + pb.bK(1), voffB);
    G_WAIT_V(6); G_BAR;
    for (;;) {
        const long Ln = (long)(ui + 1) * G + c; const bool has_next = Ln < nun;
        if (has_next) pb.unit(Ln, nxt);
        const char* nA = has_next ? nxt.a : cA; const char* nB = has_next ? nxt.b : cB;
        for (int t = 0; t < nt; t += 2) {
            const bool last = (t == nt - 2);
            const char* a1 = cA + pb.aK(t + 1);
            const char* a2 = last ? nA + pb.aK(0) : cA + pb.aK(t + 2); const char* b2 = last ? nB + pb.bK(0) : cB + pb.bK(t + 2);
            const char* a3 = last ? nA + pb.aK(1) : cA + pb.aK(t + 3); const char* b3 = last ? nB + pb.bK(1) : cB + pb.bK(t + 3);
            G_LDB(B0, 0, 0); G_SCHED; G_LDA(At, 0, 0); G_STAGE(G_SA(1, 1), a1 + hsA, voffA);
            G_WAIT_L(8); G_BAR; G_WAIT_L(0); G_MMA(0, 0, At, B0); G_BAR; G_SCHED;
            G_LDB(B1, 0, 1); G_STAGE(G_SB(0, 0), b2, voffB);
            G_BAR; G_WAIT_L(0); G_MMA(0, 1, At, B1); G_BAR;
            G_LDA(At, 0, 1); G_STAGE(G_SA(0, 0), a2, voffA);
            G_BAR; G_WAIT_L(0); G_MMA(1, 0, At, B0); G_BAR; G_SCHED;
            G_STAGE(G_SB(0, 1), b2 + hsB, voffB);
            G_WAIT_V(6); G_BAR; G_MMA(1, 1, At, B1); G_BAR;
            G_LDB(B0, 1, 0); G_SCHED; G_LDA(At, 1, 0); G_STAGE(G_SA(0, 1), a2 + hsA, voffA);
            G_WAIT_L(8); G_BAR; G_WAIT_L(0); G_MMA(0, 0, At, B0); G_BAR; G_SCHED;
            G_LDB(B1, 1, 1); G_STAGE(G_SB(1, 0), b3, voffB);
            G_BAR; G_WAIT_L(0); G_MMA(0, 1, At, B1); G_BAR;
            G_LDA(At, 1, 1); G_STAGE(G_SA(1, 0), a3, voffA);
            G_BAR; G_WAIT_L(0); G_MMA(1, 0, At, B0); G_BAR; G_SCHED;
            G_STAGE(G_SB(1, 1), b3 + hsB, voffB);
            G_WAIT_V(6); G_BAR; G_MMA(1, 1, At, B1); G_BAR;
        }
        { const int l2 = ltid() & 63; pb.epi(acc, cur, wr, wc, l2 & 15, l2 >> 4); }
        if (!has_next) break;
#pragma unroll
        for (int a = 0; a < 2; ++a)
#pragma unroll
            for (int b = 0; b < 2; ++b)
#pragma unroll
                for (int m = 0; m < 4; ++m)
#pragma unroll
                    for (int n = 0; n < 2; ++n) acc[a][b][m][n] = (f32x4){0.f, 0.f, 0.f, 0.f};
        cur = nxt; cA = nA; cB = nB; ++ui;
    }
    G_WAIT_V(0);
    if (wr == 0) G_BAR;
    G_BAR;
}

#define EPI_ROWS for (int ai = 0; ai < 2; ++ai) for (int m = 0; m < 4; ++m)
#define EPI_COLS for (int bj = 0; bj < 2; ++bj) for (int n = 0; n < 2; ++n)
#define EPI_ROW (128 * ai + 64 * wr + 16 * m + fr)
#define EPI_COL (128 * bj + 32 * wc + 16 * n + 4 * fq)

template <class Epi> struct Prob2D {
    static constexpr bool PERM = Epi::PERM;
    const char* A; const char* B; unsigned lda, ldb; int nt, nM, nN; Epi e;
    __device__ __forceinline__ long nunits() const { return (long)nM * nN; }
    __device__ __forceinline__ unsigned rowA(int R) const { return (unsigned)R * lda; }
    __device__ __forceinline__ void unit(long L, UInfo& u) const { int pm, pn; tile_order((int)L, nM, nN, pm, pn); u.a = A + (size_t)pm * 256 * lda; u.b = B + (size_t)pn * 256 * ldb; u.r0 = pm * 256; u.c0 = pn * 256; u.x0 = 0; u.x1 = 0; }
    __device__ __forceinline__ size_t aK(int kt) const { return (size_t)kt * 128; }
    __device__ __forceinline__ size_t bK(int kt) const { return (size_t)kt * 128; }
    __device__ __forceinline__ void epi(const AccT& acc, const UInfo& u, int wr, int wc, int fr, int fq) const { e(acc, u, wr, wc, fr, fq); }
};
struct EpiStore { static constexpr bool PERM = true; bf16_t* O; size_t ldc;
    __device__ __forceinline__ void operator()(const AccT& acc, const UInfo& u, int wr, int wc, int fr, int fq) const {
#pragma unroll
        EPI_ROWS { bf16_t* rp = O + (size_t)(u.r0 + EPI_ROW) * ldc + u.c0;
#pragma unroll
            for (int bj = 0; bj < 2; ++bj) { const f32x4 v = acc[ai][bj][m][0], v2 = acc[ai][bj][m][1]; *(u32x4*)(rp + 128 * bj + 32 * wc + 8 * fq) = (u32x4){pk_bf16(v[0], v[1]), pk_bf16(v[2], v[3]), pk_bf16(v2[0], v2[1]), pk_bf16(v2[2], v2[3])}; } }
    } };
struct EpiRes { static constexpr bool PERM = false; const float* R; float* O;
    __device__ __forceinline__ void operator()(const AccT& acc, const UInfo& u, int wr, int wc, int fr, int fq) const {
#pragma unroll
        EPI_ROWS { const size_t ro = (size_t)(u.r0 + EPI_ROW) * 2048 + u.c0;
#pragma unroll
            EPI_COLS { const f32x4 r = *(const f32x4*)(R + ro + EPI_COL); *(f32x4*)(O + ro + EPI_COL) = r + acc[ai][bj][m][n]; } }
    } };
struct EpiGate { static constexpr bool PERM = true; bf16_t* Y;
    __device__ __forceinline__ void operator()(const AccT& acc, const UInfo& u, int wr, int wc, int fr, int fq) const {
#pragma unroll
        EPI_ROWS { bf16_t* rp = Y + (size_t)(u.r0 + EPI_ROW) * 4096 + u.c0;
#pragma unroll
            for (int bj = 0; bj < 2; ++bj) { const f32x4 g = acc[ai][bj][m][0], h = acc[ai][bj][m][1]; bf16_t* cp = rp + 128 * bj + 32 * wc + 8 * fq; const u32x4 y = *(const u32x4*)cp;
                const float o0 = g[0] * sigmoidf_(g[0]) * bflo(y[0]), o1 = g[1] * sigmoidf_(g[1]) * bfhi(y[0]), o2 = g[2] * sigmoidf_(g[2]) * bflo(y[1]), o3 = g[3] * sigmoidf_(g[3]) * bfhi(y[1]);
                const float o4 = h[0] * sigmoidf_(h[0]) * bflo(y[2]), o5 = h[1] * sigmoidf_(h[1]) * bfhi(y[2]), o6 = h[2] * sigmoidf_(h[2]) * bflo(y[3]), o7 = h[3] * sigmoidf_(h[3]) * bfhi(y[3]);
                *(u32x4*)cp = (u32x4){pk_bf16(o0, o1), pk_bf16(o2, o3), pk_bf16(o4, o5), pk_bf16(o6, o7)}; } }
    } };
struct EpiQK { static constexpr bool PERM = false; bf16_t* Q; bf16_t* K; bf16_t* KTD; const float2* rope;
    __device__ __forceinline__ void operator()(const AccT& acc, const UInfo& u, int wr, int wc, int fr, int fq) const {
        const int hidx = u.c0 >> 8; const bool isk = hidx >= 8; const int hh = hidx & 7; const float l2g = log2gamma(hh);
        bf16_t* dst = (isk ? K : Q) + hh * 256; const float sc = isk ? 0.0625f : 1.0f;
#pragma unroll
        EPI_ROWS { const int t = u.r0 + EPI_ROW; const float kd = fexp2((float)(255 - (t & 255)) * l2g);
#pragma unroll
            for (int n = 0; n < 2; ++n) { const int dd = 32 * wc + 16 * n + 4 * fq;
                const f32x4 x1 = acc[ai][0][m][n], x2 = acc[ai][1][m][n]; const f32x4 cs0 = *(const f32x4*)(rope + (size_t)t * 128 + dd), cs1 = *(const f32x4*)(rope + (size_t)t * 128 + dd + 2);
                float y1[4], y2[4];
                y1[0] = (x1[0] * cs0[0] - x2[0] * cs0[1]) * sc; y2[0] = (x1[0] * cs0[1] + x2[0] * cs0[0]) * sc;
                y1[1] = (x1[1] * cs0[2] - x2[1] * cs0[3]) * sc; y2[1] = (x1[1] * cs0[3] + x2[1] * cs0[2]) * sc;
                y1[2] = (x1[2] * cs1[0] - x2[2] * cs1[1]) * sc; y2[2] = (x1[2] * cs1[1] + x2[2] * cs1[0]) * sc;
                y1[3] = (x1[3] * cs1[2] - x2[3] * cs1[3]) * sc; y2[3] = (x1[3] * cs1[3] + x2[3] * cs1[2]) * sc;
                *(u32x2*)(dst + (size_t)t * 2048 + dd) = (u32x2){pk_bf16(y1[0], y1[1]), pk_bf16(y1[2], y1[3])};
                *(u32x2*)(dst + (size_t)t * 2048 + 128 + dd) = (u32x2){pk_bf16(y2[0], y2[1]), pk_bf16(y2[2], y2[3])};
                if (isk) {
#pragma unroll
                    for (int j = 0; j < 4; ++j) { KTD[(size_t)(hh * 256 + dd + j) * S_ + t] = (bf16_t)(pk_bf16(y1[j] * kd, 0.f) & 0xffffu); KTD[(size_t)(hh * 256 + 128 + dd + j) * S_ + t] = (bf16_t)(pk_bf16(y2[j] * kd, 0.f) & 0xffffu); }
                } } }
    } };
struct EpiQproj { static constexpr bool PERM = false; bf16_t* QB; float* gates;
    __device__ __forceinline__ void operator()(const AccT& acc, const UInfo& u, int wr, int wc, int fr, int fq) const {
#pragma unroll
        EPI_ROWS { const int t = u.r0 + EPI_ROW;
#pragma unroll
            EPI_COLS { const int col = u.c0 + EPI_COL; const f32x4 v = acc[ai][bj][m][n];
                if (col < 2048) *(u32x2*)(QB + (size_t)t * 2048 + col) = (u32x2){pk_bf16(v[0] * 0.08838834764831845f, v[1] * 0.08838834764831845f), pk_bf16(v[2] * 0.08838834764831845f, v[3] * 0.08838834764831845f)};
                else if (col < 2096) *(f32x4*)(gates + (size_t)t * 48 + (col - 2048)) = (f32x4){sigmoidf_(v[0]), sigmoidf_(v[1]), sigmoidf_(v[2]), sigmoidf_(v[3])}; } }
    } };
__device__ __forceinline__ float gelu_tanh(float x) { const float y = 0.7978845608028654f * (x + 0.044715f * x * x * x); const float e = fexp2(2.0f * 1.4426950408889634f * y); const float th = 1.0f - 2.0f * frcp(e + 1.0f); return 0.5f * x * (1.0f + th); }
struct EpiGelu { static constexpr bool PERM = false; bf16_t* H; const float* bias;
    __device__ __forceinline__ void operator()(const AccT& acc, const UInfo& u, int wr, int wc, int fr, int fq) const {
#pragma unroll
        EPI_ROWS { bf16_t* rp = H + (size_t)(u.r0 + EPI_ROW) * 256;
#pragma unroll
            EPI_COLS { const int col = EPI_COL; const f32x4 v = acc[ai][bj][m][n]; const f32x4 bb = *(const f32x4*)(bias + col);
                *(u32x2*)(rp + col) = (u32x2){pk_bf16(gelu_tanh(v[0] + bb[0]), gelu_tanh(v[1] + bb[1])), pk_bf16(gelu_tanh(v[2] + bb[2]), gelu_tanh(v[3] + bb[3]))}; } }
    } };
struct EpiKcmp { static constexpr bool PERM = false; bf16_t* KC;
    __device__ __forceinline__ void operator()(const AccT& acc, const UInfo& u, int wr, int wc, int fr, int fq) const {
#pragma unroll
        EPI_ROWS { const int r = u.r0 + EPI_ROW, i = r >> 2, h = r & 3;
#pragma unroll
            for (int n = 0; n < 2; ++n) { const int col = 32 * wc + 16 * n + 4 * fq; f32x4 v = acc[ai][0][m][n]; if (i == 1023) v = (f32x4){0.f, 0.f, 0.f, 0.f};
                *(u32x2*)(KC + ((size_t)h * 1024 + i) * 128 + col) = (u32x2){pk_bf16(v[0], v[1]), pk_bf16(v[2], v[3])}; } }
    } };
struct EpiVcmp { static constexpr bool PERM = false; bf16_t* VC;
    __device__ __forceinline__ void operator()(const AccT& acc, const UInfo& u, int wr, int wc, int fr, int fq) const {
#pragma unroll
        for (int m = 0; m < 4; ++m) { const int d = 64 * wr + 16 * m + fr;
#pragma unroll
            EPI_COLS { const int col = u.c0 + EPI_COL, i = col >> 2; f32x4 v = acc[0][bj][m][n]; if (i == 1023) v = (f32x4){0.f, 0.f, 0.f, 0.f};
#pragma unroll
                for (int h = 0; h < 4; ++h) VC[((size_t)h * 128 + d) * 1024 + i] = (bf16_t)(pk_bf16(v[h], 0.f) & 0xffffu); } }
    } };
struct ProbCmp1 {
    static constexpr bool PERM = false;
    const char* A; const char* B; unsigned ldb; int nt, nM; EpiGelu e;
    __device__ __forceinline__ long nunits() const { return nM; }
    __device__ __forceinline__ unsigned rowA(int R) const { return (unsigned)(R >> 2) * 65536u + (unsigned)(R & 3) * 256u; }
    __device__ __forceinline__ void unit(long L, UInfo& u) const { u.a = A + (size_t)L * 64 * 65536; u.b = B; u.r0 = (int)L * 256; u.c0 = 0; u.x0 = 0; u.x1 = 0; }
    __device__ __forceinline__ size_t aK(int kt) const { return (size_t)(kt >> 1) * 4096 + (size_t)(kt & 1) * 128; }
    __device__ __forceinline__ size_t bK(int kt) const { return (size_t)kt * 128; }
    __device__ __forceinline__ void epi(const AccT& acc, const UInfo& u, int wr, int wc, int fr, int fq) const { e(acc, u, wr, wc, fr, fq); }
};
struct ProbKV {
    static constexpr bool PERM = true;
    const char* VT; const char* KTD; bf16_t* ST; int nt;
    __device__ __forceinline__ long nunits() const { return 8 * 64 * 2; }
    __device__ __forceinline__ unsigned rowA(int R) const { return (unsigned)R * 32768u; }
    static constexpr unsigned ldb = 32768u;
    __device__ __forceinline__ void unit(long L, UInfo& u) const { const int pm = (int)L & 1, c = ((int)L >> 1) & 63, h = (int)L >> 7;
        u.a = VT + ((size_t)(h * 512 + pm * 256) * S_ + c * 256) * 2; u.b = KTD + ((size_t)(h * 256) * S_ + c * 256) * 2; u.r0 = h * 512 + pm * 256; u.c0 = c * 256; u.x0 = 0; u.x1 = 0; }
    __device__ __forceinline__ size_t aK(int kt) const { return (size_t)kt * 128; }
    __device__ __forceinline__ size_t bK(int kt) const { return (size_t)kt * 128; }
    __device__ __forceinline__ void epi(const AccT& acc, const UInfo& u, int wr, int wc, int fr, int fq) const { EpiStore e{ST, (size_t)S_}; e(acc, u, wr, wc, fr, fq); }
};
struct ProbS {
    static constexpr bool PERM = true;
    const char* Q; const char* K; bf16_t* SD; int nt;
    __device__ __forceinline__ long nunits() const { return 8 * 64; }
    __device__ __forceinline__ unsigned rowA(int R) const { return (unsigned)R * 4096u; }
    static constexpr unsigned ldb = 4096u;
    __device__ __forceinline__ void unit(long L, UInfo& u) const { const int c = (int)L & 63, h = (int)L >> 6; const size_t o = ((size_t)(c * 256) * 2048 + h * 256) * 2;
        u.a = Q + o; u.b = K + o; u.r0 = c * 256; u.c0 = h * 256; u.x0 = h; u.x1 = 0; }
    __device__ __forceinline__ size_t aK(int kt) const { return (size_t)kt * 128; }
    __device__ __forceinline__ size_t bK(int kt) const { return (size_t)kt * 128; }
    __device__ __forceinline__ void epi(const AccT& acc, const UInfo& u, int wr, int wc, int fr, int fq) const {
        const float l2g = log2gamma(u.x0);
#pragma unroll
        EPI_ROWS { const int i = EPI_ROW; bf16_t* rp = SD + (size_t)(u.r0 + i) * 2048 + u.c0;
#pragma unroll
            for (int bj = 0; bj < 2; ++bj) { const int s = 128 * bj + 32 * wc + 8 * fq; const f32x4 v = acc[ai][bj][m][0], v2 = acc[ai][bj][m][1]; float o[8];
#pragma unroll
                for (int j = 0; j < 4; ++j) { o[j] = (s + j <= i) ? v[j] * fexp2(-(float)(s + j + 1) * l2g) : 0.f; o[4 + j] = (s + 4 + j <= i) ? v2[j] * fexp2(-(float)(s + 4 + j + 1) * l2g) : 0.f; }
                *(u32x4*)(rp + s) = (u32x4){pk_bf16(o[0], o[1]), pk_bf16(o[2], o[3]), pk_bf16(o[4], o[5]), pk_bf16(o[6], o[7])}; } }
    }
};
struct ProbOut {
    static constexpr bool PERM = true;
    const char* Q; const char* ST; long dA, dB; bf16_t* Y; int nt;
    __device__ __forceinline__ long nunits() const { return 8 * 64 * 2; }
    __device__ __forceinline__ unsigned rowA(int R) const { return (unsigned)R * 4096u; }
    static constexpr unsigned ldb = 32768u;
    __device__ __forceinline__ void unit(long L, UInfo& u) const { const int pn = (int)L & 1, c = ((int)L >> 1) & 63, h = (int)L >> 7;
        u.a = Q + ((size_t)(c * 256) * 2048 + h * 256) * 2; u.b = ST + ((size_t)(h * 512 + pn * 256) * S_ + c * 256) * 2; u.r0 = c * 256; u.c0 = h * 512 + pn * 256; u.x0 = h; u.x1 = 0; }
    __device__ __forceinline__ size_t aK(int kt) const { return kt < 4 ? (size_t)kt * 128 : (size_t)(dA + (long)(kt - 4) * 128); }
    __device__ __forceinline__ size_t bK(int kt) const { return kt < 4 ? (size_t)kt * 128 : (size_t)(dB + (long)(kt - 4) * 128); }
    __device__ __forceinline__ void epi(const AccT& acc, const UInfo& u, int wr, int wc, int fr, int fq) const {
        const float l2g = log2gamma(u.x0);
#pragma unroll
        EPI_ROWS { const int i = EPI_ROW; const float qd = fexp2((float)(i + 1) * l2g); bf16_t* rp = Y + (size_t)(u.r0 + i) * 4096 + u.c0;
#pragma unroll
            for (int bj = 0; bj < 2; ++bj) { const f32x4 v = acc[ai][bj][m][0] * qd, v2 = acc[ai][bj][m][1] * qd; *(u32x4*)(rp + 128 * bj + 32 * wc + 8 * fq) = (u32x4){pk_bf16(v[0], v[1]), pk_bf16(v[2], v[3]), pk_bf16(v2[0], v2[1]), pk_bf16(v2[2], v2[3])}; } }
    }
};

__device__ __forceinline__ float shx(float v, int m, int lane) { return __int_as_float(__builtin_amdgcn_ds_bpermute((lane ^ m) << 2, __float_as_int(v))); }
__device__ __forceinline__ unsigned long long shx64(unsigned long long v, int m, int lane) {
    const unsigned lo = (unsigned)__builtin_amdgcn_ds_bpermute((lane ^ m) << 2, (int)(unsigned)v), hi = (unsigned)__builtin_amdgcn_ds_bpermute((lane ^ m) << 2, (int)(unsigned)(v >> 32));
    return ((unsigned long long)hi << 32) | lo; }
__device__ __forceinline__ float wave_sum(float v, int lane) {
#pragma unroll
    for (int o = 32; o >= 1; o >>= 1) v += shx(v, o, lane);
    return v;
}
__device__ __forceinline__ void transpose_job(const float* __restrict__ src, bf16_t* __restrict__ dst, int K, int N, int Npad, int kvperm, LAS float* tile) {
    const int tk = K / 64, tn = Npad / 64, ntile = tk * tn; const int tid = ltid();
    for (int t = blockIdx.x; t < ntile; t += gridDim.x) {
        const int k0 = (t % tk) * 64, n0 = (t / tk) * 64;
        { const int r0 = tid >> 6, cc = tid & 63;
#pragma unroll
          for (int i = 0; i < 8; ++i) { const int r = r0 + 8 * i, n = n0 + cc; tile[r * 65 + cc] = (n < N) ? src[(size_t)(k0 + r) * N + n] : 0.f; } }
        __syncthreads();
        { const int rr = tid >> 3, cc = (tid & 7) * 8; float v[8];
#pragma unroll
          for (int j = 0; j < 8; ++j) v[j] = tile[(cc + j) * 65 + rr];
          int n = n0 + rr; if (kvperm) { const int j = n >> 9; const int jp = (j == 3) ? 4 : ((j == 4) ? 3 : j); n = jp * 512 + (n & 511); }
          *(u32x4*)(dst + (size_t)n * K + k0 + cc) = (u32x4){pk_bf16(v[0], v[1]), pk_bf16(v[2], v[3]), pk_bf16(v[4], v[5]), pk_bf16(v[6], v[7])}; }
        __syncthreads();
    }
}
__device__ __forceinline__ void prep_phase(CP p, LAS unsigned char* lds) {
    LAS float* tile = (LAS float*)lds; unsigned char* ws = p->ws;
    transpose_job(p->ret_w_in, (bf16_t*)(ws + OFF_W_RIN), 2048, 12288, 12288, 0, tile);
    transpose_job(p->ret_w_out, (bf16_t*)(ws + OFF_W_ROUT), 4096, 2048, 2048, 0, tile);
    transpose_job(p->w_kv, (bf16_t*)(ws + OFF_W_KV), 2048, 3072, 3072, 1, tile);
    transpose_job(p->w1_k, (bf16_t*)(ws + OFF_W_C1K), 4096, 256, 256, 0, tile);
    transpose_job(p->w1_v, (bf16_t*)(ws + OFF_W_C1V), 4096, 256, 256, 0, tile);
    transpose_job(p->w2_k, (bf16_t*)(ws + OFF_W_C2K), 256, 128, 256, 0, tile);
    transpose_job(p->w2_v, (bf16_t*)(ws + OFF_W_C2V), 256, 128, 256, 0, tile);
    transpose_job(p->w_q, (bf16_t*)(ws + OFF_W_Q), 2048, 2096, 2304, 0, tile);
    transpose_job(p->w_o, (bf16_t*)(ws + OFF_W_O), 2048, 2048, 2048, 0, tile);
    transpose_job(p->ffn_w_in, (bf16_t*)(ws + OFF_W_FIN), 2048, 8192, 8192, 0, tile);
    transpose_job(p->ffn_w_in + (size_t)2048 * 8192, (bf16_t*)(ws + OFF_W_FIN + 32 * MiB), 2048, 8192, 8192, 0, tile);
    transpose_job(p->ffn_w_out, (bf16_t*)(ws + OFF_W_FOUT), 4096, 2048, 2048, 0, tile);
    transpose_job(p->ffn_w_out + (size_t)4096 * 2048, (bf16_t*)(ws + OFF_W_FOUT + 16 * MiB), 4096, 2048, 2048, 0, tile);
    { float2* rope = (float2*)(ws + OFF_ROPE); const int gsz = gridDim.x * 512;
      for (int i = blockIdx.x * 512 + ltid(); i < S_ * 128; i += gsz) { const int t = i >> 7, dd = i & 127;
          const float freq = exp2f(-(float)dd * (13.287712379549449f / 128.0f)); const double rev = (double)t * (double)freq * 0.15915494309189535;
          const float fx = (float)(rev - rint(rev)); rope[i] = make_float2(__builtin_amdgcn_cosf(fx), __builtin_amdgcn_sinf(fx)); } }
    if (blockIdx.x < 128) { const int kv = blockIdx.x >> 6, oc = blockIdx.x & 63; const float* pe = kv ? p->pe_v : p->pe_k; const float* w1 = kv ? p->w1_v : p->w1_k; float* peb = (float*)(ws + OFF_PEB) + kv * 256;
        const int tid = ltid(), g = tid >> 7, r = tid & 127, n = 4 * oc + g; float s = 0.f;
#pragma unroll 8
        for (int j = 0; j < 32; ++j) { const int k = r + 128 * j; s += pe[k] * w1[(size_t)k * 256 + n]; }
        s = wave_sum(s, tid & 63);
        __syncthreads(); if ((tid & 63) == 0) tile[tid >> 6] = s; __syncthreads();
        if (tid < 4) peb[4 * oc + tid] = tile[2 * tid] + tile[2 * tid + 1];
        __syncthreads(); }
}
__device__ __forceinline__ void rmsnorm_phase(const float* h, const float* g1, bf16_t* o1, const float* g2, bf16_t* o2) {
    const int w = ltid() >> 6, lane = ltid() & 63;
    for (int row = blockIdx.x * 8 + w; row < S_; row += gridDim.x * 8) {
        const f32x4* p = (const f32x4*)(h + (size_t)row * 2048); f32x4 v[8]; float ss = 0.f;
#pragma unroll
        for (int i = 0; i < 8; ++i) { v[i] = p[lane + 64 * i]; ss += v[i][0] * v[i][0] + v[i][1] * v[i][1] + v[i][2] * v[i][2] + v[i][3] * v[i][3]; }
        ss = wave_sum(ss, lane); const float r = rsqrtf(ss * (1.0f / 2048.0f) + 1e-6f);
#pragma unroll
        for (int i = 0; i < 8; ++i) { const int col = (lane + 64 * i) * 4; const f32x4 g = *(const f32x4*)(g1 + col);
            *(u32x2*)(o1 + (size_t)row * 2048 + col) = (u32x2){pk_bf16(v[i][0] * r * g[0], v[i][1] * r * g[1]), pk_bf16(v[i][2] * r * g[2], v[i][3] * r * g[3])};
            if (o2) { const f32x4 gg = *(const f32x4*)(g2 + col);
                *(u32x2*)(o2 + (size_t)row * 2048 + col) = (u32x2){pk_bf16(v[i][0] * r * gg[0], v[i][1] * r * gg[1]), pk_bf16(v[i][2] * r * gg[2], v[i][3] * r * gg[3])}; } }
    }
}
__device__ __forceinline__ void finalnorm_phase(float* h, const float* g1) {
    const int w = ltid() >> 6, lane = ltid() & 63;
    for (int row = blockIdx.x * 8 + w; row < S_; row += gridDim.x * 8) {
        f32x4* p = (f32x4*)(h + (size_t)row * 2048); f32x4 v[8]; float ss = 0.f;
#pragma unroll
        for (int i = 0; i < 8; ++i) { v[i] = p[lane + 64 * i]; ss += v[i][0] * v[i][0] + v[i][1] * v[i][1] + v[i][2] * v[i][2] + v[i][3] * v[i][3]; }
        ss = wave_sum(ss, lane); const float r = rsqrtf(ss * (1.0f / 2048.0f) + 1e-6f);
#pragma unroll
        for (int i = 0; i < 8; ++i) { const f32x4 g = *(const f32x4*)(g1 + (lane + 64 * i) * 4); p[lane + 64 * i] = v[i] * r * g; }
    }
}
__device__ __forceinline__ void scan_phase(bf16_t* ST) {
    for (int it = blockIdx.x * 512 + ltid(); it < 4096 * 32; it += gridDim.x * 512) {
        const int r = it >> 5, d8 = it & 31; const float cd = fexp2(256.0f * log2gamma(r >> 9));
        bf16_t* p = ST + (size_t)r * S_ + d8 * 8; float s[8];
#pragma unroll
        for (int j = 0; j < 8; ++j) s[j] = 0.f;
        for (int c = 0; c < 64; ++c) { const u32x4 v = *(const u32x4*)(p + c * 256);
            *(u32x4*)(p + c * 256) = (u32x4){pk_bf16(s[0], s[1]), pk_bf16(s[2], s[3]), pk_bf16(s[4], s[5]), pk_bf16(s[6], s[7])};
#pragma unroll
            for (int j = 0; j < 4; ++j) { s[2 * j] = s[2 * j] * cd + bflo(v[j]); s[2 * j + 1] = s[2 * j + 1] * cd + bfhi(v[j]); } }
    }
}
__device__ __forceinline__ void gn_phase(bf16_t* Y, const float* gain) {
    const int w = ltid() >> 6, lane = ltid() & 63;
    for (int g = blockIdx.x * 8 + w; g < S_ * 8; g += gridDim.x * 8) {
        bf16_t* p = Y + (size_t)g * 512 + lane * 8; const u32x4 v = *(const u32x4*)p; float x[8];
#pragma unroll
        for (int j = 0; j < 4; ++j) { x[2 * j] = bflo(v[j]); x[2 * j + 1] = bfhi(v[j]); }
        float s = 0.f;
#pragma unroll
        for (int j = 0; j < 8; ++j) s += x[j];
        const float mu = wave_sum(s, lane) * (1.0f / 512.0f); float q = 0.f;
#pragma unroll
        for (int j = 0; j < 8; ++j) { x[j] -= mu; q += x[j] * x[j]; }
        const float r = rsqrtf(wave_sum(q, lane) * (1.0f / 512.0f) + 1e-6f); const float* gp = gain + (g & 7) * 512 + lane * 8;
        const f32x4 g0 = *(const f32x4*)gp, g1 = *(const f32x4*)(gp + 4);
        *(u32x4*)p = (u32x4){pk_bf16(x[0] * r * g0[0], x[1] * r * g0[1]), pk_bf16(x[2] * r * g0[2], x[3] * r * g0[3]), pk_bf16(x[4] * r * g1[0], x[5] * r * g1[1]), pk_bf16(x[6] * r * g1[2], x[7] * r * g1[3])};
    }
}
__device__ __forceinline__ void conv_phase(const bf16_t* U, bf16_t* AB, const float* cw, const float* cb) {
    for (int it = blockIdx.x * 512 + ltid(); it < 512 * 512; it += gridDim.x * 512) {
        const int n8 = (it & 511) * 8, t0 = (it >> 9) * 32;
        float wa[3][8], wb[3][8], ba[8], bb[8];
#pragma unroll
        for (int tp = 0; tp < 3; ++tp)
#pragma unroll
            for (int j = 0; j < 8; ++j) { wa[tp][j] = cw[tp * 8192 + n8 + j]; wb[tp][j] = cw[tp * 8192 + 4096 + n8 + j]; }
#pragma unroll
        for (int j = 0; j < 8; ++j) { ba[j] = cb[n8 + j]; bb[j] = cb[4096 + n8 + j]; }
        float pa[2][8], pb[2][8];
#pragma unroll
        for (int k = 0; k < 2; ++k) { const int t = t0 - 2 + k; u32x4 va = (u32x4){0, 0, 0, 0}, vb = (u32x4){0, 0, 0, 0};
            if (t >= 0) { va = *(const u32x4*)(U + (size_t)t * 8192 + n8); vb = *(const u32x4*)(U + (size_t)t * 8192 + 4096 + n8); }
#pragma unroll
            for (int j = 0; j < 4; ++j) { pa[k][2 * j] = bflo(va[j]); pa[k][2 * j + 1] = bfhi(va[j]); pb[k][2 * j] = bflo(vb[j]); pb[k][2 * j + 1] = bfhi(vb[j]); } }
#pragma unroll 8
        for (int k = 0; k < 32; ++k) { const int t = t0 + k; const u32x4 va = *(const u32x4*)(U + (size_t)t * 8192 + n8), vb = *(const u32x4*)(U + (size_t)t * 8192 + 4096 + n8);
            float xa[8], xb[8], o[8];
#pragma unroll
            for (int j = 0; j < 4; ++j) { xa[2 * j] = bflo(va[j]); xa[2 * j + 1] = bfhi(va[j]); xb[2 * j] = bflo(vb[j]); xb[2 * j + 1] = bfhi(vb[j]); }
#pragma unroll
            for (int j = 0; j < 8; ++j) { const float a = ba[j] + wa[0][j] * pa[0][j] + wa[1][j] * pa[1][j] + wa[2][j] * xa[j]; const float b = bb[j] + wb[0][j] * pb[0][j] + wb[1][j] * pb[1][j] + wb[2][j] * xb[j];
                o[j] = a * sigmoidf_(a) * b; pa[0][j] = pa[1][j]; pa[1][j] = xa[j]; pb[0][j] = pb[1][j]; pb[1][j] = xb[j]; }
            *(u32x4*)(AB + (size_t)t * 4096 + n8) = (u32x4){pk_bf16(o[0], o[1]), pk_bf16(o[2], o[3]), pk_bf16(o[4], o[5]), pk_bf16(o[6], o[7])}; }
    }
}

constexpr int A_KT = 0, A_VT = 17408, A_BUFSZ = 34816, A_PSL = 69632, A_SEL = 69632 + 65536, LDS_ST = 139264;
constexpr float LOG2E = 1.4426950408889634f;
struct AttnState { f32x4 ot[8][2]; float m[2], l[2]; };

template <int MODE>
__device__ __forceinline__ void attn_compute(LAS unsigned char* lds, int boff, int tile, const bf16x8 (&qf)[2][4], AttnState& st, const int (&tpos)[2], int qb, int w, int lane,
                                             const float (&mfin)[2], const float (&linv)[2], bool rs0, bool rs1, bool masked) {
    const int l16 = lane & 15, g4 = lane >> 4;
    f32x4 s[4][2];
#pragma unroll
    for (int mt = 0; mt < 4; ++mt) { s[mt][0] = (f32x4){0.f, 0.f, 0.f, 0.f}; s[mt][1] = (f32x4){0.f, 0.f, 0.f, 0.f}; }
#pragma unroll
    for (int ks = 0; ks < 4; ++ks)
#pragma unroll
        for (int mt = 0; mt < 4; ++mt) { const bf16x8 kf = *(const LAS bf16x8*)(lds + boff + A_KT + (16 * mt + l16) * 272 + ks * 64 + g4 * 16);
            s[mt][0] = __builtin_amdgcn_mfma_f32_16x16x32_bf16(kf, qf[0][ks], s[mt][0], 0, 0, 0);
            s[mt][1] = __builtin_amdgcn_mfma_f32_16x16x32_bf16(kf, qf[1][ks], s[mt][1], 0, 0, 0);
            if (mt == 3 && (ks & 1)) __builtin_amdgcn_sched_barrier(0); }
    if (masked) {
#pragma unroll
        for (int nt = 0; nt < 2; ++nt) { const int t = tpos[nt]; const int tl = w * 8 + nt * 4 + (l16 >> 2);
#pragma unroll
            for (int mt = 0; mt < 4; ++mt)
#pragma unroll
                for (int j = 0; j < 4; ++j) { const int kl = 16 * mt + 4 * g4 + j; const int key = tile * 64 + kl; bool v;
                    if (MODE == 0 || MODE == 1) v = key <= ((t - 31) >> 4);
                    else if (MODE == 2) v = (kl <= tl);
                    else v = (key <= t) && (key > t - 512);
                    s[mt][nt][j] = v ? s[mt][nt][j] : -__builtin_inff(); } }
    }
    bf16x8 pf[2][2];
#pragma unroll
    for (int nt = 0; nt < 2; ++nt) {
        const bool rowsel = nt ? rs1 : rs0;
        const float bias = (MODE == 2 && !rowsel) ? -__builtin_inff() : 0.f;
        float mx = -1e30f;
#pragma unroll
        for (int mt = 0; mt < 4; ++mt)
#pragma unroll
            for (int j = 0; j < 4; ++j) {
                const float sv = s[mt][nt][j] * LOG2E + bias;
                s[mt][nt][j] = sv; mx = fmaxf(mx, sv); }
        float mnew, alpha = 1.f;
        if (MODE == 1) mnew = mfin[nt];
        else { mx = fmaxf(mx, shx(mx, 16, lane)); mx = fmaxf(mx, shx(mx, 32, lane)); mnew = fmaxf(st.m[nt], mx); alpha = fexp2(st.m[nt] - mnew); st.m[nt] = mnew; }
        float ps = 0.f;
#pragma unroll
        for (int mt = 0; mt < 4; ++mt)
#pragma unroll
            for (int j = 0; j < 4; ++j) { float pv = fexp2(s[mt][nt][j] - mnew); if (MODE == 1) pv *= linv[nt]; s[mt][nt][j] = pv; ps += pv; }
        if (MODE != 1) st.l[nt] = st.l[nt] * alpha + ps;
        if (MODE == 2 || MODE == 3) {
#pragma unroll
            for (int md = 0; md < 8; ++md) st.ot[md][nt] = st.ot[md][nt] * alpha;
        }
        if (MODE == 1) {
#pragma unroll
            for (int mt = 0; mt < 4; ++mt) { float a = s[mt][nt][0] + s[mt][nt][1] + s[mt][nt][2] + s[mt][nt][3], lst = s[mt][nt][3];
                a += shx(a, 1, lane); a += shx(a, 2, lane); lst += shx(lst, 1, lane); lst += shx(lst, 2, lane);
                if ((l16 & 3) == 0) { const int jb = tile * 16 + 4 * mt + g4; LAS float* pp = (LAS float*)(lds + A_PSL) + (w * 8 + nt * 4 + (l16 >> 2)) * 256;
                    atomicAdd((float*)(pp + jb), a); if (jb + 1 < 256) atomicAdd((float*)(pp + jb + 1), lst); } }
        }
        if (MODE != 0) {
#pragma unroll
            for (int kk = 0; kk < 2; ++kk) { const u32x4 pk = (u32x4){pk_bf16(s[2 * kk][nt][0], s[2 * kk][nt][1]), pk_bf16(s[2 * kk][nt][2], s[2 * kk][nt][3]), pk_bf16(s[2 * kk + 1][nt][0], s[2 * kk + 1][nt][1]), pk_bf16(s[2 * kk + 1][nt][2], s[2 * kk + 1][nt][3])};
                pf[nt][kk] = __builtin_bit_cast(bf16x8, pk); }
        }
    }
    if (MODE != 0) {
#pragma unroll
        for (int kk = 0; kk < 2; ++kk)
#pragma unroll
            for (int md = 0; md < 8; ++md) { const LAS unsigned char* vb = lds + boff + A_VT + (16 * md + l16) * 136 + kk * 64 + g4 * 8;
                const u32x2 v0 = *(const LAS u32x2*)vb, v1 = *(const LAS u32x2*)(vb + 32); const bf16x8 vf = __builtin_bit_cast(bf16x8, ((u32x4){v0[0], v0[1], v1[0], v1[1]}));
                st.ot[md][0] = __builtin_amdgcn_mfma_f32_16x16x32_bf16(vf, pf[0][kk], st.ot[md][0], 0, 0, 0);
                st.ot[md][1] = __builtin_amdgcn_mfma_f32_16x16x32_bf16(vf, pf[1][kk], st.ot[md][1], 0, 0, 0);
                if (md == 7) __builtin_amdgcn_sched_barrier(0); }
    }
}
template <int MODE>
__device__ __forceinline__ void attn_tiles(LAS unsigned char* lds, const bf16_t* kp, size_t kstride, const bf16_t* vp, size_t vstride, int tile_lo, int tile_hi,
                                           const bf16x8 (&qf)[2][4], AttnState& st, const int (&tpos)[2], int qb, int w, int lane, const float (&mfin)[2], const float (&linv)[2]) {
    if (tile_lo >= tile_hi) return;
    int tid = w * 64 + lane; asm volatile("" : "+v"(tid)); const int l16 = lane & 15;
    const int krow = tid >> 3, kc = (tid & 7) * 16, vrow = tid >> 2, vc = (tid & 3) * 16;
    u32x4 kr0, kr1, vr0 = (u32x4){0, 0, 0, 0}, vr1 = (u32x4){0, 0, 0, 0};
#define A_LOAD(T) do { const bf16_t* kg = kp + (size_t)((T) * 64 + krow) * kstride + kc; kr0 = *(const u32x4*)kg; kr1 = *(const u32x4*)(kg + 8); \
        if (MODE != 0) { const bf16_t* vg = vp + (size_t)vrow * vstride + (T) * 64 + vc; vr0 = *(const u32x4*)vg; vr1 = *(const u32x4*)(vg + 8); } } while (0)
#define A_WRITE(BO) do { LAS unsigned char* kd = lds + (BO) + A_KT + krow * 272 + kc * 2; *(LAS u32x4*)kd = kr0; *(LAS u32x4*)(kd + 16) = kr1; \
        if (MODE != 0) { LAS unsigned char* vd = lds + (BO) + A_VT + vrow * 136 + vc * 2; *(LAS u32x2*)vd = (u32x2){vr0[0], vr0[1]}; *(LAS u32x2*)(vd + 8) = (u32x2){vr0[2], vr0[3]}; *(LAS u32x2*)(vd + 16) = (u32x2){vr1[0], vr1[1]}; *(LAS u32x2*)(vd + 24) = (u32x2){vr1[2], vr1[3]}; } } while (0)
    A_LOAD(tile_lo);
    __syncthreads();
    A_WRITE(0);
    if (tile_lo + 1 < tile_hi) A_LOAD(tile_lo + 1);
    __syncthreads();
    for (int tile = tile_lo; tile < tile_hi; ++tile) {
        const int boff = ((tile - tile_lo) & 1) * A_BUFSZ;
        if (tile + 1 < tile_hi) { A_WRITE(boff ^ A_BUFSZ); if (tile + 2 < tile_hi) A_LOAD(tile + 2); }
        bool rs0 = true, rs1 = true, active = true;
        if (MODE == 2) { const int tw = tile >> 5; const unsigned bit = 1u << (tile & 31);
            const unsigned w0 = *(const LAS unsigned*)(lds + A_SEL + ((w * 8 + (l16 >> 2)) * 8 + tw) * 4), w1 = *(const LAS unsigned*)(lds + A_SEL + ((w * 8 + 4 + (l16 >> 2)) * 8 + tw) * 4);
            rs0 = (w0 & bit) != 0u; rs1 = (w1 & bit) != 0u; active = __ballot(rs0 || rs1) != 0ull; }
        if (active) {
            bool masked;
            if (MODE == 0 || MODE == 1) masked = (tile * 64 + 63 > 4 * qb - 2);
            else if (MODE == 2) masked = (tile == qb);
            else masked = (tile == qb) || (tile <= qb - 8);
            attn_compute<MODE>(lds, boff, tile, qf, st, tpos, qb, w, lane, mfin, linv, rs0, rs1, masked);
        }
        __syncthreads();
    }
#undef A_LOAD
#undef A_WRITE
}
template <int BR>
__device__ __forceinline__ void attn_finish(AttnState& st, const float* gates, float* oacc, bf16_t* att, const int (&tpos)[2], int hkv, int lane) {
    const int l16 = lane & 15, g4 = lane >> 4, g = l16 & 3;
#pragma unroll
    for (int nt = 0; nt < 2; ++nt) {
        const int t = tpos[nt]; float sc = gates[(size_t)t * 48 + (hkv * 4 + g) * 3 + BR];
        if (BR != 0) { float l = st.l[nt]; l += shx(l, 16, lane); l += shx(l, 32, lane); sc = (l > 0.f) ? sc / l : 0.f; }
        const size_t base = (size_t)t * 2048 + (hkv * 4 + g) * 128 + 4 * g4;
#pragma unroll
        for (int md = 0; md < 8; ++md) { f32x4 v = st.ot[md][nt] * sc; float* op = oacc + base + 16 * md;
            if (BR == 0) *(f32x4*)op = v;
            else if (BR == 1) *(f32x4*)op = *(const f32x4*)op + v;
            else { v = v + *(const f32x4*)op; *(u32x2*)(att + base + 16 * md) = (u32x2){pk_bf16(v[0], v[1]), pk_bf16(v[2], v[3])}; } }
    }
}
__device__ __forceinline__ void attn_reset(AttnState& st) {
#pragma unroll
    for (int md = 0; md < 8; ++md) { st.ot[md][0] = (f32x4){0.f, 0.f, 0.f, 0.f}; st.ot[md][1] = (f32x4){0.f, 0.f, 0.f, 0.f}; }
    st.m[0] = st.m[1] = -1e30f; st.l[0] = st.l[1] = 0.f;
}
__device__ __forceinline__ void attn_item(unsigned char* ws, LAS unsigned char* lds, int hkv, int qb) {
    int tid = ltid(); asm volatile("" : "+v"(tid)); const int w = tid >> 6, lane = tid & 63, l16 = lane & 15, g4 = lane >> 4;
    const bf16_t* QB = (const bf16_t*)(ws + OFF_QB); const bf16_t* KVTOK = (const bf16_t*)(ws + OFF_KVTOK); const bf16_t* KVT = (const bf16_t*)(ws + OFF_KVT);
    const bf16_t* KC = (const bf16_t*)(ws + OFF_KCMP); const bf16_t* VC = (const bf16_t*)(ws + OFF_VCMPT);
    const float* gates = (const float*)(ws + OFF_GATES); float* oacc = (float*)(ws + OFF_OACC); bf16_t* att = (bf16_t*)(ws + OFF_ATT);
    int tpos[2]; bf16x8 qf[2][4];
#pragma unroll
    for (int nt = 0; nt < 2; ++nt) { tpos[nt] = qb * 64 + w * 8 + nt * 4 + (l16 >> 2); const bf16_t* qp = QB + (size_t)tpos[nt] * 2048 + (hkv * 4 + (l16 & 3)) * 128 + g4 * 8;
#pragma unroll
        for (int ks = 0; ks < 4; ++ks) qf[nt][ks] = *(const bf16x8*)(qp + ks * 32); }
    __syncthreads();
    { LAS float* pp = (LAS float*)(lds + A_PSL) + w * 2048;
#pragma unroll
      for (int i = 0; i < 32; ++i) pp[lane + 64 * i] = 0.f; }
    AttnState st; float mfin[2] = {0.f, 0.f}, linv[2] = {0.f, 0.f};
    const int ncmp_tiles = (4 * qb + 3 + 63) >> 6;
    attn_reset(st);
    attn_tiles<0>(lds, KC + (size_t)hkv * 1024 * 128, 128, VC, 1024, 0, ncmp_tiles, qf, st, tpos, qb, w, lane, mfin, linv);
#pragma unroll
    for (int nt = 0; nt < 2; ++nt) { float l = st.l[nt]; l += shx(l, 16, lane); l += shx(l, 32, lane); mfin[nt] = st.m[nt]; linv[nt] = (l > 0.f) ? 1.0f / l : 0.f; }
    attn_reset(st);
    attn_tiles<1>(lds, KC + (size_t)hkv * 1024 * 128, 128, VC + (size_t)hkv * 128 * 1024, 1024, 0, ncmp_tiles, qf, st, tpos, qb, w, lane, mfin, linv);
    attn_finish<0>(st, gates, oacc, att, tpos, hkv, lane);
    __syncthreads();
    {
        LAS unsigned* sel = (LAS unsigned*)(lds + A_SEL) + w * 64;
        if (qb < 16) {
            if (lane < 8) { for (int tk = 0; tk < 8; ++tk) { const int lo = lane * 32; unsigned wd = 0; if (qb >= lo + 31) wd = 0xffffffffu; else if (qb >= lo) wd = (2u << (qb - lo)) - 1u; sel[tk * 8 + lane] = wd; } }
        } else {
            for (int tk = 0; tk < 8; ++tk) {
                const LAS float* pp = (const LAS float*)(lds + A_PSL) + (w * 8 + tk) * 256;
                unsigned long long key[4]; bool taken[4];
#pragma unroll
                for (int i = 0; i < 4; ++i) { const int j = lane + 64 * i; const float sc = pp[j]; const bool elig = (j >= 1) && (j <= qb - 2);
                    taken[i] = (j == 0) || (j == qb) || (j == qb - 1);
                    key[i] = elig ? (((unsigned long long)__float_as_uint(sc) << 32) | (unsigned long long)(0x1000 - j)) : 0ull; }
                for (int r = 0; r < 13; ++r) {
                    unsigned long long best = key[0];
#pragma unroll
                    for (int i = 1; i < 4; ++i) best = key[i] > best ? key[i] : best;
#pragma unroll
                    for (int o = 32; o >= 1; o >>= 1) { const unsigned long long ot = shx64(best, o, lane); best = ot > best ? ot : best; }
#pragma unroll
                    for (int i = 0; i < 4; ++i) if (key[i] == best && best != 0ull) { taken[i] = true; key[i] = 0ull; }
                }
#pragma unroll
                for (int i = 0; i < 4; ++i) { const unsigned long long bal = __ballot(taken[i]); if (lane == 0) { sel[tk * 8 + 2 * i] = (unsigned)bal; sel[tk * 8 + 2 * i + 1] = (unsigned)(bal >> 32); } }
            }
        }
    }
    __syncthreads();
    attn_reset(st);
    attn_tiles<2>(lds, KVTOK + 2 * 512 + hkv * 128, 2048, KVT + (size_t)(hkv * 128) * S_, S_, 0, qb + 1, qf, st, tpos, qb, w, lane, mfin, linv);
    attn_finish<1>(st, gates, oacc, att, tpos, hkv, lane);
    attn_reset(st);
    attn_tiles<3>(lds, KVTOK + 3 * 512 + hkv * 128, 2048, KVT + (size_t)(512 + hkv * 128) * S_, S_, (qb - 8) > 0 ? (qb - 8) : 0, qb + 1, qf, st, tpos, qb, w, lane, mfin, linv);
    attn_finish<2>(st, gates, oacc, att, tpos, hkv, lane);
}
__device__ __forceinline__ void attn_phase(unsigned char* ws, LAS unsigned char* lds) {
#pragma nounroll
    for (int it = blockIdx.x; it < 1024; it += gridDim.x) {
        const int c = it & 255, r = it >> 8;
        attn_item(ws, lds, r, (r & 1) ? 255 - c : c);
    }
}


#define XB_TMO      128
#define XB_XCNT(j)  (256  + 64 * (j))
#define XB_XSUB(j)  (1280 + 64 * (j))
#define XB_XGEN(j)  (2304 + 64 * (j))
#define XB_TOP      3328
#define XB_TOPGEN   3392
#define XCD_BAR_WORDS 3456
#define XB_SPIN_CAP (1u << 22)
__device__ __forceinline__ unsigned xb_ld(unsigned* p)              { return __hip_atomic_load(p, __ATOMIC_RELAXED, __HIP_MEMORY_SCOPE_AGENT); }
__device__ __forceinline__ unsigned xb_add(unsigned* p, unsigned v) { return __hip_atomic_fetch_add(p, v, __ATOMIC_RELAXED, __HIP_MEMORY_SCOPE_AGENT); }
__device__ __forceinline__ unsigned xb_xcc_id() { return (unsigned)__builtin_amdgcn_s_getreg((3 << 11) | 20) & 0xFu; }
#define XB_SPIN(cond, bar) do { unsigned _sp = 0; while (cond) { __builtin_amdgcn_s_sleep(1); \
    if ((++_sp & 255u) == 0u) { if (xb_ld(&(bar)[XB_TMO])) break; if (_sp > XB_SPIN_CAP) { atomicAdd(&(bar)[XB_TMO], 1u); break; } } } } while (0)
struct XcdBarrier { unsigned* bar; unsigned x; volatile LAS unsigned* st; };
__device__ __forceinline__ XcdBarrier xcd_barrier_post(unsigned* bar, volatile LAS unsigned* st) {
    XcdBarrier b; b.bar = bar; b.x = xb_xcc_id(); b.st = st;
    if (threadIdx.x == 0) (void)xb_add(&bar[XB_XCNT(b.x)], 1u);
    return b;
}
__device__ __forceinline__ void xcd_barrier_complete(unsigned* bar, unsigned x, unsigned& nloc, unsigned& nx) {
    const unsigned G = gridDim.x * gridDim.y * gridDim.z;
    unsigned sum, cnt, mine, sp = 0u;
    for (;;) {
        sum = 0u; cnt = 0u; mine = 0u;
#pragma unroll
        for (unsigned j = 0; j < 16; ++j) { const unsigned c = xb_ld(&bar[XB_XCNT(j)]); sum += c; cnt += (c > 0u) ? 1u : 0u; mine = (j == x) ? c : mine; }
        if (sum == G) break;
        __builtin_amdgcn_s_sleep(1);
        if ((++sp & 255u) == 0u) { if (xb_ld(&bar[XB_TMO])) break; if (sp > XB_SPIN_CAP) { atomicAdd(&bar[XB_TMO], 1u); break; } }
    }
    nloc = mine > 0u ? mine : 1u; nx = cnt > 0u ? cnt : 1u;
}
__device__ __forceinline__ void xcd_barrier(const XcdBarrier& b) {
    asm volatile("s_waitcnt vmcnt(0)" ::: "memory");
    __syncthreads();
    if (threadIdx.x == 0) {
        unsigned* bar = b.bar;
        __builtin_amdgcn_s_waitcnt(0);
        unsigned nloc = b.st[0], nx = b.st[1];
        if (nloc == 0u) { xcd_barrier_complete(bar, b.x, nloc, nx); b.st[0] = nloc; b.st[1] = nx; }
        const unsigned old = xb_add(&bar[XB_XSUB(b.x)], 1u);
        const unsigned gen = old / nloc;
        if (old + 1u == (gen + 1u) * nloc) {
            __builtin_amdgcn_fence(__ATOMIC_RELEASE, "agent");
            asm volatile("s_waitcnt vmcnt(0)" ::: "memory");
            const unsigned og = xb_add(&bar[XB_TOP], 1u);
            const unsigned tg = og / nx;
            if (og + 1u == (tg + 1u) * nx) xb_add(&bar[XB_TOPGEN], 1u);
            else XB_SPIN(xb_ld(&bar[XB_TOPGEN]) == tg, bar);
            __builtin_amdgcn_fence(__ATOMIC_ACQUIRE, "agent");
            xb_add(&bar[XB_XGEN(b.x)], 1u);
            asm volatile("s_waitcnt vmcnt(0)" ::: "memory");
        } else {
            XB_SPIN(xb_ld(&bar[XB_XGEN(b.x)]) == gen, bar);
            __builtin_amdgcn_fence(__ATOMIC_ACQUIRE, "agent");
            asm volatile("s_waitcnt vmcnt(0)" ::: "memory");
        }
    }
    __syncthreads();
}

constexpr int NPH = 23;
__device__ __forceinline__ void run_phase(CP p, int ph, int b, LAS unsigned char* lds) {
    asm volatile("" : "+s"(p));
    unsigned char* ws = p->ws;
    const float* xb = p->x + (size_t)b * S_ * D_; float* hb = p->out + (size_t)b * S_ * D_;
    bf16_t* XN = (bf16_t*)(ws + OFF_XN);
    const int layer = (ph >= 13) ? 1 : 0;
    switch (ph) {
    case 0: prep_phase(p, lds); break;
    case 1: rmsnorm_phase(xb, p->norm_mix, XN, nullptr, nullptr); break;
    case 2: {
        Prob2D<EpiQK> g1{(const char*)XN, (const char*)(ws + OFF_W_RIN), 4096u, 4096u, 32, 64, 16, EpiQK{(bf16_t*)(ws + OFF_Q), (bf16_t*)(ws + OFF_K), (bf16_t*)(ws + OFF_KTD), (const float2*)(ws + OFF_ROPE)}};
        gemm_phase(lds, g1);
        Prob2D<EpiStore> g2{(const char*)(ws + OFF_W_RIN) + (size_t)4096 * 4096, (const char*)XN, 4096u, 4096u, 32, 16, 64, EpiStore{(bf16_t*)(ws + OFF_VT), (size_t)S_}};
        gemm_phase(lds, g2);
    } break;
    case 3: {
        ProbKV g3{(const char*)(ws + OFF_VT), (const char*)(ws + OFF_KTD), (bf16_t*)(ws + OFF_ST), 4};
        gemm_phase(lds, g3);
        ProbS g4{(const char*)(ws + OFF_Q), (const char*)(ws + OFF_K), (bf16_t*)(ws + OFF_SD), 4};
        gemm_phase(lds, g4);
    } break;
    case 4: scan_phase((bf16_t*)(ws + OFF_ST)); break;
    case 5: {
        ProbOut g5{(const char*)(ws + OFF_Q), (const char*)(ws + OFF_ST), (long)OFF_SD - (long)OFF_Q, (long)OFF_VT - (long)OFF_ST, (bf16_t*)(ws + OFF_Y), 8};
        gemm_phase(lds, g5);
    } break;
    case 6: gn_phase((bf16_t*)(ws + OFF_Y), p->ret_gn); break;
    case 7: {
        Prob2D<EpiGate> g6{(const char*)XN, (const char*)(ws + OFF_W_RIN) + (size_t)8192 * 4096, 4096u, 4096u, 32, 64, 16, EpiGate{(bf16_t*)(ws + OFF_Y)}};
        gemm_phase(lds, g6);
    } break;
    case 8: {
        Prob2D<EpiRes> g7{(const char*)(ws + OFF_Y), (const char*)(ws + OFF_W_ROUT), 8192u, 8192u, 64, 64, 8, EpiRes{xb, hb}};
        gemm_phase(lds, g7);
    } break;
    case 9: case 19: rmsnorm_phase(hb, p->norm_ffn + layer * 2048, XN, nullptr, nullptr); break;
    case 10: case 20: {
        Prob2D<EpiStore> g8{(const char*)XN, (const char*)(ws + OFF_W_FIN + (size_t)layer * 32 * MiB), 4096u, 4096u, 32, 64, 32, EpiStore{(bf16_t*)(ws + OFF_U), (size_t)8192}};
        gemm_phase(lds, g8);
    } break;
    case 11: case 21: conv_phase((const bf16_t*)(ws + OFF_U), (bf16_t*)(ws + OFF_AB), p->ffn_conv_w + (size_t)layer * 3 * 8192, p->ffn_conv_b + (size_t)layer * 8192); break;
    case 12: case 22: {
        Prob2D<EpiRes> g9{(const char*)(ws + OFF_AB), (const char*)(ws + OFF_W_FOUT + (size_t)layer * 16 * MiB), 8192u, 8192u, 64, 64, 8, EpiRes{hb, hb}};
        gemm_phase(lds, g9);
    } break;
    case 13: rmsnorm_phase(hb, p->norm_mix + 2048, XN, p->kv_gain, (bf16_t*)(ws + OFF_HN)); break;
    case 14: {
        Prob2D<EpiStore> g10{(const char*)(ws + OFF_HN), (const char*)(ws + OFF_W_KV), 4096u, 4096u, 32, 64, 8, EpiStore{(bf16_t*)(ws + OFF_KVTOK), (size_t)2048}};
        gemm_phase(lds, g10);
        Prob2D<EpiStore> g11{(const char*)(ws + OFF_W_KV) + (size_t)2048 * 4096, (const char*)(ws + OFF_HN), 4096u, 4096u, 32, 4, 64, EpiStore{(bf16_t*)(ws + OFF_KVT), (size_t)S_}};
        gemm_phase(lds, g11);
    } break;
    case 15: {
        ProbCmp1 a{(const char*)(ws + OFF_KVTOK), (const char*)(ws + OFF_W_C1K), 8192u, 64, 16, EpiGelu{(bf16_t*)(ws + OFF_H1), (const float*)(ws + OFF_PEB)}};
        gemm_phase(lds, a, (int)gridDim.x - 32);
        ProbCmp1 v{(const char*)(ws + OFF_KVTOK) + 1024, (const char*)(ws + OFF_W_C1V), 8192u, 64, 16, EpiGelu{(bf16_t*)(ws + OFF_H1) + 4096 * 256, (const float*)(ws + OFF_PEB) + 256}};
        gemm_phase(lds, v, (int)gridDim.x - 16);
        Prob2D<EpiQproj> g12{(const char*)XN, (const char*)(ws + OFF_W_Q), 4096u, 4096u, 32, 64, 9, EpiQproj{(bf16_t*)(ws + OFF_QB), (float*)(ws + OFF_GATES)}};
        gemm_phase(lds, g12);
    } break;
    case 16: {
        Prob2D<EpiKcmp> a{(const char*)(ws + OFF_H1), (const char*)(ws + OFF_W_C2K), 512u, 512u, 4, 16, 1, EpiKcmp{(bf16_t*)(ws + OFF_KCMP)}};
        gemm_phase(lds, a);
        Prob2D<EpiVcmp> v{(const char*)(ws + OFF_W_C2V), (const char*)(ws + OFF_H1) + (size_t)4096 * 256 * 2, 512u, 512u, 4, 1, 16, EpiVcmp{(bf16_t*)(ws + OFF_VCMPT)}};
        gemm_phase(lds, v);
    } break;
    case 17: attn_phase(ws, lds); break;
    case 18: {
        Prob2D<EpiRes> g{(const char*)(ws + OFF_ATT), (const char*)(ws + OFF_W_O), 4096u, 4096u, 32, 64, 8, EpiRes{hb, hb}};
        gemm_phase(lds, g);
    } break;
    case 23: finalnorm_phase(hb, p->final_gain); break;
    default: break;
    }
}

#if MULTI
__global__ void __launch_bounds__(512) phase_kernel(Params p, int ph, int b) {
    extern __shared__ __attribute__((aligned(16))) unsigned char shm[];
    run_phase((CP)__builtin_amdgcn_kernarg_segment_ptr(), ph, b, (LAS unsigned char*)shm);
}
#else
__global__ void __launch_bounds__(512) mega_kernel(Params p) {
    extern __shared__ __attribute__((aligned(16))) unsigned char shm[];
    cg::grid_group grid = cg::this_grid();
    CP cp = (CP)__builtin_amdgcn_kernarg_segment_ptr();
    volatile LAS unsigned* st = (volatile LAS unsigned*)((LAS unsigned char*)shm + LDS_ST);
    if (threadIdx.x == 0) { st[0] = 0u; st[1] = 0u; st[2] = 0u; st[3] = 0u; }
    __syncthreads();
    XcdBarrier xb = xcd_barrier_post((unsigned*)(cp->ws + OFF_BAR), st);
    run_phase(cp, 0, 0, (LAS unsigned char*)shm);
    grid.sync();
    for (int b = 0; b < 2; ++b)
        for (int ph = 1; ph <= NPH; ++ph) {
#ifdef PROBE_PH
            const int reps = (ph == PROBE_PH || ph == PROBE_PH2) ? 2 : 1;
#else
            const int reps = 1;
#endif
            for (int rep = 0; rep < reps; ++rep) { run_phase(cp, ph, b, (LAS unsigned char*)shm); xcd_barrier(xb); } }
}
#endif

constexpr int LDS_BYTES = LDS_ST + 16;
extern "C" void kernel_launch(void* const* d_in, const int* in_sizes, int n_in, void* d_out, int out_size, void* d_ws, size_t ws_size, hipStream_t stream) {
    static int grid = 0;
    if (grid == 0) {
        if (n_in != 21 || out_size != 2 * S_ * D_ || ws_size < WS_NEED) { fprintf(stderr, "kernel_launch: unexpected shapes/ws (n_in %d out %d ws %zu need %zu)\n", n_in, out_size, ws_size, (size_t)WS_NEED); grid = -1; return; }
#if MULTI
        if (hipFuncSetAttribute((const void*)phase_kernel, hipFuncAttributeMaxDynamicSharedMemorySize, LDS_BYTES) != hipSuccess) { fprintf(stderr, "hipFuncSetAttribute failed\n"); grid = -1; return; }
#else
        if (hipFuncSetAttribute((const void*)mega_kernel, hipFuncAttributeMaxDynamicSharedMemorySize, LDS_BYTES) != hipSuccess) { fprintf(stderr, "hipFuncSetAttribute failed\n"); grid = -1; return; }
#endif
        int dev = 0, cus = 0; hipGetDevice(&dev); hipDeviceGetAttribute(&cus, hipDeviceAttributeMultiprocessorCount, dev);
        grid = cus > 0 ? cus : 256;
    }
    if (grid < 0) return;
    Params p{};
    const float** pp = (const float**)&p;
    for (int i = 0; i < 21; ++i) pp[i] = (const float*)d_in[i];
    p.out = (float*)d_out; p.ws = (unsigned char*)d_ws;
#if MULTI
    hipLaunchKernelGGL(phase_kernel, dim3(grid), dim3(512), LDS_BYTES, stream, p, 0, 0);
    for (int b = 0; b < 2; ++b)
        for (int ph = 1; ph <= NPH; ++ph) hipLaunchKernelGGL(phase_kernel, dim3(grid), dim3(512), LDS_BYTES, stream, p, ph, b);
#else
    if (hipMemsetAsync((unsigned char*)d_ws + OFF_BAR, 0, XCD_BAR_WORDS * 4, stream) != hipSuccess) { fprintf(stderr, "memset failed\n"); return; }
    void* args[] = {&p};
    hipError_t e = hipLaunchCooperativeKernel((const void*)mega_kernel, dim3(grid), dim3(512), args, LDS_BYTES, stream);
    if (e != hipSuccess) fprintf(stderr, "cooperative launch failed: %s (grid %d)\n", hipGetErrorString(e), grid);
#endif
}
```

```cpp
#include <hip/hip_runtime.h>
#include <hip/hip_cooperative_groups.h>
#include <cstdio>
namespace cg = cooperative_groups;

#ifndef MULTI
#define MULTI 0
#endif

#define LAS __attribute__((address_space(3)))
typedef unsigned short bf16_t;
typedef short bf16x8 __attribute__((ext_vector_type(8)));
typedef float f32x4 __attribute__((ext_vector_type(4)));
typedef unsigned u32x2 __attribute__((ext_vector_type(2)));
typedef unsigned u32x4 __attribute__((ext_vector_type(4)));

constexpr int S_ = 16384, D_ = 2048;
constexpr size_t MiB = 1048576;
constexpr size_t OFF_W_RIN = 0, OFF_W_ROUT = 48 * MiB, OFF_W_KV = 64 * MiB, OFF_W_C1K = 76 * MiB, OFF_W_C1V = 78 * MiB,
                 OFF_W_C2K = 80 * MiB, OFF_W_C2V = 80 * MiB + 131072, OFF_W_Q = 81 * MiB, OFF_W_O = 90 * MiB,
                 OFF_W_FIN = 98 * MiB  , OFF_W_FOUT = 162 * MiB  , OFF_ROPE = 194 * MiB, OFF_PEB = 210 * MiB, OFF_BAR = 210 * MiB + 65536,
                 OFF_XN = 211 * MiB, OFF_ACT = 275 * MiB;
constexpr size_t OFF_Q = OFF_ACT, OFF_K = OFF_ACT + 64 * MiB, OFF_KTD = OFF_ACT + 128 * MiB, OFF_VT = OFF_ACT + 192 * MiB,
                 OFF_ST = OFF_ACT + 320 * MiB, OFF_SD = OFF_ACT + 448 * MiB, OFF_Y = OFF_ACT + 512 * MiB, WS_NEED = OFF_ACT + 640 * MiB;
constexpr size_t OFF_U = OFF_ACT, OFF_AB = OFF_ACT + 256 * MiB;
constexpr size_t OFF_HN = OFF_ACT, OFF_KVTOK = OFF_ACT + 64 * MiB, OFF_KVT = OFF_ACT + 129 * MiB, OFF_QB = OFF_ACT + 161 * MiB,
                 OFF_GATES = OFF_ACT + 225 * MiB, OFF_H1 = OFF_ACT + 229 * MiB, OFF_KCMP = OFF_ACT + 233 * MiB, OFF_VCMPT = OFF_ACT + 234 * MiB,
                 OFF_ATT = OFF_ACT + 235 * MiB, OFF_OACC = OFF_ACT + 299 * MiB;

struct Params {
    const float* x; const float* norm_mix; const float* norm_ffn; const float* ret_w_in; const float* ret_gn; const float* ret_w_out;
    const float* kv_gain; const float* w_kv; const float* pe_k; const float* w1_k; const float* w2_k; const float* pe_v; const float* w1_v;
    const float* w2_v; const float* w_q; const float* w_o; const float* ffn_w_in; const float* ffn_conv_w; const float* ffn_conv_b;
    const float* ffn_w_out; const float* final_gain; float* out; unsigned char* ws;
};

typedef const __attribute__((address_space(4))) Params* CP;
__device__ __forceinline__ int ltid() { int t = threadIdx.x; asm volatile("" : "+v"(t)); return t; }
__device__ __forceinline__ unsigned pk_bf16(float lo, float hi) { unsigned r; asm("v_cvt_pk_bf16_f32 %0, %1, %2" : "=v"(r) : "v"(lo), "v"(hi)); return r; }
__device__ __forceinline__ float bflo(unsigned v) { return __uint_as_float(v << 16); }
__device__ __forceinline__ float bfhi(unsigned v) { return __uint_as_float(v & 0xffff0000u); }
__device__ __forceinline__ float fexp2(float x) { return __builtin_amdgcn_exp2f(x); }
__device__ __forceinline__ float frcp(float x) { return __builtin_amdgcn_rcpf(x); }
__device__ __forceinline__ float log2gamma(int h) { return log2f(1.0f - exp2f(-5.0f - (float)h)); }
__device__ __forceinline__ float sigmoidf_(float x) { return frcp(1.0f + fexp2(-1.4426950408889634f * x)); }

constexpr int HTB = 128 * 64 * 2;
__device__ __forceinline__ int lds_byte(int r, int c) { const int st = (r >> 4) * 2 + (c >> 5), rr = r & 15, cc = c & 31, ob = rr * 64 + cc * 2; return st * 1024 + (ob ^ (((ob >> 9) & 1) << 5)); }
__device__ __forceinline__ void stage_rc(int b, int& R, int& C) { const int st = b / 1024, sb = b % 1024, swz = sb ^ (((sb >> 9) & 1) << 5); R = (st >> 1) * 16 + swz / 64; C = (st & 1) * 32 + (swz % 64) / 2; }
__device__ __forceinline__ void tile_order(int L, int nM, int nN, int& pm, int& pn) {
    const int nwg = nM * nN; int wgid = L;
    { const int q = nwg / 8, r = nwg % 8, xcd = wgid % 8, off = wgid / 8; wgid = (xcd < r ? xcd * (q + 1) : r * (q + 1) + (xcd - r) * q) + off; }
    const int nig = 8 * nN, gid = wgid / nig, fm = gid * 8, gsz = (nM - fm) < 8 ? (nM - fm) : 8;
    pm = fm + ((wgid % nig) % gsz); pn = (wgid % nig) / gsz;
}
struct UInfo { const char* a; const char* b; int r0, c0, x0, x1; };
typedef f32x4 AccT[2][2][4][2];

template <class P>
__device__ __forceinline__ void gemm_phase(LAS unsigned char* lds, const P& pb, int cofs = 0) {
    const int tid = ltid(), wid = __builtin_amdgcn_readfirstlane(tid >> 6), lane = tid & 63, wr = wid >> 2, wc = wid & 3, fr = lane & 15, fq = lane >> 4;
    const int nt = pb.nt, G = gridDim.x, c = (int)blockIdx.x - cofs; const long nun = pb.nunits();
    if (c < 0 || c >= nun) return;
    unsigned voffA[2], voffB[2];
#pragma unroll
    for (int i = 0; i < 2; ++i) { int R, C; stage_rc(tid * 16 + i * 8192, R, C); voffA[i] = pb.rowA(R) + (unsigned)C * 2u; const int rho = R & 31; const int Rb = P::PERM ? ((R & ~31) + 8 * ((rho & 15) >> 2) + 4 * (rho >> 4) + (rho & 3)) : R; voffB[i] = (unsigned)Rb * pb.ldb + (unsigned)C * 2u; }
    const size_t hsA = pb.rowA(128), hsB = (size_t)128 * pb.ldb;
    const unsigned ldsw = (unsigned)wid * 1024u;
    const int aoff = lds_byte(wr * 64 + fr, fq * 8), boff = lds_byte(wc * 32 + fr, fq * 8);
#define G_SA(b, h) (((b) * 2 + (h)) * HTB)
#define G_SB(b, h) ((4 + (b) * 2 + (h)) * HTB)
#define G_STAGE(bufoff, gbase, voff) do { _Pragma("unroll") for (int _i = 0; _i < 2; ++_i) \
        __builtin_amdgcn_global_load_lds((const unsigned*)((const char*)(gbase) + (voff)[_i]), (LAS unsigned*)(lds + (bufoff) + ldsw + _i * 8192), 16, 0, 0); } while (0)
#define G_LDA(dst, b, h) do { _Pragma("unroll") for (int m = 0; m < 4; ++m) _Pragma("unroll") for (int k = 0; k < 2; ++k) dst[m][k] = *(const LAS bf16x8*)(lds + G_SA(b, h) + aoff + m * 2048 + k * 1024); } while (0)
#define G_LDB(dst, b, h) do { _Pragma("unroll") for (int n = 0; n < 2; ++n) _Pragma("unroll") for (int k = 0; k < 2; ++k) dst[n][k] = *(const LAS bf16x8*)(lds + G_SB(b, h) + boff + n * 2048 + k * 1024); } while (0)
#define G_MMA(ai, bj, At, Bt) do { __builtin_amdgcn_s_setprio(1); _Pragma("unroll") for (int m = 0; m < 4; ++m) _Pragma("unroll") for (int n = 0; n < 2; ++n) _Pragma("unroll") for (int k = 0; k < 2; ++k) \
        acc[ai][bj][m][n] = __builtin_amdgcn_mfma_f32_16x16x32_bf16(Bt[n][k], At[m][k], acc[ai][bj][m][n], 0, 0, 0); __builtin_amdgcn_s_setprio(0); } while (0)
#define G_WAIT_V(n) asm volatile("s_waitcnt vmcnt(" #n ")" ::: "memory")
#define G_WAIT_L(n) asm volatile("s_waitcnt lgkmcnt(" #n ")" ::: "memory")
#define G_BAR __builtin_amdgcn_s_barrier()
#define G_SCHED __builtin_amdgcn_sched_barrier(0)
    UInfo cur, nxt; int ui = 0;
    pb.unit(c, cur);
    AccT acc;
#pragma unroll
    for (int a = 0; a < 2; ++a)
#pragma unroll
        for (int b = 0; b < 2; ++b)
#pragma unroll
            for (int m = 0; m < 4; ++m)
#pragma unroll
                for (int n = 0; n < 2; ++n) acc[a][b][m][n] = (f32x4){0.f, 0.f, 0.f, 0.f};
    bf16x8 At[4][2], B0[2][2], B1[2][2];
    const char* cA = cur.a; const char* cB = cur.b;
    G_STAGE(G_SB(0, 0), cB + pb.bK(0), voffB); G_STAGE(G_SA(0, 0), cA + pb.aK(0), voffA); G_STAGE(G_SB(0, 1), cB + hsB + pb.bK(0), voffB); G_STAGE(G_SA(0, 1), cA + hsA + pb.aK(0), voffA);
    if (wr == 1) G_BAR;
    G_WAIT_V(4); G_BAR;
    G_STAGE(G_SB(1, 0), cB + pb.bK(1), voffB); G_STAGE(G_SA(1, 0), cA + pb.aK(1), voffA); G_STAGE(G_SB(1, 1), cB + hsB + pb.bK(1), voffB);
    G_WAIT_V(6); G_BAR;
    for (;;) {
        const long Ln = (long)(ui + 1) * G + c; const bool has_next = Ln < nun;
        if (has_next) pb.unit(Ln, nxt);
        const char* nA = has_next ? nxt.a : cA; const char* nB = has_next ? nxt.b : cB;
        for (int t = 0; t < nt; t += 2) {
            const bool last = (t == nt - 2);
            const char* a1 = cA + pb.aK(t + 1);
            const char* a2 = last ? nA + pb.aK(0) : cA + pb.aK(t + 2); const char* b2 = last ? nB + pb.bK(0) : cB + pb.bK(t + 2);
            const char* a3 = last ? nA + pb.aK(1) : cA + pb.aK(t + 3); const char* b3 = last ? nB + pb.bK(1) : cB + pb.bK(t + 3);
            G_LDB(B0, 0, 0); G_SCHED; G_LDA(At, 0, 0); G_STAGE(G_SA(1, 1), a1 + hsA, voffA);
            G_WAIT_L(8); G_BAR; G_WAIT_L(0); G_MMA(0, 0, At, B0); G_BAR; G_SCHED;
            G_LDB(B1, 0, 1); G_STAGE(G_SB(0, 0), b2, voffB);
            G_BAR; G_WAIT_L(0); G_MMA(0, 1, At, B1); G_BAR;
            G_LDA(At, 0, 1); G_STAGE(G_SA(0, 0), a2, voffA);
            G_BAR; G_WAIT_L(0); G_MMA(1, 0, At, B0); G_BAR; G_SCHED;
            G_STAGE(G_SB(0, 1), b2 + hsB, voffB);
            G_WAIT_V(6); G_BAR; G_MMA(1, 1, At, B1); G_BAR;
            G_LDB(B0, 1, 0); G_SCHED; G_LDA(At, 1, 0); G_STAGE(G_SA(0, 1), a2 + hsA, voffA);
            G_WAIT_L(8); G_BAR; G_WAIT_L(0); G_MMA(0, 0, At, B0); G_BAR; G_SCHED;
            G_LDB(B1, 1, 1); G_STAGE(G_SB(1, 0), b3, voffB);
            G_BAR; G_WAIT_L(0); G_MMA(0, 1, At, B1); G_BAR;
            G_LDA(At, 1, 1); G_STAGE(G_SA(1, 0), a3, voffA);
            G_BAR; G_WAIT_L(0); G_MMA(1, 0, At, B0); G_BAR; G_SCHED;
            G_STAGE(G_SB(1, 1), b3 + hsB, voffB);
            G_WAIT_V(6); G_BAR; G_MMA(1, 1, At, B1); G_BAR;
        }
        { const int l2 = ltid() & 63; pb.epi(acc, cur, wr, wc, l2 & 15, l2 >> 4); }
        if (!has_next) break;
#pragma unroll
        for (int a = 0; a < 2; ++a)
#pragma unroll
            for (int b = 0; b < 2; ++b)
#pragma unroll
                for (int m = 0; m < 4; ++m)
#pragma unroll
                    for (int n = 0; n < 2; ++n) acc[a][b][m][n] = (f32x4){0.f, 0.f, 0.f, 0.f};
        cur = nxt; cA = nA; cB = nB; ++ui;
    }
    G_WAIT_V(0);
    if (wr == 0) G_BAR;
    G_BAR;
}

#define EPI_ROWS for (int ai = 0; ai < 2; ++ai) for (int m = 0; m < 4; ++m)
#define EPI_COLS for (int bj = 0; bj < 2; ++bj) for (int n = 0; n < 2; ++n)
#define EPI_ROW (128 * ai + 64 * wr + 16 * m + fr)
#define EPI_COL (128 * bj + 32 * wc + 16 * n + 4 * fq)

template <class Epi> struct Prob2D {
    static constexpr bool PERM = Epi::PERM;
    const char* A; const char* B; unsigned lda, ldb; int nt, nM, nN; Epi e;
    __device__ __forceinline__ long nunits() const { return (long)nM * nN; }
    __device__ __forceinline__ unsigned rowA(int R) const { return (unsigned)R * lda; }
    __device__ __forceinline__ void unit(long L, UInfo& u) const { int pm, pn; tile_order((int)L, nM, nN, pm, pn); u.a = A + (size_t)pm * 256 * lda; u.b = B + (size_t)pn * 256 * ldb; u.r0 = pm * 256; u.c0 = pn * 256; u.x0 = 0; u.x1 = 0; }
    __device__ __forceinline__ size_t aK(int kt) const { return (size_t)kt * 128; }
    __device__ __forceinline__ size_t bK(int kt) const { return (size_t)kt * 128; }
    __device__ __forceinline__ void epi(const AccT& acc, const UInfo& u, int wr, int wc, int fr, int fq) const { e(acc, u, wr, wc, fr, fq); }
};
struct EpiStore { static constexpr bool PERM = true; bf16_t* O; size_t ldc;
    __device__ __forceinline__ void operator()(const AccT& acc, const UInfo& u, int wr, int wc, int fr, int fq) const {
#pragma unroll
        EPI_ROWS { bf16_t* rp = O + (size_t)(u.r0 + EPI_ROW) * ldc + u.c0;
#pragma unroll
            for (int bj = 0; bj < 2; ++bj) { const f32x4 v = acc[ai][bj][m][0], v2 = acc[ai][bj][m][1]; *(u32x4*)(rp + 128 * bj + 32 * wc + 8 * fq) = (u32x4){pk_bf16(v[0], v[1]), pk_bf16(v[2], v[3]), pk_bf16(v2[0], v2[1]), pk_bf16(v2[2], v2[3])}; } }
    } };
struct EpiRes { static constexpr bool PERM = false; const float* R; float* O;
    __device__ __forceinline__ void operator()(const AccT& acc, const UInfo& u, int wr, int wc, int fr, int fq) const {
#pragma unroll
        EPI_ROWS { const size_t ro = (size_t)(u.r0 + EPI_ROW) * 2048 + u.c0;
#pragma unroll
            EPI_COLS { const f32x4 r = *(const f32x4*)(R + ro + EPI_COL); *(f32x4*)(O + ro + EPI_COL) = r + acc[ai][bj][m][n]; } }
    } };
struct EpiGate { static constexpr bool PERM = true; bf16_t* Y;
    __device__ __forceinline__ void operator()(const AccT& acc, const UInfo& u, int wr, int wc, int fr, int fq) const {
#pragma unroll
        EPI_ROWS { bf16_t* rp = Y + (size_t)(u.r0 + EPI_ROW) * 4096 + u.c0;
#pragma unroll
            for (int bj = 0; bj < 2; ++bj) { const f32x4 g = acc[ai][bj][m][0], h = acc[ai][bj][m][1]; bf16_t* cp = rp + 128 * bj + 32 * wc + 8 * fq; const u32x4 y = *(const u32x4*)cp;
                const float o0 = g[0] * sigmoidf_(g[0]) * bflo(y[0]), o1 = g[1] * sigmoidf_(g[1]) * bfhi(y[0]), o2 = g[2] * sigmoidf_(g[2]) * bflo(y[1]), o3 = g[3] * sigmoidf_(g[3]) * bfhi(y[1]);
                const float o4 = h[0] * sigmoidf_(h[0]) * bflo(y[2]), o5 = h[1] * sigmoidf_(h[1]) * bfhi(y[2]), o6 = h[2] * sigmoidf_(h[2]) * bflo(y[3]), o7 = h[3] * sigmoidf_(h[3]) * bfhi(y[3]);
                *(u32x4*)cp = (u32x4){pk_bf16(o0, o1), pk_bf16(o2, o3), pk_bf16(o4, o5), pk_bf16(o6, o7)}; } }
    } };
struct EpiQK { static constexpr bool PERM = false; bf16_t* Q; bf16_t* K; bf16_t* KTD; const float2* rope;
    __device__ __forceinline__ void operator()(const AccT& acc, const UInfo& u, int wr, int wc, int fr, int fq) const {
        const int hidx = u.c0 >> 8; const bool isk = hidx >= 8; const int hh = hidx & 7; const float l2g = log2gamma(hh);
        bf16_t* dst = (isk ? K : Q) + hh * 256; const float sc = isk ? 0.0625f : 1.0f;
#pragma unroll
        EPI_ROWS { const int t = u.r0 + EPI_ROW; const float kd = fexp2((float)(255 - (t & 255)) * l2g);
#pragma unroll
            for (int n = 0; n < 2; ++n) { const int dd = 32 * wc + 16 * n + 4 * fq;
                const f32x4 x1 = acc[ai][0][m][n], x2 = acc[ai][1][m][n]; const f32x4 cs0 = *(const f32x4*)(rope + (size_t)t * 128 + dd), cs1 = *(const f32x4*)(rope + (size_t)t * 128 + dd + 2);
                float y1[4], y2[4];
                y1[0] = (x1[0] * cs0[0] - x2[0] * cs0[1]) * sc; y2[0] = (x1[0] * cs0[1] + x2[0] * cs0[0]) * sc;
                y1[1] = (x1[1] * cs0[2] - x2[1] * cs0[3]) * sc; y2[1] = (x1[1] * cs0[3] + x2[1] * cs0[2]) * sc;
                y1[2] = (x1[2] * cs1[0] - x2[2] * cs1[1]) * sc; y2[2] = (x1[2] * cs1[1] + x2[2] * cs1[0]) * sc;
                y1[3] = (x1[3] * cs1[2] - x2[3] * cs1[3]) * sc; y2[3] = (x1[3] * cs1[3] + x2[3] * cs1[2]) * sc;
                *(u32x2*)(dst + (size_t)t * 2048 + dd) = (u32x2){pk_bf16(y1[0], y1[1]), pk_bf16(y1[2], y1[3])};
                *(u32x2*)(dst + (size_t)t * 2048 + 128 + dd) = (u32x2){pk_bf16(y2[0], y2[1]), pk_bf16(y2[2], y2[3])};
                if (isk) {
#pragma unroll
                    for (int j = 0; j < 4; ++j) { KTD[(size_t)(hh * 256 + dd + j) * S_ + t] = (bf16_t)(pk_bf16(y1[j] * kd, 0.f) & 0xffffu); KTD[(size_t)(hh * 256 + 128 + dd + j) * S_ + t] = (bf16_t)(pk_bf16(y2[j] * kd, 0.f) & 0xffffu); }
                } } }
    } };
struct EpiQproj { static constexpr bool PERM = false; bf16_t* QB; float* gates;
    __device__ __forceinline__ void operator()(const AccT& acc, const UInfo& u, int wr, int wc, int fr, int fq) const {
#pragma unroll
        EPI_ROWS { const int t = u.r0 + EPI_ROW;
#pragma unroll
            EPI_COLS { const int col = u.c0 + EPI_COL; const f32x4 v = acc[ai][bj][m][n];
                if (col < 2048) *(u32x2*)(QB + (size_t)t * 2048 + col) = (u32x2){pk_bf16(v[0] * 0.08838834764831845f, v[1] * 0.08838834764831845f), pk_bf16(v[2] * 0.08838834764831845f, v[3] * 0.08838834764831845f)};
                else if (col < 2096) *(f32x4*)(gates + (size_t)t * 48 + (col - 2048)) = (f32x4){sigmoidf_(v[0]), sigmoidf_(v[1]), sigmoidf_(v[2]), sigmoidf_(v[3])}; } }
    } };
__device__ __forceinline__ float gelu_tanh(float x) { const float y = 0.7978845608028654f * (x + 0.044715f * x * x * x); const float e = fexp2(2.0f * 1.4426950408889634f * y); const float th = 1.0f - 2.0f * frcp(e + 1.0f); return 0.5f * x * (1.0f + th); }
struct EpiGelu { static constexpr bool PERM = false; bf16_t* H; const float* bias;
    __device__ __forceinline__ void operator()(const AccT& acc, const UInfo& u, int wr, int wc, int fr, int fq) const {
#pragma unroll
        EPI_ROWS { bf16_t* rp = H + (size_t)(u.r0 + EPI_ROW) * 256;
#pragma unroll
            EPI_COLS { const int col = EPI_COL; const f32x4 v = acc[ai][bj][m][n]; const f32x4 bb = *(const f32x4*)(bias + col);
                *(u32x2*)(rp + col) = (u32x2){pk_bf16(gelu_tanh(v[0] + bb[0]), gelu_tanh(v[1] + bb[1])), pk_bf16(gelu_tanh(v[2] + bb[2]), gelu_tanh(v[3] + bb[3]))}; } }
    } };
struct EpiKcmp { static constexpr bool PERM = false; bf16_t* KC;
    __device__ __forceinline__ void operator()(const AccT& acc, const UInfo& u, int wr, int wc, int fr, int fq) const {
#pragma unroll
        EPI_ROWS { const int r = u.r0 + EPI_ROW, i = r >> 2, h = r & 3;
#pragma unroll
            for (int n = 0; n < 2; ++n) { const int col = 32 * wc + 16 * n + 4 * fq; f32x4 v = acc[ai][0][m][n]; if (i == 1023) v = (f32x4){0.f, 0.f, 0.f, 0.f};
                *(u32x2*)(KC + ((size_t)h * 1024 + i) * 128 + col) = (u32x2){pk_bf16(v[0], v[1]), pk_bf16(v[2], v[3])}; } }
    } };
struct EpiVcmp { static constexpr bool PERM = false; bf16_t* VC;
    __device__ __forceinline__ void operator()(const AccT& acc, const UInfo& u, int wr, int wc, int fr, int fq) const {
#pragma unroll
        for (int m = 0; m < 4; ++m) { const int d = 64 * wr + 16 * m + fr;
#pragma unroll
            EPI_COLS { const int col = u.c0 + EPI_COL, i = col >> 2; f32x4 v = acc[0][bj][m][n]; if (i == 1023) v = (f32x4){0.f, 0.f, 0.f, 0.f};
#pragma unroll
                for (int h = 0; h < 4; ++h) VC[((size_t)h * 128 + d) * 1024 + i] = (bf16_t)(pk_bf16(v[h], 0.f) & 0xffffu); } }
    } };
struct ProbCmp1 {
    static constexpr bool PERM = false;
    const char* A; const char* B; unsigned ldb; int nt, nM; EpiGelu e;
    __device__ __forceinline__ long nunits() const { return nM; }
    __device__ __forceinline__ unsigned rowA(int R) const { return (unsigned)(R >> 2) * 65536u + (unsigned)(R & 3) * 256u; }
    __device__ __forceinline__ void unit(long L, UInfo& u) const { u.a = A + (size_t)L * 64 * 65536; u.b = B; u.r0 = (int)L * 256; u.c0 = 0; u.x0 = 0; u.x1 = 0; }
    __device__ __forceinline__ size_t aK(int kt) const { return (size_t)(kt >> 1) * 4096 + (size_t)(kt & 1) * 128; }
    __device__ __forceinline__ size_t bK(int kt) const { return (size_t)kt * 128; }
    __device__ __forceinline__ void epi(const AccT& acc, const UInfo& u, int wr, int wc, int fr, int fq) const { e(acc, u, wr, wc, fr, fq); }
};
struct ProbKV {
    static constexpr bool PERM = true;
    const char* VT; const char* KTD; bf16_t* ST; int nt;
    __device__ __forceinline__ long nunits() const { return 8 * 64 * 2; }
    __device__ __forceinline__ unsigned rowA(int R) const { return (unsigned)R * 32768u; }
    static constexpr unsigned ldb = 32768u;
    __device__ __forceinline__ void unit(long L, UInfo& u) const { const int pm = (int)L & 1, c = ((int)L >> 1) & 63, h = (int)L >> 7;
        u.a = VT + ((size_t)(h * 512 + pm * 256) * S_ + c * 256) * 2; u.b = KTD + ((size_t)(h * 256) * S_ + c * 256) * 2; u.r0 = h * 512 + pm * 256; u.c0 = c * 256; u.x0 = 0; u.x1 = 0; }
    __device__ __forceinline__ size_t aK(int kt) const { return (size_t)kt * 128; }
    __device__ __forceinline__ size_t bK(int kt) const { return (size_t)kt * 128; }
    __device__ __forceinline__ void epi(const AccT& acc, const UInfo& u, int wr, int wc, int fr, int fq) const { EpiStore e{ST, (size_t)S_}; e(acc, u, wr, wc, fr, fq); }
};
struct ProbS {
    static constexpr bool PERM = true;
    const char* Q; const char* K; bf16_t* SD; int nt;
    __device__ __forceinline__ long nunits() const { return 8 * 64; }
    __device__ __forceinline__ unsigned rowA(int R) const { return (unsigned)R * 4096u; }
    static constexpr unsigned ldb = 4096u;
    __device__ __forceinline__ void unit(long L, UInfo& u) const { const int c = (int)L & 63, h = (int)L >> 6; const size_t o = ((size_t)(c * 256) * 2048 + h * 256) * 2;
        u.a = Q + o; u.b = K + o; u.r0 = c * 256; u.c0 = h * 256; u.x0 = h; u.x1 = 0; }
    __device__ __forceinline__ size_t aK(int kt) const { return (size_t)kt * 128; }
    __device__ __forceinline__ size_t bK(int kt) const { return (size_t)kt * 128; }
    __device__ __forceinline__ void epi(const AccT& acc, const UInfo& u, int wr, int wc, int fr, int fq) const {
        const float l2g = log2gamma(u.x0);
#pragma unroll
        EPI_ROWS { const int i = EPI_ROW; bf16_t* rp = SD + (size_t)(u.r0 + i) * 2048 + u.c0;
#pragma unroll
            for (int bj = 0; bj < 2; ++bj) { const int s = 128 * bj + 32 * wc + 8 * fq; const f32x4 v = acc[ai][bj][m][0], v2 = acc[ai][bj][m][1]; float o[8];
#pragma unroll
                for (int j = 0; j < 4; ++j) { o[j] = (s + j <= i) ? v[j] * fexp2(-(float)(s + j + 1) * l2g) : 0.f; o[4 + j] = (s + 4 + j <= i) ? v2[j] * fexp2(-(float)(s + 4 + j + 1) * l2g) : 0.f; }
                *(u32x4*)(rp + s) = (u32x4){pk_bf16(o[0], o[1]), pk_bf16(o[2], o[3]), pk_bf16(o[4], o[5]), pk_bf16(o[6], o[7])}; } }
    }
};
struct ProbOut {
    static constexpr bool PERM = true;
    const char* Q; const char* ST; long dA, dB; bf16_t* Y; int nt;
    __device__ __forceinline__ long nunits() const { return 8 * 64 * 2; }
    __device__ __forceinline__ unsigned rowA(int R) const { return (unsigned)R * 4096u; }
    static constexpr unsigned ldb = 32768u;
    __device__ __forceinline__ void unit(long L, UInfo& u) const { const int pn = (int)L & 1, c = ((int)L >> 1) & 63, h = (int)L >> 7;
        u.a = Q + ((size_t)(c * 256) * 2048 + h * 256) * 2; u.b = ST + ((size_t)(h * 512 + pn * 256) * S_ + c * 256) * 2; u.r0 = c * 256; u.c0 = h * 512 + pn * 256; u.x0 = h; u.x1 = 0; }
    __device__ __forceinline__ size_t aK(int kt) const { return kt < 4 ? (size_t)kt * 128 : (size_t)(dA + (long)(kt - 4) * 128); }
    __device__ __forceinline__ size_t bK(int kt) const { return kt < 4 ? (size_t)kt * 128 : (size_t)(dB + (long)(kt - 4) * 128); }
    __device__ __forceinline__ void epi(const AccT& acc, const UInfo& u, int wr, int wc, int fr, int fq) const {
        const float l2g = log2gamma(u.x0);
#pragma unroll
        EPI_ROWS { const int i = EPI_ROW; const float qd = fexp2((float)(i + 1) * l2g); bf16_t* rp = Y + (size_t)(u.r0 + i) * 4096 + u.c0;
#pragma unroll
            for (int bj = 0; bj < 2; ++bj) { const f32x4 v = acc[ai][bj][m][0] * qd, v2 = acc[ai][bj][m][1] * qd; *(u32x4*)(rp + 128 * bj + 32 * wc + 8 * fq) = (u32x4){pk_bf16(v[0], v[1]), pk_bf16(v[2], v[3]), pk_bf16(v2[0], v2[1]), pk_bf16(v2[2], v2[3])}; } }
    }
};

__device__ __forceinline__ float shx(float v, int m, int lane) { return __int_as_float(__builtin_amdgcn_ds_bpermute((lane ^ m) << 2, __float_as_int(v))); }
__device__ __forceinline__ unsigned long long shx64(unsigned long long v, int m, int lane) {
    const unsigned lo = (unsigned)__builtin_amdgcn_ds_bpermute((lane ^ m) << 2, (int)(unsigned)v), hi = (unsigned)__builtin_amdgcn_ds_bpermute((lane ^ m) << 2, (int)(unsigned)(v >> 32));
    return ((unsigned long long)hi << 32) | lo; }
__device__ __forceinline__ float wave_sum(float v, int lane) {
#pragma unroll
    for (int o = 32; o >= 1; o >>= 1) v += shx(v, o, lane);
    return v;
}
__device__ __forceinline__ void transpose_job(const float* __restrict__ src, bf16_t* __restrict__ dst, int K, int N, int Npad, int kvperm, LAS float* tile) {
    const int tk = K / 64, tn = Npad / 64, ntile = tk * tn; const int tid = ltid();
    for (int t = blockIdx.x; t < ntile; t += gridDim.x) {
        const int k0 = (t % tk) * 64, n0 = (t / tk) * 64;
        { const int r0 = tid >> 6, cc = tid & 63;
#pragma unroll
          for (int i = 0; i < 8; ++i) { const int r = r0 + 8 * i, n = n0 + cc; tile[r * 65 + cc] = (n < N) ? src[(size_t)(k0 + r) * N + n] : 0.f; } }
        __syncthreads();
        { const int rr = tid >> 3, cc = (tid & 7) * 8; float v[8];
#pragma unroll
          for (int j = 0; j < 8; ++j) v[j] = tile[(cc + j) * 65 + rr];
          int n = n0 + rr; if (kvperm) { const int j = n >> 9; const int jp = (j == 3) ? 4 : ((j == 4) ? 3 : j); n = jp * 512 + (n & 511); }
          *(u32x4*)(dst + (size_t)n * K + k0 + cc) = (u32x4){pk_bf16(v[0], v[1]), pk_bf16(v[2], v[3]), pk_bf16(v[4], v[5]), pk_bf16(v[6], v[7])}; }
        __syncthreads();
    }
}
__device__ __forceinline__ void prep_phase(CP p, LAS unsigned char* lds) {
    LAS float* tile = (LAS float*)lds; unsigned char* ws = p->ws;
    transpose_job(p->ret_w_in, (bf16_t*)(ws + OFF_W_RIN), 2048, 12288, 12288, 0, tile);
    transpose_job(p->ret_w_out, (bf16_t*)(ws + OFF_W_ROUT), 4096, 2048, 2048, 0, tile);
    transpose_job(p->w_kv, (bf16_t*)(ws + OFF_W_KV), 2048, 3072, 3072, 1, tile);
    transpose_job(p->w1_k, (bf16_t*)(ws + OFF_W_C1K), 4096, 256, 256, 0, tile);
    transpose_job(p->w1_v, (bf16_t*)(ws + OFF_W_C1V), 4096, 256, 256, 0, tile);
    transpose_job(p->w2_k, (bf16_t*)(ws + OFF_W_C2K), 256, 128, 256, 0, tile);
    transpose_job(p->w2_v, (bf16_t*)(ws + OFF_W_C2V), 256, 128, 256, 0, tile);
    transpose_job(p->w_q, (bf16_t*)(ws + OFF_W_Q), 2048, 2096, 2304, 0, tile);
    transpose_job(p->w_o, (bf16_t*)(ws + OFF_W_O), 2048, 2048, 2048, 0, tile);
    transpose_job(p->ffn_w_in, (bf16_t*)(ws + OFF_W_FIN), 2048, 8192, 8192, 0, tile);
    transpose_job(p->ffn_w_in + (size_t)2048 * 8192, (bf16_t*)(ws + OFF_W_FIN + 32 * MiB), 2048, 8192, 8192, 0, tile);
    transpose_job(p->ffn_w_out, (bf16_t*)(ws + OFF_W_FOUT), 4096, 2048, 2048, 0, tile);
    transpose_job(p->ffn_w_out + (size_t)4096 * 2048, (bf16_t*)(ws + OFF_W_FOUT + 16 * MiB), 4096, 2048, 2048, 0, tile);
    { float2* rope = (float2*)(ws + OFF_ROPE); const int gsz = gridDim.x * 512;
      for (int i = blockIdx.x * 512 + ltid(); i < S_ * 128; i += gsz) { const int t = i >> 7, dd = i & 127;
          const float freq = exp2f(-(float)dd * (13.287712379549449f / 128.0f)); const double rev = (double)t * (double)freq * 0.15915494309189535;
          const float fx = (float)(rev - rint(rev)); rope[i] = make_float2(__builtin_amdgcn_cosf(fx), __builtin_amdgcn_sinf(fx)); } }
    if (blockIdx.x < 128) { const int kv = blockIdx.x >> 6, oc = blockIdx.x & 63; const float* pe = kv ? p->pe_v : p->pe_k; const float* w1 = kv ? p->w1_v : p->w1_k; float* peb = (float*)(ws + OFF_PEB) + kv * 256;
        const int tid = ltid(), g = tid >> 7, r = tid & 127, n = 4 * oc + g; float s = 0.f;
#pragma unroll 8
        for (int j = 0; j < 32; ++j) { const int k = r + 128 * j; s += pe[k] * w1[(size_t)k * 256 + n]; }
        s = wave_sum(s, tid & 63);
        __syncthreads(); if ((tid & 63) == 0) tile[tid >> 6] = s; __syncthreads();
        if (tid < 4) peb[4 * oc + tid] = tile[2 * tid] + tile[2 * tid + 1];
        __syncthreads(); }
}
__device__ __forceinline__ void rmsnorm_phase(const float* h, const float* g1, bf16_t* o1, const float* g2, bf16_t* o2) {
    const int w = ltid() >> 6, lane = ltid() & 63;
    for (int row = blockIdx.x * 8 + w; row < S_; row += gridDim.x * 8) {
        const f32x4* p = (const f32x4*)(h + (size_t)row * 2048); f32x4 v[8]; float ss = 0.f;
#pragma unroll
        for (int i = 0; i < 8; ++i) { v[i] = p[lane + 64 * i]; ss += v[i][0] * v[i][0] + v[i][1] * v[i][1] + v[i][2] * v[i][2] + v[i][3] * v[i][3]; }
        ss = wave_sum(ss, lane); const float r = rsqrtf(ss * (1.0f / 2048.0f) + 1e-6f);
#pragma unroll
        for (int i = 0; i < 8; ++i) { const int col = (lane + 64 * i) * 4; const f32x4 g = *(const f32x4*)(g1 + col);
            *(u32x2*)(o1 + (size_t)row * 2048 + col) = (u32x2){pk_bf16(v[i][0] * r * g[0], v[i][1] * r * g[1]), pk_bf16(v[i][2] * r * g[2], v[i][3] * r * g[3])};
            if (o2) { const f32x4 gg = *(const f32x4*)(g2 + col);
                *(u32x2*)(o2 + (size_t)row * 2048 + col) = (u32x2){pk_bf16(v[i][0] * r * gg[0], v[i][1] * r * gg[1]), pk_bf16(v[i][2] * r * gg[2], v[i][3] * r * gg[3])}; } }
    }
}
__device__ __forceinline__ void finalnorm_phase(float* h, const float* g1) {
    const int w = ltid() >> 6, lane = ltid() & 63;
    for (int row = blockIdx.x * 8 + w; row < S_; row += gridDim.x * 8) {
        f32x4* p = (f32x4*)(h + (size_t)row * 2048); f32x4 v[8]; float ss = 0.f;
#pragma unroll
        for (int i = 0; i < 8; ++i) { v[i] = p[lane + 64 * i]; ss += v[i][0] * v[i][0] + v[i][1] * v[i][1] + v[i][2] * v[i][2] + v[i][3] * v[i][3]; }
        ss = wave_sum(ss, lane); const float r = rsqrtf(ss * (1.0f / 2048.0f) + 1e-6f);
#pragma unroll
        for (int i = 0; i < 8; ++i) { const f32x4 g = *(const f32x4*)(g1 + (lane + 64 * i) * 4); p[lane + 64 * i] = v[i] * r * g; }
    }
}
__device__ __forceinline__ void scan_phase(bf16_t* ST) {
    for (int it = blockIdx.x * 512 + ltid(); it < 4096 * 32; it += gridDim.x * 512) {
        const int r = it >> 5, d8 = it & 31; const float cd = fexp2(256.0f * log2gamma(r >> 9));
        bf16_t* p = ST + (size_t)r * S_ + d8 * 8; float s[8];
#pragma unroll
        for (int j = 0; j < 8; ++j) s[j] = 0.f;
        for (int c = 0; c < 64; ++c) { const u32x4 v = *(const u32x4*)(p + c * 256);
            *(u32x4*)(p + c * 256) = (u32x4){pk_bf16(s[0], s[1]), pk_bf16(s[2], s[3]), pk_bf16(s[4], s[5]), pk_bf16(s[6], s[7])};
#pragma unroll
            for (int j = 0; j < 4; ++j) { s[2 * j] = s[2 * j] * cd + bflo(v[j]); s[2 * j + 1] = s[2 * j + 1] * cd + bfhi(v[j]); } }
    }
}
__device__ __forceinline__ void gn_phase(bf16_t* Y, const float* gain) {
    const int w = ltid() >> 6, lane = ltid() & 63;
    for (int g = blockIdx.x * 8 + w; g < S_ * 8; g += gridDim.x * 8) {
        bf16_t* p = Y + (size_t)g * 512 + lane * 8; const u32x4 v = *(const u32x4*)p; float x[8];
#pragma unroll
        for (int j = 0; j < 4; ++j) { x[2 * j] = bflo(v[j]); x[2 * j + 1] = bfhi(v[j]); }
        float s = 0.f;
#pragma unroll
        for (int j = 0; j < 8; ++j) s += x[j];
        const float mu = wave_sum(s, lane) * (1.0f / 512.0f); float q = 0.f;
#pragma unroll
        for (int j = 0; j < 8; ++j) { x[j] -= mu; q += x[j] * x[j]; }
        const float r = rsqrtf(wave_sum(q, lane) * (1.0f / 512.0f) + 1e-6f); const float* gp = gain + (g & 7) * 512 + lane * 8;
        const f32x4 g0 = *(const f32x4*)gp, g1 = *(const f32x4*)(gp + 4);
        *(u32x4*)p = (u32x4){pk_bf16(x[0] * r * g0[0], x[1] * r * g0[1]), pk_bf16(x[2] * r * g0[2], x[3] * r * g0[3]), pk_bf16(x[4] * r * g1[0], x[5] * r * g1[1]), pk_bf16(x[6] * r * g1[2], x[7] * r * g1[3])};
    }
}
__device__ __forceinline__ void conv_phase(const bf16_t* U, bf16_t* AB, const float* cw, const float* cb) {
    for (int it = blockIdx.x * 512 + ltid(); it < 512 * 512; it += gridDim.x * 512) {
        const int n8 = (it & 511) * 8, t0 = (it >> 9) * 32;
        float wa[3][8], wb[3][8], ba[8], bb[8];
#pragma unroll
        for (int tp = 0; tp < 3; ++tp)
#pragma unroll
            for (int j = 0; j < 8; ++j) { wa[tp][j] = cw[tp * 8192 + n8 + j]; wb[tp][j] = cw[tp * 8192 + 4096 + n8 + j]; }
#pragma unroll
        for (int j = 0; j < 8; ++j) { ba[j] = cb[n8 + j]; bb[j] = cb[4096 + n8 + j]; }
        float pa[2][8], pb[2][8];
#pragma unroll
        for (int k = 0; k < 2; ++k) { const int t = t0 - 2 + k; u32x4 va = (u32x4){0, 0, 0, 0}, vb = (u32x4){0, 0, 0, 0};
            if (t >= 0) { va = *(const u32x4*)(U + (size_t)t * 8192 + n8); vb = *(const u32x4*)(U + (size_t)t * 8192 + 4096 + n8); }
#pragma unroll
            for (int j = 0; j < 4; ++j) { pa[k][2 * j] = bflo(va[j]); pa[k][2 * j + 1] = bfhi(va[j]); pb[k][2 * j] = bflo(vb[j]); pb[k][2 * j + 1] = bfhi(vb[j]); } }
#pragma unroll 8
        for (int k = 0; k < 32; ++k) { const int t = t0 + k; const u32x4 va = *(const u32x4*)(U + (size_t)t * 8192 + n8), vb = *(const u32x4*)(U + (size_t)t * 8192 + 4096 + n8);
            float xa[8], xb[8], o[8];
#pragma unroll
            for (int j = 0; j < 4; ++j) { xa[2 * j] = bflo(va[j]); xa[2 * j + 1] = bfhi(va[j]); xb[2 * j] = bflo(vb[j]); xb[2 * j + 1] = bfhi(vb[j]); }
#pragma unroll
            for (int j = 0; j < 8; ++j) { const float a = ba[j] + wa[0][j] * pa[0][j] + wa[1][j] * pa[1][j] + wa[2][j] * xa[j]; const float b = bb[j] + wb[0][j] * pb[0][j] + wb[1][j] * pb[1][j] + wb[2][j] * xb[j];
                o[j] = a * sigmoidf_(a) * b; pa[0][j] = pa[1][j]; pa[1][j] = xa[j]; pb[0][j] = pb[1][j]; pb[1][j] = xb[j]; }
            *(u32x4*)(AB + (size_t)t * 4096 + n8) = (u32x4){pk_bf16(o[0], o[1]), pk_bf16(o[2], o[3]), pk_bf16(o[4], o[5]), pk_bf16(o[6], o[7])}; }
    }
}

constexpr int A_KT = 0, A_VT = 17408, A_BUFSZ = 34816, A_PSL = 69632, A_SEL = 69632 + 65536, LDS_ST = 139264;
constexpr float LOG2E = 1.4426950408889634f;
struct AttnState { f32x4 ot[8][2]; float m[2], l[2]; };

template <int MODE>
__device__ __forceinline__ void attn_compute(LAS unsigned char* lds, int boff, int tile, const bf16x8 (&qf)[2][4], AttnState& st, const int (&tpos)[2], int qb, int w, int lane,
                                             const float (&mfin)[2], const float (&linv)[2], bool rs0, bool rs1, bool masked) {
    const int l16 = lane & 15, g4 = lane >> 4;
    f32x4 s[4][2];
#pragma unroll
    for (int mt = 0; mt < 4; ++mt) { s[mt][0] = (f32x4){0.f, 0.f, 0.f, 0.f}; s[mt][1] = (f32x4){0.f, 0.f, 0.f, 0.f}; }
#pragma unroll
    for (int ks = 0; ks < 4; ++ks)
#pragma unroll
        for (int mt = 0; mt < 4; ++mt) { const bf16x8 kf = *(const LAS bf16x8*)(lds + boff + A_KT + (16 * mt + l16) * 272 + ks * 64 + g4 * 16);
            s[mt][0] = __builtin_amdgcn_mfma_f32_16x16x32_bf16(kf, qf[0][ks], s[mt][0], 0, 0, 0);
            s[mt][1] = __builtin_amdgcn_mfma_f32_16x16x32_bf16(kf, qf[1][ks], s[mt][1], 0, 0, 0);
            if (mt == 3 && (ks & 1)) __builtin_amdgcn_sched_barrier(0); }
    if (masked) {
#pragma unroll
        for (int nt = 0; nt < 2; ++nt) { const int t = tpos[nt]; const int tl = w * 8 + nt * 4 + (l16 >> 2);
#pragma unroll
            for (int mt = 0; mt < 4; ++mt)
#pragma unroll
                for (int j = 0; j < 4; ++j) { const int kl = 16 * mt + 4 * g4 + j; const int key = tile * 64 + kl; bool v;
                    if (MODE == 0 || MODE == 1) v = key <= ((t - 31) >> 4);
                    else if (MODE == 2) v = (kl <= tl);
                    else v = (key <= t) && (key > t - 512);
                    s[mt][nt][j] = v ? s[mt][nt][j] : -__builtin_inff(); } }
    }
    bf16x8 pf[2][2];
#pragma unroll
    for (int nt = 0; nt < 2; ++nt) {
        const bool rowsel = nt ? rs1 : rs0;
        const float bias = (MODE == 2 && !rowsel) ? -__builtin_inff() : 0.f;
        float mx = -1e30f;
#pragma unroll
        for (int mt = 0; mt < 4; ++mt)
#pragma unroll
            for (int j = 0; j < 4; ++j) {
                const float sv = s[mt][nt][j] * LOG2E + bias;
                s[mt][nt][j] = sv; mx = fmaxf(mx, sv); }
        float mnew, alpha = 1.f;
        if (MODE == 1) mnew = mfin[nt];
        else { mx = fmaxf(mx, shx(mx, 16, lane)); mx = fmaxf(mx, shx(mx, 32, lane)); mnew = fmaxf(st.m[nt], mx); alpha = fexp2(st.m[nt] - mnew); st.m[nt] = mnew; }
        float ps = 0.f;
#pragma unroll
        for (int mt = 0; mt < 4; ++mt)
#pragma unroll
            for (int j = 0; j < 4; ++j) { float pv = fexp2(s[mt][nt][j] - mnew); if (MODE == 1) pv *= linv[nt]; s[mt][nt][j] = pv; ps += pv; }
        if (MODE != 1) st.l[nt] = st.l[nt] * alpha + ps;
        if (MODE == 2 || MODE == 3) {
#pragma unroll
            for (int md = 0; md < 8; ++md) st.ot[md][nt] = st.ot[md][nt] * alpha;
        }
        if (MODE == 1) {
#pragma unroll
            for (int mt = 0; mt < 4; ++mt) { float a = s[mt][nt][0] + s[mt][nt][1] + s[mt][nt][2] + s[mt][nt][3], lst = s[mt][nt][3];
                a += shx(a, 1, lane); a += shx(a, 2, lane); lst += shx(lst, 1, lane); lst += shx(lst, 2, lane);
                if ((l16 & 3) == 0) { const int jb = tile * 16 + 4 * mt + g4; LAS float* pp = (LAS float*)(lds + A_PSL) + (w * 8 + nt * 4 + (l16 >> 2)) * 256;
                    atomicAdd((float*)(pp + jb), a); if (jb + 1 < 256) atomicAdd((float*)(pp + jb + 1), lst); } }
        }
        if (MODE != 0) {
#pragma unroll
            for (int kk = 0; kk < 2; ++kk) { const u32x4 pk = (u32x4){pk_bf16(s[2 * kk][nt][0], s[2 * kk][nt][1]), pk_bf16(s[2 * kk][nt][2], s[2 * kk][nt][3]), pk_bf16(s[2 * kk + 1][nt][0], s[2 * kk + 1][nt][1]), pk_bf16(s[2 * kk + 1][nt][2], s[2 * kk + 1][nt][3])};
                pf[nt][kk] = __builtin_bit_cast(bf16x8, pk); }
        }
    }
    if (MODE != 0) {
#pragma unroll
        for (int kk = 0; kk < 2; ++kk)
#pragma unroll
            for (int md = 0; md < 8; ++md) { const LAS unsigned char* vb = lds + boff + A_VT + (16 * md + l16) * 136 + kk * 64 + g4 * 8;
                const u32x2 v0 = *(const LAS u32x2*)vb, v1 = *(const LAS u32x2*)(vb + 32); const bf16x8 vf = __builtin_bit_cast(bf16x8, ((u32x4){v0[0], v0[1], v1[0], v1[1]}));
                st.ot[md][0] = __builtin_amdgcn_mfma_f32_16x16x32_bf16(vf, pf[0][kk], st.ot[md][0], 0, 0, 0);
                st.ot[md][1] = __builtin_amdgcn_mfma_f32_16x16x32_bf16(vf, pf[1][kk], st.ot[md][1], 0, 0, 0);
                if (md == 7) __builtin_amdgcn_sched_barrier(0); }
    }
}
template <int MODE>
__device__ __forceinline__ void attn_tiles(LAS unsigned char* lds, const bf16_t* kp, size_t kstride, const bf16_t* vp, size_t vstride, int tile_lo, int tile_hi,
                                           const bf16x8 (&qf)[2][4], AttnState& st, const int (&tpos)[2], int qb, int w, int lane, const float (&mfin)[2], const float (&linv)[2]) {
    if (tile_lo >= tile_hi) return;
    int tid = w * 64 + lane; asm volatile("" : "+v"(tid)); const int l16 = lane & 15;
    const int krow = tid >> 3, kc = (tid & 7) * 16, vrow = tid >> 2, vc = (tid & 3) * 16;
    u32x4 kr0, kr1, vr0 = (u32x4){0, 0, 0, 0}, vr1 = (u32x4){0, 0, 0, 0};
#define A_LOAD(T) do { const bf16_t* kg = kp + (size_t)((T) * 64 + krow) * kstride + kc; kr0 = *(const u32x4*)kg; kr1 = *(const u32x4*)(kg + 8); \
        if (MODE != 0) { const bf16_t* vg = vp + (size_t)vrow * vstride + (T) * 64 + vc; vr0 = *(const u32x4*)vg; vr1 = *(const u32x4*)(vg + 8); } } while (0)
#define A_WRITE(BO) do { LAS unsigned char* kd = lds + (BO) + A_KT + krow * 272 + kc * 2; *(LAS u32x4*)kd = kr0; *(LAS u32x4*)(kd + 16) = kr1; \
        if (MODE != 0) { LAS unsigned char* vd = lds + (BO) + A_VT + vrow * 136 + vc * 2; *(LAS u32x2*)vd = (u32x2){vr0[0], vr0[1]}; *(LAS u32x2*)(vd + 8) = (u32x2){vr0[2], vr0[3]}; *(LAS u32x2*)(vd + 16) = (u32x2){vr1[0], vr1[1]}; *(LAS u32x2*)(vd + 24) = (u32x2){vr1[2], vr1[3]}; } } while (0)
    A_LOAD(tile_lo);
    __syncthreads();
    A_WRITE(0);
    if (tile_lo + 1 < tile_hi) A_LOAD(tile_lo + 1);
    __syncthreads();
    for (int tile = tile_lo; tile < tile_hi; ++tile) {
        const int boff = ((tile - tile_lo) & 1) * A_BUFSZ;
        if (tile + 1 < tile_hi) { A_WRITE(boff ^ A_BUFSZ); if (tile + 2 < tile_hi) A_LOAD(tile + 2); }
        bool rs0 = true, rs1 = true, active = true;
        if (MODE == 2) { const int tw = tile >> 5; const unsigned bit = 1u << (tile & 31);
            const unsigned w0 = *(const LAS unsigned*)(lds + A_SEL + ((w * 8 + (l16 >> 2)) * 8 + tw) * 4), w1 = *(const LAS unsigned*)(lds + A_SEL + ((w * 8 + 4 + (l16 >> 2)) * 8 + tw) * 4);
            rs0 = (w0 & bit) != 0u; rs1 = (w1 & bit) != 0u; active = __ballot(rs0 || rs1) != 0ull; }
        if (active) {
            bool masked;
            if (MODE == 0 || MODE == 1) masked = (tile * 64 + 63 > 4 * qb - 2);
            else if (MODE == 2) masked = (tile == qb);
            else masked = (tile == qb) || (tile <= qb - 8);
            attn_compute<MODE>(lds, boff, tile, qf, st, tpos, qb, w, lane, mfin, linv, rs0, rs1, masked);
        }
        __syncthreads();
    }
#undef A_LOAD
#undef A_WRITE
}
template <int BR>
__device__ __forceinline__ void attn_finish(AttnState& st, const float* gates, float* oacc, bf16_t* att, const int (&tpos)[2], int hkv, int lane) {
    const int l16 = lane & 15, g4 = lane >> 4, g = l16 & 3;
#pragma unroll
    for (int nt = 0; nt < 2; ++nt) {
        const int t = tpos[nt]; float sc = gates[(size_t)t * 48 + (hkv * 4 + g) * 3 + BR];
        if (BR != 0) { float l = st.l[nt]; l += shx(l, 16, lane); l += shx(l, 32, lane); sc = (l > 0.f) ? sc / l : 0.f; }
        const size_t base = (size_t)t * 2048 + (hkv * 4 + g) * 128 + 4 * g4;
#pragma unroll
        for (int md = 0; md < 8; ++md) { f32x4 v = st.ot[md][nt] * sc; float* op = oacc + base + 16 * md;
            if (BR == 0) *(f32x4*)op = v;
            else if (BR == 1) *(f32x4*)op = *(const f32x4*)op + v;
            else { v = v + *(const f32x4*)op; *(u32x2*)(att + base + 16 * md) = (u32x2){pk_bf16(v[0], v[1]), pk_bf16(v[2], v[3])}; } }
    }
}
__device__ __forceinline__ void attn_reset(AttnState& st) {
#pragma unroll
    for (int md = 0; md < 8; ++md) { st.ot[md][0] = (f32x4){0.f, 0.f, 0.f, 0.f}; st.ot[md][1] = (f32x4){0.f, 0.f, 0.f, 0.f}; }
    st.m[0] = st.m[1] = -1e30f; st.l[0] = st.l[1] = 0.f;
}
__device__ __forceinline__ void attn_item(unsigned char* ws, LAS unsigned char* lds, int hkv, int qb) {
    int tid = ltid(); asm volatile("" : "+v"(tid)); const int w = tid >> 6, lane = tid & 63, l16 = lane & 15, g4 = lane >> 4;
    const bf16_t* QB = (const bf16_t*)(ws + OFF_QB); const bf16_t* KVTOK = (const bf16_t*)(ws + OFF_KVTOK); const bf16_t* KVT = (const bf16_t*)(ws + OFF_KVT);
    const bf16_t* KC = (const bf16_t*)(ws + OFF_KCMP); const bf16_t* VC = (const bf16_t*)(ws + OFF_VCMPT);
    const float* gates = (const float*)(ws + OFF_GATES); float* oacc = (float*)(ws + OFF_OACC); bf16_t* att = (bf16_t*)(ws + OFF_ATT);
    int tpos[2]; bf16x8 qf[2][4];
#pragma unroll
    for (int nt = 0; nt < 2; ++nt) { tpos[nt] = qb * 64 + w * 8 + nt * 4 + (l16 >> 2); const bf16_t* qp = QB + (size_t)tpos[nt] * 2048 + (hkv * 4 + (l16 & 3)) * 128 + g4 * 8;
#pragma unroll
        for (int ks = 0; ks < 4; ++ks) qf[nt][ks] = *(const bf16x8*)(qp + ks * 32); }
    __syncthreads();
    { LAS float* pp = (LAS float*)(lds + A_PSL) + w * 2048;
#pragma unroll
      for (int i = 0; i < 32; ++i) pp[lane + 64 * i] = 0.f; }
    AttnState st; float mfin[2] = {0.f, 0.f}, linv[2] = {0.f, 0.f};
    const int ncmp_tiles = (4 * qb + 3 + 63) >> 6;
    attn_reset(st);
    attn_tiles<0>(lds, KC + (size_t)hkv * 1024 * 128, 128, VC, 1024, 0, ncmp_tiles, qf, st, tpos, qb, w, lane, mfin, linv);
#pragma unroll
    for (int nt = 0; nt < 2; ++nt) { float l = st.l[nt]; l += shx(l, 16, lane); l += shx(l, 32, lane); mfin[nt] = st.m[nt]; linv[nt] = (l > 0.f) ? 1.0f / l : 0.f; }
    attn_reset(st);
    attn_tiles<1>(lds, KC + (size_t)hkv * 1024 * 128, 128, VC + (size_t)hkv * 128 * 1024, 1024, 0, ncmp_tiles, qf, st, tpos, qb, w, lane, mfin, linv);
    attn_finish<0>(st, gates, oacc, att, tpos, hkv, lane);
    __syncthreads();
    {
        LAS unsigned* sel = (LAS unsigned*)(lds + A_SEL) + w * 64;
        if (qb < 16) {
            if (lane < 8) { for (int tk = 0; tk < 8; ++tk) { const int lo = lane * 32; unsigned wd = 0; if (qb >= lo + 31) wd = 0xffffffffu; else if (qb >= lo) wd = (2u << (qb - lo)) - 1u; sel[tk * 8 + lane] = wd; } }
        } else {
            for (int tk = 0; tk < 8; ++tk) {
                const LAS float* pp = (const LAS float*)(lds + A_PSL) + (w * 8 + tk) * 256;
                unsigned key[4]; bool forced[4];
#pragma unroll
                for (int i = 0; i < 4; ++i) { const int j = lane + 64 * i; const float sc = pp[j]; const bool elig = (j >= 1) && (j <= qb - 2);
                    forced[i] = (j == 0) || (j == qb) || (j == qb - 1); key[i] = elig ? (__float_as_uint(sc) + 1u) : 0u; }
                unsigned prefix = 0u;
                for (int bit = 30; bit >= 0; --bit) { const unsigned cand = prefix | (1u << bit); int cnt = 0;
#pragma unroll
                    for (int i = 0; i < 4; ++i) cnt += __popcll(__ballot(key[i] >= cand));
                    if (cnt >= 13) prefix = cand; }
                int cgt = 0;
#pragma unroll
                for (int i = 0; i < 4; ++i) cgt += __popcll(__ballot(key[i] > prefix));
                const int need = 13 - cgt; int base = 0;
#pragma unroll
                for (int i = 0; i < 4; ++i) { const unsigned long long eqm = __ballot(key[i] == prefix);
                    const int rank = base + (int)__builtin_amdgcn_mbcnt_hi((unsigned)(eqm >> 32), __builtin_amdgcn_mbcnt_lo((unsigned)eqm, 0u));
                    const bool taken = forced[i] || (key[i] > prefix) || (key[i] == prefix && rank < need);
                    const unsigned long long bal = __ballot(taken); if (lane == 0) { sel[tk * 8 + 2 * i] = (unsigned)bal; sel[tk * 8 + 2 * i + 1] = (unsigned)(bal >> 32); }
                    base += __popcll(eqm); }
            }
        }
    }
    __syncthreads();
    attn_reset(st);
    attn_tiles<2>(lds, KVTOK + 2 * 512 + hkv * 128, 2048, KVT + (size_t)(hkv * 128) * S_, S_, 0, qb + 1, qf, st, tpos, qb, w, lane, mfin, linv);
    attn_finish<1>(st, gates, oacc, att, tpos, hkv, lane);
    attn_reset(st);
    attn_tiles<3>(lds, KVTOK + 3 * 512 + hkv * 128, 2048, KVT + (size_t)(512 + hkv * 128) * S_, S_, (qb - 8) > 0 ? (qb - 8) : 0, qb + 1, qf, st, tpos, qb, w, lane, mfin, linv);
    attn_finish<2>(st, gates, oacc, att, tpos, hkv, lane);
}
__device__ __forceinline__ void attn_phase(unsigned char* ws, LAS unsigned char* lds) {
#pragma nounroll
    for (int it = blockIdx.x; it < 1024; it += gridDim.x) {
        const int c = it & 255, r = it >> 8;
        attn_item(ws, lds, r, (r & 1) ? 255 - c : c);
    }
}


#define XB_TMO      128
#define XB_XCNT(j)  (256  + 64 * (j))
#define XB_XSUB(j)  (1280 + 64 * (j))
#define XB_XGEN(j)  (2304 + 64 * (j))
#define XB_TOP      3328
#define XB_TOPGEN   3392
#define XCD_BAR_WORDS 3456
#define XB_SPIN_CAP (1u << 22)
__device__ __forceinline__ unsigned xb_ld(unsigned* p)              { return __hip_atomic_load(p, __ATOMIC_RELAXED, __HIP_MEMORY_SCOPE_AGENT); }
__device__ __forceinline__ unsigned xb_add(unsigned* p, unsigned v) { return __hip_atomic_fetch_add(p, v, __ATOMIC_RELAXED, __HIP_MEMORY_SCOPE_AGENT); }
__device__ __forceinline__ unsigned xb_xcc_id() { return (unsigned)__builtin_amdgcn_s_getreg((3 << 11) | 20) & 0xFu; }
#define XB_SPIN(cond, bar) do { unsigned _sp = 0; while (cond) { __builtin_amdgcn_s_sleep(1); \
    if ((++_sp & 255u) == 0u) { if (xb_ld(&(bar)[XB_TMO])) break; if (_sp > XB_SPIN_CAP) { atomicAdd(&(bar)[XB_TMO], 1u); break; } } } } while (0)
struct XcdBarrier { unsigned* bar; unsigned x; volatile LAS unsigned* st; };
__device__ __forceinline__ XcdBarrier xcd_barrier_post(unsigned* bar, volatile LAS unsigned* st) {
    XcdBarrier b; b.bar = bar; b.x = xb_xcc_id(); b.st = st;
    if (threadIdx.x == 0) (void)xb_add(&bar[XB_XCNT(b.x)], 1u);
    return b;
}
__device__ __forceinline__ void xcd_barrier_complete(unsigned* bar, unsigned x, unsigned& nloc, unsigned& nx) {
    const unsigned G = gridDim.x * gridDim.y * gridDim.z;
    unsigned sum, cnt, mine, sp = 0u;
    for (;;) {
        sum = 0u; cnt = 0u; mine = 0u;
#pragma unroll
        for (unsigned j = 0; j < 16; ++j) { const unsigned c = xb_ld(&bar[XB_XCNT(j)]); sum += c; cnt += (c > 0u) ? 1u : 0u; mine = (j == x) ? c : mine; }
        if (sum == G) break;
        __builtin_amdgcn_s_sleep(1);
        if ((++sp & 255u) == 0u) { if (xb_ld(&bar[XB_TMO])) break; if (sp > XB_SPIN_CAP) { atomicAdd(&bar[XB_TMO], 1u); break; } }
    }
    nloc = mine > 0u ? mine : 1u; nx = cnt > 0u ? cnt : 1u;
}
__device__ __forceinline__ void xcd_barrier(const XcdBarrier& b) {
    asm volatile("s_waitcnt vmcnt(0)" ::: "memory");
    __syncthreads();
    if (threadIdx.x == 0) {
        unsigned* bar = b.bar;
        __builtin_amdgcn_s_waitcnt(0);
        unsigned nloc = b.st[0], nx = b.st[1];
        if (nloc == 0u) { xcd_barrier_complete(bar, b.x, nloc, nx); b.st[0] = nloc; b.st[1] = nx; }
        const unsigned old = xb_add(&bar[XB_XSUB(b.x)], 1u);
        const unsigned gen = old / nloc;
        if (old + 1u == (gen + 1u) * nloc) {
            __builtin_amdgcn_fence(__ATOMIC_RELEASE, "agent");
            asm volatile("s_waitcnt vmcnt(0)" ::: "memory");
            const unsigned og = xb_add(&bar[XB_TOP], 1u);
            const unsigned tg = og / nx;
            if (og + 1u == (tg + 1u) * nx) xb_add(&bar[XB_TOPGEN], 1u);
            else XB_SPIN(xb_ld(&bar[XB_TOPGEN]) == tg, bar);
            __builtin_amdgcn_fence(__ATOMIC_ACQUIRE, "agent");
            xb_add(&bar[XB_XGEN(b.x)], 1u);
            asm volatile("s_waitcnt vmcnt(0)" ::: "memory");
        } else {
            XB_SPIN(xb_ld(&bar[XB_XGEN(b.x)]) == gen, bar);
            __builtin_amdgcn_fence(__ATOMIC_ACQUIRE, "agent");
            asm volatile("s_waitcnt vmcnt(0)" ::: "memory");
        }
    }
    __syncthreads();
}

constexpr int NPH = 23;
__device__ __forceinline__ void run_phase(CP p, int ph, int b, LAS unsigned char* lds) {
    asm volatile("" : "+s"(p));
    unsigned char* ws = p->ws;
    const float* xb = p->x + (size_t)b * S_ * D_; float* hb = p->out + (size_t)b * S_ * D_;
    bf16_t* XN = (bf16_t*)(ws + OFF_XN);
    const int layer = (ph >= 13) ? 1 : 0;
    switch (ph) {
    case 0: prep_phase(p, lds); break;
    case 1: rmsnorm_phase(xb, p->norm_mix, XN, nullptr, nullptr); break;
    case 2: {
        Prob2D<EpiQK> g1{(const char*)XN, (const char*)(ws + OFF_W_RIN), 4096u, 4096u, 32, 64, 16, EpiQK{(bf16_t*)(ws + OFF_Q), (bf16_t*)(ws + OFF_K), (bf16_t*)(ws + OFF_KTD), (const float2*)(ws + OFF_ROPE)}};
        gemm_phase(lds, g1);
        Prob2D<EpiStore> g2{(const char*)(ws + OFF_W_RIN) + (size_t)4096 * 4096, (const char*)XN, 4096u, 4096u, 32, 16, 64, EpiStore{(bf16_t*)(ws + OFF_VT), (size_t)S_}};
        gemm_phase(lds, g2);
    } break;
    case 3: {
        ProbKV g3{(const char*)(ws + OFF_VT), (const char*)(ws + OFF_KTD), (bf16_t*)(ws + OFF_ST), 4};
        gemm_phase(lds, g3);
        ProbS g4{(const char*)(ws + OFF_Q), (const char*)(ws + OFF_K), (bf16_t*)(ws + OFF_SD), 4};
        gemm_phase(lds, g4);
    } break;
    case 4: scan_phase((bf16_t*)(ws + OFF_ST)); break;
    case 5: {
        ProbOut g5{(const char*)(ws + OFF_Q), (const char*)(ws + OFF_ST), (long)OFF_SD - (long)OFF_Q, (long)OFF_VT - (long)OFF_ST, (bf16_t*)(ws + OFF_Y), 8};
        gemm_phase(lds, g5);
    } break;
    case 6: gn_phase((bf16_t*)(ws + OFF_Y), p->ret_gn); break;
    case 7: {
        Prob2D<EpiGate> g6{(const char*)XN, (const char*)(ws + OFF_W_RIN) + (size_t)8192 * 4096, 4096u, 4096u, 32, 64, 16, EpiGate{(bf16_t*)(ws + OFF_Y)}};
        gemm_phase(lds, g6);
    } break;
    case 8: {
        Prob2D<EpiRes> g7{(const char*)(ws + OFF_Y), (const char*)(ws + OFF_W_ROUT), 8192u, 8192u, 64, 64, 8, EpiRes{xb, hb}};
        gemm_phase(lds, g7);
    } break;
    case 9: case 19: rmsnorm_phase(hb, p->norm_ffn + layer * 2048, XN, nullptr, nullptr); break;
    case 10: case 20: {
        Prob2D<EpiStore> g8{(const char*)XN, (const char*)(ws + OFF_W_FIN + (size_t)layer * 32 * MiB), 4096u, 4096u, 32, 64, 32, EpiStore{(bf16_t*)(ws + OFF_U), (size_t)8192}};
        gemm_phase(lds, g8);
    } break;
    case 11: case 21: conv_phase((const bf16_t*)(ws + OFF_U), (bf16_t*)(ws + OFF_AB), p->ffn_conv_w + (size_t)layer * 3 * 8192, p->ffn_conv_b + (size_t)layer * 8192); break;
    case 12: case 22: {
        Prob2D<EpiRes> g9{(const char*)(ws + OFF_AB), (const char*)(ws + OFF_W_FOUT + (size_t)layer * 16 * MiB), 8192u, 8192u, 64, 64, 8, EpiRes{hb, hb}};
        gemm_phase(lds, g9);
    } break;
    case 13: rmsnorm_phase(hb, p->norm_mix + 2048, XN, p->kv_gain, (bf16_t*)(ws + OFF_HN)); break;
    case 14: {
        Prob2D<EpiStore> g10{(const char*)(ws + OFF_HN), (const char*)(ws + OFF_W_KV), 4096u, 4096u, 32, 64, 8, EpiStore{(bf16_t*)(ws + OFF_KVTOK), (size_t)2048}};
        gemm_phase(lds, g10);
        Prob2D<EpiStore> g11{(const char*)(ws + OFF_W_KV) + (size_t)2048 * 4096, (const char*)(ws + OFF_HN), 4096u, 4096u, 32, 4, 64, EpiStore{(bf16_t*)(ws + OFF_KVT), (size_t)S_}};
        gemm_phase(lds, g11);
    } break;
    case 15: {
        ProbCmp1 a{(const char*)(ws + OFF_KVTOK), (const char*)(ws + OFF_W_C1K), 8192u, 64, 16, EpiGelu{(bf16_t*)(ws + OFF_H1), (const float*)(ws + OFF_PEB)}};
        gemm_phase(lds, a, (int)gridDim.x - 32);
        ProbCmp1 v{(const char*)(ws + OFF_KVTOK) + 1024, (const char*)(ws + OFF_W_C1V), 8192u, 64, 16, EpiGelu{(bf16_t*)(ws + OFF_H1) + 4096 * 256, (const float*)(ws + OFF_PEB) + 256}};
        gemm_phase(lds, v, (int)gridDim.x - 16);
        Prob2D<EpiQproj> g12{(const char*)XN, (const char*)(ws + OFF_W_Q), 4096u, 4096u, 32, 64, 9, EpiQproj{(bf16_t*)(ws + OFF_QB), (float*)(ws + OFF_GATES)}};
        gemm_phase(lds, g12);
    } break;
    case 16: {
        Prob2D<EpiKcmp> a{(const char*)(ws + OFF_H1), (const char*)(ws + OFF_W_C2K), 512u, 512u, 4, 16, 1, EpiKcmp{(bf16_t*)(ws + OFF_KCMP)}};
        gemm_phase(lds, a);
        Prob2D<EpiVcmp> v{(const char*)(ws + OFF_W_C2V), (const char*)(ws + OFF_H1) + (size_t)4096 * 256 * 2, 512u, 512u, 4, 1, 16, EpiVcmp{(bf16_t*)(ws + OFF_VCMPT)}};
        gemm_phase(lds, v);
    } break;
    case 17: attn_phase(ws, lds); break;
    case 18: {
        Prob2D<EpiRes> g{(const char*)(ws + OFF_ATT), (const char*)(ws + OFF_W_O), 4096u, 4096u, 32, 64, 8, EpiRes{hb, hb}};
        gemm_phase(lds, g);
    } break;
    case 23: finalnorm_phase(hb, p->final_gain); break;
    default: break;
    }
}

#if MULTI
__global__ void __launch_bounds__(512) phase_kernel(Params p, int ph, int b) {
    extern __shared__ __attribute__((aligned(16))) unsigned char shm[];
    run_phase((CP)__builtin_amdgcn_kernarg_segment_ptr(), ph, b, (LAS unsigned char*)shm);
}
#else
__global__ void __launch_bounds__(512) mega_kernel(Params p) {
    extern __shared__ __attribute__((aligned(16))) unsigned char shm[];
    cg::grid_group grid = cg::this_grid();
    CP cp = (CP)__builtin_amdgcn_kernarg_segment_ptr();
    volatile LAS unsigned* st = (volatile LAS unsigned*)((LAS unsigned char*)shm + LDS_ST);
    if (threadIdx.x == 0) { st[0] = 0u; st[1] = 0u; st[2] = 0u; st[3] = 0u; }
    __syncthreads();
    XcdBarrier xb = xcd_barrier_post((unsigned*)(cp->ws + OFF_BAR), st);
    run_phase(cp, 0, 0, (LAS unsigned char*)shm);
    grid.sync();
    for (int b = 0; b < 2; ++b)
        for (int ph = 1; ph <= NPH; ++ph) {
#ifdef PROBE_PH
            const int reps = (ph == PROBE_PH || ph == PROBE_PH2) ? 2 : 1;
#else
            const int reps = 1;
#endif
            for (int rep = 0; rep < reps; ++rep) { run_phase(cp, ph, b, (LAS unsigned char*)shm); xcd_barrier(xb); } }
}
#endif

constexpr int LDS_BYTES = LDS_ST + 16;
extern "C" void kernel_launch(void* const* d_in, const int* in_sizes, int n_in, void* d_out, int out_size, void* d_ws, size_t ws_size, hipStream_t stream) {
    static int grid = 0;
    if (grid == 0) {
        if (n_in != 21 || out_size != 2 * S_ * D_ || ws_size < WS_NEED) { fprintf(stderr, "kernel_launch: unexpected shapes/ws (n_in %d out %d ws %zu need %zu)\n", n_in, out_size, ws_size, (size_t)WS_NEED); grid = -1; return; }
#if MULTI
        if (hipFuncSetAttribute((const void*)phase_kernel, hipFuncAttributeMaxDynamicSharedMemorySize, LDS_BYTES) != hipSuccess) { fprintf(stderr, "hipFuncSetAttribute failed\n"); grid = -1; return; }
#else
        if (hipFuncSetAttribute((const void*)mega_kernel, hipFuncAttributeMaxDynamicSharedMemorySize, LDS_BYTES) != hipSuccess) { fprintf(stderr, "hipFuncSetAttribute failed\n"); grid = -1; return; }
#endif
        int dev = 0, cus = 0; hipGetDevice(&dev); hipDeviceGetAttribute(&cus, hipDeviceAttributeMultiprocessorCount, dev);
        grid = cus > 0 ? cus : 256;
    }
    if (grid < 0) return;
    Params p{};
    const float** pp = (const float**)&p;
    for (int i = 0; i < 21; ++i) pp[i] = (const float*)d_in[i];
    p.out = (float*)d_out; p.ws = (unsigned char*)d_ws;
#if MULTI
    hipLaunchKernelGGL(phase_kernel, dim3(grid), dim3(512), LDS_BYTES, stream, p, 0, 0);
    for (int b = 0; b < 2; ++b)
        for (int ph = 1; ph <= NPH; ++ph) hipLaunchKernelGGL(phase_kernel, dim3(grid), dim3(512), LDS_BYTES, stream, p, ph, b);
#else
    if (hipMemsetAsync((unsigned char*)d_ws + OFF_BAR, 0, XCD_BAR_WORDS * 4, stream) != hipSuccess) { fprintf(stderr, "memset failed\n"); return; }
    void* args[] = {&p};
    hipError_t e = hipLaunchCooperativeKernel((const void*)mega_kernel, dim3(grid), dim3(512), args, LDS_BYTES, stream);
    if (e != hipSuccess) fprintf(stderr, "cooperative launch failed: %s (grid %d)\n", hipGetErrorString(e), grid);
#endif
}
```

```cpp
#include <hip/hip_runtime.h>
#include <hip/hip_cooperative_groups.h>
#include <cstdio>
namespace cg = cooperative_groups;

#ifndef MULTI
#define MULTI 0
#endif

#define LAS __attribute__((address_space(3)))
typedef unsigned short bf16_t;
typedef short bf16x8 __attribute__((ext_vector_type(8)));
typedef float f32x4 __attribute__((ext_vector_type(4)));
typedef unsigned u32x2 __attribute__((ext_vector_type(2)));
typedef unsigned u32x4 __attribute__((ext_vector_type(4)));

constexpr int S_ = 16384, D_ = 2048;
constexpr size_t MiB = 1048576;
constexpr size_t OFF_W_RIN = 0, OFF_W_ROUT = 48 * MiB, OFF_W_KV = 64 * MiB, OFF_W_C1K = 76 * MiB, OFF_W_C1V = 78 * MiB,
                 OFF_W_C2K = 80 * MiB, OFF_W_C2V = 80 * MiB + 131072, OFF_W_Q = 81 * MiB, OFF_W_O = 90 * MiB,
                 OFF_W_FIN = 98 * MiB  , OFF_W_FOUT = 162 * MiB  , OFF_ROPE = 194 * MiB, OFF_PEB = 210 * MiB, OFF_BAR = 210 * MiB + 65536, OFF_SS = 210 * MiB + 131072  ,
                 OFF_XN = 211 * MiB, OFF_ACT = 275 * MiB;
constexpr size_t OFF_Q = OFF_ACT, OFF_K = OFF_ACT + 64 * MiB, OFF_KTD = OFF_ACT + 128 * MiB, OFF_VT = OFF_ACT + 192 * MiB,
                 OFF_ST = OFF_ACT + 320 * MiB, OFF_SD = OFF_ACT + 448 * MiB, OFF_Y = OFF_ACT + 512 * MiB, WS_NEED = OFF_ACT + 640 * MiB;
constexpr size_t OFF_U = OFF_ACT, OFF_AB = OFF_ACT + 256 * MiB;
constexpr size_t OFF_HN = OFF_ACT, OFF_KVTOK = OFF_ACT + 64 * MiB, OFF_KVT = OFF_ACT + 129 * MiB, OFF_QB = OFF_ACT + 161 * MiB,
                 OFF_GATES = OFF_ACT + 225 * MiB, OFF_H1 = OFF_ACT + 229 * MiB, OFF_KCMP = OFF_ACT + 233 * MiB, OFF_VCMPT = OFF_ACT + 234 * MiB,
                 OFF_ATT = OFF_ACT + 235 * MiB, OFF_OACC = OFF_ACT + 299 * MiB;

struct Params {
    const float* x; const float* norm_mix; const float* norm_ffn; const float* ret_w_in; const float* ret_gn; const float* ret_w_out;
    const float* kv_gain; const float* w_kv; const float* pe_k; const float* w1_k; const float* w2_k; const float* pe_v; const float* w1_v;
    const float* w2_v; const float* w_q; const float* w_o; const float* ffn_w_in; const float* ffn_conv_w; const float* ffn_conv_b;
    const float* ffn_w_out; const float* final_gain; float* out; unsigned char* ws;
};

typedef const __attribute__((address_space(4))) Params* CP;
__device__ __forceinline__ int ltid() { int t = threadIdx.x; asm volatile("" : "+v"(t)); return t; }
__device__ __forceinline__ unsigned pk_bf16(float lo, float hi) { unsigned r; asm("v_cvt_pk_bf16_f32 %0, %1, %2" : "=v"(r) : "v"(lo), "v"(hi)); return r; }
__device__ __forceinline__ float bflo(unsigned v) { return __uint_as_float(v << 16); }
__device__ __forceinline__ float bfhi(unsigned v) { return __uint_as_float(v & 0xffff0000u); }
__device__ __forceinline__ float fexp2(float x) { return __builtin_amdgcn_exp2f(x); }
__device__ __forceinline__ float frcp(float x) { return __builtin_amdgcn_rcpf(x); }
__device__ __forceinline__ float log2gamma(int h) { return log2f(1.0f - exp2f(-5.0f - (float)h)); }
__device__ __forceinline__ float sigmoidf_(float x) { return frcp(1.0f + fexp2(-1.4426950408889634f * x)); }

__device__ __forceinline__ float shx(float v, int m, int lane) { return __int_as_float(__builtin_amdgcn_ds_bpermute((lane ^ m) << 2, __float_as_int(v))); }
__device__ __forceinline__ unsigned long long shx64(unsigned long long v, int m, int lane) {
    const unsigned lo = (unsigned)__builtin_amdgcn_ds_bpermute((lane ^ m) << 2, (int)(unsigned)v), hi = (unsigned)__builtin_amdgcn_ds_bpermute((lane ^ m) << 2, (int)(unsigned)(v >> 32));
    return ((unsigned long long)hi << 32) | lo; }
__device__ __forceinline__ float wave_sum(float v, int lane) {
#pragma unroll
    for (int o = 32; o >= 1; o >>= 1) v += shx(v, o, lane);
    return v;
}
constexpr int HTB = 128 * 64 * 2;
__device__ __forceinline__ int lds_byte(int r, int c) { const int st = (r >> 4) * 2 + (c >> 5), rr = r & 15, cc = c & 31, ob = rr * 64 + cc * 2; return st * 1024 + (ob ^ (((ob >> 9) & 1) << 5)); }
__device__ __forceinline__ void stage_rc(int b, int& R, int& C) { const int st = b / 1024, sb = b % 1024, swz = sb ^ (((sb >> 9) & 1) << 5); R = (st >> 1) * 16 + swz / 64; C = (st & 1) * 32 + (swz % 64) / 2; }
__device__ __forceinline__ void tile_order(int L, int nM, int nN, int& pm, int& pn) {
    const int nwg = nM * nN; int wgid = L;
    { const int q = nwg / 8, r = nwg % 8, xcd = wgid % 8, off = wgid / 8; wgid = (xcd < r ? xcd * (q + 1) : r * (q + 1) + (xcd - r) * q) + off; }
    const int nig = 8 * nN, gid = wgid / nig, fm = gid * 8, gsz = (nM - fm) < 8 ? (nM - fm) : 8;
    pm = fm + ((wgid % nig) % gsz); pn = (wgid % nig) / gsz;
}
struct UInfo { const char* a; const char* b; int r0, c0, x0, x1; };
typedef f32x4 AccT[2][2][4][2];

template <class P>
__device__ __forceinline__ void gemm_phase(LAS unsigned char* lds, const P& pb, int cofs = 0) {
    const int tid = ltid(), wid = __builtin_amdgcn_readfirstlane(tid >> 6), lane = tid & 63, wr = wid >> 2, wc = wid & 3, fr = lane & 15, fq = lane >> 4;
    const int nt = pb.nt, G = gridDim.x, c = (int)blockIdx.x - cofs; const long nun = pb.nunits();
    if (c < 0 || c >= nun) return;
    unsigned voffA[2], voffB[2];
#pragma unroll
    for (int i = 0; i < 2; ++i) { int R, C; stage_rc(tid * 16 + i * 8192, R, C); voffA[i] = pb.rowA(R) + (unsigned)C * 2u; const int rho = R & 31; const int Rb = P::PERM ? ((R & ~31) + 8 * ((rho & 15) >> 2) + 4 * (rho >> 4) + (rho & 3)) : R; voffB[i] = (unsigned)Rb * pb.ldb + (unsigned)C * 2u; }
    const size_t hsA = pb.rowA(128), hsB = (size_t)128 * pb.ldb;
    const unsigned ldsw = (unsigned)wid * 1024u;
    const int aoff = lds_byte(wr * 64 + fr, fq * 8), boff = lds_byte(wc * 32 + fr, fq * 8);
#define G_SA(b, h) (((b) * 2 + (h)) * HTB)
#define G_SB(b, h) ((4 + (b) * 2 + (h)) * HTB)
#define G_STAGE(bufoff, gbase, voff) do { _Pragma("unroll") for (int _i = 0; _i < 2; ++_i) \
        __builtin_amdgcn_global_load_lds((const unsigned*)((const char*)(gbase) + (voff)[_i]), (LAS unsigned*)(lds + (bufoff) + ldsw + _i * 8192), 16, 0, 0); } while (0)
#define G_LDA(dst, b, h) do { _Pragma("unroll") for (int m = 0; m < 4; ++m) _Pragma("unroll") for (int k = 0; k < 2; ++k) dst[m][k] = *(const LAS bf16x8*)(lds + G_SA(b, h) + aoff + m * 2048 + k * 1024); } while (0)
#define G_LDB(dst, b, h) do { _Pragma("unroll") for (int n = 0; n < 2; ++n) _Pragma("unroll") for (int k = 0; k < 2; ++k) dst[n][k] = *(const LAS bf16x8*)(lds + G_SB(b, h) + boff + n * 2048 + k * 1024); } while (0)
#define G_MMA(ai, bj, At, Bt) do { __builtin_amdgcn_s_setprio(1); _Pragma("unroll") for (int m = 0; m < 4; ++m) _Pragma("unroll") for (int n = 0; n < 2; ++n) _Pragma("unroll") for (int k = 0; k < 2; ++k) \
        acc[ai][bj][m][n] = __builtin_amdgcn_mfma_f32_16x16x32_bf16(Bt[n][k], At[m][k], acc[ai][bj][m][n], 0, 0, 0); __builtin_amdgcn_s_setprio(0); } while (0)
#define G_WAIT_V(n) asm volatile("s_waitcnt vmcnt(" #n ")" ::: "memory")
#define G_WAIT_L(n) asm volatile("s_waitcnt lgkmcnt(" #n ")" ::: "memory")
#define G_BAR __builtin_amdgcn_s_barrier()
#define G_SCHED __builtin_amdgcn_sched_barrier(0)
    UInfo cur, nxt; int ui = 0;
    pb.unit(c, cur);
    AccT acc;
#pragma unroll
    for (int a = 0; a < 2; ++a)
#pragma unroll
        for (int b = 0; b < 2; ++b)
#pragma unroll
            for (int m = 0; m < 4; ++m)
#pragma unroll
                for (int n = 0; n < 2; ++n) acc[a][b][m][n] = (f32x4){0.f, 0.f, 0.f, 0.f};
    bf16x8 At[4][2], B0[2][2], B1[2][2];
    const char* cA = cur.a; const char* cB = cur.b;
    G_STAGE(G_SB(0, 0), cB + pb.bK(0), voffB); G_STAGE(G_SA(0, 0), cA + pb.aK(0), voffA); G_STAGE(G_SB(0, 1), cB + hsB + pb.bK(0), voffB); G_STAGE(G_SA(0, 1), cA + hsA + pb.aK(0), voffA);
    if (wr == 1) G_BAR;
    G_WAIT_V(4); G_BAR;
    G_STAGE(G_SB(1, 0), cB + pb.bK(1), voffB); G_STAGE(G_SA(1, 0), cA + pb.aK(1), voffA); G_STAGE(G_SB(1, 1), cB + hsB + pb.bK(1), voffB);
    G_WAIT_V(6); G_BAR;
    for (;;) {
        const long Ln = (long)(ui + 1) * G + c; const bool has_next = Ln < nun;
        if (has_next) pb.unit(Ln, nxt);
        const char* nA = has_next ? nxt.a : cA; const char* nB = has_next ? nxt.b : cB;
        for (int t = 0; t < nt; t += 2) {
            const bool last = (t == nt - 2);
            const char* a1 = cA + pb.aK(t + 1);
            const char* a2 = last ? nA + pb.aK(0) : cA + pb.aK(t + 2); const char* b2 = last ? nB + pb.bK(0) : cB + pb.bK(t + 2);
            const char* a3 = last ? nA + pb.aK(1) : cA + pb.aK(t + 3); const char* b3 = last ? nB + pb.bK(1) : cB + pb.bK(t + 3);
            G_LDB(B0, 0, 0); G_SCHED; G_LDA(At, 0, 0); G_STAGE(G_SA(1, 1), a1 + hsA, voffA);
            G_WAIT_L(8); G_BAR; G_WAIT_L(0); G_MMA(0, 0, At, B0); G_BAR; G_SCHED;
            G_LDB(B1, 0, 1); G_STAGE(G_SB(0, 0), b2, voffB);
            G_BAR; G_WAIT_L(0); G_MMA(0, 1, At, B1); G_BAR;
            G_LDA(At, 0, 1); G_STAGE(G_SA(0, 0), a2, voffA);
            G_BAR; G_WAIT_L(0); G_MMA(1, 0, At, B0); G_BAR; G_SCHED;
            G_STAGE(G_SB(0, 1), b2 + hsB, voffB);
            G_WAIT_V(6); G_BAR; G_MMA(1, 1, At, B1); G_BAR;
            G_LDB(B0, 1, 0); G_SCHED; G_LDA(At, 1, 0); G_STAGE(G_SA(0, 1), a2 + hsA, voffA);
            G_WAIT_L(8); G_BAR; G_WAIT_L(0); G_MMA(0, 0, At, B0); G_BAR; G_SCHED;
            G_LDB(B1, 1, 1); G_STAGE(G_SB(1, 0), b3, voffB);
            G_BAR; G_WAIT_L(0); G_MMA(0, 1, At, B1); G_BAR;
            G_LDA(At, 1, 1); G_STAGE(G_SA(1, 0), a3, voffA);
            G_BAR; G_WAIT_L(0); G_MMA(1, 0, At, B0); G_BAR; G_SCHED;
            G_STAGE(G_SB(1, 1), b3 + hsB, voffB);
            G_WAIT_V(6); G_BAR; G_MMA(1, 1, At, B1); G_BAR;
        }
        { const int l2 = ltid() & 63; pb.epi(acc, cur, wr, wc, l2 & 15, l2 >> 4); }
        if (!has_next) break;
#pragma unroll
        for (int a = 0; a < 2; ++a)
#pragma unroll
            for (int b = 0; b < 2; ++b)
#pragma unroll
                for (int m = 0; m < 4; ++m)
#pragma unroll
                    for (int n = 0; n < 2; ++n) acc[a][b][m][n] = (f32x4){0.f, 0.f, 0.f, 0.f};
        cur = nxt; cA = nA; cB = nB; ++ui;
    }
    G_WAIT_V(0);
    if (wr == 0) G_BAR;
    G_BAR;
}

#define EPI_ROWS for (int ai = 0; ai < 2; ++ai) for (int m = 0; m < 4; ++m)
#define EPI_COLS for (int bj = 0; bj < 2; ++bj) for (int n = 0; n < 2; ++n)
#define EPI_ROW (128 * ai + 64 * wr + 16 * m + fr)
#define EPI_COL (128 * bj + 32 * wc + 16 * n + 4 * fq)

template <class Epi> struct Prob2D {
    static constexpr bool PERM = Epi::PERM;
    const char* A; const char* B; unsigned lda, ldb; int nt, nM, nN; Epi e;
    __device__ __forceinline__ long nunits() const { return (long)nM * nN; }
    __device__ __forceinline__ unsigned rowA(int R) const { return (unsigned)R * lda; }
    __device__ __forceinline__ void unit(long L, UInfo& u) const { int pm, pn; tile_order((int)L, nM, nN, pm, pn); u.a = A + (size_t)pm * 256 * lda; u.b = B + (size_t)pn * 256 * ldb; u.r0 = pm * 256; u.c0 = pn * 256; u.x0 = 0; u.x1 = 0; }
    __device__ __forceinline__ size_t aK(int kt) const { return (size_t)kt * 128; }
    __device__ __forceinline__ size_t bK(int kt) const { return (size_t)kt * 128; }
    __device__ __forceinline__ void epi(const AccT& acc, const UInfo& u, int wr, int wc, int fr, int fq) const { e(acc, u, wr, wc, fr, fq); }
};
struct EpiStore { static constexpr bool PERM = true; bf16_t* O; size_t ldc;
    __device__ __forceinline__ void operator()(const AccT& acc, const UInfo& u, int wr, int wc, int fr, int fq) const {
#pragma unroll
        EPI_ROWS { bf16_t* rp = O + (size_t)(u.r0 + EPI_ROW) * ldc + u.c0;
#pragma unroll
            for (int bj = 0; bj < 2; ++bj) { const f32x4 v = acc[ai][bj][m][0], v2 = acc[ai][bj][m][1]; *(u32x4*)(rp + 128 * bj + 32 * wc + 8 * fq) = (u32x4){pk_bf16(v[0], v[1]), pk_bf16(v[2], v[3]), pk_bf16(v2[0], v2[1]), pk_bf16(v2[2], v2[3])}; } }
    } };
struct EpiRes { static constexpr bool PERM = false; const float* R; float* O; bf16_t* HB; float* ss;
    __device__ __forceinline__ void operator()(const AccT& acc, const UInfo& u, int wr, int wc, int fr, int fq) const {
#pragma unroll
        EPI_ROWS { const size_t ro = (size_t)(u.r0 + EPI_ROW) * 2048 + u.c0; float sq = 0.f;
#pragma unroll
            EPI_COLS { const f32x4 r = *(const f32x4*)(R + ro + EPI_COL); const f32x4 o = r + acc[ai][bj][m][n]; *(f32x4*)(O + ro + EPI_COL) = o;
                if (HB) { *(u32x2*)(HB + ro + EPI_COL) = (u32x2){pk_bf16(o[0], o[1]), pk_bf16(o[2], o[3])}; sq += o[0] * o[0] + o[1] * o[1] + o[2] * o[2] + o[3] * o[3]; } }
            if (HB) { const int lane = fq * 16 + fr; sq += shx(sq, 16, lane); sq += shx(sq, 32, lane); if (fq == 0) atomicAdd(ss + u.r0 + EPI_ROW, sq); } }
    } };
struct EpiStoreRS { static constexpr bool PERM = true; bf16_t* O; size_t ldc; const float* ss;
    __device__ __forceinline__ void operator()(const AccT& acc, const UInfo& u, int wr, int wc, int fr, int fq) const {
#pragma unroll
        EPI_ROWS { const int row = u.r0 + EPI_ROW; const float rs = rsqrtf(ss[row] * (1.0f / 2048.0f) + 1e-6f); bf16_t* rp = O + (size_t)row * ldc + u.c0;
#pragma unroll
            for (int bj = 0; bj < 2; ++bj) { const f32x4 v = acc[ai][bj][m][0] * rs, v2 = acc[ai][bj][m][1] * rs; *(u32x4*)(rp + 128 * bj + 32 * wc + 8 * fq) = (u32x4){pk_bf16(v[0], v[1]), pk_bf16(v[2], v[3]), pk_bf16(v2[0], v2[1]), pk_bf16(v2[2], v2[3])}; } }
    } };
struct EpiStoreCS { static constexpr bool PERM = true; bf16_t* O; size_t ldc; const float* ss;
    __device__ __forceinline__ void operator()(const AccT& acc, const UInfo& u, int wr, int wc, int fr, int fq) const {
        f32x4 rs[2][2];
#pragma unroll
        for (int bj = 0; bj < 2; ++bj)
#pragma unroll
            for (int n = 0; n < 2; ++n) { const f32x4 s4 = *(const f32x4*)(ss + u.c0 + 128 * bj + 32 * wc + 8 * fq + 4 * n);
#pragma unroll
                for (int j = 0; j < 4; ++j) rs[bj][n][j] = rsqrtf(s4[j] * (1.0f / 2048.0f) + 1e-6f); }
#pragma unroll
        EPI_ROWS { bf16_t* rp = O + (size_t)(u.r0 + EPI_ROW) * ldc + u.c0;
#pragma unroll
            for (int bj = 0; bj < 2; ++bj) { const f32x4 v = acc[ai][bj][m][0] * rs[bj][0], v2 = acc[ai][bj][m][1] * rs[bj][1]; *(u32x4*)(rp + 128 * bj + 32 * wc + 8 * fq) = (u32x4){pk_bf16(v[0], v[1]), pk_bf16(v[2], v[3]), pk_bf16(v2[0], v2[1]), pk_bf16(v2[2], v2[3])}; } }
    } };
struct EpiGate { static constexpr bool PERM = true; bf16_t* Y;
    __device__ __forceinline__ void operator()(const AccT& acc, const UInfo& u, int wr, int wc, int fr, int fq) const {
#pragma unroll
        EPI_ROWS { bf16_t* rp = Y + (size_t)(u.r0 + EPI_ROW) * 4096 + u.c0;
#pragma unroll
            for (int bj = 0; bj < 2; ++bj) { const f32x4 g = acc[ai][bj][m][0], h = acc[ai][bj][m][1]; bf16_t* cp = rp + 128 * bj + 32 * wc + 8 * fq; const u32x4 y = *(const u32x4*)cp;
                const float o0 = g[0] * sigmoidf_(g[0]) * bflo(y[0]), o1 = g[1] * sigmoidf_(g[1]) * bfhi(y[0]), o2 = g[2] * sigmoidf_(g[2]) * bflo(y[1]), o3 = g[3] * sigmoidf_(g[3]) * bfhi(y[1]);
                const float o4 = h[0] * sigmoidf_(h[0]) * bflo(y[2]), o5 = h[1] * sigmoidf_(h[1]) * bfhi(y[2]), o6 = h[2] * sigmoidf_(h[2]) * bflo(y[3]), o7 = h[3] * sigmoidf_(h[3]) * bfhi(y[3]);
                *(u32x4*)cp = (u32x4){pk_bf16(o0, o1), pk_bf16(o2, o3), pk_bf16(o4, o5), pk_bf16(o6, o7)}; } }
    } };
struct EpiQK { static constexpr bool PERM = false; bf16_t* Q; bf16_t* K; bf16_t* KTD; const float2* rope;
    __device__ __forceinline__ void operator()(const AccT& acc, const UInfo& u, int wr, int wc, int fr, int fq) const {
        const int hidx = u.c0 >> 8; const bool isk = hidx >= 8; const int hh = hidx & 7; const float l2g = log2gamma(hh);
        bf16_t* dst = (isk ? K : Q) + hh * 256; const float sc = isk ? 0.0625f : 1.0f;
#pragma unroll
        EPI_ROWS { const int t = u.r0 + EPI_ROW; const float kd = fexp2((float)(255 - (t & 255)) * l2g);
#pragma unroll
            for (int n = 0; n < 2; ++n) { const int dd = 32 * wc + 16 * n + 4 * fq;
                const f32x4 x1 = acc[ai][0][m][n], x2 = acc[ai][1][m][n]; const f32x4 cs0 = *(const f32x4*)(rope + (size_t)t * 128 + dd), cs1 = *(const f32x4*)(rope + (size_t)t * 128 + dd + 2);
                float y1[4], y2[4];
                y1[0] = (x1[0] * cs0[0] - x2[0] * cs0[1]) * sc; y2[0] = (x1[0] * cs0[1] + x2[0] * cs0[0]) * sc;
                y1[1] = (x1[1] * cs0[2] - x2[1] * cs0[3]) * sc; y2[1] = (x1[1] * cs0[3] + x2[1] * cs0[2]) * sc;
                y1[2] = (x1[2] * cs1[0] - x2[2] * cs1[1]) * sc; y2[2] = (x1[2] * cs1[1] + x2[2] * cs1[0]) * sc;
                y1[3] = (x1[3] * cs1[2] - x2[3] * cs1[3]) * sc; y2[3] = (x1[3] * cs1[3] + x2[3] * cs1[2]) * sc;
                *(u32x2*)(dst + (size_t)t * 2048 + dd) = (u32x2){pk_bf16(y1[0], y1[1]), pk_bf16(y1[2], y1[3])};
                *(u32x2*)(dst + (size_t)t * 2048 + 128 + dd) = (u32x2){pk_bf16(y2[0], y2[1]), pk_bf16(y2[2], y2[3])};
                if (isk) {
#pragma unroll
                    for (int j = 0; j < 4; ++j) { KTD[(size_t)(hh * 256 + dd + j) * S_ + t] = (bf16_t)(pk_bf16(y1[j] * kd, 0.f) & 0xffffu); KTD[(size_t)(hh * 256 + 128 + dd + j) * S_ + t] = (bf16_t)(pk_bf16(y2[j] * kd, 0.f) & 0xffffu); }
                } } }
    } };
struct EpiQproj { static constexpr bool PERM = false; bf16_t* QB; float* gates; const float* ss;
    __device__ __forceinline__ void operator()(const AccT& acc, const UInfo& u, int wr, int wc, int fr, int fq) const {
#pragma unroll
        EPI_ROWS { const int t = u.r0 + EPI_ROW; const float rs = rsqrtf(ss[t] * (1.0f / 2048.0f) + 1e-6f);
#pragma unroll
            EPI_COLS { const int col = u.c0 + EPI_COL; const f32x4 v = acc[ai][bj][m][n] * rs;
                if (col < 2048) *(u32x2*)(QB + (size_t)t * 2048 + col) = (u32x2){pk_bf16(v[0] * 0.08838834764831845f, v[1] * 0.08838834764831845f), pk_bf16(v[2] * 0.08838834764831845f, v[3] * 0.08838834764831845f)};
                else if (col < 2096) *(f32x4*)(gates + (size_t)t * 48 + (col - 2048)) = (f32x4){sigmoidf_(v[0]), sigmoidf_(v[1]), sigmoidf_(v[2]), sigmoidf_(v[3])}; } }
    } };
__device__ __forceinline__ float gelu_tanh(float x) { const float y = 0.7978845608028654f * (x + 0.044715f * x * x * x); const float e = fexp2(2.0f * 1.4426950408889634f * y); const float th = 1.0f - 2.0f * frcp(e + 1.0f); return 0.5f * x * (1.0f + th); }
struct EpiGelu { static constexpr bool PERM = false; bf16_t* H; const float* bias;
    __device__ __forceinline__ void operator()(const AccT& acc, const UInfo& u, int wr, int wc, int fr, int fq) const {
#pragma unroll
        EPI_ROWS { bf16_t* rp = H + (size_t)(u.r0 + EPI_ROW) * 256;
#pragma unroll
            EPI_COLS { const int col = EPI_COL; const f32x4 v = acc[ai][bj][m][n]; const f32x4 bb = *(const f32x4*)(bias + col);
                *(u32x2*)(rp + col) = (u32x2){pk_bf16(gelu_tanh(v[0] + bb[0]), gelu_tanh(v[1] + bb[1])), pk_bf16(gelu_tanh(v[2] + bb[2]), gelu_tanh(v[3] + bb[3]))}; } }
    } };
struct EpiKcmp { static constexpr bool PERM = false; bf16_t* KC;
    __device__ __forceinline__ void operator()(const AccT& acc, const UInfo& u, int wr, int wc, int fr, int fq) const {
#pragma unroll
        EPI_ROWS { const int r = u.r0 + EPI_ROW, i = r >> 2, h = r & 3;
#pragma unroll
            for (int n = 0; n < 2; ++n) { const int col = 32 * wc + 16 * n + 4 * fq; f32x4 v = acc[ai][0][m][n]; if (i == 1023) v = (f32x4){0.f, 0.f, 0.f, 0.f};
                *(u32x2*)(KC + ((size_t)h * 1024 + i) * 128 + col) = (u32x2){pk_bf16(v[0], v[1]), pk_bf16(v[2], v[3])}; } }
    } };
struct EpiVcmp { static constexpr bool PERM = false; bf16_t* VC;
    __device__ __forceinline__ void operator()(const AccT& acc, const UInfo& u, int wr, int wc, int fr, int fq) const {
#pragma unroll
        for (int m = 0; m < 4; ++m) { const int d = 64 * wr + 16 * m + fr;
#pragma unroll
            EPI_COLS { const int col = u.c0 + EPI_COL, i = col >> 2; f32x4 v = acc[0][bj][m][n]; if (i == 1023) v = (f32x4){0.f, 0.f, 0.f, 0.f};
#pragma unroll
                for (int h = 0; h < 4; ++h) VC[((size_t)h * 128 + d) * 1024 + i] = (bf16_t)(pk_bf16(v[h], 0.f) & 0xffffu); } }
    } };
struct ProbCmp1 {
    static constexpr bool PERM = false;
    const char* A; const char* B; unsigned ldb; int nt, nM; EpiGelu e;
    __device__ __forceinline__ long nunits() const { return nM; }
    __device__ __forceinline__ unsigned rowA(int R) const { return (unsigned)(R >> 2) * 65536u + (unsigned)(R & 3) * 256u; }
    __device__ __forceinline__ void unit(long L, UInfo& u) const { u.a = A + (size_t)L * 64 * 65536; u.b = B; u.r0 = (int)L * 256; u.c0 = 0; u.x0 = 0; u.x1 = 0; }
    __device__ __forceinline__ size_t aK(int kt) const { return (size_t)(kt >> 1) * 4096 + (size_t)(kt & 1) * 128; }
    __device__ __forceinline__ size_t bK(int kt) const { return (size_t)kt * 128; }
    __device__ __forceinline__ void epi(const AccT& acc, const UInfo& u, int wr, int wc, int fr, int fq) const { e(acc, u, wr, wc, fr, fq); }
};
struct ProbKV {
    static constexpr bool PERM = true;
    const char* VT; const char* KTD; bf16_t* ST; int nt;
    __device__ __forceinline__ long nunits() const { return 8 * 64 * 2; }
    __device__ __forceinline__ unsigned rowA(int R) const { return (unsigned)R * 32768u; }
    static constexpr unsigned ldb = 32768u;
    __device__ __forceinline__ void unit(long L, UInfo& u) const { const int pm = (int)L & 1, c = ((int)L >> 1) & 63, h = (int)L >> 7;
        u.a = VT + ((size_t)(h * 512 + pm * 256) * S_ + c * 256) * 2; u.b = KTD + ((size_t)(h * 256) * S_ + c * 256) * 2; u.r0 = h * 512 + pm * 256; u.c0 = c * 256; u.x0 = 0; u.x1 = 0; }
    __device__ __forceinline__ size_t aK(int kt) const { return (size_t)kt * 128; }
    __device__ __forceinline__ size_t bK(int kt) const { return (size_t)kt * 128; }
    __device__ __forceinline__ void epi(const AccT& acc, const UInfo& u, int wr, int wc, int fr, int fq) const { EpiStore e{ST, (size_t)S_}; e(acc, u, wr, wc, fr, fq); }
};
struct ProbS {
    static constexpr bool PERM = true;
    const char* Q; const char* K; bf16_t* SD; int nt;
    __device__ __forceinline__ long nunits() const { return 8 * 64; }
    __device__ __forceinline__ unsigned rowA(int R) const { return (unsigned)R * 4096u; }
    static constexpr unsigned ldb = 4096u;
    __device__ __forceinline__ void unit(long L, UInfo& u) const { const int c = (int)L & 63, h = (int)L >> 6; const size_t o = ((size_t)(c * 256) * 2048 + h * 256) * 2;
        u.a = Q + o; u.b = K + o; u.r0 = c * 256; u.c0 = h * 256; u.x0 = h; u.x1 = 0; }
    __device__ __forceinline__ size_t aK(int kt) const { return (size_t)kt * 128; }
    __device__ __forceinline__ size_t bK(int kt) const { return (size_t)kt * 128; }
    __device__ __forceinline__ void epi(const AccT& acc, const UInfo& u, int wr, int wc, int fr, int fq) const {
        const float l2g = log2gamma(u.x0);
#pragma unroll
        EPI_ROWS { const int i = EPI_ROW; bf16_t* rp = SD + (size_t)(u.r0 + i) * 2048 + u.c0;
#pragma unroll
            for (int bj = 0; bj < 2; ++bj) { const int s = 128 * bj + 32 * wc + 8 * fq; const f32x4 v = acc[ai][bj][m][0], v2 = acc[ai][bj][m][1]; float o[8];
#pragma unroll
                for (int j = 0; j < 4; ++j) { o[j] = (s + j <= i) ? v[j] * fexp2(-(float)(s + j + 1) * l2g) : 0.f; o[4 + j] = (s + 4 + j <= i) ? v2[j] * fexp2(-(float)(s + 4 + j + 1) * l2g) : 0.f; }
                *(u32x4*)(rp + s) = (u32x4){pk_bf16(o[0], o[1]), pk_bf16(o[2], o[3]), pk_bf16(o[4], o[5]), pk_bf16(o[6], o[7])}; } }
    }
};
struct ProbOut {
    static constexpr bool PERM = true;
    const char* Q; const char* ST; long dA, dB; bf16_t* Y; int nt;
    __device__ __forceinline__ long nunits() const { return 8 * 64 * 2; }
    __device__ __forceinline__ unsigned rowA(int R) const { return (unsigned)R * 4096u; }
    static constexpr unsigned ldb = 32768u;
    __device__ __forceinline__ void unit(long L, UInfo& u) const { const int pn = (int)L & 1, c = ((int)L >> 1) & 63, h = (int)L >> 7;
        u.a = Q + ((size_t)(c * 256) * 2048 + h * 256) * 2; u.b = ST + ((size_t)(h * 512 + pn * 256) * S_ + c * 256) * 2; u.r0 = c * 256; u.c0 = h * 512 + pn * 256; u.x0 = h; u.x1 = 0; }
    __device__ __forceinline__ size_t aK(int kt) const { return kt < 4 ? (size_t)kt * 128 : (size_t)(dA + (long)(kt - 4) * 128); }
    __device__ __forceinline__ size_t bK(int kt) const { return kt < 4 ? (size_t)kt * 128 : (size_t)(dB + (long)(kt - 4) * 128); }
    __device__ __forceinline__ void epi(const AccT& acc, const UInfo& u, int wr, int wc, int fr, int fq) const {
        const float l2g = log2gamma(u.x0);
#pragma unroll
        EPI_ROWS { const int i = EPI_ROW; const float qd = fexp2((float)(i + 1) * l2g); bf16_t* rp = Y + (size_t)(u.r0 + i) * 4096 + u.c0;
#pragma unroll
            for (int bj = 0; bj < 2; ++bj) { const f32x4 v = acc[ai][bj][m][0] * qd, v2 = acc[ai][bj][m][1] * qd; *(u32x4*)(rp + 128 * bj + 32 * wc + 8 * fq) = (u32x4){pk_bf16(v[0], v[1]), pk_bf16(v[2], v[3]), pk_bf16(v2[0], v2[1]), pk_bf16(v2[2], v2[3])}; } }
    }
};

__device__ __forceinline__ void transpose_job(const float* __restrict__ src, bf16_t* __restrict__ dst, int K, int N, int Npad, int kvperm, LAS float* tile, const float* gain = nullptr) {
    const int tk = K / 64, tn = Npad / 64, ntile = tk * tn; const int tid = ltid();
    for (int t = blockIdx.x; t < ntile; t += gridDim.x) {
        const int k0 = (t % tk) * 64, n0 = (t / tk) * 64;
        { const int r0 = tid >> 6, cc = tid & 63;
#pragma unroll
          for (int i = 0; i < 8; ++i) { const int r = r0 + 8 * i, n = n0 + cc; const float gk = gain ? gain[k0 + r] : 1.0f; tile[r * 65 + cc] = (n < N) ? src[(size_t)(k0 + r) * N + n] * gk : 0.f; } }
        __syncthreads();
        { const int rr = tid >> 3, cc = (tid & 7) * 8; float v[8];
#pragma unroll
          for (int j = 0; j < 8; ++j) v[j] = tile[(cc + j) * 65 + rr];
          int n = n0 + rr; if (kvperm) { const int j = n >> 9; const int jp = (j == 3) ? 4 : ((j == 4) ? 3 : j); n = jp * 512 + (n & 511); }
          *(u32x4*)(dst + (size_t)n * K + k0 + cc) = (u32x4){pk_bf16(v[0], v[1]), pk_bf16(v[2], v[3]), pk_bf16(v[4], v[5]), pk_bf16(v[6], v[7])}; }
        __syncthreads();
    }
}
__device__ __forceinline__ void prep_phase(CP p, LAS unsigned char* lds) {
    LAS float* tile = (LAS float*)lds; unsigned char* ws = p->ws;
    transpose_job(p->ret_w_in, (bf16_t*)(ws + OFF_W_RIN), 2048, 12288, 12288, 0, tile);
    transpose_job(p->ret_w_out, (bf16_t*)(ws + OFF_W_ROUT), 4096, 2048, 2048, 0, tile);
    transpose_job(p->w_kv, (bf16_t*)(ws + OFF_W_KV), 2048, 3072, 3072, 1, tile, p->kv_gain);
    transpose_job(p->w1_k, (bf16_t*)(ws + OFF_W_C1K), 4096, 256, 256, 0, tile);
    transpose_job(p->w1_v, (bf16_t*)(ws + OFF_W_C1V), 4096, 256, 256, 0, tile);
    transpose_job(p->w2_k, (bf16_t*)(ws + OFF_W_C2K), 256, 128, 256, 0, tile);
    transpose_job(p->w2_v, (bf16_t*)(ws + OFF_W_C2V), 256, 128, 256, 0, tile);
    transpose_job(p->w_q, (bf16_t*)(ws + OFF_W_Q), 2048, 2096, 2304, 0, tile, p->norm_mix + 2048);
    transpose_job(p->w_o, (bf16_t*)(ws + OFF_W_O), 2048, 2048, 2048, 0, tile);
    transpose_job(p->ffn_w_in, (bf16_t*)(ws + OFF_W_FIN), 2048, 8192, 8192, 0, tile, p->norm_ffn);
    transpose_job(p->ffn_w_in + (size_t)2048 * 8192, (bf16_t*)(ws + OFF_W_FIN + 32 * MiB), 2048, 8192, 8192, 0, tile, p->norm_ffn + 2048);
    transpose_job(p->ffn_w_out, (bf16_t*)(ws + OFF_W_FOUT), 4096, 2048, 2048, 0, tile);
    transpose_job(p->ffn_w_out + (size_t)4096 * 2048, (bf16_t*)(ws + OFF_W_FOUT + 16 * MiB), 4096, 2048, 2048, 0, tile);
    { float* ss = (float*)(ws + OFF_SS); for (int i = blockIdx.x * 512 + ltid(); i < 8 * S_; i += gridDim.x * 512) ss[i] = 0.f; }
    { float2* rope = (float2*)(ws + OFF_ROPE); const int gsz = gridDim.x * 512;
      for (int i = blockIdx.x * 512 + ltid(); i < S_ * 128; i += gsz) { const int t = i >> 7, dd = i & 127;
          const float freq = exp2f(-(float)dd * (13.287712379549449f / 128.0f)); const double rev = (double)t * (double)freq * 0.15915494309189535;
          const float fx = (float)(rev - rint(rev)); rope[i] = make_float2(__builtin_amdgcn_cosf(fx), __builtin_amdgcn_sinf(fx)); } }
    if (blockIdx.x < 128) { const int kv = blockIdx.x >> 6, oc = blockIdx.x & 63; const float* pe = kv ? p->pe_v : p->pe_k; const float* w1 = kv ? p->w1_v : p->w1_k; float* peb = (float*)(ws + OFF_PEB) + kv * 256;
        const int tid = ltid(), g = tid >> 7, r = tid & 127, n = 4 * oc + g; float s = 0.f;
#pragma unroll 8
        for (int j = 0; j < 32; ++j) { const int k = r + 128 * j; s += pe[k] * w1[(size_t)k * 256 + n]; }
        s = wave_sum(s, tid & 63);
        __syncthreads(); if ((tid & 63) == 0) tile[tid >> 6] = s; __syncthreads();
        if (tid < 4) peb[4 * oc + tid] = tile[2 * tid] + tile[2 * tid + 1];
        __syncthreads(); }
}
__device__ __forceinline__ void rmsnorm_phase(const float* h, const float* g1, bf16_t* o1, const float* g2, bf16_t* o2) {
    const int w = ltid() >> 6, lane = ltid() & 63;
    for (int row = blockIdx.x * 8 + w; row < S_; row += gridDim.x * 8) {
        const f32x4* p = (const f32x4*)(h + (size_t)row * 2048); f32x4 v[8]; float ss = 0.f;
#pragma unroll
        for (int i = 0; i < 8; ++i) { v[i] = p[lane + 64 * i]; ss += v[i][0] * v[i][0] + v[i][1] * v[i][1] + v[i][2] * v[i][2] + v[i][3] * v[i][3]; }
        ss = wave_sum(ss, lane); const float r = rsqrtf(ss * (1.0f / 2048.0f) + 1e-6f);
#pragma unroll
        for (int i = 0; i < 8; ++i) { const int col = (lane + 64 * i) * 4; const f32x4 g = *(const f32x4*)(g1 + col);
            *(u32x2*)(o1 + (size_t)row * 2048 + col) = (u32x2){pk_bf16(v[i][0] * r * g[0], v[i][1] * r * g[1]), pk_bf16(v[i][2] * r * g[2], v[i][3] * r * g[3])};
            if (o2) { const f32x4 gg = *(const f32x4*)(g2 + col);
                *(u32x2*)(o2 + (size_t)row * 2048 + col) = (u32x2){pk_bf16(v[i][0] * r * gg[0], v[i][1] * r * gg[1]), pk_bf16(v[i][2] * r * gg[2], v[i][3] * r * gg[3])}; } }
    }
}
__device__ __forceinline__ void finalnorm_phase(float* h, const float* g1) {
    const int w = ltid() >> 6, lane = ltid() & 63;
    for (int row = blockIdx.x * 8 + w; row < S_; row += gridDim.x * 8) {
        f32x4* p = (f32x4*)(h + (size_t)row * 2048); f32x4 v[8]; float ss = 0.f;
#pragma unroll
        for (int i = 0; i < 8; ++i) { v[i] = p[lane + 64 * i]; ss += v[i][0] * v[i][0] + v[i][1] * v[i][1] + v[i][2] * v[i][2] + v[i][3] * v[i][3]; }
        ss = wave_sum(ss, lane); const float r = rsqrtf(ss * (1.0f / 2048.0f) + 1e-6f);
#pragma unroll
        for (int i = 0; i < 8; ++i) { const f32x4 g = *(const f32x4*)(g1 + (lane + 64 * i) * 4); p[lane + 64 * i] = v[i] * r * g; }
    }
}
__device__ __forceinline__ void scan_phase(bf16_t* ST) {
    for (int it = blockIdx.x * 512 + ltid(); it < 4096 * 32; it += gridDim.x * 512) {
        const int r = it >> 5, d8 = it & 31; const float cd = fexp2(256.0f * log2gamma(r >> 9));
        bf16_t* p = ST + (size_t)r * S_ + d8 * 8; float s[8];
#pragma unroll
        for (int j = 0; j < 8; ++j) s[j] = 0.f;
        for (int c = 0; c < 64; ++c) { const u32x4 v = *(const u32x4*)(p + c * 256);
            *(u32x4*)(p + c * 256) = (u32x4){pk_bf16(s[0], s[1]), pk_bf16(s[2], s[3]), pk_bf16(s[4], s[5]), pk_bf16(s[6], s[7])};
#pragma unroll
            for (int j = 0; j < 4; ++j) { s[2 * j] = s[2 * j] * cd + bflo(v[j]); s[2 * j + 1] = s[2 * j + 1] * cd + bfhi(v[j]); } }
    }
}
__device__ __forceinline__ void gn_phase(bf16_t* Y, const float* gain) {
    const int w = ltid() >> 6, lane = ltid() & 63;
    for (int g = blockIdx.x * 8 + w; g < S_ * 8; g += gridDim.x * 8) {
        bf16_t* p = Y + (size_t)g * 512 + lane * 8; const u32x4 v = *(const u32x4*)p; float x[8];
#pragma unroll
        for (int j = 0; j < 4; ++j) { x[2 * j] = bflo(v[j]); x[2 * j + 1] = bfhi(v[j]); }
        float s = 0.f;
#pragma unroll
        for (int j = 0; j < 8; ++j) s += x[j];
        const float mu = wave_sum(s, lane) * (1.0f / 512.0f); float q = 0.f;
#pragma unroll
        for (int j = 0; j < 8; ++j) { x[j] -= mu; q += x[j] * x[j]; }
        const float r = rsqrtf(wave_sum(q, lane) * (1.0f / 512.0f) + 1e-6f); const float* gp = gain + (g & 7) * 512 + lane * 8;
        const f32x4 g0 = *(const f32x4*)gp, g1 = *(const f32x4*)(gp + 4);
        *(u32x4*)p = (u32x4){pk_bf16(x[0] * r * g0[0], x[1] * r * g0[1]), pk_bf16(x[2] * r * g0[2], x[3] * r * g0[3]), pk_bf16(x[4] * r * g1[0], x[5] * r * g1[1]), pk_bf16(x[6] * r * g1[2], x[7] * r * g1[3])};
    }
}
__device__ __forceinline__ void conv_phase(const bf16_t* U, bf16_t* AB, const float* cw, const float* cb) {
    for (int it = blockIdx.x * 512 + ltid(); it < 512 * 512; it += gridDim.x * 512) {
        const int n8 = (it & 511) * 8, t0 = (it >> 9) * 32;
        float wa[3][8], wb[3][8], ba[8], bb[8];
#pragma unroll
        for (int tp = 0; tp < 3; ++tp)
#pragma unroll
            for (int j = 0; j < 8; ++j) { wa[tp][j] = cw[tp * 8192 + n8 + j]; wb[tp][j] = cw[tp * 8192 + 4096 + n8 + j]; }
#pragma unroll
        for (int j = 0; j < 8; ++j) { ba[j] = cb[n8 + j]; bb[j] = cb[4096 + n8 + j]; }
        float pa[2][8], pb[2][8];
#pragma unroll
        for (int k = 0; k < 2; ++k) { const int t = t0 - 2 + k; u32x4 va = (u32x4){0, 0, 0, 0}, vb = (u32x4){0, 0, 0, 0};
            if (t >= 0) { va = *(const u32x4*)(U + (size_t)t * 8192 + n8); vb = *(const u32x4*)(U + (size_t)t * 8192 + 4096 + n8); }
#pragma unroll
            for (int j = 0; j < 4; ++j) { pa[k][2 * j] = bflo(va[j]); pa[k][2 * j + 1] = bfhi(va[j]); pb[k][2 * j] = bflo(vb[j]); pb[k][2 * j + 1] = bfhi(vb[j]); } }
#pragma unroll 8
        for (int k = 0; k < 32; ++k) { const int t = t0 + k; const u32x4 va = *(const u32x4*)(U + (size_t)t * 8192 + n8), vb = *(const u32x4*)(U + (size_t)t * 8192 + 4096 + n8);
            float xa[8], xb[8], o[8];
#pragma unroll
            for (int j = 0; j < 4; ++j) { xa[2 * j] = bflo(va[j]); xa[2 * j + 1] = bfhi(va[j]); xb[2 * j] = bflo(vb[j]); xb[2 * j + 1] = bfhi(vb[j]); }
#pragma unroll
            for (int j = 0; j < 8; ++j) { const float a = ba[j] + wa[0][j] * pa[0][j] + wa[1][j] * pa[1][j] + wa[2][j] * xa[j]; const float b = bb[j] + wb[0][j] * pb[0][j] + wb[1][j] * pb[1][j] + wb[2][j] * xb[j];
                o[j] = a * sigmoidf_(a) * b; pa[0][j] = pa[1][j]; pa[1][j] = xa[j]; pb[0][j] = pb[1][j]; pb[1][j] = xb[j]; }
            *(u32x4*)(AB + (size_t)t * 4096 + n8) = (u32x4){pk_bf16(o[0], o[1]), pk_bf16(o[2], o[3]), pk_bf16(o[4], o[5]), pk_bf16(o[6], o[7])}; }
    }
}

constexpr int A_KT = 0, A_VT = 17408, A_BUFSZ = 34816, A_PSL = 69632, A_SEL = 69632 + 65536, LDS_ST = 139264;
constexpr float LOG2E = 1.4426950408889634f;
struct AttnState { f32x4 ot[8][2]; float m[2], l[2]; };

template <int MODE>
__device__ __forceinline__ void attn_compute(LAS unsigned char* lds, int boff, int tile, const bf16x8 (&qf)[2][4], AttnState& st, const int (&tpos)[2], int qb, int w, int lane,
                                             const float (&mfin)[2], const float (&linv)[2], bool rs0, bool rs1, bool masked) {
    const int l16 = lane & 15, g4 = lane >> 4;
    f32x4 s[4][2];
#pragma unroll
    for (int mt = 0; mt < 4; ++mt) { s[mt][0] = (f32x4){0.f, 0.f, 0.f, 0.f}; s[mt][1] = (f32x4){0.f, 0.f, 0.f, 0.f}; }
#pragma unroll
    for (int ks = 0; ks < 4; ++ks)
#pragma unroll
        for (int mt = 0; mt < 4; ++mt) { const bf16x8 kf = *(const LAS bf16x8*)(lds + boff + A_KT + (16 * mt + l16) * 272 + ks * 64 + g4 * 16);
            s[mt][0] = __builtin_amdgcn_mfma_f32_16x16x32_bf16(kf, qf[0][ks], s[mt][0], 0, 0, 0);
            s[mt][1] = __builtin_amdgcn_mfma_f32_16x16x32_bf16(kf, qf[1][ks], s[mt][1], 0, 0, 0);
            if (mt == 3 && (ks & 1)) __builtin_amdgcn_sched_barrier(0); }
    if (masked) {
#pragma unroll
        for (int nt = 0; nt < 2; ++nt) { const int t = tpos[nt]; const int tl = w * 8 + nt * 4 + (l16 >> 2);
#pragma unroll
            for (int mt = 0; mt < 4; ++mt)
#pragma unroll
                for (int j = 0; j < 4; ++j) { const int kl = 16 * mt + 4 * g4 + j; const int key = tile * 64 + kl; bool v;
                    if (MODE == 0 || MODE == 1) v = key <= ((t - 31) >> 4);
                    else if (MODE == 2) v = (kl <= tl);
                    else v = (key <= t) && (key > t - 512);
                    s[mt][nt][j] = v ? s[mt][nt][j] : -__builtin_inff(); } }
    }
    bf16x8 pf[2][2];
#pragma unroll
    for (int nt = 0; nt < 2; ++nt) {
        const bool rowsel = nt ? rs1 : rs0;
        const float bias = (MODE == 2 && !rowsel) ? -__builtin_inff() : 0.f;
        float mx = -1e30f;
#pragma unroll
        for (int mt = 0; mt < 4; ++mt)
#pragma unroll
            for (int j = 0; j < 4; ++j) {
                const float sv = s[mt][nt][j] * LOG2E + bias;
                s[mt][nt][j] = sv; mx = fmaxf(mx, sv); }
        float mnew, alpha = 1.f;
        if (MODE == 1) mnew = mfin[nt];
        else { mx = fmaxf(mx, shx(mx, 16, lane)); mx = fmaxf(mx, shx(mx, 32, lane)); mnew = fmaxf(st.m[nt], mx); alpha = fexp2(st.m[nt] - mnew); st.m[nt] = mnew; }
        float ps = 0.f;
#pragma unroll
        for (int mt = 0; mt < 4; ++mt)
#pragma unroll
            for (int j = 0; j < 4; ++j) { float pv = fexp2(s[mt][nt][j] - mnew); if (MODE == 1) pv *= linv[nt]; s[mt][nt][j] = pv; ps += pv; }
        if (MODE != 1) st.l[nt] = st.l[nt] * alpha + ps;
        if (MODE == 2 || MODE == 3) {
#pragma unroll
            for (int md = 0; md < 8; ++md) st.ot[md][nt] = st.ot[md][nt] * alpha;
        }
        if (MODE == 1) {
#pragma unroll
            for (int mt = 0; mt < 4; ++mt) { float a = s[mt][nt][0] + s[mt][nt][1] + s[mt][nt][2] + s[mt][nt][3], lst = s[mt][nt][3];
                a += shx(a, 1, lane); a += shx(a, 2, lane); lst += shx(lst, 1, lane); lst += shx(lst, 2, lane);
                if ((l16 & 3) == 0) { const int jb = tile * 16 + 4 * mt + g4; LAS float* pp = (LAS float*)(lds + A_PSL) + (w * 8 + nt * 4 + (l16 >> 2)) * 256;
                    atomicAdd((float*)(pp + jb), a); if (jb + 1 < 256) atomicAdd((float*)(pp + jb + 1), lst); } }
        }
        if (MODE != 0) {
#pragma unroll
            for (int kk = 0; kk < 2; ++kk) { const u32x4 pk = (u32x4){pk_bf16(s[2 * kk][nt][0], s[2 * kk][nt][1]), pk_bf16(s[2 * kk][nt][2], s[2 * kk][nt][3]), pk_bf16(s[2 * kk + 1][nt][0], s[2 * kk + 1][nt][1]), pk_bf16(s[2 * kk + 1][nt][2], s[2 * kk + 1][nt][3])};
                pf[nt][kk] = __builtin_bit_cast(bf16x8, pk); }
        }
    }
    if (MODE != 0) {
#pragma unroll
        for (int kk = 0; kk < 2; ++kk)
#pragma unroll
            for (int md = 0; md < 8; ++md) { const LAS unsigned char* vb = lds + boff + A_VT + (16 * md + l16) * 136 + kk * 64 + g4 * 8;
                const u32x2 v0 = *(const LAS u32x2*)vb, v1 = *(const LAS u32x2*)(vb + 32); const bf16x8 vf = __builtin_bit_cast(bf16x8, ((u32x4){v0[0], v0[1], v1[0], v1[1]}));
                st.ot[md][0] = __builtin_amdgcn_mfma_f32_16x16x32_bf16(vf, pf[0][kk], st.ot[md][0], 0, 0, 0);
                st.ot[md][1] = __builtin_amdgcn_mfma_f32_16x16x32_bf16(vf, pf[1][kk], st.ot[md][1], 0, 0, 0);
                if (md == 7) __builtin_amdgcn_sched_barrier(0); }
    }
}
template <int MODE>
__device__ __forceinline__ void attn_tiles(LAS unsigned char* lds, const bf16_t* kp, size_t kstride, const bf16_t* vp, size_t vstride, int tile_lo, int tile_hi,
                                           const bf16x8 (&qf)[2][4], AttnState& st, const int (&tpos)[2], int qb, int w, int lane, const float (&mfin)[2], const float (&linv)[2]) {
    if (tile_lo >= tile_hi) return;
    int tid = w * 64 + lane; asm volatile("" : "+v"(tid)); const int l16 = lane & 15;
    const int krow = tid >> 3, kc = (tid & 7) * 16, vrow = tid >> 2, vc = (tid & 3) * 16;
    u32x4 kr0, kr1, vr0 = (u32x4){0, 0, 0, 0}, vr1 = (u32x4){0, 0, 0, 0};
#define A_LOAD(T) do { const bf16_t* kg = kp + (size_t)((T) * 64 + krow) * kstride + kc; kr0 = *(const u32x4*)kg; kr1 = *(const u32x4*)(kg + 8); \
        if (MODE != 0) { const bf16_t* vg = vp + (size_t)vrow * vstride + (T) * 64 + vc; vr0 = *(const u32x4*)vg; vr1 = *(const u32x4*)(vg + 8); } } while (0)
#define A_WRITE(BO) do { LAS unsigned char* kd = lds + (BO) + A_KT + krow * 272 + kc * 2; *(LAS u32x4*)kd = kr0; *(LAS u32x4*)(kd + 16) = kr1; \
        if (MODE != 0) { LAS unsigned char* vd = lds + (BO) + A_VT + vrow * 136 + vc * 2; *(LAS u32x2*)vd = (u32x2){vr0[0], vr0[1]}; *(LAS u32x2*)(vd + 8) = (u32x2){vr0[2], vr0[3]}; *(LAS u32x2*)(vd + 16) = (u32x2){vr1[0], vr1[1]}; *(LAS u32x2*)(vd + 24) = (u32x2){vr1[2], vr1[3]}; } } while (0)
    A_LOAD(tile_lo);
    __syncthreads();
    A_WRITE(0);
    if (tile_lo + 1 < tile_hi) A_LOAD(tile_lo + 1);
    __syncthreads();
    for (int tile = tile_lo; tile < tile_hi; ++tile) {
        const int boff = ((tile - tile_lo) & 1) * A_BUFSZ;
        if (tile + 1 < tile_hi) { A_WRITE(boff ^ A_BUFSZ); if (tile + 2 < tile_hi) A_LOAD(tile + 2); }
        bool rs0 = true, rs1 = true, active = true;
        if (MODE == 2) { const int tw = tile >> 5; const unsigned bit = 1u << (tile & 31);
            const unsigned w0 = *(const LAS unsigned*)(lds + A_SEL + ((w * 8 + (l16 >> 2)) * 8 + tw) * 4), w1 = *(const LAS unsigned*)(lds + A_SEL + ((w * 8 + 4 + (l16 >> 2)) * 8 + tw) * 4);
            rs0 = (w0 & bit) != 0u; rs1 = (w1 & bit) != 0u; active = __ballot(rs0 || rs1) != 0ull; }
        if (active) {
            bool masked;
            if (MODE == 0 || MODE == 1) masked = (tile * 64 + 63 > 4 * qb - 2);
            else if (MODE == 2) masked = (tile == qb);
            else masked = (tile == qb) || (tile <= qb - 8);
            attn_compute<MODE>(lds, boff, tile, qf, st, tpos, qb, w, lane, mfin, linv, rs0, rs1, masked);
        }
        __syncthreads();
    }
#undef A_LOAD
#undef A_WRITE
}
template <int BR>
__device__ __forceinline__ void attn_finish(AttnState& st, const float* gates, float* oacc, bf16_t* att, const int (&tpos)[2], int hkv, int lane) {
    const int l16 = lane & 15, g4 = lane >> 4, g = l16 & 3;
#pragma unroll
    for (int nt = 0; nt < 2; ++nt) {
        const int t = tpos[nt]; float sc = gates[(size_t)t * 48 + (hkv * 4 + g) * 3 + BR];
        if (BR != 0) { float l = st.l[nt]; l += shx(l, 16, lane); l += shx(l, 32, lane); sc = (l > 0.f) ? sc / l : 0.f; }
        const size_t base = (size_t)t * 2048 + (hkv * 4 + g) * 128 + 4 * g4;
#pragma unroll
        for (int md = 0; md < 8; ++md) { f32x4 v = st.ot[md][nt] * sc; float* op = oacc + base + 16 * md;
            if (BR == 0) *(f32x4*)op = v;
            else if (BR == 1) *(f32x4*)op = *(const f32x4*)op + v;
            else { v = v + *(const f32x4*)op; *(u32x2*)(att + base + 16 * md) = (u32x2){pk_bf16(v[0], v[1]), pk_bf16(v[2], v[3])}; } }
    }
}
__device__ __forceinline__ void attn_reset(AttnState& st) {
#pragma unroll
    for (int md = 0; md < 8; ++md) { st.ot[md][0] = (f32x4){0.f, 0.f, 0.f, 0.f}; st.ot[md][1] = (f32x4){0.f, 0.f, 0.f, 0.f}; }
    st.m[0] = st.m[1] = -1e30f; st.l[0] = st.l[1] = 0.f;
}
__device__ __forceinline__ void attn_item(unsigned char* ws, LAS unsigned char* lds, int hkv, int qb) {
    int tid = ltid(); asm volatile("" : "+v"(tid)); const int w = tid >> 6, lane = tid & 63, l16 = lane & 15, g4 = lane >> 4;
    const bf16_t* QB = (const bf16_t*)(ws + OFF_QB); const bf16_t* KVTOK = (const bf16_t*)(ws + OFF_KVTOK); const bf16_t* KVT = (const bf16_t*)(ws + OFF_KVT);
    const bf16_t* KC = (const bf16_t*)(ws + OFF_KCMP); const bf16_t* VC = (const bf16_t*)(ws + OFF_VCMPT);
    const float* gates = (const float*)(ws + OFF_GATES); float* oacc = (float*)(ws + OFF_OACC); bf16_t* att = (bf16_t*)(ws + OFF_ATT);
    int tpos[2]; bf16x8 qf[2][4];
#pragma unroll
    for (int nt = 0; nt < 2; ++nt) { tpos[nt] = qb * 64 + w * 8 + nt * 4 + (l16 >> 2); const bf16_t* qp = QB + (size_t)tpos[nt] * 2048 + (hkv * 4 + (l16 & 3)) * 128 + g4 * 8;
#pragma unroll
        for (int ks = 0; ks < 4; ++ks) qf[nt][ks] = *(const bf16x8*)(qp + ks * 32); }
    __syncthreads();
    { LAS float* pp = (LAS float*)(lds + A_PSL) + w * 2048;
#pragma unroll
      for (int i = 0; i < 32; ++i) pp[lane + 64 * i] = 0.f; }
    AttnState st; float mfin[2] = {0.f, 0.f}, linv[2] = {0.f, 0.f};
    const int ncmp_tiles = (4 * qb + 3 + 63) >> 6;
    attn_reset(st);
    attn_tiles<0>(lds, KC + (size_t)hkv * 1024 * 128, 128, VC, 1024, 0, ncmp_tiles, qf, st, tpos, qb, w, lane, mfin, linv);
#pragma unroll
    for (int nt = 0; nt < 2; ++nt) { float l = st.l[nt]; l += shx(l, 16, lane); l += shx(l, 32, lane); mfin[nt] = st.m[nt]; linv[nt] = (l > 0.f) ? 1.0f / l : 0.f; }
    attn_reset(st);
    attn_tiles<1>(lds, KC + (size_t)hkv * 1024 * 128, 128, VC + (size_t)hkv * 128 * 1024, 1024, 0, ncmp_tiles, qf, st, tpos, qb, w, lane, mfin, linv);
    attn_finish<0>(st, gates, oacc, att, tpos, hkv, lane);
    __syncthreads();
    {
        LAS unsigned* sel = (LAS unsigned*)(lds + A_SEL) + w * 64;
        if (qb < 16) {
            if (lane < 8) { for (int tk = 0; tk < 8; ++tk) { const int lo = lane * 32; unsigned wd = 0; if (qb >= lo + 31) wd = 0xffffffffu; else if (qb >= lo) wd = (2u << (qb - lo)) - 1u; sel[tk * 8 + lane] = wd; } }
        } else {
            for (int tk = 0; tk < 8; ++tk) {
                const LAS float* pp = (const LAS float*)(lds + A_PSL) + (w * 8 + tk) * 256;
                unsigned key[4]; bool forced[4];
#pragma unroll
                for (int i = 0; i < 4; ++i) { const int j = lane + 64 * i; const float sc = pp[j]; const bool elig = (j >= 1) && (j <= qb - 2);
                    forced[i] = (j == 0) || (j == qb) || (j == qb - 1); key[i] = elig ? (__float_as_uint(sc) + 1u) : 0u; }
                unsigned prefix = 0u;
                for (int bit = 30; bit >= 0; --bit) { const unsigned cand = prefix | (1u << bit); int cnt = 0;
#pragma unroll
                    for (int i = 0; i < 4; ++i) cnt += __popcll(__ballot(key[i] >= cand));
                    if (cnt >= 13) prefix = cand; }
                int cgt = 0;
#pragma unroll
                for (int i = 0; i < 4; ++i) cgt += __popcll(__ballot(key[i] > prefix));
                const int need = 13 - cgt; int base = 0;
#pragma unroll
                for (int i = 0; i < 4; ++i) { const unsigned long long eqm = __ballot(key[i] == prefix);
                    const int rank = base + (int)__builtin_amdgcn_mbcnt_hi((unsigned)(eqm >> 32), __builtin_amdgcn_mbcnt_lo((unsigned)eqm, 0u));
                    const bool taken = forced[i] || (key[i] > prefix) || (key[i] == prefix && rank < need);
                    const unsigned long long bal = __ballot(taken); if (lane == 0) { sel[tk * 8 + 2 * i] = (unsigned)bal; sel[tk * 8 + 2 * i + 1] = (unsigned)(bal >> 32); }
                    base += __popcll(eqm); }
            }
        }
    }
    __syncthreads();
    attn_reset(st);
    attn_tiles<2>(lds, KVTOK + 2 * 512 + hkv * 128, 2048, KVT + (size_t)(hkv * 128) * S_, S_, 0, qb + 1, qf, st, tpos, qb, w, lane, mfin, linv);
    attn_finish<1>(st, gates, oacc, att, tpos, hkv, lane);
    attn_reset(st);
    attn_tiles<3>(lds, KVTOK + 3 * 512 + hkv * 128, 2048, KVT + (size_t)(512 + hkv * 128) * S_, S_, (qb - 8) > 0 ? (qb - 8) : 0, qb + 1, qf, st, tpos, qb, w, lane, mfin, linv);
    attn_finish<2>(st, gates, oacc, att, tpos, hkv, lane);
}
__device__ __forceinline__ void attn_phase(unsigned char* ws, LAS unsigned char* lds) {
#pragma nounroll
    for (int it = blockIdx.x; it < 1024; it += gridDim.x) {
        const int c = it & 255, r = it >> 8;
        attn_item(ws, lds, r, (r & 1) ? 255 - c : c);
    }
}


#define XB_TMO      128
#define XB_XCNT(j)  (256  + 64 * (j))
#define XB_XSUB(j)  (1280 + 64 * (j))
#define XB_XGEN(j)  (2304 + 64 * (j))
#define XB_TOP      3328
#define XB_TOPGEN   3392
#define XCD_BAR_WORDS 3456
#define XB_SPIN_CAP (1u << 22)
__device__ __forceinline__ unsigned xb_ld(unsigned* p)              { return __hip_atomic_load(p, __ATOMIC_RELAXED, __HIP_MEMORY_SCOPE_AGENT); }
__device__ __forceinline__ unsigned xb_add(unsigned* p, unsigned v) { return __hip_atomic_fetch_add(p, v, __ATOMIC_RELAXED, __HIP_MEMORY_SCOPE_AGENT); }
__device__ __forceinline__ unsigned xb_xcc_id() { return (unsigned)__builtin_amdgcn_s_getreg((3 << 11) | 20) & 0xFu; }
#define XB_SPIN(cond, bar) do { unsigned _sp = 0; while (cond) { __builtin_amdgcn_s_sleep(1); \
    if ((++_sp & 255u) == 0u) { if (xb_ld(&(bar)[XB_TMO])) break; if (_sp > XB_SPIN_CAP) { atomicAdd(&(bar)[XB_TMO], 1u); break; } } } } while (0)
struct XcdBarrier { unsigned* bar; unsigned x; volatile LAS unsigned* st; };
__device__ __forceinline__ XcdBarrier xcd_barrier_post(unsigned* bar, volatile LAS unsigned* st) {
    XcdBarrier b; b.bar = bar; b.x = xb_xcc_id(); b.st = st;
    if (threadIdx.x == 0) (void)xb_add(&bar[XB_XCNT(b.x)], 1u);
    return b;
}
__device__ __forceinline__ void xcd_barrier_complete(unsigned* bar, unsigned x, unsigned& nloc, unsigned& nx) {
    const unsigned G = gridDim.x * gridDim.y * gridDim.z;
    unsigned sum, cnt, mine, sp = 0u;
    for (;;) {
        sum = 0u; cnt = 0u; mine = 0u;
#pragma unroll
        for (unsigned j = 0; j < 16; ++j) { const unsigned c = xb_ld(&bar[XB_XCNT(j)]); sum += c; cnt += (c > 0u) ? 1u : 0u; mine = (j == x) ? c : mine; }
        if (sum == G) break;
        __builtin_amdgcn_s_sleep(1);
        if ((++sp & 255u) == 0u) { if (xb_ld(&bar[XB_TMO])) break; if (sp > XB_SPIN_CAP) { atomicAdd(&bar[XB_TMO], 1u); break; } }
    }
    nloc = mine > 0u ? mine : 1u; nx = cnt > 0u ? cnt : 1u;
}
__device__ __forceinline__ void xcd_barrier(const XcdBarrier& b) {
    asm volatile("s_waitcnt vmcnt(0)" ::: "memory");
    __syncthreads();
    if (threadIdx.x == 0) {
        unsigned* bar = b.bar;
        __builtin_amdgcn_s_waitcnt(0);
        unsigned nloc = b.st[0], nx = b.st[1];
        if (nloc == 0u) { xcd_barrier_complete(bar, b.x, nloc, nx); b.st[0] = nloc; b.st[1] = nx; }
        const unsigned old = xb_add(&bar[XB_XSUB(b.x)], 1u);
        const unsigned gen = old / nloc;
        if (old + 1u == (gen + 1u) * nloc) {
            __builtin_amdgcn_fence(__ATOMIC_RELEASE, "agent");
            asm volatile("s_waitcnt vmcnt(0)" ::: "memory");
            const unsigned og = xb_add(&bar[XB_TOP], 1u);
            const unsigned tg = og / nx;
            if (og + 1u == (tg + 1u) * nx) xb_add(&bar[XB_TOPGEN], 1u);
            else XB_SPIN(xb_ld(&bar[XB_TOPGEN]) == tg, bar);
            __builtin_amdgcn_fence(__ATOMIC_ACQUIRE, "agent");
            xb_add(&bar[XB_XGEN(b.x)], 1u);
            asm volatile("s_waitcnt vmcnt(0)" ::: "memory");
        } else {
            XB_SPIN(xb_ld(&bar[XB_XGEN(b.x)]) == gen, bar);
            __builtin_amdgcn_fence(__ATOMIC_ACQUIRE, "agent");
            asm volatile("s_waitcnt vmcnt(0)" ::: "memory");
        }
    }
    __syncthreads();
}

constexpr int NPH = 23;
__device__ __forceinline__ void run_phase(CP p, int ph, int b, LAS unsigned char* lds) {
    asm volatile("" : "+s"(p));
    unsigned char* ws = p->ws;
    const float* xb = p->x + (size_t)b * S_ * D_; float* hb = p->out + (size_t)b * S_ * D_;
    bf16_t* XN = (bf16_t*)(ws + OFF_XN);
    const int layer = (ph >= 13) ? 1 : 0;
    switch (ph) {
    case 0: prep_phase(p, lds); break;
    case 1: rmsnorm_phase(xb, p->norm_mix, XN, nullptr, nullptr); break;
    case 2: {
        Prob2D<EpiQK> g1{(const char*)XN, (const char*)(ws + OFF_W_RIN), 4096u, 4096u, 32, 64, 16, EpiQK{(bf16_t*)(ws + OFF_Q), (bf16_t*)(ws + OFF_K), (bf16_t*)(ws + OFF_KTD), (const float2*)(ws + OFF_ROPE)}};
        gemm_phase(lds, g1);
        Prob2D<EpiStore> g2{(const char*)(ws + OFF_W_RIN) + (size_t)4096 * 4096, (const char*)XN, 4096u, 4096u, 32, 16, 64, EpiStore{(bf16_t*)(ws + OFF_VT), (size_t)S_}};
        gemm_phase(lds, g2);
    } break;
    case 3: {
        ProbKV g3{(const char*)(ws + OFF_VT), (const char*)(ws + OFF_KTD), (bf16_t*)(ws + OFF_ST), 4};
        gemm_phase(lds, g3);
        ProbS g4{(const char*)(ws + OFF_Q), (const char*)(ws + OFF_K), (bf16_t*)(ws + OFF_SD), 4};
        gemm_phase(lds, g4);
    } break;
    case 4: scan_phase((bf16_t*)(ws + OFF_ST)); break;
    case 5: {
        ProbOut g5{(const char*)(ws + OFF_Q), (const char*)(ws + OFF_ST), (long)OFF_SD - (long)OFF_Q, (long)OFF_VT - (long)OFF_ST, (bf16_t*)(ws + OFF_Y), 8};
        gemm_phase(lds, g5);
    } break;
    case 6: gn_phase((bf16_t*)(ws + OFF_Y), p->ret_gn); break;
    case 7: {
        Prob2D<EpiGate> g6{(const char*)XN, (const char*)(ws + OFF_W_RIN) + (size_t)8192 * 4096, 4096u, 4096u, 32, 64, 16, EpiGate{(bf16_t*)(ws + OFF_Y)}};
        gemm_phase(lds, g6);
    } break;
    case 8: {
        Prob2D<EpiRes> g7{(const char*)(ws + OFF_Y), (const char*)(ws + OFF_W_ROUT), 8192u, 8192u, 64, 64, 8, EpiRes{xb, hb, XN, (float*)(ws + OFF_SS) + (size_t)(b * 4 + 0) * S_}};
        gemm_phase(lds, g7);
    } break;
    case 10: case 20: {
        Prob2D<EpiStoreRS> g8{(const char*)XN, (const char*)(ws + OFF_W_FIN + (size_t)layer * 32 * MiB), 4096u, 4096u, 32, 64, 32, EpiStoreRS{(bf16_t*)(ws + OFF_U), (size_t)8192, (const float*)(ws + OFF_SS) + (size_t)(b * 4 + (layer ? 2 : 0)) * S_}};
        gemm_phase(lds, g8);
    } break;
    case 11: case 21: conv_phase((const bf16_t*)(ws + OFF_U), (bf16_t*)(ws + OFF_AB), p->ffn_conv_w + (size_t)layer * 3 * 8192, p->ffn_conv_b + (size_t)layer * 8192); break;
    case 12: case 22: {
        Prob2D<EpiRes> g9{(const char*)(ws + OFF_AB), (const char*)(ws + OFF_W_FOUT + (size_t)layer * 16 * MiB), 8192u, 8192u, 64, 64, 8, EpiRes{hb, hb, layer ? (bf16_t*)nullptr : XN, layer ? (float*)nullptr : (float*)(ws + OFF_SS) + (size_t)(b * 4 + 1) * S_}};
        gemm_phase(lds, g9);
    } break;
    case 14: {
        const float* ss1 = (const float*)(ws + OFF_SS) + (size_t)(b * 4 + 1) * S_;
        Prob2D<EpiStoreRS> g10{(const char*)XN, (const char*)(ws + OFF_W_KV), 4096u, 4096u, 32, 64, 8, EpiStoreRS{(bf16_t*)(ws + OFF_KVTOK), (size_t)2048, ss1}};
        gemm_phase(lds, g10);
        Prob2D<EpiStoreCS> g11{(const char*)(ws + OFF_W_KV) + (size_t)2048 * 4096, (const char*)XN, 4096u, 4096u, 32, 4, 64, EpiStoreCS{(bf16_t*)(ws + OFF_KVT), (size_t)S_, ss1}};
        gemm_phase(lds, g11);
    } break;
    case 15: {
        ProbCmp1 a{(const char*)(ws + OFF_KVTOK), (const char*)(ws + OFF_W_C1K), 8192u, 64, 16, EpiGelu{(bf16_t*)(ws + OFF_H1), (const float*)(ws + OFF_PEB)}};
        gemm_phase(lds, a, (int)gridDim.x - 32);
        ProbCmp1 v{(const char*)(ws + OFF_KVTOK) + 1024, (const char*)(ws + OFF_W_C1V), 8192u, 64, 16, EpiGelu{(bf16_t*)(ws + OFF_H1) + 4096 * 256, (const float*)(ws + OFF_PEB) + 256}};
        gemm_phase(lds, v, (int)gridDim.x - 16);
        Prob2D<EpiQproj> g12{(const char*)XN, (const char*)(ws + OFF_W_Q), 4096u, 4096u, 32, 64, 9, EpiQproj{(bf16_t*)(ws + OFF_QB), (float*)(ws + OFF_GATES), (const float*)(ws + OFF_SS) + (size_t)(b * 4 + 1) * S_}};
        gemm_phase(lds, g12);
    } break;
    case 16: {
        Prob2D<EpiKcmp> a{(const char*)(ws + OFF_H1), (const char*)(ws + OFF_W_C2K), 512u, 512u, 4, 16, 1, EpiKcmp{(bf16_t*)(ws + OFF_KCMP)}};
        gemm_phase(lds, a);
        Prob2D<EpiVcmp> v{(const char*)(ws + OFF_W_C2V), (const char*)(ws + OFF_H1) + (size_t)4096 * 256 * 2, 512u, 512u, 4, 1, 16, EpiVcmp{(bf16_t*)(ws + OFF_VCMPT)}};
        gemm_phase(lds, v);
    } break;
    case 17: attn_phase(ws, lds); break;
    case 18: {
        Prob2D<EpiRes> g{(const char*)(ws + OFF_ATT), (const char*)(ws + OFF_W_O), 4096u, 4096u, 32, 64, 8, EpiRes{hb, hb, XN, (float*)(ws + OFF_SS) + (size_t)(b * 4 + 2) * S_}};
        gemm_phase(lds, g);
    } break;
    case 23: finalnorm_phase(hb, p->final_gain); break;
    default: break;
    }
}

#if MULTI
__global__ void __launch_bounds__(512) phase_kernel(Params p, int ph, int b) {
    extern __shared__ __attribute__((aligned(16))) unsigned char shm[];
    run_phase((CP)__builtin_amdgcn_kernarg_segment_ptr(), ph, b, (LAS unsigned char*)shm);
}
#else
__global__ void __launch_bounds__(512) mega_kernel(Params p) {
    extern __shared__ __attribute__((aligned(16))) unsigned char shm[];
    cg::grid_group grid = cg::this_grid();
    CP cp = (CP)__builtin_amdgcn_kernarg_segment_ptr();
    volatile LAS unsigned* st = (volatile LAS unsigned*)((LAS unsigned char*)shm + LDS_ST);
    if (threadIdx.x == 0) { st[0] = 0u; st[1] = 0u; st[2] = 0u; st[3] = 0u; }
    __syncthreads();
    XcdBarrier xb = xcd_barrier_post((unsigned*)(cp->ws + OFF_BAR), st);
    run_phase(cp, 0, 0, (LAS unsigned char*)shm);
    grid.sync();
    for (int b = 0; b < 2; ++b)
        for (int ph = 1; ph <= NPH; ++ph) {
            if (ph == 9 || ph == 13 || ph == 19) continue;
#ifdef PROBE_PH
            const int reps = (ph == PROBE_PH || ph == PROBE_PH2) ? 2 : 1;
#else
            const int reps = 1;
#endif
            for (int rep = 0; rep < reps; ++rep) { run_phase(cp, ph, b, (LAS unsigned char*)shm); xcd_barrier(xb); } }
}
#endif

constexpr int LDS_BYTES = LDS_ST + 16;
extern "C" void kernel_launch(void* const* d_in, const int* in_sizes, int n_in, void* d_out, int out_size, void* d_ws, size_t ws_size, hipStream_t stream) {
    static int grid = 0;
    if (grid == 0) {
        if (n_in != 21 || out_size != 2 * S_ * D_ || ws_size < WS_NEED) { fprintf(stderr, "kernel_launch: unexpected shapes/ws (n_in %d out %d ws %zu need %zu)\n", n_in, out_size, ws_size, (size_t)WS_NEED); grid = -1; return; }
#if MULTI
        if (hipFuncSetAttribute((const void*)phase_kernel, hipFuncAttributeMaxDynamicSharedMemorySize, LDS_BYTES) != hipSuccess) { fprintf(stderr, "hipFuncSetAttribute failed\n"); grid = -1; return; }
#else
        if (hipFuncSetAttribute((const void*)mega_kernel, hipFuncAttributeMaxDynamicSharedMemorySize, LDS_BYTES) != hipSuccess) { fprintf(stderr, "hipFuncSetAttribute failed\n"); grid = -1; return; }
#endif
        int dev = 0, cus = 0; hipGetDevice(&dev); hipDeviceGetAttribute(&cus, hipDeviceAttributeMultiprocessorCount, dev);
        grid = cus > 0 ? cus : 256;
    }
    if (grid < 0) return;
    Params p{};
    const float** pp = (const float**)&p;
    for (int i = 0; i < 21; ++i) pp[i] = (const float*)d_in[i];
    p.out = (float*)d_out; p.ws = (unsigned char*)d_ws;
#if MULTI
    hipLaunchKernelGGL(phase_kernel, dim3(grid), dim3(512), LDS_BYTES, stream, p, 0, 0);
    for (int b = 0; b < 2; ++b)
        for (int ph = 1; ph <= NPH; ++ph) hipLaunchKernelGGL(phase_kernel, dim3(grid), dim3(512), LDS_BYTES, stream, p, ph, b);
#else
    if (hipMemsetAsync((unsigned char*)d_ws + OFF_BAR, 0, XCD_BAR_WORDS * 4, stream) != hipSuccess) { fprintf(stderr, "memset failed\n"); return; }
    void* args[] = {&p};
    hipError_t e = hipLaunchCooperativeKernel((const void*)mega_kernel, dim3(grid), dim3(512), args, LDS_BYTES, stream);
    if (e != hipSuccess) fprintf(stderr, "cooperative launch failed: %s (grid %d)\n", hipGetErrorString(e), grid);
#endif
}
```

```cpp
#include <hip/hip_runtime.h>
#include <hip/hip_cooperative_groups.h>
#include <cstdio>
namespace cg = cooperative_groups;

#ifndef MULTI
#define MULTI 0
#endif

#define LAS __attribute__((address_space(3)))
typedef unsigned short bf16_t;
typedef short bf16x8 __attribute__((ext_vector_type(8)));
typedef float f32x4 __attribute__((ext_vector_type(4)));
typedef unsigned u32x2 __attribute__((ext_vector_type(2)));
typedef unsigned u32x4 __attribute__((ext_vector_type(4)));

constexpr int S_ = 16384, D_ = 2048;
constexpr size_t MiB = 1048576;
constexpr size_t OFF_W_RIN = 0, OFF_W_ROUT = 48 * MiB, OFF_W_KV = 64 * MiB, OFF_W_C1K = 76 * MiB, OFF_W_C1V = 78 * MiB,
                 OFF_W_C2K = 80 * MiB, OFF_W_C2V = 80 * MiB + 131072, OFF_W_Q = 81 * MiB, OFF_W_O = 90 * MiB,
                 OFF_W_FIN = 98 * MiB  , OFF_W_FOUT = 162 * MiB  , OFF_ROPE = 194 * MiB, OFF_PEB = 210 * MiB, OFF_BAR = 210 * MiB + 65536, OFF_SS = 210 * MiB + 131072  ,
                 OFF_XN = 211 * MiB, OFF_ACT = 275 * MiB;
constexpr size_t OFF_Q = OFF_ACT, OFF_K = OFF_ACT + 64 * MiB, OFF_KTD = OFF_ACT + 128 * MiB, OFF_VT = OFF_ACT + 192 * MiB,
                 OFF_ST = OFF_ACT + 320 * MiB, OFF_SD = OFF_ACT + 448 * MiB, OFF_Y = OFF_ACT + 512 * MiB, WS_NEED = OFF_ACT + 640 * MiB;
constexpr size_t OFF_U = OFF_ACT, OFF_AB = OFF_ACT + 256 * MiB;
constexpr size_t OFF_HN = OFF_ACT, OFF_KVTOK = OFF_ACT + 64 * MiB, OFF_KVT = OFF_ACT + 129 * MiB, OFF_QB = OFF_ACT + 161 * MiB,
                 OFF_GATES = OFF_ACT + 225 * MiB, OFF_H1 = OFF_ACT + 229 * MiB, OFF_KCMP = OFF_ACT + 233 * MiB, OFF_VCMPT = OFF_ACT + 234 * MiB,
                 OFF_ATT = OFF_ACT + 235 * MiB, OFF_OACC = OFF_ACT + 299 * MiB;

struct Params {
    const float* x; const float* norm_mix; const float* norm_ffn; const float* ret_w_in; const float* ret_gn; const float* ret_w_out;
    const float* kv_gain; const float* w_kv; const float* pe_k; const float* w1_k; const float* w2_k; const float* pe_v; const float* w1_v;
    const float* w2_v; const float* w_q; const float* w_o; const float* ffn_w_in; const float* ffn_conv_w; const float* ffn_conv_b;
    const float* ffn_w_out; const float* final_gain; float* out; unsigned char* ws;
};

typedef const __attribute__((address_space(4))) Params* CP;
__device__ __forceinline__ int ltid() { int t = threadIdx.x; asm volatile("" : "+v"(t)); return t; }
__device__ __forceinline__ unsigned pk_bf16(float lo, float hi) { unsigned r; asm("v_cvt_pk_bf16_f32 %0, %1, %2" : "=v"(r) : "v"(lo), "v"(hi)); return r; }
__device__ __forceinline__ float bflo(unsigned v) { return __uint_as_float(v << 16); }
__device__ __forceinline__ float bfhi(unsigned v) { return __uint_as_float(v & 0xffff0000u); }
__device__ __forceinline__ float fexp2(float x) { return __builtin_amdgcn_exp2f(x); }
__device__ __forceinline__ float frcp(float x) { return __builtin_amdgcn_rcpf(x); }
__device__ __forceinline__ float log2gamma(int h) { return log2f(1.0f - exp2f(-5.0f - (float)h)); }
__device__ __forceinline__ float sigmoidf_(float x) { return frcp(1.0f + fexp2(-1.4426950408889634f * x)); }

__device__ __forceinline__ float shx(float v, int m, int lane) { return __int_as_float(__builtin_amdgcn_ds_bpermute((lane ^ m) << 2, __float_as_int(v))); }
__device__ __forceinline__ unsigned long long shx64(unsigned long long v, int m, int lane) {
    const unsigned lo = (unsigned)__builtin_amdgcn_ds_bpermute((lane ^ m) << 2, (int)(unsigned)v), hi = (unsigned)__builtin_amdgcn_ds_bpermute((lane ^ m) << 2, (int)(unsigned)(v >> 32));
    return ((unsigned long long)hi << 32) | lo; }
__device__ __forceinline__ float wave_sum(float v, int lane) {
#pragma unroll
    for (int o = 32; o >= 1; o >>= 1) v += shx(v, o, lane);
    return v;
}
constexpr int HTB = 128 * 64 * 2;
__device__ __forceinline__ int lds_byte(int r, int c) { const int st = (r >> 4) * 2 + (c >> 5), rr = r & 15, cc = c & 31, ob = rr * 64 + cc * 2; return st * 1024 + (ob ^ (((ob >> 9) & 1) << 5)); }
__device__ __forceinline__ void stage_rc(int b, int& R, int& C) { const int st = b / 1024, sb = b % 1024, swz = sb ^ (((sb >> 9) & 1) << 5); R = (st >> 1) * 16 + swz / 64; C = (st & 1) * 32 + (swz % 64) / 2; }
__device__ __forceinline__ void tile_order(int L, int nM, int nN, int& pm, int& pn) {
    const int nwg = nM * nN; int wgid = L;
    { const int q = nwg / 8, r = nwg % 8, xcd = wgid % 8, off = wgid / 8; wgid = (xcd < r ? xcd * (q + 1) : r * (q + 1) + (xcd - r) * q) + off; }
    const int nig = 8 * nN, gid = wgid / nig, fm = gid * 8, gsz = (nM - fm) < 8 ? (nM - fm) : 8;
    pm = fm + ((wgid % nig) % gsz); pn = (wgid % nig) / gsz;
}
struct UInfo { const char* a; const char* b; int r0, c0, x0, x1; };
typedef f32x4 AccT[2][2][4][2];

template <class P>
__device__ __forceinline__ void gemm_phase(LAS unsigned char* lds, const P& pb, int cofs = 0) {
    const int tid = ltid(), wid = __builtin_amdgcn_readfirstlane(tid >> 6), lane = tid & 63, wr = wid >> 2, wc = wid & 3, fr = lane & 15, fq = lane >> 4;
    const int nt = pb.nt, G = gridDim.x, c = (int)blockIdx.x - cofs; const long nun = pb.nunits();
    if (c < 0 || c >= nun) return;
    unsigned voffA[2], voffB[2];
#pragma unroll
    for (int i = 0; i < 2; ++i) { int R, C; stage_rc(tid * 16 + i * 8192, R, C); voffA[i] = pb.rowA(R) + (unsigned)C * 2u; const int rho = R & 31; const int Rb = P::PERM ? ((R & ~31) + 8 * ((rho & 15) >> 2) + 4 * (rho >> 4) + (rho & 3)) : R; voffB[i] = (unsigned)Rb * pb.ldb + (unsigned)C * 2u; }
    const size_t hsA = pb.rowA(128), hsB = (size_t)128 * pb.ldb;
    const unsigned ldsw = (unsigned)wid * 1024u;
    const int aoff = lds_byte(wr * 64 + fr, fq * 8), boff = lds_byte(wc * 32 + fr, fq * 8);
#define G_SA(b, h) (((b) * 2 + (h)) * HTB)
#define G_SB(b, h) ((4 + (b) * 2 + (h)) * HTB)
#define G_STAGE(bufoff, gbase, voff) do { _Pragma("unroll") for (int _i = 0; _i < 2; ++_i) \
        __builtin_amdgcn_global_load_lds((const unsigned*)((const char*)(gbase) + (voff)[_i]), (LAS unsigned*)(lds + (bufoff) + ldsw + _i * 8192), 16, 0, 0); } while (0)
#define G_LDA(dst, b, h) do { _Pragma("unroll") for (int m = 0; m < 4; ++m) _Pragma("unroll") for (int k = 0; k < 2; ++k) dst[m][k] = *(const LAS bf16x8*)(lds + G_SA(b, h) + aoff + m * 2048 + k * 1024); } while (0)
#define G_LDB(dst, b, h) do { _Pragma("unroll") for (int n = 0; n < 2; ++n) _Pragma("unroll") for (int k = 0; k < 2; ++k) dst[n][k] = *(const LAS bf16x8*)(lds + G_SB(b, h) + boff + n * 2048 + k * 1024); } while (0)
#define G_MMA(ai, bj, At, Bt) do { __builtin_amdgcn_s_setprio(1); _Pragma("unroll") for (int m = 0; m < 4; ++m) _Pragma("unroll") for (int n = 0; n < 2; ++n) _Pragma("unroll") for (int k = 0; k < 2; ++k) \
        acc[ai][bj][m][n] = __builtin_amdgcn_mfma_f32_16x16x32_bf16(Bt[n][k], At[m][k], acc[ai][bj][m][n], 0, 0, 0); __builtin_amdgcn_s_setprio(0); } while (0)
#define G_WAIT_V(n) asm volatile("s_waitcnt vmcnt(" #n ")" ::: "memory")
#define G_WAIT_L(n) asm volatile("s_waitcnt lgkmcnt(" #n ")" ::: "memory")
#define G_BAR __builtin_amdgcn_s_barrier()
#define G_SCHED __builtin_amdgcn_sched_barrier(0)
    UInfo cur, nxt; int ui = 0;
    pb.unit(c, cur);
    AccT acc;
#pragma unroll
    for (int a = 0; a < 2; ++a)
#pragma unroll
        for (int b = 0; b < 2; ++b)
#pragma unroll
            for (int m = 0; m < 4; ++m)
#pragma unroll
                for (int n = 0; n < 2; ++n) acc[a][b][m][n] = (f32x4){0.f, 0.f, 0.f, 0.f};
    bf16x8 At[4][2], B0[2][2], B1[2][2];
    const char* cA = cur.a; const char* cB = cur.b;
    G_STAGE(G_SB(0, 0), cB + pb.bK(0), voffB); G_STAGE(G_SA(0, 0), cA + pb.aK(0), voffA); G_STAGE(G_SB(0, 1), cB + hsB + pb.bK(0), voffB); G_STAGE(G_SA(0, 1), cA + hsA + pb.aK(0), voffA);
    if (wr == 1) G_BAR;
    G_WAIT_V(4); G_BAR;
    G_STAGE(G_SB(1, 0), cB + pb.bK(1), voffB); G_STAGE(G_SA(1, 0), cA + pb.aK(1), voffA); G_STAGE(G_SB(1, 1), cB + hsB + pb.bK(1), voffB);
    G_WAIT_V(6); G_BAR;
    for (;;) {
        const long Ln = (long)(ui + 1) * G + c; const bool has_next = Ln < nun;
        if (has_next) pb.unit(Ln, nxt);
        const char* nA = has_next ? nxt.a : cA; const char* nB = has_next ? nxt.b : cB;
        for (int t = 0; t < nt; t += 2) {
            const bool last = (t == nt - 2);
            const char* a1 = cA + pb.aK(t + 1);
            const char* a2 = last ? nA + pb.aK(0) : cA + pb.aK(t + 2); const char* b2 = last ? nB + pb.bK(0) : cB + pb.bK(t + 2);
            const char* a3 = last ? nA + pb.aK(1) : cA + pb.aK(t + 3); const char* b3 = last ? nB + pb.bK(1) : cB + pb.bK(t + 3);
            G_LDB(B0, 0, 0); G_SCHED; G_LDA(At, 0, 0); G_STAGE(G_SA(1, 1), a1 + hsA, voffA);
            G_WAIT_L(8); G_BAR; G_WAIT_L(0); G_MMA(0, 0, At, B0); G_BAR; G_SCHED;
            G_LDB(B1, 0, 1); G_STAGE(G_SB(0, 0), b2, voffB);
            G_BAR; G_WAIT_L(0); G_MMA(0, 1, At, B1); G_BAR;
            G_LDA(At, 0, 1); G_STAGE(G_SA(0, 0), a2, voffA);
            G_BAR; G_WAIT_L(0); G_MMA(1, 0, At, B0); G_BAR; G_SCHED;
            G_STAGE(G_SB(0, 1), b2 + hsB, voffB);
            G_WAIT_V(6); G_BAR; G_MMA(1, 1, At, B1); G_BAR;
            G_LDB(B0, 1, 0); G_SCHED; G_LDA(At, 1, 0); G_STAGE(G_SA(0, 1), a2 + hsA, voffA);
            G_WAIT_L(8); G_BAR; G_WAIT_L(0); G_MMA(0, 0, At, B0); G_BAR; G_SCHED;
            G_LDB(B1, 1, 1); G_STAGE(G_SB(1, 0), b3, voffB);
            G_BAR; G_WAIT_L(0); G_MMA(0, 1, At, B1); G_BAR;
            G_LDA(At, 1, 1); G_STAGE(G_SA(1, 0), a3, voffA);
            G_BAR; G_WAIT_L(0); G_MMA(1, 0, At, B0); G_BAR; G_SCHED;
            G_STAGE(G_SB(1, 1), b3 + hsB, voffB);
            G_WAIT_V(6); G_BAR; G_MMA(1, 1, At, B1); G_BAR;
        }
        { const int l2 = ltid() & 63; pb.epi(acc, cur, wr, wc, l2 & 15, l2 >> 4); }
        if (!has_next) break;
#pragma unroll
        for (int a = 0; a < 2; ++a)
#pragma unroll
            for (int b = 0; b < 2; ++b)
#pragma unroll
                for (int m = 0; m < 4; ++m)
#pragma unroll
                    for (int n = 0; n < 2; ++n) acc[a][b][m][n] = (f32x4){0.f, 0.f, 0.f, 0.f};
        cur = nxt; cA = nA; cB = nB; ++ui;
    }
    G_WAIT_V(0);
    if (wr == 0) G_BAR;
    G_BAR;
}

#define EPI_ROWS for (int ai = 0; ai < 2; ++ai) for (int m = 0; m < 4; ++m)
#define EPI_COLS for (int bj = 0; bj < 2; ++bj) for (int n = 0; n < 2; ++n)
#define EPI_ROW (128 * ai + 64 * wr + 16 * m + fr)
#define EPI_COL (128 * bj + 32 * wc + 16 * n + 4 * fq)

template <class Epi> struct Prob2D {
    static constexpr bool PERM = Epi::PERM;
    const char* A; const char* B; unsigned lda, ldb; int nt, nM, nN; Epi e;
    __device__ __forceinline__ long nunits() const { return (long)nM * nN; }
    __device__ __forceinline__ unsigned rowA(int R) const { return (unsigned)R * lda; }
    __device__ __forceinline__ void unit(long L, UInfo& u) const { int pm, pn; tile_order((int)L, nM, nN, pm, pn); u.a = A + (size_t)pm * 256 * lda; u.b = B + (size_t)pn * 256 * ldb; u.r0 = pm * 256; u.c0 = pn * 256; u.x0 = 0; u.x1 = 0; }
    __device__ __forceinline__ size_t aK(int kt) const { return (size_t)kt * 128; }
    __device__ __forceinline__ size_t bK(int kt) const { return (size_t)kt * 128; }
    __device__ __forceinline__ void epi(const AccT& acc, const UInfo& u, int wr, int wc, int fr, int fq) const { e(acc, u, wr, wc, fr, fq); }
};
struct EpiStore { static constexpr bool PERM = true; bf16_t* O; size_t ldc;
    __device__ __forceinline__ void operator()(const AccT& acc, const UInfo& u, int wr, int wc, int fr, int fq) const {
#pragma unroll
        EPI_ROWS { bf16_t* rp = O + (size_t)(u.r0 + EPI_ROW) * ldc + u.c0;
#pragma unroll
            for (int bj = 0; bj < 2; ++bj) { const f32x4 v = acc[ai][bj][m][0], v2 = acc[ai][bj][m][1]; *(u32x4*)(rp + 128 * bj + 32 * wc + 8 * fq) = (u32x4){pk_bf16(v[0], v[1]), pk_bf16(v[2], v[3]), pk_bf16(v2[0], v2[1]), pk_bf16(v2[2], v2[3])}; } }
    } };
struct EpiRes { static constexpr bool PERM = false; const float* R; float* O; bf16_t* HB; float* ss;
    __device__ __forceinline__ void operator()(const AccT& acc, const UInfo& u, int wr, int wc, int fr, int fq) const {
#pragma unroll
        EPI_ROWS { const size_t ro = (size_t)(u.r0 + EPI_ROW) * 2048 + u.c0; float sq = 0.f;
#pragma unroll
            EPI_COLS { const f32x4 r = *(const f32x4*)(R + ro + EPI_COL); const f32x4 o = r + acc[ai][bj][m][n]; *(f32x4*)(O + ro + EPI_COL) = o;
                if (HB) { *(u32x2*)(HB + ro + EPI_COL) = (u32x2){pk_bf16(o[0], o[1]), pk_bf16(o[2], o[3])}; sq += o[0] * o[0] + o[1] * o[1] + o[2] * o[2] + o[3] * o[3]; } }
            if (HB) { const int lane = fq * 16 + fr; sq += shx(sq, 16, lane); sq += shx(sq, 32, lane); if (fq == 0) atomicAdd(ss + u.r0 + EPI_ROW, sq); } }
    } };
struct EpiStoreRS { static constexpr bool PERM = true; bf16_t* O; size_t ldc; const float* ss;
    __device__ __forceinline__ void operator()(const AccT& acc, const UInfo& u, int wr, int wc, int fr, int fq) const {
#pragma unroll
        EPI_ROWS { const int row = u.r0 + EPI_ROW; const float rs = rsqrtf(ss[row] * (1.0f / 2048.0f) + 1e-6f); bf16_t* rp = O + (size_t)row * ldc + u.c0;
#pragma unroll
            for (int bj = 0; bj < 2; ++bj) { const f32x4 v = acc[ai][bj][m][0] * rs, v2 = acc[ai][bj][m][1] * rs; *(u32x4*)(rp + 128 * bj + 32 * wc + 8 * fq) = (u32x4){pk_bf16(v[0], v[1]), pk_bf16(v[2], v[3]), pk_bf16(v2[0], v2[1]), pk_bf16(v2[2], v2[3])}; } }
    } };
struct EpiStoreCS { static constexpr bool PERM = true; bf16_t* O; size_t ldc; const float* ss;
    __device__ __forceinline__ void operator()(const AccT& acc, const UInfo& u, int wr, int wc, int fr, int fq) const {
        f32x4 rs[2][2];
#pragma unroll
        for (int bj = 0; bj < 2; ++bj)
#pragma unroll
            for (int n = 0; n < 2; ++n) { const f32x4 s4 = *(const f32x4*)(ss + u.c0 + 128 * bj + 32 * wc + 8 * fq + 4 * n);
#pragma unroll
                for (int j = 0; j < 4; ++j) rs[bj][n][j] = rsqrtf(s4[j] * (1.0f / 2048.0f) + 1e-6f); }
#pragma unroll
        EPI_ROWS { bf16_t* rp = O + (size_t)(u.r0 + EPI_ROW) * ldc + u.c0;
#pragma unroll
            for (int bj = 0; bj < 2; ++bj) { const f32x4 v = acc[ai][bj][m][0] * rs[bj][0], v2 = acc[ai][bj][m][1] * rs[bj][1]; *(u32x4*)(rp + 128 * bj + 32 * wc + 8 * fq) = (u32x4){pk_bf16(v[0], v[1]), pk_bf16(v[2], v[3]), pk_bf16(v2[0], v2[1]), pk_bf16(v2[2], v2[3])}; } }
    } };
struct EpiGate { static constexpr bool PERM = true; bf16_t* Y;
    __device__ __forceinline__ void operator()(const AccT& acc, const UInfo& u, int wr, int wc, int fr, int fq) const {
#pragma unroll
        EPI_ROWS { bf16_t* rp = Y + (size_t)(u.r0 + EPI_ROW) * 4096 + u.c0;
#pragma unroll
            for (int bj = 0; bj < 2; ++bj) { const f32x4 g = acc[ai][bj][m][0], h = acc[ai][bj][m][1]; bf16_t* cp = rp + 128 * bj + 32 * wc + 8 * fq; const u32x4 y = *(const u32x4*)cp;
                const float o0 = g[0] * sigmoidf_(g[0]) * bflo(y[0]), o1 = g[1] * sigmoidf_(g[1]) * bfhi(y[0]), o2 = g[2] * sigmoidf_(g[2]) * bflo(y[1]), o3 = g[3] * sigmoidf_(g[3]) * bfhi(y[1]);
                const float o4 = h[0] * sigmoidf_(h[0]) * bflo(y[2]), o5 = h[1] * sigmoidf_(h[1]) * bfhi(y[2]), o6 = h[2] * sigmoidf_(h[2]) * bflo(y[3]), o7 = h[3] * sigmoidf_(h[3]) * bfhi(y[3]);
                *(u32x4*)cp = (u32x4){pk_bf16(o0, o1), pk_bf16(o2, o3), pk_bf16(o4, o5), pk_bf16(o6, o7)}; } }
    } };
struct EpiQK { static constexpr bool PERM = false; bf16_t* Q; bf16_t* K; bf16_t* KTD; const float2* rope;
    __device__ __forceinline__ void operator()(const AccT& acc, const UInfo& u, int wr, int wc, int fr, int fq) const {
        const int hidx = u.c0 >> 8; const bool isk = hidx >= 8; const int hh = hidx & 7; const float l2g = log2gamma(hh);
        bf16_t* dst = (isk ? K : Q) + hh * 256; const float sc = isk ? 0.0625f : 1.0f;
#pragma unroll
        EPI_ROWS { const int t = u.r0 + EPI_ROW; const float kd = fexp2((float)(255 - (t & 255)) * l2g);
#pragma unroll
            for (int n = 0; n < 2; ++n) { const int dd = 32 * wc + 16 * n + 4 * fq;
                const f32x4 x1 = acc[ai][0][m][n], x2 = acc[ai][1][m][n]; const f32x4 cs0 = *(const f32x4*)(rope + (size_t)t * 128 + dd), cs1 = *(const f32x4*)(rope + (size_t)t * 128 + dd + 2);
                float y1[4], y2[4];
                y1[0] = (x1[0] * cs0[0] - x2[0] * cs0[1]) * sc; y2[0] = (x1[0] * cs0[1] + x2[0] * cs0[0]) * sc;
                y1[1] = (x1[1] * cs0[2] - x2[1] * cs0[3]) * sc; y2[1] = (x1[1] * cs0[3] + x2[1] * cs0[2]) * sc;
                y1[2] = (x1[2] * cs1[0] - x2[2] * cs1[1]) * sc; y2[2] = (x1[2] * cs1[1] + x2[2] * cs1[0]) * sc;
                y1[3] = (x1[3] * cs1[2] - x2[3] * cs1[3]) * sc; y2[3] = (x1[3] * cs1[3] + x2[3] * cs1[2]) * sc;
                *(u32x2*)(dst + (size_t)t * 2048 + dd) = (u32x2){pk_bf16(y1[0], y1[1]), pk_bf16(y1[2], y1[3])};
                *(u32x2*)(dst + (size_t)t * 2048 + 128 + dd) = (u32x2){pk_bf16(y2[0], y2[1]), pk_bf16(y2[2], y2[3])};
                if (isk) {
#pragma unroll
                    for (int j = 0; j < 4; ++j) { KTD[(size_t)(hh * 256 + dd + j) * S_ + t] = (bf16_t)(pk_bf16(y1[j] * kd, 0.f) & 0xffffu); KTD[(size_t)(hh * 256 + 128 + dd + j) * S_ + t] = (bf16_t)(pk_bf16(y2[j] * kd, 0.f) & 0xffffu); }
                } } }
    } };
struct EpiQproj { static constexpr bool PERM = false; bf16_t* QB; float* gates; const float* ss;
    __device__ __forceinline__ void operator()(const AccT& acc, const UInfo& u, int wr, int wc, int fr, int fq) const {
#pragma unroll
        EPI_ROWS { const int t = u.r0 + EPI_ROW; const float rs = rsqrtf(ss[t] * (1.0f / 2048.0f) + 1e-6f);
#pragma unroll
            EPI_COLS { const int col = u.c0 + EPI_COL; const f32x4 v = acc[ai][bj][m][n] * rs;
                if (col < 2048) *(u32x2*)(QB + (size_t)t * 2048 + col) = (u32x2){pk_bf16(v[0] * 0.08838834764831845f, v[1] * 0.08838834764831845f), pk_bf16(v[2] * 0.08838834764831845f, v[3] * 0.08838834764831845f)};
                else if (col < 2096) *(f32x4*)(gates + (size_t)t * 48 + (col - 2048)) = (f32x4){sigmoidf_(v[0]), sigmoidf_(v[1]), sigmoidf_(v[2]), sigmoidf_(v[3])}; } }
    } };
__device__ __forceinline__ float gelu_tanh(float x) { const float y = 0.7978845608028654f * (x + 0.044715f * x * x * x); const float e = fexp2(2.0f * 1.4426950408889634f * y); const float th = 1.0f - 2.0f * frcp(e + 1.0f); return 0.5f * x * (1.0f + th); }
struct EpiGelu { static constexpr bool PERM = false; bf16_t* H; const float* bias;
    __device__ __forceinline__ void operator()(const AccT& acc, const UInfo& u, int wr, int wc, int fr, int fq) const {
#pragma unroll
        EPI_ROWS { bf16_t* rp = H + (size_t)(u.r0 + EPI_ROW) * 256;
#pragma unroll
            EPI_COLS { const int col = EPI_COL; const f32x4 v = acc[ai][bj][m][n]; const f32x4 bb = *(const f32x4*)(bias + col);
                *(u32x2*)(rp + col) = (u32x2){pk_bf16(gelu_tanh(v[0] + bb[0]), gelu_tanh(v[1] + bb[1])), pk_bf16(gelu_tanh(v[2] + bb[2]), gelu_tanh(v[3] + bb[3]))}; } }
    } };
struct EpiKcmp { static constexpr bool PERM = false; bf16_t* KC;
    __device__ __forceinline__ void operator()(const AccT& acc, const UInfo& u, int wr, int wc, int fr, int fq) const {
#pragma unroll
        EPI_ROWS { const int r = u.r0 + EPI_ROW, i = r >> 2, h = r & 3;
#pragma unroll
            for (int n = 0; n < 2; ++n) { const int col = 32 * wc + 16 * n + 4 * fq; f32x4 v = acc[ai][0][m][n]; if (i == 1023) v = (f32x4){0.f, 0.f, 0.f, 0.f};
                *(u32x2*)(KC + ((size_t)h * 1024 + i) * 128 + col) = (u32x2){pk_bf16(v[0], v[1]), pk_bf16(v[2], v[3])}; } }
    } };
struct EpiVcmp { static constexpr bool PERM = false; bf16_t* VC;
    __device__ __forceinline__ void operator()(const AccT& acc, const UInfo& u, int wr, int wc, int fr, int fq) const {
#pragma unroll
        for (int m = 0; m < 4; ++m) { const int d = 64 * wr + 16 * m + fr;
#pragma unroll
            EPI_COLS { const int col = u.c0 + EPI_COL, i = col >> 2; f32x4 v = acc[0][bj][m][n]; if (i == 1023) v = (f32x4){0.f, 0.f, 0.f, 0.f};
#pragma unroll
                for (int h = 0; h < 4; ++h) VC[((size_t)h * 128 + d) * 1024 + i] = (bf16_t)(pk_bf16(v[h], 0.f) & 0xffffu); } }
    } };
struct ProbCmp1 {
    static constexpr bool PERM = false;
    const char* A; const char* B; unsigned ldb; int nt, nM; EpiGelu e;
    __device__ __forceinline__ long nunits() const { return nM; }
    __device__ __forceinline__ unsigned rowA(int R) const { return (unsigned)(R >> 2) * 65536u + (unsigned)(R & 3) * 256u; }
    __device__ __forceinline__ void unit(long L, UInfo& u) const { u.a = A + (size_t)L * 64 * 65536; u.b = B; u.r0 = (int)L * 256; u.c0 = 0; u.x0 = 0; u.x1 = 0; }
    __device__ __forceinline__ size_t aK(int kt) const { return (size_t)(kt >> 1) * 4096 + (size_t)(kt & 1) * 128; }
    __device__ __forceinline__ size_t bK(int kt) const { return (size_t)kt * 128; }
    __device__ __forceinline__ void epi(const AccT& acc, const UInfo& u, int wr, int wc, int fr, int fq) const { e(acc, u, wr, wc, fr, fq); }
};
struct ProbKV {
    static constexpr bool PERM = true;
    const char* VT; const char* KTD; bf16_t* ST; int nt;
    __device__ __forceinline__ long nunits() const { return 8 * 64 * 2; }
    __device__ __forceinline__ unsigned rowA(int R) const { return (unsigned)R * 32768u; }
    static constexpr unsigned ldb = 32768u;
    __device__ __forceinline__ void unit(long L, UInfo& u) const { const int pm = (int)L & 1, c = ((int)L >> 1) & 63, h = (int)L >> 7;
        u.a = VT + ((size_t)(h * 512 + pm * 256) * S_ + c * 256) * 2; u.b = KTD + ((size_t)(h * 256) * S_ + c * 256) * 2; u.r0 = h * 512 + pm * 256; u.c0 = c * 256; u.x0 = 0; u.x1 = 0; }
    __device__ __forceinline__ size_t aK(int kt) const { return (size_t)kt * 128; }
    __device__ __forceinline__ size_t bK(int kt) const { return (size_t)kt * 128; }
    __device__ __forceinline__ void epi(const AccT& acc, const UInfo& u, int wr, int wc, int fr, int fq) const { EpiStore e{ST, (size_t)S_}; e(acc, u, wr, wc, fr, fq); }
};
struct ProbS {
    static constexpr bool PERM = true;
    const char* Q; const char* K; bf16_t* SD; int nt;
    __device__ __forceinline__ long nunits() const { return 8 * 64; }
    __device__ __forceinline__ unsigned rowA(int R) const { return (unsigned)R * 4096u; }
    static constexpr unsigned ldb = 4096u;
    __device__ __forceinline__ void unit(long L, UInfo& u) const { const int c = (int)L & 63, h = (int)L >> 6; const size_t o = ((size_t)(c * 256) * 2048 + h * 256) * 2;
        u.a = Q + o; u.b = K + o; u.r0 = c * 256; u.c0 = h * 256; u.x0 = h; u.x1 = 0; }
    __device__ __forceinline__ size_t aK(int kt) const { return (size_t)kt * 128; }
    __device__ __forceinline__ size_t bK(int kt) const { return (size_t)kt * 128; }
    __device__ __forceinline__ void epi(const AccT& acc, const UInfo& u, int wr, int wc, int fr, int fq) const {
        const float l2g = log2gamma(u.x0);
#pragma unroll
        EPI_ROWS { const int i = EPI_ROW; bf16_t* rp = SD + (size_t)(u.r0 + i) * 2048 + u.c0;
#pragma unroll
            for (int bj = 0; bj < 2; ++bj) { const int s = 128 * bj + 32 * wc + 8 * fq; const f32x4 v = acc[ai][bj][m][0], v2 = acc[ai][bj][m][1]; float o[8];
#pragma unroll
                for (int j = 0; j < 4; ++j) { o[j] = (s + j <= i) ? v[j] * fexp2(-(float)(s + j + 1) * l2g) : 0.f; o[4 + j] = (s + 4 + j <= i) ? v2[j] * fexp2(-(float)(s + 4 + j + 1) * l2g) : 0.f; }
                *(u32x4*)(rp + s) = (u32x4){pk_bf16(o[0], o[1]), pk_bf16(o[2], o[3]), pk_bf16(o[4], o[5]), pk_bf16(o[6], o[7])}; } }
    }
};
struct ProbOut {
    static constexpr bool PERM = true;
    const char* Q; const char* ST; long dA, dB; bf16_t* Y; int nt;
    __device__ __forceinline__ long nunits() const { return 8 * 64 * 2; }
    __device__ __forceinline__ unsigned rowA(int R) const { return (unsigned)R * 4096u; }
    static constexpr unsigned ldb = 32768u;
    __device__ __forceinline__ void unit(long L, UInfo& u) const { const int pn = (int)L & 1, c = ((int)L >> 1) & 63, h = (int)L >> 7;
        u.a = Q + ((size_t)(c * 256) * 2048 + h * 256) * 2; u.b = ST + ((size_t)(h * 512 + pn * 256) * S_ + c * 256) * 2; u.r0 = c * 256; u.c0 = h * 512 + pn * 256; u.x0 = h; u.x1 = 0; }
    __device__ __forceinline__ size_t aK(int kt) const { return kt < 4 ? (size_t)kt * 128 : (size_t)(dA + (long)(kt - 4) * 128); }
    __device__ __forceinline__ size_t bK(int kt) const { return kt < 4 ? (size_t)kt * 128 : (size_t)(dB + (long)(kt - 4) * 128); }
    __device__ __forceinline__ void epi(const AccT& acc, const UInfo& u, int wr, int wc, int fr, int fq) const {
        const float l2g = log2gamma(u.x0);
#pragma unroll
        EPI_ROWS { const int i = EPI_ROW; const float qd = fexp2((float)(i + 1) * l2g); bf16_t* rp = Y + (size_t)(u.r0 + i) * 4096 + u.c0;
#pragma unroll
            for (int bj = 0; bj < 2; ++bj) { const f32x4 v = acc[ai][bj][m][0] * qd, v2 = acc[ai][bj][m][1] * qd; *(u32x4*)(rp + 128 * bj + 32 * wc + 8 * fq) = (u32x4){pk_bf16(v[0], v[1]), pk_bf16(v[2], v[3]), pk_bf16(v2[0], v2[1]), pk_bf16(v2[2], v2[3])}; } }
    }
};

__device__ __forceinline__ void transpose_job(const float* __restrict__ src, bf16_t* __restrict__ dst, int K, int N, int Npad, int kvperm, LAS float* tile, const float* gain = nullptr) {
    const int tk = K / 64, tn = Npad / 256, ntile = tk * tn; const int tid = ltid();
    for (int t = blockIdx.x; t < ntile; t += gridDim.x) {
        const int k0 = (t % tk) * 64, n0 = (t / tk) * 256;
        { const int r0 = tid >> 6, cc = tid & 63; float v[8][4];
#pragma unroll
          for (int i = 0; i < 8; ++i)
#pragma unroll
              for (int q = 0; q < 4; ++q) { const int n = n0 + cc + 64 * q; v[i][q] = (n < N) ? src[(size_t)(k0 + r0 + 8 * i) * N + n] : 0.f; }
#pragma unroll
          for (int i = 0; i < 8; ++i) { const float gk = gain ? gain[k0 + r0 + 8 * i] : 1.0f;
#pragma unroll
              for (int q = 0; q < 4; ++q) tile[(r0 + 8 * i) * 257 + cc + 64 * q] = v[i][q] * gk; } }
        __syncthreads();
        { const int rr = tid >> 1, c0 = (tid & 1) * 32;
          int n = n0 + rr; if (kvperm) { const int j = n >> 9; const int jp = (j == 3) ? 4 : ((j == 4) ? 3 : j); n = jp * 512 + (n & 511); }
          bf16_t* dp = dst + (size_t)n * K + k0 + c0;
#pragma unroll
          for (int g = 0; g < 4; ++g) { float x[8];
#pragma unroll
              for (int j = 0; j < 8; ++j) x[j] = tile[(c0 + 8 * g + j) * 257 + rr];
              *(u32x4*)(dp + 8 * g) = (u32x4){pk_bf16(x[0], x[1]), pk_bf16(x[2], x[3]), pk_bf16(x[4], x[5]), pk_bf16(x[6], x[7])}; } }
        __syncthreads();
    }
}
__device__ __forceinline__ void prep_phase(CP p, LAS unsigned char* lds) {
    LAS float* tile = (LAS float*)lds; unsigned char* ws = p->ws;
    transpose_job(p->ret_w_in, (bf16_t*)(ws + OFF_W_RIN), 2048, 12288, 12288, 0, tile);
    transpose_job(p->ret_w_out, (bf16_t*)(ws + OFF_W_ROUT), 4096, 2048, 2048, 0, tile);
    transpose_job(p->w_kv, (bf16_t*)(ws + OFF_W_KV), 2048, 3072, 3072, 1, tile, p->kv_gain);
    transpose_job(p->w1_k, (bf16_t*)(ws + OFF_W_C1K), 4096, 256, 256, 0, tile);
    transpose_job(p->w1_v, (bf16_t*)(ws + OFF_W_C1V), 4096, 256, 256, 0, tile);
    transpose_job(p->w2_k, (bf16_t*)(ws + OFF_W_C2K), 256, 128, 256, 0, tile);
    transpose_job(p->w2_v, (bf16_t*)(ws + OFF_W_C2V), 256, 128, 256, 0, tile);
    transpose_job(p->w_q, (bf16_t*)(ws + OFF_W_Q), 2048, 2096, 2304, 0, tile, p->norm_mix + 2048);
    transpose_job(p->w_o, (bf16_t*)(ws + OFF_W_O), 2048, 2048, 2048, 0, tile);
    transpose_job(p->ffn_w_in, (bf16_t*)(ws + OFF_W_FIN), 2048, 8192, 8192, 0, tile, p->norm_ffn);
    transpose_job(p->ffn_w_in + (size_t)2048 * 8192, (bf16_t*)(ws + OFF_W_FIN + 32 * MiB), 2048, 8192, 8192, 0, tile, p->norm_ffn + 2048);
    transpose_job(p->ffn_w_out, (bf16_t*)(ws + OFF_W_FOUT), 4096, 2048, 2048, 0, tile);
    transpose_job(p->ffn_w_out + (size_t)4096 * 2048, (bf16_t*)(ws + OFF_W_FOUT + 16 * MiB), 4096, 2048, 2048, 0, tile);
    { float* ss = (float*)(ws + OFF_SS); for (int i = blockIdx.x * 512 + ltid(); i < 8 * S_; i += gridDim.x * 512) ss[i] = 0.f; }
    { float2* rope = (float2*)(ws + OFF_ROPE); const int gsz = gridDim.x * 512;
      for (int i = blockIdx.x * 512 + ltid(); i < S_ * 128; i += gsz) { const int t = i >> 7, dd = i & 127;
          const float freq = exp2f(-(float)dd * (13.287712379549449f / 128.0f)); const double rev = (double)t * (double)freq * 0.15915494309189535;
          const float fx = (float)(rev - rint(rev)); rope[i] = make_float2(__builtin_amdgcn_cosf(fx), __builtin_amdgcn_sinf(fx)); } }
    if (blockIdx.x < 128) { const int kv = blockIdx.x >> 6, oc = blockIdx.x & 63; const float* pe = kv ? p->pe_v : p->pe_k; const float* w1 = kv ? p->w1_v : p->w1_k; float* peb = (float*)(ws + OFF_PEB) + kv * 256;
        const int tid = ltid(), g = tid >> 7, r = tid & 127, n = 4 * oc + g; float s = 0.f;
#pragma unroll 8
        for (int j = 0; j < 32; ++j) { const int k = r + 128 * j; s += pe[k] * w1[(size_t)k * 256 + n]; }
        s = wave_sum(s, tid & 63);
        __syncthreads(); if ((tid & 63) == 0) tile[tid >> 6] = s; __syncthreads();
        if (tid < 4) peb[4 * oc + tid] = tile[2 * tid] + tile[2 * tid + 1];
        __syncthreads(); }
}
__device__ __forceinline__ void rmsnorm_phase(const float* h, const float* g1, bf16_t* o1, const float* g2, bf16_t* o2) {
    const int w = ltid() >> 6, lane = ltid() & 63;
    for (int row = blockIdx.x * 8 + w; row < S_; row += gridDim.x * 8) {
        const f32x4* p = (const f32x4*)(h + (size_t)row * 2048); f32x4 v[8]; float ss = 0.f;
#pragma unroll
        for (int i = 0; i < 8; ++i) { v[i] = p[lane + 64 * i]; ss += v[i][0] * v[i][0] + v[i][1] * v[i][1] + v[i][2] * v[i][2] + v[i][3] * v[i][3]; }
        ss = wave_sum(ss, lane); const float r = rsqrtf(ss * (1.0f / 2048.0f) + 1e-6f);
#pragma unroll
        for (int i = 0; i < 8; ++i) { const int col = (lane + 64 * i) * 4; const f32x4 g = *(const f32x4*)(g1 + col);
            *(u32x2*)(o1 + (size_t)row * 2048 + col) = (u32x2){pk_bf16(v[i][0] * r * g[0], v[i][1] * r * g[1]), pk_bf16(v[i][2] * r * g[2], v[i][3] * r * g[3])};
            if (o2) { const f32x4 gg = *(const f32x4*)(g2 + col);
                *(u32x2*)(o2 + (size_t)row * 2048 + col) = (u32x2){pk_bf16(v[i][0] * r * gg[0], v[i][1] * r * gg[1]), pk_bf16(v[i][2] * r * gg[2], v[i][3] * r * gg[3])}; } }
    }
}
__device__ __forceinline__ void finalnorm_phase(float* h, const float* g1) {
    const int w = ltid() >> 6, lane = ltid() & 63;
    for (int row = blockIdx.x * 8 + w; row < S_; row += gridDim.x * 8) {
        f32x4* p = (f32x4*)(h + (size_t)row * 2048); f32x4 v[8]; float ss = 0.f;
#pragma unroll
        for (int i = 0; i < 8; ++i) { v[i] = p[lane + 64 * i]; ss += v[i][0] * v[i][0] + v[i][1] * v[i][1] + v[i][2] * v[i][2] + v[i][3] * v[i][3]; }
        ss = wave_sum(ss, lane); const float r = rsqrtf(ss * (1.0f / 2048.0f) + 1e-6f);
#pragma unroll
        for (int i = 0; i < 8; ++i) { const f32x4 g = *(const f32x4*)(g1 + (lane + 64 * i) * 4); p[lane + 64 * i] = v[i] * r * g; }
    }
}
__device__ __forceinline__ void scan_phase(bf16_t* ST) {
    for (int it = blockIdx.x * 512 + ltid(); it < 4096 * 32; it += gridDim.x * 512) {
        const int r = it >> 5, d8 = it & 31; const float cd = fexp2(256.0f * log2gamma(r >> 9));
        bf16_t* p = ST + (size_t)r * S_ + d8 * 8; float s[8];
#pragma unroll
        for (int j = 0; j < 8; ++j) s[j] = 0.f;
        for (int c = 0; c < 64; ++c) { const u32x4 v = *(const u32x4*)(p + c * 256);
            *(u32x4*)(p + c * 256) = (u32x4){pk_bf16(s[0], s[1]), pk_bf16(s[2], s[3]), pk_bf16(s[4], s[5]), pk_bf16(s[6], s[7])};
#pragma unroll
            for (int j = 0; j < 4; ++j) { s[2 * j] = s[2 * j] * cd + bflo(v[j]); s[2 * j + 1] = s[2 * j + 1] * cd + bfhi(v[j]); } }
    }
}
__device__ __forceinline__ void gn_phase(bf16_t* Y, const float* gain) {
    const int w = ltid() >> 6, lane = ltid() & 63;
    for (int g = blockIdx.x * 8 + w; g < S_ * 8; g += gridDim.x * 8) {
        bf16_t* p = Y + (size_t)g * 512 + lane * 8; const u32x4 v = *(const u32x4*)p; float x[8];
#pragma unroll
        for (int j = 0; j < 4; ++j) { x[2 * j] = bflo(v[j]); x[2 * j + 1] = bfhi(v[j]); }
        float s = 0.f;
#pragma unroll
        for (int j = 0; j < 8; ++j) s += x[j];
        const float mu = wave_sum(s, lane) * (1.0f / 512.0f); float q = 0.f;
#pragma unroll
        for (int j = 0; j < 8; ++j) { x[j] -= mu; q += x[j] * x[j]; }
        const float r = rsqrtf(wave_sum(q, lane) * (1.0f / 512.0f) + 1e-6f); const float* gp = gain + (g & 7) * 512 + lane * 8;
        const f32x4 g0 = *(const f32x4*)gp, g1 = *(const f32x4*)(gp + 4);
        *(u32x4*)p = (u32x4){pk_bf16(x[0] * r * g0[0], x[1] * r * g0[1]), pk_bf16(x[2] * r * g0[2], x[3] * r * g0[3]), pk_bf16(x[4] * r * g1[0], x[5] * r * g1[1]), pk_bf16(x[6] * r * g1[2], x[7] * r * g1[3])};
    }
}
__device__ __forceinline__ void conv_phase(const bf16_t* U, bf16_t* AB, const float* cw, const float* cb) {
    for (int it = blockIdx.x * 512 + ltid(); it < 512 * 512; it += gridDim.x * 512) {
        const int n8 = (it & 511) * 8, t0 = (it >> 9) * 32;
        float wa[3][8], wb[3][8], ba[8], bb[8];
#pragma unroll
        for (int tp = 0; tp < 3; ++tp)
#pragma unroll
            for (int j = 0; j < 8; ++j) { wa[tp][j] = cw[tp * 8192 + n8 + j]; wb[tp][j] = cw[tp * 8192 + 4096 + n8 + j]; }
#pragma unroll
        for (int j = 0; j < 8; ++j) { ba[j] = cb[n8 + j]; bb[j] = cb[4096 + n8 + j]; }
        float pa[2][8], pb[2][8];
#pragma unroll
        for (int k = 0; k < 2; ++k) { const int t = t0 - 2 + k; u32x4 va = (u32x4){0, 0, 0, 0}, vb = (u32x4){0, 0, 0, 0};
            if (t >= 0) { va = *(const u32x4*)(U + (size_t)t * 8192 + n8); vb = *(const u32x4*)(U + (size_t)t * 8192 + 4096 + n8); }
#pragma unroll
            for (int j = 0; j < 4; ++j) { pa[k][2 * j] = bflo(va[j]); pa[k][2 * j + 1] = bfhi(va[j]); pb[k][2 * j] = bflo(vb[j]); pb[k][2 * j + 1] = bfhi(vb[j]); } }
#pragma unroll 8
        for (int k = 0; k < 32; ++k) { const int t = t0 + k; const u32x4 va = *(const u32x4*)(U + (size_t)t * 8192 + n8), vb = *(const u32x4*)(U + (size_t)t * 8192 + 4096 + n8);
            float xa[8], xb[8], o[8];
#pragma unroll
            for (int j = 0; j < 4; ++j) { xa[2 * j] = bflo(va[j]); xa[2 * j + 1] = bfhi(va[j]); xb[2 * j] = bflo(vb[j]); xb[2 * j + 1] = bfhi(vb[j]); }
#pragma unroll
            for (int j = 0; j < 8; ++j) { const float a = ba[j] + wa[0][j] * pa[0][j] + wa[1][j] * pa[1][j] + wa[2][j] * xa[j]; const float b = bb[j] + wb[0][j] * pb[0][j] + wb[1][j] * pb[1][j] + wb[2][j] * xb[j];
                o[j] = a * sigmoidf_(a) * b; pa[0][j] = pa[1][j]; pa[1][j] = xa[j]; pb[0][j] = pb[1][j]; pb[1][j] = xb[j]; }
            *(u32x4*)(AB + (size_t)t * 4096 + n8) = (u32x4){pk_bf16(o[0], o[1]), pk_bf16(o[2], o[3]), pk_bf16(o[4], o[5]), pk_bf16(o[6], o[7])}; }
    }
}

constexpr int A_KT = 0, A_VT = 17408, A_BUFSZ = 34816, A_PSL = 69632, A_SEL = 69632 + 65536, LDS_ST = 139264;
constexpr float LOG2E = 1.4426950408889634f;
struct AttnState { f32x4 ot[8][2]; float m[2], l[2]; };

template <int MODE>
__device__ __forceinline__ void attn_compute(LAS unsigned char* lds, int boff, int tile, const bf16x8 (&qf)[2][4], AttnState& st, const int (&tpos)[2], int qb, int w, int lane,
                                             const float (&mfin)[2], const float (&linv)[2], bool rs0, bool rs1, bool masked) {
    const int l16 = lane & 15, g4 = lane >> 4;
    f32x4 s[4][2];
#pragma unroll
    for (int mt = 0; mt < 4; ++mt) { s[mt][0] = (f32x4){0.f, 0.f, 0.f, 0.f}; s[mt][1] = (f32x4){0.f, 0.f, 0.f, 0.f}; }
#pragma unroll
    for (int ks = 0; ks < 4; ++ks)
#pragma unroll
        for (int mt = 0; mt < 4; ++mt) { const bf16x8 kf = *(const LAS bf16x8*)(lds + boff + A_KT + (16 * mt + l16) * 272 + ks * 64 + g4 * 16);
            s[mt][0] = __builtin_amdgcn_mfma_f32_16x16x32_bf16(kf, qf[0][ks], s[mt][0], 0, 0, 0);
            s[mt][1] = __builtin_amdgcn_mfma_f32_16x16x32_bf16(kf, qf[1][ks], s[mt][1], 0, 0, 0);
            if (mt == 3 && (ks & 1)) __builtin_amdgcn_sched_barrier(0); }
    if (masked) {
#pragma unroll
        for (int nt = 0; nt < 2; ++nt) { const int t = tpos[nt]; const int tl = w * 8 + nt * 4 + (l16 >> 2);
#pragma unroll
            for (int mt = 0; mt < 4; ++mt)
#pragma unroll
                for (int j = 0; j < 4; ++j) { const int kl = 16 * mt + 4 * g4 + j; const int key = tile * 64 + kl; bool v;
                    if (MODE == 0 || MODE == 1) v = key <= ((t - 31) >> 4);
                    else if (MODE == 2) v = (kl <= tl);
                    else v = (key <= t) && (key > t - 512);
                    s[mt][nt][j] = v ? s[mt][nt][j] : -__builtin_inff(); } }
    }
    bf16x8 pf[2][2];
#pragma unroll
    for (int nt = 0; nt < 2; ++nt) {
        const bool rowsel = nt ? rs1 : rs0;
        const float bias = (MODE == 2 && !rowsel) ? -__builtin_inff() : 0.f;
        float mx = -1e30f;
#pragma unroll
        for (int mt = 0; mt < 4; ++mt)
#pragma unroll
            for (int j = 0; j < 4; ++j) {
                const float sv = s[mt][nt][j] * LOG2E + bias;
                s[mt][nt][j] = sv; mx = fmaxf(mx, sv); }
        float mnew, alpha = 1.f;
        if (MODE == 1) mnew = mfin[nt];
        else { mx = fmaxf(mx, shx(mx, 16, lane)); mx = fmaxf(mx, shx(mx, 32, lane)); mnew = fmaxf(st.m[nt], mx); alpha = fexp2(st.m[nt] - mnew); st.m[nt] = mnew; }
        float ps = 0.f;
#pragma unroll
        for (int mt = 0; mt < 4; ++mt)
#pragma unroll
            for (int j = 0; j < 4; ++j) { float pv = fexp2(s[mt][nt][j] - mnew); if (MODE == 1) pv *= linv[nt]; s[mt][nt][j] = pv; ps += pv; }
        if (MODE != 1) st.l[nt] = st.l[nt] * alpha + ps;
        if (MODE == 2 || MODE == 3) {
#pragma unroll
            for (int md = 0; md < 8; ++md) st.ot[md][nt] = st.ot[md][nt] * alpha;
        }
        if (MODE == 1) {
#pragma unroll
            for (int mt = 0; mt < 4; ++mt) { float a = s[mt][nt][0] + s[mt][nt][1] + s[mt][nt][2] + s[mt][nt][3], lst = s[mt][nt][3];
                a += shx(a, 1, lane); a += shx(a, 2, lane); lst += shx(lst, 1, lane); lst += shx(lst, 2, lane);
                if ((l16 & 3) == 0) { const int jb = tile * 16 + 4 * mt + g4; LAS float* pp = (LAS float*)(lds + A_PSL) + (w * 8 + nt * 4 + (l16 >> 2)) * 256;
                    atomicAdd((float*)(pp + jb), a); if (jb + 1 < 256) atomicAdd((float*)(pp + jb + 1), lst); } }
        }
        if (MODE != 0) {
#pragma unroll
            for (int kk = 0; kk < 2; ++kk) { const u32x4 pk = (u32x4){pk_bf16(s[2 * kk][nt][0], s[2 * kk][nt][1]), pk_bf16(s[2 * kk][nt][2], s[2 * kk][nt][3]), pk_bf16(s[2 * kk + 1][nt][0], s[2 * kk + 1][nt][1]), pk_bf16(s[2 * kk + 1][nt][2], s[2 * kk + 1][nt][3])};
                pf[nt][kk] = __builtin_bit_cast(bf16x8, pk); }
        }
    }
    if (MODE != 0) {
#pragma unroll
        for (int kk = 0; kk < 2; ++kk)
#pragma unroll
            for (int md = 0; md < 8; ++md) { const LAS unsigned char* vb = lds + boff + A_VT + (16 * md + l16) * 136 + kk * 64 + g4 * 8;
                const u32x2 v0 = *(const LAS u32x2*)vb, v1 = *(const LAS u32x2*)(vb + 32); const bf16x8 vf = __builtin_bit_cast(bf16x8, ((u32x4){v0[0], v0[1], v1[0], v1[1]}));
                st.ot[md][0] = __builtin_amdgcn_mfma_f32_16x16x32_bf16(vf, pf[0][kk], st.ot[md][0], 0, 0, 0);
                st.ot[md][1] = __builtin_amdgcn_mfma_f32_16x16x32_bf16(vf, pf[1][kk], st.ot[md][1], 0, 0, 0);
                if (md == 7) __builtin_amdgcn_sched_barrier(0); }
    }
}
template <int MODE>
__device__ __forceinline__ void attn_tiles(LAS unsigned char* lds, const bf16_t* kp, size_t kstride, const bf16_t* vp, size_t vstride, int tile_lo, int tile_hi,
                                           const bf16x8 (&qf)[2][4], AttnState& st, const int (&tpos)[2], int qb, int w, int lane, const float (&mfin)[2], const float (&linv)[2]) {
    if (tile_lo >= tile_hi) return;
    int tid = w * 64 + lane; asm volatile("" : "+v"(tid)); const int l16 = lane & 15;
    const int krow = tid >> 3, kc = (tid & 7) * 16, vrow = tid >> 2, vc = (tid & 3) * 16;
    u32x4 kr0, kr1, vr0 = (u32x4){0, 0, 0, 0}, vr1 = (u32x4){0, 0, 0, 0};
#define A_LOAD(T) do { const bf16_t* kg = kp + (size_t)((T) * 64 + krow) * kstride + kc; kr0 = *(const u32x4*)kg; kr1 = *(const u32x4*)(kg + 8); \
        if (MODE != 0) { const bf16_t* vg = vp + (size_t)vrow * vstride + (T) * 64 + vc; vr0 = *(const u32x4*)vg; vr1 = *(const u32x4*)(vg + 8); } } while (0)
#define A_WRITE(BO) do { LAS unsigned char* kd = lds + (BO) + A_KT + krow * 272 + kc * 2; *(LAS u32x4*)kd = kr0; *(LAS u32x4*)(kd + 16) = kr1; \
        if (MODE != 0) { LAS unsigned char* vd = lds + (BO) + A_VT + vrow * 136 + vc * 2; *(LAS u32x2*)vd = (u32x2){vr0[0], vr0[1]}; *(LAS u32x2*)(vd + 8) = (u32x2){vr0[2], vr0[3]}; *(LAS u32x2*)(vd + 16) = (u32x2){vr1[0], vr1[1]}; *(LAS u32x2*)(vd + 24) = (u32x2){vr1[2], vr1[3]}; } } while (0)
    A_LOAD(tile_lo);
    __syncthreads();
    A_WRITE(0);
    if (tile_lo + 1 < tile_hi) A_LOAD(tile_lo + 1);
    __syncthreads();
    for (int tile = tile_lo; tile < tile_hi; ++tile) {
        const int boff = ((tile - tile_lo) & 1) * A_BUFSZ;
        if (tile + 1 < tile_hi) { A_WRITE(boff ^ A_BUFSZ); if (tile + 2 < tile_hi) A_LOAD(tile + 2); }
        bool rs0 = true, rs1 = true, active = true;
        if (MODE == 2) { const int tw = tile >> 5; const unsigned bit = 1u << (tile & 31);
            const unsigned w0 = *(const LAS unsigned*)(lds + A_SEL + ((w * 8 + (l16 >> 2)) * 8 + tw) * 4), w1 = *(const LAS unsigned*)(lds + A_SEL + ((w * 8 + 4 + (l16 >> 2)) * 8 + tw) * 4);
            rs0 = (w0 & bit) != 0u; rs1 = (w1 & bit) != 0u; active = __ballot(rs0 || rs1) != 0ull; }
        if (active) {
            bool masked;
            if (MODE == 0 || MODE == 1) masked = (tile * 64 + 63 > 4 * qb - 2);
            else if (MODE == 2) masked = (tile == qb);
            else masked = (tile == qb) || (tile <= qb - 8);
            attn_compute<MODE>(lds, boff, tile, qf, st, tpos, qb, w, lane, mfin, linv, rs0, rs1, masked);
        }
        __syncthreads();
    }
#undef A_LOAD
#undef A_WRITE
}
template <int BR>
__device__ __forceinline__ void attn_finish(AttnState& st, const float* gates, float* oacc, bf16_t* att, const int (&tpos)[2], int hkv, int lane) {
    const int l16 = lane & 15, g4 = lane >> 4, g = l16 & 3;
#pragma unroll
    for (int nt = 0; nt < 2; ++nt) {
        const int t = tpos[nt]; float sc = gates[(size_t)t * 48 + (hkv * 4 + g) * 3 + BR];
        if (BR != 0) { float l = st.l[nt]; l += shx(l, 16, lane); l += shx(l, 32, lane); sc = (l > 0.f) ? sc / l : 0.f; }
        const size_t base = (size_t)t * 2048 + (hkv * 4 + g) * 128 + 4 * g4;
#pragma unroll
        for (int md = 0; md < 8; ++md) { f32x4 v = st.ot[md][nt] * sc; float* op = oacc + base + 16 * md;
            if (BR == 0) *(f32x4*)op = v;
            else if (BR == 1) *(f32x4*)op = *(const f32x4*)op + v;
            else { v = v + *(const f32x4*)op; *(u32x2*)(att + base + 16 * md) = (u32x2){pk_bf16(v[0], v[1]), pk_bf16(v[2], v[3])}; } }
    }
}
__device__ __forceinline__ void attn_reset(AttnState& st) {
#pragma unroll
    for (int md = 0; md < 8; ++md) { st.ot[md][0] = (f32x4){0.f, 0.f, 0.f, 0.f}; st.ot[md][1] = (f32x4){0.f, 0.f, 0.f, 0.f}; }
    st.m[0] = st.m[1] = -1e30f; st.l[0] = st.l[1] = 0.f;
}
__device__ __forceinline__ void attn_item(unsigned char* ws, LAS unsigned char* lds, int hkv, int qb) {
    int tid = ltid(); asm volatile("" : "+v"(tid)); const int w = tid >> 6, lane = tid & 63, l16 = lane & 15, g4 = lane >> 4;
    const bf16_t* QB = (const bf16_t*)(ws + OFF_QB); const bf16_t* KVTOK = (const bf16_t*)(ws + OFF_KVTOK); const bf16_t* KVT = (const bf16_t*)(ws + OFF_KVT);
    const bf16_t* KC = (const bf16_t*)(ws + OFF_KCMP); const bf16_t* VC = (const bf16_t*)(ws + OFF_VCMPT);
    const float* gates = (const float*)(ws + OFF_GATES); float* oacc = (float*)(ws + OFF_OACC); bf16_t* att = (bf16_t*)(ws + OFF_ATT);
    int tpos[2]; bf16x8 qf[2][4];
#pragma unroll
    for (int nt = 0; nt < 2; ++nt) { tpos[nt] = qb * 64 + w * 8 + nt * 4 + (l16 >> 2); const bf16_t* qp = QB + (size_t)tpos[nt] * 2048 + (hkv * 4 + (l16 & 3)) * 128 + g4 * 8;
#pragma unroll
        for (int ks = 0; ks < 4; ++ks) qf[nt][ks] = *(const bf16x8*)(qp + ks * 32); }
    __syncthreads();
    { LAS float* pp = (LAS float*)(lds + A_PSL) + w * 2048;
#pragma unroll
      for (int i = 0; i < 32; ++i) pp[lane + 64 * i] = 0.f; }
    AttnState st; float mfin[2] = {0.f, 0.f}, linv[2] = {0.f, 0.f};
    const int ncmp_tiles = (4 * qb + 3 + 63) >> 6;
    attn_reset(st);
    attn_tiles<0>(lds, KC + (size_t)hkv * 1024 * 128, 128, VC, 1024, 0, ncmp_tiles, qf, st, tpos, qb, w, lane, mfin, linv);
#pragma unroll
    for (int nt = 0; nt < 2; ++nt) { float l = st.l[nt]; l += shx(l, 16, lane); l += shx(l, 32, lane); mfin[nt] = st.m[nt]; linv[nt] = (l > 0.f) ? 1.0f / l : 0.f; }
    attn_reset(st);
    attn_tiles<1>(lds, KC + (size_t)hkv * 1024 * 128, 128, VC + (size_t)hkv * 128 * 1024, 1024, 0, ncmp_tiles, qf, st, tpos, qb, w, lane, mfin, linv);
    attn_finish<0>(st, gates, oacc, att, tpos, hkv, lane);
    __syncthreads();
    {
        LAS unsigned* sel = (LAS unsigned*)(lds + A_SEL) + w * 64;
        if (qb < 16) {
            if (lane < 8) { for (int tk = 0; tk < 8; ++tk) { const int lo = lane * 32; unsigned wd = 0; if (qb >= lo + 31) wd = 0xffffffffu; else if (qb >= lo) wd = (2u << (qb - lo)) - 1u; sel[tk * 8 + lane] = wd; } }
        } else {
            for (int tk = 0; tk < 8; ++tk) {
                const LAS float* pp = (const LAS float*)(lds + A_PSL) + (w * 8 + tk) * 256;
                unsigned key[4]; bool forced[4];
#pragma unroll
                for (int i = 0; i < 4; ++i) { const int j = lane + 64 * i; const float sc = pp[j]; const bool elig = (j >= 1) && (j <= qb - 2);
                    forced[i] = (j == 0) || (j == qb) || (j == qb - 1); key[i] = elig ? (__float_as_uint(sc) + 1u) : 0u; }
                unsigned prefix = 0u;
                for (int bit = 30; bit >= 0; --bit) { const unsigned cand = prefix | (1u << bit); int cnt = 0;
#pragma unroll
                    for (int i = 0; i < 4; ++i) cnt += __popcll(__ballot(key[i] >= cand));
                    if (cnt >= 13) prefix = cand; }
                int cgt = 0;
#pragma unroll
                for (int i = 0; i < 4; ++i) cgt += __popcll(__ballot(key[i] > prefix));
                const int need = 13 - cgt; int base = 0;
#pragma unroll
                for (int i = 0; i < 4; ++i) { const unsigned long long eqm = __ballot(key[i] == prefix);
                    const int rank = base + (int)__builtin_amdgcn_mbcnt_hi((unsigned)(eqm >> 32), __builtin_amdgcn_mbcnt_lo((unsigned)eqm, 0u));
                    const bool taken = forced[i] || (key[i] > prefix) || (key[i] == prefix && rank < need);
                    const unsigned long long bal = __ballot(taken); if (lane == 0) { sel[tk * 8 + 2 * i] = (unsigned)bal; sel[tk * 8 + 2 * i + 1] = (unsigned)(bal >> 32); }
                    base += __popcll(eqm); }
            }
        }
    }
    __syncthreads();
    attn_reset(st);
    attn_tiles<2>(lds, KVTOK + 2 * 512 + hkv * 128, 2048, KVT + (size_t)(hkv * 128) * S_, S_, 0, qb + 1, qf, st, tpos, qb, w, lane, mfin, linv);
    attn_finish<1>(st, gates, oacc, att, tpos, hkv, lane);
    attn_reset(st);
    attn_tiles<3>(lds, KVTOK + 3 * 512 + hkv * 128, 2048, KVT + (size_t)(512 + hkv * 128) * S_, S_, (qb - 8) > 0 ? (qb - 8) : 0, qb + 1, qf, st, tpos, qb, w, lane, mfin, linv);
    attn_finish<2>(st, gates, oacc, att, tpos, hkv, lane);
}
__device__ __forceinline__ void attn_phase(unsigned char* ws, LAS unsigned char* lds) {
#pragma nounroll
    for (int it = blockIdx.x; it < 1024; it += gridDim.x) {
        const int c = it & 255, r = it >> 8;
        attn_item(ws, lds, r, (r & 1) ? 255 - c : c);
    }
}


#define XB_TMO      128
#define XB_XCNT(j)  (256  + 64 * (j))
#define XB_XSUB(j)  (1280 + 64 * (j))
#define XB_XGEN(j)  (2304 + 64 * (j))
#define XB_TOP      3328
#define XB_TOPGEN   3392
#define XCD_BAR_WORDS 3456
#define XB_SPIN_CAP (1u << 22)
__device__ __forceinline__ unsigned xb_ld(unsigned* p)              { return __hip_atomic_load(p, __ATOMIC_RELAXED, __HIP_MEMORY_SCOPE_AGENT); }
__device__ __forceinline__ unsigned xb_add(unsigned* p, unsigned v) { return __hip_atomic_fetch_add(p, v, __ATOMIC_RELAXED, __HIP_MEMORY_SCOPE_AGENT); }
__device__ __forceinline__ unsigned xb_xcc_id() { return (unsigned)__builtin_amdgcn_s_getreg((3 << 11) | 20) & 0xFu; }
#define XB_SPIN(cond, bar) do { unsigned _sp = 0; while (cond) { __builtin_amdgcn_s_sleep(1); \
    if ((++_sp & 255u) == 0u) { if (xb_ld(&(bar)[XB_TMO])) break; if (_sp > XB_SPIN_CAP) { atomicAdd(&(bar)[XB_TMO], 1u); break; } } } } while (0)
struct XcdBarrier { unsigned* bar; unsigned x; volatile LAS unsigned* st; };
__device__ __forceinline__ XcdBarrier xcd_barrier_post(unsigned* bar, volatile LAS unsigned* st) {
    XcdBarrier b; b.bar = bar; b.x = xb_xcc_id(); b.st = st;
    if (threadIdx.x == 0) (void)xb_add(&bar[XB_XCNT(b.x)], 1u);
    return b;
}
__device__ __forceinline__ void xcd_barrier_complete(unsigned* bar, unsigned x, unsigned& nloc, unsigned& nx) {
    const unsigned G = gridDim.x * gridDim.y * gridDim.z;
    unsigned sum, cnt, mine, sp = 0u;
    for (;;) {
        sum = 0u; cnt = 0u; mine = 0u;
#pragma unroll
        for (unsigned j = 0; j < 16; ++j) { const unsigned c = xb_ld(&bar[XB_XCNT(j)]); sum += c; cnt += (c > 0u) ? 1u : 0u; mine = (j == x) ? c : mine; }
        if (sum == G) break;
        __builtin_amdgcn_s_sleep(1);
        if ((++sp & 255u) == 0u) { if (xb_ld(&bar[XB_TMO])) break; if (sp > XB_SPIN_CAP) { atomicAdd(&bar[XB_TMO], 1u); break; } }
    }
    nloc = mine > 0u ? mine : 1u; nx = cnt > 0u ? cnt : 1u;
}
__device__ __forceinline__ void xcd_barrier(const XcdBarrier& b) {
    asm volatile("s_waitcnt vmcnt(0)" ::: "memory");
    __syncthreads();
    if (threadIdx.x == 0) {
        unsigned* bar = b.bar;
        __builtin_amdgcn_s_waitcnt(0);
        unsigned nloc = b.st[0], nx = b.st[1];
        if (nloc == 0u) { xcd_barrier_complete(bar, b.x, nloc, nx); b.st[0] = nloc; b.st[1] = nx; }
        const unsigned old = xb_add(&bar[XB_XSUB(b.x)], 1u);
        const unsigned gen = old / nloc;
        if (old + 1u == (gen + 1u) * nloc) {
            __builtin_amdgcn_fence(__ATOMIC_RELEASE, "agent");
            asm volatile("s_waitcnt vmcnt(0)" ::: "memory");
            const unsigned og = xb_add(&bar[XB_TOP], 1u);
            const unsigned tg = og / nx;
            if (og + 1u == (tg + 1u) * nx) xb_add(&bar[XB_TOPGEN], 1u);
            else XB_SPIN(xb_ld(&bar[XB_TOPGEN]) == tg, bar);
            __builtin_amdgcn_fence(__ATOMIC_ACQUIRE, "agent");
            xb_add(&bar[XB_XGEN(b.x)], 1u);
            asm volatile("s_waitcnt vmcnt(0)" ::: "memory");
        } else {
            XB_SPIN(xb_ld(&bar[XB_XGEN(b.x)]) == gen, bar);
            __builtin_amdgcn_fence(__ATOMIC_ACQUIRE, "agent");
            asm volatile("s_waitcnt vmcnt(0)" ::: "memory");
        }
    }
    __syncthreads();
}

constexpr int NPH = 23;
__device__ __forceinline__ void run_phase(CP p, int ph, int b, LAS unsigned char* lds) {
    asm volatile("" : "+s"(p));
    unsigned char* ws = p->ws;
    const float* xb = p->x + (size_t)b * S_ * D_; float* hb = p->out + (size_t)b * S_ * D_;
    bf16_t* XN = (bf16_t*)(ws + OFF_XN);
    const int layer = (ph >= 13) ? 1 : 0;
    switch (ph) {
    case 0: prep_phase(p, lds); break;
    case 1: rmsnorm_phase(xb, p->norm_mix, XN, nullptr, nullptr); break;
    case 2: {
        Prob2D<EpiQK> g1{(const char*)XN, (const char*)(ws + OFF_W_RIN), 4096u, 4096u, 32, 64, 16, EpiQK{(bf16_t*)(ws + OFF_Q), (bf16_t*)(ws + OFF_K), (bf16_t*)(ws + OFF_KTD), (const float2*)(ws + OFF_ROPE)}};
        gemm_phase(lds, g1);
        Prob2D<EpiStore> g2{(const char*)(ws + OFF_W_RIN) + (size_t)4096 * 4096, (const char*)XN, 4096u, 4096u, 32, 16, 64, EpiStore{(bf16_t*)(ws + OFF_VT), (size_t)S_}};
        gemm_phase(lds, g2);
    } break;
    case 3: {
        ProbKV g3{(const char*)(ws + OFF_VT), (const char*)(ws + OFF_KTD), (bf16_t*)(ws + OFF_ST), 4};
        gemm_phase(lds, g3);
        ProbS g4{(const char*)(ws + OFF_Q), (const char*)(ws + OFF_K), (bf16_t*)(ws + OFF_SD), 4};
        gemm_phase(lds, g4);
    } break;
    case 4: scan_phase((bf16_t*)(ws + OFF_ST)); break;
    case 5: {
        ProbOut g5{(const char*)(ws + OFF_Q), (const char*)(ws + OFF_ST), (long)OFF_SD - (long)OFF_Q, (long)OFF_VT - (long)OFF_ST, (bf16_t*)(ws + OFF_Y), 8};
        gemm_phase(lds, g5);
    } break;
    case 6: gn_phase((bf16_t*)(ws + OFF_Y), p->ret_gn); break;
    case 7: {
        Prob2D<EpiGate> g6{(const char*)XN, (const char*)(ws + OFF_W_RIN) + (size_t)8192 * 4096, 4096u, 4096u, 32, 64, 16, EpiGate{(bf16_t*)(ws + OFF_Y)}};
        gemm_phase(lds, g6);
    } break;
    case 8: {
        Prob2D<EpiRes> g7{(const char*)(ws + OFF_Y), (const char*)(ws + OFF_W_ROUT), 8192u, 8192u, 64, 64, 8, EpiRes{xb, hb, XN, (float*)(ws + OFF_SS) + (size_t)(b * 4 + 0) * S_}};
        gemm_phase(lds, g7);
    } break;
    case 10: case 20: {
        Prob2D<EpiStoreRS> g8{(const char*)XN, (const char*)(ws + OFF_W_FIN + (size_t)layer * 32 * MiB), 4096u, 4096u, 32, 64, 32, EpiStoreRS{(bf16_t*)(ws + OFF_U), (size_t)8192, (const float*)(ws + OFF_SS) + (size_t)(b * 4 + (layer ? 2 : 0)) * S_}};
        gemm_phase(lds, g8);
    } break;
    case 11: case 21: conv_phase((const bf16_t*)(ws + OFF_U), (bf16_t*)(ws + OFF_AB), p->ffn_conv_w + (size_t)layer * 3 * 8192, p->ffn_conv_b + (size_t)layer * 8192); break;
    case 12: case 22: {
        Prob2D<EpiRes> g9{(const char*)(ws + OFF_AB), (const char*)(ws + OFF_W_FOUT + (size_t)layer * 16 * MiB), 8192u, 8192u, 64, 64, 8, EpiRes{hb, hb, layer ? (bf16_t*)nullptr : XN, layer ? (float*)nullptr : (float*)(ws + OFF_SS) + (size_t)(b * 4 + 1) * S_}};
        gemm_phase(lds, g9);
    } break;
    case 14: {
        const float* ss1 = (const float*)(ws + OFF_SS) + (size_t)(b * 4 + 1) * S_;
        Prob2D<EpiStoreRS> g10{(const char*)XN, (const char*)(ws + OFF_W_KV), 4096u, 4096u, 32, 64, 8, EpiStoreRS{(bf16_t*)(ws + OFF_KVTOK), (size_t)2048, ss1}};
        gemm_phase(lds, g10);
        Prob2D<EpiStoreCS> g11{(const char*)(ws + OFF_W_KV) + (size_t)2048 * 4096, (const char*)XN, 4096u, 4096u, 32, 4, 64, EpiStoreCS{(bf16_t*)(ws + OFF_KVT), (size_t)S_, ss1}};
        gemm_phase(lds, g11);
    } break;
    case 15: {
        ProbCmp1 a{(const char*)(ws + OFF_KVTOK), (const char*)(ws + OFF_W_C1K), 8192u, 64, 16, EpiGelu{(bf16_t*)(ws + OFF_H1), (const float*)(ws + OFF_PEB)}};
        gemm_phase(lds, a, (int)gridDim.x - 32);
        ProbCmp1 v{(const char*)(ws + OFF_KVTOK) + 1024, (const char*)(ws + OFF_W_C1V), 8192u, 64, 16, EpiGelu{(bf16_t*)(ws + OFF_H1) + 4096 * 256, (const float*)(ws + OFF_PEB) + 256}};
        gemm_phase(lds, v, (int)gridDim.x - 16);
        Prob2D<EpiQproj> g12{(const char*)XN, (const char*)(ws + OFF_W_Q), 4096u, 4096u, 32, 64, 9, EpiQproj{(bf16_t*)(ws + OFF_QB), (float*)(ws + OFF_GATES), (const float*)(ws + OFF_SS) + (size_t)(b * 4 + 1) * S_}};
        gemm_phase(lds, g12);
    } break;
    case 16: {
        Prob2D<EpiKcmp> a{(const char*)(ws + OFF_H1), (const char*)(ws + OFF_W_C2K), 512u, 512u, 4, 16, 1, EpiKcmp{(bf16_t*)(ws + OFF_KCMP)}};
        gemm_phase(lds, a);
        Prob2D<EpiVcmp> v{(const char*)(ws + OFF_W_C2V), (const char*)(ws + OFF_H1) + (size_t)4096 * 256 * 2, 512u, 512u, 4, 1, 16, EpiVcmp{(bf16_t*)(ws + OFF_VCMPT)}};
        gemm_phase(lds, v);
    } break;
    case 17: attn_phase(ws, lds); break;
    case 18: {
        Prob2D<EpiRes> g{(const char*)(ws + OFF_ATT), (const char*)(ws + OFF_W_O), 4096u, 4096u, 32, 64, 8, EpiRes{hb, hb, XN, (float*)(ws + OFF_SS) + (size_t)(b * 4 + 2) * S_}};
        gemm_phase(lds, g);
    } break;
    case 23: finalnorm_phase(hb, p->final_gain); break;
    default: break;
    }
}

#if MULTI
__global__ void __launch_bounds__(512) phase_kernel(Params p, int ph, int b) {
    extern __shared__ __attribute__((aligned(16))) unsigned char shm[];
    run_phase((CP)__builtin_amdgcn_kernarg_segment_ptr(), ph, b, (LAS unsigned char*)shm);
}
#else
__global__ void __launch_bounds__(512) mega_kernel(Params p) {
    extern __shared__ __attribute__((aligned(16))) unsigned char shm[];
    cg::grid_group grid = cg::this_grid();
    CP cp = (CP)__builtin_amdgcn_kernarg_segment_ptr();
    volatile LAS unsigned* st = (volatile LAS unsigned*)((LAS unsigned char*)shm + LDS_ST);
    if (threadIdx.x == 0) { st[0] = 0u; st[1] = 0u; st[2] = 0u; st[3] = 0u; }
    __syncthreads();
    XcdBarrier xb = xcd_barrier_post((unsigned*)(cp->ws + OFF_BAR), st);
    run_phase(cp, 0, 0, (LAS unsigned char*)shm);
    grid.sync();
    for (int b = 0; b < 2; ++b)
        for (int ph = 1; ph <= NPH; ++ph) {
            if (ph == 9 || ph == 13 || ph == 19) continue;
#ifdef PROBE_PH
            const int reps = (ph == PROBE_PH || ph == PROBE_PH2) ? 2 : 1;
#else
            const int reps = 1;
#endif
            for (int rep = 0; rep < reps; ++rep) { run_phase(cp, ph, b, (LAS unsigned char*)shm); xcd_barrier(xb); } }
}
#endif

constexpr int LDS_BYTES = LDS_ST + 16;
extern "C" void kernel_launch(void* const* d_in, const int* in_sizes, int n_in, void* d_out, int out_size, void* d_ws, size_t ws_size, hipStream_t stream) {
    static int grid = 0;
    if (grid == 0) {
        if (n_in != 21 || out_size != 2 * S_ * D_ || ws_size < WS_NEED) { fprintf(stderr, "kernel_launch: unexpected shapes/ws (n_in %d out %d ws %zu need %zu)\n", n_in, out_size, ws_size, (size_t)WS_NEED); grid = -1; return; }
#if MULTI
        if (hipFuncSetAttribute((const void*)phase_kernel, hipFuncAttributeMaxDynamicSharedMemorySize, LDS_BYTES) != hipSuccess) { fprintf(stderr, "hipFuncSetAttribute failed\n"); grid = -1; return; }
#else
        if (hipFuncSetAttribute((const void*)mega_kernel, hipFuncAttributeMaxDynamicSharedMemorySize, LDS_BYTES) != hipSuccess) { fprintf(stderr, "hipFuncSetAttribute failed\n"); grid = -1; return; }
#endif
        int dev = 0, cus = 0; hipGetDevice(&dev); hipDeviceGetAttribute(&cus, hipDeviceAttributeMultiprocessorCount, dev);
        grid = cus > 0 ? cus : 256;
    }
    if (grid < 0) return;
    Params p{};
    const float** pp = (const float**)&p;
    for (int i = 0; i < 21; ++i) pp[i] = (const float*)d_in[i];
    p.out = (float*)d_out; p.ws = (unsigned char*)d_ws;
#if MULTI
    hipLaunchKernelGGL(phase_kernel, dim3(grid), dim3(512), LDS_BYTES, stream, p, 0, 0);
    for (int b = 0; b < 2; ++b)
        for (int ph = 1; ph <= NPH; ++ph) hipLaunchKernelGGL(phase_kernel, dim3(grid), dim3(512), LDS_BYTES, stream, p, ph, b);
#else
    if (hipMemsetAsync((unsigned char*)d_ws + OFF_BAR, 0, XCD_BAR_WORDS * 4, stream) != hipSuccess) { fprintf(stderr, "memset failed\n"); return; }
    void* args[] = {&p};
    hipError_t e = hipLaunchCooperativeKernel((const void*)mega_kernel, dim3(grid), dim3(512), args, LDS_BYTES, stream);
    if (e != hipSuccess) fprintf(stderr, "cooperative launch failed: %s (grid %d)\n", hipGetErrorString(e), grid);
#endif
}
```

```cpp
#include <hip/hip_runtime.h>
#include <hip/hip_cooperative_groups.h>
#include <cstdio>
namespace cg = cooperative_groups;

#ifndef MULTI
#define MULTI 0
#endif

#define LAS __attribute__((address_space(3)))
typedef unsigned short bf16_t;
typedef short bf16x8 __attribute__((ext_vector_type(8)));
typedef float f32x4 __attribute__((ext_vector_type(4)));
typedef unsigned u32x2 __attribute__((ext_vector_type(2)));
typedef unsigned u32x4 __attribute__((ext_vector_type(4)));

constexpr int S_ = 16384, D_ = 2048;
constexpr size_t MiB = 1048576;
constexpr size_t OFF_W_RIN = 0, OFF_W_ROUT = 48 * MiB, OFF_W_KV = 64 * MiB, OFF_W_C1K = 76 * MiB, OFF_W_C1V = 78 * MiB,
                 OFF_W_C2K = 80 * MiB, OFF_W_C2V = 80 * MiB + 131072, OFF_W_Q = 81 * MiB, OFF_W_O = 90 * MiB,
                 OFF_W_FIN = 98 * MiB  , OFF_W_FOUT = 162 * MiB  , OFF_ROPE = 194 * MiB, OFF_PEB = 210 * MiB, OFF_BAR = 210 * MiB + 65536, OFF_SS = 210 * MiB + 131072  ,
                 OFF_XN = 211 * MiB, OFF_ACT = 275 * MiB;
constexpr size_t OFF_Q = OFF_ACT, OFF_K = OFF_ACT + 64 * MiB, OFF_KTD = OFF_ACT + 128 * MiB, OFF_VT = OFF_ACT + 192 * MiB,
                 OFF_ST = OFF_ACT + 320 * MiB, OFF_SD = OFF_ACT + 448 * MiB, OFF_Y = OFF_ACT + 512 * MiB, WS_NEED = OFF_ACT + 640 * MiB;
constexpr size_t OFF_U = OFF_ACT, OFF_AB = OFF_ACT + 256 * MiB;
constexpr size_t OFF_HN = OFF_ACT, OFF_KVTOK = OFF_ACT + 64 * MiB, OFF_KVT = OFF_ACT + 129 * MiB, OFF_QB = OFF_ACT + 161 * MiB,
                 OFF_GATES = OFF_ACT + 225 * MiB, OFF_H1 = OFF_ACT + 229 * MiB, OFF_KCMP = OFF_ACT + 233 * MiB, OFF_VCMPT = OFF_ACT + 234 * MiB,
                 OFF_ATT = OFF_ACT + 235 * MiB, OFF_OACC = OFF_ACT + 299 * MiB;

struct Params {
    const float* x; const float* norm_mix; const float* norm_ffn; const float* ret_w_in; const float* ret_gn; const float* ret_w_out;
    const float* kv_gain; const float* w_kv; const float* pe_k; const float* w1_k; const float* w2_k; const float* pe_v; const float* w1_v;
    const float* w2_v; const float* w_q; const float* w_o; const float* ffn_w_in; const float* ffn_conv_w; const float* ffn_conv_b;
    const float* ffn_w_out; const float* final_gain; float* out; unsigned char* ws;
};

typedef const __attribute__((address_space(4))) Params* CP;
__device__ __forceinline__ int ltid() { int t = threadIdx.x; asm volatile("" : "+v"(t)); return t; }
__device__ __forceinline__ unsigned pk_bf16(float lo, float hi) { unsigned r; asm("v_cvt_pk_bf16_f32 %0, %1, %2" : "=v"(r) : "v"(lo), "v"(hi)); return r; }
__device__ __forceinline__ float bflo(unsigned v) { return __uint_as_float(v << 16); }
__device__ __forceinline__ float bfhi(unsigned v) { return __uint_as_float(v & 0xffff0000u); }
__device__ __forceinline__ float fexp2(float x) { return __builtin_amdgcn_exp2f(x); }
__device__ __forceinline__ float frcp(float x) { return __builtin_amdgcn_rcpf(x); }
__device__ __forceinline__ float log2gamma(int h) { return log2f(1.0f - exp2f(-5.0f - (float)h)); }
__device__ __forceinline__ float sigmoidf_(float x) { return frcp(1.0f + fexp2(-1.4426950408889634f * x)); }

__device__ __forceinline__ float shx(float v, int m, int lane) { return __int_as_float(__builtin_amdgcn_ds_bpermute((lane ^ m) << 2, __float_as_int(v))); }
__device__ __forceinline__ unsigned long long shx64(unsigned long long v, int m, int lane) {
    const unsigned lo = (unsigned)__builtin_amdgcn_ds_bpermute((lane ^ m) << 2, (int)(unsigned)v), hi = (unsigned)__builtin_amdgcn_ds_bpermute((lane ^ m) << 2, (int)(unsigned)(v >> 32));
    return ((unsigned long long)hi << 32) | lo; }
__device__ __forceinline__ float wave_sum(float v, int lane) {
#pragma unroll
    for (int o = 32; o >= 1; o >>= 1) v += shx(v, o, lane);
    return v;
}
constexpr int HTB = 128 * 64 * 2;
__device__ __forceinline__ int lds_byte(int r, int c) { const int st = (r >> 4) * 2 + (c >> 5), rr = r & 15, cc = c & 31, ob = rr * 64 + cc * 2; return st * 1024 + (ob ^ (((ob >> 9) & 1) << 5)); }
__device__ __forceinline__ void stage_rc(int b, int& R, int& C) { const int st = b / 1024, sb = b % 1024, swz = sb ^ (((sb >> 9) & 1) << 5); R = (st >> 1) * 16 + swz / 64; C = (st & 1) * 32 + (swz % 64) / 2; }
__device__ __forceinline__ void tile_order(int L, int nM, int nN, int& pm, int& pn) {
    const int nwg = nM * nN; int wgid = L;
    { const int q = nwg / 8, r = nwg % 8, xcd = wgid % 8, off = wgid / 8; wgid = (xcd < r ? xcd * (q + 1) : r * (q + 1) + (xcd - r) * q) + off; }
    const int nig = 8 * nN, gid = wgid / nig, fm = gid * 8, gsz = (nM - fm) < 8 ? (nM - fm) : 8;
    pm = fm + ((wgid % nig) % gsz); pn = (wgid % nig) / gsz;
}
struct UInfo { const char* a; const char* b; int r0, c0, x0, x1; };
typedef f32x4 AccT[2][2][4][2];

template <class P>
__device__ __forceinline__ void gemm_phase(LAS unsigned char* lds, const P& pb, int cofs = 0) {
    const int tid = ltid(), wid = __builtin_amdgcn_readfirstlane(tid >> 6), lane = tid & 63, wr = wid >> 2, wc = wid & 3, fr = lane & 15, fq = lane >> 4;
    const int nt = pb.nt, G = gridDim.x, c = (int)blockIdx.x - cofs; const long nun = pb.nunits();
    if (c < 0 || c >= nun) return;
    unsigned voffA[2], voffB[2];
#pragma unroll
    for (int i = 0; i < 2; ++i) { int R, C; stage_rc(tid * 16 + i * 8192, R, C); voffA[i] = pb.rowA(R) + (unsigned)C * 2u; const int rho = R & 31; const int Rb = P::PERM ? ((R & ~31) + 8 * ((rho & 15) >> 2) + 4 * (rho >> 4) + (rho & 3)) : R; voffB[i] = (unsigned)Rb * pb.ldb + (unsigned)C * 2u; }
    const size_t hsA = pb.rowA(128), hsB = (size_t)128 * pb.ldb;
    const unsigned ldsw = (unsigned)wid * 1024u;
    const int aoff = lds_byte(wr * 64 + fr, fq * 8), boff = lds_byte(wc * 32 + fr, fq * 8);
#define G_SA(b, h) (((b) * 2 + (h)) * HTB)
#define G_SB(b, h) ((4 + (b) * 2 + (h)) * HTB)
#define G_STAGE(bufoff, gbase, voff) do { _Pragma("unroll") for (int _i = 0; _i < 2; ++_i) \
        __builtin_amdgcn_global_load_lds((const unsigned*)((const char*)(gbase) + (voff)[_i]), (LAS unsigned*)(lds + (bufoff) + ldsw + _i * 8192), 16, 0, 0); } while (0)
#define G_LDA(dst, b, h) do { _Pragma("unroll") for (int m = 0; m < 4; ++m) _Pragma("unroll") for (int k = 0; k < 2; ++k) dst[m][k] = *(const LAS bf16x8*)(lds + G_SA(b, h) + aoff + m * 2048 + k * 1024); } while (0)
#define G_LDB(dst, b, h) do { _Pragma("unroll") for (int n = 0; n < 2; ++n) _Pragma("unroll") for (int k = 0; k < 2; ++k) dst[n][k] = *(const LAS bf16x8*)(lds + G_SB(b, h) + boff + n * 2048 + k * 1024); } while (0)
#define G_MMA(ai, bj, At, Bt) do { __builtin_amdgcn_s_setprio(1); _Pragma("unroll") for (int m = 0; m < 4; ++m) _Pragma("unroll") for (int n = 0; n < 2; ++n) _Pragma("unroll") for (int k = 0; k < 2; ++k) \
        acc[ai][bj][m][n] = __builtin_amdgcn_mfma_f32_16x16x32_bf16(Bt[n][k], At[m][k], acc[ai][bj][m][n], 0, 0, 0); __builtin_amdgcn_s_setprio(0); } while (0)
#define G_WAIT_V(n) asm volatile("s_waitcnt vmcnt(" #n ")" ::: "memory")
#define G_WAIT_L(n) asm volatile("s_waitcnt lgkmcnt(" #n ")" ::: "memory")
#define G_BAR __builtin_amdgcn_s_barrier()
#define G_SCHED __builtin_amdgcn_sched_barrier(0)
    UInfo cur, nxt; int ui = 0;
    pb.unit(c, cur);
    AccT acc;
#pragma unroll
    for (int a = 0; a < 2; ++a)
#pragma unroll
        for (int b = 0; b < 2; ++b)
#pragma unroll
            for (int m = 0; m < 4; ++m)
#pragma unroll
                for (int n = 0; n < 2; ++n) acc[a][b][m][n] = (f32x4){0.f, 0.f, 0.f, 0.f};
    bf16x8 At[4][2], B0[2][2], B1[2][2];
    const char* cA = cur.a; const char* cB = cur.b;
    G_STAGE(G_SB(0, 0), cB + pb.bK(0), voffB); G_STAGE(G_SA(0, 0), cA + pb.aK(0), voffA); G_STAGE(G_SB(0, 1), cB + hsB + pb.bK(0), voffB); G_STAGE(G_SA(0, 1), cA + hsA + pb.aK(0), voffA);
    if (wr == 1) G_BAR;
    G_WAIT_V(4); G_BAR;
    G_STAGE(G_SB(1, 0), cB + pb.bK(1), voffB); G_STAGE(G_SA(1, 0), cA + pb.aK(1), voffA); G_STAGE(G_SB(1, 1), cB + hsB + pb.bK(1), voffB);
    G_WAIT_V(6); G_BAR;
    for (;;) {
        const long Ln = (long)(ui + 1) * G + c; const bool has_next = Ln < nun;
        if (has_next) pb.unit(Ln, nxt);
        const char* nA = has_next ? nxt.a : cA; const char* nB = has_next ? nxt.b : cB;
        for (int t = 0; t < nt; t += 2) {
            const bool last = (t == nt - 2);
            const char* a1 = cA + pb.aK(t + 1);
            const char* a2 = last ? nA + pb.aK(0) : cA + pb.aK(t + 2); const char* b2 = last ? nB + pb.bK(0) : cB + pb.bK(t + 2);
            const char* a3 = last ? nA + pb.aK(1) : cA + pb.aK(t + 3); const char* b3 = last ? nB + pb.bK(1) : cB + pb.bK(t + 3);
            G_LDB(B0, 0, 0); G_SCHED; G_LDA(At, 0, 0); G_STAGE(G_SA(1, 1), a1 + hsA, voffA);
            G_WAIT_L(8); G_BAR; G_WAIT_L(0); G_MMA(0, 0, At, B0); G_BAR; G_SCHED;
            G_LDB(B1, 0, 1); G_STAGE(G_SB(0, 0), b2, voffB);
            G_BAR; G_WAIT_L(0); G_MMA(0, 1, At, B1); G_BAR;
            G_LDA(At, 0, 1); G_STAGE(G_SA(0, 0), a2, voffA);
            G_BAR; G_WAIT_L(0); G_MMA(1, 0, At, B0); G_BAR; G_SCHED;
            G_STAGE(G_SB(0, 1), b2 + hsB, voffB);
            G_WAIT_V(6); G_BAR; G_MMA(1, 1, At, B1); G_BAR;
            G_LDB(B0, 1, 0); G_SCHED; G_LDA(At, 1, 0); G_STAGE(G_SA(0, 1), a2 + hsA, voffA);
            G_WAIT_L(8); G_BAR; G_WAIT_L(0); G_MMA(0, 0, At, B0); G_BAR; G_SCHED;
            G_LDB(B1, 1, 1); G_STAGE(G_SB(1, 0), b3, voffB);
            G_BAR; G_WAIT_L(0); G_MMA(0, 1, At, B1); G_BAR;
            G_LDA(At, 1, 1); G_STAGE(G_SA(1, 0), a3, voffA);
            G_BAR; G_WAIT_L(0); G_MMA(1, 0, At, B0); G_BAR; G_SCHED;
            G_STAGE(G_SB(1, 1), b3 + hsB, voffB);
            G_WAIT_V(6); G_BAR; G_MMA(1, 1, At, B1); G_BAR;
        }
        { const int l2 = ltid() & 63; pb.epi(acc, cur, wr, wc, l2 & 15, l2 >> 4); }
        if (!has_next) break;
#pragma unroll
        for (int a = 0; a < 2; ++a)
#pragma unroll
            for (int b = 0; b < 2; ++b)
#pragma unroll
                for (int m = 0; m < 4; ++m)
#pragma unroll
                    for (int n = 0; n < 2; ++n) acc[a][b][m][n] = (f32x4){0.f, 0.f, 0.f, 0.f};
        cur = nxt; cA = nA; cB = nB; ++ui;
    }
    G_WAIT_V(0);
    if (wr == 0) G_BAR;
    G_BAR;
}

#define EPI_ROWS for (int ai = 0; ai < 2; ++ai) for (int m = 0; m < 4; ++m)
#define EPI_COLS for (int bj = 0; bj < 2; ++bj) for (int n = 0; n < 2; ++n)
#define EPI_ROW (128 * ai + 64 * wr + 16 * m + fr)
#define EPI_COL (128 * bj + 32 * wc + 16 * n + 4 * fq)

template <class Epi> struct Prob2D {
    static constexpr bool PERM = Epi::PERM;
    const char* A; const char* B; unsigned lda, ldb; int nt, nM, nN; Epi e;
    __device__ __forceinline__ long nunits() const { return (long)nM * nN; }
    __device__ __forceinline__ unsigned rowA(int R) const { return (unsigned)R * lda; }
    __device__ __forceinline__ void unit(long L, UInfo& u) const { int pm, pn; tile_order((int)L, nM, nN, pm, pn); u.a = A + (size_t)pm * 256 * lda; u.b = B + (size_t)pn * 256 * ldb; u.r0 = pm * 256; u.c0 = pn * 256; u.x0 = 0; u.x1 = 0; }
    __device__ __forceinline__ size_t aK(int kt) const { return (size_t)kt * 128; }
    __device__ __forceinline__ size_t bK(int kt) const { return (size_t)kt * 128; }
    __device__ __forceinline__ void epi(const AccT& acc, const UInfo& u, int wr, int wc, int fr, int fq) const { e(acc, u, wr, wc, fr, fq); }
};
struct EpiStore { static constexpr bool PERM = true; bf16_t* O; size_t ldc;
    __device__ __forceinline__ void operator()(const AccT& acc, const UInfo& u, int wr, int wc, int fr, int fq) const {
#pragma unroll
        EPI_ROWS { bf16_t* rp = O + (size_t)(u.r0 + EPI_ROW) * ldc + u.c0;
#pragma unroll
            for (int bj = 0; bj < 2; ++bj) { const f32x4 v = acc[ai][bj][m][0], v2 = acc[ai][bj][m][1]; *(u32x4*)(rp + 128 * bj + 32 * wc + 8 * fq) = (u32x4){pk_bf16(v[0], v[1]), pk_bf16(v[2], v[3]), pk_bf16(v2[0], v2[1]), pk_bf16(v2[2], v2[3])}; } }
    } };
struct EpiRes { static constexpr bool PERM = false; const float* R; float* O; bf16_t* HB; float* ss;
    __device__ __forceinline__ void operator()(const AccT& acc, const UInfo& u, int wr, int wc, int fr, int fq) const {
#pragma unroll
        EPI_ROWS { const size_t ro = (size_t)(u.r0 + EPI_ROW) * 2048 + u.c0; float sq = 0.f;
#pragma unroll
            EPI_COLS { const f32x4 r = *(const f32x4*)(R + ro + EPI_COL); const f32x4 o = r + acc[ai][bj][m][n]; *(f32x4*)(O + ro + EPI_COL) = o;
                if (HB) { *(u32x2*)(HB + ro + EPI_COL) = (u32x2){pk_bf16(o[0], o[1]), pk_bf16(o[2], o[3])}; sq += o[0] * o[0] + o[1] * o[1] + o[2] * o[2] + o[3] * o[3]; } }
            if (HB) { const int lane = fq * 16 + fr; sq += shx(sq, 16, lane); sq += shx(sq, 32, lane); if (fq == 0) atomicAdd(ss + u.r0 + EPI_ROW, sq); } }
    } };
struct EpiStoreRS { static constexpr bool PERM = true; bf16_t* O; size_t ldc; const float* ss;
    __device__ __forceinline__ void operator()(const AccT& acc, const UInfo& u, int wr, int wc, int fr, int fq) const {
#pragma unroll
        EPI_ROWS { const int row = u.r0 + EPI_ROW; const float rs = rsqrtf(ss[row] * (1.0f / 2048.0f) + 1e-6f); bf16_t* rp = O + (size_t)row * ldc + u.c0;
#pragma unroll
            for (int bj = 0; bj < 2; ++bj) { const f32x4 v = acc[ai][bj][m][0] * rs, v2 = acc[ai][bj][m][1] * rs; *(u32x4*)(rp + 128 * bj + 32 * wc + 8 * fq) = (u32x4){pk_bf16(v[0], v[1]), pk_bf16(v[2], v[3]), pk_bf16(v2[0], v2[1]), pk_bf16(v2[2], v2[3])}; } }
    } };
struct EpiStoreCS { static constexpr bool PERM = true; bf16_t* O; size_t ldc; const float* ss;
    __device__ __forceinline__ void operator()(const AccT& acc, const UInfo& u, int wr, int wc, int fr, int fq) const {
        f32x4 rs[2][2];
#pragma unroll
        for (int bj = 0; bj < 2; ++bj)
#pragma unroll
            for (int n = 0; n < 2; ++n) { const f32x4 s4 = *(const f32x4*)(ss + u.c0 + 128 * bj + 32 * wc + 8 * fq + 4 * n);
#pragma unroll
                for (int j = 0; j < 4; ++j) rs[bj][n][j] = rsqrtf(s4[j] * (1.0f / 2048.0f) + 1e-6f); }
#pragma unroll
        EPI_ROWS { bf16_t* rp = O + (size_t)(u.r0 + EPI_ROW) * ldc + u.c0;
#pragma unroll
            for (int bj = 0; bj < 2; ++bj) { const f32x4 v = acc[ai][bj][m][0] * rs[bj][0], v2 = acc[ai][bj][m][1] * rs[bj][1]; *(u32x4*)(rp + 128 * bj + 32 * wc + 8 * fq) = (u32x4){pk_bf16(v[0], v[1]), pk_bf16(v[2], v[3]), pk_bf16(v2[0], v2[1]), pk_bf16(v2[2], v2[3])}; } }
    } };
struct EpiGate { static constexpr bool PERM = true; bf16_t* Y;
    __device__ __forceinline__ void operator()(const AccT& acc, const UInfo& u, int wr, int wc, int fr, int fq) const {
#pragma unroll
        EPI_ROWS { bf16_t* rp = Y + (size_t)(u.r0 + EPI_ROW) * 4096 + u.c0;
#pragma unroll
            for (int bj = 0; bj < 2; ++bj) { const f32x4 g = acc[ai][bj][m][0], h = acc[ai][bj][m][1]; bf16_t* cp = rp + 128 * bj + 32 * wc + 8 * fq; const u32x4 y = *(const u32x4*)cp;
                const float o0 = g[0] * sigmoidf_(g[0]) * bflo(y[0]), o1 = g[1] * sigmoidf_(g[1]) * bfhi(y[0]), o2 = g[2] * sigmoidf_(g[2]) * bflo(y[1]), o3 = g[3] * sigmoidf_(g[3]) * bfhi(y[1]);
                const float o4 = h[0] * sigmoidf_(h[0]) * bflo(y[2]), o5 = h[1] * sigmoidf_(h[1]) * bfhi(y[2]), o6 = h[2] * sigmoidf_(h[2]) * bflo(y[3]), o7 = h[3] * sigmoidf_(h[3]) * bfhi(y[3]);
                *(u32x4*)cp = (u32x4){pk_bf16(o0, o1), pk_bf16(o2, o3), pk_bf16(o4, o5), pk_bf16(o6, o7)}; } }
    } };
struct EpiQK { static constexpr bool PERM = false; bf16_t* Q; bf16_t* K; bf16_t* KTD; const float2* rope;
    __device__ __forceinline__ void operator()(const AccT& acc, const UInfo& u, int wr, int wc, int fr, int fq) const {
        const int hidx = u.c0 >> 8; const bool isk = hidx >= 8; const int hh = hidx & 7; const float l2g = log2gamma(hh);
        bf16_t* dst = (isk ? K : Q) + hh * 256; const float sc = isk ? 0.0625f : 1.0f;
#pragma unroll
        EPI_ROWS { const int t = u.r0 + EPI_ROW; const float kd = fexp2((float)(255 - (t & 255)) * l2g);
#pragma unroll
            for (int n = 0; n < 2; ++n) { const int dd = 32 * wc + 16 * n + 4 * fq;
                const f32x4 x1 = acc[ai][0][m][n], x2 = acc[ai][1][m][n]; const f32x4 cs0 = *(const f32x4*)(rope + (size_t)t * 128 + dd), cs1 = *(const f32x4*)(rope + (size_t)t * 128 + dd + 2);
                float y1[4], y2[4];
                y1[0] = (x1[0] * cs0[0] - x2[0] * cs0[1]) * sc; y2[0] = (x1[0] * cs0[1] + x2[0] * cs0[0]) * sc;
                y1[1] = (x1[1] * cs0[2] - x2[1] * cs0[3]) * sc; y2[1] = (x1[1] * cs0[3] + x2[1] * cs0[2]) * sc;
                y1[2] = (x1[2] * cs1[0] - x2[2] * cs1[1]) * sc; y2[2] = (x1[2] * cs1[1] + x2[2] * cs1[0]) * sc;
                y1[3] = (x1[3] * cs1[2] - x2[3] * cs1[3]) * sc; y2[3] = (x1[3] * cs1[3] + x2[3] * cs1[2]) * sc;
                *(u32x2*)(dst + (size_t)t * 2048 + dd) = (u32x2){pk_bf16(y1[0], y1[1]), pk_bf16(y1[2], y1[3])};
                *(u32x2*)(dst + (size_t)t * 2048 + 128 + dd) = (u32x2){pk_bf16(y2[0], y2[1]), pk_bf16(y2[2], y2[3])};
                if (isk) {
#pragma unroll
                    for (int j = 0; j < 4; ++j) { KTD[(size_t)(hh * 256 + dd + j) * S_ + t] = (bf16_t)(pk_bf16(y1[j] * kd, 0.f) & 0xffffu); KTD[(size_t)(hh * 256 + 128 + dd + j) * S_ + t] = (bf16_t)(pk_bf16(y2[j] * kd, 0.f) & 0xffffu); }
                } } }
    } };
struct EpiQproj { static constexpr bool PERM = false; bf16_t* QB; float* gates; const float* ss;
    __device__ __forceinline__ void operator()(const AccT& acc, const UInfo& u, int wr, int wc, int fr, int fq) const {
#pragma unroll
        EPI_ROWS { const int t = u.r0 + EPI_ROW; const float rs = rsqrtf(ss[t] * (1.0f / 2048.0f) + 1e-6f);
#pragma unroll
            EPI_COLS { const int col = u.c0 + EPI_COL; const f32x4 v = acc[ai][bj][m][n] * rs;
                if (col < 2048) *(u32x2*)(QB + (size_t)t * 2048 + col) = (u32x2){pk_bf16(v[0] * 0.08838834764831845f, v[1] * 0.08838834764831845f), pk_bf16(v[2] * 0.08838834764831845f, v[3] * 0.08838834764831845f)};
                else if (col < 2096) *(f32x4*)(gates + (size_t)t * 48 + (col - 2048)) = (f32x4){sigmoidf_(v[0]), sigmoidf_(v[1]), sigmoidf_(v[2]), sigmoidf_(v[3])}; } }
    } };
__device__ __forceinline__ float gelu_tanh(float x) { const float y = 0.7978845608028654f * (x + 0.044715f * x * x * x); const float e = fexp2(2.0f * 1.4426950408889634f * y); const float th = 1.0f - 2.0f * frcp(e + 1.0f); return 0.5f * x * (1.0f + th); }
struct EpiGelu { static constexpr bool PERM = false; bf16_t* H; const float* bias;
    __device__ __forceinline__ void operator()(const AccT& acc, const UInfo& u, int wr, int wc, int fr, int fq) const {
#pragma unroll
        EPI_ROWS { bf16_t* rp = H + (size_t)(u.r0 + EPI_ROW) * 256;
#pragma unroll
            EPI_COLS { const int col = EPI_COL; const f32x4 v = acc[ai][bj][m][n]; const f32x4 bb = *(const f32x4*)(bias + col);
                *(u32x2*)(rp + col) = (u32x2){pk_bf16(gelu_tanh(v[0] + bb[0]), gelu_tanh(v[1] + bb[1])), pk_bf16(gelu_tanh(v[2] + bb[2]), gelu_tanh(v[3] + bb[3]))}; } }
    } };
struct EpiKcmp { static constexpr bool PERM = false; bf16_t* KC;
    __device__ __forceinline__ void operator()(const AccT& acc, const UInfo& u, int wr, int wc, int fr, int fq) const {
#pragma unroll
        EPI_ROWS { const int r = u.r0 + EPI_ROW, i = r >> 2, h = r & 3;
#pragma unroll
            for (int n = 0; n < 2; ++n) { const int col = 32 * wc + 16 * n + 4 * fq; f32x4 v = acc[ai][0][m][n]; if (i == 1023) v = (f32x4){0.f, 0.f, 0.f, 0.f};
                *(u32x2*)(KC + ((size_t)h * 1024 + i) * 128 + col) = (u32x2){pk_bf16(v[0], v[1]), pk_bf16(v[2], v[3])}; } }
    } };
struct EpiVcmp { static constexpr bool PERM = false; bf16_t* VC;
    __device__ __forceinline__ void operator()(const AccT& acc, const UInfo& u, int wr, int wc, int fr, int fq) const {
#pragma unroll
        for (int m = 0; m < 4; ++m) { const int d = 64 * wr + 16 * m + fr;
#pragma unroll
            EPI_COLS { const int col = u.c0 + EPI_COL, i = col >> 2; f32x4 v = acc[0][bj][m][n]; if (i == 1023) v = (f32x4){0.f, 0.f, 0.f, 0.f};
#pragma unroll
                for (int h = 0; h < 4; ++h) VC[((size_t)h * 128 + d) * 1024 + i] = (bf16_t)(pk_bf16(v[h], 0.f) & 0xffffu); } }
    } };
struct ProbCmp1 {
    static constexpr bool PERM = false;
    const char* A; const char* B; unsigned ldb; int nt, nM; EpiGelu e;
    __device__ __forceinline__ long nunits() const { return nM; }
    __device__ __forceinline__ unsigned rowA(int R) const { return (unsigned)(R >> 2) * 65536u + (unsigned)(R & 3) * 256u; }
    __device__ __forceinline__ void unit(long L, UInfo& u) const { u.a = A + (size_t)L * 64 * 65536; u.b = B; u.r0 = (int)L * 256; u.c0 = 0; u.x0 = 0; u.x1 = 0; }
    __device__ __forceinline__ size_t aK(int kt) const { return (size_t)(kt >> 1) * 4096 + (size_t)(kt & 1) * 128; }
    __device__ __forceinline__ size_t bK(int kt) const { return (size_t)kt * 128; }
    __device__ __forceinline__ void epi(const AccT& acc, const UInfo& u, int wr, int wc, int fr, int fq) const { e(acc, u, wr, wc, fr, fq); }
};
struct ProbKV {
    static constexpr bool PERM = true;
    const char* VT; const char* KTD; bf16_t* ST; int nt;
    __device__ __forceinline__ long nunits() const { return 8 * 64 * 2; }
    __device__ __forceinline__ unsigned rowA(int R) const { return (unsigned)R * 32768u; }
    static constexpr unsigned ldb = 32768u;
    __device__ __forceinline__ void unit(long L, UInfo& u) const { const int pm = (int)L & 1, c = ((int)L >> 1) & 63, h = (int)L >> 7;
        u.a = VT + ((size_t)(h * 512 + pm * 256) * S_ + c * 256) * 2; u.b = KTD + ((size_t)(h * 256) * S_ + c * 256) * 2; u.r0 = h * 512 + pm * 256; u.c0 = c * 256; u.x0 = 0; u.x1 = 0; }
    __device__ __forceinline__ size_t aK(int kt) const { return (size_t)kt * 128; }
    __device__ __forceinline__ size_t bK(int kt) const { return (size_t)kt * 128; }
    __device__ __forceinline__ void epi(const AccT& acc, const UInfo& u, int wr, int wc, int fr, int fq) const { EpiStore e{ST, (size_t)S_}; e(acc, u, wr, wc, fr, fq); }
};
struct ProbS {
    static constexpr bool PERM = true;
    const char* Q; const char* K; bf16_t* SD; int nt;
    __device__ __forceinline__ long nunits() const { return 8 * 64; }
    __device__ __forceinline__ unsigned rowA(int R) const { return (unsigned)R * 4096u; }
    static constexpr unsigned ldb = 4096u;
    __device__ __forceinline__ void unit(long L, UInfo& u) const { const int c = (int)L & 63, h = (int)L >> 6; const size_t o = ((size_t)(c * 256) * 2048 + h * 256) * 2;
        u.a = Q + o; u.b = K + o; u.r0 = c * 256; u.c0 = h * 256; u.x0 = h; u.x1 = 0; }
    __device__ __forceinline__ size_t aK(int kt) const { return (size_t)kt * 128; }
    __device__ __forceinline__ size_t bK(int kt) const { return (size_t)kt * 128; }
    __device__ __forceinline__ void epi(const AccT& acc, const UInfo& u, int wr, int wc, int fr, int fq) const {
        const float l2g = log2gamma(u.x0);
#pragma unroll
        EPI_ROWS { const int i = EPI_ROW; bf16_t* rp = SD + (size_t)(u.r0 + i) * 2048 + u.c0;
#pragma unroll
            for (int bj = 0; bj < 2; ++bj) { const int s = 128 * bj + 32 * wc + 8 * fq; const f32x4 v = acc[ai][bj][m][0], v2 = acc[ai][bj][m][1]; float o[8];
#pragma unroll
                for (int j = 0; j < 4; ++j) { o[j] = (s + j <= i) ? v[j] * fexp2(-(float)(s + j + 1) * l2g) : 0.f; o[4 + j] = (s + 4 + j <= i) ? v2[j] * fexp2(-(float)(s + 4 + j + 1) * l2g) : 0.f; }
                *(u32x4*)(rp + s) = (u32x4){pk_bf16(o[0], o[1]), pk_bf16(o[2], o[3]), pk_bf16(o[4], o[5]), pk_bf16(o[6], o[7])}; } }
    }
};
struct ProbOut {
    static constexpr bool PERM = true;
    const char* Q; const char* ST; long dA, dB; bf16_t* Y; int nt;
    __device__ __forceinline__ long nunits() const { return 8 * 64 * 2; }
    __device__ __forceinline__ unsigned rowA(int R) const { return (unsigned)R * 4096u; }
    static constexpr unsigned ldb = 32768u;
    __device__ __forceinline__ void unit(long L, UInfo& u) const { const int pn = (int)L & 1, c = ((int)L >> 1) & 63, h = (int)L >> 7;
        u.a = Q + ((size_t)(c * 256) * 2048 + h * 256) * 2; u.b = ST + ((size_t)(h * 512 + pn * 256) * S_ + c * 256) * 2; u.r0 = c * 256; u.c0 = h * 512 + pn * 256; u.x0 = h; u.x1 = 0; }
    __device__ __forceinline__ size_t aK(int kt) const { return kt < 4 ? (size_t)kt * 128 : (size_t)(dA + (long)(kt - 4) * 128); }
    __device__ __forceinline__ size_t bK(int kt) const { return kt < 4 ? (size_t)kt * 128 : (size_t)(dB + (long)(kt - 4) * 128); }
    __device__ __forceinline__ void epi(const AccT& acc, const UInfo& u, int wr, int wc, int fr, int fq) const {
        const float l2g = log2gamma(u.x0);
#pragma unroll
        EPI_ROWS { const int i = EPI_ROW; const float qd = fexp2((float)(i + 1) * l2g); bf16_t* rp = Y + (size_t)(u.r0 + i) * 4096 + u.c0;
#pragma unroll
            for (int bj = 0; bj < 2; ++bj) { const f32x4 v = acc[ai][bj][m][0] * qd, v2 = acc[ai][bj][m][1] * qd; *(u32x4*)(rp + 128 * bj + 32 * wc + 8 * fq) = (u32x4){pk_bf16(v[0], v[1]), pk_bf16(v[2], v[3]), pk_bf16(v2[0], v2[1]), pk_bf16(v2[2], v2[3])}; } }
    }
};

__device__ __forceinline__ void transpose_job(const float* __restrict__ src, bf16_t* __restrict__ dst, int K, int N, int Npad, int kvperm, LAS float* tile, const float* gain = nullptr) {
    const int tk = K / 64, tn = Npad / 256, ntile = tk * tn; const int tid = ltid();
    for (int t = blockIdx.x; t < ntile; t += gridDim.x) {
        const int k0 = (t % tk) * 64, n0 = (t / tk) * 256;
        { const int r0 = tid >> 6, cc = tid & 63; float v[8][4];
#pragma unroll
          for (int i = 0; i < 8; ++i)
#pragma unroll
              for (int q = 0; q < 4; ++q) { const int n = n0 + cc + 64 * q; v[i][q] = (n < N) ? src[(size_t)(k0 + r0 + 8 * i) * N + n] : 0.f; }
#pragma unroll
          for (int i = 0; i < 8; ++i) { const float gk = gain ? gain[k0 + r0 + 8 * i] : 1.0f;
#pragma unroll
              for (int q = 0; q < 4; ++q) tile[(r0 + 8 * i) * 257 + cc + 64 * q] = v[i][q] * gk; } }
        __syncthreads();
        { const int rr = tid >> 1, c0 = (tid & 1) * 32;
          int n = n0 + rr; if (kvperm) { const int j = n >> 9; const int jp = (j == 3) ? 4 : ((j == 4) ? 3 : j); n = jp * 512 + (n & 511); }
          bf16_t* dp = dst + (size_t)n * K + k0 + c0;
#pragma unroll
          for (int g = 0; g < 4; ++g) { float x[8];
#pragma unroll
              for (int j = 0; j < 8; ++j) x[j] = tile[(c0 + 8 * g + j) * 257 + rr];
              *(u32x4*)(dp + 8 * g) = (u32x4){pk_bf16(x[0], x[1]), pk_bf16(x[2], x[3]), pk_bf16(x[4], x[5]), pk_bf16(x[6], x[7])}; } }
        __syncthreads();
    }
}
__device__ __forceinline__ void prep_phase(CP p, LAS unsigned char* lds) {
    LAS float* tile = (LAS float*)lds; unsigned char* ws = p->ws;
    transpose_job(p->ret_w_in, (bf16_t*)(ws + OFF_W_RIN), 2048, 12288, 12288, 0, tile);
    transpose_job(p->ret_w_out, (bf16_t*)(ws + OFF_W_ROUT), 4096, 2048, 2048, 0, tile);
    transpose_job(p->w_kv, (bf16_t*)(ws + OFF_W_KV), 2048, 3072, 3072, 1, tile, p->kv_gain);
    transpose_job(p->w1_k, (bf16_t*)(ws + OFF_W_C1K), 4096, 256, 256, 0, tile);
    transpose_job(p->w1_v, (bf16_t*)(ws + OFF_W_C1V), 4096, 256, 256, 0, tile);
    transpose_job(p->w2_k, (bf16_t*)(ws + OFF_W_C2K), 256, 128, 256, 0, tile);
    transpose_job(p->w2_v, (bf16_t*)(ws + OFF_W_C2V), 256, 128, 256, 0, tile);
    transpose_job(p->w_q, (bf16_t*)(ws + OFF_W_Q), 2048, 2096, 2304, 0, tile, p->norm_mix + 2048);
    transpose_job(p->w_o, (bf16_t*)(ws + OFF_W_O), 2048, 2048, 2048, 0, tile);
    transpose_job(p->ffn_w_in, (bf16_t*)(ws + OFF_W_FIN), 2048, 8192, 8192, 0, tile, p->norm_ffn);
    transpose_job(p->ffn_w_in + (size_t)2048 * 8192, (bf16_t*)(ws + OFF_W_FIN + 32 * MiB), 2048, 8192, 8192, 0, tile, p->norm_ffn + 2048);
    transpose_job(p->ffn_w_out, (bf16_t*)(ws + OFF_W_FOUT), 4096, 2048, 2048, 0, tile);
    transpose_job(p->ffn_w_out + (size_t)4096 * 2048, (bf16_t*)(ws + OFF_W_FOUT + 16 * MiB), 4096, 2048, 2048, 0, tile);
    { float* ss = (float*)(ws + OFF_SS); for (int i = blockIdx.x * 512 + ltid(); i < 8 * S_; i += gridDim.x * 512) ss[i] = 0.f; }
    { float2* rope = (float2*)(ws + OFF_ROPE); const int gsz = gridDim.x * 512;
      for (int i = blockIdx.x * 512 + ltid(); i < S_ * 128; i += gsz) { const int t = i >> 7, dd = i & 127;
          const float freq = exp2f(-(float)dd * (13.287712379549449f / 128.0f)); const double rev = (double)t * (double)freq * 0.15915494309189535;
          const float fx = (float)(rev - rint(rev)); rope[i] = make_float2(__builtin_amdgcn_cosf(fx), __builtin_amdgcn_sinf(fx)); } }
    if (blockIdx.x < 128) { const int kv = blockIdx.x >> 6, oc = blockIdx.x & 63; const float* pe = kv ? p->pe_v : p->pe_k; const float* w1 = kv ? p->w1_v : p->w1_k; float* peb = (float*)(ws + OFF_PEB) + kv * 256;
        const int tid = ltid(), g = tid >> 7, r = tid & 127, n = 4 * oc + g; float s = 0.f;
#pragma unroll 8
        for (int j = 0; j < 32; ++j) { const int k = r + 128 * j; s += pe[k] * w1[(size_t)k * 256 + n]; }
        s = wave_sum(s, tid & 63);
        __syncthreads(); if ((tid & 63) == 0) tile[tid >> 6] = s; __syncthreads();
        if (tid < 4) peb[4 * oc + tid] = tile[2 * tid] + tile[2 * tid + 1];
        __syncthreads(); }
}
__device__ __forceinline__ void rmsnorm_phase(const float* h, const float* g1, bf16_t* o1, const float* g2, bf16_t* o2) {
    const int w = ltid() >> 6, lane = ltid() & 63;
    for (int row = blockIdx.x * 8 + w; row < S_; row += gridDim.x * 8) {
        const f32x4* p = (const f32x4*)(h + (size_t)row * 2048); f32x4 v[8]; float ss = 0.f;
#pragma unroll
        for (int i = 0; i < 8; ++i) { v[i] = p[lane + 64 * i]; ss += v[i][0] * v[i][0] + v[i][1] * v[i][1] + v[i][2] * v[i][2] + v[i][3] * v[i][3]; }
        ss = wave_sum(ss, lane); const float r = rsqrtf(ss * (1.0f / 2048.0f) + 1e-6f);
#pragma unroll
        for (int i = 0; i < 8; ++i) { const int col = (lane + 64 * i) * 4; const f32x4 g = *(const f32x4*)(g1 + col);
            *(u32x2*)(o1 + (size_t)row * 2048 + col) = (u32x2){pk_bf16(v[i][0] * r * g[0], v[i][1] * r * g[1]), pk_bf16(v[i][2] * r * g[2], v[i][3] * r * g[3])};
            if (o2) { const f32x4 gg = *(const f32x4*)(g2 + col);
                *(u32x2*)(o2 + (size_t)row * 2048 + col) = (u32x2){pk_bf16(v[i][0] * r * gg[0], v[i][1] * r * gg[1]), pk_bf16(v[i][2] * r * gg[2], v[i][3] * r * gg[3])}; } }
    }
}
__device__ __forceinline__ void finalnorm_phase(float* h, const float* g1) {
    const int w = ltid() >> 6, lane = ltid() & 63;
    for (int row = blockIdx.x * 8 + w; row < S_; row += gridDim.x * 8) {
        f32x4* p = (f32x4*)(h + (size_t)row * 2048); f32x4 v[8]; float ss = 0.f;
#pragma unroll
        for (int i = 0; i < 8; ++i) { v[i] = p[lane + 64 * i]; ss += v[i][0] * v[i][0] + v[i][1] * v[i][1] + v[i][2] * v[i][2] + v[i][3] * v[i][3]; }
        ss = wave_sum(ss, lane); const float r = rsqrtf(ss * (1.0f / 2048.0f) + 1e-6f);
#pragma unroll
        for (int i = 0; i < 8; ++i) { const f32x4 g = *(const f32x4*)(g1 + (lane + 64 * i) * 4); p[lane + 64 * i] = v[i] * r * g; }
    }
}
__device__ __forceinline__ void scan_phase(bf16_t* ST) {
    for (int it = blockIdx.x * 512 + ltid(); it < 4096 * 32; it += gridDim.x * 512) {
        const int r = it >> 5, d8 = it & 31; const float cd = fexp2(256.0f * log2gamma(r >> 9));
        bf16_t* p = ST + (size_t)r * S_ + d8 * 8; float s[8];
#pragma unroll
        for (int j = 0; j < 8; ++j) s[j] = 0.f;
        for (int c = 0; c < 64; ++c) { const u32x4 v = *(const u32x4*)(p + c * 256);
            *(u32x4*)(p + c * 256) = (u32x4){pk_bf16(s[0], s[1]), pk_bf16(s[2], s[3]), pk_bf16(s[4], s[5]), pk_bf16(s[6], s[7])};
#pragma unroll
            for (int j = 0; j < 4; ++j) { s[2 * j] = s[2 * j] * cd + bflo(v[j]); s[2 * j + 1] = s[2 * j + 1] * cd + bfhi(v[j]); } }
    }
}
__device__ __forceinline__ void gn_phase(bf16_t* Y, const float* gain) {
    const int w = ltid() >> 6, lane = ltid() & 63;
    for (int g = blockIdx.x * 8 + w; g < S_ * 8; g += gridDim.x * 8) {
        bf16_t* p = Y + (size_t)g * 512 + lane * 8; const u32x4 v = *(const u32x4*)p; float x[8];
#pragma unroll
        for (int j = 0; j < 4; ++j) { x[2 * j] = bflo(v[j]); x[2 * j + 1] = bfhi(v[j]); }
        float s = 0.f;
#pragma unroll
        for (int j = 0; j < 8; ++j) s += x[j];
        const float mu = wave_sum(s, lane) * (1.0f / 512.0f); float q = 0.f;
#pragma unroll
        for (int j = 0; j < 8; ++j) { x[j] -= mu; q += x[j] * x[j]; }
        const float r = rsqrtf(wave_sum(q, lane) * (1.0f / 512.0f) + 1e-6f); const float* gp = gain + (g & 7) * 512 + lane * 8;
        const f32x4 g0 = *(const f32x4*)gp, g1 = *(const f32x4*)(gp + 4);
        *(u32x4*)p = (u32x4){pk_bf16(x[0] * r * g0[0], x[1] * r * g0[1]), pk_bf16(x[2] * r * g0[2], x[3] * r * g0[3]), pk_bf16(x[4] * r * g1[0], x[5] * r * g1[1]), pk_bf16(x[6] * r * g1[2], x[7] * r * g1[3])};
    }
}
__device__ __forceinline__ void conv_phase(const bf16_t* U, bf16_t* AB, const float* cw, const float* cb) {
    for (int it = blockIdx.x * 512 + ltid(); it < 512 * 512; it += gridDim.x * 512) {
        const int n8 = (it & 511) * 8, t0 = (it >> 9) * 32;
        float wa[3][8], wb[3][8], ba[8], bb[8];
#pragma unroll
        for (int tp = 0; tp < 3; ++tp)
#pragma unroll
            for (int j = 0; j < 8; ++j) { wa[tp][j] = cw[tp * 8192 + n8 + j]; wb[tp][j] = cw[tp * 8192 + 4096 + n8 + j]; }
#pragma unroll
        for (int j = 0; j < 8; ++j) { ba[j] = cb[n8 + j]; bb[j] = cb[4096 + n8 + j]; }
        float pa[2][8], pb[2][8];
#pragma unroll
        for (int k = 0; k < 2; ++k) { const int t = t0 - 2 + k; u32x4 va = (u32x4){0, 0, 0, 0}, vb = (u32x4){0, 0, 0, 0};
            if (t >= 0) { va = *(const u32x4*)(U + (size_t)t * 8192 + n8); vb = *(const u32x4*)(U + (size_t)t * 8192 + 4096 + n8); }
#pragma unroll
            for (int j = 0; j < 4; ++j) { pa[k][2 * j] = bflo(va[j]); pa[k][2 * j + 1] = bfhi(va[j]); pb[k][2 * j] = bflo(vb[j]); pb[k][2 * j + 1] = bfhi(vb[j]); } }
#pragma unroll 8
        for (int k = 0; k < 32; ++k) { const int t = t0 + k; const u32x4 va = *(const u32x4*)(U + (size_t)t * 8192 + n8), vb = *(const u32x4*)(U + (size_t)t * 8192 + 4096 + n8);
            float xa[8], xb[8], o[8];
#pragma unroll
            for (int j = 0; j < 4; ++j) { xa[2 * j] = bflo(va[j]); xa[2 * j + 1] = bfhi(va[j]); xb[2 * j] = bflo(vb[j]); xb[2 * j + 1] = bfhi(vb[j]); }
#pragma unroll
            for (int j = 0; j < 8; ++j) { const float a = ba[j] + wa[0][j] * pa[0][j] + wa[1][j] * pa[1][j] + wa[2][j] * xa[j]; const float b = bb[j] + wb[0][j] * pb[0][j] + wb[1][j] * pb[1][j] + wb[2][j] * xb[j];
                o[j] = a * sigmoidf_(a) * b; pa[0][j] = pa[1][j]; pa[1][j] = xa[j]; pb[0][j] = pb[1][j]; pb[1][j] = xb[j]; }
            *(u32x4*)(AB + (size_t)t * 4096 + n8) = (u32x4){pk_bf16(o[0], o[1]), pk_bf16(o[2], o[3]), pk_bf16(o[4], o[5]), pk_bf16(o[6], o[7])}; }
    }
}

constexpr int A_KT = 0, A_VT = 17408, A_BUFSZ = 34816, A_PSL = 69632, A_SEL = 69632 + 65536, LDS_ST = 139264;
constexpr float LOG2E = 1.4426950408889634f;
struct AttnState { f32x4 ot[8][2]; float m[2], l[2]; };

template <int MODE>
__device__ __forceinline__ void attn_compute(LAS unsigned char* lds, int boff, int tile, const bf16x8 (&qf)[2][4], AttnState& st, const int (&tpos)[2], int qb, int w, int lane,
                                             const float (&mfin)[2], const float (&linv)[2], bool rs0, bool rs1, bool masked, bool a0, bool a1) {
    const int l16 = lane & 15, g4 = lane >> 4;
    f32x4 s[4][2];
#pragma unroll
    for (int mt = 0; mt < 4; ++mt) { s[mt][0] = (f32x4){0.f, 0.f, 0.f, 0.f}; s[mt][1] = (f32x4){0.f, 0.f, 0.f, 0.f}; }
#pragma unroll
    for (int ks = 0; ks < 4; ++ks) {
        bf16x8 kf[4];
#pragma unroll
        for (int mt = 0; mt < 4; ++mt) kf[mt] = *(const LAS bf16x8*)(lds + boff + A_KT + (16 * mt + l16) * 272 + ks * 64 + g4 * 16);
        if (a0) {
#pragma unroll
            for (int mt = 0; mt < 4; ++mt) s[mt][0] = __builtin_amdgcn_mfma_f32_16x16x32_bf16(kf[mt], qf[0][ks], s[mt][0], 0, 0, 0);
        }
        if (a1) {
#pragma unroll
            for (int mt = 0; mt < 4; ++mt) s[mt][1] = __builtin_amdgcn_mfma_f32_16x16x32_bf16(kf[mt], qf[1][ks], s[mt][1], 0, 0, 0);
        }
        if (ks & 1) __builtin_amdgcn_sched_barrier(0);
    }
    if (masked) {
#pragma unroll
        for (int nt = 0; nt < 2; ++nt) { const int t = tpos[nt]; const int tl = w * 8 + nt * 4 + (l16 >> 2);
#pragma unroll
            for (int mt = 0; mt < 4; ++mt)
#pragma unroll
                for (int j = 0; j < 4; ++j) { const int kl = 16 * mt + 4 * g4 + j; const int key = tile * 64 + kl; bool v;
                    if (MODE == 0 || MODE == 1) v = key <= ((t - 31) >> 4);
                    else if (MODE == 2) v = (kl <= tl);
                    else v = (key <= t) && (key > t - 512);
                    s[mt][nt][j] = v ? s[mt][nt][j] : -__builtin_inff(); } }
    }
    bf16x8 pf[2][2];
#pragma unroll
    for (int nt = 0; nt < 2; ++nt) {
        if (nt ? a1 : a0) {
            const bool rowsel = nt ? rs1 : rs0;
            const float bias = (MODE == 2 && !rowsel) ? -__builtin_inff() : 0.f;
            float mx = -1e30f;
#pragma unroll
            for (int mt = 0; mt < 4; ++mt)
#pragma unroll
                for (int j = 0; j < 4; ++j) {
                    const float sv = s[mt][nt][j] * LOG2E + bias;
                    s[mt][nt][j] = sv; mx = fmaxf(mx, sv); }
            float mnew, alpha = 1.f;
            if (MODE == 1) mnew = mfin[nt];
            else { mx = fmaxf(mx, shx(mx, 16, lane)); mx = fmaxf(mx, shx(mx, 32, lane)); mnew = fmaxf(st.m[nt], mx); alpha = fexp2(st.m[nt] - mnew); st.m[nt] = mnew; }
            float ps = 0.f;
#pragma unroll
            for (int mt = 0; mt < 4; ++mt)
#pragma unroll
                for (int j = 0; j < 4; ++j) { float pv = fexp2(s[mt][nt][j] - mnew); if (MODE == 1) pv *= linv[nt]; s[mt][nt][j] = pv; ps += pv; }
            if (MODE != 1) st.l[nt] = st.l[nt] * alpha + ps;
            if (MODE == 2 || MODE == 3) {
#pragma unroll
                for (int md = 0; md < 8; ++md) st.ot[md][nt] = st.ot[md][nt] * alpha;
            }
            if (MODE == 1) {
#pragma unroll
                for (int mt = 0; mt < 4; ++mt) { float a = s[mt][nt][0] + s[mt][nt][1] + s[mt][nt][2] + s[mt][nt][3], lst = s[mt][nt][3];
                    a += shx(a, 1, lane); a += shx(a, 2, lane); lst += shx(lst, 1, lane); lst += shx(lst, 2, lane);
                    if ((l16 & 3) == 0) { const int jb = tile * 16 + 4 * mt + g4; LAS float* pp = (LAS float*)(lds + A_PSL) + (w * 8 + nt * 4 + (l16 >> 2)) * 256;
                        atomicAdd((float*)(pp + jb), a); if (jb + 1 < 256) atomicAdd((float*)(pp + jb + 1), lst); } }
            }
            if (MODE != 0) {
#pragma unroll
                for (int kk = 0; kk < 2; ++kk) { const u32x4 pk = (u32x4){pk_bf16(s[2 * kk][nt][0], s[2 * kk][nt][1]), pk_bf16(s[2 * kk][nt][2], s[2 * kk][nt][3]), pk_bf16(s[2 * kk + 1][nt][0], s[2 * kk + 1][nt][1]), pk_bf16(s[2 * kk + 1][nt][2], s[2 * kk + 1][nt][3])};
                    pf[nt][kk] = __builtin_bit_cast(bf16x8, pk); }
            }
        } else { pf[nt][0] = (bf16x8){0, 0, 0, 0, 0, 0, 0, 0}; pf[nt][1] = (bf16x8){0, 0, 0, 0, 0, 0, 0, 0}; }
    }
    if (MODE != 0) {
#pragma unroll
        for (int kk = 0; kk < 2; ++kk)
#pragma unroll
            for (int mg = 0; mg < 2; ++mg) {
                bf16x8 vf[4];
#pragma unroll
                for (int q = 0; q < 4; ++q) { const LAS unsigned char* vb = lds + boff + A_VT + (16 * (4 * mg + q) + l16) * 136 + kk * 64 + g4 * 8;
                    const u32x2 v0 = *(const LAS u32x2*)vb, v1 = *(const LAS u32x2*)(vb + 32); vf[q] = __builtin_bit_cast(bf16x8, ((u32x4){v0[0], v0[1], v1[0], v1[1]})); }
                if (a0) {
#pragma unroll
                    for (int q = 0; q < 4; ++q) st.ot[4 * mg + q][0] = __builtin_amdgcn_mfma_f32_16x16x32_bf16(vf[q], pf[0][kk], st.ot[4 * mg + q][0], 0, 0, 0);
                }
                if (a1) {
#pragma unroll
                    for (int q = 0; q < 4; ++q) st.ot[4 * mg + q][1] = __builtin_amdgcn_mfma_f32_16x16x32_bf16(vf[q], pf[1][kk], st.ot[4 * mg + q][1], 0, 0, 0);
                }
                if (mg == 1) __builtin_amdgcn_sched_barrier(0);
            }
    }
}
template <int MODE>
__device__ __forceinline__ void attn_tiles(LAS unsigned char* lds, const bf16_t* kp, size_t kstride, const bf16_t* vp, size_t vstride, int tile_lo, int tile_hi,
                                           const bf16x8 (&qf)[2][4], AttnState& st, const int (&tpos)[2], int qb, int w, int lane, const float (&mfin)[2], const float (&linv)[2]) {
    if (tile_lo >= tile_hi) return;
    int tid = w * 64 + lane; asm volatile("" : "+v"(tid)); const int l16 = lane & 15;
    const int krow = tid >> 3, kc = (tid & 7) * 16, vrow = tid >> 2, vc = (tid & 3) * 16;
    u32x4 kr0, kr1, vr0 = (u32x4){0, 0, 0, 0}, vr1 = (u32x4){0, 0, 0, 0};
#define A_LOAD(T) do { const bf16_t* kg = kp + (size_t)((T) * 64 + krow) * kstride + kc; kr0 = *(const u32x4*)kg; kr1 = *(const u32x4*)(kg + 8); \
        if (MODE != 0) { const bf16_t* vg = vp + (size_t)vrow * vstride + (T) * 64 + vc; vr0 = *(const u32x4*)vg; vr1 = *(const u32x4*)(vg + 8); } } while (0)
#define A_WRITE(BO) do { LAS unsigned char* kd = lds + (BO) + A_KT + krow * 272 + kc * 2; *(LAS u32x4*)kd = kr0; *(LAS u32x4*)(kd + 16) = kr1; \
        if (MODE != 0) { LAS unsigned char* vd = lds + (BO) + A_VT + vrow * 136 + vc * 2; *(LAS u32x2*)vd = (u32x2){vr0[0], vr0[1]}; *(LAS u32x2*)(vd + 8) = (u32x2){vr0[2], vr0[3]}; *(LAS u32x2*)(vd + 16) = (u32x2){vr1[0], vr1[1]}; *(LAS u32x2*)(vd + 24) = (u32x2){vr1[2], vr1[3]}; } } while (0)
    A_LOAD(tile_lo);
    __syncthreads();
    A_WRITE(0);
    if (tile_lo + 1 < tile_hi) A_LOAD(tile_lo + 1);
    __syncthreads();
    for (int tile = tile_lo; tile < tile_hi; ++tile) {
        const int boff = ((tile - tile_lo) & 1) * A_BUFSZ;
        if (tile + 1 < tile_hi) { A_WRITE(boff ^ A_BUFSZ); if (tile + 2 < tile_hi) A_LOAD(tile + 2); }
        bool rs0 = true, rs1 = true, active = true;
        if (MODE == 2) { const int tw = tile >> 5; const unsigned bit = 1u << (tile & 31);
            const unsigned w0 = *(const LAS unsigned*)(lds + A_SEL + ((w * 8 + (l16 >> 2)) * 8 + tw) * 4), w1 = *(const LAS unsigned*)(lds + A_SEL + ((w * 8 + 4 + (l16 >> 2)) * 8 + tw) * 4);
            rs0 = (w0 & bit) != 0u; rs1 = (w1 & bit) != 0u; active = __ballot(rs0 || rs1) != 0ull; }
        if (active) {
            bool masked;
            if (MODE == 0 || MODE == 1) masked = (tile * 64 + 63 > 4 * qb - 2);
            else if (MODE == 2) masked = (tile == qb);
            else masked = (tile == qb) || (tile <= qb - 8);
            const bool a0 = (MODE != 2) || (__ballot(rs0) != 0ull), a1 = (MODE != 2) || (__ballot(rs1) != 0ull);
            attn_compute<MODE>(lds, boff, tile, qf, st, tpos, qb, w, lane, mfin, linv, rs0, rs1, masked, a0, a1);
        }
        __syncthreads();
    }
#undef A_LOAD
#undef A_WRITE
}
template <int BR>
__device__ __forceinline__ void attn_finish(AttnState& st, const float* gates, float* oacc, bf16_t* att, const int (&tpos)[2], int hkv, int lane) {
    const int l16 = lane & 15, g4 = lane >> 4, g = l16 & 3;
#pragma unroll
    for (int nt = 0; nt < 2; ++nt) {
        const int t = tpos[nt]; float sc = gates[(size_t)t * 48 + (hkv * 4 + g) * 3 + BR];
        if (BR != 0) { float l = st.l[nt]; l += shx(l, 16, lane); l += shx(l, 32, lane); sc = (l > 0.f) ? sc / l : 0.f; }
        const size_t base = (size_t)t * 2048 + (hkv * 4 + g) * 128 + 4 * g4;
#pragma unroll
        for (int md = 0; md < 8; ++md) { f32x4 v = st.ot[md][nt] * sc; float* op = oacc + base + 16 * md;
            if (BR == 0) *(f32x4*)op = v;
            else if (BR == 1) *(f32x4*)op = *(const f32x4*)op + v;
            else { v = v + *(const f32x4*)op; *(u32x2*)(att + base + 16 * md) = (u32x2){pk_bf16(v[0], v[1]), pk_bf16(v[2], v[3])}; } }
    }
}
__device__ __forceinline__ void attn_reset(AttnState& st) {
#pragma unroll
    for (int md = 0; md < 8; ++md) { st.ot[md][0] = (f32x4){0.f, 0.f, 0.f, 0.f}; st.ot[md][1] = (f32x4){0.f, 0.f, 0.f, 0.f}; }
    st.m[0] = st.m[1] = -1e30f; st.l[0] = st.l[1] = 0.f;
}
__device__ __forceinline__ void attn_item(unsigned char* ws, LAS unsigned char* lds, int hkv, int qb) {
    int tid = ltid(); asm volatile("" : "+v"(tid)); const int w = tid >> 6, lane = tid & 63, l16 = lane & 15, g4 = lane >> 4;
    const bf16_t* QB = (const bf16_t*)(ws + OFF_QB); const bf16_t* KVTOK = (const bf16_t*)(ws + OFF_KVTOK); const bf16_t* KVT = (const bf16_t*)(ws + OFF_KVT);
    const bf16_t* KC = (const bf16_t*)(ws + OFF_KCMP); const bf16_t* VC = (const bf16_t*)(ws + OFF_VCMPT);
    const float* gates = (const float*)(ws + OFF_GATES); float* oacc = (float*)(ws + OFF_OACC); bf16_t* att = (bf16_t*)(ws + OFF_ATT);
    int tpos[2]; bf16x8 qf[2][4];
#pragma unroll
    for (int nt = 0; nt < 2; ++nt) { tpos[nt] = qb * 64 + w * 8 + nt * 4 + (l16 >> 2); const bf16_t* qp = QB + (size_t)tpos[nt] * 2048 + (hkv * 4 + (l16 & 3)) * 128 + g4 * 8;
#pragma unroll
        for (int ks = 0; ks < 4; ++ks) qf[nt][ks] = *(const bf16x8*)(qp + ks * 32); }
    __syncthreads();
    { LAS float* pp = (LAS float*)(lds + A_PSL) + w * 2048;
#pragma unroll
      for (int i = 0; i < 32; ++i) pp[lane + 64 * i] = 0.f; }
    AttnState st; float mfin[2] = {0.f, 0.f}, linv[2] = {0.f, 0.f};
    const int ncmp_tiles = (4 * qb + 3 + 63) >> 6;
    attn_reset(st);
    attn_tiles<0>(lds, KC + (size_t)hkv * 1024 * 128, 128, VC, 1024, 0, ncmp_tiles, qf, st, tpos, qb, w, lane, mfin, linv);
#pragma unroll
    for (int nt = 0; nt < 2; ++nt) { float l = st.l[nt]; l += shx(l, 16, lane); l += shx(l, 32, lane); mfin[nt] = st.m[nt]; linv[nt] = (l > 0.f) ? 1.0f / l : 0.f; }
    attn_reset(st);
    attn_tiles<1>(lds, KC + (size_t)hkv * 1024 * 128, 128, VC + (size_t)hkv * 128 * 1024, 1024, 0, ncmp_tiles, qf, st, tpos, qb, w, lane, mfin, linv);
    attn_finish<0>(st, gates, oacc, att, tpos, hkv, lane);
    __syncthreads();
    {
        LAS unsigned* sel = (LAS unsigned*)(lds + A_SEL) + w * 64;
        if (qb < 16) {
            if (lane < 8) { for (int tk = 0; tk < 8; ++tk) { const int lo = lane * 32; unsigned wd = 0; if (qb >= lo + 31) wd = 0xffffffffu; else if (qb >= lo) wd = (2u << (qb - lo)) - 1u; sel[tk * 8 + lane] = wd; } }
        } else {
            for (int tk = 0; tk < 8; ++tk) {
                const LAS float* pp = (const LAS float*)(lds + A_PSL) + (w * 8 + tk) * 256;
                unsigned key[4]; bool forced[4];
#pragma unroll
                for (int i = 0; i < 4; ++i) { const int j = lane + 64 * i; const float sc = pp[j]; const bool elig = (j >= 1) && (j <= qb - 2);
                    forced[i] = (j == 0) || (j == qb) || (j == qb - 1); key[i] = elig ? (__float_as_uint(sc) + 1u) : 0u; }
                unsigned prefix = 0u;
                for (int bit = 30; bit >= 0; --bit) { const unsigned cand = prefix | (1u << bit); int cnt = 0;
#pragma unroll
                    for (int i = 0; i < 4; ++i) cnt += __popcll(__ballot(key[i] >= cand));
                    if (cnt >= 13) prefix = cand; }
                int cgt = 0;
#pragma unroll
                for (int i = 0; i < 4; ++i) cgt += __popcll(__ballot(key[i] > prefix));
                const int need = 13 - cgt; int base = 0;
#pragma unroll
                for (int i = 0; i < 4; ++i) { const unsigned long long eqm = __ballot(key[i] == prefix);
                    const int rank = base + (int)__builtin_amdgcn_mbcnt_hi((unsigned)(eqm >> 32), __builtin_amdgcn_mbcnt_lo((unsigned)eqm, 0u));
                    const bool taken = forced[i] || (key[i] > prefix) || (key[i] == prefix && rank < need);
                    const unsigned long long bal = __ballot(taken); if (lane == 0) { sel[tk * 8 + 2 * i] = (unsigned)bal; sel[tk * 8 + 2 * i + 1] = (unsigned)(bal >> 32); }
                    base += __popcll(eqm); }
            }
        }
    }
    __syncthreads();
    attn_reset(st);
    attn_tiles<2>(lds, KVTOK + 2 * 512 + hkv * 128, 2048, KVT + (size_t)(hkv * 128) * S_, S_, 0, qb + 1, qf, st, tpos, qb, w, lane, mfin, linv);
    attn_finish<1>(st, gates, oacc, att, tpos, hkv, lane);
    attn_reset(st);
    attn_tiles<3>(lds, KVTOK + 3 * 512 + hkv * 128, 2048, KVT + (size_t)(512 + hkv * 128) * S_, S_, (qb - 8) > 0 ? (qb - 8) : 0, qb + 1, qf, st, tpos, qb, w, lane, mfin, linv);
    attn_finish<2>(st, gates, oacc, att, tpos, hkv, lane);
}
__device__ __forceinline__ void attn_phase(unsigned char* ws, LAS unsigned char* lds) {
#pragma nounroll
    for (int it = blockIdx.x; it < 1024; it += gridDim.x) {
        const int c = it & 255, r = it >> 8;
        attn_item(ws, lds, r, (r & 1) ? 255 - c : c);
    }
}


#define XB_TMO      128
#define XB_XCNT(j)  (256  + 64 * (j))
#define XB_XSUB(j)  (1280 + 64 * (j))
#define XB_XGEN(j)  (2304 + 64 * (j))
#define XB_TOP      3328
#define XB_TOPGEN   3392
#define XCD_BAR_WORDS 3456
#define XB_SPIN_CAP (1u << 22)
__device__ __forceinline__ unsigned xb_ld(unsigned* p)              { return __hip_atomic_load(p, __ATOMIC_RELAXED, __HIP_MEMORY_SCOPE_AGENT); }
__device__ __forceinline__ unsigned xb_add(unsigned* p, unsigned v) { return __hip_atomic_fetch_add(p, v, __ATOMIC_RELAXED, __HIP_MEMORY_SCOPE_AGENT); }
__device__ __forceinline__ unsigned xb_xcc_id() { return (unsigned)__builtin_amdgcn_s_getreg((3 << 11) | 20) & 0xFu; }
#define XB_SPIN(cond, bar) do { unsigned _sp = 0; while (cond) { __builtin_amdgcn_s_sleep(1); \
    if ((++_sp & 255u) == 0u) { if (xb_ld(&(bar)[XB_TMO])) break; if (_sp > XB_SPIN_CAP) { atomicAdd(&(bar)[XB_TMO], 1u); break; } } } } while (0)
struct XcdBarrier { unsigned* bar; unsigned x; volatile LAS unsigned* st; };
__device__ __forceinline__ XcdBarrier xcd_barrier_post(unsigned* bar, volatile LAS unsigned* st) {
    XcdBarrier b; b.bar = bar; b.x = xb_xcc_id(); b.st = st;
    if (threadIdx.x == 0) (void)xb_add(&bar[XB_XCNT(b.x)], 1u);
    return b;
}
__device__ __forceinline__ void xcd_barrier_complete(unsigned* bar, unsigned x, unsigned& nloc, unsigned& nx) {
    const unsigned G = gridDim.x * gridDim.y * gridDim.z;
    unsigned sum, cnt, mine, sp = 0u;
    for (;;) {
        sum = 0u; cnt = 0u; mine = 0u;
#pragma unroll
        for (unsigned j = 0; j < 16; ++j) { const unsigned c = xb_ld(&bar[XB_XCNT(j)]); sum += c; cnt += (c > 0u) ? 1u : 0u; mine = (j == x) ? c : mine; }
        if (sum == G) break;
        __builtin_amdgcn_s_sleep(1);
        if ((++sp & 255u) == 0u) { if (xb_ld(&bar[XB_TMO])) break; if (sp > XB_SPIN_CAP) { atomicAdd(&bar[XB_TMO], 1u); break; } }
    }
    nloc = mine > 0u ? mine : 1u; nx = cnt > 0u ? cnt : 1u;
}
__device__ __forceinline__ void xcd_barrier(const XcdBarrier& b) {
    asm volatile("s_waitcnt vmcnt(0)" ::: "memory");
    __syncthreads();
    if (threadIdx.x == 0) {
        unsigned* bar = b.bar;
        __builtin_amdgcn_s_waitcnt(0);
        unsigned nloc = b.st[0], nx = b.st[1];
        if (nloc == 0u) { xcd_barrier_complete(bar, b.x, nloc, nx); b.st[0] = nloc; b.st[1] = nx; }
        const unsigned old = xb_add(&bar[XB_XSUB(b.x)], 1u);
        const unsigned gen = old / nloc;
        if (old + 1u == (gen + 1u) * nloc) {
            __builtin_amdgcn_fence(__ATOMIC_RELEASE, "agent");
            asm volatile("s_waitcnt vmcnt(0)" ::: "memory");
            const unsigned og = xb_add(&bar[XB_TOP], 1u);
            const unsigned tg = og / nx;
            if (og + 1u == (tg + 1u) * nx) xb_add(&bar[XB_TOPGEN], 1u);
            else XB_SPIN(xb_ld(&bar[XB_TOPGEN]) == tg, bar);
            __builtin_amdgcn_fence(__ATOMIC_ACQUIRE, "agent");
            xb_add(&bar[XB_XGEN(b.x)], 1u);
            asm volatile("s_waitcnt vmcnt(0)" ::: "memory");
        } else {
            XB_SPIN(xb_ld(&bar[XB_XGEN(b.x)]) == gen, bar);
            __builtin_amdgcn_fence(__ATOMIC_ACQUIRE, "agent");
            asm volatile("s_waitcnt vmcnt(0)" ::: "memory");
        }
    }
    __syncthreads();
}

constexpr int NPH = 23;
__device__ __forceinline__ void run_phase(CP p, int ph, int b, LAS unsigned char* lds) {
    asm volatile("" : "+s"(p));
    unsigned char* ws = p->ws;
    const float* xb = p->x + (size_t)b * S_ * D_; float* hb = p->out + (size_t)b * S_ * D_;
    bf16_t* XN = (bf16_t*)(ws + OFF_XN);
    const int layer = (ph >= 13) ? 1 : 0;
    switch (ph) {
    case 0: prep_phase(p, lds); break;
    case 1: rmsnorm_phase(xb, p->norm_mix, XN, nullptr, nullptr); break;
    case 2: {
        Prob2D<EpiQK> g1{(const char*)XN, (const char*)(ws + OFF_W_RIN), 4096u, 4096u, 32, 64, 16, EpiQK{(bf16_t*)(ws + OFF_Q), (bf16_t*)(ws + OFF_K), (bf16_t*)(ws + OFF_KTD), (const float2*)(ws + OFF_ROPE)}};
        gemm_phase(lds, g1);
        Prob2D<EpiStore> g2{(const char*)(ws + OFF_W_RIN) + (size_t)4096 * 4096, (const char*)XN, 4096u, 4096u, 32, 16, 64, EpiStore{(bf16_t*)(ws + OFF_VT), (size_t)S_}};
        gemm_phase(lds, g2);
    } break;
    case 3: {
        ProbKV g3{(const char*)(ws + OFF_VT), (const char*)(ws + OFF_KTD), (bf16_t*)(ws + OFF_ST), 4};
        gemm_phase(lds, g3);
        ProbS g4{(const char*)(ws + OFF_Q), (const char*)(ws + OFF_K), (bf16_t*)(ws + OFF_SD), 4};
        gemm_phase(lds, g4);
    } break;
    case 4: scan_phase((bf16_t*)(ws + OFF_ST)); break;
    case 5: {
        ProbOut g5{(const char*)(ws + OFF_Q), (const char*)(ws + OFF_ST), (long)OFF_SD - (long)OFF_Q, (long)OFF_VT - (long)OFF_ST, (bf16_t*)(ws + OFF_Y), 8};
        gemm_phase(lds, g5);
    } break;
    case 6: gn_phase((bf16_t*)(ws + OFF_Y), p->ret_gn); break;
    case 7: {
        Prob2D<EpiGate> g6{(const char*)XN, (const char*)(ws + OFF_W_RIN) + (size_t)8192 * 4096, 4096u, 4096u, 32, 64, 16, EpiGate{(bf16_t*)(ws + OFF_Y)}};
        gemm_phase(lds, g6);
    } break;
    case 8: {
        Prob2D<EpiRes> g7{(const char*)(ws + OFF_Y), (const char*)(ws + OFF_W_ROUT), 8192u, 8192u, 64, 64, 8, EpiRes{xb, hb, XN, (float*)(ws + OFF_SS) + (size_t)(b * 4 + 0) * S_}};
        gemm_phase(lds, g7);
    } break;
    case 10: case 20: {
        Prob2D<EpiStoreRS> g8{(const char*)XN, (const char*)(ws + OFF_W_FIN + (size_t)layer * 32 * MiB), 4096u, 4096u, 32, 64, 32, EpiStoreRS{(bf16_t*)(ws + OFF_U), (size_t)8192, (const float*)(ws + OFF_SS) + (size_t)(b * 4 + (layer ? 2 : 0)) * S_}};
        gemm_phase(lds, g8);
    } break;
    case 11: case 21: conv_phase((const bf16_t*)(ws + OFF_U), (bf16_t*)(ws + OFF_AB), p->ffn_conv_w + (size_t)layer * 3 * 8192, p->ffn_conv_b + (size_t)layer * 8192); break;
    case 12: case 22: {
        Prob2D<EpiRes> g9{(const char*)(ws + OFF_AB), (const char*)(ws + OFF_W_FOUT + (size_t)layer * 16 * MiB), 8192u, 8192u, 64, 64, 8, EpiRes{hb, hb, layer ? (bf16_t*)nullptr : XN, layer ? (float*)nullptr : (float*)(ws + OFF_SS) + (size_t)(b * 4 + 1) * S_}};
        gemm_phase(lds, g9);
    } break;
    case 14: {
        const float* ss1 = (const float*)(ws + OFF_SS) + (size_t)(b * 4 + 1) * S_;
        Prob2D<EpiStoreRS> g10{(const char*)XN, (const char*)(ws + OFF_W_KV), 4096u, 4096u, 32, 64, 8, EpiStoreRS{(bf16_t*)(ws + OFF_KVTOK), (size_t)2048, ss1}};
        gemm_phase(lds, g10);
        Prob2D<EpiStoreCS> g11{(const char*)(ws + OFF_W_KV) + (size_t)2048 * 4096, (const char*)XN, 4096u, 4096u, 32, 4, 64, EpiStoreCS{(bf16_t*)(ws + OFF_KVT), (size_t)S_, ss1}};
        gemm_phase(lds, g11);
    } break;
    case 15: {
        ProbCmp1 a{(const char*)(ws + OFF_KVTOK), (const char*)(ws + OFF_W_C1K), 8192u, 64, 16, EpiGelu{(bf16_t*)(ws + OFF_H1), (const float*)(ws + OFF_PEB)}};
        gemm_phase(lds, a, (int)gridDim.x - 32);
        ProbCmp1 v{(const char*)(ws + OFF_KVTOK) + 1024, (const char*)(ws + OFF_W_C1V), 8192u, 64, 16, EpiGelu{(bf16_t*)(ws + OFF_H1) + 4096 * 256, (const float*)(ws + OFF_PEB) + 256}};
        gemm_phase(lds, v, (int)gridDim.x - 16);
        Prob2D<EpiQproj> g12{(const char*)XN, (const char*)(ws + OFF_W_Q), 4096u, 4096u, 32, 64, 9, EpiQproj{(bf16_t*)(ws + OFF_QB), (float*)(ws + OFF_GATES), (const float*)(ws + OFF_SS) + (size_t)(b * 4 + 1) * S_}};
        gemm_phase(lds, g12);
    } break;
    case 16: {
        Prob2D<EpiKcmp> a{(const char*)(ws + OFF_H1), (const char*)(ws + OFF_W_C2K), 512u, 512u, 4, 16, 1, EpiKcmp{(bf16_t*)(ws + OFF_KCMP)}};
        gemm_phase(lds, a);
        Prob2D<EpiVcmp> v{(const char*)(ws + OFF_W_C2V), (const char*)(ws + OFF_H1) + (size_t)4096 * 256 * 2, 512u, 512u, 4, 1, 16, EpiVcmp{(bf16_t*)(ws + OFF_VCMPT)}};
        gemm_phase(lds, v);
    } break;
    case 17: attn_phase(ws, lds); break;
    case 18: {
        Prob2D<EpiRes> g{(const char*)(ws + OFF_ATT), (const char*)(ws + OFF_W_O), 4096u, 4096u, 32, 64, 8, EpiRes{hb, hb, XN, (float*)(ws + OFF_SS) + (size_t)(b * 4 + 2) * S_}};
        gemm_phase(lds, g);
    } break;
    case 23: finalnorm_phase(hb, p->final_gain); break;
    default: break;
    }
}

#if MULTI
__global__ void __launch_bounds__(512) phase_kernel(Params p, int ph, int b) {
    extern __shared__ __attribute__((aligned(16))) unsigned char shm[];
    run_phase((CP)__builtin_amdgcn_kernarg_segment_ptr(), ph, b, (LAS unsigned char*)shm);
}
#else
__global__ void __launch_bounds__(512) mega_kernel(Params p) {
    extern __shared__ __attribute__((aligned(16))) unsigned char shm[];
    cg::grid_group grid = cg::this_grid();
    CP cp = (CP)__builtin_amdgcn_kernarg_segment_ptr();
    volatile LAS unsigned* st = (volatile LAS unsigned*)((LAS unsigned char*)shm + LDS_ST);
    if (threadIdx.x == 0) { st[0] = 0u; st[1] = 0u; st[2] = 0u; st[3] = 0u; }
    __syncthreads();
    XcdBarrier xb = xcd_barrier_post((unsigned*)(cp->ws + OFF_BAR), st);
    run_phase(cp, 0, 0, (LAS unsigned char*)shm);
    grid.sync();
    for (int b = 0; b < 2; ++b)
        for (int ph = 1; ph <= NPH; ++ph) {
            if (ph == 9 || ph == 13 || ph == 19) continue;
#ifdef PROBE_PH
            const int reps = (ph == PROBE_PH || ph == PROBE_PH2) ? 2 : 1;
#else
            const int reps = 1;
#endif
            for (int rep = 0; rep < reps; ++rep) { run_phase(cp, ph, b, (LAS unsigned char*)shm); xcd_barrier(xb); } }
}
#endif

constexpr int LDS_BYTES = LDS_ST + 16;
extern "C" void kernel_launch(void* const* d_in, const int* in_sizes, int n_in, void* d_out, int out_size, void* d_ws, size_t ws_size, hipStream_t stream) {
    static int grid = 0;
    if (grid == 0) {
        if (n_in != 21 || out_size != 2 * S_ * D_ || ws_size < WS_NEED) { fprintf(stderr, "kernel_launch: unexpected shapes/ws (n_in %d out %d ws %zu need %zu)\n", n_in, out_size, ws_size, (size_t)WS_NEED); grid = -1; return; }
#if MULTI
        if (hipFuncSetAttribute((const void*)phase_kernel, hipFuncAttributeMaxDynamicSharedMemorySize, LDS_BYTES) != hipSuccess) { fprintf(stderr, "hipFuncSetAttribute failed\n"); grid = -1; return; }
#else
        if (hipFuncSetAttribute((const void*)mega_kernel, hipFuncAttributeMaxDynamicSharedMemorySize, LDS_BYTES) != hipSuccess) { fprintf(stderr, "hipFuncSetAttribute failed\n"); grid = -1; return; }
#endif
        int dev = 0, cus = 0; hipGetDevice(&dev); hipDeviceGetAttribute(&cus, hipDeviceAttributeMultiprocessorCount, dev);
        grid = cus > 0 ? cus : 256;
    }
    if (grid < 0) return;
    Params p{};
    const float** pp = (const float**)&p;
    for (int i = 0; i < 21; ++i) pp[i] = (const float*)d_in[i];
    p.out = (float*)d_out; p.ws = (unsigned char*)d_ws;
#if MULTI
    hipLaunchKernelGGL(phase_kernel, dim3(grid), dim3(512), LDS_BYTES, stream, p, 0, 0);
    for (int b = 0; b < 2; ++b)
        for (int ph = 1; ph <= NPH; ++ph) hipLaunchKernelGGL(phase_kernel, dim3(grid), dim3(512), LDS_BYTES, stream, p, ph, b);
#else
    if (hipMemsetAsync((unsigned char*)d_ws + OFF_BAR, 0, XCD_BAR_WORDS * 4, stream) != hipSuccess) { fprintf(stderr, "memset failed\n"); return; }
    void* args[] = {&p};
    hipError_t e = hipLaunchCooperativeKernel((const void*)mega_kernel, dim3(grid), dim3(512), args, LDS_BYTES, stream);
    if (e != hipSuccess) fprintf(stderr, "cooperative launch failed: %s (grid %d)\n", hipGetErrorString(e), grid);
#endif
}
```

```cpp
#include <hip/hip_runtime.h>
#include <hip/hip_cooperative_groups.h>
#include <cstdio>
namespace cg = cooperative_groups;

#ifndef MULTI
#define MULTI 0
#endif

#define LAS __attribute__((address_space(3)))
typedef unsigned short bf16_t;
typedef short bf16x8 __attribute__((ext_vector_type(8)));
typedef float f32x4 __attribute__((ext_vector_type(4)));
typedef unsigned u32x2 __attribute__((ext_vector_type(2)));
typedef unsigned u32x4 __attribute__((ext_vector_type(4)));

constexpr int S_ = 16384, D_ = 2048;
constexpr size_t MiB = 1048576;
constexpr size_t OFF_W_RIN = 0, OFF_W_ROUT = 48 * MiB, OFF_W_KV = 64 * MiB, OFF_W_C1K = 76 * MiB, OFF_W_C1V = 78 * MiB,
                 OFF_W_C2K = 80 * MiB, OFF_W_C2V = 80 * MiB + 131072, OFF_W_Q = 81 * MiB, OFF_W_O = 90 * MiB,
                 OFF_W_FIN = 98 * MiB  , OFF_W_FOUT = 162 * MiB  , OFF_ROPE = 194 * MiB, OFF_PEB = 210 * MiB, OFF_BAR = 210 * MiB + 65536, OFF_SS = 210 * MiB + 131072  ,
                 OFF_XN = 211 * MiB, OFF_ACT = 275 * MiB;
constexpr size_t OFF_Q = OFF_ACT, OFF_K = OFF_ACT + 64 * MiB, OFF_KTD = OFF_ACT + 128 * MiB, OFF_VT = OFF_ACT + 192 * MiB,
                 OFF_ST = OFF_ACT + 320 * MiB, OFF_SD = OFF_ACT + 448 * MiB, OFF_Y = OFF_ACT + 512 * MiB, WS_NEED = OFF_ACT + 640 * MiB;
constexpr size_t OFF_U = OFF_ACT, OFF_AB = OFF_ACT + 256 * MiB;
constexpr size_t OFF_HN = OFF_ACT, OFF_KVTOK = OFF_ACT + 64 * MiB, OFF_KVT = OFF_ACT + 129 * MiB, OFF_QB = OFF_ACT + 161 * MiB,
                 OFF_GATES = OFF_ACT + 225 * MiB, OFF_H1 = OFF_ACT + 229 * MiB, OFF_KCMP = OFF_ACT + 233 * MiB, OFF_VCMPT = OFF_ACT + 234 * MiB,
                 OFF_ATT = OFF_ACT + 235 * MiB, OFF_OACC = OFF_ACT + 299 * MiB;

struct Params {
    const float* x; const float* norm_mix; const float* norm_ffn; const float* ret_w_in; const float* ret_gn; const float* ret_w_out;
    const float* kv_gain; const float* w_kv; const float* pe_k; const float* w1_k; const float* w2_k; const float* pe_v; const float* w1_v;
    const float* w2_v; const float* w_q; const float* w_o; const float* ffn_w_in; const float* ffn_conv_w; const float* ffn_conv_b;
    const float* ffn_w_out; const float* final_gain; float* out; unsigned char* ws;
};

typedef const __attribute__((address_space(4))) Params* CP;
__device__ __forceinline__ int ltid() { int t = threadIdx.x; asm volatile("" : "+v"(t)); return t; }
__device__ __forceinline__ unsigned pk_bf16(float lo, float hi) { unsigned r; asm("v_cvt_pk_bf16_f32 %0, %1, %2" : "=v"(r) : "v"(lo), "v"(hi)); return r; }
__device__ __forceinline__ float bflo(unsigned v) { return __uint_as_float(v << 16); }
__device__ __forceinline__ float bfhi(unsigned v) { return __uint_as_float(v & 0xffff0000u); }
__device__ __forceinline__ float fexp2(float x) { return __builtin_amdgcn_exp2f(x); }
__device__ __forceinline__ float frcp(float x) { return __builtin_amdgcn_rcpf(x); }
__device__ __forceinline__ float log2gamma(int h) { return log2f(1.0f - exp2f(-5.0f - (float)h)); }
__device__ __forceinline__ float sigmoidf_(float x) { return frcp(1.0f + fexp2(-1.4426950408889634f * x)); }

__device__ __forceinline__ float shx(float v, int m, int lane) { return __int_as_float(__builtin_amdgcn_ds_bpermute((lane ^ m) << 2, __float_as_int(v))); }
__device__ __forceinline__ unsigned long long shx64(unsigned long long v, int m, int lane) {
    const unsigned lo = (unsigned)__builtin_amdgcn_ds_bpermute((lane ^ m) << 2, (int)(unsigned)v), hi = (unsigned)__builtin_amdgcn_ds_bpermute((lane ^ m) << 2, (int)(unsigned)(v >> 32));
    return ((unsigned long long)hi << 32) | lo; }
__device__ __forceinline__ float wave_sum(float v, int lane) {
#pragma unroll
    for (int o = 32; o >= 1; o >>= 1) v += shx(v, o, lane);
    return v;
}
constexpr int HTB = 128 * 64 * 2;
__device__ __forceinline__ int lds_byte(int r, int c) { const int st = (r >> 4) * 2 + (c >> 5), rr = r & 15, cc = c & 31, ob = rr * 64 + cc * 2; return st * 1024 + (ob ^ (((ob >> 9) & 1) << 5)); }
__device__ __forceinline__ void stage_rc(int b, int& R, int& C) { const int st = b / 1024, sb = b % 1024, swz = sb ^ (((sb >> 9) & 1) << 5); R = (st >> 1) * 16 + swz / 64; C = (st & 1) * 32 + (swz % 64) / 2; }
__device__ __forceinline__ void tile_order(int L, int nM, int nN, int& pm, int& pn) {
    const int nwg = nM * nN; int wgid = L;
    { const int q = nwg / 8, r = nwg % 8, xcd = wgid % 8, off = wgid / 8; wgid = (xcd < r ? xcd * (q + 1) : r * (q + 1) + (xcd - r) * q) + off; }
    const int nig = 8 * nN, gid = wgid / nig, fm = gid * 8, gsz = (nM - fm) < 8 ? (nM - fm) : 8;
    pm = fm + ((wgid % nig) % gsz); pn = (wgid % nig) / gsz;
}
struct UInfo { const char* a; const char* b; int r0, c0, x0, x1; };
typedef f32x4 AccT[2][2][4][2];

template <class P>
__device__ __forceinline__ void gemm_phase(LAS unsigned char* lds, const P& pb, int cofs = 0) {
    const int tid = ltid(), wid = __builtin_amdgcn_readfirstlane(tid >> 6), lane = tid & 63, wr = wid >> 2, wc = wid & 3, fr = lane & 15, fq = lane >> 4;
    const int nt = pb.nt, G = gridDim.x, c = (int)blockIdx.x - cofs; const long nun = pb.nunits();
    if (c < 0 || c >= nun) return;
    unsigned voffA[2], voffB[2];
#pragma unroll
    for (int i = 0; i < 2; ++i) { int R, C; stage_rc(tid * 16 + i * 8192, R, C); voffA[i] = pb.rowA(R) + (unsigned)C * 2u; const int rho = R & 31; const int Rb = P::PERM ? ((R & ~31) + 8 * ((rho & 15) >> 2) + 4 * (rho >> 4) + (rho & 3)) : R; voffB[i] = (unsigned)Rb * pb.ldb + (unsigned)C * 2u; }
    const size_t hsA = pb.rowA(128), hsB = (size_t)128 * pb.ldb;
    const unsigned ldsw = (unsigned)wid * 1024u;
    const int aoff = lds_byte(wr * 64 + fr, fq * 8), boff = lds_byte(wc * 32 + fr, fq * 8);
#define G_SA(b, h) (((b) * 2 + (h)) * HTB)
#define G_SB(b, h) ((4 + (b) * 2 + (h)) * HTB)
#define G_STAGE(bufoff, gbase, voff) do { _Pragma("unroll") for (int _i = 0; _i < 2; ++_i) \
        __builtin_amdgcn_global_load_lds((const unsigned*)((const char*)(gbase) + (voff)[_i]), (LAS unsigned*)(lds + (bufoff) + ldsw + _i * 8192), 16, 0, 0); } while (0)
#define G_LDA(dst, b, h) do { _Pragma("unroll") for (int m = 0; m < 4; ++m) _Pragma("unroll") for (int k = 0; k < 2; ++k) dst[m][k] = *(const LAS bf16x8*)(lds + G_SA(b, h) + aoff + m * 2048 + k * 1024); } while (0)
#define G_LDB(dst, b, h) do { _Pragma("unroll") for (int n = 0; n < 2; ++n) _Pragma("unroll") for (int k = 0; k < 2; ++k) dst[n][k] = *(const LAS bf16x8*)(lds + G_SB(b, h) + boff + n * 2048 + k * 1024); } while (0)
#define G_MMA(ai, bj, At, Bt) do { __builtin_amdgcn_s_setprio(1); _Pragma("unroll") for (int m = 0; m < 4; ++m) _Pragma("unroll") for (int n = 0; n < 2; ++n) _Pragma("unroll") for (int k = 0; k < 2; ++k) \
        acc[ai][bj][m][n] = __builtin_amdgcn_mfma_f32_16x16x32_bf16(Bt[n][k], At[m][k], acc[ai][bj][m][n], 0, 0, 0); __builtin_amdgcn_s_setprio(0); } while (0)
#define G_WAIT_V(n) asm volatile("s_waitcnt vmcnt(" #n ")" ::: "memory")
#define G_WAIT_L(n) asm volatile("s_waitcnt lgkmcnt(" #n ")" ::: "memory")
#define G_BAR __builtin_amdgcn_s_barrier()
#define G_SCHED __builtin_amdgcn_sched_barrier(0)
    UInfo cur, nxt; int ui = 0;
    pb.unit(c, cur);
    AccT acc;
#pragma unroll
    for (int a = 0; a < 2; ++a)
#pragma unroll
        for (int b = 0; b < 2; ++b)
#pragma unroll
            for (int m = 0; m < 4; ++m)
#pragma unroll
                for (int n = 0; n < 2; ++n) acc[a][b][m][n] = (f32x4){0.f, 0.f, 0.f, 0.f};
    bf16x8 At[4][2], B0[2][2], B1[2][2];
    const char* cA = cur.a; const char* cB = cur.b;
    G_STAGE(G_SB(0, 0), cB + pb.bK(0), voffB); G_STAGE(G_SA(0, 0), cA + pb.aK(0), voffA); G_STAGE(G_SB(0, 1), cB + hsB + pb.bK(0), voffB); G_STAGE(G_SA(0, 1), cA + hsA + pb.aK(0), voffA);
    if (wr == 1) G_BAR;
    G_WAIT_V(4); G_BAR;
    G_STAGE(G_SB(1, 0), cB + pb.bK(1), voffB); G_STAGE(G_SA(1, 0), cA + pb.aK(1), voffA); G_STAGE(G_SB(1, 1), cB + hsB + pb.bK(1), voffB);
    G_WAIT_V(6); G_BAR;
    for (;;) {
        const long Ln = (long)(ui + 1) * G + c; const bool has_next = Ln < nun;
        if (has_next) pb.unit(Ln, nxt);
        const char* nA = has_next ? nxt.a : cA; const char* nB = has_next ? nxt.b : cB;
        for (int t = 0; t < nt; t += 2) {
            const bool last = (t == nt - 2);
            const char* a1 = cA + pb.aK(t + 1);
            const char* a2 = last ? nA + pb.aK(0) : cA + pb.aK(t + 2); const char* b2 = last ? nB + pb.bK(0) : cB + pb.bK(t + 2);
            const char* a3 = last ? nA + pb.aK(1) : cA + pb.aK(t + 3); const char* b3 = last ? nB + pb.bK(1) : cB + pb.bK(t + 3);
            G_LDB(B0, 0, 0); G_SCHED; G_LDA(At, 0, 0); G_STAGE(G_SA(1, 1), a1 + hsA, voffA);
            G_WAIT_L(8); G_BAR; G_WAIT_L(0); G_MMA(0, 0, At, B0); G_BAR; G_SCHED;
            G_LDB(B1, 0, 1); G_STAGE(G_SB(0, 0), b2, voffB);
            G_BAR; G_WAIT_L(0); G_MMA(0, 1, At, B1); G_BAR;
            G_LDA(At, 0, 1); G_STAGE(G_SA(0, 0), a2, voffA);
            G_BAR; G_WAIT_L(0); G_MMA(1, 0, At, B0); G_BAR; G_SCHED;
            G_STAGE(G_SB(0, 1), b2 + hsB, voffB);
            G_WAIT_V(6); G_BAR; G_MMA(1, 1, At, B1); G_BAR;
            G_LDB(B0, 1, 0); G_SCHED; G_LDA(At, 1, 0); G_STAGE(G_SA(0, 1), a2 + hsA, voffA);
            G_WAIT_L(8); G_BAR; G_WAIT_L(0); G_MMA(0, 0, At, B0); G_BAR; G_SCHED;
            G_LDB(B1, 1, 1); G_STAGE(G_SB(1, 0), b3, voffB);
            G_BAR; G_WAIT_L(0); G_MMA(0, 1, At, B1); G_BAR;
            G_LDA(At, 1, 1); G_STAGE(G_SA(1, 0), a3, voffA);
            G_BAR; G_WAIT_L(0); G_MMA(1, 0, At, B0); G_BAR; G_SCHED;
            G_STAGE(G_SB(1, 1), b3 + hsB, voffB);
            G_WAIT_V(6); G_BAR; G_MMA(1, 1, At, B1); G_BAR;
        }
        { const int l2 = ltid() & 63; pb.epi(acc, cur, wr, wc, l2 & 15, l2 >> 4); }
        if (!has_next) break;
#pragma unroll
        for (int a = 0; a < 2; ++a)
#pragma unroll
            for (int b = 0; b < 2; ++b)
#pragma unroll
                for (int m = 0; m < 4; ++m)
#pragma unroll
                    for (int n = 0; n < 2; ++n) acc[a][b][m][n] = (f32x4){0.f, 0.f, 0.f, 0.f};
        cur = nxt; cA = nA; cB = nB; ++ui;
    }
    G_WAIT_V(0);
    if (wr == 0) G_BAR;
    G_BAR;
}

#define EPI_ROWS for (int ai = 0; ai < 2; ++ai) for (int m = 0; m < 4; ++m)
#define EPI_COLS for (int bj = 0; bj < 2; ++bj) for (int n = 0; n < 2; ++n)
#define EPI_ROW (128 * ai + 64 * wr + 16 * m + fr)
#define EPI_COL (128 * bj + 32 * wc + 16 * n + 4 * fq)

template <class Epi> struct Prob2D {
    static constexpr bool PERM = Epi::PERM;
    const char* A; const char* B; unsigned lda, ldb; int nt, nM, nN; Epi e;
    __device__ __forceinline__ long nunits() const { return (long)nM * nN; }
    __device__ __forceinline__ unsigned rowA(int R) const { return (unsigned)R * lda; }
    __device__ __forceinline__ void unit(long L, UInfo& u) const { int pm, pn; tile_order((int)L, nM, nN, pm, pn); u.a = A + (size_t)pm * 256 * lda; u.b = B + (size_t)pn * 256 * ldb; u.r0 = pm * 256; u.c0 = pn * 256; u.x0 = 0; u.x1 = 0; }
    __device__ __forceinline__ size_t aK(int kt) const { return (size_t)kt * 128; }
    __device__ __forceinline__ size_t bK(int kt) const { return (size_t)kt * 128; }
    __device__ __forceinline__ void epi(const AccT& acc, const UInfo& u, int wr, int wc, int fr, int fq) const { e(acc, u, wr, wc, fr, fq); }
};
struct EpiStore { static constexpr bool PERM = true; bf16_t* O; size_t ldc;
    __device__ __forceinline__ void operator()(const AccT& acc, const UInfo& u, int wr, int wc, int fr, int fq) const {
#pragma unroll
        EPI_ROWS { bf16_t* rp = O + (size_t)(u.r0 + EPI_ROW) * ldc + u.c0;
#pragma unroll
            for (int bj = 0; bj < 2; ++bj) { const f32x4 v = acc[ai][bj][m][0], v2 = acc[ai][bj][m][1]; *(u32x4*)(rp + 128 * bj + 32 * wc + 8 * fq) = (u32x4){pk_bf16(v[0], v[1]), pk_bf16(v[2], v[3]), pk_bf16(v2[0], v2[1]), pk_bf16(v2[2], v2[3])}; } }
    } };
struct EpiRes { static constexpr bool PERM = false; const float* R; float* O; bf16_t* HB; float* ss;
    __device__ __forceinline__ void operator()(const AccT& acc, const UInfo& u, int wr, int wc, int fr, int fq) const {
#pragma unroll
        EPI_ROWS { const size_t ro = (size_t)(u.r0 + EPI_ROW) * 2048 + u.c0; float sq = 0.f;
#pragma unroll
            EPI_COLS { const f32x4 r = *(const f32x4*)(R + ro + EPI_COL); const f32x4 o = r + acc[ai][bj][m][n]; *(f32x4*)(O + ro + EPI_COL) = o;
                if (HB) { *(u32x2*)(HB + ro + EPI_COL) = (u32x2){pk_bf16(o[0], o[1]), pk_bf16(o[2], o[3])}; sq += o[0] * o[0] + o[1] * o[1] + o[2] * o[2] + o[3] * o[3]; } }
            if (HB) { const int lane = fq * 16 + fr; sq += shx(sq, 16, lane); sq += shx(sq, 32, lane); if (fq == 0) atomicAdd(ss + u.r0 + EPI_ROW, sq); } }
    } };
struct EpiStoreRS { static constexpr bool PERM = true; bf16_t* O; size_t ldc; const float* ss;
    __device__ __forceinline__ void operator()(const AccT& acc, const UInfo& u, int wr, int wc, int fr, int fq) const {
#pragma unroll
        EPI_ROWS { const int row = u.r0 + EPI_ROW; const float rs = rsqrtf(ss[row] * (1.0f / 2048.0f) + 1e-6f); bf16_t* rp = O + (size_t)row * ldc + u.c0;
#pragma unroll
            for (int bj = 0; bj < 2; ++bj) { const f32x4 v = acc[ai][bj][m][0] * rs, v2 = acc[ai][bj][m][1] * rs; *(u32x4*)(rp + 128 * bj + 32 * wc + 8 * fq) = (u32x4){pk_bf16(v[0], v[1]), pk_bf16(v[2], v[3]), pk_bf16(v2[0], v2[1]), pk_bf16(v2[2], v2[3])}; } }
    } };
struct EpiStoreCS { static constexpr bool PERM = true; bf16_t* O; size_t ldc; const float* ss;
    __device__ __forceinline__ void operator()(const AccT& acc, const UInfo& u, int wr, int wc, int fr, int fq) const {
        f32x4 rs[2][2];
#pragma unroll
        for (int bj = 0; bj < 2; ++bj)
#pragma unroll
            for (int n = 0; n < 2; ++n) { const f32x4 s4 = *(const f32x4*)(ss + u.c0 + 128 * bj + 32 * wc + 8 * fq + 4 * n);
#pragma unroll
                for (int j = 0; j < 4; ++j) rs[bj][n][j] = rsqrtf(s4[j] * (1.0f / 2048.0f) + 1e-6f); }
#pragma unroll
        EPI_ROWS { bf16_t* rp = O + (size_t)(u.r0 + EPI_ROW) * ldc + u.c0;
#pragma unroll
            for (int bj = 0; bj < 2; ++bj) { const f32x4 v = acc[ai][bj][m][0] * rs[bj][0], v2 = acc[ai][bj][m][1] * rs[bj][1]; *(u32x4*)(rp + 128 * bj + 32 * wc + 8 * fq) = (u32x4){pk_bf16(v[0], v[1]), pk_bf16(v[2], v[3]), pk_bf16(v2[0], v2[1]), pk_bf16(v2[2], v2[3])}; } }
    } };
struct EpiGate { static constexpr bool PERM = true; bf16_t* Y;
    __device__ __forceinline__ void operator()(const AccT& acc, const UInfo& u, int wr, int wc, int fr, int fq) const {
#pragma unroll
        EPI_ROWS { bf16_t* rp = Y + (size_t)(u.r0 + EPI_ROW) * 4096 + u.c0;
#pragma unroll
            for (int bj = 0; bj < 2; ++bj) { const f32x4 g = acc[ai][bj][m][0], h = acc[ai][bj][m][1]; bf16_t* cp = rp + 128 * bj + 32 * wc + 8 * fq; const u32x4 y = *(const u32x4*)cp;
                const float o0 = g[0] * sigmoidf_(g[0]) * bflo(y[0]), o1 = g[1] * sigmoidf_(g[1]) * bfhi(y[0]), o2 = g[2] * sigmoidf_(g[2]) * bflo(y[1]), o3 = g[3] * sigmoidf_(g[3]) * bfhi(y[1]);
                const float o4 = h[0] * sigmoidf_(h[0]) * bflo(y[2]), o5 = h[1] * sigmoidf_(h[1]) * bfhi(y[2]), o6 = h[2] * sigmoidf_(h[2]) * bflo(y[3]), o7 = h[3] * sigmoidf_(h[3]) * bfhi(y[3]);
                *(u32x4*)cp = (u32x4){pk_bf16(o0, o1), pk_bf16(o2, o3), pk_bf16(o4, o5), pk_bf16(o6, o7)}; } }
    } };
struct EpiQK { static constexpr bool PERM = false; bf16_t* Q; bf16_t* K; bf16_t* KTD; const float2* rope;
    __device__ __forceinline__ void operator()(const AccT& acc, const UInfo& u, int wr, int wc, int fr, int fq) const {
        const int hidx = u.c0 >> 8; const bool isk = hidx >= 8; const int hh = hidx & 7; const float l2g = log2gamma(hh);
        bf16_t* dst = (isk ? K : Q) + hh * 256; const float sc = isk ? 0.0625f : 1.0f;
#pragma unroll
        EPI_ROWS { const int t = u.r0 + EPI_ROW; const float kd = fexp2((float)(255 - (t & 255)) * l2g);
#pragma unroll
            for (int n = 0; n < 2; ++n) { const int dd = 32 * wc + 16 * n + 4 * fq;
                const f32x4 x1 = acc[ai][0][m][n], x2 = acc[ai][1][m][n]; const f32x4 cs0 = *(const f32x4*)(rope + (size_t)t * 128 + dd), cs1 = *(const f32x4*)(rope + (size_t)t * 128 + dd + 2);
                float y1[4], y2[4];
                y1[0] = (x1[0] * cs0[0] - x2[0] * cs0[1]) * sc; y2[0] = (x1[0] * cs0[1] + x2[0] * cs0[0]) * sc;
                y1[1] = (x1[1] * cs0[2] - x2[1] * cs0[3]) * sc; y2[1] = (x1[1] * cs0[3] + x2[1] * cs0[2]) * sc;
                y1[2] = (x1[2] * cs1[0] - x2[2] * cs1[1]) * sc; y2[2] = (x1[2] * cs1[1] + x2[2] * cs1[0]) * sc;
                y1[3] = (x1[3] * cs1[2] - x2[3] * cs1[3]) * sc; y2[3] = (x1[3] * cs1[3] + x2[3] * cs1[2]) * sc;
                *(u32x2*)(dst + (size_t)t * 2048 + dd) = (u32x2){pk_bf16(y1[0], y1[1]), pk_bf16(y1[2], y1[3])};
                *(u32x2*)(dst + (size_t)t * 2048 + 128 + dd) = (u32x2){pk_bf16(y2[0], y2[1]), pk_bf16(y2[2], y2[3])};
                if (isk) {
#pragma unroll
                    for (int j = 0; j < 4; ++j) { KTD[(size_t)(hh * 256 + dd + j) * S_ + t] = (bf16_t)(pk_bf16(y1[j] * kd, 0.f) & 0xffffu); KTD[(size_t)(hh * 256 + 128 + dd + j) * S_ + t] = (bf16_t)(pk_bf16(y2[j] * kd, 0.f) & 0xffffu); }
                } } }
    } };
struct EpiQproj { static constexpr bool PERM = false; bf16_t* QB; float* gates; const float* ss;
    __device__ __forceinline__ void operator()(const AccT& acc, const UInfo& u, int wr, int wc, int fr, int fq) const {
#pragma unroll
        EPI_ROWS { const int t = u.r0 + EPI_ROW; const float rs = rsqrtf(ss[t] * (1.0f / 2048.0f) + 1e-6f);
#pragma unroll
            EPI_COLS { const int col = u.c0 + EPI_COL; const f32x4 v = acc[ai][bj][m][n] * rs;
                if (col < 2048) *(u32x2*)(QB + (size_t)t * 2048 + col) = (u32x2){pk_bf16(v[0] * 0.08838834764831845f, v[1] * 0.08838834764831845f), pk_bf16(v[2] * 0.08838834764831845f, v[3] * 0.08838834764831845f)};
                else if (col < 2096) *(f32x4*)(gates + (size_t)t * 48 + (col - 2048)) = (f32x4){sigmoidf_(v[0]), sigmoidf_(v[1]), sigmoidf_(v[2]), sigmoidf_(v[3])}; } }
    } };
__device__ __forceinline__ float gelu_tanh(float x) { const float y = 0.7978845608028654f * (x + 0.044715f * x * x * x); const float e = fexp2(2.0f * 1.4426950408889634f * y); const float th = 1.0f - 2.0f * frcp(e + 1.0f); return 0.5f * x * (1.0f + th); }
struct EpiGelu { static constexpr bool PERM = false; bf16_t* H; const float* bias;
    __device__ __forceinline__ void operator()(const AccT& acc, const UInfo& u, int wr, int wc, int fr, int fq) const {
#pragma unroll
        EPI_ROWS { bf16_t* rp = H + (size_t)(u.r0 + EPI_ROW) * 256;
#pragma unroll
            EPI_COLS { const int col = EPI_COL; const f32x4 v = acc[ai][bj][m][n]; const f32x4 bb = *(const f32x4*)(bias + col);
                *(u32x2*)(rp + col) = (u32x2){pk_bf16(gelu_tanh(v[0] + bb[0]), gelu_tanh(v[1] + bb[1])), pk_bf16(gelu_tanh(v[2] + bb[2]), gelu_tanh(v[3] + bb[3]))}; } }
    } };
struct EpiKcmp { static constexpr bool PERM = false; bf16_t* KC;
    __device__ __forceinline__ void operator()(const AccT& acc, const UInfo& u, int wr, int wc, int fr, int fq) const {
#pragma unroll
        EPI_ROWS { const int r = u.r0 + EPI_ROW, i = r >> 2, h = r & 3;
#pragma unroll
            for (int n = 0; n < 2; ++n) { const int col = 32 * wc + 16 * n + 4 * fq; f32x4 v = acc[ai][0][m][n]; if (i == 1023) v = (f32x4){0.f, 0.f, 0.f, 0.f};
                *(u32x2*)(KC + ((size_t)h * 1024 + i) * 128 + col) = (u32x2){pk_bf16(v[0], v[1]), pk_bf16(v[2], v[3])}; } }
    } };
struct EpiVcmp { static constexpr bool PERM = false; bf16_t* VC;
    __device__ __forceinline__ void operator()(const AccT& acc, const UInfo& u, int wr, int wc, int fr, int fq) const {
#pragma unroll
        for (int m = 0; m < 4; ++m) { const int d = 64 * wr + 16 * m + fr;
#pragma unroll
            EPI_COLS { const int col = u.c0 + EPI_COL, i = col >> 2; f32x4 v = acc[0][bj][m][n]; if (i == 1023) v = (f32x4){0.f, 0.f, 0.f, 0.f};
#pragma unroll
                for (int h = 0; h < 4; ++h) VC[((size_t)h * 128 + d) * 1024 + i] = (bf16_t)(pk_bf16(v[h], 0.f) & 0xffffu); } }
    } };
struct ProbCmp1 {
    static constexpr bool PERM = false;
    const char* A; const char* B; unsigned ldb; int nt, nM; EpiGelu e;
    __device__ __forceinline__ long nunits() const { return nM; }
    __device__ __forceinline__ unsigned rowA(int R) const { return (unsigned)(R >> 2) * 65536u + (unsigned)(R & 3) * 256u; }
    __device__ __forceinline__ void unit(long L, UInfo& u) const { u.a = A + (size_t)L * 64 * 65536; u.b = B; u.r0 = (int)L * 256; u.c0 = 0; u.x0 = 0; u.x1 = 0; }
    __device__ __forceinline__ size_t aK(int kt) const { return (size_t)(kt >> 1) * 4096 + (size_t)(kt & 1) * 128; }
    __device__ __forceinline__ size_t bK(int kt) const { return (size_t)kt * 128; }
    __device__ __forceinline__ void epi(const AccT& acc, const UInfo& u, int wr, int wc, int fr, int fq) const { e(acc, u, wr, wc, fr, fq); }
};
struct ProbKV {
    static constexpr bool PERM = true;
    const char* VT; const char* KTD; bf16_t* ST; int nt;
    __device__ __forceinline__ long nunits() const { return 8 * 64 * 2; }
    __device__ __forceinline__ unsigned rowA(int R) const { return (unsigned)R * 32768u; }
    static constexpr unsigned ldb = 32768u;
    __device__ __forceinline__ void unit(long L, UInfo& u) const { const int pm = (int)L & 1, c = ((int)L >> 1) & 63, h = (int)L >> 7;
        u.a = VT + ((size_t)(h * 512 + pm * 256) * S_ + c * 256) * 2; u.b = KTD + ((size_t)(h * 256) * S_ + c * 256) * 2; u.r0 = h * 512 + pm * 256; u.c0 = c * 256; u.x0 = 0; u.x1 = 0; }
    __device__ __forceinline__ size_t aK(int kt) const { return (size_t)kt * 128; }
    __device__ __forceinline__ size_t bK(int kt) const { return (size_t)kt * 128; }
    __device__ __forceinline__ void epi(const AccT& acc, const UInfo& u, int wr, int wc, int fr, int fq) const { EpiStore e{ST, (size_t)S_}; e(acc, u, wr, wc, fr, fq); }
};
struct ProbS {
    static constexpr bool PERM = true;
    const char* Q; const char* K; bf16_t* SD; int nt;
    __device__ __forceinline__ long nunits() const { return 8 * 64; }
    __device__ __forceinline__ unsigned rowA(int R) const { return (unsigned)R * 4096u; }
    static constexpr unsigned ldb = 4096u;
    __device__ __forceinline__ void unit(long L, UInfo& u) const { const int c = (int)L & 63, h = (int)L >> 6; const size_t o = ((size_t)(c * 256) * 2048 + h * 256) * 2;
        u.a = Q + o; u.b = K + o; u.r0 = c * 256; u.c0 = h * 256; u.x0 = h; u.x1 = 0; }
    __device__ __forceinline__ size_t aK(int kt) const { return (size_t)kt * 128; }
    __device__ __forceinline__ size_t bK(int kt) const { return (size_t)kt * 128; }
    __device__ __forceinline__ void epi(const AccT& acc, const UInfo& u, int wr, int wc, int fr, int fq) const {
        const float l2g = log2gamma(u.x0);
#pragma unroll
        EPI_ROWS { const int i = EPI_ROW; bf16_t* rp = SD + (size_t)(u.r0 + i) * 2048 + u.c0;
#pragma unroll
            for (int bj = 0; bj < 2; ++bj) { const int s = 128 * bj + 32 * wc + 8 * fq; const f32x4 v = acc[ai][bj][m][0], v2 = acc[ai][bj][m][1]; float o[8];
#pragma unroll
                for (int j = 0; j < 4; ++j) { o[j] = (s + j <= i) ? v[j] * fexp2(-(float)(s + j + 1) * l2g) : 0.f; o[4 + j] = (s + 4 + j <= i) ? v2[j] * fexp2(-(float)(s + 4 + j + 1) * l2g) : 0.f; }
                *(u32x4*)(rp + s) = (u32x4){pk_bf16(o[0], o[1]), pk_bf16(o[2], o[3]), pk_bf16(o[4], o[5]), pk_bf16(o[6], o[7])}; } }
    }
};
struct ProbOut {
    static constexpr bool PERM = true;
    const char* Q; const char* ST; long dA, dB; bf16_t* Y; int nt;
    __device__ __forceinline__ long nunits() const { return 8 * 64 * 2; }
    __device__ __forceinline__ unsigned rowA(int R) const { return (unsigned)R * 4096u; }
    static constexpr unsigned ldb = 32768u;
    __device__ __forceinline__ void unit(long L, UInfo& u) const { const int pn = (int)L & 1, c = ((int)L >> 1) & 63, h = (int)L >> 7;
        u.a = Q + ((size_t)(c * 256) * 2048 + h * 256) * 2; u.b = ST + ((size_t)(h * 512 + pn * 256) * S_ + c * 256) * 2; u.r0 = c * 256; u.c0 = h * 512 + pn * 256; u.x0 = h; u.x1 = 0; }
    __device__ __forceinline__ size_t aK(int kt) const { return kt < 4 ? (size_t)kt * 128 : (size_t)(dA + (long)(kt - 4) * 128); }
    __device__ __forceinline__ size_t bK(int kt) const { return kt < 4 ? (size_t)kt * 128 : (size_t)(dB + (long)(kt - 4) * 128); }
    __device__ __forceinline__ void epi(const AccT& acc, const UInfo& u, int wr, int wc, int fr, int fq) const {
        const float l2g = log2gamma(u.x0);
#pragma unroll
        EPI_ROWS { const int i = EPI_ROW; const float qd = fexp2((float)(i + 1) * l2g); bf16_t* rp = Y + (size_t)(u.r0 + i) * 4096 + u.c0;
#pragma unroll
            for (int bj = 0; bj < 2; ++bj) { const f32x4 v = acc[ai][bj][m][0] * qd, v2 = acc[ai][bj][m][1] * qd; *(u32x4*)(rp + 128 * bj + 32 * wc + 8 * fq) = (u32x4){pk_bf16(v[0], v[1]), pk_bf16(v[2], v[3]), pk_bf16(v2[0], v2[1]), pk_bf16(v2[2], v2[3])}; } }
    }
};

__device__ __forceinline__ void transpose_job(const float* __restrict__ src, bf16_t* __restrict__ dst, int K, int N, int Npad, int kvperm, LAS float* tile, const float* gain = nullptr) {
    const int tk = K / 64, tn = Npad / 256, ntile = tk * tn; const int tid = ltid();
    for (int t = blockIdx.x; t < ntile; t += gridDim.x) {
        const int k0 = (t % tk) * 64, n0 = (t / tk) * 256;
        { const int r0 = tid >> 6, cc = tid & 63; float v[8][4];
#pragma unroll
          for (int i = 0; i < 8; ++i)
#pragma unroll
              for (int q = 0; q < 4; ++q) { const int n = n0 + cc + 64 * q; v[i][q] = (n < N) ? src[(size_t)(k0 + r0 + 8 * i) * N + n] : 0.f; }
#pragma unroll
          for (int i = 0; i < 8; ++i) { const float gk = gain ? gain[k0 + r0 + 8 * i] : 1.0f;
#pragma unroll
              for (int q = 0; q < 4; ++q) tile[(r0 + 8 * i) * 257 + cc + 64 * q] = v[i][q] * gk; } }
        __syncthreads();
        { const int rr = tid >> 1, c0 = (tid & 1) * 32;
          int n = n0 + rr; if (kvperm) { const int j = n >> 9; const int jp = (j == 3) ? 4 : ((j == 4) ? 3 : j); n = jp * 512 + (n & 511); }
          bf16_t* dp = dst + (size_t)n * K + k0 + c0;
#pragma unroll
          for (int g = 0; g < 4; ++g) { float x[8];
#pragma unroll
              for (int j = 0; j < 8; ++j) x[j] = tile[(c0 + 8 * g + j) * 257 + rr];
              *(u32x4*)(dp + 8 * g) = (u32x4){pk_bf16(x[0], x[1]), pk_bf16(x[2], x[3]), pk_bf16(x[4], x[5]), pk_bf16(x[6], x[7])}; } }
        __syncthreads();
    }
}
__device__ __forceinline__ void prep_phase(CP p, LAS unsigned char* lds) {
    LAS float* tile = (LAS float*)lds; unsigned char* ws = p->ws;
    transpose_job(p->ret_w_in, (bf16_t*)(ws + OFF_W_RIN), 2048, 12288, 12288, 0, tile);
    transpose_job(p->ret_w_out, (bf16_t*)(ws + OFF_W_ROUT), 4096, 2048, 2048, 0, tile);
    transpose_job(p->w_kv, (bf16_t*)(ws + OFF_W_KV), 2048, 3072, 3072, 1, tile, p->kv_gain);
    transpose_job(p->w1_k, (bf16_t*)(ws + OFF_W_C1K), 4096, 256, 256, 0, tile);
    transpose_job(p->w1_v, (bf16_t*)(ws + OFF_W_C1V), 4096, 256, 256, 0, tile);
    transpose_job(p->w2_k, (bf16_t*)(ws + OFF_W_C2K), 256, 128, 256, 0, tile);
    transpose_job(p->w2_v, (bf16_t*)(ws + OFF_W_C2V), 256, 128, 256, 0, tile);
    transpose_job(p->w_q, (bf16_t*)(ws + OFF_W_Q), 2048, 2096, 2304, 0, tile, p->norm_mix + 2048);
    transpose_job(p->w_o, (bf16_t*)(ws + OFF_W_O), 2048, 2048, 2048, 0, tile);
    transpose_job(p->ffn_w_in, (bf16_t*)(ws + OFF_W_FIN), 2048, 8192, 8192, 0, tile, p->norm_ffn);
    transpose_job(p->ffn_w_in + (size_t)2048 * 8192, (bf16_t*)(ws + OFF_W_FIN + 32 * MiB), 2048, 8192, 8192, 0, tile, p->norm_ffn + 2048);
    transpose_job(p->ffn_w_out, (bf16_t*)(ws + OFF_W_FOUT), 4096, 2048, 2048, 0, tile);
    transpose_job(p->ffn_w_out + (size_t)4096 * 2048, (bf16_t*)(ws + OFF_W_FOUT + 16 * MiB), 4096, 2048, 2048, 0, tile);
    { float* ss = (float*)(ws + OFF_SS); for (int i = blockIdx.x * 512 + ltid(); i < 8 * S_; i += gridDim.x * 512) ss[i] = 0.f; }
    { float2* rope = (float2*)(ws + OFF_ROPE); const int gsz = gridDim.x * 512;
      for (int i = blockIdx.x * 512 + ltid(); i < S_ * 128; i += gsz) { const int t = i >> 7, dd = i & 127;
          const float freq = exp2f(-(float)dd * (13.287712379549449f / 128.0f)); const double rev = (double)t * (double)freq * 0.15915494309189535;
          const float fx = (float)(rev - rint(rev)); rope[i] = make_float2(__builtin_amdgcn_cosf(fx), __builtin_amdgcn_sinf(fx)); } }
    if (blockIdx.x < 128) { const int kv = blockIdx.x >> 6, oc = blockIdx.x & 63; const float* pe = kv ? p->pe_v : p->pe_k; const float* w1 = kv ? p->w1_v : p->w1_k; float* peb = (float*)(ws + OFF_PEB) + kv * 256;
        const int tid = ltid(), g = tid >> 7, r = tid & 127, n = 4 * oc + g; float s = 0.f;
#pragma unroll 8
        for (int j = 0; j < 32; ++j) { const int k = r + 128 * j; s += pe[k] * w1[(size_t)k * 256 + n]; }
        s = wave_sum(s, tid & 63);
        __syncthreads(); if ((tid & 63) == 0) tile[tid >> 6] = s; __syncthreads();
        if (tid < 4) peb[4 * oc + tid] = tile[2 * tid] + tile[2 * tid + 1];
        __syncthreads(); }
}
__device__ __forceinline__ void rmsnorm_phase(const float* h, const float* g1, bf16_t* o1, const float* g2, bf16_t* o2) {
    const int w = ltid() >> 6, lane = ltid() & 63;
    for (int row = blockIdx.x * 8 + w; row < S_; row += gridDim.x * 8) {
        const f32x4* p = (const f32x4*)(h + (size_t)row * 2048); f32x4 v[8]; float ss = 0.f;
#pragma unroll
        for (int i = 0; i < 8; ++i) { v[i] = p[lane + 64 * i]; ss += v[i][0] * v[i][0] + v[i][1] * v[i][1] + v[i][2] * v[i][2] + v[i][3] * v[i][3]; }
        ss = wave_sum(ss, lane); const float r = rsqrtf(ss * (1.0f / 2048.0f) + 1e-6f);
#pragma unroll
        for (int i = 0; i < 8; ++i) { const int col = (lane + 64 * i) * 4; const f32x4 g = *(const f32x4*)(g1 + col);
            *(u32x2*)(o1 + (size_t)row * 2048 + col) = (u32x2){pk_bf16(v[i][0] * r * g[0], v[i][1] * r * g[1]), pk_bf16(v[i][2] * r * g[2], v[i][3] * r * g[3])};
            if (o2) { const f32x4 gg = *(const f32x4*)(g2 + col);
                *(u32x2*)(o2 + (size_t)row * 2048 + col) = (u32x2){pk_bf16(v[i][0] * r * gg[0], v[i][1] * r * gg[1]), pk_bf16(v[i][2] * r * gg[2], v[i][3] * r * gg[3])}; } }
    }
}
__device__ __forceinline__ void finalnorm_phase(float* h, const float* g1) {
    const int w = ltid() >> 6, lane = ltid() & 63;
    for (int row = blockIdx.x * 8 + w; row < S_; row += gridDim.x * 8) {
        f32x4* p = (f32x4*)(h + (size_t)row * 2048); f32x4 v[8]; float ss = 0.f;
#pragma unroll
        for (int i = 0; i < 8; ++i) { v[i] = p[lane + 64 * i]; ss += v[i][0] * v[i][0] + v[i][1] * v[i][1] + v[i][2] * v[i][2] + v[i][3] * v[i][3]; }
        ss = wave_sum(ss, lane); const float r = rsqrtf(ss * (1.0f / 2048.0f) + 1e-6f);
#pragma unroll
        for (int i = 0; i < 8; ++i) { const f32x4 g = *(const f32x4*)(g1 + (lane + 64 * i) * 4); p[lane + 64 * i] = v[i] * r * g; }
    }
}
__device__ __forceinline__ void scan_phase(bf16_t* ST) {
    for (int it = blockIdx.x * 512 + ltid(); it < 4096 * 32; it += gridDim.x * 512) {
        const int r = it >> 5, d8 = it & 31; const float cd = fexp2(256.0f * log2gamma(r >> 9));
        bf16_t* p = ST + (size_t)r * S_ + d8 * 8; float s[8];
#pragma unroll
        for (int j = 0; j < 8; ++j) s[j] = 0.f;
        for (int c = 0; c < 64; ++c) { const u32x4 v = *(const u32x4*)(p + c * 256);
            *(u32x4*)(p + c * 256) = (u32x4){pk_bf16(s[0], s[1]), pk_bf16(s[2], s[3]), pk_bf16(s[4], s[5]), pk_bf16(s[6], s[7])};
#pragma unroll
            for (int j = 0; j < 4; ++j) { s[2 * j] = s[2 * j] * cd + bflo(v[j]); s[2 * j + 1] = s[2 * j + 1] * cd + bfhi(v[j]); } }
    }
}
__device__ __forceinline__ void gn_phase(bf16_t* Y, const float* gain) {
    const int w = ltid() >> 6, lane = ltid() & 63;
    for (int g = blockIdx.x * 8 + w; g < S_ * 8; g += gridDim.x * 8) {
        bf16_t* p = Y + (size_t)g * 512 + lane * 8; const u32x4 v = *(const u32x4*)p; float x[8];
#pragma unroll
        for (int j = 0; j < 4; ++j) { x[2 * j] = bflo(v[j]); x[2 * j + 1] = bfhi(v[j]); }
        float s = 0.f;
#pragma unroll
        for (int j = 0; j < 8; ++j) s += x[j];
        const float mu = wave_sum(s, lane) * (1.0f / 512.0f); float q = 0.f;
#pragma unroll
        for (int j = 0; j < 8; ++j) { x[j] -= mu; q += x[j] * x[j]; }
        const float r = rsqrtf(wave_sum(q, lane) * (1.0f / 512.0f) + 1e-6f); const float* gp = gain + (g & 7) * 512 + lane * 8;
        const f32x4 g0 = *(const f32x4*)gp, g1 = *(const f32x4*)(gp + 4);
        *(u32x4*)p = (u32x4){pk_bf16(x[0] * r * g0[0], x[1] * r * g0[1]), pk_bf16(x[2] * r * g0[2], x[3] * r * g0[3]), pk_bf16(x[4] * r * g1[0], x[5] * r * g1[1]), pk_bf16(x[6] * r * g1[2], x[7] * r * g1[3])};
    }
}
__device__ __forceinline__ void conv_phase(const bf16_t* U, bf16_t* AB, const float* cw, const float* cb) {
    for (int it = blockIdx.x * 512 + ltid(); it < 512 * 512; it += gridDim.x * 512) {
        const int n8 = (it & 511) * 8, t0 = (it >> 9) * 32;
        float wa[3][8], wb[3][8], ba[8], bb[8];
#pragma unroll
        for (int tp = 0; tp < 3; ++tp)
#pragma unroll
            for (int j = 0; j < 8; ++j) { wa[tp][j] = cw[tp * 8192 + n8 + j]; wb[tp][j] = cw[tp * 8192 + 4096 + n8 + j]; }
#pragma unroll
        for (int j = 0; j < 8; ++j) { ba[j] = cb[n8 + j]; bb[j] = cb[4096 + n8 + j]; }
        float pa[2][8], pb[2][8];
#pragma unroll
        for (int k = 0; k < 2; ++k) { const int t = t0 - 2 + k; u32x4 va = (u32x4){0, 0, 0, 0}, vb = (u32x4){0, 0, 0, 0};
            if (t >= 0) { va = *(const u32x4*)(U + (size_t)t * 8192 + n8); vb = *(const u32x4*)(U + (size_t)t * 8192 + 4096 + n8); }
#pragma unroll
            for (int j = 0; j < 4; ++j) { pa[k][2 * j] = bflo(va[j]); pa[k][2 * j + 1] = bfhi(va[j]); pb[k][2 * j] = bflo(vb[j]); pb[k][2 * j + 1] = bfhi(vb[j]); } }
#pragma unroll 8
        for (int k = 0; k < 32; ++k) { const int t = t0 + k; const u32x4 va = *(const u32x4*)(U + (size_t)t * 8192 + n8), vb = *(const u32x4*)(U + (size_t)t * 8192 + 4096 + n8);
            float xa[8], xb[8], o[8];
#pragma unroll
            for (int j = 0; j < 4; ++j) { xa[2 * j] = bflo(va[j]); xa[2 * j + 1] = bfhi(va[j]); xb[2 * j] = bflo(vb[j]); xb[2 * j + 1] = bfhi(vb[j]); }
#pragma unroll
            for (int j = 0; j < 8; ++j) { const float a = ba[j] + wa[0][j] * pa[0][j] + wa[1][j] * pa[1][j] + wa[2][j] * xa[j]; const float b = bb[j] + wb[0][j] * pb[0][j] + wb[1][j] * pb[1][j] + wb[2][j] * xb[j];
                o[j] = a * sigmoidf_(a) * b; pa[0][j] = pa[1][j]; pa[1][j] = xa[j]; pb[0][j] = pb[1][j]; pb[1][j] = xb[j]; }
            *(u32x4*)(AB + (size_t)t * 4096 + n8) = (u32x4){pk_bf16(o[0], o[1]), pk_bf16(o[2], o[3]), pk_bf16(o[4], o[5]), pk_bf16(o[6], o[7])}; }
    }
}

constexpr int A_KT = 0, A_VT = 17408, A_BUFSZ = 34816, A_PSL = 69632, A_SEL = 69632 + 65536, LDS_ST = 139264;
constexpr float LOG2E = 1.4426950408889634f;
struct AttnState { f32x4 ot[8][2]; float m[2], l[2]; };

template <int MODE>
__device__ __forceinline__ void attn_compute(LAS unsigned char* lds, int boff, int tile, const bf16x8 (&qf)[2][4], AttnState& st, const int (&tpos)[2], int qb, int w, int lane,
                                             const float (&mfin)[2], const float (&linv)[2], bool rs0, bool rs1, bool masked, bool a0, bool a1) {
    const int l16 = lane & 15, g4 = lane >> 4;
    f32x4 s[4][2];
#pragma unroll
    for (int mt = 0; mt < 4; ++mt) { s[mt][0] = (f32x4){0.f, 0.f, 0.f, 0.f}; s[mt][1] = (f32x4){0.f, 0.f, 0.f, 0.f}; }
#pragma unroll
    for (int ks = 0; ks < 4; ++ks) {
        bf16x8 kf[4];
#pragma unroll
        for (int mt = 0; mt < 4; ++mt) kf[mt] = *(const LAS bf16x8*)(lds + boff + A_KT + (16 * mt + l16) * 272 + ks * 64 + g4 * 16);
        if (a0) {
#pragma unroll
            for (int mt = 0; mt < 4; ++mt) s[mt][0] = __builtin_amdgcn_mfma_f32_16x16x32_bf16(kf[mt], qf[0][ks], s[mt][0], 0, 0, 0);
        }
        if (a1) {
#pragma unroll
            for (int mt = 0; mt < 4; ++mt) s[mt][1] = __builtin_amdgcn_mfma_f32_16x16x32_bf16(kf[mt], qf[1][ks], s[mt][1], 0, 0, 0);
        }
        if (ks & 1) __builtin_amdgcn_sched_barrier(0);
    }
    if (masked) {
#pragma unroll
        for (int nt = 0; nt < 2; ++nt) { const int t = tpos[nt]; const int tl = w * 8 + nt * 4 + (l16 >> 2);
#pragma unroll
            for (int mt = 0; mt < 4; ++mt)
#pragma unroll
                for (int j = 0; j < 4; ++j) { const int kl = 16 * mt + 4 * g4 + j; const int key = tile * 64 + kl; bool v;
                    if (MODE == 0 || MODE == 1) v = key <= ((t - 31) >> 4);
                    else if (MODE == 2) v = (kl <= tl);
                    else v = (key <= t) && (key > t - 512);
                    s[mt][nt][j] = v ? s[mt][nt][j] : -__builtin_inff(); } }
    }
    bf16x8 pf[2][2];
#pragma unroll
    for (int nt = 0; nt < 2; ++nt) {
        if (nt ? a1 : a0) {
            const bool rowsel = nt ? rs1 : rs0;
            const float bias = (MODE == 2 && !rowsel) ? -__builtin_inff() : 0.f;
            float mx = -1e30f;
#pragma unroll
            for (int mt = 0; mt < 4; ++mt)
#pragma unroll
                for (int j = 0; j < 4; ++j) {
                    const float sv = s[mt][nt][j] * LOG2E + bias;
                    s[mt][nt][j] = sv; mx = fmaxf(mx, sv); }
            float mnew, alpha = 1.f;
            if (MODE == 1) mnew = mfin[nt];
            else { mx = fmaxf(mx, shx(mx, 16, lane)); mx = fmaxf(mx, shx(mx, 32, lane)); mnew = fmaxf(st.m[nt], mx); alpha = fexp2(st.m[nt] - mnew); st.m[nt] = mnew; }
            float ps = 0.f;
#pragma unroll
            for (int mt = 0; mt < 4; ++mt)
#pragma unroll
                for (int j = 0; j < 4; ++j) { float pv = fexp2(s[mt][nt][j] - mnew); if (MODE == 1) pv *= linv[nt]; s[mt][nt][j] = pv; ps += pv; }
            if (MODE != 1) st.l[nt] = st.l[nt] * alpha + ps;
            if (MODE == 2 || MODE == 3) {
#pragma unroll
                for (int md = 0; md < 8; ++md) st.ot[md][nt] = st.ot[md][nt] * alpha;
            }
            if (MODE == 1) {
#pragma unroll
                for (int mt = 0; mt < 4; ++mt) { float a = s[mt][nt][0] + s[mt][nt][1] + s[mt][nt][2] + s[mt][nt][3], lst = s[mt][nt][3];
                    a += shx(a, 1, lane); a += shx(a, 2, lane); lst += shx(lst, 1, lane); lst += shx(lst, 2, lane);
                    if ((l16 & 3) == 0) { const int jb = tile * 16 + 4 * mt + g4; LAS float* pp = (LAS float*)(lds + A_PSL) + (w * 8 + nt * 4 + (l16 >> 2)) * 256;
                        atomicAdd((float*)(pp + jb), a); if (jb + 1 < 256) atomicAdd((float*)(pp + jb + 1), lst); } }
            }
            if (MODE != 0) {
#pragma unroll
                for (int kk = 0; kk < 2; ++kk) { const u32x4 pk = (u32x4){pk_bf16(s[2 * kk][nt][0], s[2 * kk][nt][1]), pk_bf16(s[2 * kk][nt][2], s[2 * kk][nt][3]), pk_bf16(s[2 * kk + 1][nt][0], s[2 * kk + 1][nt][1]), pk_bf16(s[2 * kk + 1][nt][2], s[2 * kk + 1][nt][3])};
                    pf[nt][kk] = __builtin_bit_cast(bf16x8, pk); }
            }
        } else { pf[nt][0] = (bf16x8){0, 0, 0, 0, 0, 0, 0, 0}; pf[nt][1] = (bf16x8){0, 0, 0, 0, 0, 0, 0, 0}; }
    }
    if (MODE != 0) {
#pragma unroll
        for (int kk = 0; kk < 2; ++kk)
#pragma unroll
            for (int mg = 0; mg < 2; ++mg) {
                bf16x8 vf[4];
#pragma unroll
                for (int q = 0; q < 4; ++q) { const LAS unsigned char* vb = lds + boff + A_VT + (16 * (4 * mg + q) + l16) * 136 + kk * 64 + g4 * 8;
                    const u32x2 v0 = *(const LAS u32x2*)vb, v1 = *(const LAS u32x2*)(vb + 32); vf[q] = __builtin_bit_cast(bf16x8, ((u32x4){v0[0], v0[1], v1[0], v1[1]})); }
                if (a0) {
#pragma unroll
                    for (int q = 0; q < 4; ++q) st.ot[4 * mg + q][0] = __builtin_amdgcn_mfma_f32_16x16x32_bf16(vf[q], pf[0][kk], st.ot[4 * mg + q][0], 0, 0, 0);
                }
                if (a1) {
#pragma unroll
                    for (int q = 0; q < 4; ++q) st.ot[4 * mg + q][1] = __builtin_amdgcn_mfma_f32_16x16x32_bf16(vf[q], pf[1][kk], st.ot[4 * mg + q][1], 0, 0, 0);
                }
                if (mg == 1) __builtin_amdgcn_sched_barrier(0);
            }
    }
}
template <int MODE>
__device__ __forceinline__ void attn_tiles(LAS unsigned char* lds, const bf16_t* kp, size_t kstride, const bf16_t* vp, size_t vstride, int tile_lo, int tile_hi,
                                           const bf16x8 (&qf)[2][4], AttnState& st, const int (&tpos)[2], int qb, int w, int lane, const float (&mfin)[2], const float (&linv)[2]) {
    if (tile_lo >= tile_hi) return;
    int tid = w * 64 + lane; asm volatile("" : "+v"(tid)); const int l16 = lane & 15;
    const int krow = tid >> 3, kc = (tid & 7) * 16, vrow = tid >> 2, vc = (tid & 3) * 16;
    u32x4 kr0, kr1, vr0 = (u32x4){0, 0, 0, 0}, vr1 = (u32x4){0, 0, 0, 0};
#define A_LOAD(T) do { const bf16_t* kg = kp + (size_t)((T) * 64 + krow) * kstride + kc; kr0 = *(const u32x4*)kg; kr1 = *(const u32x4*)(kg + 8); \
        if (MODE != 0) { const bf16_t* vg = vp + (size_t)vrow * vstride + (T) * 64 + vc; vr0 = *(const u32x4*)vg; vr1 = *(const u32x4*)(vg + 8); } } while (0)
#define A_WRITE(BO) do { LAS unsigned char* kd = lds + (BO) + A_KT + krow * 272 + kc * 2; *(LAS u32x4*)kd = kr0; *(LAS u32x4*)(kd + 16) = kr1; \
        if (MODE != 0) { LAS unsigned char* vd = lds + (BO) + A_VT + vrow * 136 + vc * 2; *(LAS u32x2*)vd = (u32x2){vr0[0], vr0[1]}; *(LAS u32x2*)(vd + 8) = (u32x2){vr0[2], vr0[3]}; *(LAS u32x2*)(vd + 16) = (u32x2){vr1[0], vr1[1]}; *(LAS u32x2*)(vd + 24) = (u32x2){vr1[2], vr1[3]}; } } while (0)
    A_LOAD(tile_lo);
    __syncthreads();
    A_WRITE(0);
    if (tile_lo + 1 < tile_hi) A_LOAD(tile_lo + 1);
    __syncthreads();
    unsigned selw0 = 0u, selw1 = 0u;
    for (int tile = tile_lo; tile < tile_hi; ++tile) {
        const int boff = ((tile - tile_lo) & 1) * A_BUFSZ;
        if (MODE == 2 && (tile == tile_lo || (tile & 31) == 0)) { const int tw = tile >> 5;
            selw0 = *(const LAS unsigned*)(lds + A_SEL + ((w * 8 + (l16 >> 2)) * 8 + tw) * 4); selw1 = *(const LAS unsigned*)(lds + A_SEL + ((w * 8 + 4 + (l16 >> 2)) * 8 + tw) * 4); }
        if (tile + 1 < tile_hi) { A_WRITE(boff ^ A_BUFSZ); if (tile + 2 < tile_hi) A_LOAD(tile + 2); }
        bool rs0 = true, rs1 = true, active = true;
        if (MODE == 2) { const unsigned bit = 1u << (tile & 31);
            rs0 = (selw0 & bit) != 0u; rs1 = (selw1 & bit) != 0u; active = __ballot(rs0 || rs1) != 0ull; }
        if (active) {
            bool masked;
            if (MODE == 0 || MODE == 1) masked = (tile * 64 + 63 > 4 * qb - 2);
            else if (MODE == 2) masked = (tile == qb);
            else masked = (tile == qb) || (tile <= qb - 8);
            const bool a0 = (MODE != 2) || (__ballot(rs0) != 0ull), a1 = (MODE != 2) || (__ballot(rs1) != 0ull);
            attn_compute<MODE>(lds, boff, tile, qf, st, tpos, qb, w, lane, mfin, linv, rs0, rs1, masked, a0, a1);
        }
        __syncthreads();
    }
#undef A_LOAD
#undef A_WRITE
}
template <int BR>
__device__ __forceinline__ void attn_finish(AttnState& st, const float* gates, float* oacc, bf16_t* att, const int (&tpos)[2], int hkv, int lane) {
    const int l16 = lane & 15, g4 = lane >> 4, g = l16 & 3;
#pragma unroll
    for (int nt = 0; nt < 2; ++nt) {
        const int t = tpos[nt]; float sc = gates[(size_t)t * 48 + (hkv * 4 + g) * 3 + BR];
        if (BR != 0) { float l = st.l[nt]; l += shx(l, 16, lane); l += shx(l, 32, lane); sc = (l > 0.f) ? sc / l : 0.f; }
        const size_t base = (size_t)t * 2048 + (hkv * 4 + g) * 128 + 4 * g4;
#pragma unroll
        for (int md = 0; md < 8; ++md) { f32x4 v = st.ot[md][nt] * sc; float* op = oacc + base + 16 * md;
            if (BR == 0) *(f32x4*)op = v;
            else if (BR == 1) *(f32x4*)op = *(const f32x4*)op + v;
            else { v = v + *(const f32x4*)op; *(u32x2*)(att + base + 16 * md) = (u32x2){pk_bf16(v[0], v[1]), pk_bf16(v[2], v[3])}; } }
    }
}
__device__ __forceinline__ void attn_reset(AttnState& st) {
#pragma unroll
    for (int md = 0; md < 8; ++md) { st.ot[md][0] = (f32x4){0.f, 0.f, 0.f, 0.f}; st.ot[md][1] = (f32x4){0.f, 0.f, 0.f, 0.f}; }
    st.m[0] = st.m[1] = -1e30f; st.l[0] = st.l[1] = 0.f;
}
__device__ __forceinline__ void attn_item(unsigned char* ws, LAS unsigned char* lds, int hkv, int qb) {
    int tid = ltid(); asm volatile("" : "+v"(tid)); const int w = tid >> 6, lane = tid & 63, l16 = lane & 15, g4 = lane >> 4;
    const bf16_t* QB = (const bf16_t*)(ws + OFF_QB); const bf16_t* KVTOK = (const bf16_t*)(ws + OFF_KVTOK); const bf16_t* KVT = (const bf16_t*)(ws + OFF_KVT);
    const bf16_t* KC = (const bf16_t*)(ws + OFF_KCMP); const bf16_t* VC = (const bf16_t*)(ws + OFF_VCMPT);
    const float* gates = (const float*)(ws + OFF_GATES); float* oacc = (float*)(ws + OFF_OACC); bf16_t* att = (bf16_t*)(ws + OFF_ATT);
    int tpos[2]; bf16x8 qf[2][4];
#pragma unroll
    for (int nt = 0; nt < 2; ++nt) { tpos[nt] = qb * 64 + w * 8 + nt * 4 + (l16 >> 2); const bf16_t* qp = QB + (size_t)tpos[nt] * 2048 + (hkv * 4 + (l16 & 3)) * 128 + g4 * 8;
#pragma unroll
        for (int ks = 0; ks < 4; ++ks) qf[nt][ks] = *(const bf16x8*)(qp + ks * 32); }
    __syncthreads();
    { LAS float* pp = (LAS float*)(lds + A_PSL) + w * 2048;
#pragma unroll
      for (int i = 0; i < 32; ++i) pp[lane + 64 * i] = 0.f; }
    AttnState st; float mfin[2] = {0.f, 0.f}, linv[2] = {0.f, 0.f};
    const int ncmp_tiles = (4 * qb + 3 + 63) >> 6;
    attn_reset(st);
    attn_tiles<0>(lds, KC + (size_t)hkv * 1024 * 128, 128, VC, 1024, 0, ncmp_tiles, qf, st, tpos, qb, w, lane, mfin, linv);
#pragma unroll
    for (int nt = 0; nt < 2; ++nt) { float l = st.l[nt]; l += shx(l, 16, lane); l += shx(l, 32, lane); mfin[nt] = st.m[nt]; linv[nt] = (l > 0.f) ? 1.0f / l : 0.f; }
    attn_reset(st);
    attn_tiles<1>(lds, KC + (size_t)hkv * 1024 * 128, 128, VC + (size_t)hkv * 128 * 1024, 1024, 0, ncmp_tiles, qf, st, tpos, qb, w, lane, mfin, linv);
    attn_finish<0>(st, gates, oacc, att, tpos, hkv, lane);
    __syncthreads();
    {
        LAS unsigned* sel = (LAS unsigned*)(lds + A_SEL) + w * 64;
        if (qb < 16) {
            if (lane < 8) { for (int tk = 0; tk < 8; ++tk) { const int lo = lane * 32; unsigned wd = 0; if (qb >= lo + 31) wd = 0xffffffffu; else if (qb >= lo) wd = (2u << (qb - lo)) - 1u; sel[tk * 8 + lane] = wd; } }
        } else {
            for (int tk = 0; tk < 8; ++tk) {
                const LAS float* pp = (const LAS float*)(lds + A_PSL) + (w * 8 + tk) * 256;
                unsigned key[4]; bool forced[4];
#pragma unroll
                for (int i = 0; i < 4; ++i) { const int j = lane + 64 * i; const float sc = pp[j]; const bool elig = (j >= 1) && (j <= qb - 2);
                    forced[i] = (j == 0) || (j == qb) || (j == qb - 1); key[i] = elig ? (__float_as_uint(sc) + 1u) : 0u; }
                unsigned prefix = 0u;
                for (int bit = 30; bit >= 0; --bit) { const unsigned cand = prefix | (1u << bit); int cnt = 0;
#pragma unroll
                    for (int i = 0; i < 4; ++i) cnt += __popcll(__ballot(key[i] >= cand));
                    if (cnt >= 13) prefix = cand; }
                int cgt = 0;
#pragma unroll
                for (int i = 0; i < 4; ++i) cgt += __popcll(__ballot(key[i] > prefix));
                const int need = 13 - cgt; int base = 0;
#pragma unroll
                for (int i = 0; i < 4; ++i) { const unsigned long long eqm = __ballot(key[i] == prefix);
                    const int rank = base + (int)__builtin_amdgcn_mbcnt_hi((unsigned)(eqm >> 32), __builtin_amdgcn_mbcnt_lo((unsigned)eqm, 0u));
                    const bool taken = forced[i] || (key[i] > prefix) || (key[i] == prefix && rank < need);
                    const unsigned long long bal = __ballot(taken); if (lane == 0) { sel[tk * 8 + 2 * i] = (unsigned)bal; sel[tk * 8 + 2 * i + 1] = (unsigned)(bal >> 32); }
                    base += __popcll(eqm); }
            }
        }
    }
    __syncthreads();
    attn_reset(st);
    attn_tiles<2>(lds, KVTOK + 2 * 512 + hkv * 128, 2048, KVT + (size_t)(hkv * 128) * S_, S_, 0, qb + 1, qf, st, tpos, qb, w, lane, mfin, linv);
    attn_finish<1>(st, gates, oacc, att, tpos, hkv, lane);
    attn_reset(st);
    attn_tiles<3>(lds, KVTOK + 3 * 512 + hkv * 128, 2048, KVT + (size_t)(512 + hkv * 128) * S_, S_, (qb - 8) > 0 ? (qb - 8) : 0, qb + 1, qf, st, tpos, qb, w, lane, mfin, linv);
    attn_finish<2>(st, gates, oacc, att, tpos, hkv, lane);
}
__device__ __forceinline__ void attn_phase(unsigned char* ws, LAS unsigned char* lds) {
#pragma nounroll
    for (int it = blockIdx.x; it < 1024; it += gridDim.x) {
        const int c = it & 255, r = it >> 8;
        attn_item(ws, lds, r, (r & 1) ? 255 - c : c);
    }
}


#define XB_TMO      128
#define XB_XCNT(j)  (256  + 64 * (j))
#define XB_XSUB(j)  (1280 + 64 * (j))
#define XB_XGEN(j)  (2304 + 64 * (j))
#define XB_TOP      3328
#define XB_TOPGEN   3392
#define XCD_BAR_WORDS 3456
#define XB_SPIN_CAP (1u << 22)
__device__ __forceinline__ unsigned xb_ld(unsigned* p)              { return __hip_atomic_load(p, __ATOMIC_RELAXED, __HIP_MEMORY_SCOPE_AGENT); }
__device__ __forceinline__ unsigned xb_add(unsigned* p, unsigned v) { return __hip_atomic_fetch_add(p, v, __ATOMIC_RELAXED, __HIP_MEMORY_SCOPE_AGENT); }
__device__ __forceinline__ unsigned xb_xcc_id() { return (unsigned)__builtin_amdgcn_s_getreg((3 << 11) | 20) & 0xFu; }
#define XB_SPIN(cond, bar) do { unsigned _sp = 0; while (cond) { __builtin_amdgcn_s_sleep(1); \
    if ((++_sp & 255u) == 0u) { if (xb_ld(&(bar)[XB_TMO])) break; if (_sp > XB_SPIN_CAP) { atomicAdd(&(bar)[XB_TMO], 1u); break; } } } } while (0)
struct XcdBarrier { unsigned* bar; unsigned x; volatile LAS unsigned* st; };
__device__ __forceinline__ XcdBarrier xcd_barrier_post(unsigned* bar, volatile LAS unsigned* st) {
    XcdBarrier b; b.bar = bar; b.x = xb_xcc_id(); b.st = st;
    if (threadIdx.x == 0) (void)xb_add(&bar[XB_XCNT(b.x)], 1u);
    return b;
}
__device__ __forceinline__ void xcd_barrier_complete(unsigned* bar, unsigned x, unsigned& nloc, unsigned& nx) {
    const unsigned G = gridDim.x * gridDim.y * gridDim.z;
    unsigned sum, cnt, mine, sp = 0u;
    for (;;) {
        sum = 0u; cnt = 0u; mine = 0u;
#pragma unroll
        for (unsigned j = 0; j < 16; ++j) { const unsigned c = xb_ld(&bar[XB_XCNT(j)]); sum += c; cnt += (c > 0u) ? 1u : 0u; mine = (j == x) ? c : mine; }
        if (sum == G) break;
        __builtin_amdgcn_s_sleep(1);
        if ((++sp & 255u) == 0u) { if (xb_ld(&bar[XB_TMO])) break; if (sp > XB_SPIN_CAP) { atomicAdd(&bar[XB_TMO], 1u); break; } }
    }
    nloc = mine > 0u ? mine : 1u; nx = cnt > 0u ? cnt : 1u;
}
__device__ __forceinline__ void xcd_barrier(const XcdBarrier& b) {
    asm volatile("s_waitcnt vmcnt(0)" ::: "memory");
    __syncthreads();
    if (threadIdx.x == 0) {
        unsigned* bar = b.bar;
        __builtin_amdgcn_s_waitcnt(0);
        unsigned nloc = b.st[0], nx = b.st[1];
        if (nloc == 0u) { xcd_barrier_complete(bar, b.x, nloc, nx); b.st[0] = nloc; b.st[1] = nx; }
        const unsigned old = xb_add(&bar[XB_XSUB(b.x)], 1u);
        const unsigned gen = old / nloc;
        if (old + 1u == (gen + 1u) * nloc) {
            __builtin_amdgcn_fence(__ATOMIC_RELEASE, "agent");
            asm volatile("s_waitcnt vmcnt(0)" ::: "memory");
            const unsigned og = xb_add(&bar[XB_TOP], 1u);
            const unsigned tg = og / nx;
            if (og + 1u == (tg + 1u) * nx) xb_add(&bar[XB_TOPGEN], 1u);
            else XB_SPIN(xb_ld(&bar[XB_TOPGEN]) == tg, bar);
            __builtin_amdgcn_fence(__ATOMIC_ACQUIRE, "agent");
            xb_add(&bar[XB_XGEN(b.x)], 1u);
            asm volatile("s_waitcnt vmcnt(0)" ::: "memory");
        } else {
            XB_SPIN(xb_ld(&bar[XB_XGEN(b.x)]) == gen, bar);
            __builtin_amdgcn_fence(__ATOMIC_ACQUIRE, "agent");
            asm volatile("s_waitcnt vmcnt(0)" ::: "memory");
        }
    }
    __syncthreads();
}

constexpr int NPH = 23;
__device__ __forceinline__ void run_phase(CP p, int ph, int b, LAS unsigned char* lds) {
    asm volatile("" : "+s"(p));
    unsigned char* ws = p->ws;
    const float* xb = p->x + (size_t)b * S_ * D_; float* hb = p->out + (size_t)b * S_ * D_;
    bf16_t* XN = (bf16_t*)(ws + OFF_XN);
    const int layer = (ph >= 13) ? 1 : 0;
    switch (ph) {
    case 0: prep_phase(p, lds); break;
    case 1: rmsnorm_phase(xb, p->norm_mix, XN, nullptr, nullptr); break;
    case 2: {
        Prob2D<EpiQK> g1{(const char*)XN, (const char*)(ws + OFF_W_RIN), 4096u, 4096u, 32, 64, 16, EpiQK{(bf16_t*)(ws + OFF_Q), (bf16_t*)(ws + OFF_K), (bf16_t*)(ws + OFF_KTD), (const float2*)(ws + OFF_ROPE)}};
        gemm_phase(lds, g1);
        Prob2D<EpiStore> g2{(const char*)(ws + OFF_W_RIN) + (size_t)4096 * 4096, (const char*)XN, 4096u, 4096u, 32, 16, 64, EpiStore{(bf16_t*)(ws + OFF_VT), (size_t)S_}};
        gemm_phase(lds, g2);
    } break;
    case 3: {
        ProbKV g3{(const char*)(ws + OFF_VT), (const char*)(ws + OFF_KTD), (bf16_t*)(ws + OFF_ST), 4};
        gemm_phase(lds, g3);
        ProbS g4{(const char*)(ws + OFF_Q), (const char*)(ws + OFF_K), (bf16_t*)(ws + OFF_SD), 4};
        gemm_phase(lds, g4);
    } break;
    case 4: scan_phase((bf16_t*)(ws + OFF_ST)); break;
    case 5: {
        ProbOut g5{(const char*)(ws + OFF_Q), (const char*)(ws + OFF_ST), (long)OFF_SD - (long)OFF_Q, (long)OFF_VT - (long)OFF_ST, (bf16_t*)(ws + OFF_Y), 8};
        gemm_phase(lds, g5);
    } break;
    case 6: gn_phase((bf16_t*)(ws + OFF_Y), p->ret_gn); break;
    case 7: {
        Prob2D<EpiGate> g6{(const char*)XN, (const char*)(ws + OFF_W_RIN) + (size_t)8192 * 4096, 4096u, 4096u, 32, 64, 16, EpiGate{(bf16_t*)(ws + OFF_Y)}};
        gemm_phase(lds, g6);
    } break;
    case 8: {
        Prob2D<EpiRes> g7{(const char*)(ws + OFF_Y), (const char*)(ws + OFF_W_ROUT), 8192u, 8192u, 64, 64, 8, EpiRes{xb, hb, XN, (float*)(ws + OFF_SS) + (size_t)(b * 4 + 0) * S_}};
        gemm_phase(lds, g7);
    } break;
    case 10: case 20: {
        Prob2D<EpiStoreRS> g8{(const char*)XN, (const char*)(ws + OFF_W_FIN + (size_t)layer * 32 * MiB), 4096u, 4096u, 32, 64, 32, EpiStoreRS{(bf16_t*)(ws + OFF_U), (size_t)8192, (const float*)(ws + OFF_SS) + (size_t)(b * 4 + (layer ? 2 : 0)) * S_}};
        gemm_phase(lds, g8);
    } break;
    case 11: case 21: conv_phase((const bf16_t*)(ws + OFF_U), (bf16_t*)(ws + OFF_AB), p->ffn_conv_w + (size_t)layer * 3 * 8192, p->ffn_conv_b + (size_t)layer * 8192); break;
    case 12: case 22: {
        Prob2D<EpiRes> g9{(const char*)(ws + OFF_AB), (const char*)(ws + OFF_W_FOUT + (size_t)layer * 16 * MiB), 8192u, 8192u, 64, 64, 8, EpiRes{hb, hb, layer ? (bf16_t*)nullptr : XN, layer ? (float*)nullptr : (float*)(ws + OFF_SS) + (size_t)(b * 4 + 1) * S_}};
        gemm_phase(lds, g9);
    } break;
    case 14: {
        const float* ss1 = (const float*)(ws + OFF_SS) + (size_t)(b * 4 + 1) * S_;
        Prob2D<EpiStoreRS> g10{(const char*)XN, (const char*)(ws + OFF_W_KV), 4096u, 4096u, 32, 64, 8, EpiStoreRS{(bf16_t*)(ws + OFF_KVTOK), (size_t)2048, ss1}};
        gemm_phase(lds, g10);
        Prob2D<EpiStoreCS> g11{(const char*)(ws + OFF_W_KV) + (size_t)2048 * 4096, (const char*)XN, 4096u, 4096u, 32, 4, 64, EpiStoreCS{(bf16_t*)(ws + OFF_KVT), (size_t)S_, ss1}};
        gemm_phase(lds, g11);
    } break;
    case 15: {
        ProbCmp1 a{(const char*)(ws + OFF_KVTOK), (const char*)(ws + OFF_W_C1K), 8192u, 64, 16, EpiGelu{(bf16_t*)(ws + OFF_H1), (const float*)(ws + OFF_PEB)}};
        gemm_phase(lds, a, (int)gridDim.x - 32);
        ProbCmp1 v{(const char*)(ws + OFF_KVTOK) + 1024, (const char*)(ws + OFF_W_C1V), 8192u, 64, 16, EpiGelu{(bf16_t*)(ws + OFF_H1) + 4096 * 256, (const float*)(ws + OFF_PEB) + 256}};
        gemm_phase(lds, v, (int)gridDim.x - 16);
        Prob2D<EpiQproj> g12{(const char*)XN, (const char*)(ws + OFF_W_Q), 4096u, 4096u, 32, 64, 9, EpiQproj{(bf16_t*)(ws + OFF_QB), (float*)(ws + OFF_GATES), (const float*)(ws + OFF_SS) + (size_t)(b * 4 + 1) * S_}};
        gemm_phase(lds, g12);
    } break;
    case 16: {
        Prob2D<EpiKcmp> a{(const char*)(ws + OFF_H1), (const char*)(ws + OFF_W_C2K), 512u, 512u, 4, 16, 1, EpiKcmp{(bf16_t*)(ws + OFF_KCMP)}};
        gemm_phase(lds, a);
        Prob2D<EpiVcmp> v{(const char*)(ws + OFF_W_C2V), (const char*)(ws + OFF_H1) + (size_t)4096 * 256 * 2, 512u, 512u, 4, 1, 16, EpiVcmp{(bf16_t*)(ws + OFF_VCMPT)}};
        gemm_phase(lds, v);
    } break;
    case 17: attn_phase(ws, lds); break;
    case 18: {
        Prob2D<EpiRes> g{(const char*)(ws + OFF_ATT), (const char*)(ws + OFF_W_O), 4096u, 4096u, 32, 64, 8, EpiRes{hb, hb, XN, (float*)(ws + OFF_SS) + (size_t)(b * 4 + 2) * S_}};
        gemm_phase(lds, g);
    } break;
    case 23: finalnorm_phase(hb, p->final_gain); break;
    default: break;
    }
}

#if MULTI
__global__ void __launch_bounds__(512) phase_kernel(Params p, int ph, int b) {
    extern __shared__ __attribute__((aligned(16))) unsigned char shm[];
    run_phase((CP)__builtin_amdgcn_kernarg_segment_ptr(), ph, b, (LAS unsigned char*)shm);
}
#else
__global__ void __launch_bounds__(512) mega_kernel(Params p) {
    extern __shared__ __attribute__((aligned(16))) unsigned char shm[];
    cg::grid_group grid = cg::this_grid();
    CP cp = (CP)__builtin_amdgcn_kernarg_segment_ptr();
    volatile LAS unsigned* st = (volatile LAS unsigned*)((LAS unsigned char*)shm + LDS_ST);
    if (threadIdx.x == 0) { st[0] = 0u; st[1] = 0u; st[2] = 0u; st[3] = 0u; }
    __syncthreads();
    XcdBarrier xb = xcd_barrier_post((unsigned*)(cp->ws + OFF_BAR), st);
    run_phase(cp, 0, 0, (LAS unsigned char*)shm);
    grid.sync();
    for (int b = 0; b < 2; ++b)
        for (int ph = 1; ph <= NPH; ++ph) {
            if (ph == 9 || ph == 13 || ph == 19) continue;
#ifdef PROBE_PH
            const int reps = (ph == PROBE_PH || ph == PROBE_PH2) ? 2 : 1;
#else
            const int reps = 1;
#endif
            for (int rep = 0; rep < reps; ++rep) { run_phase(cp, ph, b, (LAS unsigned char*)shm); xcd_barrier(xb); } }
}
#endif

constexpr int LDS_BYTES = LDS_ST + 16;
extern "C" void kernel_launch(void* const* d_in, const int* in_sizes, int n_in, void* d_out, int out_size, void* d_ws, size_t ws_size, hipStream_t stream) {
    static int grid = 0;
    if (grid == 0) {
        if (n_in != 21 || out_size != 2 * S_ * D_ || ws_size < WS_NEED) { fprintf(stderr, "kernel_launch: unexpected shapes/ws (n_in %d out %d ws %zu need %zu)\n", n_in, out_size, ws_size, (size_t)WS_NEED); grid = -1; return; }
#if MULTI
        if (hipFuncSetAttribute((const void*)phase_kernel, hipFuncAttributeMaxDynamicSharedMemorySize, LDS_BYTES) != hipSuccess) { fprintf(stderr, "hipFuncSetAttribute failed\n"); grid = -1; return; }
#else
        if (hipFuncSetAttribute((const void*)mega_kernel, hipFuncAttributeMaxDynamicSharedMemorySize, LDS_BYTES) != hipSuccess) { fprintf(stderr, "hipFuncSetAttribute failed\n"); grid = -1; return; }
#endif
        int dev = 0, cus = 0; hipGetDevice(&dev); hipDeviceGetAttribute(&cus, hipDeviceAttributeMultiprocessorCount, dev);
        grid = cus > 0 ? cus : 256;
    }
    if (grid < 0) return;
    Params p{};
    const float** pp = (const float**)&p;
    for (int i = 0; i < 21; ++i) pp[i] = (const float*)d_in[i];
    p.out = (float*)d_out; p.ws = (unsigned char*)d_ws;
#if MULTI
    hipLaunchKernelGGL(phase_kernel, dim3(grid), dim3(512), LDS_BYTES, stream, p, 0, 0);
    for (int b = 0; b < 2; ++b)
        for (int ph = 1; ph <= NPH; ++ph) hipLaunchKernelGGL(phase_kernel, dim3(grid), dim3(512), LDS_BYTES, stream, p, ph, b);
#else
    if (hipMemsetAsync((unsigned char*)d_ws + OFF_BAR, 0, XCD_BAR_WORDS * 4, stream) != hipSuccess) { fprintf(stderr, "memset failed\n"); return; }
    void* args[] = {&p};
    hipError_t e = hipLaunchCooperativeKernel((const void*)mega_kernel, dim3(grid), dim3(512), args, LDS_BYTES, stream);
    if (e != hipSuccess) fprintf(stderr, "cooperative launch failed: %s (grid %d)\n", hipGetErrorString(e), grid);
#endif
}
```

```cpp
#include <hip/hip_runtime.h>
#include <hip/hip_cooperative_groups.h>
#include <cstdio>
namespace cg = cooperative_groups;

#ifndef MULTI
#define MULTI 0
#endif

#define LAS __attribute__((address_space(3)))
typedef unsigned short bf16_t;
typedef short bf16x8 __attribute__((ext_vector_type(8)));
typedef float f32x4 __attribute__((ext_vector_type(4)));
typedef unsigned u32x2 __attribute__((ext_vector_type(2)));
typedef unsigned u32x4 __attribute__((ext_vector_type(4)));

constexpr int S_ = 16384, D_ = 2048;
constexpr size_t MiB = 1048576;
constexpr size_t OFF_W_RIN = 0, OFF_W_ROUT = 48 * MiB, OFF_W_KV = 64 * MiB, OFF_W_C1K = 76 * MiB, OFF_W_C1V = 78 * MiB,
                 OFF_W_C2K = 80 * MiB, OFF_W_C2V = 80 * MiB + 131072, OFF_W_Q = 81 * MiB, OFF_W_O = 90 * MiB,
                 OFF_W_FIN = 98 * MiB  , OFF_W_FOUT = 162 * MiB  , OFF_ROPE = 194 * MiB, OFF_PEB = 210 * MiB, OFF_BAR = 210 * MiB + 65536, OFF_SS = 210 * MiB + 131072  ,
                 OFF_XN = 211 * MiB, OFF_ACT = 275 * MiB;
constexpr size_t OFF_Q = OFF_ACT, OFF_K = OFF_ACT + 64 * MiB, OFF_KTD = OFF_ACT + 128 * MiB, OFF_VT = OFF_ACT + 192 * MiB,
                 OFF_ST = OFF_ACT + 320 * MiB, OFF_SD = OFF_ACT + 448 * MiB, OFF_Y = OFF_ACT + 512 * MiB, WS_NEED = OFF_ACT + 640 * MiB;
constexpr size_t OFF_U = OFF_ACT, OFF_AB = OFF_ACT + 256 * MiB;
constexpr size_t OFF_HN = OFF_ACT, OFF_KVTOK = OFF_ACT + 64 * MiB, OFF_KVT = OFF_ACT + 129 * MiB, OFF_QB = OFF_ACT + 161 * MiB,
                 OFF_GATES = OFF_ACT + 225 * MiB, OFF_H1 = OFF_ACT + 229 * MiB, OFF_KCMP = OFF_ACT + 233 * MiB, OFF_VCMPT = OFF_ACT + 234 * MiB,
                 OFF_ATT = OFF_ACT + 235 * MiB, OFF_OACC = OFF_ACT + 299 * MiB;

struct Params {
    const float* x; const float* norm_mix; const float* norm_ffn; const float* ret_w_in; const float* ret_gn; const float* ret_w_out;
    const float* kv_gain; const float* w_kv; const float* pe_k; const float* w1_k; const float* w2_k; const float* pe_v; const float* w1_v;
    const float* w2_v; const float* w_q; const float* w_o; const float* ffn_w_in; const float* ffn_conv_w; const float* ffn_conv_b;
    const float* ffn_w_out; const float* final_gain; float* out; unsigned char* ws;
};

typedef const __attribute__((address_space(4))) Params* CP;
__device__ __forceinline__ int ltid() { int t = threadIdx.x; asm volatile("" : "+v"(t)); return t; }
__device__ __forceinline__ unsigned pk_bf16(float lo, float hi) { unsigned r; asm("v_cvt_pk_bf16_f32 %0, %1, %2" : "=v"(r) : "v"(lo), "v"(hi)); return r; }
__device__ __forceinline__ float bflo(unsigned v) { return __uint_as_float(v << 16); }
__device__ __forceinline__ float bfhi(unsigned v) { return __uint_as_float(v & 0xffff0000u); }
__device__ __forceinline__ float fexp2(float x) { return __builtin_amdgcn_exp2f(x); }
__device__ __forceinline__ float frcp(float x) { return __builtin_amdgcn_rcpf(x); }
__device__ __forceinline__ float log2gamma(int h) { return log2f(1.0f - exp2f(-5.0f - (float)h)); }
__device__ __forceinline__ float sigmoidf_(float x) { return frcp(1.0f + fexp2(-1.4426950408889634f * x)); }

__device__ __forceinline__ float shx(float v, int m, int lane) { return __int_as_float(__builtin_amdgcn_ds_bpermute((lane ^ m) << 2, __float_as_int(v))); }
__device__ __forceinline__ unsigned long long shx64(unsigned long long v, int m, int lane) {
    const unsigned lo = (unsigned)__builtin_amdgcn_ds_bpermute((lane ^ m) << 2, (int)(unsigned)v), hi = (unsigned)__builtin_amdgcn_ds_bpermute((lane ^ m) << 2, (int)(unsigned)(v >> 32));
    return ((unsigned long long)hi << 32) | lo; }
__device__ __forceinline__ float wave_sum(float v, int lane) {
#pragma unroll
    for (int o = 32; o >= 1; o >>= 1) v += shx(v, o, lane);
    return v;
}
constexpr int HTB = 128 * 64 * 2;
__device__ __forceinline__ int lds_byte(int r, int c) { const int st = (r >> 4) * 2 + (c >> 5), rr = r & 15, cc = c & 31, ob = rr * 64 + cc * 2; return st * 1024 + (ob ^ (((ob >> 9) & 1) << 5)); }
__device__ __forceinline__ void stage_rc(int b, int& R, int& C) { const int st = b / 1024, sb = b % 1024, swz = sb ^ (((sb >> 9) & 1) << 5); R = (st >> 1) * 16 + swz / 64; C = (st & 1) * 32 + (swz % 64) / 2; }
__device__ __forceinline__ void tile_order(int L, int nM, int nN, int& pm, int& pn) {
    const int nwg = nM * nN; int wgid = L;
    { const int q = nwg / 8, r = nwg % 8, xcd = wgid % 8, off = wgid / 8; wgid = (xcd < r ? xcd * (q + 1) : r * (q + 1) + (xcd - r) * q) + off; }
    const int nig = 8 * nN, gid = wgid / nig, fm = gid * 8, gsz = (nM - fm) < 8 ? (nM - fm) : 8;
    pm = fm + ((wgid % nig) % gsz); pn = (wgid % nig) / gsz;
}
struct UInfo { const char* a; const char* b; int r0, c0, x0, x1; };
typedef f32x4 AccT[2][2][4][2];

template <class P>
__device__ __forceinline__ void gemm_phase(LAS unsigned char* lds, const P& pb, int cofs = 0) {
    const int tid = ltid(), wid = __builtin_amdgcn_readfirstlane(tid >> 6), lane = tid & 63, wr = wid >> 2, wc = wid & 3, fr = lane & 15, fq = lane >> 4;
    const int nt = pb.nt, G = gridDim.x, c = (int)blockIdx.x - cofs; const long nun = pb.nunits();
    if (c < 0 || c >= nun) return;
    unsigned voffA[2], voffB[2];
#pragma unroll
    for (int i = 0; i < 2; ++i) { int R, C; stage_rc(tid * 16 + i * 8192, R, C); voffA[i] = pb.rowA(R) + (unsigned)C * 2u; const int rho = R & 31; const int Rb = P::PERM ? ((R & ~31) + 8 * ((rho & 15) >> 2) + 4 * (rho >> 4) + (rho & 3)) : R; voffB[i] = (unsigned)Rb * pb.ldb + (unsigned)C * 2u; }
    const size_t hsA = pb.rowA(128), hsB = (size_t)128 * pb.ldb;
    const unsigned ldsw = (unsigned)wid * 1024u;
    const int aoff = lds_byte(wr * 64 + fr, fq * 8), boff = lds_byte(wc * 32 + fr, fq * 8);
#define G_SA(b, h) (((b) * 2 + (h)) * HTB)
#define G_SB(b, h) ((4 + (b) * 2 + (h)) * HTB)
#define G_STAGE(bufoff, gbase, voff) do { _Pragma("unroll") for (int _i = 0; _i < 2; ++_i) \
        __builtin_amdgcn_global_load_lds((const unsigned*)((const char*)(gbase) + (voff)[_i]), (LAS unsigned*)(lds + (bufoff) + ldsw + _i * 8192), 16, 0, 0); } while (0)
#define G_LDA(dst, b, h) do { _Pragma("unroll") for (int m = 0; m < 4; ++m) _Pragma("unroll") for (int k = 0; k < 2; ++k) dst[m][k] = *(const LAS bf16x8*)(lds + G_SA(b, h) + aoff + m * 2048 + k * 1024); } while (0)
#define G_LDB(dst, b, h) do { _Pragma("unroll") for (int n = 0; n < 2; ++n) _Pragma("unroll") for (int k = 0; k < 2; ++k) dst[n][k] = *(const LAS bf16x8*)(lds + G_SB(b, h) + boff + n * 2048 + k * 1024); } while (0)
#define G_MMA(ai, bj, At, Bt) do { __builtin_amdgcn_s_setprio(1); _Pragma("unroll") for (int m = 0; m < 4; ++m) _Pragma("unroll") for (int n = 0; n < 2; ++n) _Pragma("unroll") for (int k = 0; k < 2; ++k) \
        acc[ai][bj][m][n] = __builtin_amdgcn_mfma_f32_16x16x32_bf16(Bt[n][k], At[m][k], acc[ai][bj][m][n], 0, 0, 0); __builtin_amdgcn_s_setprio(0); } while (0)
#define G_WAIT_V(n) asm volatile("s_waitcnt vmcnt(" #n ")" ::: "memory")
#define G_WAIT_L(n) asm volatile("s_waitcnt lgkmcnt(" #n ")" ::: "memory")
#define G_BAR __builtin_amdgcn_s_barrier()
#define G_SCHED __builtin_amdgcn_sched_barrier(0)
    UInfo cur, nxt; int ui = 0;
    pb.unit(c, cur);
    AccT acc;
#pragma unroll
    for (int a = 0; a < 2; ++a)
#pragma unroll
        for (int b = 0; b < 2; ++b)
#pragma unroll
            for (int m = 0; m < 4; ++m)
#pragma unroll
                for (int n = 0; n < 2; ++n) acc[a][b][m][n] = (f32x4){0.f, 0.f, 0.f, 0.f};
    bf16x8 At[4][2], B0[2][2], B1[2][2];
    const char* cA = cur.a; const char* cB = cur.b;
    G_STAGE(G_SB(0, 0), cB + pb.bK(0), voffB); G_STAGE(G_SA(0, 0), cA + pb.aK(0), voffA); G_STAGE(G_SB(0, 1), cB + hsB + pb.bK(0), voffB); G_STAGE(G_SA(0, 1), cA + hsA + pb.aK(0), voffA);
    if (wr == 1) G_BAR;
    G_WAIT_V(4); G_BAR;
    G_STAGE(G_SB(1, 0), cB + pb.bK(1), voffB); G_STAGE(G_SA(1, 0), cA + pb.aK(1), voffA); G_STAGE(G_SB(1, 1), cB + hsB + pb.bK(1), voffB);
    G_WAIT_V(6); G_BAR;
    for (;;) {
        const long Ln = (long)(ui + 1) * G + c; const bool has_next = Ln < nun;
        if (has_next) pb.unit(Ln, nxt);
        const char* nA = has_next ? nxt.a : cA; const char* nB = has_next ? nxt.b : cB;
        for (int t = 0; t < nt; t += 2) {
            const bool last = (t == nt - 2);
            const char* a1 = cA + pb.aK(t + 1);
            const char* a2 = last ? nA + pb.aK(0) : cA + pb.aK(t + 2); const char* b2 = last ? nB + pb.bK(0) : cB + pb.bK(t + 2);
            const char* a3 = last ? nA + pb.aK(1) : cA + pb.aK(t + 3); const char* b3 = last ? nB + pb.bK(1) : cB + pb.bK(t + 3);
            G_LDB(B0, 0, 0); G_SCHED; G_LDA(At, 0, 0); G_STAGE(G_SA(1, 1), a1 + hsA, voffA);
            G_WAIT_L(8); G_BAR; G_WAIT_L(0); G_MMA(0, 0, At, B0); G_BAR; G_SCHED;
            G_LDB(B1, 0, 1); G_STAGE(G_SB(0, 0), b2, voffB);
            G_BAR; G_WAIT_L(0); G_MMA(0, 1, At, B1); G_BAR;
            G_LDA(At, 0, 1); G_STAGE(G_SA(0, 0), a2, voffA);
            G_BAR; G_WAIT_L(0); G_MMA(1, 0, At, B0); G_BAR; G_SCHED;
            G_STAGE(G_SB(0, 1), b2 + hsB, voffB);
            G_WAIT_V(6); G_BAR; G_MMA(1, 1, At, B1); G_BAR;
            G_LDB(B0, 1, 0); G_SCHED; G_LDA(At, 1, 0); G_STAGE(G_SA(0, 1), a2 + hsA, voffA);
            G_WAIT_L(8); G_BAR; G_WAIT_L(0); G_MMA(0, 0, At, B0); G_BAR; G_SCHED;
            G_LDB(B1, 1, 1); G_STAGE(G_SB(1, 0), b3, voffB);
            G_BAR; G_WAIT_L(0); G_MMA(0, 1, At, B1); G_BAR;
            G_LDA(At, 1, 1); G_STAGE(G_SA(1, 0), a3, voffA);
            G_BAR; G_WAIT_L(0); G_MMA(1, 0, At, B0); G_BAR; G_SCHED;
            G_STAGE(G_SB(1, 1), b3 + hsB, voffB);
            G_WAIT_V(6); G_BAR; G_MMA(1, 1, At, B1); G_BAR;
        }
        { const int l2 = ltid() & 63; pb.epi(acc, cur, wr, wc, l2 & 15, l2 >> 4); }
        if (!has_next) break;
#pragma unroll
        for (int a = 0; a < 2; ++a)
#pragma unroll
            for (int b = 0; b < 2; ++b)
#pragma unroll
                for (int m = 0; m < 4; ++m)
#pragma unroll
                    for (int n = 0; n < 2; ++n) acc[a][b][m][n] = (f32x4){0.f, 0.f, 0.f, 0.f};
        cur = nxt; cA = nA; cB = nB; ++ui;
    }
    G_WAIT_V(0);
    if (wr == 0) G_BAR;
    G_BAR;
}

#define EPI_ROWS for (int ai = 0; ai < 2; ++ai) for (int m = 0; m < 4; ++m)
#define EPI_COLS for (int bj = 0; bj < 2; ++bj) for (int n = 0; n < 2; ++n)
#define EPI_ROW (128 * ai + 64 * wr + 16 * m + fr)
#define EPI_COL (128 * bj + 32 * wc + 16 * n + 4 * fq)

template <class Epi> struct Prob2D {
    static constexpr bool PERM = Epi::PERM;
    const char* A; const char* B; unsigned lda, ldb; int nt, nM, nN; Epi e;
    __device__ __forceinline__ long nunits() const { return (long)nM * nN; }
    __device__ __forceinline__ unsigned rowA(int R) const { return (unsigned)R * lda; }
    __device__ __forceinline__ void unit(long L, UInfo& u) const { int pm, pn; tile_order((int)L, nM, nN, pm, pn); u.a = A + (size_t)pm * 256 * lda; u.b = B + (size_t)pn * 256 * ldb; u.r0 = pm * 256; u.c0 = pn * 256; u.x0 = 0; u.x1 = 0; }
    __device__ __forceinline__ size_t aK(int kt) const { return (size_t)kt * 128; }
    __device__ __forceinline__ size_t bK(int kt) const { return (size_t)kt * 128; }
    __device__ __forceinline__ void epi(const AccT& acc, const UInfo& u, int wr, int wc, int fr, int fq) const { e(acc, u, wr, wc, fr, fq); }
};
struct EpiStore { static constexpr bool PERM = true; bf16_t* O; size_t ldc;
    __device__ __forceinline__ void operator()(const AccT& acc, const UInfo& u, int wr, int wc, int fr, int fq) const {
#pragma unroll
        EPI_ROWS { bf16_t* rp = O + (size_t)(u.r0 + EPI_ROW) * ldc + u.c0;
#pragma unroll
            for (int bj = 0; bj < 2; ++bj) { const f32x4 v = acc[ai][bj][m][0], v2 = acc[ai][bj][m][1]; *(u32x4*)(rp + 128 * bj + 32 * wc + 8 * fq) = (u32x4){pk_bf16(v[0], v[1]), pk_bf16(v[2], v[3]), pk_bf16(v2[0], v2[1]), pk_bf16(v2[2], v2[3])}; } }
    } };
struct EpiRes { static constexpr bool PERM = false; const float* R; float* O; bf16_t* HB; float* ss;
    __device__ __forceinline__ void operator()(const AccT& acc, const UInfo& u, int wr, int wc, int fr, int fq) const {
#pragma unroll
        EPI_ROWS { const size_t ro = (size_t)(u.r0 + EPI_ROW) * 2048 + u.c0; float sq = 0.f;
#pragma unroll
            EPI_COLS { const f32x4 r = *(const f32x4*)(R + ro + EPI_COL); const f32x4 o = r + acc[ai][bj][m][n]; *(f32x4*)(O + ro + EPI_COL) = o;
                if (HB) { *(u32x2*)(HB + ro + EPI_COL) = (u32x2){pk_bf16(o[0], o[1]), pk_bf16(o[2], o[3])}; sq += o[0] * o[0] + o[1] * o[1] + o[2] * o[2] + o[3] * o[3]; } }
            if (HB) { const int lane = fq * 16 + fr; sq += shx(sq, 16, lane); sq += shx(sq, 32, lane); if (fq == 0) atomicAdd(ss + u.r0 + EPI_ROW, sq); } }
    } };
struct EpiStoreRS { static constexpr bool PERM = true; bf16_t* O; size_t ldc; const float* ss;
    __device__ __forceinline__ void operator()(const AccT& acc, const UInfo& u, int wr, int wc, int fr, int fq) const {
#pragma unroll
        EPI_ROWS { const int row = u.r0 + EPI_ROW; const float rs = rsqrtf(ss[row] * (1.0f / 2048.0f) + 1e-6f); bf16_t* rp = O + (size_t)row * ldc + u.c0;
#pragma unroll
            for (int bj = 0; bj < 2; ++bj) { const f32x4 v = acc[ai][bj][m][0] * rs, v2 = acc[ai][bj][m][1] * rs; *(u32x4*)(rp + 128 * bj + 32 * wc + 8 * fq) = (u32x4){pk_bf16(v[0], v[1]), pk_bf16(v[2], v[3]), pk_bf16(v2[0], v2[1]), pk_bf16(v2[2], v2[3])}; } }
    } };
struct EpiStoreCS { static constexpr bool PERM = true; bf16_t* O; size_t ldc; const float* ss;
    __device__ __forceinline__ void operator()(const AccT& acc, const UInfo& u, int wr, int wc, int fr, int fq) const {
        f32x4 rs[2][2];
#pragma unroll
        for (int bj = 0; bj < 2; ++bj)
#pragma unroll
            for (int n = 0; n < 2; ++n) { const f32x4 s4 = *(const f32x4*)(ss + u.c0 + 128 * bj + 32 * wc + 8 * fq + 4 * n);
#pragma unroll
                for (int j = 0; j < 4; ++j) rs[bj][n][j] = rsqrtf(s4[j] * (1.0f / 2048.0f) + 1e-6f); }
#pragma unroll
        EPI_ROWS { bf16_t* rp = O + (size_t)(u.r0 + EPI_ROW) * ldc + u.c0;
#pragma unroll
            for (int bj = 0; bj < 2; ++bj) { const f32x4 v = acc[ai][bj][m][0] * rs[bj][0], v2 = acc[ai][bj][m][1] * rs[bj][1]; *(u32x4*)(rp + 128 * bj + 32 * wc + 8 * fq) = (u32x4){pk_bf16(v[0], v[1]), pk_bf16(v[2], v[3]), pk_bf16(v2[0], v2[1]), pk_bf16(v2[2], v2[3])}; } }
    } };
struct EpiGate { static constexpr bool PERM = true; bf16_t* Y;
    __device__ __forceinline__ void operator()(const AccT& acc, const UInfo& u, int wr, int wc, int fr, int fq) const {
#pragma unroll
        EPI_ROWS { bf16_t* rp = Y + (size_t)(u.r0 + EPI_ROW) * 4096 + u.c0;
#pragma unroll
            for (int bj = 0; bj < 2; ++bj) { const f32x4 g = acc[ai][bj][m][0], h = acc[ai][bj][m][1]; bf16_t* cp = rp + 128 * bj + 32 * wc + 8 * fq; const u32x4 y = *(const u32x4*)cp;
                const float o0 = g[0] * sigmoidf_(g[0]) * bflo(y[0]), o1 = g[1] * sigmoidf_(g[1]) * bfhi(y[0]), o2 = g[2] * sigmoidf_(g[2]) * bflo(y[1]), o3 = g[3] * sigmoidf_(g[3]) * bfhi(y[1]);
                const float o4 = h[0] * sigmoidf_(h[0]) * bflo(y[2]), o5 = h[1] * sigmoidf_(h[1]) * bfhi(y[2]), o6 = h[2] * sigmoidf_(h[2]) * bflo(y[3]), o7 = h[3] * sigmoidf_(h[3]) * bfhi(y[3]);
                *(u32x4*)cp = (u32x4){pk_bf16(o0, o1), pk_bf16(o2, o3), pk_bf16(o4, o5), pk_bf16(o6, o7)}; } }
    } };
struct EpiQK { static constexpr bool PERM = false; bf16_t* Q; bf16_t* K; bf16_t* KTD; const float2* rope;
    __device__ __forceinline__ void operator()(const AccT& acc, const UInfo& u, int wr, int wc, int fr, int fq) const {
        const int hidx = u.c0 >> 8; const bool isk = hidx >= 8; const int hh = hidx & 7; const float l2g = log2gamma(hh);
        bf16_t* dst = (isk ? K : Q) + hh * 256; const float sc = isk ? 0.0625f : 1.0f;
#pragma unroll
        EPI_ROWS { const int t = u.r0 + EPI_ROW; const float kd = fexp2((float)(255 - (t & 255)) * l2g);
#pragma unroll
            for (int n = 0; n < 2; ++n) { const int dd = 32 * wc + 16 * n + 4 * fq;
                const f32x4 x1 = acc[ai][0][m][n], x2 = acc[ai][1][m][n]; const f32x4 cs0 = *(const f32x4*)(rope + (size_t)t * 128 + dd), cs1 = *(const f32x4*)(rope + (size_t)t * 128 + dd + 2);
                float y1[4], y2[4];
                y1[0] = (x1[0] * cs0[0] - x2[0] * cs0[1]) * sc; y2[0] = (x1[0] * cs0[1] + x2[0] * cs0[0]) * sc;
                y1[1] = (x1[1] * cs0[2] - x2[1] * cs0[3]) * sc; y2[1] = (x1[1] * cs0[3] + x2[1] * cs0[2]) * sc;
                y1[2] = (x1[2] * cs1[0] - x2[2] * cs1[1]) * sc; y2[2] = (x1[2] * cs1[1] + x2[2] * cs1[0]) * sc;
                y1[3] = (x1[3] * cs1[2] - x2[3] * cs1[3]) * sc; y2[3] = (x1[3] * cs1[3] + x2[3] * cs1[2]) * sc;
                *(u32x2*)(dst + (size_t)t * 2048 + dd) = (u32x2){pk_bf16(y1[0], y1[1]), pk_bf16(y1[2], y1[3])};
                *(u32x2*)(dst + (size_t)t * 2048 + 128 + dd) = (u32x2){pk_bf16(y2[0], y2[1]), pk_bf16(y2[2], y2[3])};
                if (isk) {
#pragma unroll
                    for (int j = 0; j < 4; ++j) { KTD[(size_t)(hh * 256 + dd + j) * S_ + t] = (bf16_t)(pk_bf16(y1[j] * kd, 0.f) & 0xffffu); KTD[(size_t)(hh * 256 + 128 + dd + j) * S_ + t] = (bf16_t)(pk_bf16(y2[j] * kd, 0.f) & 0xffffu); }
                } } }
    } };
struct EpiQproj { static constexpr bool PERM = false; bf16_t* QB; float* gates; const float* ss;
    __device__ __forceinline__ void operator()(const AccT& acc, const UInfo& u, int wr, int wc, int fr, int fq) const {
#pragma unroll
        EPI_ROWS { const int t = u.r0 + EPI_ROW; const float rs = rsqrtf(ss[t] * (1.0f / 2048.0f) + 1e-6f);
#pragma unroll
            EPI_COLS { const int col = u.c0 + EPI_COL; const f32x4 v = acc[ai][bj][m][n] * rs;
                if (col < 2048) *(u32x2*)(QB + (size_t)t * 2048 + col) = (u32x2){pk_bf16(v[0] * 0.08838834764831845f, v[1] * 0.08838834764831845f), pk_bf16(v[2] * 0.08838834764831845f, v[3] * 0.08838834764831845f)};
                else if (col < 2096) *(f32x4*)(gates + (size_t)t * 48 + (col - 2048)) = (f32x4){sigmoidf_(v[0]), sigmoidf_(v[1]), sigmoidf_(v[2]), sigmoidf_(v[3])}; } }
    } };
__device__ __forceinline__ float gelu_tanh(float x) { const float y = 0.7978845608028654f * (x + 0.044715f * x * x * x); const float e = fexp2(2.0f * 1.4426950408889634f * y); const float th = 1.0f - 2.0f * frcp(e + 1.0f); return 0.5f * x * (1.0f + th); }
struct EpiGelu { static constexpr bool PERM = false; bf16_t* H; const float* bias;
    __device__ __forceinline__ void operator()(const AccT& acc, const UInfo& u, int wr, int wc, int fr, int fq) const {
#pragma unroll
        EPI_ROWS { bf16_t* rp = H + (size_t)(u.r0 + EPI_ROW) * 256;
#pragma unroll
            EPI_COLS { const int col = EPI_COL; const f32x4 v = acc[ai][bj][m][n]; const f32x4 bb = *(const f32x4*)(bias + col);
                *(u32x2*)(rp + col) = (u32x2){pk_bf16(gelu_tanh(v[0] + bb[0]), gelu_tanh(v[1] + bb[1])), pk_bf16(gelu_tanh(v[2] + bb[2]), gelu_tanh(v[3] + bb[3]))}; } }
    } };
struct EpiKcmp { static constexpr bool PERM = false; bf16_t* KC;
    __device__ __forceinline__ void operator()(const AccT& acc, const UInfo& u, int wr, int wc, int fr, int fq) const {
#pragma unroll
        EPI_ROWS { const int r = u.r0 + EPI_ROW, i = r >> 2, h = r & 3;
#pragma unroll
            for (int n = 0; n < 2; ++n) { const int col = 32 * wc + 16 * n + 4 * fq; f32x4 v = acc[ai][0][m][n]; if (i == 1023) v = (f32x4){0.f, 0.f, 0.f, 0.f};
                *(u32x2*)(KC + ((size_t)h * 1024 + i) * 128 + col) = (u32x2){pk_bf16(v[0], v[1]), pk_bf16(v[2], v[3])}; } }
    } };
struct EpiVcmp { static constexpr bool PERM = false; bf16_t* VC;
    __device__ __forceinline__ void operator()(const AccT& acc, const UInfo& u, int wr, int wc, int fr, int fq) const {
#pragma unroll
        for (int m = 0; m < 4; ++m) { const int d = 64 * wr + 16 * m + fr;
#pragma unroll
            EPI_COLS { const int col = u.c0 + EPI_COL, i = col >> 2; f32x4 v = acc[0][bj][m][n]; if (i == 1023) v = (f32x4){0.f, 0.f, 0.f, 0.f};
#pragma unroll
                for (int h = 0; h < 4; ++h) VC[((size_t)h * 128 + d) * 1024 + i] = (bf16_t)(pk_bf16(v[h], 0.f) & 0xffffu); } }
    } };
struct ProbCmp1 {
    static constexpr bool PERM = false;
    const char* A; const char* B; unsigned ldb; int nt, nM; EpiGelu e;
    __device__ __forceinline__ long nunits() const { return nM; }
    __device__ __forceinline__ unsigned rowA(int R) const { return (unsigned)(R >> 2) * 65536u + (unsigned)(R & 3) * 256u; }
    __device__ __forceinline__ void unit(long L, UInfo& u) const { u.a = A + (size_t)L * 64 * 65536; u.b = B; u.r0 = (int)L * 256; u.c0 = 0; u.x0 = 0; u.x1 = 0; }
    __device__ __forceinline__ size_t aK(int kt) const { return (size_t)(kt >> 1) * 4096 + (size_t)(kt & 1) * 128; }
    __device__ __forceinline__ size_t bK(int kt) const { return (size_t)kt * 128; }
    __device__ __forceinline__ void epi(const AccT& acc, const UInfo& u, int wr, int wc, int fr, int fq) const { e(acc, u, wr, wc, fr, fq); }
};
struct ProbKV {
    static constexpr bool PERM = true;
    const char* VT; const char* KTD; bf16_t* ST; int nt;
    __device__ __forceinline__ long nunits() const { return 8 * 64 * 2; }
    __device__ __forceinline__ unsigned rowA(int R) const { return (unsigned)R * 32768u; }
    static constexpr unsigned ldb = 32768u;
    __device__ __forceinline__ void unit(long L, UInfo& u) const { const int pm = (int)L & 1, c = ((int)L >> 1) & 63, h = (int)L >> 7;
        u.a = VT + ((size_t)(h * 512 + pm * 256) * S_ + c * 256) * 2; u.b = KTD + ((size_t)(h * 256) * S_ + c * 256) * 2; u.r0 = h * 512 + pm * 256; u.c0 = c * 256; u.x0 = 0; u.x1 = 0; }
    __device__ __forceinline__ size_t aK(int kt) const { return (size_t)kt * 128; }
    __device__ __forceinline__ size_t bK(int kt) const { return (size_t)kt * 128; }
    __device__ __forceinline__ void epi(const AccT& acc, const UInfo& u, int wr, int wc, int fr, int fq) const { EpiStore e{ST, (size_t)S_}; e(acc, u, wr, wc, fr, fq); }
};
struct ProbS {
    static constexpr bool PERM = true;
    const char* Q; const char* K; bf16_t* SD; int nt;
    __device__ __forceinline__ long nunits() const { return 8 * 64; }
    __device__ __forceinline__ unsigned rowA(int R) const { return (unsigned)R * 4096u; }
    static constexpr unsigned ldb = 4096u;
    __device__ __forceinline__ void unit(long L, UInfo& u) const { const int c = (int)L & 63, h = (int)L >> 6; const size_t o = ((size_t)(c * 256) * 2048 + h * 256) * 2;
        u.a = Q + o; u.b = K + o; u.r0 = c * 256; u.c0 = h * 256; u.x0 = h; u.x1 = 0; }
    __device__ __forceinline__ size_t aK(int kt) const { return (size_t)kt * 128; }
    __device__ __forceinline__ size_t bK(int kt) const { return (size_t)kt * 128; }
    __device__ __forceinline__ void epi(const AccT& acc, const UInfo& u, int wr, int wc, int fr, int fq) const {
        const float l2g = log2gamma(u.x0);
#pragma unroll
        EPI_ROWS { const int i = EPI_ROW; bf16_t* rp = SD + (size_t)(u.r0 + i) * 2048 + u.c0;
#pragma unroll
            for (int bj = 0; bj < 2; ++bj) { const int s = 128 * bj + 32 * wc + 8 * fq; const f32x4 v = acc[ai][bj][m][0], v2 = acc[ai][bj][m][1]; float o[8];
#pragma unroll
                for (int j = 0; j < 4; ++j) { o[j] = (s + j <= i) ? v[j] * fexp2(-(float)(s + j + 1) * l2g) : 0.f; o[4 + j] = (s + 4 + j <= i) ? v2[j] * fexp2(-(float)(s + 4 + j + 1) * l2g) : 0.f; }
                *(u32x4*)(rp + s) = (u32x4){pk_bf16(o[0], o[1]), pk_bf16(o[2], o[3]), pk_bf16(o[4], o[5]), pk_bf16(o[6], o[7])}; } }
    }
};
struct ProbOut {
    static constexpr bool PERM = true;
    const char* Q; const char* ST; long dA, dB; bf16_t* Y; int nt;
    __device__ __forceinline__ long nunits() const { return 8 * 64 * 2; }
    __device__ __forceinline__ unsigned rowA(int R) const { return (unsigned)R * 4096u; }
    static constexpr unsigned ldb = 32768u;
    __device__ __forceinline__ void unit(long L, UInfo& u) const { const int pn = (int)L & 1, c = ((int)L >> 1) & 63, h = (int)L >> 7;
        u.a = Q + ((size_t)(c * 256) * 2048 + h * 256) * 2; u.b = ST + ((size_t)(h * 512 + pn * 256) * S_ + c * 256) * 2; u.r0 = c * 256; u.c0 = h * 512 + pn * 256; u.x0 = h; u.x1 = 0; }
    __device__ __forceinline__ size_t aK(int kt) const { return kt < 4 ? (size_t)kt * 128 : (size_t)(dA + (long)(kt - 4) * 128); }
    __device__ __forceinline__ size_t bK(int kt) const { return kt < 4 ? (size_t)kt * 128 : (size_t)(dB + (long)(kt - 4) * 128); }
    __device__ __forceinline__ void epi(const AccT& acc, const UInfo& u, int wr, int wc, int fr, int fq) const {
        const float l2g = log2gamma(u.x0);
#pragma unroll
        EPI_ROWS { const int i = EPI_ROW; const float qd = fexp2((float)(i + 1) * l2g); bf16_t* rp = Y + (size_t)(u.r0 + i) * 4096 + u.c0;
#pragma unroll
            for (int bj = 0; bj < 2; ++bj) { const f32x4 v = acc[ai][bj][m][0] * qd, v2 = acc[ai][bj][m][1] * qd; *(u32x4*)(rp + 128 * bj + 32 * wc + 8 * fq) = (u32x4){pk_bf16(v[0], v[1]), pk_bf16(v[2], v[3]), pk_bf16(v2[0], v2[1]), pk_bf16(v2[2], v2[3])}; } }
    }
};

__device__ __forceinline__ void transpose_job(const float* __restrict__ src, bf16_t* __restrict__ dst, int K, int N, int Npad, int kvperm, LAS float* tile, const float* gain = nullptr) {
    const int tk = K / 64, tn = Npad / 256, ntile = tk * tn; const int tid = ltid();
    for (int t = blockIdx.x; t < ntile; t += gridDim.x) {
        const int k0 = (t % tk) * 64, n0 = (t / tk) * 256;
        { const int r0 = tid >> 6, cc = tid & 63; float v[8][4];
#pragma unroll
          for (int i = 0; i < 8; ++i)
#pragma unroll
              for (int q = 0; q < 4; ++q) { const int n = n0 + cc + 64 * q; v[i][q] = (n < N) ? src[(size_t)(k0 + r0 + 8 * i) * N + n] : 0.f; }
#pragma unroll
          for (int i = 0; i < 8; ++i) { const float gk = gain ? gain[k0 + r0 + 8 * i] : 1.0f;
#pragma unroll
              for (int q = 0; q < 4; ++q) tile[(r0 + 8 * i) * 257 + cc + 64 * q] = v[i][q] * gk; } }
        __syncthreads();
        { const int rr = tid >> 1, c0 = (tid & 1) * 32;
          int n = n0 + rr; if (kvperm) { const int j = n >> 9; const int jp = (j == 3) ? 4 : ((j == 4) ? 3 : j); n = jp * 512 + (n & 511); }
          bf16_t* dp = dst + (size_t)n * K + k0 + c0;
#pragma unroll
          for (int g = 0; g < 4; ++g) { float x[8];
#pragma unroll
              for (int j = 0; j < 8; ++j) x[j] = tile[(c0 + 8 * g + j) * 257 + rr];
              *(u32x4*)(dp + 8 * g) = (u32x4){pk_bf16(x[0], x[1]), pk_bf16(x[2], x[3]), pk_bf16(x[4], x[5]), pk_bf16(x[6], x[7])}; } }
        __syncthreads();
    }
}
__device__ __forceinline__ void prep_phase(CP p, LAS unsigned char* lds) {
    LAS float* tile = (LAS float*)lds; unsigned char* ws = p->ws;
    transpose_job(p->ret_w_in, (bf16_t*)(ws + OFF_W_RIN), 2048, 12288, 12288, 0, tile);
    transpose_job(p->ret_w_out, (bf16_t*)(ws + OFF_W_ROUT), 4096, 2048, 2048, 0, tile);
    transpose_job(p->w_kv, (bf16_t*)(ws + OFF_W_KV), 2048, 3072, 3072, 1, tile, p->kv_gain);
    transpose_job(p->w1_k, (bf16_t*)(ws + OFF_W_C1K), 4096, 256, 256, 0, tile);
    transpose_job(p->w1_v, (bf16_t*)(ws + OFF_W_C1V), 4096, 256, 256, 0, tile);
    transpose_job(p->w2_k, (bf16_t*)(ws + OFF_W_C2K), 256, 128, 256, 0, tile);
    transpose_job(p->w2_v, (bf16_t*)(ws + OFF_W_C2V), 256, 128, 256, 0, tile);
    transpose_job(p->w_q, (bf16_t*)(ws + OFF_W_Q), 2048, 2096, 2304, 0, tile, p->norm_mix + 2048);
    transpose_job(p->w_o, (bf16_t*)(ws + OFF_W_O), 2048, 2048, 2048, 0, tile);
    transpose_job(p->ffn_w_in, (bf16_t*)(ws + OFF_W_FIN), 2048, 8192, 8192, 0, tile, p->norm_ffn);
    transpose_job(p->ffn_w_in + (size_t)2048 * 8192, (bf16_t*)(ws + OFF_W_FIN + 32 * MiB), 2048, 8192, 8192, 0, tile, p->norm_ffn + 2048);
    transpose_job(p->ffn_w_out, (bf16_t*)(ws + OFF_W_FOUT), 4096, 2048, 2048, 0, tile);
    transpose_job(p->ffn_w_out + (size_t)4096 * 2048, (bf16_t*)(ws + OFF_W_FOUT + 16 * MiB), 4096, 2048, 2048, 0, tile);
    { float* ss = (float*)(ws + OFF_SS); for (int i = blockIdx.x * 512 + ltid(); i < 8 * S_; i += gridDim.x * 512) ss[i] = 0.f; }
    { float2* rope = (float2*)(ws + OFF_ROPE); const int gsz = gridDim.x * 512;
      for (int i = blockIdx.x * 512 + ltid(); i < S_ * 128; i += gsz) { const int t = i >> 7, dd = i & 127;
          const float freq = exp2f(-(float)dd * (13.287712379549449f / 128.0f)); const double rev = (double)t * (double)freq * 0.15915494309189535;
          const float fx = (float)(rev - rint(rev)); rope[i] = make_float2(__builtin_amdgcn_cosf(fx), __builtin_amdgcn_sinf(fx)); } }
    if (blockIdx.x < 128) { const int kv = blockIdx.x >> 6, oc = blockIdx.x & 63; const float* pe = kv ? p->pe_v : p->pe_k; const float* w1 = kv ? p->w1_v : p->w1_k; float* peb = (float*)(ws + OFF_PEB) + kv * 256;
        const int tid = ltid(), g = tid >> 7, r = tid & 127, n = 4 * oc + g; float s = 0.f;
#pragma unroll 8
        for (int j = 0; j < 32; ++j) { const int k = r + 128 * j; s += pe[k] * w1[(size_t)k * 256 + n]; }
        s = wave_sum(s, tid & 63);
        __syncthreads(); if ((tid & 63) == 0) tile[tid >> 6] = s; __syncthreads();
        if (tid < 4) peb[4 * oc + tid] = tile[2 * tid] + tile[2 * tid + 1];
        __syncthreads(); }
}
__device__ __forceinline__ void rmsnorm_phase(const float* h, const float* g1, bf16_t* o1, const float* g2, bf16_t* o2) {
    const int w = ltid() >> 6, lane = ltid() & 63;
    for (int row = blockIdx.x * 8 + w; row < S_; row += gridDim.x * 8) {
        const f32x4* p = (const f32x4*)(h + (size_t)row * 2048); f32x4 v[8]; float ss = 0.f;
#pragma unroll
        for (int i = 0; i < 8; ++i) { v[i] = p[lane + 64 * i]; ss += v[i][0] * v[i][0] + v[i][1] * v[i][1] + v[i][2] * v[i][2] + v[i][3] * v[i][3]; }
        ss = wave_sum(ss, lane); const float r = rsqrtf(ss * (1.0f / 2048.0f) + 1e-6f);
#pragma unroll
        for (int i = 0; i < 8; ++i) { const int col = (lane + 64 * i) * 4; const f32x4 g = *(const f32x4*)(g1 + col);
            *(u32x2*)(o1 + (size_t)row * 2048 + col) = (u32x2){pk_bf16(v[i][0] * r * g[0], v[i][1] * r * g[1]), pk_bf16(v[i][2] * r * g[2], v[i][3] * r * g[3])};
            if (o2) { const f32x4 gg = *(const f32x4*)(g2 + col);
                *(u32x2*)(o2 + (size_t)row * 2048 + col) = (u32x2){pk_bf16(v[i][0] * r * gg[0], v[i][1] * r * gg[1]), pk_bf16(v[i][2] * r * gg[2], v[i][3] * r * gg[3])}; } }
    }
}
__device__ __forceinline__ void finalnorm_phase(float* h, const float* g1) {
    const int w = ltid() >> 6, lane = ltid() & 63;
    for (int row = blockIdx.x * 8 + w; row < S_; row += gridDim.x * 8) {
        f32x4* p = (f32x4*)(h + (size_t)row * 2048); f32x4 v[8]; float ss = 0.f;
#pragma unroll
        for (int i = 0; i < 8; ++i) { v[i] = p[lane + 64 * i]; ss += v[i][0] * v[i][0] + v[i][1] * v[i][1] + v[i][2] * v[i][2] + v[i][3] * v[i][3]; }
        ss = wave_sum(ss, lane); const float r = rsqrtf(ss * (1.0f / 2048.0f) + 1e-6f);
#pragma unroll
        for (int i = 0; i < 8; ++i) { const f32x4 g = *(const f32x4*)(g1 + (lane + 64 * i) * 4); p[lane + 64 * i] = v[i] * r * g; }
    }
}
__device__ __forceinline__ void scan_phase(bf16_t* ST) {
    for (int it = blockIdx.x * 512 + ltid(); it < 4096 * 32; it += gridDim.x * 512) {
        const int r = it >> 5, d8 = it & 31; const float cd = fexp2(256.0f * log2gamma(r >> 9));
        bf16_t* p = ST + (size_t)r * S_ + d8 * 8; float s[8];
#pragma unroll
        for (int j = 0; j < 8; ++j) s[j] = 0.f;
        for (int c = 0; c < 64; ++c) { const u32x4 v = *(const u32x4*)(p + c * 256);
            *(u32x4*)(p + c * 256) = (u32x4){pk_bf16(s[0], s[1]), pk_bf16(s[2], s[3]), pk_bf16(s[4], s[5]), pk_bf16(s[6], s[7])};
#pragma unroll
            for (int j = 0; j < 4; ++j) { s[2 * j] = s[2 * j] * cd + bflo(v[j]); s[2 * j + 1] = s[2 * j + 1] * cd + bfhi(v[j]); } }
    }
}
__device__ __forceinline__ void gn_phase(bf16_t* Y, const float* gain) {
    const int w = ltid() >> 6, lane = ltid() & 63;
    for (int g = blockIdx.x * 8 + w; g < S_ * 8; g += gridDim.x * 8) {
        bf16_t* p = Y + (size_t)g * 512 + lane * 8; const u32x4 v = *(const u32x4*)p; float x[8];
#pragma unroll
        for (int j = 0; j < 4; ++j) { x[2 * j] = bflo(v[j]); x[2 * j + 1] = bfhi(v[j]); }
        float s = 0.f;
#pragma unroll
        for (int j = 0; j < 8; ++j) s += x[j];
        const float mu = wave_sum(s, lane) * (1.0f / 512.0f); float q = 0.f;
#pragma unroll
        for (int j = 0; j < 8; ++j) { x[j] -= mu; q += x[j] * x[j]; }
        const float r = rsqrtf(wave_sum(q, lane) * (1.0f / 512.0f) + 1e-6f); const float* gp = gain + (g & 7) * 512 + lane * 8;
        const f32x4 g0 = *(const f32x4*)gp, g1 = *(const f32x4*)(gp + 4);
        *(u32x4*)p = (u32x4){pk_bf16(x[0] * r * g0[0], x[1] * r * g0[1]), pk_bf16(x[2] * r * g0[2], x[3] * r * g0[3]), pk_bf16(x[4] * r * g1[0], x[5] * r * g1[1]), pk_bf16(x[6] * r * g1[2], x[7] * r * g1[3])};
    }
}
__device__ __forceinline__ void conv_phase(const bf16_t* U, bf16_t* AB, const float* cw, const float* cb) {
    for (int it = blockIdx.x * 512 + ltid(); it < 512 * 512; it += gridDim.x * 512) {
        const int n8 = (it & 511) * 8, t0 = (it >> 9) * 32;
        float wa[3][8], wb[3][8], ba[8], bb[8];
#pragma unroll
        for (int tp = 0; tp < 3; ++tp)
#pragma unroll
            for (int j = 0; j < 8; ++j) { wa[tp][j] = cw[tp * 8192 + n8 + j]; wb[tp][j] = cw[tp * 8192 + 4096 + n8 + j]; }
#pragma unroll
        for (int j = 0; j < 8; ++j) { ba[j] = cb[n8 + j]; bb[j] = cb[4096 + n8 + j]; }
        float pa[2][8], pb[2][8];
#pragma unroll
        for (int k = 0; k < 2; ++k) { const int t = t0 - 2 + k; u32x4 va = (u32x4){0, 0, 0, 0}, vb = (u32x4){0, 0, 0, 0};
            if (t >= 0) { va = *(const u32x4*)(U + (size_t)t * 8192 + n8); vb = *(const u32x4*)(U + (size_t)t * 8192 + 4096 + n8); }
#pragma unroll
            for (int j = 0; j < 4; ++j) { pa[k][2 * j] = bflo(va[j]); pa[k][2 * j + 1] = bfhi(va[j]); pb[k][2 * j] = bflo(vb[j]); pb[k][2 * j + 1] = bfhi(vb[j]); } }
#pragma unroll 8
        for (int k = 0; k < 32; ++k) { const int t = t0 + k; const u32x4 va = *(const u32x4*)(U + (size_t)t * 8192 + n8), vb = *(const u32x4*)(U + (size_t)t * 8192 + 4096 + n8);
            float xa[8], xb[8], o[8];
#pragma unroll
            for (int j = 0; j < 4; ++j) { xa[2 * j] = bflo(va[j]); xa[2 * j + 1] = bfhi(va[j]); xb[2 * j] = bflo(vb[j]); xb[2 * j + 1] = bfhi(vb[j]); }
#pragma unroll
            for (int j = 0; j < 8; ++j) { const float a = ba[j] + wa[0][j] * pa[0][j] + wa[1][j] * pa[1][j] + wa[2][j] * xa[j]; const float b = bb[j] + wb[0][j] * pb[0][j] + wb[1][j] * pb[1][j] + wb[2][j] * xb[j];
                o[j] = a * sigmoidf_(a) * b; pa[0][j] = pa[1][j]; pa[1][j] = xa[j]; pb[0][j] = pb[1][j]; pb[1][j] = xb[j]; }
            *(u32x4*)(AB + (size_t)t * 4096 + n8) = (u32x4){pk_bf16(o[0], o[1]), pk_bf16(o[2], o[3]), pk_bf16(o[4], o[5]), pk_bf16(o[6], o[7])}; }
    }
}

constexpr int A_KT = 0, A_VT = 17408, A_BUFSZ = 34816, A_PSL = 69632, A_SEL = 4 * A_BUFSZ, LDS_ST = A_SEL + 2048;
constexpr float LOG2E = 1.4426950408889634f;
struct AttnState { f32x4 ot[8][2]; float m[2], l[2]; };

template <int MODE>
__device__ __forceinline__ void attn_compute(LAS unsigned char* lds, int boff, int tile, const bf16x8 (&qf)[2][4], AttnState& st, const int (&tpos)[2], int qb, int w, int lane,
                                             const float (&mfin)[2], const float (&linv)[2], bool rs0, bool rs1, bool masked, bool a0, bool a1) {
    const int l16 = lane & 15, g4 = lane >> 4;
    f32x4 s[4][2];
#pragma unroll
    for (int mt = 0; mt < 4; ++mt) { s[mt][0] = (f32x4){0.f, 0.f, 0.f, 0.f}; s[mt][1] = (f32x4){0.f, 0.f, 0.f, 0.f}; }
#pragma unroll
    for (int ks = 0; ks < 4; ++ks) {
        bf16x8 kf[4];
#pragma unroll
        for (int mt = 0; mt < 4; ++mt) kf[mt] = *(const LAS bf16x8*)(lds + boff + A_KT + (16 * mt + l16) * 272 + ks * 64 + g4 * 16);
        if (a0) {
#pragma unroll
            for (int mt = 0; mt < 4; ++mt) s[mt][0] = __builtin_amdgcn_mfma_f32_16x16x32_bf16(kf[mt], qf[0][ks], s[mt][0], 0, 0, 0);
        }
        if (a1) {
#pragma unroll
            for (int mt = 0; mt < 4; ++mt) s[mt][1] = __builtin_amdgcn_mfma_f32_16x16x32_bf16(kf[mt], qf[1][ks], s[mt][1], 0, 0, 0);
        }
        if (ks & 1) __builtin_amdgcn_sched_barrier(0);
    }
    if (masked) {
#pragma unroll
        for (int nt = 0; nt < 2; ++nt) { const int t = tpos[nt]; const int tl = w * 8 + nt * 4 + (l16 >> 2);
#pragma unroll
            for (int mt = 0; mt < 4; ++mt)
#pragma unroll
                for (int j = 0; j < 4; ++j) { const int kl = 16 * mt + 4 * g4 + j; const int key = tile * 64 + kl; bool v;
                    if (MODE == 0 || MODE == 1) v = key <= ((t - 31) >> 4);
                    else if (MODE == 2) v = (kl <= tl);
                    else v = (key <= t) && (key > t - 512);
                    s[mt][nt][j] = v ? s[mt][nt][j] : -__builtin_inff(); } }
    }
    bf16x8 pf[2][2];
#pragma unroll
    for (int nt = 0; nt < 2; ++nt) {
        if (nt ? a1 : a0) {
            const bool rowsel = nt ? rs1 : rs0;
            const float bias = (MODE == 2 && !rowsel) ? -__builtin_inff() : 0.f;
            float mx = -1e30f;
#pragma unroll
            for (int mt = 0; mt < 4; ++mt)
#pragma unroll
                for (int j = 0; j < 4; ++j) {
                    const float sv = s[mt][nt][j] * LOG2E + bias;
                    s[mt][nt][j] = sv; mx = fmaxf(mx, sv); }
            float mnew, alpha = 1.f;
            if (MODE == 1) mnew = mfin[nt];
            else { mx = fmaxf(mx, shx(mx, 16, lane)); mx = fmaxf(mx, shx(mx, 32, lane)); mnew = fmaxf(st.m[nt], mx); alpha = fexp2(st.m[nt] - mnew); st.m[nt] = mnew; }
            float ps = 0.f;
#pragma unroll
            for (int mt = 0; mt < 4; ++mt)
#pragma unroll
                for (int j = 0; j < 4; ++j) { float pv = fexp2(s[mt][nt][j] - mnew); if (MODE == 1) pv *= linv[nt]; s[mt][nt][j] = pv; ps += pv; }
            if (MODE != 1) st.l[nt] = st.l[nt] * alpha + ps;
            if (MODE == 2 || MODE == 3) {
#pragma unroll
                for (int md = 0; md < 8; ++md) st.ot[md][nt] = st.ot[md][nt] * alpha;
            }
            if (MODE == 1) {
#pragma unroll
                for (int mt = 0; mt < 4; ++mt) { float a = s[mt][nt][0] + s[mt][nt][1] + s[mt][nt][2] + s[mt][nt][3], lst = s[mt][nt][3];
                    a += shx(a, 1, lane); a += shx(a, 2, lane); lst += shx(lst, 1, lane); lst += shx(lst, 2, lane);
                    if ((l16 & 3) == 0) { const int jb = tile * 16 + 4 * mt + g4; LAS float* pp = (LAS float*)(lds + A_PSL) + (w * 8 + nt * 4 + (l16 >> 2)) * 256;
                        atomicAdd((float*)(pp + jb), a); if (jb + 1 < 256) atomicAdd((float*)(pp + jb + 1), lst); } }
            }
            if (MODE != 0) {
#pragma unroll
                for (int kk = 0; kk < 2; ++kk) { const u32x4 pk = (u32x4){pk_bf16(s[2 * kk][nt][0], s[2 * kk][nt][1]), pk_bf16(s[2 * kk][nt][2], s[2 * kk][nt][3]), pk_bf16(s[2 * kk + 1][nt][0], s[2 * kk + 1][nt][1]), pk_bf16(s[2 * kk + 1][nt][2], s[2 * kk + 1][nt][3])};
                    pf[nt][kk] = __builtin_bit_cast(bf16x8, pk); }
            }
        } else { pf[nt][0] = (bf16x8){0, 0, 0, 0, 0, 0, 0, 0}; pf[nt][1] = (bf16x8){0, 0, 0, 0, 0, 0, 0, 0}; }
    }
    if (MODE != 0) {
#pragma unroll
        for (int kk = 0; kk < 2; ++kk)
#pragma unroll
            for (int mg = 0; mg < 2; ++mg) {
                bf16x8 vf[4];
#pragma unroll
                for (int q = 0; q < 4; ++q) { const LAS unsigned char* vb = lds + boff + A_VT + (16 * (4 * mg + q) + l16) * 136 + kk * 64 + g4 * 8;
                    const u32x2 v0 = *(const LAS u32x2*)vb, v1 = *(const LAS u32x2*)(vb + 32); vf[q] = __builtin_bit_cast(bf16x8, ((u32x4){v0[0], v0[1], v1[0], v1[1]})); }
                if (a0) {
#pragma unroll
                    for (int q = 0; q < 4; ++q) st.ot[4 * mg + q][0] = __builtin_amdgcn_mfma_f32_16x16x32_bf16(vf[q], pf[0][kk], st.ot[4 * mg + q][0], 0, 0, 0);
                }
                if (a1) {
#pragma unroll
                    for (int q = 0; q < 4; ++q) st.ot[4 * mg + q][1] = __builtin_amdgcn_mfma_f32_16x16x32_bf16(vf[q], pf[1][kk], st.ot[4 * mg + q][1], 0, 0, 0);
                }
                if (mg == 1) __builtin_amdgcn_sched_barrier(0);
            }
    }
}
template <int MODE>
__device__ __forceinline__ void attn_tiles(LAS unsigned char* lds, const bf16_t* kp, size_t kstride, const bf16_t* vp, size_t vstride, int tile_lo, int tile_hi,
                                           const bf16x8 (&qf)[2][4], AttnState& st, const int (&tpos)[2], int qb, int w, int lane, const float (&mfin)[2], const float (&linv)[2]) {
    if (tile_lo >= tile_hi) return;
    int tid = w * 64 + lane; asm volatile("" : "+v"(tid)); const int l16 = lane & 15;
    const int krow = tid >> 3, kc = (tid & 7) * 16, vrow = tid >> 2, vc = (tid & 3) * 16;
    u32x4 kr0, kr1, vr0 = (u32x4){0, 0, 0, 0}, vr1 = (u32x4){0, 0, 0, 0};
#define A_LOAD(T) do { const bf16_t* kg = kp + (size_t)((T) * 64 + krow) * kstride + kc; kr0 = *(const u32x4*)kg; kr1 = *(const u32x4*)(kg + 8); \
        if (MODE != 0) { const bf16_t* vg = vp + (size_t)vrow * vstride + (T) * 64 + vc; vr0 = *(const u32x4*)vg; vr1 = *(const u32x4*)(vg + 8); } } while (0)
#define A_WRITE(BO) do { LAS unsigned char* kd = lds + (BO) + A_KT + krow * 272 + kc * 2; *(LAS u32x4*)kd = kr0; *(LAS u32x4*)(kd + 16) = kr1; \
        if (MODE != 0) { LAS unsigned char* vd = lds + (BO) + A_VT + vrow * 136 + vc * 2; *(LAS u32x2*)vd = (u32x2){vr0[0], vr0[1]}; *(LAS u32x2*)(vd + 8) = (u32x2){vr0[2], vr0[3]}; *(LAS u32x2*)(vd + 16) = (u32x2){vr1[0], vr1[1]}; *(LAS u32x2*)(vd + 24) = (u32x2){vr1[2], vr1[3]}; } } while (0)
    A_LOAD(tile_lo);
    __syncthreads();
    A_WRITE(0);
    if (tile_lo + 1 < tile_hi) A_LOAD(tile_lo + 1);
    __syncthreads();
    unsigned selw0 = 0u, selw1 = 0u;
    for (int tile = tile_lo; tile < tile_hi; ++tile) {
        const int boff = ((tile - tile_lo) & 1) * A_BUFSZ;
        if (MODE == 2 && (tile == tile_lo || (tile & 31) == 0)) { const int tw = tile >> 5;
            selw0 = *(const LAS unsigned*)(lds + A_SEL + ((w * 8 + (l16 >> 2)) * 8 + tw) * 4); selw1 = *(const LAS unsigned*)(lds + A_SEL + ((w * 8 + 4 + (l16 >> 2)) * 8 + tw) * 4); }
        if (tile + 1 < tile_hi) { A_WRITE(boff ^ A_BUFSZ); if (tile + 2 < tile_hi) A_LOAD(tile + 2); }
        bool rs0 = true, rs1 = true, active = true;
        if (MODE == 2) { const unsigned bit = 1u << (tile & 31);
            rs0 = (selw0 & bit) != 0u; rs1 = (selw1 & bit) != 0u; active = __ballot(rs0 || rs1) != 0ull; }
        if (active) {
            bool masked;
            if (MODE == 0 || MODE == 1) masked = (tile * 64 + 63 > 4 * qb - 2);
            else if (MODE == 2) masked = (tile == qb);
            else masked = (tile == qb) || (tile <= qb - 8);
            const bool a0 = (MODE != 2) || (__ballot(rs0) != 0ull), a1 = (MODE != 2) || (__ballot(rs1) != 0ull);
            attn_compute<MODE>(lds, boff, tile, qf, st, tpos, qb, w, lane, mfin, linv, rs0, rs1, masked, a0, a1);
        }
        __syncthreads();
    }
#undef A_LOAD
#undef A_WRITE
}
__device__ __forceinline__ void attn_tiles_slc2(LAS unsigned char* lds, const bf16_t* kp, size_t kstride, const bf16_t* vp, size_t vstride, int n,
                                                const bf16x8 (&qf)[2][4], AttnState& st, const int (&tpos)[2], int qb, int w, int lane, const float (&mfin)[2], const float (&linv)[2]) {
    int tid = w * 64 + lane; asm volatile("" : "+v"(tid)); const int l16 = lane & 15;
    const int krow = tid >> 3, kc = (tid & 7) * 16, vrow = tid >> 2, vc = (tid & 3) * 16;
    const int nst = (n + 1) >> 1; constexpr int STG = 2 * A_BUFSZ;
    u32x4 kX0, kX1, vX0, vX1, kY0 = (u32x4){0, 0, 0, 0}, kY1 = (u32x4){0, 0, 0, 0}, vY0 = (u32x4){0, 0, 0, 0}, vY1 = (u32x4){0, 0, 0, 0};
#define S_LOAD1(T, S) do { const bf16_t* kg = kp + (size_t)((T) * 64 + krow) * kstride + kc; k##S##0 = *(const u32x4*)kg; k##S##1 = *(const u32x4*)(kg + 8); \
        const bf16_t* vg = vp + (size_t)vrow * vstride + (T) * 64 + vc; v##S##0 = *(const u32x4*)vg; v##S##1 = *(const u32x4*)(vg + 8); } while (0)
#define S_WRITE1(BO, S) do { LAS unsigned char* kd = lds + (BO) + A_KT + krow * 272 + kc * 2; *(LAS u32x4*)kd = k##S##0; *(LAS u32x4*)(kd + 16) = k##S##1; \
        LAS unsigned char* vd = lds + (BO) + A_VT + vrow * 136 + vc * 2; *(LAS u32x2*)vd = (u32x2){v##S##0[0], v##S##0[1]}; *(LAS u32x2*)(vd + 8) = (u32x2){v##S##0[2], v##S##0[3]}; *(LAS u32x2*)(vd + 16) = (u32x2){v##S##1[0], v##S##1[1]}; *(LAS u32x2*)(vd + 24) = (u32x2){v##S##1[2], v##S##1[3]}; } while (0)
#define S_LOADS(SG) do { S_LOAD1(2 * (SG), X); if (2 * (SG) + 1 < n) S_LOAD1(2 * (SG) + 1, Y); } while (0)
#define S_WRITES(SG, BASE) do { S_WRITE1((BASE), X); if (2 * (SG) + 1 < n) S_WRITE1((BASE) + A_BUFSZ, Y); } while (0)
    S_LOADS(0);
    __syncthreads();
    S_WRITES(0, 0);
    if (nst > 1) S_LOADS(1);
    __syncthreads();
    unsigned selw0 = 0u, selw1 = 0u;
    for (int s = 0; s < nst; ++s) {
        const int base = (s & 1) * STG;
        if ((s & 15) == 0) { const int tw = s >> 4;
            selw0 = *(const LAS unsigned*)(lds + A_SEL + ((w * 8 + (l16 >> 2)) * 8 + tw) * 4); selw1 = *(const LAS unsigned*)(lds + A_SEL + ((w * 8 + 4 + (l16 >> 2)) * 8 + tw) * 4); }
        if (s + 1 < nst) { S_WRITES(s + 1, base ^ STG); if (s + 2 < nst) S_LOADS(s + 2); }
#pragma unroll
        for (int hf = 0; hf < 2; ++hf) {
            const int tile = 2 * s + hf;
            if (tile < n) {
                const unsigned bit = 1u << (tile & 31);
                const bool rs0 = (selw0 & bit) != 0u, rs1 = (selw1 & bit) != 0u;
                const bool a0 = __ballot(rs0) != 0ull, a1 = __ballot(rs1) != 0ull;
                if (a0 || a1) attn_compute<2>(lds, base + hf * A_BUFSZ, tile, qf, st, tpos, qb, w, lane, mfin, linv, rs0, rs1, tile == qb, a0, a1);
            }
        }
        asm volatile("s_waitcnt lgkmcnt(0)" ::: "memory"); __builtin_amdgcn_s_barrier(); asm volatile("" ::: "memory");
    }
    __syncthreads();
#undef S_LOAD1
#undef S_WRITE1
#undef S_LOADS
#undef S_WRITES
}
template <int BR>
__device__ __forceinline__ void attn_finish(AttnState& st, const float* gates, float* oacc, bf16_t* att, const int (&tpos)[2], int hkv, int lane) {
    const int l16 = lane & 15, g4 = lane >> 4, g = l16 & 3;
#pragma unroll
    for (int nt = 0; nt < 2; ++nt) {
        const int t = tpos[nt]; float sc = gates[(size_t)t * 48 + (hkv * 4 + g) * 3 + BR];
        if (BR != 0) { float l = st.l[nt]; l += shx(l, 16, lane); l += shx(l, 32, lane); sc = (l > 0.f) ? sc / l : 0.f; }
        const size_t base = (size_t)t * 2048 + (hkv * 4 + g) * 128 + 4 * g4;
#pragma unroll
        for (int md = 0; md < 8; ++md) { f32x4 v = st.ot[md][nt] * sc; float* op = oacc + base + 16 * md;
            if (BR == 0) *(f32x4*)op = v;
            else if (BR == 1) *(f32x4*)op = *(const f32x4*)op + v;
            else { v = v + *(const f32x4*)op; *(u32x2*)(att + base + 16 * md) = (u32x2){pk_bf16(v[0], v[1]), pk_bf16(v[2], v[3])}; } }
    }
}
__device__ __forceinline__ void attn_reset(AttnState& st) {
#pragma unroll
    for (int md = 0; md < 8; ++md) { st.ot[md][0] = (f32x4){0.f, 0.f, 0.f, 0.f}; st.ot[md][1] = (f32x4){0.f, 0.f, 0.f, 0.f}; }
    st.m[0] = st.m[1] = -1e30f; st.l[0] = st.l[1] = 0.f;
}
__device__ __forceinline__ void attn_item(unsigned char* ws, LAS unsigned char* lds, int hkv, int qb) {
    int tid = ltid(); asm volatile("" : "+v"(tid)); const int w = tid >> 6, lane = tid & 63, l16 = lane & 15, g4 = lane >> 4;
    const bf16_t* QB = (const bf16_t*)(ws + OFF_QB); const bf16_t* KVTOK = (const bf16_t*)(ws + OFF_KVTOK); const bf16_t* KVT = (const bf16_t*)(ws + OFF_KVT);
    const bf16_t* KC = (const bf16_t*)(ws + OFF_KCMP); const bf16_t* VC = (const bf16_t*)(ws + OFF_VCMPT);
    const float* gates = (const float*)(ws + OFF_GATES); float* oacc = (float*)(ws + OFF_OACC); bf16_t* att = (bf16_t*)(ws + OFF_ATT);
    int tpos[2]; bf16x8 qf[2][4];
#pragma unroll
    for (int nt = 0; nt < 2; ++nt) { tpos[nt] = qb * 64 + w * 8 + nt * 4 + (l16 >> 2); const bf16_t* qp = QB + (size_t)tpos[nt] * 2048 + (hkv * 4 + (l16 & 3)) * 128 + g4 * 8;
#pragma unroll
        for (int ks = 0; ks < 4; ++ks) qf[nt][ks] = *(const bf16x8*)(qp + ks * 32); }
    __syncthreads();
    { LAS float* pp = (LAS float*)(lds + A_PSL) + w * 2048;
#pragma unroll
      for (int i = 0; i < 32; ++i) pp[lane + 64 * i] = 0.f; }
    AttnState st; float mfin[2] = {0.f, 0.f}, linv[2] = {0.f, 0.f};
    const int ncmp_tiles = (4 * qb + 3 + 63) >> 6;
    attn_reset(st);
    attn_tiles<0>(lds, KC + (size_t)hkv * 1024 * 128, 128, VC, 1024, 0, ncmp_tiles, qf, st, tpos, qb, w, lane, mfin, linv);
#pragma unroll
    for (int nt = 0; nt < 2; ++nt) { float l = st.l[nt]; l += shx(l, 16, lane); l += shx(l, 32, lane); mfin[nt] = st.m[nt]; linv[nt] = (l > 0.f) ? 1.0f / l : 0.f; }
    attn_reset(st);
    attn_tiles<1>(lds, KC + (size_t)hkv * 1024 * 128, 128, VC + (size_t)hkv * 128 * 1024, 1024, 0, ncmp_tiles, qf, st, tpos, qb, w, lane, mfin, linv);
    attn_finish<0>(st, gates, oacc, att, tpos, hkv, lane);
    __syncthreads();
    {
        LAS unsigned* sel = (LAS unsigned*)(lds + A_SEL) + w * 64;
        if (qb < 16) {
            if (lane < 8) { for (int tk = 0; tk < 8; ++tk) { const int lo = lane * 32; unsigned wd = 0; if (qb >= lo + 31) wd = 0xffffffffu; else if (qb >= lo) wd = (2u << (qb - lo)) - 1u; sel[tk * 8 + lane] = wd; } }
        } else {
            for (int tk = 0; tk < 8; ++tk) {
                const LAS float* pp = (const LAS float*)(lds + A_PSL) + (w * 8 + tk) * 256;
                unsigned key[4]; bool forced[4];
#pragma unroll
                for (int i = 0; i < 4; ++i) { const int j = lane + 64 * i; const float sc = pp[j]; const bool elig = (j >= 1) && (j <= qb - 2);
                    forced[i] = (j == 0) || (j == qb) || (j == qb - 1); key[i] = elig ? (__float_as_uint(sc) + 1u) : 0u; }
                unsigned prefix = 0u;
                for (int bit = 30; bit >= 0; --bit) { const unsigned cand = prefix | (1u << bit); int cnt = 0;
#pragma unroll
                    for (int i = 0; i < 4; ++i) cnt += __popcll(__ballot(key[i] >= cand));
                    if (cnt >= 13) prefix = cand; }
                int cgt = 0;
#pragma unroll
                for (int i = 0; i < 4; ++i) cgt += __popcll(__ballot(key[i] > prefix));
                const int need = 13 - cgt; int base = 0;
#pragma unroll
                for (int i = 0; i < 4; ++i) { const unsigned long long eqm = __ballot(key[i] == prefix);
                    const int rank = base + (int)__builtin_amdgcn_mbcnt_hi((unsigned)(eqm >> 32), __builtin_amdgcn_mbcnt_lo((unsigned)eqm, 0u));
                    const bool taken = forced[i] || (key[i] > prefix) || (key[i] == prefix && rank < need);
                    const unsigned long long bal = __ballot(taken); if (lane == 0) { sel[tk * 8 + 2 * i] = (unsigned)bal; sel[tk * 8 + 2 * i + 1] = (unsigned)(bal >> 32); }
                    base += __popcll(eqm); }
            }
        }
    }
    __syncthreads();
    attn_reset(st);
    attn_tiles_slc2(lds, KVTOK + 2 * 512 + hkv * 128, 2048, KVT + (size_t)(hkv * 128) * S_, S_, qb + 1, qf, st, tpos, qb, w, lane, mfin, linv);
    attn_finish<1>(st, gates, oacc, att, tpos, hkv, lane);
    attn_reset(st);
    attn_tiles<3>(lds, KVTOK + 3 * 512 + hkv * 128, 2048, KVT + (size_t)(512 + hkv * 128) * S_, S_, (qb - 8) > 0 ? (qb - 8) : 0, qb + 1, qf, st, tpos, qb, w, lane, mfin, linv);
    attn_finish<2>(st, gates, oacc, att, tpos, hkv, lane);
}
__device__ __forceinline__ void attn_phase(unsigned char* ws, LAS unsigned char* lds) {
#pragma nounroll
    for (int it = blockIdx.x; it < 1024; it += gridDim.x) {
        const int c = it & 255, r = it >> 8;
        attn_item(ws, lds, r, (r & 1) ? 255 - c : c);
    }
}


#define XB_TMO      128
#define XB_XCNT(j)  (256  + 64 * (j))
#define XB_XSUB(j)  (1280 + 64 * (j))
#define XB_XGEN(j)  (2304 + 64 * (j))
#define XB_TOP      3328
#define XB_TOPGEN   3392
#define XCD_BAR_WORDS 3456
#define XB_SPIN_CAP (1u << 22)
__device__ __forceinline__ unsigned xb_ld(unsigned* p)              { return __hip_atomic_load(p, __ATOMIC_RELAXED, __HIP_MEMORY_SCOPE_AGENT); }
__device__ __forceinline__ unsigned xb_add(unsigned* p, unsigned v) { return __hip_atomic_fetch_add(p, v, __ATOMIC_RELAXED, __HIP_MEMORY_SCOPE_AGENT); }
__device__ __forceinline__ unsigned xb_xcc_id() { return (unsigned)__builtin_amdgcn_s_getreg((3 << 11) | 20) & 0xFu; }
#define XB_SPIN(cond, bar) do { unsigned _sp = 0; while (cond) { __builtin_amdgcn_s_sleep(1); \
    if ((++_sp & 255u) == 0u) { if (xb_ld(&(bar)[XB_TMO])) break; if (_sp > XB_SPIN_CAP) { atomicAdd(&(bar)[XB_TMO], 1u); break; } } } } while (0)
struct XcdBarrier { unsigned* bar; unsigned x; volatile LAS unsigned* st; };
__device__ __forceinline__ XcdBarrier xcd_barrier_post(unsigned* bar, volatile LAS unsigned* st) {
    XcdBarrier b; b.bar = bar; b.x = xb_xcc_id(); b.st = st;
    if (threadIdx.x == 0) (void)xb_add(&bar[XB_XCNT(b.x)], 1u);
    return b;
}
__device__ __forceinline__ void xcd_barrier_complete(unsigned* bar, unsigned x, unsigned& nloc, unsigned& nx) {
    const unsigned G = gridDim.x * gridDim.y * gridDim.z;
    unsigned sum, cnt, mine, sp = 0u;
    for (;;) {
        sum = 0u; cnt = 0u; mine = 0u;
#pragma unroll
        for (unsigned j = 0; j < 16; ++j) { const unsigned c = xb_ld(&bar[XB_XCNT(j)]); sum += c; cnt += (c > 0u) ? 1u : 0u; mine = (j == x) ? c : mine; }
        if (sum == G) break;
        __builtin_amdgcn_s_sleep(1);
        if ((++sp & 255u) == 0u) { if (xb_ld(&bar[XB_TMO])) break; if (sp > XB_SPIN_CAP) { atomicAdd(&bar[XB_TMO], 1u); break; } }
    }
    nloc = mine > 0u ? mine : 1u; nx = cnt > 0u ? cnt : 1u;
}
__device__ __forceinline__ void xcd_barrier(const XcdBarrier& b) {
    asm volatile("s_waitcnt vmcnt(0)" ::: "memory");
    __syncthreads();
    if (threadIdx.x == 0) {
        unsigned* bar = b.bar;
        __builtin_amdgcn_s_waitcnt(0);
        unsigned nloc = b.st[0], nx = b.st[1];
        if (nloc == 0u) { xcd_barrier_complete(bar, b.x, nloc, nx); b.st[0] = nloc; b.st[1] = nx; }
        const unsigned old = xb_add(&bar[XB_XSUB(b.x)], 1u);
        const unsigned gen = old / nloc;
        if (old + 1u == (gen + 1u) * nloc) {
            __builtin_amdgcn_fence(__ATOMIC_RELEASE, "agent");
            asm volatile("s_waitcnt vmcnt(0)" ::: "memory");
            const unsigned og = xb_add(&bar[XB_TOP], 1u);
            const unsigned tg = og / nx;
            if (og + 1u == (tg + 1u) * nx) xb_add(&bar[XB_TOPGEN], 1u);
            else XB_SPIN(xb_ld(&bar[XB_TOPGEN]) == tg, bar);
            __builtin_amdgcn_fence(__ATOMIC_ACQUIRE, "agent");
            xb_add(&bar[XB_XGEN(b.x)], 1u);
            asm volatile("s_waitcnt vmcnt(0)" ::: "memory");
        } else {
            XB_SPIN(xb_ld(&bar[XB_XGEN(b.x)]) == gen, bar);
            __builtin_amdgcn_fence(__ATOMIC_ACQUIRE, "agent");
            asm volatile("s_waitcnt vmcnt(0)" ::: "memory");
        }
    }
    __syncthreads();
}

constexpr int NPH = 23;
__device__ __forceinline__ void run_phase(CP p, int ph, int b, LAS unsigned char* lds) {
    asm volatile("" : "+s"(p));
    unsigned char* ws = p->ws;
    const float* xb = p->x + (size_t)b * S_ * D_; float* hb = p->out + (size_t)b * S_ * D_;
    bf16_t* XN = (bf16_t*)(ws + OFF_XN);
    const int layer = (ph >= 13) ? 1 : 0;
    switch (ph) {
    case 0: prep_phase(p, lds); break;
    case 1: rmsnorm_phase(xb, p->norm_mix, XN, nullptr, nullptr); break;
    case 2: {
        Prob2D<EpiQK> g1{(const char*)XN, (const char*)(ws + OFF_W_RIN), 4096u, 4096u, 32, 64, 16, EpiQK{(bf16_t*)(ws + OFF_Q), (bf16_t*)(ws + OFF_K), (bf16_t*)(ws + OFF_KTD), (const float2*)(ws + OFF_ROPE)}};
        gemm_phase(lds, g1);
        Prob2D<EpiStore> g2{(const char*)(ws + OFF_W_RIN) + (size_t)4096 * 4096, (const char*)XN, 4096u, 4096u, 32, 16, 64, EpiStore{(bf16_t*)(ws + OFF_VT), (size_t)S_}};
        gemm_phase(lds, g2);
    } break;
    case 3: {
        ProbKV g3{(const char*)(ws + OFF_VT), (const char*)(ws + OFF_KTD), (bf16_t*)(ws + OFF_ST), 4};
        gemm_phase(lds, g3);
        ProbS g4{(const char*)(ws + OFF_Q), (const char*)(ws + OFF_K), (bf16_t*)(ws + OFF_SD), 4};
        gemm_phase(lds, g4);
    } break;
    case 4: scan_phase((bf16_t*)(ws + OFF_ST)); break;
    case 5: {
        ProbOut g5{(const char*)(ws + OFF_Q), (const char*)(ws + OFF_ST), (long)OFF_SD - (long)OFF_Q, (long)OFF_VT - (long)OFF_ST, (bf16_t*)(ws + OFF_Y), 8};
        gemm_phase(lds, g5);
    } break;
    case 6: gn_phase((bf16_t*)(ws + OFF_Y), p->ret_gn); break;
    case 7: {
        Prob2D<EpiGate> g6{(const char*)XN, (const char*)(ws + OFF_W_RIN) + (size_t)8192 * 4096, 4096u, 4096u, 32, 64, 16, EpiGate{(bf16_t*)(ws + OFF_Y)}};
        gemm_phase(lds, g6);
    } break;
    case 8: {
        Prob2D<EpiRes> g7{(const char*)(ws + OFF_Y), (const char*)(ws + OFF_W_ROUT), 8192u, 8192u, 64, 64, 8, EpiRes{xb, hb, XN, (float*)(ws + OFF_SS) + (size_t)(b * 4 + 0) * S_}};
        gemm_phase(lds, g7);
    } break;
    case 10: case 20: {
        Prob2D<EpiStoreRS> g8{(const char*)XN, (const char*)(ws + OFF_W_FIN + (size_t)layer * 32 * MiB), 4096u, 4096u, 32, 64, 32, EpiStoreRS{(bf16_t*)(ws + OFF_U), (size_t)8192, (const float*)(ws + OFF_SS) + (size_t)(b * 4 + (layer ? 2 : 0)) * S_}};
        gemm_phase(lds, g8);
    } break;
    case 11: case 21: conv_phase((const bf16_t*)(ws + OFF_U), (bf16_t*)(ws + OFF_AB), p->ffn_conv_w + (size_t)layer * 3 * 8192, p->ffn_conv_b + (size_t)layer * 8192); break;
    case 12: case 22: {
        Prob2D<EpiRes> g9{(const char*)(ws + OFF_AB), (const char*)(ws + OFF_W_FOUT + (size_t)layer * 16 * MiB), 8192u, 8192u, 64, 64, 8, EpiRes{hb, hb, layer ? (bf16_t*)nullptr : XN, layer ? (float*)nullptr : (float*)(ws + OFF_SS) + (size_t)(b * 4 + 1) * S_}};
        gemm_phase(lds, g9);
    } break;
    case 14: {
        const float* ss1 = (const float*)(ws + OFF_SS) + (size_t)(b * 4 + 1) * S_;
        Prob2D<EpiStoreRS> g10{(const char*)XN, (const char*)(ws + OFF_W_KV), 4096u, 4096u, 32, 64, 8, EpiStoreRS{(bf16_t*)(ws + OFF_KVTOK), (size_t)2048, ss1}};
        gemm_phase(lds, g10);
        Prob2D<EpiStoreCS> g11{(const char*)(ws + OFF_W_KV) + (size_t)2048 * 4096, (const char*)XN, 4096u, 4096u, 32, 4, 64, EpiStoreCS{(bf16_t*)(ws + OFF_KVT), (size_t)S_, ss1}};
        gemm_phase(lds, g11);
    } break;
    case 15: {
        ProbCmp1 a{(const char*)(ws + OFF_KVTOK), (const char*)(ws + OFF_W_C1K), 8192u, 64, 16, EpiGelu{(bf16_t*)(ws + OFF_H1), (const float*)(ws + OFF_PEB)}};
        gemm_phase(lds, a, (int)gridDim.x - 32);
        ProbCmp1 v{(const char*)(ws + OFF_KVTOK) + 1024, (const char*)(ws + OFF_W_C1V), 8192u, 64, 16, EpiGelu{(bf16_t*)(ws + OFF_H1) + 4096 * 256, (const float*)(ws + OFF_PEB) + 256}};
        gemm_phase(lds, v, (int)gridDim.x - 16);
        Prob2D<EpiQproj> g12{(const char*)XN, (const char*)(ws + OFF_W_Q), 4096u, 4096u, 32, 64, 9, EpiQproj{(bf16_t*)(ws + OFF_QB), (float*)(ws + OFF_GATES), (const float*)(ws + OFF_SS) + (size_t)(b * 4 + 1) * S_}};
        gemm_phase(lds, g12);
    } break;
    case 16: {
        Prob2D<EpiKcmp> a{(const char*)(ws + OFF_H1), (const char*)(ws + OFF_W_C2K), 512u, 512u, 4, 16, 1, EpiKcmp{(bf16_t*)(ws + OFF_KCMP)}};
        gemm_phase(lds, a);
        Prob2D<EpiVcmp> v{(const char*)(ws + OFF_W_C2V), (const char*)(ws + OFF_H1) + (size_t)4096 * 256 * 2, 512u, 512u, 4, 1, 16, EpiVcmp{(bf16_t*)(ws + OFF_VCMPT)}};
        gemm_phase(lds, v);
    } break;
    case 17: attn_phase(ws, lds); break;
    case 18: {
        Prob2D<EpiRes> g{(const char*)(ws + OFF_ATT), (const char*)(ws + OFF_W_O), 4096u, 4096u, 32, 64, 8, EpiRes{hb, hb, XN, (float*)(ws + OFF_SS) + (size_t)(b * 4 + 2) * S_}};
        gemm_phase(lds, g);
    } break;
    case 23: finalnorm_phase(hb, p->final_gain); break;
    default: break;
    }
}

#if MULTI
__global__ void __launch_bounds__(512) phase_kernel(Params p, int ph, int b) {
    extern __shared__ __attribute__((aligned(16))) unsigned char shm[];
    run_phase((CP)__builtin_amdgcn_kernarg_segment_ptr(), ph, b, (LAS unsigned char*)shm);
}
#else
__global__ void __launch_bounds__(512) mega_kernel(Params p) {
    extern __shared__ __attribute__((aligned(16))) unsigned char shm[];
    cg::grid_group grid = cg::this_grid();
    CP cp = (CP)__builtin_amdgcn_kernarg_segment_ptr();
    volatile LAS unsigned* st = (volatile LAS unsigned*)((LAS unsigned char*)shm + LDS_ST);
    if (threadIdx.x == 0) { st[0] = 0u; st[1] = 0u; st[2] = 0u; st[3] = 0u; }
    __syncthreads();
    XcdBarrier xb = xcd_barrier_post((unsigned*)(cp->ws + OFF_BAR), st);
    run_phase(cp, 0, 0, (LAS unsigned char*)shm);
    grid.sync();
    for (int b = 0; b < 2; ++b)
        for (int ph = 1; ph <= NPH; ++ph) {
            if (ph == 9 || ph == 13 || ph == 19) continue;
#ifdef PROBE_PH
            const int reps = (ph == PROBE_PH || ph == PROBE_PH2) ? 2 : 1;
#else
            const int reps = 1;
#endif
            for (int rep = 0; rep < reps; ++rep) { run_phase(cp, ph, b, (LAS unsigned char*)shm); xcd_barrier(xb); } }
}
#endif

constexpr int LDS_BYTES = LDS_ST + 16;
extern "C" void kernel_launch(void* const* d_in, const int* in_sizes, int n_in, void* d_out, int out_size, void* d_ws, size_t ws_size, hipStream_t stream) {
    static int grid = 0;
    if (grid == 0) {
        if (n_in != 21 || out_size != 2 * S_ * D_ || ws_size < WS_NEED) { fprintf(stderr, "kernel_launch: unexpected shapes/ws (n_in %d out %d ws %zu need %zu)\n", n_in, out_size, ws_size, (size_t)WS_NEED); grid = -1; return; }
#if MULTI
        if (hipFuncSetAttribute((const void*)phase_kernel, hipFuncAttributeMaxDynamicSharedMemorySize, LDS_BYTES) != hipSuccess) { fprintf(stderr, "hipFuncSetAttribute failed\n"); grid = -1; return; }
#else
        if (hipFuncSetAttribute((const void*)mega_kernel, hipFuncAttributeMaxDynamicSharedMemorySize, LDS_BYTES) != hipSuccess) { fprintf(stderr, "hipFuncSetAttribute failed\n"); grid = -1; return; }
#endif
        int dev = 0, cus = 0; hipGetDevice(&dev); hipDeviceGetAttribute(&cus, hipDeviceAttributeMultiprocessorCount, dev);
        grid = cus > 0 ? cus : 256;
    }
    if (grid < 0) return;
    Params p{};
    const float** pp = (const float**)&p;
    for (int i = 0; i < 21; ++i) pp[i] = (const float*)d_in[i];
    p.out = (float*)d_out; p.ws = (unsigned char*)d_ws;
#if MULTI
    hipLaunchKernelGGL(phase_kernel, dim3(grid), dim3(512), LDS_BYTES, stream, p, 0, 0);
    for (int b = 0; b < 2; ++b)
        for (int ph = 1; ph <= NPH; ++ph) hipLaunchKernelGGL(phase_kernel, dim3(grid), dim3(512), LDS_BYTES, stream, p, ph, b);
#else
    if (hipMemsetAsync((unsigned char*)d_ws + OFF_BAR, 0, XCD_BAR_WORDS * 4, stream) != hipSuccess) { fprintf(stderr, "memset failed\n"); return; }
    void* args[] = {&p};
    hipError_t e = hipLaunchCooperativeKernel((const void*)mega_kernel, dim3(grid), dim3(512), args, LDS_BYTES, stream);
    if (e != hipSuccess) fprintf(stderr, "cooperative launch failed: %s (grid %d)\n", hipGetErrorString(e), grid);
#endif
}
```

```cpp
#include <hip/hip_runtime.h>
#include <hip/hip_cooperative_groups.h>
#include <cstdio>
namespace cg = cooperative_groups;

#ifndef MULTI
#define MULTI 0
#endif

#define LAS __attribute__((address_space(3)))
typedef unsigned short bf16_t;
typedef short bf16x8 __attribute__((ext_vector_type(8)));
typedef float f32x4 __attribute__((ext_vector_type(4)));
typedef unsigned u32x2 __attribute__((ext_vector_type(2)));
typedef unsigned u32x4 __attribute__((ext_vector_type(4)));

constexpr int S_ = 16384, D_ = 2048;
constexpr size_t MiB = 1048576;
constexpr size_t OFF_W_RIN = 0, OFF_W_ROUT = 48 * MiB, OFF_W_KV = 64 * MiB, OFF_W_C1K = 76 * MiB, OFF_W_C1V = 78 * MiB,
                 OFF_W_C2K = 80 * MiB, OFF_W_C2V = 80 * MiB + 131072, OFF_W_Q = 81 * MiB, OFF_W_O = 90 * MiB,
                 OFF_W_FIN = 98 * MiB  , OFF_W_FOUT = 162 * MiB  , OFF_ROPE = 194 * MiB, OFF_PEB = 210 * MiB, OFF_BAR = 210 * MiB + 65536, OFF_SS = 210 * MiB + 131072  ,
                 OFF_XN = 211 * MiB, OFF_ACT = 275 * MiB;
constexpr size_t OFF_Q = OFF_ACT, OFF_K = OFF_ACT + 64 * MiB, OFF_KTD = OFF_ACT + 128 * MiB, OFF_VT = OFF_ACT + 192 * MiB,
                 OFF_ST = OFF_ACT + 320 * MiB, OFF_SD = OFF_ACT + 448 * MiB, OFF_Y = OFF_ACT + 512 * MiB, WS_NEED = OFF_ACT + 640 * MiB;
constexpr size_t OFF_U = OFF_ACT, OFF_AB = OFF_ACT + 256 * MiB;
constexpr size_t OFF_HN = OFF_ACT, OFF_KVTOK = OFF_ACT + 64 * MiB, OFF_KVT = OFF_ACT + 129 * MiB, OFF_QB = OFF_ACT + 161 * MiB,
                 OFF_GATES = OFF_ACT + 225 * MiB, OFF_H1 = OFF_ACT + 229 * MiB, OFF_KCMP = OFF_ACT + 233 * MiB, OFF_VCMPT = OFF_ACT + 234 * MiB,
                 OFF_ATT = OFF_ACT + 235 * MiB, OFF_OACC = OFF_ACT + 299 * MiB;

struct Params {
    const float* x; const float* norm_mix; const float* norm_ffn; const float* ret_w_in; const float* ret_gn; const float* ret_w_out;
    const float* kv_gain; const float* w_kv; const float* pe_k; const float* w1_k; const float* w2_k; const float* pe_v; const float* w1_v;
    const float* w2_v; const float* w_q; const float* w_o; const float* ffn_w_in; const float* ffn_conv_w; const float* ffn_conv_b;
    const float* ffn_w_out; const float* final_gain; float* out; unsigned char* ws;
};

typedef const __attribute__((address_space(4))) Params* CP;
__device__ __forceinline__ int ltid() { int t = threadIdx.x; asm volatile("" : "+v"(t)); return t; }
__device__ __forceinline__ unsigned pk_bf16(float lo, float hi) { unsigned r; asm("v_cvt_pk_bf16_f32 %0, %1, %2" : "=v"(r) : "v"(lo), "v"(hi)); return r; }
__device__ __forceinline__ float bflo(unsigned v) { return __uint_as_float(v << 16); }
__device__ __forceinline__ float bfhi(unsigned v) { return __uint_as_float(v & 0xffff0000u); }
__device__ __forceinline__ float fexp2(float x) { return __builtin_amdgcn_exp2f(x); }
__device__ __forceinline__ float frcp(float x) { return __builtin_amdgcn_rcpf(x); }
__device__ __forceinline__ float log2gamma(int h) { return log2f(1.0f - exp2f(-5.0f - (float)h)); }
__device__ __forceinline__ float sigmoidf_(float x) { return frcp(1.0f + fexp2(-1.4426950408889634f * x)); }

__device__ __forceinline__ float shx(float v, int m, int lane) { return __int_as_float(__builtin_amdgcn_ds_bpermute((lane ^ m) << 2, __float_as_int(v))); }
__device__ __forceinline__ unsigned long long shx64(unsigned long long v, int m, int lane) {
    const unsigned lo = (unsigned)__builtin_amdgcn_ds_bpermute((lane ^ m) << 2, (int)(unsigned)v), hi = (unsigned)__builtin_amdgcn_ds_bpermute((lane ^ m) << 2, (int)(unsigned)(v >> 32));
    return ((unsigned long long)hi << 32) | lo; }
__device__ __forceinline__ float wave_sum(float v, int lane) {
#pragma unroll
    for (int o = 32; o >= 1; o >>= 1) v += shx(v, o, lane);
    return v;
}
constexpr int HTB = 128 * 64 * 2;
__device__ __forceinline__ int lds_byte(int r, int c) { const int st = (r >> 4) * 2 + (c >> 5), rr = r & 15, cc = c & 31, ob = rr * 64 + cc * 2; return st * 1024 + (ob ^ (((ob >> 9) & 1) << 5)); }
__device__ __forceinline__ void stage_rc(int b, int& R, int& C) { const int st = b / 1024, sb = b % 1024, swz = sb ^ (((sb >> 9) & 1) << 5); R = (st >> 1) * 16 + swz / 64; C = (st & 1) * 32 + (swz % 64) / 2; }
__device__ __forceinline__ void tile_order(int L, int nM, int nN, int& pm, int& pn) {
    const int nwg = nM * nN; int wgid = L;
    { const int q = nwg / 8, r = nwg % 8, xcd = wgid % 8, off = wgid / 8; wgid = (xcd < r ? xcd * (q + 1) : r * (q + 1) + (xcd - r) * q) + off; }
    const int nig = 8 * nN, gid = wgid / nig, fm = gid * 8, gsz = (nM - fm) < 8 ? (nM - fm) : 8;
    pm = fm + ((wgid % nig) % gsz); pn = (wgid % nig) / gsz;
}
struct UInfo { const char* a; const char* b; int r0, c0, x0, x1; };
typedef f32x4 AccT[2][2][4][2];

template <class P>
__device__ __forceinline__ void gemm_phase(LAS unsigned char* lds, const P& pb, int cofs = 0) {
    const int tid = ltid(), wid = __builtin_amdgcn_readfirstlane(tid >> 6), lane = tid & 63, wr = wid >> 2, wc = wid & 3, fr = lane & 15, fq = lane >> 4;
    const int nt = pb.nt, G = gridDim.x, c = (int)blockIdx.x - cofs; const long nun = pb.nunits();
    if (c < 0 || c >= nun) return;
    unsigned voffA[2], voffB[2];
#pragma unroll
    for (int i = 0; i < 2; ++i) { int R, C; stage_rc(tid * 16 + i * 8192, R, C); voffA[i] = pb.rowA(R) + (unsigned)C * 2u; const int rho = R & 31; const int Rb = P::PERM ? ((R & ~31) + 8 * ((rho & 15) >> 2) + 4 * (rho >> 4) + (rho & 3)) : R; voffB[i] = (unsigned)Rb * pb.ldb + (unsigned)C * 2u; }
    const size_t hsA = pb.rowA(128), hsB = (size_t)128 * pb.ldb;
    const unsigned ldsw = (unsigned)wid * 1024u;
    const int aoff = lds_byte(wr * 64 + fr, fq * 8), boff = lds_byte(wc * 32 + fr, fq * 8);
#define G_SA(b, h) (((b) * 2 + (h)) * HTB)
#define G_SB(b, h) ((4 + (b) * 2 + (h)) * HTB)
#define G_STAGE(bufoff, gbase, voff) do { _Pragma("unroll") for (int _i = 0; _i < 2; ++_i) \
        __builtin_amdgcn_global_load_lds((const unsigned*)((const char*)(gbase) + (voff)[_i]), (LAS unsigned*)(lds + (bufoff) + ldsw + _i * 8192), 16, 0, 0); } while (0)
#define G_LDA(dst, b, h) do { _Pragma("unroll") for (int m = 0; m < 4; ++m) _Pragma("unroll") for (int k = 0; k < 2; ++k) dst[m][k] = *(const LAS bf16x8*)(lds + G_SA(b, h) + aoff + m * 2048 + k * 1024); } while (0)
#define G_LDB(dst, b, h) do { _Pragma("unroll") for (int n = 0; n < 2; ++n) _Pragma("unroll") for (int k = 0; k < 2; ++k) dst[n][k] = *(const LAS bf16x8*)(lds + G_SB(b, h) + boff + n * 2048 + k * 1024); } while (0)
#define G_MMA(ai, bj, At, Bt) do { __builtin_amdgcn_s_setprio(1); _Pragma("unroll") for (int m = 0; m < 4; ++m) _Pragma("unroll") for (int n = 0; n < 2; ++n) _Pragma("unroll") for (int k = 0; k < 2; ++k) \
        acc[ai][bj][m][n] = __builtin_amdgcn_mfma_f32_16x16x32_bf16(Bt[n][k], At[m][k], acc[ai][bj][m][n], 0, 0, 0); __builtin_amdgcn_s_setprio(0); } while (0)
#define G_WAIT_V(n) asm volatile("s_waitcnt vmcnt(" #n ")" ::: "memory")
#define G_WAIT_L(n) asm volatile("s_waitcnt lgkmcnt(" #n ")" ::: "memory")
#define G_BAR __builtin_amdgcn_s_barrier()
#define G_SCHED __builtin_amdgcn_sched_barrier(0)
    UInfo cur, nxt; int ui = 0;
    pb.unit(c, cur);
    AccT acc;
#pragma unroll
    for (int a = 0; a < 2; ++a)
#pragma unroll
        for (int b = 0; b < 2; ++b)
#pragma unroll
            for (int m = 0; m < 4; ++m)
#pragma unroll
                for (int n = 0; n < 2; ++n) acc[a][b][m][n] = (f32x4){0.f, 0.f, 0.f, 0.f};
    bf16x8 At[4][2], B0[2][2], B1[2][2];
    const char* cA = cur.a; const char* cB = cur.b;
    G_STAGE(G_SB(0, 0), cB + pb.bK(0), voffB); G_STAGE(G_SA(0, 0), cA + pb.aK(0), voffA); G_STAGE(G_SB(0, 1), cB + hsB + pb.bK(0), voffB); G_STAGE(G_SA(0, 1), cA + hsA + pb.aK(0), voffA);
    if (wr == 1) G_BAR;
    G_WAIT_V(4); G_BAR;
    G_STAGE(G_SB(1, 0), cB + pb.bK(1), voffB); G_STAGE(G_SA(1, 0), cA + pb.aK(1), voffA); G_STAGE(G_SB(1, 1), cB + hsB + pb.bK(1), voffB);
    G_WAIT_V(6); G_BAR;
    for (;;) {
        const long Ln = (long)(ui + 1) * G + c; const bool has_next = Ln < nun;
        if (has_next) pb.unit(Ln, nxt);
        const char* nA = has_next ? nxt.a : cA; const char* nB = has_next ? nxt.b : cB;
        for (int t = 0; t < nt; t += 2) {
            const bool last = (t == nt - 2);
            const char* a1 = cA + pb.aK(t + 1);
            const char* a2 = last ? nA + pb.aK(0) : cA + pb.aK(t + 2); const char* b2 = last ? nB + pb.bK(0) : cB + pb.bK(t + 2);
            const char* a3 = last ? nA + pb.aK(1) : cA + pb.aK(t + 3); const char* b3 = last ? nB + pb.bK(1) : cB + pb.bK(t + 3);
            G_LDB(B0, 0, 0); G_SCHED; G_LDA(At, 0, 0); G_STAGE(G_SA(1, 1), a1 + hsA, voffA);
            G_WAIT_L(8); G_BAR; G_WAIT_L(0); G_MMA(0, 0, At, B0); G_BAR; G_SCHED;
            G_LDB(B1, 0, 1); G_STAGE(G_SB(0, 0), b2, voffB);
            G_BAR; G_WAIT_L(0); G_MMA(0, 1, At, B1); G_BAR;
            G_LDA(At, 0, 1); G_STAGE(G_SA(0, 0), a2, voffA);
            G_BAR; G_WAIT_L(0); G_MMA(1, 0, At, B0); G_BAR; G_SCHED;
            G_STAGE(G_SB(0, 1), b2 + hsB, voffB);
            G_WAIT_V(6); G_BAR; G_MMA(1, 1, At, B1); G_BAR;
            G_LDB(B0, 1, 0); G_SCHED; G_LDA(At, 1, 0); G_STAGE(G_SA(0, 1), a2 + hsA, voffA);
            G_WAIT_L(8); G_BAR; G_WAIT_L(0); G_MMA(0, 0, At, B0); G_BAR; G_SCHED;
            G_LDB(B1, 1, 1); G_STAGE(G_SB(1, 0), b3, voffB);
            G_BAR; G_WAIT_L(0); G_MMA(0, 1, At, B1); G_BAR;
            G_LDA(At, 1, 1); G_STAGE(G_SA(1, 0), a3, voffA);
            G_BAR; G_WAIT_L(0); G_MMA(1, 0, At, B0); G_BAR; G_SCHED;
            G_STAGE(G_SB(1, 1), b3 + hsB, voffB);
            G_WAIT_V(6); G_BAR; G_MMA(1, 1, At, B1); G_BAR;
        }
        { const int l2 = ltid() & 63; pb.epi(acc, cur, wr, wc, l2 & 15, l2 >> 4); }
        if (!has_next) break;
#pragma unroll
        for (int a = 0; a < 2; ++a)
#pragma unroll
            for (int b = 0; b < 2; ++b)
#pragma unroll
                for (int m = 0; m < 4; ++m)
#pragma unroll
                    for (int n = 0; n < 2; ++n) acc[a][b][m][n] = (f32x4){0.f, 0.f, 0.f, 0.f};
        cur = nxt; cA = nA; cB = nB; ++ui;
    }
    G_WAIT_V(0);
    if (wr == 0) G_BAR;
    G_BAR;
}

#define EPI_ROWS for (int ai = 0; ai < 2; ++ai) for (int m = 0; m < 4; ++m)
#define EPI_COLS for (int bj = 0; bj < 2; ++bj) for (int n = 0; n < 2; ++n)
#define EPI_ROW (128 * ai + 64 * wr + 16 * m + fr)
#define EPI_COL (128 * bj + 32 * wc + 16 * n + 4 * fq)

template <class Epi> struct Prob2D {
    static constexpr bool PERM = Epi::PERM;
    const char* A; const char* B; unsigned lda, ldb; int nt, nM, nN; Epi e;
    __device__ __forceinline__ long nunits() const { return (long)nM * nN; }
    __device__ __forceinline__ unsigned rowA(int R) const { return (unsigned)R * lda; }
    __device__ __forceinline__ void unit(long L, UInfo& u) const { int pm, pn; tile_order((int)L, nM, nN, pm, pn); u.a = A + (size_t)pm * 256 * lda; u.b = B + (size_t)pn * 256 * ldb; u.r0 = pm * 256; u.c0 = pn * 256; u.x0 = 0; u.x1 = 0; }
    __device__ __forceinline__ size_t aK(int kt) const { return (size_t)kt * 128; }
    __device__ __forceinline__ size_t bK(int kt) const { return (size_t)kt * 128; }
    __device__ __forceinline__ void epi(const AccT& acc, const UInfo& u, int wr, int wc, int fr, int fq) const { e(acc, u, wr, wc, fr, fq); }
};
struct EpiStore { static constexpr bool PERM = true; bf16_t* O; size_t ldc;
    __device__ __forceinline__ void operator()(const AccT& acc, const UInfo& u, int wr, int wc, int fr, int fq) const {
#pragma unroll
        EPI_ROWS { bf16_t* rp = O + (size_t)(u.r0 + EPI_ROW) * ldc + u.c0;
#pragma unroll
            for (int bj = 0; bj < 2; ++bj) { const f32x4 v = acc[ai][bj][m][0], v2 = acc[ai][bj][m][1]; *(u32x4*)(rp + 128 * bj + 32 * wc + 8 * fq) = (u32x4){pk_bf16(v[0], v[1]), pk_bf16(v[2], v[3]), pk_bf16(v2[0], v2[1]), pk_bf16(v2[2], v2[3])}; } }
    } };
struct EpiRes { static constexpr bool PERM = false; const float* R; float* O; bf16_t* HB; float* ss;
    __device__ __forceinline__ void operator()(const AccT& acc, const UInfo& u, int wr, int wc, int fr, int fq) const {
#pragma unroll
        EPI_ROWS { const size_t ro = (size_t)(u.r0 + EPI_ROW) * 2048 + u.c0; float sq = 0.f;
#pragma unroll
            EPI_COLS { const f32x4 r = *(const f32x4*)(R + ro + EPI_COL); const f32x4 o = r + acc[ai][bj][m][n]; *(f32x4*)(O + ro + EPI_COL) = o;
                if (HB) { *(u32x2*)(HB + ro + EPI_COL) = (u32x2){pk_bf16(o[0], o[1]), pk_bf16(o[2], o[3])}; sq += o[0] * o[0] + o[1] * o[1] + o[2] * o[2] + o[3] * o[3]; } }
            if (HB) { const int lane = fq * 16 + fr; sq += shx(sq, 16, lane); sq += shx(sq, 32, lane); if (fq == 0) atomicAdd(ss + u.r0 + EPI_ROW, sq); } }
    } };
struct EpiStoreRS { static constexpr bool PERM = true; bf16_t* O; size_t ldc; const float* ss;
    __device__ __forceinline__ void operator()(const AccT& acc, const UInfo& u, int wr, int wc, int fr, int fq) const {
#pragma unroll
        EPI_ROWS { const int row = u.r0 + EPI_ROW; const float rs = rsqrtf(ss[row] * (1.0f / 2048.0f) + 1e-6f); bf16_t* rp = O + (size_t)row * ldc + u.c0;
#pragma unroll
            for (int bj = 0; bj < 2; ++bj) { const f32x4 v = acc[ai][bj][m][0] * rs, v2 = acc[ai][bj][m][1] * rs; *(u32x4*)(rp + 128 * bj + 32 * wc + 8 * fq) = (u32x4){pk_bf16(v[0], v[1]), pk_bf16(v[2], v[3]), pk_bf16(v2[0], v2[1]), pk_bf16(v2[2], v2[3])}; } }
    } };
struct EpiStoreCS { static constexpr bool PERM = true; bf16_t* O; size_t ldc; const float* ss;
    __device__ __forceinline__ void operator()(const AccT& acc, const UInfo& u, int wr, int wc, int fr, int fq) const {
        f32x4 rs[2][2];
#pragma unroll
        for (int bj = 0; bj < 2; ++bj)
#pragma unroll
            for (int n = 0; n < 2; ++n) { const f32x4 s4 = *(const f32x4*)(ss + u.c0 + 128 * bj + 32 * wc + 8 * fq + 4 * n);
#pragma unroll
                for (int j = 0; j < 4; ++j) rs[bj][n][j] = rsqrtf(s4[j] * (1.0f / 2048.0f) + 1e-6f); }
#pragma unroll
        EPI_ROWS { bf16_t* rp = O + (size_t)(u.r0 + EPI_ROW) * ldc + u.c0;
#pragma unroll
            for (int bj = 0; bj < 2; ++bj) { const f32x4 v = acc[ai][bj][m][0] * rs[bj][0], v2 = acc[ai][bj][m][1] * rs[bj][1]; *(u32x4*)(rp + 128 * bj + 32 * wc + 8 * fq) = (u32x4){pk_bf16(v[0], v[1]), pk_bf16(v[2], v[3]), pk_bf16(v2[0], v2[1]), pk_bf16(v2[2], v2[3])}; } }
    } };
struct EpiGate { static constexpr bool PERM = true; bf16_t* Y;
    __device__ __forceinline__ void operator()(const AccT& acc, const UInfo& u, int wr, int wc, int fr, int fq) const {
#pragma unroll
        EPI_ROWS { bf16_t* rp = Y + (size_t)(u.r0 + EPI_ROW) * 4096 + u.c0;
#pragma unroll
            for (int bj = 0; bj < 2; ++bj) { const f32x4 g = acc[ai][bj][m][0], h = acc[ai][bj][m][1]; bf16_t* cp = rp + 128 * bj + 32 * wc + 8 * fq; const u32x4 y = *(const u32x4*)cp;
                const float o0 = g[0] * sigmoidf_(g[0]) * bflo(y[0]), o1 = g[1] * sigmoidf_(g[1]) * bfhi(y[0]), o2 = g[2] * sigmoidf_(g[2]) * bflo(y[1]), o3 = g[3] * sigmoidf_(g[3]) * bfhi(y[1]);
                const float o4 = h[0] * sigmoidf_(h[0]) * bflo(y[2]), o5 = h[1] * sigmoidf_(h[1]) * bfhi(y[2]), o6 = h[2] * sigmoidf_(h[2]) * bflo(y[3]), o7 = h[3] * sigmoidf_(h[3]) * bfhi(y[3]);
                *(u32x4*)cp = (u32x4){pk_bf16(o0, o1), pk_bf16(o2, o3), pk_bf16(o4, o5), pk_bf16(o6, o7)}; } }
    } };
struct EpiQK { static constexpr bool PERM = false; bf16_t* Q; bf16_t* K; bf16_t* KTD; const float2* rope;
    __device__ __forceinline__ void operator()(const AccT& acc, const UInfo& u, int wr, int wc, int fr, int fq) const {
        const int hidx = u.c0 >> 8; const bool isk = hidx >= 8; const int hh = hidx & 7; const float l2g = log2gamma(hh);
        bf16_t* dst = (isk ? K : Q) + hh * 256; const float sc = isk ? 0.0625f : 1.0f;
#pragma unroll
        EPI_ROWS { const int t = u.r0 + EPI_ROW; const float kd = fexp2((float)(255 - (t & 255)) * l2g);
#pragma unroll
            for (int n = 0; n < 2; ++n) { const int dd = 32 * wc + 16 * n + 4 * fq;
                const f32x4 x1 = acc[ai][0][m][n], x2 = acc[ai][1][m][n]; const f32x4 cs0 = *(const f32x4*)(rope + (size_t)t * 128 + dd), cs1 = *(const f32x4*)(rope + (size_t)t * 128 + dd + 2);
                float y1[4], y2[4];
                y1[0] = (x1[0] * cs0[0] - x2[0] * cs0[1]) * sc; y2[0] = (x1[0] * cs0[1] + x2[0] * cs0[0]) * sc;
                y1[1] = (x1[1] * cs0[2] - x2[1] * cs0[3]) * sc; y2[1] = (x1[1] * cs0[3] + x2[1] * cs0[2]) * sc;
                y1[2] = (x1[2] * cs1[0] - x2[2] * cs1[1]) * sc; y2[2] = (x1[2] * cs1[1] + x2[2] * cs1[0]) * sc;
                y1[3] = (x1[3] * cs1[2] - x2[3] * cs1[3]) * sc; y2[3] = (x1[3] * cs1[3] + x2[3] * cs1[2]) * sc;
                *(u32x2*)(dst + (size_t)t * 2048 + dd) = (u32x2){pk_bf16(y1[0], y1[1]), pk_bf16(y1[2], y1[3])};
                *(u32x2*)(dst + (size_t)t * 2048 + 128 + dd) = (u32x2){pk_bf16(y2[0], y2[1]), pk_bf16(y2[2], y2[3])};
                if (isk) {
#pragma unroll
                    for (int j = 0; j < 4; ++j) { KTD[(size_t)(hh * 256 + dd + j) * S_ + t] = (bf16_t)(pk_bf16(y1[j] * kd, 0.f) & 0xffffu); KTD[(size_t)(hh * 256 + 128 + dd + j) * S_ + t] = (bf16_t)(pk_bf16(y2[j] * kd, 0.f) & 0xffffu); }
                } } }
    } };
struct EpiQproj { static constexpr bool PERM = false; bf16_t* QB; float* gates; const float* ss;
    __device__ __forceinline__ void operator()(const AccT& acc, const UInfo& u, int wr, int wc, int fr, int fq) const {
#pragma unroll
        EPI_ROWS { const int t = u.r0 + EPI_ROW; const float rs = rsqrtf(ss[t] * (1.0f / 2048.0f) + 1e-6f);
#pragma unroll
            EPI_COLS { const int col = u.c0 + EPI_COL; const f32x4 v = acc[ai][bj][m][n] * rs;
                if (col < 2048) *(u32x2*)(QB + (size_t)t * 2048 + col) = (u32x2){pk_bf16(v[0] * 0.08838834764831845f, v[1] * 0.08838834764831845f), pk_bf16(v[2] * 0.08838834764831845f, v[3] * 0.08838834764831845f)};
                else if (col < 2096) *(f32x4*)(gates + (size_t)t * 48 + (col - 2048)) = (f32x4){sigmoidf_(v[0]), sigmoidf_(v[1]), sigmoidf_(v[2]), sigmoidf_(v[3])}; } }
    } };
__device__ __forceinline__ float gelu_tanh(float x) { const float y = 0.7978845608028654f * (x + 0.044715f * x * x * x); const float e = fexp2(2.0f * 1.4426950408889634f * y); const float th = 1.0f - 2.0f * frcp(e + 1.0f); return 0.5f * x * (1.0f + th); }
struct EpiGelu { static constexpr bool PERM = false; bf16_t* H; const float* bias;
    __device__ __forceinline__ void operator()(const AccT& acc, const UInfo& u, int wr, int wc, int fr, int fq) const {
#pragma unroll
        EPI_ROWS { bf16_t* rp = H + (size_t)(u.r0 + EPI_ROW) * 256;
#pragma unroll
            EPI_COLS { const int col = EPI_COL; const f32x4 v = acc[ai][bj][m][n]; const f32x4 bb = *(const f32x4*)(bias + col);
                *(u32x2*)(rp + col) = (u32x2){pk_bf16(gelu_tanh(v[0] + bb[0]), gelu_tanh(v[1] + bb[1])), pk_bf16(gelu_tanh(v[2] + bb[2]), gelu_tanh(v[3] + bb[3]))}; } }
    } };
struct EpiKcmp { static constexpr bool PERM = false; bf16_t* KC;
    __device__ __forceinline__ void operator()(const AccT& acc, const UInfo& u, int wr, int wc, int fr, int fq) const {
#pragma unroll
        EPI_ROWS { const int r = u.r0 + EPI_ROW, i = r >> 2, h = r & 3;
#pragma unroll
            for (int n = 0; n < 2; ++n) { const int col = 32 * wc + 16 * n + 4 * fq; f32x4 v = acc[ai][0][m][n]; if (i == 1023) v = (f32x4){0.f, 0.f, 0.f, 0.f};
                *(u32x2*)(KC + ((size_t)h * 1024 + i) * 128 + col) = (u32x2){pk_bf16(v[0], v[1]), pk_bf16(v[2], v[3])}; } }
    } };
struct EpiVcmp { static constexpr bool PERM = false; bf16_t* VC;
    __device__ __forceinline__ void operator()(const AccT& acc, const UInfo& u, int wr, int wc, int fr, int fq) const {
#pragma unroll
        for (int m = 0; m < 4; ++m) { const int d = 64 * wr + 16 * m + fr;
#pragma unroll
            EPI_COLS { const int col = u.c0 + EPI_COL, i = col >> 2; f32x4 v = acc[0][bj][m][n]; if (i == 1023) v = (f32x4){0.f, 0.f, 0.f, 0.f};
#pragma unroll
                for (int h = 0; h < 4; ++h) VC[((size_t)h * 128 + d) * 1024 + i] = (bf16_t)(pk_bf16(v[h], 0.f) & 0xffffu); } }
    } };
struct ProbCmp1 {
    static constexpr bool PERM = false;
    const char* A; const char* B; unsigned ldb; int nt, nM; EpiGelu e;
    __device__ __forceinline__ long nunits() const { return nM; }
    __device__ __forceinline__ unsigned rowA(int R) const { return (unsigned)(R >> 2) * 65536u + (unsigned)(R & 3) * 256u; }
    __device__ __forceinline__ void unit(long L, UInfo& u) const { u.a = A + (size_t)L * 64 * 65536; u.b = B; u.r0 = (int)L * 256; u.c0 = 0; u.x0 = 0; u.x1 = 0; }
    __device__ __forceinline__ size_t aK(int kt) const { return (size_t)(kt >> 1) * 4096 + (size_t)(kt & 1) * 128; }
    __device__ __forceinline__ size_t bK(int kt) const { return (size_t)kt * 128; }
    __device__ __forceinline__ void epi(const AccT& acc, const UInfo& u, int wr, int wc, int fr, int fq) const { e(acc, u, wr, wc, fr, fq); }
};
struct ProbKV {
    static constexpr bool PERM = true;
    const char* VT; const char* KTD; bf16_t* ST; int nt;
    __device__ __forceinline__ long nunits() const { return 8 * 64 * 2; }
    __device__ __forceinline__ unsigned rowA(int R) const { return (unsigned)R * 32768u; }
    static constexpr unsigned ldb = 32768u;
    __device__ __forceinline__ void unit(long L, UInfo& u) const { const int pm = (int)L & 1, c = ((int)L >> 1) & 63, h = (int)L >> 7;
        u.a = VT + ((size_t)(h * 512 + pm * 256) * S_ + c * 256) * 2; u.b = KTD + ((size_t)(h * 256) * S_ + c * 256) * 2; u.r0 = h * 512 + pm * 256; u.c0 = c * 256; u.x0 = 0; u.x1 = 0; }
    __device__ __forceinline__ size_t aK(int kt) const { return (size_t)kt * 128; }
    __device__ __forceinline__ size_t bK(int kt) const { return (size_t)kt * 128; }
    __device__ __forceinline__ void epi(const AccT& acc, const UInfo& u, int wr, int wc, int fr, int fq) const { EpiStore e{ST, (size_t)S_}; e(acc, u, wr, wc, fr, fq); }
};
struct ProbS {
    static constexpr bool PERM = true;
    const char* Q; const char* K; bf16_t* SD; int nt;
    __device__ __forceinline__ long nunits() const { return 8 * 64; }
    __device__ __forceinline__ unsigned rowA(int R) const { return (unsigned)R * 4096u; }
    static constexpr unsigned ldb = 4096u;
    __device__ __forceinline__ void unit(long L, UInfo& u) const { const int c = (int)L & 63, h = (int)L >> 6; const size_t o = ((size_t)(c * 256) * 2048 + h * 256) * 2;
        u.a = Q + o; u.b = K + o; u.r0 = c * 256; u.c0 = h * 256; u.x0 = h; u.x1 = 0; }
    __device__ __forceinline__ size_t aK(int kt) const { return (size_t)kt * 128; }
    __device__ __forceinline__ size_t bK(int kt) const { return (size_t)kt * 128; }
    __device__ __forceinline__ void epi(const AccT& acc, const UInfo& u, int wr, int wc, int fr, int fq) const {
        const float l2g = log2gamma(u.x0);
#pragma unroll
        EPI_ROWS { const int i = EPI_ROW; bf16_t* rp = SD + (size_t)(u.r0 + i) * 2048 + u.c0;
#pragma unroll
            for (int bj = 0; bj < 2; ++bj) { const int s = 128 * bj + 32 * wc + 8 * fq; const f32x4 v = acc[ai][bj][m][0], v2 = acc[ai][bj][m][1]; float o[8];
#pragma unroll
                for (int j = 0; j < 4; ++j) { o[j] = (s + j <= i) ? v[j] * fexp2(-(float)(s + j + 1) * l2g) : 0.f; o[4 + j] = (s + 4 + j <= i) ? v2[j] * fexp2(-(float)(s + 4 + j + 1) * l2g) : 0.f; }
                *(u32x4*)(rp + s) = (u32x4){pk_bf16(o[0], o[1]), pk_bf16(o[2], o[3]), pk_bf16(o[4], o[5]), pk_bf16(o[6], o[7])}; } }
    }
};
struct ProbOut {
    static constexpr bool PERM = true;
    const char* Q; const char* ST; long dA, dB; bf16_t* Y; int nt;
    __device__ __forceinline__ long nunits() const { return 8 * 64 * 2; }
    __device__ __forceinline__ unsigned rowA(int R) const { return (unsigned)R * 4096u; }
    static constexpr unsigned ldb = 32768u;
    __device__ __forceinline__ void unit(long L, UInfo& u) const { const int pn = (int)L & 1, c = ((int)L >> 1) & 63, h = (int)L >> 7;
        u.a = Q + ((size_t)(c * 256) * 2048 + h * 256) * 2; u.b = ST + ((size_t)(h * 512 + pn * 256) * S_ + c * 256) * 2; u.r0 = c * 256; u.c0 = h * 512 + pn * 256; u.x0 = h; u.x1 = 0; }
    __device__ __forceinline__ size_t aK(int kt) const { return kt < 4 ? (size_t)kt * 128 : (size_t)(dA + (long)(kt - 4) * 128); }
    __device__ __forceinline__ size_t bK(int kt) const { return kt < 4 ? (size_t)kt * 128 : (size_t)(dB + (long)(kt - 4) * 128); }
    __device__ __forceinline__ void epi(const AccT& acc, const UInfo& u, int wr, int wc, int fr, int fq) const {
        const float l2g = log2gamma(u.x0);
#pragma unroll
        EPI_ROWS { const int i = EPI_ROW; const float qd = fexp2((float)(i + 1) * l2g); bf16_t* rp = Y + (size_t)(u.r0 + i) * 4096 + u.c0;
#pragma unroll
            for (int bj = 0; bj < 2; ++bj) { const f32x4 v = acc[ai][bj][m][0] * qd, v2 = acc[ai][bj][m][1] * qd; *(u32x4*)(rp + 128 * bj + 32 * wc + 8 * fq) = (u32x4){pk_bf16(v[0], v[1]), pk_bf16(v[2], v[3]), pk_bf16(v2[0], v2[1]), pk_bf16(v2[2], v2[3])}; } }
    }
};

__device__ __forceinline__ void transpose_job(const float* __restrict__ src, bf16_t* __restrict__ dst, int K, int N, int Npad, int kvperm, LAS float* tile, const float* gain = nullptr) {
    const int tk = K / 64, tn = Npad / 256, ntile = tk * tn; const int tid = ltid();
    for (int t = blockIdx.x; t < ntile; t += gridDim.x) {
        const int k0 = (t % tk) * 64, n0 = (t / tk) * 256;
        { const int r0 = tid >> 6, cc = tid & 63; float v[8][4];
#pragma unroll
          for (int i = 0; i < 8; ++i)
#pragma unroll
              for (int q = 0; q < 4; ++q) { const int n = n0 + cc + 64 * q; v[i][q] = (n < N) ? src[(size_t)(k0 + r0 + 8 * i) * N + n] : 0.f; }
#pragma unroll
          for (int i = 0; i < 8; ++i) { const float gk = gain ? gain[k0 + r0 + 8 * i] : 1.0f;
#pragma unroll
              for (int q = 0; q < 4; ++q) tile[(r0 + 8 * i) * 257 + cc + 64 * q] = v[i][q] * gk; } }
        __syncthreads();
        { const int rr = tid >> 1, c0 = (tid & 1) * 32;
          int n = n0 + rr; if (kvperm) { const int j = n >> 9; const int jp = (j == 3) ? 4 : ((j == 4) ? 3 : j); n = jp * 512 + (n & 511); }
          bf16_t* dp = dst + (size_t)n * K + k0 + c0;
#pragma unroll
          for (int g = 0; g < 4; ++g) { float x[8];
#pragma unroll
              for (int j = 0; j < 8; ++j) x[j] = tile[(c0 + 8 * g + j) * 257 + rr];
              *(u32x4*)(dp + 8 * g) = (u32x4){pk_bf16(x[0], x[1]), pk_bf16(x[2], x[3]), pk_bf16(x[4], x[5]), pk_bf16(x[6], x[7])}; } }
        __syncthreads();
    }
}
__device__ __forceinline__ void prep_phase(CP p, LAS unsigned char* lds) {
    LAS float* tile = (LAS float*)lds; unsigned char* ws = p->ws;
    transpose_job(p->ret_w_in, (bf16_t*)(ws + OFF_W_RIN), 2048, 12288, 12288, 0, tile);
    transpose_job(p->ret_w_out, (bf16_t*)(ws + OFF_W_ROUT), 4096, 2048, 2048, 0, tile);
    transpose_job(p->w_kv, (bf16_t*)(ws + OFF_W_KV), 2048, 3072, 3072, 1, tile, p->kv_gain);
    transpose_job(p->w1_k, (bf16_t*)(ws + OFF_W_C1K), 4096, 256, 256, 0, tile);
    transpose_job(p->w1_v, (bf16_t*)(ws + OFF_W_C1V), 4096, 256, 256, 0, tile);
    transpose_job(p->w2_k, (bf16_t*)(ws + OFF_W_C2K), 256, 128, 256, 0, tile);
    transpose_job(p->w2_v, (bf16_t*)(ws + OFF_W_C2V), 256, 128, 256, 0, tile);
    transpose_job(p->w_q, (bf16_t*)(ws + OFF_W_Q), 2048, 2096, 2304, 0, tile, p->norm_mix + 2048);
    transpose_job(p->w_o, (bf16_t*)(ws + OFF_W_O), 2048, 2048, 2048, 0, tile);
    transpose_job(p->ffn_w_in, (bf16_t*)(ws + OFF_W_FIN), 2048, 8192, 8192, 0, tile, p->norm_ffn);
    transpose_job(p->ffn_w_in + (size_t)2048 * 8192, (bf16_t*)(ws + OFF_W_FIN + 32 * MiB), 2048, 8192, 8192, 0, tile, p->norm_ffn + 2048);
    transpose_job(p->ffn_w_out, (bf16_t*)(ws + OFF_W_FOUT), 4096, 2048, 2048, 0, tile);
    transpose_job(p->ffn_w_out + (size_t)4096 * 2048, (bf16_t*)(ws + OFF_W_FOUT + 16 * MiB), 4096, 2048, 2048, 0, tile);
    { float* ss = (float*)(ws + OFF_SS); for (int i = blockIdx.x * 512 + ltid(); i < 8 * S_; i += gridDim.x * 512) ss[i] = 0.f; }
    { float2* rope = (float2*)(ws + OFF_ROPE); const int gsz = gridDim.x * 512;
      for (int i = blockIdx.x * 512 + ltid(); i < S_ * 128; i += gsz) { const int t = i >> 7, dd = i & 127;
          const float freq = exp2f(-(float)dd * (13.287712379549449f / 128.0f)); const double rev = (double)t * (double)freq * 0.15915494309189535;
          const float fx = (float)(rev - rint(rev)); rope[i] = make_float2(__builtin_amdgcn_cosf(fx), __builtin_amdgcn_sinf(fx)); } }
    if (blockIdx.x < 128) { const int kv = blockIdx.x >> 6, oc = blockIdx.x & 63; const float* pe = kv ? p->pe_v : p->pe_k; const float* w1 = kv ? p->w1_v : p->w1_k; float* peb = (float*)(ws + OFF_PEB) + kv * 256;
        const int tid = ltid(), g = tid >> 7, r = tid & 127, n = 4 * oc + g; float s = 0.f;
#pragma unroll 8
        for (int j = 0; j < 32; ++j) { const int k = r + 128 * j; s += pe[k] * w1[(size_t)k * 256 + n]; }
        s = wave_sum(s, tid & 63);
        __syncthreads(); if ((tid & 63) == 0) tile[tid >> 6] = s; __syncthreads();
        if (tid < 4) peb[4 * oc + tid] = tile[2 * tid] + tile[2 * tid + 1];
        __syncthreads(); }
}
__device__ __forceinline__ void rmsnorm_phase(const float* h, const float* g1, bf16_t* o1, const float* g2, bf16_t* o2) {
    const int w = ltid() >> 6, lane = ltid() & 63;
    for (int row = blockIdx.x * 8 + w; row < S_; row += gridDim.x * 8) {
        const f32x4* p = (const f32x4*)(h + (size_t)row * 2048); f32x4 v[8]; float ss = 0.f;
#pragma unroll
        for (int i = 0; i < 8; ++i) { v[i] = p[lane + 64 * i]; ss += v[i][0] * v[i][0] + v[i][1] * v[i][1] + v[i][2] * v[i][2] + v[i][3] * v[i][3]; }
        ss = wave_sum(ss, lane); const float r = rsqrtf(ss * (1.0f / 2048.0f) + 1e-6f);
#pragma unroll
        for (int i = 0; i < 8; ++i) { const int col = (lane + 64 * i) * 4; const f32x4 g = *(const f32x4*)(g1 + col);
            *(u32x2*)(o1 + (size_t)row * 2048 + col) = (u32x2){pk_bf16(v[i][0] * r * g[0], v[i][1] * r * g[1]), pk_bf16(v[i][2] * r * g[2], v[i][3] * r * g[3])};
            if (o2) { const f32x4 gg = *(const f32x4*)(g2 + col);
                *(u32x2*)(o2 + (size_t)row * 2048 + col) = (u32x2){pk_bf16(v[i][0] * r * gg[0], v[i][1] * r * gg[1]), pk_bf16(v[i][2] * r * gg[2], v[i][3] * r * gg[3])}; } }
    }
}
__device__ __forceinline__ void finalnorm_phase(float* h, const float* g1) {
    const int w = ltid() >> 6, lane = ltid() & 63;
    for (int row = blockIdx.x * 8 + w; row < S_; row += gridDim.x * 8) {
        f32x4* p = (f32x4*)(h + (size_t)row * 2048); f32x4 v[8]; float ss = 0.f;
#pragma unroll
        for (int i = 0; i < 8; ++i) { v[i] = p[lane + 64 * i]; ss += v[i][0] * v[i][0] + v[i][1] * v[i][1] + v[i][2] * v[i][2] + v[i][3] * v[i][3]; }
        ss = wave_sum(ss, lane); const float r = rsqrtf(ss * (1.0f / 2048.0f) + 1e-6f);
#pragma unroll
        for (int i = 0; i < 8; ++i) { const f32x4 g = *(const f32x4*)(g1 + (lane + 64 * i) * 4); p[lane + 64 * i] = v[i] * r * g; }
    }
}
__device__ __forceinline__ void scan_phase(bf16_t* ST) {
    for (int it = blockIdx.x * 512 + ltid(); it < 4096 * 32; it += gridDim.x * 512) {
        const int r = it >> 5, d8 = it & 31; const float cd = fexp2(256.0f * log2gamma(r >> 9));
        bf16_t* p = ST + (size_t)r * S_ + d8 * 8; float s[8];
#pragma unroll
        for (int j = 0; j < 8; ++j) s[j] = 0.f;
        for (int c = 0; c < 64; ++c) { const u32x4 v = *(const u32x4*)(p + c * 256);
            *(u32x4*)(p + c * 256) = (u32x4){pk_bf16(s[0], s[1]), pk_bf16(s[2], s[3]), pk_bf16(s[4], s[5]), pk_bf16(s[6], s[7])};
#pragma unroll
            for (int j = 0; j < 4; ++j) { s[2 * j] = s[2 * j] * cd + bflo(v[j]); s[2 * j + 1] = s[2 * j + 1] * cd + bfhi(v[j]); } }
    }
}
__device__ __forceinline__ void gn_phase(bf16_t* Y, const float* gain) {
    const int w = ltid() >> 6, lane = ltid() & 63;
    for (int g = blockIdx.x * 8 + w; g < S_ * 8; g += gridDim.x * 8) {
        bf16_t* p = Y + (size_t)g * 512 + lane * 8; const u32x4 v = *(const u32x4*)p; float x[8];
#pragma unroll
        for (int j = 0; j < 4; ++j) { x[2 * j] = bflo(v[j]); x[2 * j + 1] = bfhi(v[j]); }
        float s = 0.f;
#pragma unroll
        for (int j = 0; j < 8; ++j) s += x[j];
        const float mu = wave_sum(s, lane) * (1.0f / 512.0f); float q = 0.f;
#pragma unroll
        for (int j = 0; j < 8; ++j) { x[j] -= mu; q += x[j] * x[j]; }
        const float r = rsqrtf(wave_sum(q, lane) * (1.0f / 512.0f) + 1e-6f); const float* gp = gain + (g & 7) * 512 + lane * 8;
        const f32x4 g0 = *(const f32x4*)gp, g1 = *(const f32x4*)(gp + 4);
        *(u32x4*)p = (u32x4){pk_bf16(x[0] * r * g0[0], x[1] * r * g0[1]), pk_bf16(x[2] * r * g0[2], x[3] * r * g0[3]), pk_bf16(x[4] * r * g1[0], x[5] * r * g1[1]), pk_bf16(x[6] * r * g1[2], x[7] * r * g1[3])};
    }
}
__device__ __forceinline__ void conv_phase(const bf16_t* U, bf16_t* AB, const float* cw, const float* cb) {
    for (int it = blockIdx.x * 512 + ltid(); it < 512 * 512; it += gridDim.x * 512) {
        const int n8 = (it & 511) * 8, t0 = (it >> 9) * 32;
        float wa[3][8], wb[3][8], ba[8], bb[8];
#pragma unroll
        for (int tp = 0; tp < 3; ++tp)
#pragma unroll
            for (int j = 0; j < 8; ++j) { wa[tp][j] = cw[tp * 8192 + n8 + j]; wb[tp][j] = cw[tp * 8192 + 4096 + n8 + j]; }
#pragma unroll
        for (int j = 0; j < 8; ++j) { ba[j] = cb[n8 + j]; bb[j] = cb[4096 + n8 + j]; }
        float pa[2][8], pb[2][8];
#pragma unroll
        for (int k = 0; k < 2; ++k) { const int t = t0 - 2 + k; u32x4 va = (u32x4){0, 0, 0, 0}, vb = (u32x4){0, 0, 0, 0};
            if (t >= 0) { va = *(const u32x4*)(U + (size_t)t * 8192 + n8); vb = *(const u32x4*)(U + (size_t)t * 8192 + 4096 + n8); }
#pragma unroll
            for (int j = 0; j < 4; ++j) { pa[k][2 * j] = bflo(va[j]); pa[k][2 * j + 1] = bfhi(va[j]); pb[k][2 * j] = bflo(vb[j]); pb[k][2 * j + 1] = bfhi(vb[j]); } }
#pragma unroll 8
        for (int k = 0; k < 32; ++k) { const int t = t0 + k; const u32x4 va = *(const u32x4*)(U + (size_t)t * 8192 + n8), vb = *(const u32x4*)(U + (size_t)t * 8192 + 4096 + n8);
            float xa[8], xb[8], o[8];
#pragma unroll
            for (int j = 0; j < 4; ++j) { xa[2 * j] = bflo(va[j]); xa[2 * j + 1] = bfhi(va[j]); xb[2 * j] = bflo(vb[j]); xb[2 * j + 1] = bfhi(vb[j]); }
#pragma unroll
            for (int j = 0; j < 8; ++j) { const float a = ba[j] + wa[0][j] * pa[0][j] + wa[1][j] * pa[1][j] + wa[2][j] * xa[j]; const float b = bb[j] + wb[0][j] * pb[0][j] + wb[1][j] * pb[1][j] + wb[2][j] * xb[j];
                o[j] = a * sigmoidf_(a) * b; pa[0][j] = pa[1][j]; pa[1][j] = xa[j]; pb[0][j] = pb[1][j]; pb[1][j] = xb[j]; }
            *(u32x4*)(AB + (size_t)t * 4096 + n8) = (u32x4){pk_bf16(o[0], o[1]), pk_bf16(o[2], o[3]), pk_bf16(o[4], o[5]), pk_bf16(o[6], o[7])}; }
    }
}

constexpr int XCD_CTR_WORD = 3456;
constexpr int A_KT = 0, A_VT = 17408, A_BUFSZ = 34816, A_PSL = 69632, A_SEL = 4 * A_BUFSZ, LDS_ST = A_SEL + 2048;
constexpr float LOG2E = 1.4426950408889634f;
struct AttnState { f32x4 ot[8][2]; float m[2], l[2]; };

template <int MODE>
__device__ __forceinline__ void attn_compute(LAS unsigned char* lds, int boff, int tile, const bf16x8 (&qf)[2][4], AttnState& st, const int (&tpos)[2], int qb, int w, int lane,
                                             const float (&mfin)[2], const float (&linv)[2], bool rs0, bool rs1, bool masked, bool a0, bool a1) {
    const int l16 = lane & 15, g4 = lane >> 4;
    f32x4 s[4][2];
#pragma unroll
    for (int mt = 0; mt < 4; ++mt) { s[mt][0] = (f32x4){0.f, 0.f, 0.f, 0.f}; s[mt][1] = (f32x4){0.f, 0.f, 0.f, 0.f}; }
#pragma unroll
    for (int ks = 0; ks < 4; ++ks) {
        bf16x8 kf[4];
#pragma unroll
        for (int mt = 0; mt < 4; ++mt) kf[mt] = *(const LAS bf16x8*)(lds + boff + A_KT + (16 * mt + l16) * 272 + ks * 64 + g4 * 16);
        if (a0) {
#pragma unroll
            for (int mt = 0; mt < 4; ++mt) s[mt][0] = __builtin_amdgcn_mfma_f32_16x16x32_bf16(kf[mt], qf[0][ks], s[mt][0], 0, 0, 0);
        }
        if (a1) {
#pragma unroll
            for (int mt = 0; mt < 4; ++mt) s[mt][1] = __builtin_amdgcn_mfma_f32_16x16x32_bf16(kf[mt], qf[1][ks], s[mt][1], 0, 0, 0);
        }
        if (ks & 1) __builtin_amdgcn_sched_barrier(0);
    }
    if (masked) {
#pragma unroll
        for (int nt = 0; nt < 2; ++nt) { const int t = tpos[nt]; const int tl = w * 8 + nt * 4 + (l16 >> 2);
#pragma unroll
            for (int mt = 0; mt < 4; ++mt)
#pragma unroll
                for (int j = 0; j < 4; ++j) { const int kl = 16 * mt + 4 * g4 + j; const int key = tile * 64 + kl; bool v;
                    if (MODE == 0 || MODE == 1) v = key <= ((t - 31) >> 4);
                    else if (MODE == 2) v = (kl <= tl);
                    else v = (key <= t) && (key > t - 512);
                    s[mt][nt][j] = v ? s[mt][nt][j] : -__builtin_inff(); } }
    }
    bf16x8 pf[2][2];
#pragma unroll
    for (int nt = 0; nt < 2; ++nt) {
        if (nt ? a1 : a0) {
            const bool rowsel = nt ? rs1 : rs0;
            const float bias = (MODE == 2 && !rowsel) ? -__builtin_inff() : 0.f;
            float mx = -1e30f;
#pragma unroll
            for (int mt = 0; mt < 4; ++mt)
#pragma unroll
                for (int j = 0; j < 4; ++j) {
                    const float sv = s[mt][nt][j] * LOG2E + bias;
                    s[mt][nt][j] = sv; mx = fmaxf(mx, sv); }
            float mnew, alpha = 1.f;
            if (MODE == 1) mnew = mfin[nt];
            else { mx = fmaxf(mx, shx(mx, 16, lane)); mx = fmaxf(mx, shx(mx, 32, lane)); mnew = fmaxf(st.m[nt], mx); alpha = fexp2(st.m[nt] - mnew); st.m[nt] = mnew; }
            float ps = 0.f;
#pragma unroll
            for (int mt = 0; mt < 4; ++mt)
#pragma unroll
                for (int j = 0; j < 4; ++j) { float pv = fexp2(s[mt][nt][j] - mnew); if (MODE == 1) pv *= linv[nt]; s[mt][nt][j] = pv; ps += pv; }
            if (MODE != 1) st.l[nt] = st.l[nt] * alpha + ps;
            if (MODE == 2 || MODE == 3) {
#pragma unroll
                for (int md = 0; md < 8; ++md) st.ot[md][nt] = st.ot[md][nt] * alpha;
            }
            if (MODE == 1) {
#pragma unroll
                for (int mt = 0; mt < 4; ++mt) { float a = s[mt][nt][0] + s[mt][nt][1] + s[mt][nt][2] + s[mt][nt][3], lst = s[mt][nt][3];
                    a += shx(a, 1, lane); a += shx(a, 2, lane); lst += shx(lst, 1, lane); lst += shx(lst, 2, lane);
                    if ((l16 & 3) == 0) { const int jb = tile * 16 + 4 * mt + g4; LAS float* pp = (LAS float*)(lds + A_PSL) + (w * 8 + nt * 4 + (l16 >> 2)) * 256;
                        atomicAdd((float*)(pp + jb), a); if (jb + 1 < 256) atomicAdd((float*)(pp + jb + 1), lst); } }
            }
            if (MODE != 0) {
#pragma unroll
                for (int kk = 0; kk < 2; ++kk) { const u32x4 pk = (u32x4){pk_bf16(s[2 * kk][nt][0], s[2 * kk][nt][1]), pk_bf16(s[2 * kk][nt][2], s[2 * kk][nt][3]), pk_bf16(s[2 * kk + 1][nt][0], s[2 * kk + 1][nt][1]), pk_bf16(s[2 * kk + 1][nt][2], s[2 * kk + 1][nt][3])};
                    pf[nt][kk] = __builtin_bit_cast(bf16x8, pk); }
            }
        } else { pf[nt][0] = (bf16x8){0, 0, 0, 0, 0, 0, 0, 0}; pf[nt][1] = (bf16x8){0, 0, 0, 0, 0, 0, 0, 0}; }
    }
    if (MODE != 0) {
#pragma unroll
        for (int kk = 0; kk < 2; ++kk)
#pragma unroll
            for (int mg = 0; mg < 2; ++mg) {
                bf16x8 vf[4];
#pragma unroll
                for (int q = 0; q < 4; ++q) { const LAS unsigned char* vb = lds + boff + A_VT + (16 * (4 * mg + q) + l16) * 136 + kk * 64 + g4 * 8;
                    const u32x2 v0 = *(const LAS u32x2*)vb, v1 = *(const LAS u32x2*)(vb + 32); vf[q] = __builtin_bit_cast(bf16x8, ((u32x4){v0[0], v0[1], v1[0], v1[1]})); }
                if (a0) {
#pragma unroll
                    for (int q = 0; q < 4; ++q) st.ot[4 * mg + q][0] = __builtin_amdgcn_mfma_f32_16x16x32_bf16(vf[q], pf[0][kk], st.ot[4 * mg + q][0], 0, 0, 0);
                }
                if (a1) {
#pragma unroll
                    for (int q = 0; q < 4; ++q) st.ot[4 * mg + q][1] = __builtin_amdgcn_mfma_f32_16x16x32_bf16(vf[q], pf[1][kk], st.ot[4 * mg + q][1], 0, 0, 0);
                }
                if (mg == 1) __builtin_amdgcn_sched_barrier(0);
            }
    }
}
template <int MODE>
__device__ __forceinline__ void attn_tiles(LAS unsigned char* lds, const bf16_t* kp, size_t kstride, const bf16_t* vp, size_t vstride, int tile_lo, int tile_hi,
                                           const bf16x8 (&qf)[2][4], AttnState& st, const int (&tpos)[2], int qb, int w, int lane, const float (&mfin)[2], const float (&linv)[2]) {
    if (tile_lo >= tile_hi) return;
    int tid = w * 64 + lane; asm volatile("" : "+v"(tid)); const int l16 = lane & 15;
    const int krow = tid >> 3, kc = (tid & 7) * 16, vrow = tid >> 2, vc = (tid & 3) * 16;
    u32x4 kr0, kr1, vr0 = (u32x4){0, 0, 0, 0}, vr1 = (u32x4){0, 0, 0, 0};
#define A_LOAD(T) do { const bf16_t* kg = kp + (size_t)((T) * 64 + krow) * kstride + kc; kr0 = *(const u32x4*)kg; kr1 = *(const u32x4*)(kg + 8); \
        if (MODE != 0) { const bf16_t* vg = vp + (size_t)vrow * vstride + (T) * 64 + vc; vr0 = *(const u32x4*)vg; vr1 = *(const u32x4*)(vg + 8); } } while (0)
#define A_WRITE(BO) do { LAS unsigned char* kd = lds + (BO) + A_KT + krow * 272 + kc * 2; *(LAS u32x4*)kd = kr0; *(LAS u32x4*)(kd + 16) = kr1; \
        if (MODE != 0) { LAS unsigned char* vd = lds + (BO) + A_VT + vrow * 136 + vc * 2; *(LAS u32x2*)vd = (u32x2){vr0[0], vr0[1]}; *(LAS u32x2*)(vd + 8) = (u32x2){vr0[2], vr0[3]}; *(LAS u32x2*)(vd + 16) = (u32x2){vr1[0], vr1[1]}; *(LAS u32x2*)(vd + 24) = (u32x2){vr1[2], vr1[3]}; } } while (0)
    A_LOAD(tile_lo);
    __syncthreads();
    A_WRITE(0);
    if (tile_lo + 1 < tile_hi) A_LOAD(tile_lo + 1);
    __syncthreads();
    unsigned selw0 = 0u, selw1 = 0u;
    for (int tile = tile_lo; tile < tile_hi; ++tile) {
        const int boff = ((tile - tile_lo) & 1) * A_BUFSZ;
        if (MODE == 2 && (tile == tile_lo || (tile & 31) == 0)) { const int tw = tile >> 5;
            selw0 = *(const LAS unsigned*)(lds + A_SEL + ((w * 8 + (l16 >> 2)) * 8 + tw) * 4); selw1 = *(const LAS unsigned*)(lds + A_SEL + ((w * 8 + 4 + (l16 >> 2)) * 8 + tw) * 4); }
        if (tile + 1 < tile_hi) { A_WRITE(boff ^ A_BUFSZ); if (tile + 2 < tile_hi) A_LOAD(tile + 2); }
        bool rs0 = true, rs1 = true, active = true;
        if (MODE == 2) { const unsigned bit = 1u << (tile & 31);
            rs0 = (selw0 & bit) != 0u; rs1 = (selw1 & bit) != 0u; active = __ballot(rs0 || rs1) != 0ull; }
        if (active) {
            bool masked;
            if (MODE == 0 || MODE == 1) masked = (tile * 64 + 63 > 4 * qb - 2);
            else if (MODE == 2) masked = (tile == qb);
            else masked = (tile == qb) || (tile <= qb - 8);
            const bool a0 = (MODE != 2) || (__ballot(rs0) != 0ull), a1 = (MODE != 2) || (__ballot(rs1) != 0ull);
            attn_compute<MODE>(lds, boff, tile, qf, st, tpos, qb, w, lane, mfin, linv, rs0, rs1, masked, a0, a1);
        }
        __syncthreads();
    }
#undef A_LOAD
#undef A_WRITE
}
__device__ __forceinline__ void attn_tiles_slc2(LAS unsigned char* lds, const bf16_t* kp, size_t kstride, const bf16_t* vp, size_t vstride, int n,
                                                const bf16x8 (&qf)[2][4], AttnState& st, const int (&tpos)[2], int qb, int w, int lane, const float (&mfin)[2], const float (&linv)[2]) {
    int tid = w * 64 + lane; asm volatile("" : "+v"(tid)); const int l16 = lane & 15;
    const int krow = tid >> 3, kc = (tid & 7) * 16, vrow = tid >> 2, vc = (tid & 3) * 16;
    const int nst = (n + 1) >> 1; constexpr int STG = 2 * A_BUFSZ;
    u32x4 kX0, kX1, vX0, vX1, kY0 = (u32x4){0, 0, 0, 0}, kY1 = (u32x4){0, 0, 0, 0}, vY0 = (u32x4){0, 0, 0, 0}, vY1 = (u32x4){0, 0, 0, 0};
#define S_LOAD1(T, S) do { const bf16_t* kg = kp + (size_t)((T) * 64 + krow) * kstride + kc; k##S##0 = *(const u32x4*)kg; k##S##1 = *(const u32x4*)(kg + 8); \
        const bf16_t* vg = vp + (size_t)vrow * vstride + (T) * 64 + vc; v##S##0 = *(const u32x4*)vg; v##S##1 = *(const u32x4*)(vg + 8); } while (0)
#define S_WRITE1(BO, S) do { LAS unsigned char* kd = lds + (BO) + A_KT + krow * 272 + kc * 2; *(LAS u32x4*)kd = k##S##0; *(LAS u32x4*)(kd + 16) = k##S##1; \
        LAS unsigned char* vd = lds + (BO) + A_VT + vrow * 136 + vc * 2; *(LAS u32x2*)vd = (u32x2){v##S##0[0], v##S##0[1]}; *(LAS u32x2*)(vd + 8) = (u32x2){v##S##0[2], v##S##0[3]}; *(LAS u32x2*)(vd + 16) = (u32x2){v##S##1[0], v##S##1[1]}; *(LAS u32x2*)(vd + 24) = (u32x2){v##S##1[2], v##S##1[3]}; } while (0)
#define S_LOADS(SG) do { S_LOAD1(2 * (SG), X); if (2 * (SG) + 1 < n) S_LOAD1(2 * (SG) + 1, Y); } while (0)
#define S_WRITES(SG, BASE) do { S_WRITE1((BASE), X); if (2 * (SG) + 1 < n) S_WRITE1((BASE) + A_BUFSZ, Y); } while (0)
    S_LOADS(0);
    __syncthreads();
    S_WRITES(0, 0);
    if (nst > 1) S_LOADS(1);
    __syncthreads();
    unsigned selw0 = 0u, selw1 = 0u;
    for (int s = 0; s < nst; ++s) {
        const int base = (s & 1) * STG;
        if ((s & 15) == 0) { const int tw = s >> 4;
            selw0 = *(const LAS unsigned*)(lds + A_SEL + ((w * 8 + (l16 >> 2)) * 8 + tw) * 4); selw1 = *(const LAS unsigned*)(lds + A_SEL + ((w * 8 + 4 + (l16 >> 2)) * 8 + tw) * 4); }
        if (s + 1 < nst) { S_WRITES(s + 1, base ^ STG); if (s + 2 < nst) S_LOADS(s + 2); }
#pragma unroll
        for (int hf = 0; hf < 2; ++hf) {
            const int tile = 2 * s + hf;
            if (tile < n) {
                const unsigned bit = 1u << (tile & 31);
                const bool rs0 = (selw0 & bit) != 0u, rs1 = (selw1 & bit) != 0u;
                const bool a0 = __ballot(rs0) != 0ull, a1 = __ballot(rs1) != 0ull;
                if (a0 || a1) attn_compute<2>(lds, base + hf * A_BUFSZ, tile, qf, st, tpos, qb, w, lane, mfin, linv, rs0, rs1, tile == qb, a0, a1);
            }
        }
        asm volatile("s_waitcnt lgkmcnt(0)" ::: "memory"); __builtin_amdgcn_s_barrier(); asm volatile("" ::: "memory");
    }
    __syncthreads();
#undef S_LOAD1
#undef S_WRITE1
#undef S_LOADS
#undef S_WRITES
}
template <int BR>
__device__ __forceinline__ void attn_finish(AttnState& st, const float* gates, float* oacc, bf16_t* att, const int (&tpos)[2], int hkv, int lane) {
    const int l16 = lane & 15, g4 = lane >> 4, g = l16 & 3;
#pragma unroll
    for (int nt = 0; nt < 2; ++nt) {
        const int t = tpos[nt]; float sc = gates[(size_t)t * 48 + (hkv * 4 + g) * 3 + BR];
        if (BR != 0) { float l = st.l[nt]; l += shx(l, 16, lane); l += shx(l, 32, lane); sc = (l > 0.f) ? sc / l : 0.f; }
        const size_t base = (size_t)t * 2048 + (hkv * 4 + g) * 128 + 4 * g4;
#pragma unroll
        for (int md = 0; md < 8; ++md) { f32x4 v = st.ot[md][nt] * sc; float* op = oacc + base + 16 * md;
            if (BR == 0) *(f32x4*)op = v;
            else if (BR == 1) *(f32x4*)op = *(const f32x4*)op + v;
            else { v = v + *(const f32x4*)op; *(u32x2*)(att + base + 16 * md) = (u32x2){pk_bf16(v[0], v[1]), pk_bf16(v[2], v[3])}; } }
    }
}
__device__ __forceinline__ void attn_reset(AttnState& st) {
#pragma unroll
    for (int md = 0; md < 8; ++md) { st.ot[md][0] = (f32x4){0.f, 0.f, 0.f, 0.f}; st.ot[md][1] = (f32x4){0.f, 0.f, 0.f, 0.f}; }
    st.m[0] = st.m[1] = -1e30f; st.l[0] = st.l[1] = 0.f;
}
__device__ __forceinline__ void attn_item(unsigned char* ws, LAS unsigned char* lds, int hkv, int qb) {
    int tid = ltid(); asm volatile("" : "+v"(tid)); const int w = tid >> 6, lane = tid & 63, l16 = lane & 15, g4 = lane >> 4;
    const bf16_t* QB = (const bf16_t*)(ws + OFF_QB); const bf16_t* KVTOK = (const bf16_t*)(ws + OFF_KVTOK); const bf16_t* KVT = (const bf16_t*)(ws + OFF_KVT);
    const bf16_t* KC = (const bf16_t*)(ws + OFF_KCMP); const bf16_t* VC = (const bf16_t*)(ws + OFF_VCMPT);
    const float* gates = (const float*)(ws + OFF_GATES); float* oacc = (float*)(ws + OFF_OACC); bf16_t* att = (bf16_t*)(ws + OFF_ATT);
    int tpos[2]; bf16x8 qf[2][4];
#pragma unroll
    for (int nt = 0; nt < 2; ++nt) { tpos[nt] = qb * 64 + w * 8 + nt * 4 + (l16 >> 2); const bf16_t* qp = QB + (size_t)tpos[nt] * 2048 + (hkv * 4 + (l16 & 3)) * 128 + g4 * 8;
#pragma unroll
        for (int ks = 0; ks < 4; ++ks) qf[nt][ks] = *(const bf16x8*)(qp + ks * 32); }
    __syncthreads();
    { LAS float* pp = (LAS float*)(lds + A_PSL) + w * 2048;
#pragma unroll
      for (int i = 0; i < 32; ++i) pp[lane + 64 * i] = 0.f; }
    AttnState st; float mfin[2] = {0.f, 0.f}, linv[2] = {0.f, 0.f};
    const int ncmp_tiles = (4 * qb + 3 + 63) >> 6;
    attn_reset(st);
    attn_tiles<0>(lds, KC + (size_t)hkv * 1024 * 128, 128, VC, 1024, 0, ncmp_tiles, qf, st, tpos, qb, w, lane, mfin, linv);
#pragma unroll
    for (int nt = 0; nt < 2; ++nt) { float l = st.l[nt]; l += shx(l, 16, lane); l += shx(l, 32, lane); mfin[nt] = st.m[nt]; linv[nt] = (l > 0.f) ? 1.0f / l : 0.f; }
    attn_reset(st);
    attn_tiles<1>(lds, KC + (size_t)hkv * 1024 * 128, 128, VC + (size_t)hkv * 128 * 1024, 1024, 0, ncmp_tiles, qf, st, tpos, qb, w, lane, mfin, linv);
    attn_finish<0>(st, gates, oacc, att, tpos, hkv, lane);
    __syncthreads();
    {
        LAS unsigned* sel = (LAS unsigned*)(lds + A_SEL) + w * 64;
        if (qb < 16) {
            if (lane < 8) { for (int tk = 0; tk < 8; ++tk) { const int lo = lane * 32; unsigned wd = 0; if (qb >= lo + 31) wd = 0xffffffffu; else if (qb >= lo) wd = (2u << (qb - lo)) - 1u; sel[tk * 8 + lane] = wd; } }
        } else {
            for (int tk = 0; tk < 8; ++tk) {
                const LAS float* pp = (const LAS float*)(lds + A_PSL) + (w * 8 + tk) * 256;
                unsigned key[4]; bool forced[4];
#pragma unroll
                for (int i = 0; i < 4; ++i) { const int j = lane + 64 * i; const float sc = pp[j]; const bool elig = (j >= 1) && (j <= qb - 2);
                    forced[i] = (j == 0) || (j == qb) || (j == qb - 1); key[i] = elig ? (__float_as_uint(sc) + 1u) : 0u; }
                unsigned prefix = 0u;
                for (int bit = 30; bit >= 0; --bit) { const unsigned cand = prefix | (1u << bit); int cnt = 0;
#pragma unroll
                    for (int i = 0; i < 4; ++i) cnt += __popcll(__ballot(key[i] >= cand));
                    if (cnt >= 13) prefix = cand; }
                int cgt = 0;
#pragma unroll
                for (int i = 0; i < 4; ++i) cgt += __popcll(__ballot(key[i] > prefix));
                const int need = 13 - cgt; int base = 0;
#pragma unroll
                for (int i = 0; i < 4; ++i) { const unsigned long long eqm = __ballot(key[i] == prefix);
                    const int rank = base + (int)__builtin_amdgcn_mbcnt_hi((unsigned)(eqm >> 32), __builtin_amdgcn_mbcnt_lo((unsigned)eqm, 0u));
                    const bool taken = forced[i] || (key[i] > prefix) || (key[i] == prefix && rank < need);
                    const unsigned long long bal = __ballot(taken); if (lane == 0) { sel[tk * 8 + 2 * i] = (unsigned)bal; sel[tk * 8 + 2 * i + 1] = (unsigned)(bal >> 32); }
                    base += __popcll(eqm); }
            }
        }
    }
    __syncthreads();
    attn_reset(st);
    attn_tiles_slc2(lds, KVTOK + 2 * 512 + hkv * 128, 2048, KVT + (size_t)(hkv * 128) * S_, S_, qb + 1, qf, st, tpos, qb, w, lane, mfin, linv);
    attn_finish<1>(st, gates, oacc, att, tpos, hkv, lane);
    attn_reset(st);
    attn_tiles<3>(lds, KVTOK + 3 * 512 + hkv * 128, 2048, KVT + (size_t)(512 + hkv * 128) * S_, S_, (qb - 8) > 0 ? (qb - 8) : 0, qb + 1, qf, st, tpos, qb, w, lane, mfin, linv);
    attn_finish<2>(st, gates, oacc, att, tpos, hkv, lane);
}
__device__ __forceinline__ void attn_phase(unsigned char* ws, LAS unsigned char* lds, int b) {
    unsigned* ctr = (unsigned*)(ws + OFF_BAR) + XCD_CTR_WORD + 64 * b;
    volatile LAS int* slot = (volatile LAS int*)(lds + LDS_ST + 8);
#pragma nounroll
    for (;;) {
        __syncthreads();
        if (threadIdx.x == 0) *slot = (int)__hip_atomic_fetch_add(ctr, 1u, __ATOMIC_RELAXED, __HIP_MEMORY_SCOPE_AGENT);
        __syncthreads();
        const int it = *slot;
        if (it >= 1024) break;
        attn_item(ws, lds, it & 3, 255 - (it >> 2));
    }
}

#define XB_TMO      128
#define XB_XCNT(j)  (256  + 64 * (j))
#define XB_XSUB(j)  (1280 + 64 * (j))
#define XB_XGEN(j)  (2304 + 64 * (j))
#define XB_TOP      3328
#define XB_TOPGEN   3392
#define XCD_BAR_WORDS 3456
#define XB_SPIN_CAP (1u << 22)
__device__ __forceinline__ unsigned xb_ld(unsigned* p)              { return __hip_atomic_load(p, __ATOMIC_RELAXED, __HIP_MEMORY_SCOPE_AGENT); }
__device__ __forceinline__ unsigned xb_add(unsigned* p, unsigned v) { return __hip_atomic_fetch_add(p, v, __ATOMIC_RELAXED, __HIP_MEMORY_SCOPE_AGENT); }
__device__ __forceinline__ unsigned xb_xcc_id() { return (unsigned)__builtin_amdgcn_s_getreg((3 << 11) | 20) & 0xFu; }
#define XB_SPIN(cond, bar) do { unsigned _sp = 0; while (cond) { __builtin_amdgcn_s_sleep(1); \
    if ((++_sp & 255u) == 0u) { if (xb_ld(&(bar)[XB_TMO])) break; if (_sp > XB_SPIN_CAP) { atomicAdd(&(bar)[XB_TMO], 1u); break; } } } } while (0)
struct XcdBarrier { unsigned* bar; unsigned x; volatile LAS unsigned* st; };
__device__ __forceinline__ XcdBarrier xcd_barrier_post(unsigned* bar, volatile LAS unsigned* st) {
    XcdBarrier b; b.bar = bar; b.x = xb_xcc_id(); b.st = st;
    if (threadIdx.x == 0) (void)xb_add(&bar[XB_XCNT(b.x)], 1u);
    return b;
}
__device__ __forceinline__ void xcd_barrier_complete(unsigned* bar, unsigned x, unsigned& nloc, unsigned& nx) {
    const unsigned G = gridDim.x * gridDim.y * gridDim.z;
    unsigned sum, cnt, mine, sp = 0u;
    for (;;) {
        sum = 0u; cnt = 0u; mine = 0u;
#pragma unroll
        for (unsigned j = 0; j < 16; ++j) { const unsigned c = xb_ld(&bar[XB_XCNT(j)]); sum += c; cnt += (c > 0u) ? 1u : 0u; mine = (j == x) ? c : mine; }
        if (sum == G) break;
        __builtin_amdgcn_s_sleep(1);
        if ((++sp & 255u) == 0u) { if (xb_ld(&bar[XB_TMO])) break; if (sp > XB_SPIN_CAP) { atomicAdd(&bar[XB_TMO], 1u); break; } }
    }
    nloc = mine > 0u ? mine : 1u; nx = cnt > 0u ? cnt : 1u;
}
__device__ __forceinline__ void xcd_barrier(const XcdBarrier& b) {
    asm volatile("s_waitcnt vmcnt(0)" ::: "memory");
    __syncthreads();
    if (threadIdx.x == 0) {
        unsigned* bar = b.bar;
        __builtin_amdgcn_s_waitcnt(0);
        unsigned nloc = b.st[0], nx = b.st[1];
        if (nloc == 0u) { xcd_barrier_complete(bar, b.x, nloc, nx); b.st[0] = nloc; b.st[1] = nx; }
        const unsigned old = xb_add(&bar[XB_XSUB(b.x)], 1u);
        const unsigned gen = old / nloc;
        if (old + 1u == (gen + 1u) * nloc) {
            __builtin_amdgcn_fence(__ATOMIC_RELEASE, "agent");
            asm volatile("s_waitcnt vmcnt(0)" ::: "memory");
            const unsigned og = xb_add(&bar[XB_TOP], 1u);
            const unsigned tg = og / nx;
            if (og + 1u == (tg + 1u) * nx) xb_add(&bar[XB_TOPGEN], 1u);
            else XB_SPIN(xb_ld(&bar[XB_TOPGEN]) == tg, bar);
            __builtin_amdgcn_fence(__ATOMIC_ACQUIRE, "agent");
            xb_add(&bar[XB_XGEN(b.x)], 1u);
            asm volatile("s_waitcnt vmcnt(0)" ::: "memory");
        } else {
            XB_SPIN(xb_ld(&bar[XB_XGEN(b.x)]) == gen, bar);
            __builtin_amdgcn_fence(__ATOMIC_ACQUIRE, "agent");
            asm volatile("s_waitcnt vmcnt(0)" ::: "memory");
        }
    }
    __syncthreads();
}

constexpr int NPH = 23;
__device__ __forceinline__ void run_phase(CP p, int ph, int b, LAS unsigned char* lds) {
    asm volatile("" : "+s"(p));
    unsigned char* ws = p->ws;
    const float* xb = p->x + (size_t)b * S_ * D_; float* hb = p->out + (size_t)b * S_ * D_;
    bf16_t* XN = (bf16_t*)(ws + OFF_XN);
    const int layer = (ph >= 13) ? 1 : 0;
    switch (ph) {
    case 0: prep_phase(p, lds); break;
    case 1: rmsnorm_phase(xb, p->norm_mix, XN, nullptr, nullptr); break;
    case 2: {
        Prob2D<EpiQK> g1{(const char*)XN, (const char*)(ws + OFF_W_RIN), 4096u, 4096u, 32, 64, 16, EpiQK{(bf16_t*)(ws + OFF_Q), (bf16_t*)(ws + OFF_K), (bf16_t*)(ws + OFF_KTD), (const float2*)(ws + OFF_ROPE)}};
        gemm_phase(lds, g1);
        Prob2D<EpiStore> g2{(const char*)(ws + OFF_W_RIN) + (size_t)4096 * 4096, (const char*)XN, 4096u, 4096u, 32, 16, 64, EpiStore{(bf16_t*)(ws + OFF_VT), (size_t)S_}};
        gemm_phase(lds, g2);
    } break;
    case 3: {
        ProbKV g3{(const char*)(ws + OFF_VT), (const char*)(ws + OFF_KTD), (bf16_t*)(ws + OFF_ST), 4};
        gemm_phase(lds, g3);
        ProbS g4{(const char*)(ws + OFF_Q), (const char*)(ws + OFF_K), (bf16_t*)(ws + OFF_SD), 4};
        gemm_phase(lds, g4);
    } break;
    case 4: scan_phase((bf16_t*)(ws + OFF_ST)); break;
    case 5: {
        ProbOut g5{(const char*)(ws + OFF_Q), (const char*)(ws + OFF_ST), (long)OFF_SD - (long)OFF_Q, (long)OFF_VT - (long)OFF_ST, (bf16_t*)(ws + OFF_Y), 8};
        gemm_phase(lds, g5);
    } break;
    case 6: gn_phase((bf16_t*)(ws + OFF_Y), p->ret_gn); break;
    case 7: {
        Prob2D<EpiGate> g6{(const char*)XN, (const char*)(ws + OFF_W_RIN) + (size_t)8192 * 4096, 4096u, 4096u, 32, 64, 16, EpiGate{(bf16_t*)(ws + OFF_Y)}};
        gemm_phase(lds, g6);
    } break;
    case 8: {
        Prob2D<EpiRes> g7{(const char*)(ws + OFF_Y), (const char*)(ws + OFF_W_ROUT), 8192u, 8192u, 64, 64, 8, EpiRes{xb, hb, XN, (float*)(ws + OFF_SS) + (size_t)(b * 4 + 0) * S_}};
        gemm_phase(lds, g7);
    } break;
    case 10: case 20: {
        Prob2D<EpiStoreRS> g8{(const char*)XN, (const char*)(ws + OFF_W_FIN + (size_t)layer * 32 * MiB), 4096u, 4096u, 32, 64, 32, EpiStoreRS{(bf16_t*)(ws + OFF_U), (size_t)8192, (const float*)(ws + OFF_SS) + (size_t)(b * 4 + (layer ? 2 : 0)) * S_}};
        gemm_phase(lds, g8);
    } break;
    case 11: case 21: conv_phase((const bf16_t*)(ws + OFF_U), (bf16_t*)(ws + OFF_AB), p->ffn_conv_w + (size_t)layer * 3 * 8192, p->ffn_conv_b + (size_t)layer * 8192); break;
    case 12: case 22: {
        Prob2D<EpiRes> g9{(const char*)(ws + OFF_AB), (const char*)(ws + OFF_W_FOUT + (size_t)layer * 16 * MiB), 8192u, 8192u, 64, 64, 8, EpiRes{hb, hb, layer ? (bf16_t*)nullptr : XN, layer ? (float*)nullptr : (float*)(ws + OFF_SS) + (size_t)(b * 4 + 1) * S_}};
        gemm_phase(lds, g9);
    } break;
    case 14: {
        const float* ss1 = (const float*)(ws + OFF_SS) + (size_t)(b * 4 + 1) * S_;
        Prob2D<EpiStoreRS> g10{(const char*)XN, (const char*)(ws + OFF_W_KV), 4096u, 4096u, 32, 64, 8, EpiStoreRS{(bf16_t*)(ws + OFF_KVTOK), (size_t)2048, ss1}};
        gemm_phase(lds, g10);
        Prob2D<EpiStoreCS> g11{(const char*)(ws + OFF_W_KV) + (size_t)2048 * 4096, (const char*)XN, 4096u, 4096u, 32, 4, 64, EpiStoreCS{(bf16_t*)(ws + OFF_KVT), (size_t)S_, ss1}};
        gemm_phase(lds, g11);
    } break;
    case 15: {
        ProbCmp1 a{(const char*)(ws + OFF_KVTOK), (const char*)(ws + OFF_W_C1K), 8192u, 64, 16, EpiGelu{(bf16_t*)(ws + OFF_H1), (const float*)(ws + OFF_PEB)}};
        gemm_phase(lds, a, (int)gridDim.x - 32);
        ProbCmp1 v{(const char*)(ws + OFF_KVTOK) + 1024, (const char*)(ws + OFF_W_C1V), 8192u, 64, 16, EpiGelu{(bf16_t*)(ws + OFF_H1) + 4096 * 256, (const float*)(ws + OFF_PEB) + 256}};
        gemm_phase(lds, v, (int)gridDim.x - 16);
        Prob2D<EpiQproj> g12{(const char*)XN, (const char*)(ws + OFF_W_Q), 4096u, 4096u, 32, 64, 9, EpiQproj{(bf16_t*)(ws + OFF_QB), (float*)(ws + OFF_GATES), (const float*)(ws + OFF_SS) + (size_t)(b * 4 + 1) * S_}};
        gemm_phase(lds, g12);
    } break;
    case 16: {
        Prob2D<EpiKcmp> a{(const char*)(ws + OFF_H1), (const char*)(ws + OFF_W_C2K), 512u, 512u, 4, 16, 1, EpiKcmp{(bf16_t*)(ws + OFF_KCMP)}};
        gemm_phase(lds, a);
        Prob2D<EpiVcmp> v{(const char*)(ws + OFF_W_C2V), (const char*)(ws + OFF_H1) + (size_t)4096 * 256 * 2, 512u, 512u, 4, 1, 16, EpiVcmp{(bf16_t*)(ws + OFF_VCMPT)}};
        gemm_phase(lds, v);
    } break;
    case 17: attn_phase(ws, lds, b); break;
    case 18: {
        Prob2D<EpiRes> g{(const char*)(ws + OFF_ATT), (const char*)(ws + OFF_W_O), 4096u, 4096u, 32, 64, 8, EpiRes{hb, hb, XN, (float*)(ws + OFF_SS) + (size_t)(b * 4 + 2) * S_}};
        gemm_phase(lds, g);
    } break;
    case 23: finalnorm_phase(hb, p->final_gain); break;
    default: break;
    }
}

#if MULTI
__global__ void __launch_bounds__(512) phase_kernel(Params p, int ph, int b) {
    extern __shared__ __attribute__((aligned(16))) unsigned char shm[];
    run_phase((CP)__builtin_amdgcn_kernarg_segment_ptr(), ph, b, (LAS unsigned char*)shm);
}
#else
__global__ void __launch_bounds__(512) mega_kernel(Params p) {
    extern __shared__ __attribute__((aligned(16))) unsigned char shm[];
    cg::grid_group grid = cg::this_grid();
    CP cp = (CP)__builtin_amdgcn_kernarg_segment_ptr();
    volatile LAS unsigned* st = (volatile LAS unsigned*)((LAS unsigned char*)shm + LDS_ST);
    if (threadIdx.x == 0) { st[0] = 0u; st[1] = 0u; st[2] = 0u; st[3] = 0u; }
    __syncthreads();
    XcdBarrier xb = xcd_barrier_post((unsigned*)(cp->ws + OFF_BAR), st);
    run_phase(cp, 0, 0, (LAS unsigned char*)shm);
    grid.sync();
    for (int b = 0; b < 2; ++b)
        for (int ph = 1; ph <= NPH; ++ph) {
            if (ph == 9 || ph == 13 || ph == 19) continue;
#ifdef PROBE_PH
            const int reps = (ph == PROBE_PH || ph == PROBE_PH2) ? 2 : 1;
#else
            const int reps = 1;
#endif
            for (int rep = 0; rep < reps; ++rep) { run_phase(cp, ph, b, (LAS unsigned char*)shm); xcd_barrier(xb); } }
}
#endif

constexpr int LDS_BYTES = LDS_ST + 16;
extern "C" void kernel_launch(void* const* d_in, const int* in_sizes, int n_in, void* d_out, int out_size, void* d_ws, size_t ws_size, hipStream_t stream) {
    static int grid = 0;
    if (grid == 0) {
        if (n_in != 21 || out_size != 2 * S_ * D_ || ws_size < WS_NEED) { fprintf(stderr, "kernel_launch: unexpected shapes/ws (n_in %d out %d ws %zu need %zu)\n", n_in, out_size, ws_size, (size_t)WS_NEED); grid = -1; return; }
#if MULTI
        if (hipFuncSetAttribute((const void*)phase_kernel, hipFuncAttributeMaxDynamicSharedMemorySize, LDS_BYTES) != hipSuccess) { fprintf(stderr, "hipFuncSetAttribute failed\n"); grid = -1; return; }
#else
        if (hipFuncSetAttribute((const void*)mega_kernel, hipFuncAttributeMaxDynamicSharedMemorySize, LDS_BYTES) != hipSuccess) { fprintf(stderr, "hipFuncSetAttribute failed\n"); grid = -1; return; }
#endif
        int dev = 0, cus = 0; hipGetDevice(&dev); hipDeviceGetAttribute(&cus, hipDeviceAttributeMultiprocessorCount, dev);
        grid = cus > 0 ? cus : 256;
    }
    if (grid < 0) return;
    Params p{};
    const float** pp = (const float**)&p;
    for (int i = 0; i < 21; ++i) pp[i] = (const float*)d_in[i];
    p.out = (float*)d_out; p.ws = (unsigned char*)d_ws;
#if MULTI
    hipLaunchKernelGGL(phase_kernel, dim3(grid), dim3(512), LDS_BYTES, stream, p, 0, 0);
    for (int b = 0; b < 2; ++b)
        for (int ph = 1; ph <= NPH; ++ph) hipLaunchKernelGGL(phase_kernel, dim3(grid), dim3(512), LDS_BYTES, stream, p, ph, b);
#else
    if (hipMemsetAsync((unsigned char*)d_ws + OFF_BAR, 0, (XCD_BAR_WORDS + 128) * 4, stream) != hipSuccess) { fprintf(stderr, "memset failed\n"); return; }
    void* args[] = {&p};
    hipError_t e = hipLaunchCooperativeKernel((const void*)mega_kernel, dim3(grid), dim3(512), args, LDS_BYTES, stream);
    if (e != hipSuccess) fprintf(stderr, "cooperative launch failed: %s (grid %d)\n", hipGetErrorString(e), grid);
#endif
}
```

```cpp
#include <hip/hip_runtime.h>
#include <hip/hip_cooperative_groups.h>
#include <cstdio>
namespace cg = cooperative_groups;

#ifndef MULTI
#define MULTI 0
#endif

#define LAS __attribute__((address_space(3)))
typedef unsigned short bf16_t;
typedef short bf16x8 __attribute__((ext_vector_type(8)));
typedef float f32x4 __attribute__((ext_vector_type(4)));
typedef unsigned u32x2 __attribute__((ext_vector_type(2)));
typedef unsigned u32x4 __attribute__((ext_vector_type(4)));

constexpr int S_ = 16384, D_ = 2048;
constexpr size_t MiB = 1048576;
constexpr size_t OFF_W_RIN = 0, OFF_W_ROUT = 48 * MiB, OFF_W_KV = 64 * MiB, OFF_W_C1K = 76 * MiB, OFF_W_C1V = 78 * MiB,
                 OFF_W_C2K = 80 * MiB, OFF_W_C2V = 80 * MiB + 131072, OFF_W_Q = 81 * MiB, OFF_W_O = 90 * MiB,
                 OFF_W_FIN = 98 * MiB  , OFF_W_FOUT = 162 * MiB  , OFF_ROPE = 194 * MiB, OFF_PEB = 210 * MiB, OFF_BAR = 210 * MiB + 65536, OFF_SS = 210 * MiB + 131072  ,
                 OFF_XN = 211 * MiB, OFF_ACT = 275 * MiB;
constexpr size_t OFF_Q = OFF_ACT, OFF_K = OFF_ACT + 64 * MiB, OFF_KTD = OFF_ACT + 128 * MiB, OFF_VT = OFF_ACT + 192 * MiB,
                 OFF_ST = OFF_ACT + 320 * MiB, OFF_SD = OFF_ACT + 448 * MiB, OFF_Y = OFF_ACT + 512 * MiB, OFF_GNS = OFF_ACT + 640 * MiB  , WS_NEED = OFF_ACT + 641 * MiB;
constexpr size_t OFF_U = OFF_ACT, OFF_AB = OFF_ACT + 256 * MiB;
constexpr size_t OFF_HN = OFF_ACT, OFF_KVTOK = OFF_ACT + 64 * MiB, OFF_KVT = OFF_ACT + 129 * MiB, OFF_QB = OFF_ACT + 161 * MiB,
                 OFF_GATES = OFF_ACT + 225 * MiB, OFF_H1 = OFF_ACT + 229 * MiB, OFF_KCMP = OFF_ACT + 233 * MiB, OFF_VCMPT = OFF_ACT + 234 * MiB,
                 OFF_ATT = OFF_ACT + 235 * MiB, OFF_OACC = OFF_ACT + 299 * MiB;

struct Params {
    const float* x; const float* norm_mix; const float* norm_ffn; const float* ret_w_in; const float* ret_gn; const float* ret_w_out;
    const float* kv_gain; const float* w_kv; const float* pe_k; const float* w1_k; const float* w2_k; const float* pe_v; const float* w1_v;
    const float* w2_v; const float* w_q; const float* w_o; const float* ffn_w_in; const float* ffn_conv_w; const float* ffn_conv_b;
    const float* ffn_w_out; const float* final_gain; float* out; unsigned char* ws;
};

typedef const __attribute__((address_space(4))) Params* CP;
__device__ __forceinline__ int ltid() { int t = threadIdx.x; asm volatile("" : "+v"(t)); return t; }
__device__ __forceinline__ unsigned pk_bf16(float lo, float hi) { unsigned r; asm("v_cvt_pk_bf16_f32 %0, %1, %2" : "=v"(r) : "v"(lo), "v"(hi)); return r; }
__device__ __forceinline__ float bflo(unsigned v) { return __uint_as_float(v << 16); }
__device__ __forceinline__ float bfhi(unsigned v) { return __uint_as_float(v & 0xffff0000u); }
__device__ __forceinline__ float fexp2(float x) { return __builtin_amdgcn_exp2f(x); }
__device__ __forceinline__ float frcp(float x) { return __builtin_amdgcn_rcpf(x); }
__device__ __forceinline__ float log2gamma(int h) { return log2f(1.0f - exp2f(-5.0f - (float)h)); }
__device__ __forceinline__ float sigmoidf_(float x) { return frcp(1.0f + fexp2(-1.4426950408889634f * x)); }

__device__ __forceinline__ float shx(float v, int m, int lane) { return __int_as_float(__builtin_amdgcn_ds_bpermute((lane ^ m) << 2, __float_as_int(v))); }
__device__ __forceinline__ unsigned long long shx64(unsigned long long v, int m, int lane) {
    const unsigned lo = (unsigned)__builtin_amdgcn_ds_bpermute((lane ^ m) << 2, (int)(unsigned)v), hi = (unsigned)__builtin_amdgcn_ds_bpermute((lane ^ m) << 2, (int)(unsigned)(v >> 32));
    return ((unsigned long long)hi << 32) | lo; }
__device__ __forceinline__ float wave_sum(float v, int lane) {
#pragma unroll
    for (int o = 32; o >= 1; o >>= 1) v += shx(v, o, lane);
    return v;
}
constexpr int HTB = 128 * 64 * 2;
__device__ __forceinline__ int lds_byte(int r, int c) { const int st = (r >> 4) * 2 + (c >> 5), rr = r & 15, cc = c & 31, ob = rr * 64 + cc * 2; return st * 1024 + (ob ^ (((ob >> 9) & 1) << 5)); }
__device__ __forceinline__ void stage_rc(int b, int& R, int& C) { const int st = b / 1024, sb = b % 1024, swz = sb ^ (((sb >> 9) & 1) << 5); R = (st >> 1) * 16 + swz / 64; C = (st & 1) * 32 + (swz % 64) / 2; }
__device__ __forceinline__ void tile_order(int L, int nM, int nN, int& pm, int& pn) {
    const int nwg = nM * nN; int wgid = L;
    { const int q = nwg / 8, r = nwg % 8, xcd = wgid % 8, off = wgid / 8; wgid = (xcd < r ? xcd * (q + 1) : r * (q + 1) + (xcd - r) * q) + off; }
    const int nig = 8 * nN, gid = wgid / nig, fm = gid * 8, gsz = (nM - fm) < 8 ? (nM - fm) : 8;
    pm = fm + ((wgid % nig) % gsz); pn = (wgid % nig) / gsz;
}
struct UInfo { const char* a; const char* b; int r0, c0, x0, x1; };
typedef f32x4 AccT[2][2][4][2];

template <class P>
__device__ __forceinline__ void gemm_phase(LAS unsigned char* lds, const P& pb, int cofs = 0) {
    const int tid = ltid(), wid = __builtin_amdgcn_readfirstlane(tid >> 6), lane = tid & 63, wr = wid >> 2, wc = wid & 3, fr = lane & 15, fq = lane >> 4;
    const int nt = pb.nt, G = gridDim.x, c = (int)blockIdx.x - cofs; const long nun = pb.nunits();
    if (c < 0 || c >= nun) return;
    unsigned voffA[2], voffB[2];
#pragma unroll
    for (int i = 0; i < 2; ++i) { int R, C; stage_rc(tid * 16 + i * 8192, R, C); voffA[i] = pb.rowA(R) + (unsigned)C * 2u; const int rho = R & 31; const int Rb = P::PERM ? ((R & ~31) + 8 * ((rho & 15) >> 2) + 4 * (rho >> 4) + (rho & 3)) : R; voffB[i] = (unsigned)Rb * pb.ldb + (unsigned)C * 2u; }
    const size_t hsA = pb.rowA(128), hsB = (size_t)128 * pb.ldb;
    const unsigned ldsw = (unsigned)wid * 1024u;
    const int aoff = lds_byte(wr * 64 + fr, fq * 8), boff = lds_byte(wc * 32 + fr, fq * 8);
#define G_SA(b, h) (((b) * 2 + (h)) * HTB)
#define G_SB(b, h) ((4 + (b) * 2 + (h)) * HTB)
#define G_STAGE(bufoff, gbase, voff) do { _Pragma("unroll") for (int _i = 0; _i < 2; ++_i) \
        __builtin_amdgcn_global_load_lds((const unsigned*)((const char*)(gbase) + (voff)[_i]), (LAS unsigned*)(lds + (bufoff) + ldsw + _i * 8192), 16, 0, 0); } while (0)
#define G_LDA(dst, b, h) do { _Pragma("unroll") for (int m = 0; m < 4; ++m) _Pragma("unroll") for (int k = 0; k < 2; ++k) dst[m][k] = *(const LAS bf16x8*)(lds + G_SA(b, h) + aoff + m * 2048 + k * 1024); } while (0)
#define G_LDB(dst, b, h) do { _Pragma("unroll") for (int n = 0; n < 2; ++n) _Pragma("unroll") for (int k = 0; k < 2; ++k) dst[n][k] = *(const LAS bf16x8*)(lds + G_SB(b, h) + boff + n * 2048 + k * 1024); } while (0)
#define G_MMA(ai, bj, At, Bt) do { __builtin_amdgcn_s_setprio(1); _Pragma("unroll") for (int m = 0; m < 4; ++m) _Pragma("unroll") for (int n = 0; n < 2; ++n) _Pragma("unroll") for (int k = 0; k < 2; ++k) \
        acc[ai][bj][m][n] = __builtin_amdgcn_mfma_f32_16x16x32_bf16(Bt[n][k], At[m][k], acc[ai][bj][m][n], 0, 0, 0); __builtin_amdgcn_s_setprio(0); } while (0)
#define G_WAIT_V(n) asm volatile("s_waitcnt vmcnt(" #n ")" ::: "memory")
#define G_WAIT_L(n) asm volatile("s_waitcnt lgkmcnt(" #n ")" ::: "memory")
#define G_BAR __builtin_amdgcn_s_barrier()
#define G_SCHED __builtin_amdgcn_sched_barrier(0)
    UInfo cur, nxt; int ui = 0;
    pb.unit(c, cur);
    AccT acc;
#pragma unroll
    for (int a = 0; a < 2; ++a)
#pragma unroll
        for (int b = 0; b < 2; ++b)
#pragma unroll
            for (int m = 0; m < 4; ++m)
#pragma unroll
                for (int n = 0; n < 2; ++n) acc[a][b][m][n] = (f32x4){0.f, 0.f, 0.f, 0.f};
    bf16x8 At[4][2], B0[2][2], B1[2][2];
    const char* cA = cur.a; const char* cB = cur.b;
    G_STAGE(G_SB(0, 0), cB + pb.bK(0), voffB); G_STAGE(G_SA(0, 0), cA + pb.aK(0), voffA); G_STAGE(G_SB(0, 1), cB + hsB + pb.bK(0), voffB); G_STAGE(G_SA(0, 1), cA + hsA + pb.aK(0), voffA);
    if (wr == 1) G_BAR;
    G_WAIT_V(4); G_BAR;
    G_STAGE(G_SB(1, 0), cB + pb.bK(1), voffB); G_STAGE(G_SA(1, 0), cA + pb.aK(1), voffA); G_STAGE(G_SB(1, 1), cB + hsB + pb.bK(1), voffB);
    G_WAIT_V(6); G_BAR;
    for (;;) {
        const long Ln = (long)(ui + 1) * G + c; const bool has_next = Ln < nun;
        if (has_next) pb.unit(Ln, nxt);
        const char* nA = has_next ? nxt.a : cA; const char* nB = has_next ? nxt.b : cB;
        for (int t = 0; t < nt; t += 2) {
            const bool last = (t == nt - 2);
            const char* a1 = cA + pb.aK(t + 1);
            const char* a2 = last ? nA + pb.aK(0) : cA + pb.aK(t + 2); const char* b2 = last ? nB + pb.bK(0) : cB + pb.bK(t + 2);
            const char* a3 = last ? nA + pb.aK(1) : cA + pb.aK(t + 3); const char* b3 = last ? nB + pb.bK(1) : cB + pb.bK(t + 3);
            G_LDB(B0, 0, 0); G_SCHED; G_LDA(At, 0, 0); G_STAGE(G_SA(1, 1), a1 + hsA, voffA);
            G_WAIT_L(8); G_BAR; G_WAIT_L(0); G_MMA(0, 0, At, B0); G_BAR; G_SCHED;
            G_LDB(B1, 0, 1); G_STAGE(G_SB(0, 0), b2, voffB);
            G_BAR; G_WAIT_L(0); G_MMA(0, 1, At, B1); G_BAR;
            G_LDA(At, 0, 1); G_STAGE(G_SA(0, 0), a2, voffA);
            G_BAR; G_WAIT_L(0); G_MMA(1, 0, At, B0); G_BAR; G_SCHED;
            G_STAGE(G_SB(0, 1), b2 + hsB, voffB);
            G_WAIT_V(6); G_BAR; G_MMA(1, 1, At, B1); G_BAR;
            G_LDB(B0, 1, 0); G_SCHED; G_LDA(At, 1, 0); G_STAGE(G_SA(0, 1), a2 + hsA, voffA);
            G_WAIT_L(8); G_BAR; G_WAIT_L(0); G_MMA(0, 0, At, B0); G_BAR; G_SCHED;
            G_LDB(B1, 1, 1); G_STAGE(G_SB(1, 0), b3, voffB);
            G_BAR; G_WAIT_L(0); G_MMA(0, 1, At, B1); G_BAR;
            G_LDA(At, 1, 1); G_STAGE(G_SA(1, 0), a3, voffA);
            G_BAR; G_WAIT_L(0); G_MMA(1, 0, At, B0); G_BAR; G_SCHED;
            G_STAGE(G_SB(1, 1), b3 + hsB, voffB);
            G_WAIT_V(6); G_BAR; G_MMA(1, 1, At, B1); G_BAR;
        }
        { const int l2 = ltid() & 63; pb.epi(acc, cur, wr, wc, l2 & 15, l2 >> 4); }
        if (!has_next) break;
#pragma unroll
        for (int a = 0; a < 2; ++a)
#pragma unroll
            for (int b = 0; b < 2; ++b)
#pragma unroll
                for (int m = 0; m < 4; ++m)
#pragma unroll
                    for (int n = 0; n < 2; ++n) acc[a][b][m][n] = (f32x4){0.f, 0.f, 0.f, 0.f};
        cur = nxt; cA = nA; cB = nB; ++ui;
    }
    G_WAIT_V(0);
    if (wr == 0) G_BAR;
    G_BAR;
}

#define EPI_ROWS for (int ai = 0; ai < 2; ++ai) for (int m = 0; m < 4; ++m)
#define EPI_COLS for (int bj = 0; bj < 2; ++bj) for (int n = 0; n < 2; ++n)
#define EPI_ROW (128 * ai + 64 * wr + 16 * m + fr)
#define EPI_COL (128 * bj + 32 * wc + 16 * n + 4 * fq)

template <class Epi> struct Prob2D {
    static constexpr bool PERM = Epi::PERM;
    const char* A; const char* B; unsigned lda, ldb; int nt, nM, nN; Epi e;
    __device__ __forceinline__ long nunits() const { return (long)nM * nN; }
    __device__ __forceinline__ unsigned rowA(int R) const { return (unsigned)R * lda; }
    __device__ __forceinline__ void unit(long L, UInfo& u) const { int pm, pn; tile_order((int)L, nM, nN, pm, pn); u.a = A + (size_t)pm * 256 * lda; u.b = B + (size_t)pn * 256 * ldb; u.r0 = pm * 256; u.c0 = pn * 256; u.x0 = 0; u.x1 = 0; }
    __device__ __forceinline__ size_t aK(int kt) const { return (size_t)kt * 128; }
    __device__ __forceinline__ size_t bK(int kt) const { return (size_t)kt * 128; }
    __device__ __forceinline__ void epi(const AccT& acc, const UInfo& u, int wr, int wc, int fr, int fq) const { e(acc, u, wr, wc, fr, fq); }
};
struct EpiStore { static constexpr bool PERM = true; bf16_t* O; size_t ldc;
    __device__ __forceinline__ void operator()(const AccT& acc, const UInfo& u, int wr, int wc, int fr, int fq) const {
#pragma unroll
        EPI_ROWS { bf16_t* rp = O + (size_t)(u.r0 + EPI_ROW) * ldc + u.c0;
#pragma unroll
            for (int bj = 0; bj < 2; ++bj) { const f32x4 v = acc[ai][bj][m][0], v2 = acc[ai][bj][m][1]; *(u32x4*)(rp + 128 * bj + 32 * wc + 8 * fq) = (u32x4){pk_bf16(v[0], v[1]), pk_bf16(v[2], v[3]), pk_bf16(v2[0], v2[1]), pk_bf16(v2[2], v2[3])}; } }
    } };
struct EpiRes { static constexpr bool PERM = false; const float* R; float* O; bf16_t* HB; float* ss;
    __device__ __forceinline__ void operator()(const AccT& acc, const UInfo& u, int wr, int wc, int fr, int fq) const {
#pragma unroll
        EPI_ROWS { const size_t ro = (size_t)(u.r0 + EPI_ROW) * 2048 + u.c0; float sq = 0.f;
#pragma unroll
            EPI_COLS { const f32x4 r = *(const f32x4*)(R + ro + EPI_COL); const f32x4 o = r + acc[ai][bj][m][n]; *(f32x4*)(O + ro + EPI_COL) = o;
                if (HB) { *(u32x2*)(HB + ro + EPI_COL) = (u32x2){pk_bf16(o[0], o[1]), pk_bf16(o[2], o[3])}; sq += o[0] * o[0] + o[1] * o[1] + o[2] * o[2] + o[3] * o[3]; } }
            if (HB) { const int lane = fq * 16 + fr; sq += shx(sq, 16, lane); sq += shx(sq, 32, lane); if (fq == 0) atomicAdd(ss + u.r0 + EPI_ROW, sq); } }
    } };
struct EpiStoreRS { static constexpr bool PERM = true; bf16_t* O; size_t ldc; const float* ss;
    __device__ __forceinline__ void operator()(const AccT& acc, const UInfo& u, int wr, int wc, int fr, int fq) const {
#pragma unroll
        EPI_ROWS { const int row = u.r0 + EPI_ROW; const float rs = rsqrtf(ss[row] * (1.0f / 2048.0f) + 1e-6f); bf16_t* rp = O + (size_t)row * ldc + u.c0;
#pragma unroll
            for (int bj = 0; bj < 2; ++bj) { const f32x4 v = acc[ai][bj][m][0] * rs, v2 = acc[ai][bj][m][1] * rs; *(u32x4*)(rp + 128 * bj + 32 * wc + 8 * fq) = (u32x4){pk_bf16(v[0], v[1]), pk_bf16(v[2], v[3]), pk_bf16(v2[0], v2[1]), pk_bf16(v2[2], v2[3])}; } }
    } };
struct EpiStoreCS { static constexpr bool PERM = true; bf16_t* O; size_t ldc; const float* ss;
    __device__ __forceinline__ void operator()(const AccT& acc, const UInfo& u, int wr, int wc, int fr, int fq) const {
        f32x4 rs[2][2];
#pragma unroll
        for (int bj = 0; bj < 2; ++bj)
#pragma unroll
            for (int n = 0; n < 2; ++n) { const f32x4 s4 = *(const f32x4*)(ss + u.c0 + 128 * bj + 32 * wc + 8 * fq + 4 * n);
#pragma unroll
                for (int j = 0; j < 4; ++j) rs[bj][n][j] = rsqrtf(s4[j] * (1.0f / 2048.0f) + 1e-6f); }
#pragma unroll
        EPI_ROWS { bf16_t* rp = O + (size_t)(u.r0 + EPI_ROW) * ldc + u.c0;
#pragma unroll
            for (int bj = 0; bj < 2; ++bj) { const f32x4 v = acc[ai][bj][m][0] * rs[bj][0], v2 = acc[ai][bj][m][1] * rs[bj][1]; *(u32x4*)(rp + 128 * bj + 32 * wc + 8 * fq) = (u32x4){pk_bf16(v[0], v[1]), pk_bf16(v[2], v[3]), pk_bf16(v2[0], v2[1]), pk_bf16(v2[2], v2[3])}; } }
    } };
struct EpiGate { static constexpr bool PERM = true; bf16_t* Y; const float2* gns; const float* gain;
    __device__ __forceinline__ void operator()(const AccT& acc, const UInfo& u, int wr, int wc, int fr, int fq) const {
        const int hh = u.c0 >> 9;
#pragma unroll
        EPI_ROWS { const int row = u.r0 + EPI_ROW; bf16_t* rp = Y + (size_t)row * 4096 + u.c0;
            const float2 sg = gns[(size_t)row * 8 + hh]; const float mu = sg.x, rs = sg.y;
#pragma unroll
            for (int bj = 0; bj < 2; ++bj) { const f32x4 g = acc[ai][bj][m][0], h = acc[ai][bj][m][1]; bf16_t* cp = rp + 128 * bj + 32 * wc + 8 * fq; const u32x4 y = *(const u32x4*)cp;
                const float* gp = gain + u.c0 + 128 * bj + 32 * wc + 8 * fq; const f32x4 g0 = *(const f32x4*)gp * rs, g1 = *(const f32x4*)(gp + 4) * rs;
                const float o0 = g[0] * sigmoidf_(g[0]) * (bflo(y[0]) - mu) * g0[0], o1 = g[1] * sigmoidf_(g[1]) * (bfhi(y[0]) - mu) * g0[1], o2 = g[2] * sigmoidf_(g[2]) * (bflo(y[1]) - mu) * g0[2], o3 = g[3] * sigmoidf_(g[3]) * (bfhi(y[1]) - mu) * g0[3];
                const float o4 = h[0] * sigmoidf_(h[0]) * (bflo(y[2]) - mu) * g1[0], o5 = h[1] * sigmoidf_(h[1]) * (bfhi(y[2]) - mu) * g1[1], o6 = h[2] * sigmoidf_(h[2]) * (bflo(y[3]) - mu) * g1[2], o7 = h[3] * sigmoidf_(h[3]) * (bfhi(y[3]) - mu) * g1[3];
                *(u32x4*)cp = (u32x4){pk_bf16(o0, o1), pk_bf16(o2, o3), pk_bf16(o4, o5), pk_bf16(o6, o7)}; } }
    } };
struct EpiQK { static constexpr bool PERM = false; bf16_t* Q; bf16_t* K; bf16_t* KTD; const float2* rope;
    __device__ __forceinline__ void operator()(const AccT& acc, const UInfo& u, int wr, int wc, int fr, int fq) const {
        const int hidx = u.c0 >> 8; const bool isk = hidx >= 8; const int hh = hidx & 7; const float l2g = log2gamma(hh);
        bf16_t* dst = (isk ? K : Q) + hh * 256; const float sc = isk ? 0.0625f : 1.0f;
#pragma unroll
        EPI_ROWS { const int t = u.r0 + EPI_ROW; const float kd = fexp2((float)(255 - (t & 255)) * l2g);
#pragma unroll
            for (int n = 0; n < 2; ++n) { const int dd = 32 * wc + 16 * n + 4 * fq;
                const f32x4 x1 = acc[ai][0][m][n], x2 = acc[ai][1][m][n]; const f32x4 cs0 = *(const f32x4*)(rope + (size_t)t * 128 + dd), cs1 = *(const f32x4*)(rope + (size_t)t * 128 + dd + 2);
                float y1[4], y2[4];
                y1[0] = (x1[0] * cs0[0] - x2[0] * cs0[1]) * sc; y2[0] = (x1[0] * cs0[1] + x2[0] * cs0[0]) * sc;
                y1[1] = (x1[1] * cs0[2] - x2[1] * cs0[3]) * sc; y2[1] = (x1[1] * cs0[3] + x2[1] * cs0[2]) * sc;
                y1[2] = (x1[2] * cs1[0] - x2[2] * cs1[1]) * sc; y2[2] = (x1[2] * cs1[1] + x2[2] * cs1[0]) * sc;
                y1[3] = (x1[3] * cs1[2] - x2[3] * cs1[3]) * sc; y2[3] = (x1[3] * cs1[3] + x2[3] * cs1[2]) * sc;
                *(u32x2*)(dst + (size_t)t * 2048 + dd) = (u32x2){pk_bf16(y1[0], y1[1]), pk_bf16(y1[2], y1[3])};
                *(u32x2*)(dst + (size_t)t * 2048 + 128 + dd) = (u32x2){pk_bf16(y2[0], y2[1]), pk_bf16(y2[2], y2[3])};
                if (isk) {
#pragma unroll
                    for (int j = 0; j < 4; ++j) { KTD[(size_t)(hh * 256 + dd + j) * S_ + t] = (bf16_t)(pk_bf16(y1[j] * kd, 0.f) & 0xffffu); KTD[(size_t)(hh * 256 + 128 + dd + j) * S_ + t] = (bf16_t)(pk_bf16(y2[j] * kd, 0.f) & 0xffffu); }
                } } }
    } };
struct EpiQproj { static constexpr bool PERM = false; bf16_t* QB; float* gates; const float* ss;
    __device__ __forceinline__ void operator()(const AccT& acc, const UInfo& u, int wr, int wc, int fr, int fq) const {
#pragma unroll
        EPI_ROWS { const int t = u.r0 + EPI_ROW; const float rs = rsqrtf(ss[t] * (1.0f / 2048.0f) + 1e-6f);
#pragma unroll
            EPI_COLS { const int col = u.c0 + EPI_COL; const f32x4 v = acc[ai][bj][m][n] * rs;
                if (col < 2048) *(u32x2*)(QB + (size_t)t * 2048 + col) = (u32x2){pk_bf16(v[0] * 0.08838834764831845f, v[1] * 0.08838834764831845f), pk_bf16(v[2] * 0.08838834764831845f, v[3] * 0.08838834764831845f)};
                else if (col < 2096) *(f32x4*)(gates + (size_t)t * 48 + (col - 2048)) = (f32x4){sigmoidf_(v[0]), sigmoidf_(v[1]), sigmoidf_(v[2]), sigmoidf_(v[3])}; } }
    } };
__device__ __forceinline__ float gelu_tanh(float x) { const float y = 0.7978845608028654f * (x + 0.044715f * x * x * x); const float e = fexp2(2.0f * 1.4426950408889634f * y); const float th = 1.0f - 2.0f * frcp(e + 1.0f); return 0.5f * x * (1.0f + th); }
struct EpiGelu { static constexpr bool PERM = false; bf16_t* H; const float* bias;
    __device__ __forceinline__ void operator()(const AccT& acc, const UInfo& u, int wr, int wc, int fr, int fq) const {
#pragma unroll
        EPI_ROWS { bf16_t* rp = H + (size_t)(u.r0 + EPI_ROW) * 256;
#pragma unroll
            EPI_COLS { const int col = EPI_COL; const f32x4 v = acc[ai][bj][m][n]; const f32x4 bb = *(const f32x4*)(bias + col);
                *(u32x2*)(rp + col) = (u32x2){pk_bf16(gelu_tanh(v[0] + bb[0]), gelu_tanh(v[1] + bb[1])), pk_bf16(gelu_tanh(v[2] + bb[2]), gelu_tanh(v[3] + bb[3]))}; } }
    } };
struct EpiKcmp { static constexpr bool PERM = false; bf16_t* KC;
    __device__ __forceinline__ void operator()(const AccT& acc, const UInfo& u, int wr, int wc, int fr, int fq) const {
#pragma unroll
        EPI_ROWS { const int r = u.r0 + EPI_ROW, i = r >> 2, h = r & 3;
#pragma unroll
            for (int n = 0; n < 2; ++n) { const int col = 32 * wc + 16 * n + 4 * fq; f32x4 v = acc[ai][0][m][n]; if (i == 1023) v = (f32x4){0.f, 0.f, 0.f, 0.f};
                *(u32x2*)(KC + ((size_t)h * 1024 + i) * 128 + col) = (u32x2){pk_bf16(v[0], v[1]), pk_bf16(v[2], v[3])}; } }
    } };
struct EpiVcmp { static constexpr bool PERM = false; bf16_t* VC;
    __device__ __forceinline__ void operator()(const AccT& acc, const UInfo& u, int wr, int wc, int fr, int fq) const {
#pragma unroll
        for (int m = 0; m < 4; ++m) { const int d = 64 * wr + 16 * m + fr;
#pragma unroll
            EPI_COLS { const int col = u.c0 + EPI_COL, i = col >> 2; f32x4 v = acc[0][bj][m][n]; if (i == 1023) v = (f32x4){0.f, 0.f, 0.f, 0.f};
#pragma unroll
                for (int h = 0; h < 4; ++h) VC[((size_t)h * 128 + d) * 1024 + i] = (bf16_t)(pk_bf16(v[h], 0.f) & 0xffffu); } }
    } };
struct ProbCmp1 {
    static constexpr bool PERM = false;
    const char* A; const char* B; unsigned ldb; int nt, nM; EpiGelu e;
    __device__ __forceinline__ long nunits() const { return nM; }
    __device__ __forceinline__ unsigned rowA(int R) const { return (unsigned)(R >> 2) * 65536u + (unsigned)(R & 3) * 256u; }
    __device__ __forceinline__ void unit(long L, UInfo& u) const { u.a = A + (size_t)L * 64 * 65536; u.b = B; u.r0 = (int)L * 256; u.c0 = 0; u.x0 = 0; u.x1 = 0; }
    __device__ __forceinline__ size_t aK(int kt) const { return (size_t)(kt >> 1) * 4096 + (size_t)(kt & 1) * 128; }
    __device__ __forceinline__ size_t bK(int kt) const { return (size_t)kt * 128; }
    __device__ __forceinline__ void epi(const AccT& acc, const UInfo& u, int wr, int wc, int fr, int fq) const { e(acc, u, wr, wc, fr, fq); }
};
struct ProbKV {
    static constexpr bool PERM = true;
    const char* VT; const char* KTD; bf16_t* ST; int nt;
    __device__ __forceinline__ long nunits() const { return 8 * 64 * 2; }
    __device__ __forceinline__ unsigned rowA(int R) const { return (unsigned)R * 32768u; }
    static constexpr unsigned ldb = 32768u;
    __device__ __forceinline__ void unit(long L, UInfo& u) const { const int pm = (int)L & 1, c = ((int)L >> 1) & 63, h = (int)L >> 7;
        u.a = VT + ((size_t)(h * 512 + pm * 256) * S_ + c * 256) * 2; u.b = KTD + ((size_t)(h * 256) * S_ + c * 256) * 2; u.r0 = h * 512 + pm * 256; u.c0 = c * 256; u.x0 = 0; u.x1 = 0; }
    __device__ __forceinline__ size_t aK(int kt) const { return (size_t)kt * 128; }
    __device__ __forceinline__ size_t bK(int kt) const { return (size_t)kt * 128; }
    __device__ __forceinline__ void epi(const AccT& acc, const UInfo& u, int wr, int wc, int fr, int fq) const { EpiStore e{ST, (size_t)S_}; e(acc, u, wr, wc, fr, fq); }
};
struct ProbS {
    static constexpr bool PERM = true;
    const char* Q; const char* K; bf16_t* SD; int nt;
    __device__ __forceinline__ long nunits() const { return 8 * 64; }
    __device__ __forceinline__ unsigned rowA(int R) const { return (unsigned)R * 4096u; }
    static constexpr unsigned ldb = 4096u;
    __device__ __forceinline__ void unit(long L, UInfo& u) const { const int c = (int)L & 63, h = (int)L >> 6; const size_t o = ((size_t)(c * 256) * 2048 + h * 256) * 2;
        u.a = Q + o; u.b = K + o; u.r0 = c * 256; u.c0 = h * 256; u.x0 = h; u.x1 = 0; }
    __device__ __forceinline__ size_t aK(int kt) const { return (size_t)kt * 128; }
    __device__ __forceinline__ size_t bK(int kt) const { return (size_t)kt * 128; }
    __device__ __forceinline__ void epi(const AccT& acc, const UInfo& u, int wr, int wc, int fr, int fq) const {
        const float l2g = log2gamma(u.x0);
#pragma unroll
        EPI_ROWS { const int i = EPI_ROW; bf16_t* rp = SD + (size_t)(u.r0 + i) * 2048 + u.c0;
#pragma unroll
            for (int bj = 0; bj < 2; ++bj) { const int s = 128 * bj + 32 * wc + 8 * fq; const f32x4 v = acc[ai][bj][m][0], v2 = acc[ai][bj][m][1]; float o[8];
#pragma unroll
                for (int j = 0; j < 4; ++j) { o[j] = (s + j <= i) ? v[j] * fexp2(-(float)(s + j + 1) * l2g) : 0.f; o[4 + j] = (s + 4 + j <= i) ? v2[j] * fexp2(-(float)(s + 4 + j + 1) * l2g) : 0.f; }
                *(u32x4*)(rp + s) = (u32x4){pk_bf16(o[0], o[1]), pk_bf16(o[2], o[3]), pk_bf16(o[4], o[5]), pk_bf16(o[6], o[7])}; } }
    }
};
struct ProbOut {
    static constexpr bool PERM = true;
    const char* Q; const char* ST; long dA, dB; bf16_t* Y; int nt;
    __device__ __forceinline__ long nunits() const { return 8 * 64 * 2; }
    __device__ __forceinline__ unsigned rowA(int R) const { return (unsigned)R * 4096u; }
    static constexpr unsigned ldb = 32768u;
    __device__ __forceinline__ void unit(long L, UInfo& u) const { const int pn = (int)L & 1, c = ((int)L >> 1) & 63, h = (int)L >> 7;
        u.a = Q + ((size_t)(c * 256) * 2048 + h * 256) * 2; u.b = ST + ((size_t)(h * 512 + pn * 256) * S_ + c * 256) * 2; u.r0 = c * 256; u.c0 = h * 512 + pn * 256; u.x0 = h; u.x1 = 0; }
    __device__ __forceinline__ size_t aK(int kt) const { return kt < 4 ? (size_t)kt * 128 : (size_t)(dA + (long)(kt - 4) * 128); }
    __device__ __forceinline__ size_t bK(int kt) const { return kt < 4 ? (size_t)kt * 128 : (size_t)(dB + (long)(kt - 4) * 128); }
    __device__ __forceinline__ void epi(const AccT& acc, const UInfo& u, int wr, int wc, int fr, int fq) const {
        const float l2g = log2gamma(u.x0);
#pragma unroll
        EPI_ROWS { const int i = EPI_ROW; const float qd = fexp2((float)(i + 1) * l2g); bf16_t* rp = Y + (size_t)(u.r0 + i) * 4096 + u.c0;
#pragma unroll
            for (int bj = 0; bj < 2; ++bj) { const f32x4 v = acc[ai][bj][m][0] * qd, v2 = acc[ai][bj][m][1] * qd; *(u32x4*)(rp + 128 * bj + 32 * wc + 8 * fq) = (u32x4){pk_bf16(v[0], v[1]), pk_bf16(v[2], v[3]), pk_bf16(v2[0], v2[1]), pk_bf16(v2[2], v2[3])}; } }
    }
};

__device__ __forceinline__ void transpose_job(const float* __restrict__ src, bf16_t* __restrict__ dst, int K, int N, int Npad, int kvperm, LAS float* tile, const float* gain = nullptr) {
    const int tk = K / 64, tn = Npad / 256, ntile = tk * tn; const int tid = ltid();
    for (int t = blockIdx.x; t < ntile; t += gridDim.x) {
        const int k0 = (t % tk) * 64, n0 = (t / tk) * 256;
        { const int r0 = tid >> 6, cc = tid & 63; float v[8][4];
#pragma unroll
          for (int i = 0; i < 8; ++i)
#pragma unroll
              for (int q = 0; q < 4; ++q) { const int n = n0 + cc + 64 * q; v[i][q] = (n < N) ? src[(size_t)(k0 + r0 + 8 * i) * N + n] : 0.f; }
#pragma unroll
          for (int i = 0; i < 8; ++i) { const float gk = gain ? gain[k0 + r0 + 8 * i] : 1.0f;
#pragma unroll
              for (int q = 0; q < 4; ++q) tile[(r0 + 8 * i) * 257 + cc + 64 * q] = v[i][q] * gk; } }
        __syncthreads();
        { const int rr = tid >> 1, c0 = (tid & 1) * 32;
          int n = n0 + rr; if (kvperm) { const int j = n >> 9; const int jp = (j == 3) ? 4 : ((j == 4) ? 3 : j); n = jp * 512 + (n & 511); }
          bf16_t* dp = dst + (size_t)n * K + k0 + c0;
#pragma unroll
          for (int g = 0; g < 4; ++g) { float x[8];
#pragma unroll
              for (int j = 0; j < 8; ++j) x[j] = tile[(c0 + 8 * g + j) * 257 + rr];
              *(u32x4*)(dp + 8 * g) = (u32x4){pk_bf16(x[0], x[1]), pk_bf16(x[2], x[3]), pk_bf16(x[4], x[5]), pk_bf16(x[6], x[7])}; } }
        __syncthreads();
    }
}
__device__ __forceinline__ void prep_phase(CP p, LAS unsigned char* lds) {
    LAS float* tile = (LAS float*)lds; unsigned char* ws = p->ws;
    transpose_job(p->ret_w_in, (bf16_t*)(ws + OFF_W_RIN), 2048, 12288, 12288, 0, tile);
    transpose_job(p->ret_w_out, (bf16_t*)(ws + OFF_W_ROUT), 4096, 2048, 2048, 0, tile);
    transpose_job(p->w_kv, (bf16_t*)(ws + OFF_W_KV), 2048, 3072, 3072, 1, tile, p->kv_gain);
    transpose_job(p->w1_k, (bf16_t*)(ws + OFF_W_C1K), 4096, 256, 256, 0, tile);
    transpose_job(p->w1_v, (bf16_t*)(ws + OFF_W_C1V), 4096, 256, 256, 0, tile);
    transpose_job(p->w2_k, (bf16_t*)(ws + OFF_W_C2K), 256, 128, 256, 0, tile);
    transpose_job(p->w2_v, (bf16_t*)(ws + OFF_W_C2V), 256, 128, 256, 0, tile);
    transpose_job(p->w_q, (bf16_t*)(ws + OFF_W_Q), 2048, 2096, 2304, 0, tile, p->norm_mix + 2048);
    transpose_job(p->w_o, (bf16_t*)(ws + OFF_W_O), 2048, 2048, 2048, 0, tile);
    transpose_job(p->ffn_w_in, (bf16_t*)(ws + OFF_W_FIN), 2048, 8192, 8192, 0, tile, p->norm_ffn);
    transpose_job(p->ffn_w_in + (size_t)2048 * 8192, (bf16_t*)(ws + OFF_W_FIN + 32 * MiB), 2048, 8192, 8192, 0, tile, p->norm_ffn + 2048);
    transpose_job(p->ffn_w_out, (bf16_t*)(ws + OFF_W_FOUT), 4096, 2048, 2048, 0, tile);
    transpose_job(p->ffn_w_out + (size_t)4096 * 2048, (bf16_t*)(ws + OFF_W_FOUT + 16 * MiB), 4096, 2048, 2048, 0, tile);
    { float* ss = (float*)(ws + OFF_SS); for (int i = blockIdx.x * 512 + ltid(); i < 8 * S_; i += gridDim.x * 512) ss[i] = 0.f; }
    { float2* rope = (float2*)(ws + OFF_ROPE); const int gsz = gridDim.x * 512;
      for (int i = blockIdx.x * 512 + ltid(); i < S_ * 128; i += gsz) { const int t = i >> 7, dd = i & 127;
          const float freq = exp2f(-(float)dd * (13.287712379549449f / 128.0f)); const double rev = (double)t * (double)freq * 0.15915494309189535;
          const float fx = (float)(rev - rint(rev)); rope[i] = make_float2(__builtin_amdgcn_cosf(fx), __builtin_amdgcn_sinf(fx)); } }
    if (blockIdx.x < 128) { const int kv = blockIdx.x >> 6, oc = blockIdx.x & 63; const float* pe = kv ? p->pe_v : p->pe_k; const float* w1 = kv ? p->w1_v : p->w1_k; float* peb = (float*)(ws + OFF_PEB) + kv * 256;
        const int tid = ltid(), g = tid >> 7, r = tid & 127, n = 4 * oc + g; float s = 0.f;
#pragma unroll 8
        for (int j = 0; j < 32; ++j) { const int k = r + 128 * j; s += pe[k] * w1[(size_t)k * 256 + n]; }
        s = wave_sum(s, tid & 63);
        __syncthreads(); if ((tid & 63) == 0) tile[tid >> 6] = s; __syncthreads();
        if (tid < 4) peb[4 * oc + tid] = tile[2 * tid] + tile[2 * tid + 1];
        __syncthreads(); }
}
__device__ __forceinline__ void rmsnorm_phase(const float* h, const float* g1, bf16_t* o1, const float* g2, bf16_t* o2) {
    const int w = ltid() >> 6, lane = ltid() & 63;
    for (int row = blockIdx.x * 8 + w; row < S_; row += gridDim.x * 8) {
        const f32x4* p = (const f32x4*)(h + (size_t)row * 2048); f32x4 v[8]; float ss = 0.f;
#pragma unroll
        for (int i = 0; i < 8; ++i) { v[i] = p[lane + 64 * i]; ss += v[i][0] * v[i][0] + v[i][1] * v[i][1] + v[i][2] * v[i][2] + v[i][3] * v[i][3]; }
        ss = wave_sum(ss, lane); const float r = rsqrtf(ss * (1.0f / 2048.0f) + 1e-6f);
#pragma unroll
        for (int i = 0; i < 8; ++i) { const int col = (lane + 64 * i) * 4; const f32x4 g = *(const f32x4*)(g1 + col);
            *(u32x2*)(o1 + (size_t)row * 2048 + col) = (u32x2){pk_bf16(v[i][0] * r * g[0], v[i][1] * r * g[1]), pk_bf16(v[i][2] * r * g[2], v[i][3] * r * g[3])};
            if (o2) { const f32x4 gg = *(const f32x4*)(g2 + col);
                *(u32x2*)(o2 + (size_t)row * 2048 + col) = (u32x2){pk_bf16(v[i][0] * r * gg[0], v[i][1] * r * gg[1]), pk_bf16(v[i][2] * r * gg[2], v[i][3] * r * gg[3])}; } }
    }
}
__device__ __forceinline__ void finalnorm_phase(float* h, const float* g1) {
    const int w = ltid() >> 6, lane = ltid() & 63;
    for (int row = blockIdx.x * 8 + w; row < S_; row += gridDim.x * 8) {
        f32x4* p = (f32x4*)(h + (size_t)row * 2048); f32x4 v[8]; float ss = 0.f;
#pragma unroll
        for (int i = 0; i < 8; ++i) { v[i] = p[lane + 64 * i]; ss += v[i][0] * v[i][0] + v[i][1] * v[i][1] + v[i][2] * v[i][2] + v[i][3] * v[i][3]; }
        ss = wave_sum(ss, lane); const float r = rsqrtf(ss * (1.0f / 2048.0f) + 1e-6f);
#pragma unroll
        for (int i = 0; i < 8; ++i) { const f32x4 g = *(const f32x4*)(g1 + (lane + 64 * i) * 4); p[lane + 64 * i] = v[i] * r * g; }
    }
}
__device__ __forceinline__ void scan_phase(bf16_t* ST) {
    for (int it = blockIdx.x * 512 + ltid(); it < 4096 * 32; it += gridDim.x * 512) {
        const int r = it >> 5, d8 = it & 31; const float cd = fexp2(256.0f * log2gamma(r >> 9));
        bf16_t* p = ST + (size_t)r * S_ + d8 * 8; float s[8];
#pragma unroll
        for (int j = 0; j < 8; ++j) s[j] = 0.f;
        for (int c = 0; c < 64; ++c) { const u32x4 v = *(const u32x4*)(p + c * 256);
            *(u32x4*)(p + c * 256) = (u32x4){pk_bf16(s[0], s[1]), pk_bf16(s[2], s[3]), pk_bf16(s[4], s[5]), pk_bf16(s[6], s[7])};
#pragma unroll
            for (int j = 0; j < 4; ++j) { s[2 * j] = s[2 * j] * cd + bflo(v[j]); s[2 * j + 1] = s[2 * j + 1] * cd + bfhi(v[j]); } }
    }
}
__device__ __forceinline__ void gn_phase(const bf16_t* Y, float2* gns) {
    const int w = ltid() >> 6, lane = ltid() & 63;
    for (int g = blockIdx.x * 8 + w; g < S_ * 8; g += gridDim.x * 8) {
        const u32x4 v = *(const u32x4*)(Y + (size_t)g * 512 + lane * 8); float x[8];
#pragma unroll
        for (int j = 0; j < 4; ++j) { x[2 * j] = bflo(v[j]); x[2 * j + 1] = bfhi(v[j]); }
        float s = 0.f;
#pragma unroll
        for (int j = 0; j < 8; ++j) s += x[j];
        const float mu = wave_sum(s, lane) * (1.0f / 512.0f); float q = 0.f;
#pragma unroll
        for (int j = 0; j < 8; ++j) { x[j] -= mu; q += x[j] * x[j]; }
        const float r = rsqrtf(wave_sum(q, lane) * (1.0f / 512.0f) + 1e-6f);
        if (lane == 0) gns[g] = make_float2(mu, r);
    }
}
__device__ __forceinline__ void conv_phase(const bf16_t* U, bf16_t* AB, const float* cw, const float* cb) {
    for (int it = blockIdx.x * 512 + ltid(); it < 512 * 512; it += gridDim.x * 512) {
        const int n8 = (it & 511) * 8, t0 = (it >> 9) * 32;
        float wa[3][8], wb[3][8], ba[8], bb[8];
#pragma unroll
        for (int tp = 0; tp < 3; ++tp)
#pragma unroll
            for (int j = 0; j < 8; ++j) { wa[tp][j] = cw[tp * 8192 + n8 + j]; wb[tp][j] = cw[tp * 8192 + 4096 + n8 + j]; }
#pragma unroll
        for (int j = 0; j < 8; ++j) { ba[j] = cb[n8 + j]; bb[j] = cb[4096 + n8 + j]; }
        float pa[2][8], pb[2][8];
#pragma unroll
        for (int k = 0; k < 2; ++k) { const int t = t0 - 2 + k; u32x4 va = (u32x4){0, 0, 0, 0}, vb = (u32x4){0, 0, 0, 0};
            if (t >= 0) { va = *(const u32x4*)(U + (size_t)t * 8192 + n8); vb = *(const u32x4*)(U + (size_t)t * 8192 + 4096 + n8); }
#pragma unroll
            for (int j = 0; j < 4; ++j) { pa[k][2 * j] = bflo(va[j]); pa[k][2 * j + 1] = bfhi(va[j]); pb[k][2 * j] = bflo(vb[j]); pb[k][2 * j + 1] = bfhi(vb[j]); } }
#pragma unroll 8
        for (int k = 0; k < 32; ++k) { const int t = t0 + k; const u32x4 va = *(const u32x4*)(U + (size_t)t * 8192 + n8), vb = *(const u32x4*)(U + (size_t)t * 8192 + 4096 + n8);
            float xa[8], xb[8], o[8];
#pragma unroll
            for (int j = 0; j < 4; ++j) { xa[2 * j] = bflo(va[j]); xa[2 * j + 1] = bfhi(va[j]); xb[2 * j] = bflo(vb[j]); xb[2 * j + 1] = bfhi(vb[j]); }
#pragma unroll
            for (int j = 0; j < 8; ++j) { const float a = ba[j] + wa[0][j] * pa[0][j] + wa[1][j] * pa[1][j] + wa[2][j] * xa[j]; const float b = bb[j] + wb[0][j] * pb[0][j] + wb[1][j] * pb[1][j] + wb[2][j] * xb[j];
                o[j] = a * sigmoidf_(a) * b; pa[0][j] = pa[1][j]; pa[1][j] = xa[j]; pb[0][j] = pb[1][j]; pb[1][j] = xb[j]; }
            *(u32x4*)(AB + (size_t)t * 4096 + n8) = (u32x4){pk_bf16(o[0], o[1]), pk_bf16(o[2], o[3]), pk_bf16(o[4], o[5]), pk_bf16(o[6], o[7])}; }
    }
}

constexpr int XCD_CTR_WORD = 3456;
constexpr int A_KT = 0, A_VT = 17408, A_BUFSZ = 34816, A_PSL = 69632, A_SEL = 4 * A_BUFSZ, LDS_ST = A_SEL + 2048;
constexpr float LOG2E = 1.4426950408889634f;
struct AttnState { f32x4 ot[8][2]; float m[2], l[2]; };

template <int MODE>
__device__ __forceinline__ void attn_compute(LAS unsigned char* lds, int boff, int tile, const bf16x8 (&qf)[2][4], AttnState& st, const int (&tpos)[2], int qb, int w, int lane,
                                             const float (&mfin)[2], const float (&linv)[2], bool rs0, bool rs1, bool masked, bool a0, bool a1) {
    const int l16 = lane & 15, g4 = lane >> 4;
    f32x4 s[4][2];
#pragma unroll
    for (int mt = 0; mt < 4; ++mt) { s[mt][0] = (f32x4){0.f, 0.f, 0.f, 0.f}; s[mt][1] = (f32x4){0.f, 0.f, 0.f, 0.f}; }
#pragma unroll
    for (int ks = 0; ks < 4; ++ks) {
        bf16x8 kf[4];
#pragma unroll
        for (int mt = 0; mt < 4; ++mt) kf[mt] = *(const LAS bf16x8*)(lds + boff + A_KT + (16 * mt + l16) * 272 + ks * 64 + g4 * 16);
        if (a0) {
#pragma unroll
            for (int mt = 0; mt < 4; ++mt) s[mt][0] = __builtin_amdgcn_mfma_f32_16x16x32_bf16(kf[mt], qf[0][ks], s[mt][0], 0, 0, 0);
        }
        if (a1) {
#pragma unroll
            for (int mt = 0; mt < 4; ++mt) s[mt][1] = __builtin_amdgcn_mfma_f32_16x16x32_bf16(kf[mt], qf[1][ks], s[mt][1], 0, 0, 0);
        }
        if (ks & 1) __builtin_amdgcn_sched_barrier(0);
    }
    if (masked) {
#pragma unroll
        for (int nt = 0; nt < 2; ++nt) { const int t = tpos[nt]; const int tl = w * 8 + nt * 4 + (l16 >> 2);
#pragma unroll
            for (int mt = 0; mt < 4; ++mt)
#pragma unroll
                for (int j = 0; j < 4; ++j) { const int kl = 16 * mt + 4 * g4 + j; const int key = tile * 64 + kl; bool v;
                    if (MODE == 0 || MODE == 1) v = key <= ((t - 31) >> 4);
                    else if (MODE == 2) v = (kl <= tl);
                    else v = (key <= t) && (key > t - 512);
                    s[mt][nt][j] = v ? s[mt][nt][j] : -__builtin_inff(); } }
    }
    bf16x8 pf[2][2];
#pragma unroll
    for (int nt = 0; nt < 2; ++nt) {
        if (nt ? a1 : a0) {
            const bool rowsel = nt ? rs1 : rs0;
            const float bias = (MODE == 2 && !rowsel) ? -__builtin_inff() : 0.f;
            float mx = -1e30f;
#pragma unroll
            for (int mt = 0; mt < 4; ++mt)
#pragma unroll
                for (int j = 0; j < 4; ++j) {
                    const float sv = s[mt][nt][j] * LOG2E + bias;
                    s[mt][nt][j] = sv; mx = fmaxf(mx, sv); }
            float mnew, alpha = 1.f;
            if (MODE == 1) mnew = mfin[nt];
            else { mx = fmaxf(mx, shx(mx, 16, lane)); mx = fmaxf(mx, shx(mx, 32, lane)); mnew = fmaxf(st.m[nt], mx); alpha = fexp2(st.m[nt] - mnew); st.m[nt] = mnew; }
            float ps = 0.f;
#pragma unroll
            for (int mt = 0; mt < 4; ++mt)
#pragma unroll
                for (int j = 0; j < 4; ++j) { float pv = fexp2(s[mt][nt][j] - mnew); if (MODE == 1) pv *= linv[nt]; s[mt][nt][j] = pv; ps += pv; }
            if (MODE != 1) st.l[nt] = st.l[nt] * alpha + ps;
            if (MODE == 2 || MODE == 3) {
#pragma unroll
                for (int md = 0; md < 8; ++md) st.ot[md][nt] = st.ot[md][nt] * alpha;
            }
            if (MODE == 1) {
#pragma unroll
                for (int mt = 0; mt < 4; ++mt) { float a = s[mt][nt][0] + s[mt][nt][1] + s[mt][nt][2] + s[mt][nt][3], lst = s[mt][nt][3];
                    a += shx(a, 1, lane); a += shx(a, 2, lane); lst += shx(lst, 1, lane); lst += shx(lst, 2, lane);
                    if ((l16 & 3) == 0) { const int jb = tile * 16 + 4 * mt + g4; LAS float* pp = (LAS float*)(lds + A_PSL) + (w * 8 + nt * 4 + (l16 >> 2)) * 256;
                        atomicAdd((float*)(pp + jb), a); if (jb + 1 < 256) atomicAdd((float*)(pp + jb + 1), lst); } }
            }
            if (MODE != 0) {
#pragma unroll
                for (int kk = 0; kk < 2; ++kk) { const u32x4 pk = (u32x4){pk_bf16(s[2 * kk][nt][0], s[2 * kk][nt][1]), pk_bf16(s[2 * kk][nt][2], s[2 * kk][nt][3]), pk_bf16(s[2 * kk + 1][nt][0], s[2 * kk + 1][nt][1]), pk_bf16(s[2 * kk + 1][nt][2], s[2 * kk + 1][nt][3])};
                    pf[nt][kk] = __builtin_bit_cast(bf16x8, pk); }
            }
        } else { pf[nt][0] = (bf16x8){0, 0, 0, 0, 0, 0, 0, 0}; pf[nt][1] = (bf16x8){0, 0, 0, 0, 0, 0, 0, 0}; }
    }
    if (MODE != 0) {
#pragma unroll
        for (int kk = 0; kk < 2; ++kk)
#pragma unroll
            for (int mg = 0; mg < 2; ++mg) {
                bf16x8 vf[4];
#pragma unroll
                for (int q = 0; q < 4; ++q) { const LAS unsigned char* vb = lds + boff + A_VT + (16 * (4 * mg + q) + l16) * 136 + kk * 64 + g4 * 8;
                    const u32x2 v0 = *(const LAS u32x2*)vb, v1 = *(const LAS u32x2*)(vb + 32); vf[q] = __builtin_bit_cast(bf16x8, ((u32x4){v0[0], v0[1], v1[0], v1[1]})); }
                if (a0) {
#pragma unroll
                    for (int q = 0; q < 4; ++q) st.ot[4 * mg + q][0] = __builtin_amdgcn_mfma_f32_16x16x32_bf16(vf[q], pf[0][kk], st.ot[4 * mg + q][0], 0, 0, 0);
                }
                if (a1) {
#pragma unroll
                    for (int q = 0; q < 4; ++q) st.ot[4 * mg + q][1] = __builtin_amdgcn_mfma_f32_16x16x32_bf16(vf[q], pf[1][kk], st.ot[4 * mg + q][1], 0, 0, 0);
                }
                if (mg == 1) __builtin_amdgcn_sched_barrier(0);
            }
    }
}
template <int MODE>
__device__ __forceinline__ void attn_tiles(LAS unsigned char* lds, const bf16_t* kp, size_t kstride, const bf16_t* vp, size_t vstride, int tile_lo, int tile_hi,
                                           const bf16x8 (&qf)[2][4], AttnState& st, const int (&tpos)[2], int qb, int w, int lane, const float (&mfin)[2], const float (&linv)[2]) {
    if (tile_lo >= tile_hi) return;
    int tid = w * 64 + lane; asm volatile("" : "+v"(tid)); const int l16 = lane & 15;
    const int krow = tid >> 3, kc = (tid & 7) * 16, vrow = tid >> 2, vc = (tid & 3) * 16;
    u32x4 kr0, kr1, vr0 = (u32x4){0, 0, 0, 0}, vr1 = (u32x4){0, 0, 0, 0};
#define A_LOAD(T) do { const bf16_t* kg = kp + (size_t)((T) * 64 + krow) * kstride + kc; kr0 = *(const u32x4*)kg; kr1 = *(const u32x4*)(kg + 8); \
        if (MODE != 0) { const bf16_t* vg = vp + (size_t)vrow * vstride + (T) * 64 + vc; vr0 = *(const u32x4*)vg; vr1 = *(const u32x4*)(vg + 8); } } while (0)
#define A_WRITE(BO) do { LAS unsigned char* kd = lds + (BO) + A_KT + krow * 272 + kc * 2; *(LAS u32x4*)kd = kr0; *(LAS u32x4*)(kd + 16) = kr1; \
        if (MODE != 0) { LAS unsigned char* vd = lds + (BO) + A_VT + vrow * 136 + vc * 2; *(LAS u32x2*)vd = (u32x2){vr0[0], vr0[1]}; *(LAS u32x2*)(vd + 8) = (u32x2){vr0[2], vr0[3]}; *(LAS u32x2*)(vd + 16) = (u32x2){vr1[0], vr1[1]}; *(LAS u32x2*)(vd + 24) = (u32x2){vr1[2], vr1[3]}; } } while (0)
    A_LOAD(tile_lo);
    __syncthreads();
    A_WRITE(0);
    if (tile_lo + 1 < tile_hi) A_LOAD(tile_lo + 1);
    __syncthreads();
    unsigned selw0 = 0u, selw1 = 0u;
    for (int tile = tile_lo; tile < tile_hi; ++tile) {
        const int boff = ((tile - tile_lo) & 1) * A_BUFSZ;
        if (MODE == 2 && (tile == tile_lo || (tile & 31) == 0)) { const int tw = tile >> 5;
            selw0 = *(const LAS unsigned*)(lds + A_SEL + ((w * 8 + (l16 >> 2)) * 8 + tw) * 4); selw1 = *(const LAS unsigned*)(lds + A_SEL + ((w * 8 + 4 + (l16 >> 2)) * 8 + tw) * 4); }
        if (tile + 1 < tile_hi) { A_WRITE(boff ^ A_BUFSZ); if (tile + 2 < tile_hi) A_LOAD(tile + 2); }
        bool rs0 = true, rs1 = true, active = true;
        if (MODE == 2) { const unsigned bit = 1u << (tile & 31);
            rs0 = (selw0 & bit) != 0u; rs1 = (selw1 & bit) != 0u; active = __ballot(rs0 || rs1) != 0ull; }
        if (active) {
            bool masked;
            if (MODE == 0 || MODE == 1) masked = (tile * 64 + 63 > 4 * qb - 2);
            else if (MODE == 2) masked = (tile == qb);
            else masked = (tile == qb) || (tile <= qb - 8);
            const bool a0 = (MODE != 2) || (__ballot(rs0) != 0ull), a1 = (MODE != 2) || (__ballot(rs1) != 0ull);
            attn_compute<MODE>(lds, boff, tile, qf, st, tpos, qb, w, lane, mfin, linv, rs0, rs1, masked, a0, a1);
        }
        __syncthreads();
    }
#undef A_LOAD
#undef A_WRITE
}
__device__ __forceinline__ void attn_tiles_slc2(LAS unsigned char* lds, const bf16_t* kp, size_t kstride, const bf16_t* vp, size_t vstride, int n,
                                                const bf16x8 (&qf)[2][4], AttnState& st, const int (&tpos)[2], int qb, int w, int lane, const float (&mfin)[2], const float (&linv)[2]) {
    int tid = w * 64 + lane; asm volatile("" : "+v"(tid)); const int l16 = lane & 15;
    const int krow = tid >> 3, kc = (tid & 7) * 16, vrow = tid >> 2, vc = (tid & 3) * 16;
    const int nst = (n + 1) >> 1; constexpr int STG = 2 * A_BUFSZ;
    u32x4 kX0, kX1, vX0, vX1, kY0 = (u32x4){0, 0, 0, 0}, kY1 = (u32x4){0, 0, 0, 0}, vY0 = (u32x4){0, 0, 0, 0}, vY1 = (u32x4){0, 0, 0, 0};
#define S_LOAD1(T, S) do { const bf16_t* kg = kp + (size_t)((T) * 64 + krow) * kstride + kc; k##S##0 = *(const u32x4*)kg; k##S##1 = *(const u32x4*)(kg + 8); \
        const bf16_t* vg = vp + (size_t)vrow * vstride + (T) * 64 + vc; v##S##0 = *(const u32x4*)vg; v##S##1 = *(const u32x4*)(vg + 8); } while (0)
#define S_WRITE1(BO, S) do { LAS unsigned char* kd = lds + (BO) + A_KT + krow * 272 + kc * 2; *(LAS u32x4*)kd = k##S##0; *(LAS u32x4*)(kd + 16) = k##S##1; \
        LAS unsigned char* vd = lds + (BO) + A_VT + vrow * 136 + vc * 2; *(LAS u32x2*)vd = (u32x2){v##S##0[0], v##S##0[1]}; *(LAS u32x2*)(vd + 8) = (u32x2){v##S##0[2], v##S##0[3]}; *(LAS u32x2*)(vd + 16) = (u32x2){v##S##1[0], v##S##1[1]}; *(LAS u32x2*)(vd + 24) = (u32x2){v##S##1[2], v##S##1[3]}; } while (0)
#define S_LOADS(SG) do { S_LOAD1(2 * (SG), X); if (2 * (SG) + 1 < n) S_LOAD1(2 * (SG) + 1, Y); } while (0)
#define S_WRITES(SG, BASE) do { S_WRITE1((BASE), X); if (2 * (SG) + 1 < n) S_WRITE1((BASE) + A_BUFSZ, Y); } while (0)
    S_LOADS(0);
    __syncthreads();
    S_WRITES(0, 0);
    if (nst > 1) S_LOADS(1);
    __syncthreads();
    unsigned selw0 = 0u, selw1 = 0u;
    for (int s = 0; s < nst; ++s) {
        const int base = (s & 1) * STG;
        if ((s & 15) == 0) { const int tw = s >> 4;
            selw0 = *(const LAS unsigned*)(lds + A_SEL + ((w * 8 + (l16 >> 2)) * 8 + tw) * 4); selw1 = *(const LAS unsigned*)(lds + A_SEL + ((w * 8 + 4 + (l16 >> 2)) * 8 + tw) * 4); }
        if (s + 1 < nst) { S_WRITES(s + 1, base ^ STG); if (s + 2 < nst) S_LOADS(s + 2); }
#pragma unroll
        for (int hf = 0; hf < 2; ++hf) {
            const int tile = 2 * s + hf;
            if (tile < n) {
                const unsigned bit = 1u << (tile & 31);
                const bool rs0 = (selw0 & bit) != 0u, rs1 = (selw1 & bit) != 0u;
                const bool a0 = __ballot(rs0) != 0ull, a1 = __ballot(rs1) != 0ull;
                if (a0 || a1) attn_compute<2>(lds, base + hf * A_BUFSZ, tile, qf, st, tpos, qb, w, lane, mfin, linv, rs0, rs1, tile == qb, a0, a1);
            }
        }
        asm volatile("s_waitcnt lgkmcnt(0)" ::: "memory"); __builtin_amdgcn_s_barrier(); asm volatile("" ::: "memory");
    }
    __syncthreads();
#undef S_LOAD1
#undef S_WRITE1
#undef S_LOADS
#undef S_WRITES
}
template <int BR>
__device__ __forceinline__ void attn_finish(AttnState& st, const float* gates, float* oacc, bf16_t* att, const int (&tpos)[2], int hkv, int lane) {
    const int l16 = lane & 15, g4 = lane >> 4, g = l16 & 3;
#pragma unroll
    for (int nt = 0; nt < 2; ++nt) {
        const int t = tpos[nt]; float sc = gates[(size_t)t * 48 + (hkv * 4 + g) * 3 + BR];
        if (BR != 0) { float l = st.l[nt]; l += shx(l, 16, lane); l += shx(l, 32, lane); sc = (l > 0.f) ? sc / l : 0.f; }
        const size_t base = (size_t)t * 2048 + (hkv * 4 + g) * 128 + 4 * g4;
#pragma unroll
        for (int md = 0; md < 8; ++md) { f32x4 v = st.ot[md][nt] * sc; float* op = oacc + base + 16 * md;
            if (BR == 0) *(f32x4*)op = v;
            else if (BR == 1) *(f32x4*)op = *(const f32x4*)op + v;
            else { v = v + *(const f32x4*)op; *(u32x2*)(att + base + 16 * md) = (u32x2){pk_bf16(v[0], v[1]), pk_bf16(v[2], v[3])}; } }
    }
}
__device__ __forceinline__ void attn_reset(AttnState& st) {
#pragma unroll
    for (int md = 0; md < 8; ++md) { st.ot[md][0] = (f32x4){0.f, 0.f, 0.f, 0.f}; st.ot[md][1] = (f32x4){0.f, 0.f, 0.f, 0.f}; }
    st.m[0] = st.m[1] = -1e30f; st.l[0] = st.l[1] = 0.f;
}
__device__ __forceinline__ void attn_item(unsigned char* ws, LAS unsigned char* lds, int hkv, int qb) {
    int tid = ltid(); asm volatile("" : "+v"(tid)); const int w = tid >> 6, lane = tid & 63, l16 = lane & 15, g4 = lane >> 4;
    const bf16_t* QB = (const bf16_t*)(ws + OFF_QB); const bf16_t* KVTOK = (const bf16_t*)(ws + OFF_KVTOK); const bf16_t* KVT = (const bf16_t*)(ws + OFF_KVT);
    const bf16_t* KC = (const bf16_t*)(ws + OFF_KCMP); const bf16_t* VC = (const bf16_t*)(ws + OFF_VCMPT);
    const float* gates = (const float*)(ws + OFF_GATES); float* oacc = (float*)(ws + OFF_OACC); bf16_t* att = (bf16_t*)(ws + OFF_ATT);
    int tpos[2]; bf16x8 qf[2][4];
#pragma unroll
    for (int nt = 0; nt < 2; ++nt) { tpos[nt] = qb * 64 + w * 8 + nt * 4 + (l16 >> 2); const bf16_t* qp = QB + (size_t)tpos[nt] * 2048 + (hkv * 4 + (l16 & 3)) * 128 + g4 * 8;
#pragma unroll
        for (int ks = 0; ks < 4; ++ks) qf[nt][ks] = *(const bf16x8*)(qp + ks * 32); }
    __syncthreads();
    { LAS float* pp = (LAS float*)(lds + A_PSL) + w * 2048;
#pragma unroll
      for (int i = 0; i < 32; ++i) pp[lane + 64 * i] = 0.f; }
    AttnState st; float mfin[2] = {0.f, 0.f}, linv[2] = {0.f, 0.f};
    const int ncmp_tiles = (4 * qb + 3 + 63) >> 6;
    attn_reset(st);
    attn_tiles<0>(lds, KC + (size_t)hkv * 1024 * 128, 128, VC, 1024, 0, ncmp_tiles, qf, st, tpos, qb, w, lane, mfin, linv);
#pragma unroll
    for (int nt = 0; nt < 2; ++nt) { float l = st.l[nt]; l += shx(l, 16, lane); l += shx(l, 32, lane); mfin[nt] = st.m[nt]; linv[nt] = (l > 0.f) ? 1.0f / l : 0.f; }
    attn_reset(st);
    attn_tiles<1>(lds, KC + (size_t)hkv * 1024 * 128, 128, VC + (size_t)hkv * 128 * 1024, 1024, 0, ncmp_tiles, qf, st, tpos, qb, w, lane, mfin, linv);
    attn_finish<0>(st, gates, oacc, att, tpos, hkv, lane);
    __syncthreads();
    {
        LAS unsigned* sel = (LAS unsigned*)(lds + A_SEL) + w * 64;
        if (qb < 16) {
            if (lane < 8) { for (int tk = 0; tk < 8; ++tk) { const int lo = lane * 32; unsigned wd = 0; if (qb >= lo + 31) wd = 0xffffffffu; else if (qb >= lo) wd = (2u << (qb - lo)) - 1u; sel[tk * 8 + lane] = wd; } }
        } else {
            for (int tk = 0; tk < 8; ++tk) {
                const LAS float* pp = (const LAS float*)(lds + A_PSL) + (w * 8 + tk) * 256;
                unsigned key[4]; bool forced[4];
#pragma unroll
                for (int i = 0; i < 4; ++i) { const int j = lane + 64 * i; const float sc = pp[j]; const bool elig = (j >= 1) && (j <= qb - 2);
                    forced[i] = (j == 0) || (j == qb) || (j == qb - 1); key[i] = elig ? (__float_as_uint(sc) + 1u) : 0u; }
                unsigned prefix = 0u;
                for (int bit = 30; bit >= 0; --bit) { const unsigned cand = prefix | (1u << bit); int cnt = 0;
#pragma unroll
                    for (int i = 0; i < 4; ++i) cnt += __popcll(__ballot(key[i] >= cand));
                    if (cnt >= 13) prefix = cand; }
                int cgt = 0;
#pragma unroll
                for (int i = 0; i < 4; ++i) cgt += __popcll(__ballot(key[i] > prefix));
                const int need = 13 - cgt; int base = 0;
#pragma unroll
                for (int i = 0; i < 4; ++i) { const unsigned long long eqm = __ballot(key[i] == prefix);
                    const int rank = base + (int)__builtin_amdgcn_mbcnt_hi((unsigned)(eqm >> 32), __builtin_amdgcn_mbcnt_lo((unsigned)eqm, 0u));
                    const bool taken = forced[i] || (key[i] > prefix) || (key[i] == prefix && rank < need);
                    const unsigned long long bal = __ballot(taken); if (lane == 0) { sel[tk * 8 + 2 * i] = (unsigned)bal; sel[tk * 8 + 2 * i + 1] = (unsigned)(bal >> 32); }
                    base += __popcll(eqm); }
            }
        }
    }
    __syncthreads();
    attn_reset(st);
    attn_tiles_slc2(lds, KVTOK + 2 * 512 + hkv * 128, 2048, KVT + (size_t)(hkv * 128) * S_, S_, qb + 1, qf, st, tpos, qb, w, lane, mfin, linv);
    attn_finish<1>(st, gates, oacc, att, tpos, hkv, lane);
    attn_reset(st);
    attn_tiles<3>(lds, KVTOK + 3 * 512 + hkv * 128, 2048, KVT + (size_t)(512 + hkv * 128) * S_, S_, (qb - 8) > 0 ? (qb - 8) : 0, qb + 1, qf, st, tpos, qb, w, lane, mfin, linv);
    attn_finish<2>(st, gates, oacc, att, tpos, hkv, lane);
}
__device__ __forceinline__ void attn_phase(unsigned char* ws, LAS unsigned char* lds, int b) {
    unsigned* ctr = (unsigned*)(ws + OFF_BAR) + XCD_CTR_WORD + 64 * b;
    volatile LAS int* slot = (volatile LAS int*)(lds + LDS_ST + 8);
#pragma nounroll
    for (;;) {
        __syncthreads();
        if (threadIdx.x == 0) *slot = (int)__hip_atomic_fetch_add(ctr, 1u, __ATOMIC_RELAXED, __HIP_MEMORY_SCOPE_AGENT);
        __syncthreads();
        const int it = *slot;
        if (it >= 1024) break;
        attn_item(ws, lds, it & 3, 255 - (it >> 2));
    }
}

#define XB_TMO      128
#define XB_XCNT(j)  (256  + 64 * (j))
#define XB_XSUB(j)  (1280 + 64 * (j))
#define XB_XGEN(j)  (2304 + 64 * (j))
#define XB_TOP      3328
#define XB_TOPGEN   3392
#define XCD_BAR_WORDS 3456
#define XB_SPIN_CAP (1u << 22)
__device__ __forceinline__ unsigned xb_ld(unsigned* p)              { return __hip_atomic_load(p, __ATOMIC_RELAXED, __HIP_MEMORY_SCOPE_AGENT); }
__device__ __forceinline__ unsigned xb_add(unsigned* p, unsigned v) { return __hip_atomic_fetch_add(p, v, __ATOMIC_RELAXED, __HIP_MEMORY_SCOPE_AGENT); }
__device__ __forceinline__ unsigned xb_xcc_id() { return (unsigned)__builtin_amdgcn_s_getreg((3 << 11) | 20) & 0xFu; }
#define XB_SPIN(cond, bar) do { unsigned _sp = 0; while (cond) { __builtin_amdgcn_s_sleep(1); \
    if ((++_sp & 255u) == 0u) { if (xb_ld(&(bar)[XB_TMO])) break; if (_sp > XB_SPIN_CAP) { atomicAdd(&(bar)[XB_TMO], 1u); break; } } } } while (0)
struct XcdBarrier { unsigned* bar; unsigned x; volatile LAS unsigned* st; };
__device__ __forceinline__ XcdBarrier xcd_barrier_post(unsigned* bar, volatile LAS unsigned* st) {
    XcdBarrier b; b.bar = bar; b.x = xb_xcc_id(); b.st = st;
    if (threadIdx.x == 0) (void)xb_add(&bar[XB_XCNT(b.x)], 1u);
    return b;
}
__device__ __forceinline__ void xcd_barrier_complete(unsigned* bar, unsigned x, unsigned& nloc, unsigned& nx) {
    const unsigned G = gridDim.x * gridDim.y * gridDim.z;
    unsigned sum, cnt, mine, sp = 0u;
    for (;;) {
        sum = 0u; cnt = 0u; mine = 0u;
#pragma unroll
        for (unsigned j = 0; j < 16; ++j) { const unsigned c = xb_ld(&bar[XB_XCNT(j)]); sum += c; cnt += (c > 0u) ? 1u : 0u; mine = (j == x) ? c : mine; }
        if (sum == G) break;
        __builtin_amdgcn_s_sleep(1);
        if ((++sp & 255u) == 0u) { if (xb_ld(&bar[XB_TMO])) break; if (sp > XB_SPIN_CAP) { atomicAdd(&bar[XB_TMO], 1u); break; } }
    }
    nloc = mine > 0u ? mine : 1u; nx = cnt > 0u ? cnt : 1u;
}
__device__ __forceinline__ void xcd_barrier(const XcdBarrier& b) {
    asm volatile("s_waitcnt vmcnt(0)" ::: "memory");
    __syncthreads();
    if (threadIdx.x == 0) {
        unsigned* bar = b.bar;
        __builtin_amdgcn_s_waitcnt(0);
        unsigned nloc = b.st[0], nx = b.st[1];
        if (nloc == 0u) { xcd_barrier_complete(bar, b.x, nloc, nx); b.st[0] = nloc; b.st[1] = nx; }
        const unsigned old = xb_add(&bar[XB_XSUB(b.x)], 1u);
        const unsigned gen = old / nloc;
        if (old + 1u == (gen + 1u) * nloc) {
            __builtin_amdgcn_fence(__ATOMIC_RELEASE, "agent");
            asm volatile("s_waitcnt vmcnt(0)" ::: "memory");
            const unsigned og = xb_add(&bar[XB_TOP], 1u);
            const unsigned tg = og / nx;
            if (og + 1u == (tg + 1u) * nx) xb_add(&bar[XB_TOPGEN], 1u);
            else XB_SPIN(xb_ld(&bar[XB_TOPGEN]) == tg, bar);
            __builtin_amdgcn_fence(__ATOMIC_ACQUIRE, "agent");
            xb_add(&bar[XB_XGEN(b.x)], 1u);
            asm volatile("s_waitcnt vmcnt(0)" ::: "memory");
        } else {
            XB_SPIN(xb_ld(&bar[XB_XGEN(b.x)]) == gen, bar);
            __builtin_amdgcn_fence(__ATOMIC_ACQUIRE, "agent");
            asm volatile("s_waitcnt vmcnt(0)" ::: "memory");
        }
    }
    __syncthreads();
}

constexpr int NPH = 23;
__device__ __forceinline__ void run_phase(CP p, int ph, int b, LAS unsigned char* lds) {
    asm volatile("" : "+s"(p));
    unsigned char* ws = p->ws;
    const float* xb = p->x + (size_t)b * S_ * D_; float* hb = p->out + (size_t)b * S_ * D_;
    bf16_t* XN = (bf16_t*)(ws + OFF_XN);
    const int layer = (ph >= 13) ? 1 : 0;
    switch (ph) {
    case 0: prep_phase(p, lds); break;
    case 1: rmsnorm_phase(xb, p->norm_mix, XN, nullptr, nullptr); break;
    case 2: {
        Prob2D<EpiQK> g1{(const char*)XN, (const char*)(ws + OFF_W_RIN), 4096u, 4096u, 32, 64, 16, EpiQK{(bf16_t*)(ws + OFF_Q), (bf16_t*)(ws + OFF_K), (bf16_t*)(ws + OFF_KTD), (const float2*)(ws + OFF_ROPE)}};
        gemm_phase(lds, g1);
        Prob2D<EpiStore> g2{(const char*)(ws + OFF_W_RIN) + (size_t)4096 * 4096, (const char*)XN, 4096u, 4096u, 32, 16, 64, EpiStore{(bf16_t*)(ws + OFF_VT), (size_t)S_}};
        gemm_phase(lds, g2);
    } break;
    case 3: {
        ProbKV g3{(const char*)(ws + OFF_VT), (const char*)(ws + OFF_KTD), (bf16_t*)(ws + OFF_ST), 4};
        gemm_phase(lds, g3);
        ProbS g4{(const char*)(ws + OFF_Q), (const char*)(ws + OFF_K), (bf16_t*)(ws + OFF_SD), 4};
        gemm_phase(lds, g4);
    } break;
    case 4: scan_phase((bf16_t*)(ws + OFF_ST)); break;
    case 5: {
        ProbOut g5{(const char*)(ws + OFF_Q), (const char*)(ws + OFF_ST), (long)OFF_SD - (long)OFF_Q, (long)OFF_VT - (long)OFF_ST, (bf16_t*)(ws + OFF_Y), 8};
        gemm_phase(lds, g5);
    } break;
    case 6: gn_phase((const bf16_t*)(ws + OFF_Y), (float2*)(ws + OFF_GNS)); break;
    case 7: {
        Prob2D<EpiGate> g6{(const char*)XN, (const char*)(ws + OFF_W_RIN) + (size_t)8192 * 4096, 4096u, 4096u, 32, 64, 16, EpiGate{(bf16_t*)(ws + OFF_Y), (const float2*)(ws + OFF_GNS), p->ret_gn}};
        gemm_phase(lds, g6);
    } break;
    case 8: {
        Prob2D<EpiRes> g7{(const char*)(ws + OFF_Y), (const char*)(ws + OFF_W_ROUT), 8192u, 8192u, 64, 64, 8, EpiRes{xb, hb, XN, (float*)(ws + OFF_SS) + (size_t)(b * 4 + 0) * S_}};
        gemm_phase(lds, g7);
    } break;
    case 10: case 20: {
        Prob2D<EpiStoreRS> g8{(const char*)XN, (const char*)(ws + OFF_W_FIN + (size_t)layer * 32 * MiB), 4096u, 4096u, 32, 64, 32, EpiStoreRS{(bf16_t*)(ws + OFF_U), (size_t)8192, (const float*)(ws + OFF_SS) + (size_t)(b * 4 + (layer ? 2 : 0)) * S_}};
        gemm_phase(lds, g8);
    } break;
    case 11: case 21: conv_phase((const bf16_t*)(ws + OFF_U), (bf16_t*)(ws + OFF_AB), p->ffn_conv_w + (size_t)layer * 3 * 8192, p->ffn_conv_b + (size_t)layer * 8192); break;
    case 12: case 22: {
        Prob2D<EpiRes> g9{(const char*)(ws + OFF_AB), (const char*)(ws + OFF_W_FOUT + (size_t)layer * 16 * MiB), 8192u, 8192u, 64, 64, 8, EpiRes{hb, hb, layer ? (bf16_t*)nullptr : XN, layer ? (float*)nullptr : (float*)(ws + OFF_SS) + (size_t)(b * 4 + 1) * S_}};
        gemm_phase(lds, g9);
    } break;
    case 14: {
        const float* ss1 = (const float*)(ws + OFF_SS) + (size_t)(b * 4 + 1) * S_;
        Prob2D<EpiStoreRS> g10{(const char*)XN, (const char*)(ws + OFF_W_KV), 4096u, 4096u, 32, 64, 8, EpiStoreRS{(bf16_t*)(ws + OFF_KVTOK), (size_t)2048, ss1}};
        gemm_phase(lds, g10);
        Prob2D<EpiStoreCS> g11{(const char*)(ws + OFF_W_KV) + (size_t)2048 * 4096, (const char*)XN, 4096u, 4096u, 32, 4, 64, EpiStoreCS{(bf16_t*)(ws + OFF_KVT), (size_t)S_, ss1}};
        gemm_phase(lds, g11);
    } break;
    case 15: {
        ProbCmp1 a{(const char*)(ws + OFF_KVTOK), (const char*)(ws + OFF_W_C1K), 8192u, 64, 16, EpiGelu{(bf16_t*)(ws + OFF_H1), (const float*)(ws + OFF_PEB)}};
        gemm_phase(lds, a, (int)gridDim.x - 32);
        ProbCmp1 v{(const char*)(ws + OFF_KVTOK) + 1024, (const char*)(ws + OFF_W_C1V), 8192u, 64, 16, EpiGelu{(bf16_t*)(ws + OFF_H1) + 4096 * 256, (const float*)(ws + OFF_PEB) + 256}};
        gemm_phase(lds, v, (int)gridDim.x - 16);
        Prob2D<EpiQproj> g12{(const char*)XN, (const char*)(ws + OFF_W_Q), 4096u, 4096u, 32, 64, 9, EpiQproj{(bf16_t*)(ws + OFF_QB), (float*)(ws + OFF_GATES), (const float*)(ws + OFF_SS) + (size_t)(b * 4 + 1) * S_}};
        gemm_phase(lds, g12);
    } break;
    case 16: {
        Prob2D<EpiKcmp> a{(const char*)(ws + OFF_H1), (const char*)(ws + OFF_W_C2K), 512u, 512u, 4, 16, 1, EpiKcmp{(bf16_t*)(ws + OFF_KCMP)}};
        gemm_phase(lds, a);
        Prob2D<EpiVcmp> v{(const char*)(ws + OFF_W_C2V), (const char*)(ws + OFF_H1) + (size_t)4096 * 256 * 2, 512u, 512u, 4, 1, 16, EpiVcmp{(bf16_t*)(ws + OFF_VCMPT)}};
        gemm_phase(lds, v);
    } break;
    case 17: attn_phase(ws, lds, b); break;
    case 18: {
        Prob2D<EpiRes> g{(const char*)(ws + OFF_ATT), (const char*)(ws + OFF_W_O), 4096u, 4096u, 32, 64, 8, EpiRes{hb, hb, XN, (float*)(ws + OFF_SS) + (size_t)(b * 4 + 2) * S_}};
        gemm_phase(lds, g);
    } break;
    case 23: finalnorm_phase(hb, p->final_gain); break;
    default: break;
    }
}

#if MULTI
__global__ void __launch_bounds__(512) phase_kernel(Params p, int ph, int b) {
    extern __shared__ __attribute__((aligned(16))) unsigned char shm[];
    run_phase((CP)__builtin_amdgcn_kernarg_segment_ptr(), ph, b, (LAS unsigned char*)shm);
}
#else
__global__ void __launch_bounds__(512) mega_kernel(Params p) {
    extern __shared__ __attribute__((aligned(16))) unsigned char shm[];
    cg::grid_group grid = cg::this_grid();
    CP cp = (CP)__builtin_amdgcn_kernarg_segment_ptr();
    volatile LAS unsigned* st = (volatile LAS unsigned*)((LAS unsigned char*)shm + LDS_ST);
    if (threadIdx.x == 0) { st[0] = 0u; st[1] = 0u; st[2] = 0u; st[3] = 0u; }
    __syncthreads();
    XcdBarrier xb = xcd_barrier_post((unsigned*)(cp->ws + OFF_BAR), st);
    run_phase(cp, 0, 0, (LAS unsigned char*)shm);
    grid.sync();
    for (int b = 0; b < 2; ++b)
        for (int ph = 1; ph <= NPH; ++ph) {
            if (ph == 9 || ph == 13 || ph == 19) continue;
#ifdef PROBE_PH
            const int reps = (ph == PROBE_PH || ph == PROBE_PH2) ? 2 : 1;
#else
            const int reps = 1;
#endif
            for (int rep = 0; rep < reps; ++rep) { run_phase(cp, ph, b, (LAS unsigned char*)shm); xcd_barrier(xb); } }
}
#endif

constexpr int LDS_BYTES = LDS_ST + 16;
extern "C" void kernel_launch(void* const* d_in, const int* in_sizes, int n_in, void* d_out, int out_size, void* d_ws, size_t ws_size, hipStream_t stream) {
    static int grid = 0;
    if (grid == 0) {
        if (n_in != 21 || out_size != 2 * S_ * D_ || ws_size < WS_NEED) { fprintf(stderr, "kernel_launch: unexpected shapes/ws (n_in %d out %d ws %zu need %zu)\n", n_in, out_size, ws_size, (size_t)WS_NEED); grid = -1; return; }
#if MULTI
        if (hipFuncSetAttribute((const void*)phase_kernel, hipFuncAttributeMaxDynamicSharedMemorySize, LDS_BYTES) != hipSuccess) { fprintf(stderr, "hipFuncSetAttribute failed\n"); grid = -1; return; }
#else
        if (hipFuncSetAttribute((const void*)mega_kernel, hipFuncAttributeMaxDynamicSharedMemorySize, LDS_BYTES) != hipSuccess) { fprintf(stderr, "hipFuncSetAttribute failed\n"); grid = -1; return; }
#endif
        int dev = 0, cus = 0; hipGetDevice(&dev); hipDeviceGetAttribute(&cus, hipDeviceAttributeMultiprocessorCount, dev);
        grid = cus > 0 ? cus : 256;
    }
    if (grid < 0) return;
    Params p{};
    const float** pp = (const float**)&p;
    for (int i = 0; i < 21; ++i) pp[i] = (const float*)d_in[i];
    p.out = (float*)d_out; p.ws = (unsigned char*)d_ws;
#if MULTI
    hipLaunchKernelGGL(phase_kernel, dim3(grid), dim3(512), LDS_BYTES, stream, p, 0, 0);
    for (int b = 0; b < 2; ++b)
        for (int ph = 1; ph <= NPH; ++ph) hipLaunchKernelGGL(phase_kernel, dim3(grid), dim3(512), LDS_BYTES, stream, p, ph, b);
#else
    if (hipMemsetAsync((unsigned char*)d_ws + OFF_BAR, 0, (XCD_BAR_WORDS + 128) * 4, stream) != hipSuccess) { fprintf(stderr, "memset failed\n"); return; }
    void* args[] = {&p};
    hipError_t e = hipLaunchCooperativeKernel((const void*)mega_kernel, dim3(grid), dim3(512), args, LDS_BYTES, stream);
    if (e != hipSuccess) fprintf(stderr, "cooperative launch failed: %s (grid %d)\n", hipGetErrorString(e), grid);
#endif
}
```

```cpp
#include <hip/hip_runtime.h>
#include <hip/hip_cooperative_groups.h>
#include <cstdio>
namespace cg = cooperative_groups;

#ifndef MULTI
#define MULTI 0
#endif

#define LAS __attribute__((address_space(3)))
typedef unsigned short bf16_t;
typedef short bf16x8 __attribute__((ext_vector_type(8)));
typedef float f32x4 __attribute__((ext_vector_type(4)));
typedef unsigned u32x2 __attribute__((ext_vector_type(2)));
typedef unsigned u32x4 __attribute__((ext_vector_type(4)));

constexpr int S_ = 16384, D_ = 2048;
constexpr size_t MiB = 1048576;
constexpr size_t OFF_W_RIN = 0, OFF_W_ROUT = 48 * MiB, OFF_W_KV = 64 * MiB, OFF_W_C1K = 76 * MiB, OFF_W_C1V = 78 * MiB,
                 OFF_W_C2K = 80 * MiB, OFF_W_C2V = 80 * MiB + 131072, OFF_W_Q = 81 * MiB, OFF_W_O = 90 * MiB,
                 OFF_W_FIN = 98 * MiB  , OFF_W_FOUT = 162 * MiB  , OFF_ROPE = 194 * MiB, OFF_PEB = 210 * MiB, OFF_BAR = 210 * MiB + 65536, OFF_SS = 210 * MiB + 131072  ,
                 OFF_XN = 211 * MiB, OFF_ACT = 275 * MiB;
constexpr size_t OFF_Q = OFF_ACT, OFF_K = OFF_ACT + 64 * MiB, OFF_KTD = OFF_ACT + 128 * MiB, OFF_VT = OFF_ACT + 192 * MiB,
                 OFF_ST = OFF_ACT + 320 * MiB, OFF_SD = OFF_ACT + 448 * MiB, OFF_Y = OFF_ACT + 512 * MiB, OFF_GNS = OFF_ACT + 640 * MiB  , WS_NEED = OFF_ACT + 641 * MiB;
constexpr size_t OFF_U = OFF_ACT, OFF_AB = OFF_ACT + 256 * MiB;
constexpr size_t OFF_HN = OFF_ACT, OFF_KVTOK = OFF_ACT + 64 * MiB, OFF_KVT = OFF_ACT + 129 * MiB, OFF_QB = OFF_ACT + 161 * MiB,
                 OFF_GATES = OFF_ACT + 225 * MiB, OFF_H1 = OFF_ACT + 229 * MiB, OFF_KCMP = OFF_ACT + 233 * MiB, OFF_VCMPT = OFF_ACT + 234 * MiB,
                 OFF_ATT = OFF_ACT + 235 * MiB, OFF_OACC = OFF_ACT + 299 * MiB;

struct Params {
    const float* x; const float* norm_mix; const float* norm_ffn; const float* ret_w_in; const float* ret_gn; const float* ret_w_out;
    const float* kv_gain; const float* w_kv; const float* pe_k; const float* w1_k; const float* w2_k; const float* pe_v; const float* w1_v;
    const float* w2_v; const float* w_q; const float* w_o; const float* ffn_w_in; const float* ffn_conv_w; const float* ffn_conv_b;
    const float* ffn_w_out; const float* final_gain; float* out; unsigned char* ws;
};

typedef const __attribute__((address_space(4))) Params* CP;
__device__ __forceinline__ int ltid() { int t = threadIdx.x; asm volatile("" : "+v"(t)); return t; }
__device__ __forceinline__ unsigned pk_bf16(float lo, float hi) { unsigned r; asm("v_cvt_pk_bf16_f32 %0, %1, %2" : "=v"(r) : "v"(lo), "v"(hi)); return r; }
__device__ __forceinline__ float bflo(unsigned v) { return __uint_as_float(v << 16); }
__device__ __forceinline__ float bfhi(unsigned v) { return __uint_as_float(v & 0xffff0000u); }
__device__ __forceinline__ float fexp2(float x) { return __builtin_amdgcn_exp2f(x); }
__device__ __forceinline__ float frcp(float x) { return __builtin_amdgcn_rcpf(x); }
__device__ __forceinline__ float log2gamma(int h) { return log2f(1.0f - exp2f(-5.0f - (float)h)); }
__device__ __forceinline__ float sigmoidf_(float x) { return frcp(1.0f + fexp2(-1.4426950408889634f * x)); }

__device__ __forceinline__ float shx(float v, int m, int lane) { return __int_as_float(__builtin_amdgcn_ds_bpermute((lane ^ m) << 2, __float_as_int(v))); }
__device__ __forceinline__ unsigned long long shx64(unsigned long long v, int m, int lane) {
    const unsigned lo = (unsigned)__builtin_amdgcn_ds_bpermute((lane ^ m) << 2, (int)(unsigned)v), hi = (unsigned)__builtin_amdgcn_ds_bpermute((lane ^ m) << 2, (int)(unsigned)(v >> 32));
    return ((unsigned long long)hi << 32) | lo; }
__device__ __forceinline__ float wave_sum(float v, int lane) {
#pragma unroll
    for (int o = 32; o >= 1; o >>= 1) v += shx(v, o, lane);
    return v;
}
constexpr int HTB = 128 * 64 * 2;
__device__ __forceinline__ int lds_byte(int r, int c) { const int st = (r >> 4) * 2 + (c >> 5), rr = r & 15, cc = c & 31, ob = rr * 64 + cc * 2; return st * 1024 + (ob ^ (((ob >> 9) & 1) << 5)); }
__device__ __forceinline__ void stage_rc(int b, int& R, int& C) { const int st = b / 1024, sb = b % 1024, swz = sb ^ (((sb >> 9) & 1) << 5); R = (st >> 1) * 16 + swz / 64; C = (st & 1) * 32 + (swz % 64) / 2; }
__device__ __forceinline__ void tile_order(int L, int nM, int nN, int& pm, int& pn) {
    const int nwg = nM * nN; int wgid = L;
    { const int q = nwg / 8, r = nwg % 8, xcd = wgid % 8, off = wgid / 8; wgid = (xcd < r ? xcd * (q + 1) : r * (q + 1) + (xcd - r) * q) + off; }
    const int nig = 8 * nN, gid = wgid / nig, fm = gid * 8, gsz = (nM - fm) < 8 ? (nM - fm) : 8;
    pm = fm + ((wgid % nig) % gsz); pn = (wgid % nig) / gsz;
}
struct UInfo { const char* a; const char* b; int r0, c0, x0, x1; };
typedef f32x4 AccT[2][2][4][2];

template <class P>
__device__ __forceinline__ void gemm_phase(LAS unsigned char* lds, const P& pb, int cofs = 0) {
    const int tid = ltid(), wid = __builtin_amdgcn_readfirstlane(tid >> 6), lane = tid & 63, wr = wid >> 2, wc = wid & 3, fr = lane & 15, fq = lane >> 4;
    const int nt = pb.nt, G = gridDim.x, c = (int)blockIdx.x - cofs; const long nun = pb.nunits();
    if (c < 0 || c >= nun) return;
    unsigned voffA[2], voffB[2];
#pragma unroll
    for (int i = 0; i < 2; ++i) { int R, C; stage_rc(tid * 16 + i * 8192, R, C); voffA[i] = pb.rowA(R) + (unsigned)C * 2u; const int rho = R & 31; const int Rb = P::PERM ? ((R & ~31) + 8 * ((rho & 15) >> 2) + 4 * (rho >> 4) + (rho & 3)) : R; voffB[i] = (unsigned)Rb * pb.ldb + (unsigned)C * 2u; }
    const size_t hsA = pb.rowA(128), hsB = (size_t)128 * pb.ldb;
    const unsigned ldsw = (unsigned)wid * 1024u;
    const int aoff = lds_byte(wr * 64 + fr, fq * 8), boff = lds_byte(wc * 32 + fr, fq * 8);
#define G_SA(b, h) (((b) * 2 + (h)) * HTB)
#define G_SB(b, h) ((4 + (b) * 2 + (h)) * HTB)
#define G_STAGE(bufoff, gbase, voff) do { _Pragma("unroll") for (int _i = 0; _i < 2; ++_i) \
        __builtin_amdgcn_global_load_lds((const unsigned*)((const char*)(gbase) + (voff)[_i]), (LAS unsigned*)(lds + (bufoff) + ldsw + _i * 8192), 16, 0, 0); } while (0)
#define G_LDA(dst, b, h) do { _Pragma("unroll") for (int m = 0; m < 4; ++m) _Pragma("unroll") for (int k = 0; k < 2; ++k) dst[m][k] = *(const LAS bf16x8*)(lds + G_SA(b, h) + aoff + m * 2048 + k * 1024); } while (0)
#define G_LDB(dst, b, h) do { _Pragma("unroll") for (int n = 0; n < 2; ++n) _Pragma("unroll") for (int k = 0; k < 2; ++k) dst[n][k] = *(const LAS bf16x8*)(lds + G_SB(b, h) + boff + n * 2048 + k * 1024); } while (0)
#define G_MMA(ai, bj, At, Bt) do { __builtin_amdgcn_s_setprio(1); _Pragma("unroll") for (int m = 0; m < 4; ++m) _Pragma("unroll") for (int n = 0; n < 2; ++n) _Pragma("unroll") for (int k = 0; k < 2; ++k) \
        acc[ai][bj][m][n] = __builtin_amdgcn_mfma_f32_16x16x32_bf16(Bt[n][k], At[m][k], acc[ai][bj][m][n], 0, 0, 0); __builtin_amdgcn_s_setprio(0); } while (0)
#define G_WAIT_V(n) asm volatile("s_waitcnt vmcnt(" #n ")" ::: "memory")
#define G_WAIT_L(n) asm volatile("s_waitcnt lgkmcnt(" #n ")" ::: "memory")
#define G_BAR __builtin_amdgcn_s_barrier()
#define G_SCHED __builtin_amdgcn_sched_barrier(0)
    UInfo cur, nxt; int ui = 0;
    pb.unit(c, cur);
    AccT acc;
#pragma unroll
    for (int a = 0; a < 2; ++a)
#pragma unroll
        for (int b = 0; b < 2; ++b)
#pragma unroll
            for (int m = 0; m < 4; ++m)
#pragma unroll
                for (int n = 0; n < 2; ++n) acc[a][b][m][n] = (f32x4){0.f, 0.f, 0.f, 0.f};
    bf16x8 At[4][2], B0[2][2], B1[2][2];
    const char* cA = cur.a; const char* cB = cur.b;
    G_STAGE(G_SB(0, 0), cB + pb.bK(0), voffB); G_STAGE(G_SA(0, 0), cA + pb.aK(0), voffA); G_STAGE(G_SB(0, 1), cB + hsB + pb.bK(0), voffB); G_STAGE(G_SA(0, 1), cA + hsA + pb.aK(0), voffA);
    if (wr == 1) G_BAR;
    G_WAIT_V(4); G_BAR;
    G_STAGE(G_SB(1, 0), cB + pb.bK(1), voffB); G_STAGE(G_SA(1, 0), cA + pb.aK(1), voffA); G_STAGE(G_SB(1, 1), cB + hsB + pb.bK(1), voffB);
    G_WAIT_V(6); G_BAR;
    for (;;) {
        const long Ln = (long)(ui + 1) * G + c; const bool has_next = Ln < nun;
        if (has_next) pb.unit(Ln, nxt);
        const char* nA = has_next ? nxt.a : cA; const char* nB = has_next ? nxt.b : cB;
        for (int t = 0; t < nt; t += 2) {
            const bool last = (t == nt - 2);
            const char* a1 = cA + pb.aK(t + 1);
            const char* a2 = last ? nA + pb.aK(0) : cA + pb.aK(t + 2); const char* b2 = last ? nB + pb.bK(0) : cB + pb.bK(t + 2);
            const char* a3 = last ? nA + pb.aK(1) : cA + pb.aK(t + 3); const char* b3 = last ? nB + pb.bK(1) : cB + pb.bK(t + 3);
            G_LDB(B0, 0, 0); G_SCHED; G_LDA(At, 0, 0); G_STAGE(G_SA(1, 1), a1 + hsA, voffA);
            G_WAIT_L(8); G_BAR; G_WAIT_L(0); G_MMA(0, 0, At, B0); G_BAR; G_SCHED;
            G_LDB(B1, 0, 1); G_STAGE(G_SB(0, 0), b2, voffB);
            G_BAR; G_WAIT_L(0); G_MMA(0, 1, At, B1); G_BAR;
            G_LDA(At, 0, 1); G_STAGE(G_SA(0, 0), a2, voffA);
            G_BAR; G_WAIT_L(0); G_MMA(1, 0, At, B0); G_BAR; G_SCHED;
            G_STAGE(G_SB(0, 1), b2 + hsB, voffB);
            G_WAIT_V(6); G_BAR; G_MMA(1, 1, At, B1); G_BAR;
            G_LDB(B0, 1, 0); G_SCHED; G_LDA(At, 1, 0); G_STAGE(G_SA(0, 1), a2 + hsA, voffA);
            G_WAIT_L(8); G_BAR; G_WAIT_L(0); G_MMA(0, 0, At, B0); G_BAR; G_SCHED;
            G_LDB(B1, 1, 1); G_STAGE(G_SB(1, 0), b3, voffB);
            G_BAR; G_WAIT_L(0); G_MMA(0, 1, At, B1); G_BAR;
            G_LDA(At, 1, 1); G_STAGE(G_SA(1, 0), a3, voffA);
            G_BAR; G_WAIT_L(0); G_MMA(1, 0, At, B0); G_BAR; G_SCHED;
            G_STAGE(G_SB(1, 1), b3 + hsB, voffB);
            G_WAIT_V(6); G_BAR; G_MMA(1, 1, At, B1); G_BAR;
        }
        { const int l2 = ltid() & 63; pb.epi(acc, cur, wr, wc, l2 & 15, l2 >> 4); }
        if (!has_next) break;
#pragma unroll
        for (int a = 0; a < 2; ++a)
#pragma unroll
            for (int b = 0; b < 2; ++b)
#pragma unroll
                for (int m = 0; m < 4; ++m)
#pragma unroll
                    for (int n = 0; n < 2; ++n) acc[a][b][m][n] = (f32x4){0.f, 0.f, 0.f, 0.f};
        cur = nxt; cA = nA; cB = nB; ++ui;
    }
    G_WAIT_V(0);
    if (wr == 0) G_BAR;
    G_BAR;
}

#define EPI_ROWS for (int ai = 0; ai < 2; ++ai) for (int m = 0; m < 4; ++m)
#define EPI_COLS for (int bj = 0; bj < 2; ++bj) for (int n = 0; n < 2; ++n)
#define EPI_ROW (128 * ai + 64 * wr + 16 * m + fr)
#define EPI_COL (128 * bj + 32 * wc + 16 * n + 4 * fq)

template <class Epi> struct Prob2D {
    static constexpr bool PERM = Epi::PERM;
    const char* A; const char* B; unsigned lda, ldb; int nt, nM, nN; Epi e;
    __device__ __forceinline__ long nunits() const { return (long)nM * nN; }
    __device__ __forceinline__ unsigned rowA(int R) const { return (unsigned)R * lda; }
    __device__ __forceinline__ void unit(long L, UInfo& u) const { int pm, pn; tile_order((int)L, nM, nN, pm, pn); u.a = A + (size_t)pm * 256 * lda; u.b = B + (size_t)pn * 256 * ldb; u.r0 = pm * 256; u.c0 = pn * 256; u.x0 = 0; u.x1 = 0; }
    __device__ __forceinline__ size_t aK(int kt) const { return (size_t)kt * 128; }
    __device__ __forceinline__ size_t bK(int kt) const { return (size_t)kt * 128; }
    __device__ __forceinline__ void epi(const AccT& acc, const UInfo& u, int wr, int wc, int fr, int fq) const { e(acc, u, wr, wc, fr, fq); }
};
struct EpiStore { static constexpr bool PERM = true; bf16_t* O; size_t ldc;
    __device__ __forceinline__ void operator()(const AccT& acc, const UInfo& u, int wr, int wc, int fr, int fq) const {
#pragma unroll
        EPI_ROWS { bf16_t* rp = O + (size_t)(u.r0 + EPI_ROW) * ldc + u.c0;
#pragma unroll
            for (int bj = 0; bj < 2; ++bj) { const f32x4 v = acc[ai][bj][m][0], v2 = acc[ai][bj][m][1]; *(u32x4*)(rp + 128 * bj + 32 * wc + 8 * fq) = (u32x4){pk_bf16(v[0], v[1]), pk_bf16(v[2], v[3]), pk_bf16(v2[0], v2[1]), pk_bf16(v2[2], v2[3])}; } }
    } };
struct EpiRes { static constexpr bool PERM = false; const float* R; float* O; bf16_t* HB; float* ss;
    __device__ __forceinline__ void operator()(const AccT& acc, const UInfo& u, int wr, int wc, int fr, int fq) const {
#pragma unroll
        EPI_ROWS { const size_t ro = (size_t)(u.r0 + EPI_ROW) * 2048 + u.c0; float sq = 0.f;
#pragma unroll
            EPI_COLS { const f32x4 r = *(const f32x4*)(R + ro + EPI_COL); const f32x4 o = r + acc[ai][bj][m][n]; *(f32x4*)(O + ro + EPI_COL) = o;
                if (HB) { *(u32x2*)(HB + ro + EPI_COL) = (u32x2){pk_bf16(o[0], o[1]), pk_bf16(o[2], o[3])}; sq += o[0] * o[0] + o[1] * o[1] + o[2] * o[2] + o[3] * o[3]; } }
            if (HB) { const int lane = fq * 16 + fr; sq += shx(sq, 16, lane); sq += shx(sq, 32, lane); if (fq == 0) atomicAdd(ss + u.r0 + EPI_ROW, sq); } }
    } };
struct EpiStoreRS { static constexpr bool PERM = true; bf16_t* O; size_t ldc; const float* ss;
    __device__ __forceinline__ void operator()(const AccT& acc, const UInfo& u, int wr, int wc, int fr, int fq) const {
#pragma unroll
        EPI_ROWS { const int row = u.r0 + EPI_ROW; const float rs = rsqrtf(ss[row] * (1.0f / 2048.0f) + 1e-6f); bf16_t* rp = O + (size_t)row * ldc + u.c0;
#pragma unroll
            for (int bj = 0; bj < 2; ++bj) { const f32x4 v = acc[ai][bj][m][0] * rs, v2 = acc[ai][bj][m][1] * rs; *(u32x4*)(rp + 128 * bj + 32 * wc + 8 * fq) = (u32x4){pk_bf16(v[0], v[1]), pk_bf16(v[2], v[3]), pk_bf16(v2[0], v2[1]), pk_bf16(v2[2], v2[3])}; } }
    } };
struct EpiStoreCS { static constexpr bool PERM = true; bf16_t* O; size_t ldc; const float* ss;
    __device__ __forceinline__ void operator()(const AccT& acc, const UInfo& u, int wr, int wc, int fr, int fq) const {
        f32x4 rs[2][2];
#pragma unroll
        for (int bj = 0; bj < 2; ++bj)
#pragma unroll
            for (int n = 0; n < 2; ++n) { const f32x4 s4 = *(const f32x4*)(ss + u.c0 + 128 * bj + 32 * wc + 8 * fq + 4 * n);
#pragma unroll
                for (int j = 0; j < 4; ++j) rs[bj][n][j] = rsqrtf(s4[j] * (1.0f / 2048.0f) + 1e-6f); }
#pragma unroll
        EPI_ROWS { bf16_t* rp = O + (size_t)(u.r0 + EPI_ROW) * ldc + u.c0;
#pragma unroll
            for (int bj = 0; bj < 2; ++bj) { const f32x4 v = acc[ai][bj][m][0] * rs[bj][0], v2 = acc[ai][bj][m][1] * rs[bj][1]; *(u32x4*)(rp + 128 * bj + 32 * wc + 8 * fq) = (u32x4){pk_bf16(v[0], v[1]), pk_bf16(v[2], v[3]), pk_bf16(v2[0], v2[1]), pk_bf16(v2[2], v2[3])}; } }
    } };
struct EpiGate { static constexpr bool PERM = true; bf16_t* Y; const float2* gns; const float* gain;
    __device__ __forceinline__ void operator()(const AccT& acc, const UInfo& u, int wr, int wc, int fr, int fq) const {
        const int hh = u.c0 >> 9;
#pragma unroll
        EPI_ROWS { const int row = u.r0 + EPI_ROW; bf16_t* rp = Y + (size_t)row * 4096 + u.c0;
            const float2 sg = gns[(size_t)row * 8 + hh]; const float mu = sg.x, rs = sg.y;
#pragma unroll
            for (int bj = 0; bj < 2; ++bj) { const f32x4 g = acc[ai][bj][m][0], h = acc[ai][bj][m][1]; bf16_t* cp = rp + 128 * bj + 32 * wc + 8 * fq; const u32x4 y = *(const u32x4*)cp;
                const float* gp = gain + u.c0 + 128 * bj + 32 * wc + 8 * fq; const f32x4 g0 = *(const f32x4*)gp * rs, g1 = *(const f32x4*)(gp + 4) * rs;
                const float o0 = g[0] * sigmoidf_(g[0]) * (bflo(y[0]) - mu) * g0[0], o1 = g[1] * sigmoidf_(g[1]) * (bfhi(y[0]) - mu) * g0[1], o2 = g[2] * sigmoidf_(g[2]) * (bflo(y[1]) - mu) * g0[2], o3 = g[3] * sigmoidf_(g[3]) * (bfhi(y[1]) - mu) * g0[3];
                const float o4 = h[0] * sigmoidf_(h[0]) * (bflo(y[2]) - mu) * g1[0], o5 = h[1] * sigmoidf_(h[1]) * (bfhi(y[2]) - mu) * g1[1], o6 = h[2] * sigmoidf_(h[2]) * (bflo(y[3]) - mu) * g1[2], o7 = h[3] * sigmoidf_(h[3]) * (bfhi(y[3]) - mu) * g1[3];
                *(u32x4*)cp = (u32x4){pk_bf16(o0, o1), pk_bf16(o2, o3), pk_bf16(o4, o5), pk_bf16(o6, o7)}; } }
    } };
struct EpiQK { static constexpr bool PERM = false; bf16_t* Q; bf16_t* K; bf16_t* KTD; const float2* rope;
    __device__ __forceinline__ void operator()(const AccT& acc, const UInfo& u, int wr, int wc, int fr, int fq) const {
        const int hidx = u.c0 >> 8; const bool isk = hidx >= 8; const int hh = hidx & 7; const float l2g = log2gamma(hh);
        bf16_t* dst = (isk ? K : Q) + hh * 256; const float sc = isk ? 0.0625f : 1.0f;
#pragma unroll
        EPI_ROWS { const int t = u.r0 + EPI_ROW; const float kd = fexp2((float)(255 - (t & 255)) * l2g);
#pragma unroll
            for (int n = 0; n < 2; ++n) { const int dd = 32 * wc + 16 * n + 4 * fq;
                const f32x4 x1 = acc[ai][0][m][n], x2 = acc[ai][1][m][n]; const f32x4 cs0 = *(const f32x4*)(rope + (size_t)t * 128 + dd), cs1 = *(const f32x4*)(rope + (size_t)t * 128 + dd + 2);
                float y1[4], y2[4];
                y1[0] = (x1[0] * cs0[0] - x2[0] * cs0[1]) * sc; y2[0] = (x1[0] * cs0[1] + x2[0] * cs0[0]) * sc;
                y1[1] = (x1[1] * cs0[2] - x2[1] * cs0[3]) * sc; y2[1] = (x1[1] * cs0[3] + x2[1] * cs0[2]) * sc;
                y1[2] = (x1[2] * cs1[0] - x2[2] * cs1[1]) * sc; y2[2] = (x1[2] * cs1[1] + x2[2] * cs1[0]) * sc;
                y1[3] = (x1[3] * cs1[2] - x2[3] * cs1[3]) * sc; y2[3] = (x1[3] * cs1[3] + x2[3] * cs1[2]) * sc;
                *(u32x2*)(dst + (size_t)t * 2048 + dd) = (u32x2){pk_bf16(y1[0], y1[1]), pk_bf16(y1[2], y1[3])};
                *(u32x2*)(dst + (size_t)t * 2048 + 128 + dd) = (u32x2){pk_bf16(y2[0], y2[1]), pk_bf16(y2[2], y2[3])};
                if (isk) {
#pragma unroll
                    for (int j = 0; j < 4; ++j) { KTD[(size_t)(hh * 256 + dd + j) * S_ + t] = (bf16_t)(pk_bf16(y1[j] * kd, 0.f) & 0xffffu); KTD[(size_t)(hh * 256 + 128 + dd + j) * S_ + t] = (bf16_t)(pk_bf16(y2[j] * kd, 0.f) & 0xffffu); }
                } } }
    } };
struct EpiQproj { static constexpr bool PERM = false; bf16_t* QB; float* gates; const float* ss;
    __device__ __forceinline__ void operator()(const AccT& acc, const UInfo& u, int wr, int wc, int fr, int fq) const {
#pragma unroll
        EPI_ROWS { const int t = u.r0 + EPI_ROW; const float rs = rsqrtf(ss[t] * (1.0f / 2048.0f) + 1e-6f);
#pragma unroll
            EPI_COLS { const int col = u.c0 + EPI_COL; const f32x4 v = acc[ai][bj][m][n] * rs;
                if (col < 2048) *(u32x2*)(QB + (size_t)t * 2048 + col) = (u32x2){pk_bf16(v[0] * 0.08838834764831845f, v[1] * 0.08838834764831845f), pk_bf16(v[2] * 0.08838834764831845f, v[3] * 0.08838834764831845f)};
                else if (col < 2096) *(f32x4*)(gates + (size_t)t * 48 + (col - 2048)) = (f32x4){sigmoidf_(v[0]), sigmoidf_(v[1]), sigmoidf_(v[2]), sigmoidf_(v[3])}; } }
    } };
__device__ __forceinline__ float gelu_tanh(float x) { const float y = 0.7978845608028654f * (x + 0.044715f * x * x * x); const float e = fexp2(2.0f * 1.4426950408889634f * y); const float th = 1.0f - 2.0f * frcp(e + 1.0f); return 0.5f * x * (1.0f + th); }
struct EpiGelu { static constexpr bool PERM = false; bf16_t* H; const float* bias;
    __device__ __forceinline__ void operator()(const AccT& acc, const UInfo& u, int wr, int wc, int fr, int fq) const {
#pragma unroll
        EPI_ROWS { bf16_t* rp = H + (size_t)(u.r0 + EPI_ROW) * 256;
#pragma unroll
            EPI_COLS { const int col = EPI_COL; const f32x4 v = acc[ai][bj][m][n]; const f32x4 bb = *(const f32x4*)(bias + col);
                *(u32x2*)(rp + col) = (u32x2){pk_bf16(gelu_tanh(v[0] + bb[0]), gelu_tanh(v[1] + bb[1])), pk_bf16(gelu_tanh(v[2] + bb[2]), gelu_tanh(v[3] + bb[3]))}; } }
    } };
struct EpiKcmp { static constexpr bool PERM = false; bf16_t* KC;
    __device__ __forceinline__ void operator()(const AccT& acc, const UInfo& u, int wr, int wc, int fr, int fq) const {
#pragma unroll
        EPI_ROWS { const int r = u.r0 + EPI_ROW, i = r >> 2, h = r & 3;
#pragma unroll
            for (int n = 0; n < 2; ++n) { const int col = 32 * wc + 16 * n + 4 * fq; f32x4 v = acc[ai][0][m][n]; if (i == 1023) v = (f32x4){0.f, 0.f, 0.f, 0.f};
                *(u32x2*)(KC + ((size_t)h * 1024 + i) * 128 + col) = (u32x2){pk_bf16(v[0], v[1]), pk_bf16(v[2], v[3])}; } }
    } };
struct EpiVcmp { static constexpr bool PERM = false; bf16_t* VC;
    __device__ __forceinline__ void operator()(const AccT& acc, const UInfo& u, int wr, int wc, int fr, int fq) const {
#pragma unroll
        for (int m = 0; m < 4; ++m) { const int d = 64 * wr + 16 * m + fr;
#pragma unroll
            EPI_COLS { const int col = u.c0 + EPI_COL, i = col >> 2; f32x4 v = acc[0][bj][m][n]; if (i == 1023) v = (f32x4){0.f, 0.f, 0.f, 0.f};
#pragma unroll
                for (int h = 0; h < 4; ++h) VC[((size_t)h * 128 + d) * 1024 + i] = (bf16_t)(pk_bf16(v[h], 0.f) & 0xffffu); } }
    } };
struct ProbCmp1 {
    static constexpr bool PERM = false;
    const char* A; const char* B; unsigned ldb; int nt, nM; EpiGelu e;
    __device__ __forceinline__ long nunits() const { return nM; }
    __device__ __forceinline__ unsigned rowA(int R) const { return (unsigned)(R >> 2) * 65536u + (unsigned)(R & 3) * 256u; }
    __device__ __forceinline__ void unit(long L, UInfo& u) const { u.a = A + (size_t)L * 64 * 65536; u.b = B; u.r0 = (int)L * 256; u.c0 = 0; u.x0 = 0; u.x1 = 0; }
    __device__ __forceinline__ size_t aK(int kt) const { return (size_t)(kt >> 1) * 4096 + (size_t)(kt & 1) * 128; }
    __device__ __forceinline__ size_t bK(int kt) const { return (size_t)kt * 128; }
    __device__ __forceinline__ void epi(const AccT& acc, const UInfo& u, int wr, int wc, int fr, int fq) const { e(acc, u, wr, wc, fr, fq); }
};
struct ProbKV {
    static constexpr bool PERM = true;
    const char* VT; const char* KTD; bf16_t* ST; int nt;
    __device__ __forceinline__ long nunits() const { return 8 * 64 * 2; }
    __device__ __forceinline__ unsigned rowA(int R) const { return (unsigned)R * 32768u; }
    static constexpr unsigned ldb = 32768u;
    __device__ __forceinline__ void unit(long L, UInfo& u) const { const int pm = (int)L & 1, c = ((int)L >> 1) & 63, h = (int)L >> 7;
        u.a = VT + ((size_t)(h * 512 + pm * 256) * S_ + c * 256) * 2; u.b = KTD + ((size_t)(h * 256) * S_ + c * 256) * 2; u.r0 = h * 512 + pm * 256; u.c0 = c * 256; u.x0 = 0; u.x1 = 0; }
    __device__ __forceinline__ size_t aK(int kt) const { return (size_t)kt * 128; }
    __device__ __forceinline__ size_t bK(int kt) const { return (size_t)kt * 128; }
    __device__ __forceinline__ void epi(const AccT& acc, const UInfo& u, int wr, int wc, int fr, int fq) const { EpiStore e{ST, (size_t)S_}; e(acc, u, wr, wc, fr, fq); }
};
struct ProbS {
    static constexpr bool PERM = true;
    const char* Q; const char* K; bf16_t* SD; int nt;
    __device__ __forceinline__ long nunits() const { return 8 * 64; }
    __device__ __forceinline__ unsigned rowA(int R) const { return (unsigned)R * 4096u; }
    static constexpr unsigned ldb = 4096u;
    __device__ __forceinline__ void unit(long L, UInfo& u) const { const int c = (int)L & 63, h = (int)L >> 6; const size_t o = ((size_t)(c * 256) * 2048 + h * 256) * 2;
        u.a = Q + o; u.b = K + o; u.r0 = c * 256; u.c0 = h * 256; u.x0 = h; u.x1 = 0; }
    __device__ __forceinline__ size_t aK(int kt) const { return (size_t)kt * 128; }
    __device__ __forceinline__ size_t bK(int kt) const { return (size_t)kt * 128; }
    __device__ __forceinline__ void epi(const AccT& acc, const UInfo& u, int wr, int wc, int fr, int fq) const {
        const float l2g = log2gamma(u.x0);
#pragma unroll
        EPI_ROWS { const int i = EPI_ROW; bf16_t* rp = SD + (size_t)(u.r0 + i) * 2048 + u.c0;
#pragma unroll
            for (int bj = 0; bj < 2; ++bj) { const int s = 128 * bj + 32 * wc + 8 * fq; const f32x4 v = acc[ai][bj][m][0], v2 = acc[ai][bj][m][1]; float o[8];
#pragma unroll
                for (int j = 0; j < 4; ++j) { o[j] = (s + j <= i) ? v[j] * fexp2(-(float)(s + j + 1) * l2g) : 0.f; o[4 + j] = (s + 4 + j <= i) ? v2[j] * fexp2(-(float)(s + 4 + j + 1) * l2g) : 0.f; }
                *(u32x4*)(rp + s) = (u32x4){pk_bf16(o[0], o[1]), pk_bf16(o[2], o[3]), pk_bf16(o[4], o[5]), pk_bf16(o[6], o[7])}; } }
    }
};
struct ProbOut {
    static constexpr bool PERM = true;
    const char* Q; const char* ST; long dA, dB; bf16_t* Y; int nt;
    __device__ __forceinline__ long nunits() const { return 8 * 64 * 2; }
    __device__ __forceinline__ unsigned rowA(int R) const { return (unsigned)R * 4096u; }
    static constexpr unsigned ldb = 32768u;
    __device__ __forceinline__ void unit(long L, UInfo& u) const { const int pn = (int)L & 1, c = ((int)L >> 1) & 63, h = (int)L >> 7;
        u.a = Q + ((size_t)(c * 256) * 2048 + h * 256) * 2; u.b = ST + ((size_t)(h * 512 + pn * 256) * S_ + c * 256) * 2; u.r0 = c * 256; u.c0 = h * 512 + pn * 256; u.x0 = h; u.x1 = 0; }
    __device__ __forceinline__ size_t aK(int kt) const { return kt < 4 ? (size_t)kt * 128 : (size_t)(dA + (long)(kt - 4) * 128); }
    __device__ __forceinline__ size_t bK(int kt) const { return kt < 4 ? (size_t)kt * 128 : (size_t)(dB + (long)(kt - 4) * 128); }
    __device__ __forceinline__ void epi(const AccT& acc, const UInfo& u, int wr, int wc, int fr, int fq) const {
        const float l2g = log2gamma(u.x0);
#pragma unroll
        EPI_ROWS { const int i = EPI_ROW; const float qd = fexp2((float)(i + 1) * l2g); bf16_t* rp = Y + (size_t)(u.r0 + i) * 4096 + u.c0;
#pragma unroll
            for (int bj = 0; bj < 2; ++bj) { const f32x4 v = acc[ai][bj][m][0] * qd, v2 = acc[ai][bj][m][1] * qd; *(u32x4*)(rp + 128 * bj + 32 * wc + 8 * fq) = (u32x4){pk_bf16(v[0], v[1]), pk_bf16(v[2], v[3]), pk_bf16(v2[0], v2[1]), pk_bf16(v2[2], v2[3])}; } }
    }
};

__device__ __forceinline__ void transpose_job(const float* __restrict__ src, bf16_t* __restrict__ dst, int K, int N, int Npad, int kvperm, LAS float* tile, const float* gain = nullptr) {
    const int tk = K / 64, tn = Npad / 256, ntile = tk * tn; const int tid = ltid();
    for (int t = blockIdx.x; t < ntile; t += gridDim.x) {
        const int k0 = (t % tk) * 64, n0 = (t / tk) * 256;
        { const int r0 = tid >> 6, cc = tid & 63; float v[8][4];
#pragma unroll
          for (int i = 0; i < 8; ++i)
#pragma unroll
              for (int q = 0; q < 4; ++q) { const int n = n0 + cc + 64 * q; v[i][q] = (n < N) ? src[(size_t)(k0 + r0 + 8 * i) * N + n] : 0.f; }
#pragma unroll
          for (int i = 0; i < 8; ++i) { const float gk = gain ? gain[k0 + r0 + 8 * i] : 1.0f;
#pragma unroll
              for (int q = 0; q < 4; ++q) tile[(r0 + 8 * i) * 257 + cc + 64 * q] = v[i][q] * gk; } }
        __syncthreads();
        { const int rr = tid >> 1, c0 = (tid & 1) * 32;
          int n = n0 + rr; if (kvperm) { const int j = n >> 9; const int jp = (j == 3) ? 4 : ((j == 4) ? 3 : j); n = jp * 512 + (n & 511); }
          bf16_t* dp = dst + (size_t)n * K + k0 + c0;
#pragma unroll
          for (int g = 0; g < 4; ++g) { float x[8];
#pragma unroll
              for (int j = 0; j < 8; ++j) x[j] = tile[(c0 + 8 * g + j) * 257 + rr];
              *(u32x4*)(dp + 8 * g) = (u32x4){pk_bf16(x[0], x[1]), pk_bf16(x[2], x[3]), pk_bf16(x[4], x[5]), pk_bf16(x[6], x[7])}; } }
        __syncthreads();
    }
}
__device__ __forceinline__ void prep_phase(CP p, LAS unsigned char* lds) {
    LAS float* tile = (LAS float*)lds; unsigned char* ws = p->ws;
    transpose_job(p->ret_w_in, (bf16_t*)(ws + OFF_W_RIN), 2048, 12288, 12288, 0, tile);
    transpose_job(p->ret_w_out, (bf16_t*)(ws + OFF_W_ROUT), 4096, 2048, 2048, 0, tile);
    transpose_job(p->w_kv, (bf16_t*)(ws + OFF_W_KV), 2048, 3072, 3072, 1, tile, p->kv_gain);
    transpose_job(p->w1_k, (bf16_t*)(ws + OFF_W_C1K), 4096, 256, 256, 0, tile);
    transpose_job(p->w1_v, (bf16_t*)(ws + OFF_W_C1V), 4096, 256, 256, 0, tile);
    transpose_job(p->w2_k, (bf16_t*)(ws + OFF_W_C2K), 256, 128, 256, 0, tile);
    transpose_job(p->w2_v, (bf16_t*)(ws + OFF_W_C2V), 256, 128, 256, 0, tile);
    transpose_job(p->w_q, (bf16_t*)(ws + OFF_W_Q), 2048, 2096, 2304, 0, tile, p->norm_mix + 2048);
    transpose_job(p->w_o, (bf16_t*)(ws + OFF_W_O), 2048, 2048, 2048, 0, tile);
    transpose_job(p->ffn_w_in, (bf16_t*)(ws + OFF_W_FIN), 2048, 8192, 8192, 0, tile, p->norm_ffn);
    transpose_job(p->ffn_w_in + (size_t)2048 * 8192, (bf16_t*)(ws + OFF_W_FIN + 32 * MiB), 2048, 8192, 8192, 0, tile, p->norm_ffn + 2048);
    transpose_job(p->ffn_w_out, (bf16_t*)(ws + OFF_W_FOUT), 4096, 2048, 2048, 0, tile);
    transpose_job(p->ffn_w_out + (size_t)4096 * 2048, (bf16_t*)(ws + OFF_W_FOUT + 16 * MiB), 4096, 2048, 2048, 0, tile);
    { float* ss = (float*)(ws + OFF_SS); for (int i = blockIdx.x * 512 + ltid(); i < 8 * S_; i += gridDim.x * 512) ss[i] = 0.f; }
    { float2* rope = (float2*)(ws + OFF_ROPE); const int gsz = gridDim.x * 512;
      for (int i = blockIdx.x * 512 + ltid(); i < S_ * 128; i += gsz) { const int t = i >> 7, dd = i & 127;
          const float freq = exp2f(-(float)dd * (13.287712379549449f / 128.0f)); const double rev = (double)t * (double)freq * 0.15915494309189535;
          const float fx = (float)(rev - rint(rev)); rope[i] = make_float2(__builtin_amdgcn_cosf(fx), __builtin_amdgcn_sinf(fx)); } }
    if (blockIdx.x < 128) { const int kv = blockIdx.x >> 6, oc = blockIdx.x & 63; const float* pe = kv ? p->pe_v : p->pe_k; const float* w1 = kv ? p->w1_v : p->w1_k; float* peb = (float*)(ws + OFF_PEB) + kv * 256;
        const int tid = ltid(), g = tid >> 7, r = tid & 127, n = 4 * oc + g; float s = 0.f;
#pragma unroll 8
        for (int j = 0; j < 32; ++j) { const int k = r + 128 * j; s += pe[k] * w1[(size_t)k * 256 + n]; }
        s = wave_sum(s, tid & 63);
        __syncthreads(); if ((tid & 63) == 0) tile[tid >> 6] = s; __syncthreads();
        if (tid < 4) peb[4 * oc + tid] = tile[2 * tid] + tile[2 * tid + 1];
        __syncthreads(); }
}
__device__ __forceinline__ void rmsnorm_phase(const float* h, const float* g1, bf16_t* o1, const float* g2, bf16_t* o2) {
    const int w = ltid() >> 6, lane = ltid() & 63;
    for (int row = blockIdx.x * 8 + w; row < S_; row += gridDim.x * 8) {
        const f32x4* p = (const f32x4*)(h + (size_t)row * 2048); f32x4 v[8]; float ss = 0.f;
#pragma unroll
        for (int i = 0; i < 8; ++i) { v[i] = p[lane + 64 * i]; ss += v[i][0] * v[i][0] + v[i][1] * v[i][1] + v[i][2] * v[i][2] + v[i][3] * v[i][3]; }
        ss = wave_sum(ss, lane); const float r = rsqrtf(ss * (1.0f / 2048.0f) + 1e-6f);
#pragma unroll
        for (int i = 0; i < 8; ++i) { const int col = (lane + 64 * i) * 4; const f32x4 g = *(const f32x4*)(g1 + col);
            *(u32x2*)(o1 + (size_t)row * 2048 + col) = (u32x2){pk_bf16(v[i][0] * r * g[0], v[i][1] * r * g[1]), pk_bf16(v[i][2] * r * g[2], v[i][3] * r * g[3])};
            if (o2) { const f32x4 gg = *(const f32x4*)(g2 + col);
                *(u32x2*)(o2 + (size_t)row * 2048 + col) = (u32x2){pk_bf16(v[i][0] * r * gg[0], v[i][1] * r * gg[1]), pk_bf16(v[i][2] * r * gg[2], v[i][3] * r * gg[3])}; } }
    }
}
__device__ __forceinline__ void finalnorm_phase(float* h, const float* g1) {
    const int w = ltid() >> 6, lane = ltid() & 63;
    for (int row = blockIdx.x * 8 + w; row < S_; row += gridDim.x * 8) {
        f32x4* p = (f32x4*)(h + (size_t)row * 2048); f32x4 v[8]; float ss = 0.f;
#pragma unroll
        for (int i = 0; i < 8; ++i) { v[i] = p[lane + 64 * i]; ss += v[i][0] * v[i][0] + v[i][1] * v[i][1] + v[i][2] * v[i][2] + v[i][3] * v[i][3]; }
        ss = wave_sum(ss, lane); const float r = rsqrtf(ss * (1.0f / 2048.0f) + 1e-6f);
#pragma unroll
        for (int i = 0; i < 8; ++i) { const f32x4 g = *(const f32x4*)(g1 + (lane + 64 * i) * 4); p[lane + 64 * i] = v[i] * r * g; }
    }
}
__device__ __forceinline__ void scan_phase(bf16_t* ST) {
    for (int it = blockIdx.x * 512 + ltid(); it < 4096 * 32; it += gridDim.x * 512) {
        const int r = it >> 5, d8 = it & 31; const float cd = fexp2(256.0f * log2gamma(r >> 9));
        bf16_t* p = ST + (size_t)r * S_ + d8 * 8; float s[8];
#pragma unroll
        for (int j = 0; j < 8; ++j) s[j] = 0.f;
        for (int c = 0; c < 64; ++c) { const u32x4 v = *(const u32x4*)(p + c * 256);
            *(u32x4*)(p + c * 256) = (u32x4){pk_bf16(s[0], s[1]), pk_bf16(s[2], s[3]), pk_bf16(s[4], s[5]), pk_bf16(s[6], s[7])};
#pragma unroll
            for (int j = 0; j < 4; ++j) { s[2 * j] = s[2 * j] * cd + bflo(v[j]); s[2 * j + 1] = s[2 * j + 1] * cd + bfhi(v[j]); } }
    }
}
__device__ __forceinline__ void gn_phase(const bf16_t* Y, float2* gns) {
    const int w = ltid() >> 6, lane = ltid() & 63;
    for (int g = blockIdx.x * 8 + w; g < S_ * 8; g += gridDim.x * 8) {
        const u32x4 v = *(const u32x4*)(Y + (size_t)g * 512 + lane * 8); float x[8];
#pragma unroll
        for (int j = 0; j < 4; ++j) { x[2 * j] = bflo(v[j]); x[2 * j + 1] = bfhi(v[j]); }
        float s = 0.f;
#pragma unroll
        for (int j = 0; j < 8; ++j) s += x[j];
        const float mu = wave_sum(s, lane) * (1.0f / 512.0f); float q = 0.f;
#pragma unroll
        for (int j = 0; j < 8; ++j) { x[j] -= mu; q += x[j] * x[j]; }
        const float r = rsqrtf(wave_sum(q, lane) * (1.0f / 512.0f) + 1e-6f);
        if (lane == 0) gns[g] = make_float2(mu, r);
    }
}
__device__ __forceinline__ void conv_phase(const bf16_t* U, bf16_t* AB, const float* cw, const float* cb) {
    for (int it = blockIdx.x * 512 + ltid(); it < 512 * 512; it += gridDim.x * 512) {
        const int n8 = (it & 511) * 8, t0 = (it >> 9) * 32;
        float wa[3][8], wb[3][8], ba[8], bb[8];
#pragma unroll
        for (int tp = 0; tp < 3; ++tp)
#pragma unroll
            for (int j = 0; j < 8; ++j) { wa[tp][j] = cw[tp * 8192 + n8 + j]; wb[tp][j] = cw[tp * 8192 + 4096 + n8 + j]; }
#pragma unroll
        for (int j = 0; j < 8; ++j) { ba[j] = cb[n8 + j]; bb[j] = cb[4096 + n8 + j]; }
        float pa[2][8], pb[2][8];
#pragma unroll
        for (int k = 0; k < 2; ++k) { const int t = t0 - 2 + k; u32x4 va = (u32x4){0, 0, 0, 0}, vb = (u32x4){0, 0, 0, 0};
            if (t >= 0) { va = *(const u32x4*)(U + (size_t)t * 8192 + n8); vb = *(const u32x4*)(U + (size_t)t * 8192 + 4096 + n8); }
#pragma unroll
            for (int j = 0; j < 4; ++j) { pa[k][2 * j] = bflo(va[j]); pa[k][2 * j + 1] = bfhi(va[j]); pb[k][2 * j] = bflo(vb[j]); pb[k][2 * j + 1] = bfhi(vb[j]); } }
#pragma unroll 8
        for (int k = 0; k < 32; ++k) { const int t = t0 + k; const u32x4 va = *(const u32x4*)(U + (size_t)t * 8192 + n8), vb = *(const u32x4*)(U + (size_t)t * 8192 + 4096 + n8);
            float xa[8], xb[8], o[8];
#pragma unroll
            for (int j = 0; j < 4; ++j) { xa[2 * j] = bflo(va[j]); xa[2 * j + 1] = bfhi(va[j]); xb[2 * j] = bflo(vb[j]); xb[2 * j + 1] = bfhi(vb[j]); }
#pragma unroll
            for (int j = 0; j < 8; ++j) { const float a = ba[j] + wa[0][j] * pa[0][j] + wa[1][j] * pa[1][j] + wa[2][j] * xa[j]; const float b = bb[j] + wb[0][j] * pb[0][j] + wb[1][j] * pb[1][j] + wb[2][j] * xb[j];
                o[j] = a * sigmoidf_(a) * b; pa[0][j] = pa[1][j]; pa[1][j] = xa[j]; pb[0][j] = pb[1][j]; pb[1][j] = xb[j]; }
            *(u32x4*)(AB + (size_t)t * 4096 + n8) = (u32x4){pk_bf16(o[0], o[1]), pk_bf16(o[2], o[3]), pk_bf16(o[4], o[5]), pk_bf16(o[6], o[7])}; }
    }
}

constexpr int XCD_CTR_WORD = 3456;
constexpr int A_KT = 0, A_VT = 17408, A_BUFSZ = 34816, A_PSL = 69632, A_SEL = 4 * A_BUFSZ, LDS_ST = A_SEL + 2048;
constexpr float LOG2E = 1.4426950408889634f;
struct AttnState { f32x4 ot[8][2]; float m[2], l[2]; };

template <int MODE>
__device__ __forceinline__ void attn_compute(LAS unsigned char* lds, int boff, int tile, const bf16x8 (&qf)[2][4], AttnState& st, const int (&tpos)[2], int qb, int w, int lane,
                                             const float (&mfin)[2], const float (&linv)[2], bool rs0, bool rs1, bool masked, bool a0, bool a1) {
    const int l16 = lane & 15, g4 = lane >> 4;
    f32x4 s[4][2];
#pragma unroll
    for (int mt = 0; mt < 4; ++mt) { s[mt][0] = (f32x4){0.f, 0.f, 0.f, 0.f}; s[mt][1] = (f32x4){0.f, 0.f, 0.f, 0.f}; }
#pragma unroll
    for (int ks = 0; ks < 4; ++ks) {
        bf16x8 kf[4];
#pragma unroll
        for (int mt = 0; mt < 4; ++mt) kf[mt] = *(const LAS bf16x8*)(lds + boff + A_KT + (16 * mt + l16) * 272 + ks * 64 + g4 * 16);
        if (a0) {
#pragma unroll
            for (int mt = 0; mt < 4; ++mt) s[mt][0] = __builtin_amdgcn_mfma_f32_16x16x32_bf16(kf[mt], qf[0][ks], s[mt][0], 0, 0, 0);
        }
        if (a1) {
#pragma unroll
            for (int mt = 0; mt < 4; ++mt) s[mt][1] = __builtin_amdgcn_mfma_f32_16x16x32_bf16(kf[mt], qf[1][ks], s[mt][1], 0, 0, 0);
        }
    }
    if (masked) {
#pragma unroll
        for (int nt = 0; nt < 2; ++nt) { const int t = tpos[nt]; const int tl = w * 8 + nt * 4 + (l16 >> 2);
#pragma unroll
            for (int mt = 0; mt < 4; ++mt)
#pragma unroll
                for (int j = 0; j < 4; ++j) { const int kl = 16 * mt + 4 * g4 + j; const int key = tile * 64 + kl; bool v;
                    if (MODE == 0 || MODE == 1) v = key <= ((t - 31) >> 4);
                    else if (MODE == 2) v = (kl <= tl);
                    else v = (key <= t) && (key > t - 512);
                    s[mt][nt][j] = v ? s[mt][nt][j] : -__builtin_inff(); } }
    }
    bf16x8 pf[2][2];
#pragma unroll
    for (int nt = 0; nt < 2; ++nt) {
        if (nt ? a1 : a0) {
            const bool rowsel = nt ? rs1 : rs0;
            const float bias = (MODE == 2 && !rowsel) ? -__builtin_inff() : 0.f;
            float mx = -1e30f;
#pragma unroll
            for (int mt = 0; mt < 4; ++mt)
#pragma unroll
                for (int j = 0; j < 4; ++j) {
                    const float sv = s[mt][nt][j] * LOG2E + bias;
                    s[mt][nt][j] = sv; mx = fmaxf(mx, sv); }
            float mnew, alpha = 1.f;
            if (MODE == 1) mnew = mfin[nt];
            else { mx = fmaxf(mx, shx(mx, 16, lane)); mx = fmaxf(mx, shx(mx, 32, lane)); mnew = fmaxf(st.m[nt], mx); alpha = fexp2(st.m[nt] - mnew); st.m[nt] = mnew; }
            float ps = 0.f;
#pragma unroll
            for (int mt = 0; mt < 4; ++mt)
#pragma unroll
                for (int j = 0; j < 4; ++j) { float pv = fexp2(s[mt][nt][j] - mnew); if (MODE == 1) pv *= linv[nt]; s[mt][nt][j] = pv; ps += pv; }
            if (MODE != 1) st.l[nt] = st.l[nt] * alpha + ps;
            if (MODE == 2 || MODE == 3) {
#pragma unroll
                for (int md = 0; md < 8; ++md) st.ot[md][nt] = st.ot[md][nt] * alpha;
            }
            if (MODE == 1) {
#pragma unroll
                for (int mt = 0; mt < 4; ++mt) { float a = s[mt][nt][0] + s[mt][nt][1] + s[mt][nt][2] + s[mt][nt][3], lst = s[mt][nt][3];
                    a += shx(a, 1, lane); a += shx(a, 2, lane); lst += shx(lst, 1, lane); lst += shx(lst, 2, lane);
                    if ((l16 & 3) == 0) { const int jb = tile * 16 + 4 * mt + g4; LAS float* pp = (LAS float*)(lds + A_PSL) + (w * 8 + nt * 4 + (l16 >> 2)) * 256;
                        atomicAdd((float*)(pp + jb), a); if (jb + 1 < 256) atomicAdd((float*)(pp + jb + 1), lst); } }
            }
            if (MODE != 0) {
#pragma unroll
                for (int kk = 0; kk < 2; ++kk) { const u32x4 pk = (u32x4){pk_bf16(s[2 * kk][nt][0], s[2 * kk][nt][1]), pk_bf16(s[2 * kk][nt][2], s[2 * kk][nt][3]), pk_bf16(s[2 * kk + 1][nt][0], s[2 * kk + 1][nt][1]), pk_bf16(s[2 * kk + 1][nt][2], s[2 * kk + 1][nt][3])};
                    pf[nt][kk] = __builtin_bit_cast(bf16x8, pk); }
            }
        } else { pf[nt][0] = (bf16x8){0, 0, 0, 0, 0, 0, 0, 0}; pf[nt][1] = (bf16x8){0, 0, 0, 0, 0, 0, 0, 0}; }
    }
    if (MODE != 0) {
#pragma unroll
        for (int kk = 0; kk < 2; ++kk)
#pragma unroll
            for (int mg = 0; mg < 2; ++mg) {
                bf16x8 vf[4];
#pragma unroll
                for (int q = 0; q < 4; ++q) { const LAS unsigned char* vb = lds + boff + A_VT + (16 * (4 * mg + q) + l16) * 136 + kk * 64 + g4 * 8;
                    const u32x2 v0 = *(const LAS u32x2*)vb, v1 = *(const LAS u32x2*)(vb + 32); vf[q] = __builtin_bit_cast(bf16x8, ((u32x4){v0[0], v0[1], v1[0], v1[1]})); }
                if (a0) {
#pragma unroll
                    for (int q = 0; q < 4; ++q) st.ot[4 * mg + q][0] = __builtin_amdgcn_mfma_f32_16x16x32_bf16(vf[q], pf[0][kk], st.ot[4 * mg + q][0], 0, 0, 0);
                }
                if (a1) {
#pragma unroll
                    for (int q = 0; q < 4; ++q) st.ot[4 * mg + q][1] = __builtin_amdgcn_mfma_f32_16x16x32_bf16(vf[q], pf[1][kk], st.ot[4 * mg + q][1], 0, 0, 0);
                }
            }
    }
}
template <int MODE>
__device__ __forceinline__ void attn_tiles(LAS unsigned char* lds, const bf16_t* kp, size_t kstride, const bf16_t* vp, size_t vstride, int tile_lo, int tile_hi,
                                           const bf16x8 (&qf)[2][4], AttnState& st, const int (&tpos)[2], int qb, int w, int lane, const float (&mfin)[2], const float (&linv)[2]) {
    if (tile_lo >= tile_hi) return;
    int tid = w * 64 + lane; asm volatile("" : "+v"(tid)); const int l16 = lane & 15;
    const int krow = tid >> 3, kc = (tid & 7) * 16, vrow = tid >> 2, vc = (tid & 3) * 16;
    u32x4 kr0, kr1, vr0 = (u32x4){0, 0, 0, 0}, vr1 = (u32x4){0, 0, 0, 0};
#define A_LOAD(T) do { const bf16_t* kg = kp + (size_t)((T) * 64 + krow) * kstride + kc; kr0 = *(const u32x4*)kg; kr1 = *(const u32x4*)(kg + 8); \
        if (MODE != 0) { const bf16_t* vg = vp + (size_t)vrow * vstride + (T) * 64 + vc; vr0 = *(const u32x4*)vg; vr1 = *(const u32x4*)(vg + 8); } } while (0)
#define A_WRITE(BO) do { LAS unsigned char* kd = lds + (BO) + A_KT + krow * 272 + kc * 2; *(LAS u32x4*)kd = kr0; *(LAS u32x4*)(kd + 16) = kr1; \
        if (MODE != 0) { LAS unsigned char* vd = lds + (BO) + A_VT + vrow * 136 + vc * 2; *(LAS u32x2*)vd = (u32x2){vr0[0], vr0[1]}; *(LAS u32x2*)(vd + 8) = (u32x2){vr0[2], vr0[3]}; *(LAS u32x2*)(vd + 16) = (u32x2){vr1[0], vr1[1]}; *(LAS u32x2*)(vd + 24) = (u32x2){vr1[2], vr1[3]}; } } while (0)
    A_LOAD(tile_lo);
    __syncthreads();
    A_WRITE(0);
    if (tile_lo + 1 < tile_hi) A_LOAD(tile_lo + 1);
    __syncthreads();
    unsigned selw0 = 0u, selw1 = 0u;
    for (int tile = tile_lo; tile < tile_hi; ++tile) {
        const int boff = ((tile - tile_lo) & 1) * A_BUFSZ;
        if (MODE == 2 && (tile == tile_lo || (tile & 31) == 0)) { const int tw = tile >> 5;
            selw0 = *(const LAS unsigned*)(lds + A_SEL + ((w * 8 + (l16 >> 2)) * 8 + tw) * 4); selw1 = *(const LAS unsigned*)(lds + A_SEL + ((w * 8 + 4 + (l16 >> 2)) * 8 + tw) * 4); }
        if (tile + 1 < tile_hi) { A_WRITE(boff ^ A_BUFSZ); if (tile + 2 < tile_hi) A_LOAD(tile + 2); }
        bool rs0 = true, rs1 = true, active = true;
        if (MODE == 2) { const unsigned bit = 1u << (tile & 31);
            rs0 = (selw0 & bit) != 0u; rs1 = (selw1 & bit) != 0u; active = __ballot(rs0 || rs1) != 0ull; }
        if (active) {
            bool masked;
            if (MODE == 0 || MODE == 1) masked = (tile * 64 + 63 > 4 * qb - 2);
            else if (MODE == 2) masked = (tile == qb);
            else masked = (tile == qb) || (tile <= qb - 8);
            const bool a0 = (MODE != 2) || (__ballot(rs0) != 0ull), a1 = (MODE != 2) || (__ballot(rs1) != 0ull);
            attn_compute<MODE>(lds, boff, tile, qf, st, tpos, qb, w, lane, mfin, linv, rs0, rs1, masked, a0, a1);
        }
        __syncthreads();
    }
#undef A_LOAD
#undef A_WRITE
}
__device__ __forceinline__ void attn_tiles_slc2(LAS unsigned char* lds, const bf16_t* kp, size_t kstride, const bf16_t* vp, size_t vstride, int n,
                                                const bf16x8 (&qf)[2][4], AttnState& st, const int (&tpos)[2], int qb, int w, int lane, const float (&mfin)[2], const float (&linv)[2]) {
    int tid = w * 64 + lane; asm volatile("" : "+v"(tid)); const int l16 = lane & 15;
    const int krow = tid >> 3, kc = (tid & 7) * 16, vrow = tid >> 2, vc = (tid & 3) * 16;
    const int nst = (n + 1) >> 1; constexpr int STG = 2 * A_BUFSZ;
    u32x4 kX0, kX1, vX0, vX1, kY0 = (u32x4){0, 0, 0, 0}, kY1 = (u32x4){0, 0, 0, 0}, vY0 = (u32x4){0, 0, 0, 0}, vY1 = (u32x4){0, 0, 0, 0};
#define S_LOAD1(T, S) do { const bf16_t* kg = kp + (size_t)((T) * 64 + krow) * kstride + kc; k##S##0 = *(const u32x4*)kg; k##S##1 = *(const u32x4*)(kg + 8); \
        const bf16_t* vg = vp + (size_t)vrow * vstride + (T) * 64 + vc; v##S##0 = *(const u32x4*)vg; v##S##1 = *(const u32x4*)(vg + 8); } while (0)
#define S_WRITE1(BO, S) do { LAS unsigned char* kd = lds + (BO) + A_KT + krow * 272 + kc * 2; *(LAS u32x4*)kd = k##S##0; *(LAS u32x4*)(kd + 16) = k##S##1; \
        LAS unsigned char* vd = lds + (BO) + A_VT + vrow * 136 + vc * 2; *(LAS u32x2*)vd = (u32x2){v##S##0[0], v##S##0[1]}; *(LAS u32x2*)(vd + 8) = (u32x2){v##S##0[2], v##S##0[3]}; *(LAS u32x2*)(vd + 16) = (u32x2){v##S##1[0], v##S##1[1]}; *(LAS u32x2*)(vd + 24) = (u32x2){v##S##1[2], v##S##1[3]}; } while (0)
#define S_LOADS(SG) do { S_LOAD1(2 * (SG), X); if (2 * (SG) + 1 < n) S_LOAD1(2 * (SG) + 1, Y); } while (0)
#define S_WRITES(SG, BASE) do { S_WRITE1((BASE), X); if (2 * (SG) + 1 < n) S_WRITE1((BASE) + A_BUFSZ, Y); } while (0)
    S_LOADS(0);
    __syncthreads();
    S_WRITES(0, 0);
    if (nst > 1) S_LOADS(1);
    __syncthreads();
    unsigned selw0 = 0u, selw1 = 0u;
    for (int s = 0; s < nst; ++s) {
        const int base = (s & 1) * STG;
        if ((s & 15) == 0) { const int tw = s >> 4;
            selw0 = *(const LAS unsigned*)(lds + A_SEL + ((w * 8 + (l16 >> 2)) * 8 + tw) * 4); selw1 = *(const LAS unsigned*)(lds + A_SEL + ((w * 8 + 4 + (l16 >> 2)) * 8 + tw) * 4); }
        if (s + 1 < nst) { S_WRITES(s + 1, base ^ STG); if (s + 2 < nst) S_LOADS(s + 2); }
#pragma unroll
        for (int hf = 0; hf < 2; ++hf) {
            const int tile = 2 * s + hf;
            if (tile < n) {
                const unsigned bit = 1u << (tile & 31);
                const bool rs0 = (selw0 & bit) != 0u, rs1 = (selw1 & bit) != 0u;
                const bool a0 = __ballot(rs0) != 0ull, a1 = __ballot(rs1) != 0ull;
                if (a0 || a1) attn_compute<2>(lds, base + hf * A_BUFSZ, tile, qf, st, tpos, qb, w, lane, mfin, linv, rs0, rs1, tile == qb, a0, a1);
            }
        }
        asm volatile("s_waitcnt lgkmcnt(0)" ::: "memory"); __builtin_amdgcn_s_barrier(); asm volatile("" ::: "memory");
    }
    __syncthreads();
#undef S_LOAD1
#undef S_WRITE1
#undef S_LOADS
#undef S_WRITES
}
template <int BR>
__device__ __forceinline__ void attn_finish(AttnState& st, const float* gates, float* oacc, bf16_t* att, const int (&tpos)[2], int hkv, int lane) {
    const int l16 = lane & 15, g4 = lane >> 4, g = l16 & 3;
#pragma unroll
    for (int nt = 0; nt < 2; ++nt) {
        const int t = tpos[nt]; float sc = gates[(size_t)t * 48 + (hkv * 4 + g) * 3 + BR];
        if (BR != 0) { float l = st.l[nt]; l += shx(l, 16, lane); l += shx(l, 32, lane); sc = (l > 0.f) ? sc / l : 0.f; }
        const size_t base = (size_t)t * 2048 + (hkv * 4 + g) * 128 + 4 * g4;
#pragma unroll
        for (int md = 0; md < 8; ++md) { f32x4 v = st.ot[md][nt] * sc; float* op = oacc + base + 16 * md;
            if (BR == 0) *(f32x4*)op = v;
            else if (BR == 1) *(f32x4*)op = *(const f32x4*)op + v;
            else { v = v + *(const f32x4*)op; *(u32x2*)(att + base + 16 * md) = (u32x2){pk_bf16(v[0], v[1]), pk_bf16(v[2], v[3])}; } }
    }
}
__device__ __forceinline__ void attn_reset(AttnState& st) {
#pragma unroll
    for (int md = 0; md < 8; ++md) { st.ot[md][0] = (f32x4){0.f, 0.f, 0.f, 0.f}; st.ot[md][1] = (f32x4){0.f, 0.f, 0.f, 0.f}; }
    st.m[0] = st.m[1] = -1e30f; st.l[0] = st.l[1] = 0.f;
}
__device__ __forceinline__ void attn_item(unsigned char* ws, LAS unsigned char* lds, int hkv, int qb) {
    int tid = ltid(); asm volatile("" : "+v"(tid)); const int w = tid >> 6, lane = tid & 63, l16 = lane & 15, g4 = lane >> 4;
    const bf16_t* QB = (const bf16_t*)(ws + OFF_QB); const bf16_t* KVTOK = (const bf16_t*)(ws + OFF_KVTOK); const bf16_t* KVT = (const bf16_t*)(ws + OFF_KVT);
    const bf16_t* KC = (const bf16_t*)(ws + OFF_KCMP); const bf16_t* VC = (const bf16_t*)(ws + OFF_VCMPT);
    const float* gates = (const float*)(ws + OFF_GATES); float* oacc = (float*)(ws + OFF_OACC); bf16_t* att = (bf16_t*)(ws + OFF_ATT);
    int tpos[2]; bf16x8 qf[2][4];
#pragma unroll
    for (int nt = 0; nt < 2; ++nt) { tpos[nt] = qb * 64 + w * 8 + nt * 4 + (l16 >> 2); const bf16_t* qp = QB + (size_t)tpos[nt] * 2048 + (hkv * 4 + (l16 & 3)) * 128 + g4 * 8;
#pragma unroll
        for (int ks = 0; ks < 4; ++ks) qf[nt][ks] = *(const bf16x8*)(qp + ks * 32); }
    __syncthreads();
    { LAS float* pp = (LAS float*)(lds + A_PSL) + w * 2048;
#pragma unroll
      for (int i = 0; i < 32; ++i) pp[lane + 64 * i] = 0.f; }
    AttnState st; float mfin[2] = {0.f, 0.f}, linv[2] = {0.f, 0.f};
    const int ncmp_tiles = (4 * qb + 3 + 63) >> 6;
    attn_reset(st);
    attn_tiles<0>(lds, KC + (size_t)hkv * 1024 * 128, 128, VC, 1024, 0, ncmp_tiles, qf, st, tpos, qb, w, lane, mfin, linv);
#pragma unroll
    for (int nt = 0; nt < 2; ++nt) { float l = st.l[nt]; l += shx(l, 16, lane); l += shx(l, 32, lane); mfin[nt] = st.m[nt]; linv[nt] = (l > 0.f) ? 1.0f / l : 0.f; }
    attn_reset(st);
    attn_tiles<1>(lds, KC + (size_t)hkv * 1024 * 128, 128, VC + (size_t)hkv * 128 * 1024, 1024, 0, ncmp_tiles, qf, st, tpos, qb, w, lane, mfin, linv);
    attn_finish<0>(st, gates, oacc, att, tpos, hkv, lane);
    __syncthreads();
    {
        LAS unsigned* sel = (LAS unsigned*)(lds + A_SEL) + w * 64;
        if (qb < 16) {
            if (lane < 8) { for (int tk = 0; tk < 8; ++tk) { const int lo = lane * 32; unsigned wd = 0; if (qb >= lo + 31) wd = 0xffffffffu; else if (qb >= lo) wd = (2u << (qb - lo)) - 1u; sel[tk * 8 + lane] = wd; } }
        } else {
            for (int tk = 0; tk < 8; ++tk) {
                const LAS float* pp = (const LAS float*)(lds + A_PSL) + (w * 8 + tk) * 256;
                unsigned key[4]; bool forced[4];
#pragma unroll
                for (int i = 0; i < 4; ++i) { const int j = lane + 64 * i; const float sc = pp[j]; const bool elig = (j >= 1) && (j <= qb - 2);
                    forced[i] = (j == 0) || (j == qb) || (j == qb - 1); key[i] = elig ? (__float_as_uint(sc) + 1u) : 0u; }
                unsigned prefix = 0u;
                for (int bit = 30; bit >= 0; --bit) { const unsigned cand = prefix | (1u << bit); int cnt = 0;
#pragma unroll
                    for (int i = 0; i < 4; ++i) cnt += __popcll(__ballot(key[i] >= cand));
                    if (cnt >= 13) prefix = cand; }
                int cgt = 0;
#pragma unroll
                for (int i = 0; i < 4; ++i) cgt += __popcll(__ballot(key[i] > prefix));
                const int need = 13 - cgt; int base = 0;
#pragma unroll
                for (int i = 0; i < 4; ++i) { const unsigned long long eqm = __ballot(key[i] == prefix);
                    const int rank = base + (int)__builtin_amdgcn_mbcnt_hi((unsigned)(eqm >> 32), __builtin_amdgcn_mbcnt_lo((unsigned)eqm, 0u));
                    const bool taken = forced[i] || (key[i] > prefix) || (key[i] == prefix && rank < need);
                    const unsigned long long bal = __ballot(taken); if (lane == 0) { sel[tk * 8 + 2 * i] = (unsigned)bal; sel[tk * 8 + 2 * i + 1] = (unsigned)(bal >> 32); }
                    base += __popcll(eqm); }
            }
        }
    }
    __syncthreads();
    attn_reset(st);
    attn_tiles_slc2(lds, KVTOK + 2 * 512 + hkv * 128, 2048, KVT + (size_t)(hkv * 128) * S_, S_, qb + 1, qf, st, tpos, qb, w, lane, mfin, linv);
    attn_finish<1>(st, gates, oacc, att, tpos, hkv, lane);
    attn_reset(st);
    attn_tiles<3>(lds, KVTOK + 3 * 512 + hkv * 128, 2048, KVT + (size_t)(512 + hkv * 128) * S_, S_, (qb - 8) > 0 ? (qb - 8) : 0, qb + 1, qf, st, tpos, qb, w, lane, mfin, linv);
    attn_finish<2>(st, gates, oacc, att, tpos, hkv, lane);
}
__device__ __forceinline__ void attn_phase(unsigned char* ws, LAS unsigned char* lds, int b) {
    unsigned* ctr = (unsigned*)(ws + OFF_BAR) + XCD_CTR_WORD + 64 * b;
    volatile LAS int* slot = (volatile LAS int*)(lds + LDS_ST + 8);
#pragma nounroll
    for (;;) {
        __syncthreads();
        if (threadIdx.x == 0) *slot = (int)__hip_atomic_fetch_add(ctr, 1u, __ATOMIC_RELAXED, __HIP_MEMORY_SCOPE_AGENT);
        __syncthreads();
        const int it = *slot;
        if (it >= 1024) break;
        attn_item(ws, lds, it & 3, 255 - (it >> 2));
    }
}

#define XB_TMO      128
#define XB_XCNT(j)  (256  + 64 * (j))
#define XB_XSUB(j)  (1280 + 64 * (j))
#define XB_XGEN(j)  (2304 + 64 * (j))
#define XB_TOP      3328
#define XB_TOPGEN   3392
#define XCD_BAR_WORDS 3456
#define XB_SPIN_CAP (1u << 22)
__device__ __forceinline__ unsigned xb_ld(unsigned* p)              { return __hip_atomic_load(p, __ATOMIC_RELAXED, __HIP_MEMORY_SCOPE_AGENT); }
__device__ __forceinline__ unsigned xb_add(unsigned* p, unsigned v) { return __hip_atomic_fetch_add(p, v, __ATOMIC_RELAXED, __HIP_MEMORY_SCOPE_AGENT); }
__device__ __forceinline__ unsigned xb_xcc_id() { return (unsigned)__builtin_amdgcn_s_getreg((3 << 11) | 20) & 0xFu; }
#define XB_SPIN(cond, bar) do { unsigned _sp = 0; while (cond) { __builtin_amdgcn_s_sleep(1); \
    if ((++_sp & 255u) == 0u) { if (xb_ld(&(bar)[XB_TMO])) break; if (_sp > XB_SPIN_CAP) { atomicAdd(&(bar)[XB_TMO], 1u); break; } } } } while (0)
struct XcdBarrier { unsigned* bar; unsigned x; volatile LAS unsigned* st; };
__device__ __forceinline__ XcdBarrier xcd_barrier_post(unsigned* bar, volatile LAS unsigned* st) {
    XcdBarrier b; b.bar = bar; b.x = xb_xcc_id(); b.st = st;
    if (threadIdx.x == 0) (void)xb_add(&bar[XB_XCNT(b.x)], 1u);
    return b;
}
__device__ __forceinline__ void xcd_barrier_complete(unsigned* bar, unsigned x, unsigned& nloc, unsigned& nx) {
    const unsigned G = gridDim.x * gridDim.y * gridDim.z;
    unsigned sum, cnt, mine, sp = 0u;
    for (;;) {
        sum = 0u; cnt = 0u; mine = 0u;
#pragma unroll
        for (unsigned j = 0; j < 16; ++j) { const unsigned c = xb_ld(&bar[XB_XCNT(j)]); sum += c; cnt += (c > 0u) ? 1u : 0u; mine = (j == x) ? c : mine; }
        if (sum == G) break;
        __builtin_amdgcn_s_sleep(1);
        if ((++sp & 255u) == 0u) { if (xb_ld(&bar[XB_TMO])) break; if (sp > XB_SPIN_CAP) { atomicAdd(&bar[XB_TMO], 1u); break; } }
    }
    nloc = mine > 0u ? mine : 1u; nx = cnt > 0u ? cnt : 1u;
}
__device__ __forceinline__ void xcd_barrier(const XcdBarrier& b) {
    asm volatile("s_waitcnt vmcnt(0)" ::: "memory");
    __syncthreads();
    if (threadIdx.x == 0) {
        unsigned* bar = b.bar;
        __builtin_amdgcn_s_waitcnt(0);
        unsigned nloc = b.st[0], nx = b.st[1];
        if (nloc == 0u) { xcd_barrier_complete(bar, b.x, nloc, nx); b.st[0] = nloc; b.st[1] = nx; }
        const unsigned old = xb_add(&bar[XB_XSUB(b.x)], 1u);
        const unsigned gen = old / nloc;
        if (old + 1u == (gen + 1u) * nloc) {
            __builtin_amdgcn_fence(__ATOMIC_RELEASE, "agent");
            asm volatile("s_waitcnt vmcnt(0)" ::: "memory");
            const unsigned og = xb_add(&bar[XB_TOP], 1u);
            const unsigned tg = og / nx;
            if (og + 1u == (tg + 1u) * nx) xb_add(&bar[XB_TOPGEN], 1u);
            else XB_SPIN(xb_ld(&bar[XB_TOPGEN]) == tg, bar);
            __builtin_amdgcn_fence(__ATOMIC_ACQUIRE, "agent");
            xb_add(&bar[XB_XGEN(b.x)], 1u);
            asm volatile("s_waitcnt vmcnt(0)" ::: "memory");
        } else {
            XB_SPIN(xb_ld(&bar[XB_XGEN(b.x)]) == gen, bar);
            __builtin_amdgcn_fence(__ATOMIC_ACQUIRE, "agent");
            asm volatile("s_waitcnt vmcnt(0)" ::: "memory");
        }
    }
    __syncthreads();
}

constexpr int NPH = 23;
__device__ __forceinline__ void run_phase(CP p, int ph, int b, LAS unsigned char* lds) {
    asm volatile("" : "+s"(p));
    unsigned char* ws = p->ws;
    const float* xb = p->x + (size_t)b * S_ * D_; float* hb = p->out + (size_t)b * S_ * D_;
    bf16_t* XN = (bf16_t*)(ws + OFF_XN);
    const int layer = (ph >= 13) ? 1 : 0;
    switch (ph) {
    case 0: prep_phase(p, lds); break;
    case 1: rmsnorm_phase(xb, p->norm_mix, XN, nullptr, nullptr); break;
    case 2: {
        Prob2D<EpiQK> g1{(const char*)XN, (const char*)(ws + OFF_W_RIN), 4096u, 4096u, 32, 64, 16, EpiQK{(bf16_t*)(ws + OFF_Q), (bf16_t*)(ws + OFF_K), (bf16_t*)(ws + OFF_KTD), (const float2*)(ws + OFF_ROPE)}};
        gemm_phase(lds, g1);
        Prob2D<EpiStore> g2{(const char*)(ws + OFF_W_RIN) + (size_t)4096 * 4096, (const char*)XN, 4096u, 4096u, 32, 16, 64, EpiStore{(bf16_t*)(ws + OFF_VT), (size_t)S_}};
        gemm_phase(lds, g2);
    } break;
    case 3: {
        ProbKV g3{(const char*)(ws + OFF_VT), (const char*)(ws + OFF_KTD), (bf16_t*)(ws + OFF_ST), 4};
        gemm_phase(lds, g3);
        ProbS g4{(const char*)(ws + OFF_Q), (const char*)(ws + OFF_K), (bf16_t*)(ws + OFF_SD), 4};
        gemm_phase(lds, g4);
    } break;
    case 4: scan_phase((bf16_t*)(ws + OFF_ST)); break;
    case 5: {
        ProbOut g5{(const char*)(ws + OFF_Q), (const char*)(ws + OFF_ST), (long)OFF_SD - (long)OFF_Q, (long)OFF_VT - (long)OFF_ST, (bf16_t*)(ws + OFF_Y), 8};
        gemm_phase(lds, g5);
    } break;
    case 6: gn_phase((const bf16_t*)(ws + OFF_Y), (float2*)(ws + OFF_GNS)); break;
    case 7: {
        Prob2D<EpiGate> g6{(const char*)XN, (const char*)(ws + OFF_W_RIN) + (size_t)8192 * 4096, 4096u, 4096u, 32, 64, 16, EpiGate{(bf16_t*)(ws + OFF_Y), (const float2*)(ws + OFF_GNS), p->ret_gn}};
        gemm_phase(lds, g6);
    } break;
    case 8: {
        Prob2D<EpiRes> g7{(const char*)(ws + OFF_Y), (const char*)(ws + OFF_W_ROUT), 8192u, 8192u, 64, 64, 8, EpiRes{xb, hb, XN, (float*)(ws + OFF_SS) + (size_t)(b * 4 + 0) * S_}};
        gemm_phase(lds, g7);
    } break;
    case 10: case 20: {
        Prob2D<EpiStoreRS> g8{(const char*)XN, (const char*)(ws + OFF_W_FIN + (size_t)layer * 32 * MiB), 4096u, 4096u, 32, 64, 32, EpiStoreRS{(bf16_t*)(ws + OFF_U), (size_t)8192, (const float*)(ws + OFF_SS) + (size_t)(b * 4 + (layer ? 2 : 0)) * S_}};
        gemm_phase(lds, g8);
    } break;
    case 11: case 21: conv_phase((const bf16_t*)(ws + OFF_U), (bf16_t*)(ws + OFF_AB), p->ffn_conv_w + (size_t)layer * 3 * 8192, p->ffn_conv_b + (size_t)layer * 8192); break;
    case 12: case 22: {
        Prob2D<EpiRes> g9{(const char*)(ws + OFF_AB), (const char*)(ws + OFF_W_FOUT + (size_t)layer * 16 * MiB), 8192u, 8192u, 64, 64, 8, EpiRes{hb, hb, layer ? (bf16_t*)nullptr : XN, layer ? (float*)nullptr : (float*)(ws + OFF_SS) + (size_t)(b * 4 + 1) * S_}};
        gemm_phase(lds, g9);
    } break;
    case 14: {
        const float* ss1 = (const float*)(ws + OFF_SS) + (size_t)(b * 4 + 1) * S_;
        Prob2D<EpiStoreRS> g10{(const char*)XN, (const char*)(ws + OFF_W_KV), 4096u, 4096u, 32, 64, 8, EpiStoreRS{(bf16_t*)(ws + OFF_KVTOK), (size_t)2048, ss1}};
        gemm_phase(lds, g10);
        Prob2D<EpiStoreCS> g11{(const char*)(ws + OFF_W_KV) + (size_t)2048 * 4096, (const char*)XN, 4096u, 4096u, 32, 4, 64, EpiStoreCS{(bf16_t*)(ws + OFF_KVT), (size_t)S_, ss1}};
        gemm_phase(lds, g11);
    } break;
    case 15: {
        ProbCmp1 a{(const char*)(ws + OFF_KVTOK), (const char*)(ws + OFF_W_C1K), 8192u, 64, 16, EpiGelu{(bf16_t*)(ws + OFF_H1), (const float*)(ws + OFF_PEB)}};
        gemm_phase(lds, a, (int)gridDim.x - 32);
        ProbCmp1 v{(const char*)(ws + OFF_KVTOK) + 1024, (const char*)(ws + OFF_W_C1V), 8192u, 64, 16, EpiGelu{(bf16_t*)(ws + OFF_H1) + 4096 * 256, (const float*)(ws + OFF_PEB) + 256}};
        gemm_phase(lds, v, (int)gridDim.x - 16);
        Prob2D<EpiQproj> g12{(const char*)XN, (const char*)(ws + OFF_W_Q), 4096u, 4096u, 32, 64, 9, EpiQproj{(bf16_t*)(ws + OFF_QB), (float*)(ws + OFF_GATES), (const float*)(ws + OFF_SS) + (size_t)(b * 4 + 1) * S_}};
        gemm_phase(lds, g12);
    } break;
    case 16: {
        Prob2D<EpiKcmp> a{(const char*)(ws + OFF_H1), (const char*)(ws + OFF_W_C2K), 512u, 512u, 4, 16, 1, EpiKcmp{(bf16_t*)(ws + OFF_KCMP)}};
        gemm_phase(lds, a);
        Prob2D<EpiVcmp> v{(const char*)(ws + OFF_W_C2V), (const char*)(ws + OFF_H1) + (size_t)4096 * 256 * 2, 512u, 512u, 4, 1, 16, EpiVcmp{(bf16_t*)(ws + OFF_VCMPT)}};
        gemm_phase(lds, v);
    } break;
    case 17: attn_phase(ws, lds, b); break;
    case 18: {
        Prob2D<EpiRes> g{(const char*)(ws + OFF_ATT), (const char*)(ws + OFF_W_O), 4096u, 4096u, 32, 64, 8, EpiRes{hb, hb, XN, (float*)(ws + OFF_SS) + (size_t)(b * 4 + 2) * S_}};
        gemm_phase(lds, g);
    } break;
    case 23: finalnorm_phase(hb, p->final_gain); break;
    default: break;
    }
}

#if MULTI
__global__ void __launch_bounds__(512) phase_kernel(Params p, int ph, int b) {
    extern __shared__ __attribute__((aligned(16))) unsigned char shm[];
    run_phase((CP)__builtin_amdgcn_kernarg_segment_ptr(), ph, b, (LAS unsigned char*)shm);
}
#else
__global__ void __launch_bounds__(512) mega_kernel(Params p) {
    extern __shared__ __attribute__((aligned(16))) unsigned char shm[];
    cg::grid_group grid = cg::this_grid();
    CP cp = (CP)__builtin_amdgcn_kernarg_segment_ptr();
    volatile LAS unsigned* st = (volatile LAS unsigned*)((LAS unsigned char*)shm + LDS_ST);
    if (threadIdx.x == 0) { st[0] = 0u; st[1] = 0u; st[2] = 0u; st[3] = 0u; }
    __syncthreads();
    XcdBarrier xb = xcd_barrier_post((unsigned*)(cp->ws + OFF_BAR), st);
    run_phase(cp, 0, 0, (LAS unsigned char*)shm);
    grid.sync();
    for (int b = 0; b < 2; ++b)
        for (int ph = 1; ph <= NPH; ++ph) {
            if (ph == 9 || ph == 13 || ph == 19) continue;
#ifdef PROBE_PH
            const int reps = (ph == PROBE_PH || ph == PROBE_PH2) ? 2 : 1;
#else
            const int reps = 1;
#endif
            for (int rep = 0; rep < reps; ++rep) { run_phase(cp, ph, b, (LAS unsigned char*)shm); xcd_barrier(xb); } }
}
#endif

constexpr int LDS_BYTES = LDS_ST + 16;
extern "C" void kernel_launch(void* const* d_in, const int* in_sizes, int n_in, void* d_out, int out_size, void* d_ws, size_t ws_size, hipStream_t stream) {
    static int grid = 0;
    if (grid == 0) {
        if (n_in != 21 || out_size != 2 * S_ * D_ || ws_size < WS_NEED) { fprintf(stderr, "kernel_launch: unexpected shapes/ws (n_in %d out %d ws %zu need %zu)\n", n_in, out_size, ws_size, (size_t)WS_NEED); grid = -1; return; }
#if MULTI
        if (hipFuncSetAttribute((const void*)phase_kernel, hipFuncAttributeMaxDynamicSharedMemorySize, LDS_BYTES) != hipSuccess) { fprintf(stderr, "hipFuncSetAttribute failed\n"); grid = -1; return; }
#else
        if (hipFuncSetAttribute((const void*)mega_kernel, hipFuncAttributeMaxDynamicSharedMemorySize, LDS_BYTES) != hipSuccess) { fprintf(stderr, "hipFuncSetAttribute failed\n"); grid = -1; return; }
#endif
        int dev = 0, cus = 0; hipGetDevice(&dev); hipDeviceGetAttribute(&cus, hipDeviceAttributeMultiprocessorCount, dev);
        grid = cus > 0 ? cus : 256;
    }
    if (grid < 0) return;
    Params p{};
    const float** pp = (const float**)&p;
    for (int i = 0; i < 21; ++i) pp[i] = (const float*)d_in[i];
    p.out = (float*)d_out; p.ws = (unsigned char*)d_ws;
#if MULTI
    hipLaunchKernelGGL(phase_kernel, dim3(grid), dim3(512), LDS_BYTES, stream, p, 0, 0);
    for (int b = 0; b < 2; ++b)
        for (int ph = 1; ph <= NPH; ++ph) hipLaunchKernelGGL(phase_kernel, dim3(grid), dim3(512), LDS_BYTES, stream, p, ph, b);
#else
    if (hipMemsetAsync((unsigned char*)d_ws + OFF_BAR, 0, (XCD_BAR_WORDS + 128) * 4, stream) != hipSuccess) { fprintf(stderr, "memset failed\n"); return; }
    void* args[] = {&p};
    hipError_t e = hipLaunchCooperativeKernel((const void*)mega_kernel, dim3(grid), dim3(512), args, LDS_BYTES, stream);
    if (e != hipSuccess) fprintf(stderr, "cooperative launch failed: %s (grid %d)\n", hipGetErrorString(e), grid);
#endif
}
```

```cpp
#include <hip/hip_runtime.h>
#include <hip/hip_cooperative_groups.h>
#include <cstdio>
namespace cg = cooperative_groups;

#ifndef MULTI
#define MULTI 0
#endif

#define LAS __attribute__((address_space(3)))
typedef unsigned short bf16_t;
typedef short bf16x8 __attribute__((ext_vector_type(8)));
typedef float f32x4 __attribute__((ext_vector_type(4)));
typedef unsigned u32x2 __attribute__((ext_vector_type(2)));
typedef unsigned u32x4 __attribute__((ext_vector_type(4)));

constexpr int S_ = 16384, D_ = 2048;
constexpr size_t MiB = 1048576;
constexpr size_t OFF_W_RIN = 0, OFF_W_ROUT = 48 * MiB, OFF_W_KV = 64 * MiB, OFF_W_C1K = 76 * MiB, OFF_W_C1V = 78 * MiB,
                 OFF_W_C2K = 80 * MiB, OFF_W_C2V = 80 * MiB + 131072, OFF_W_Q = 81 * MiB, OFF_W_O = 90 * MiB,
                 OFF_W_FIN = 98 * MiB  , OFF_W_FOUT = 162 * MiB  , OFF_ROPE = 194 * MiB, OFF_PEB = 210 * MiB, OFF_BAR = 210 * MiB + 65536, OFF_SS = 210 * MiB + 131072  ,
                 OFF_XN = 211 * MiB, OFF_ACT = 275 * MiB;
constexpr size_t OFF_Q = OFF_ACT, OFF_K = OFF_ACT + 64 * MiB, OFF_KTD = OFF_ACT + 128 * MiB, OFF_VT = OFF_ACT + 192 * MiB,
                 OFF_ST = OFF_ACT + 320 * MiB, OFF_SD = OFF_ACT + 448 * MiB, OFF_Y = OFF_ACT + 512 * MiB, OFF_GNS = OFF_ACT + 640 * MiB  , WS_NEED = OFF_ACT + 641 * MiB;
constexpr size_t OFF_U = OFF_ACT, OFF_AB = OFF_ACT + 256 * MiB;
constexpr size_t OFF_HN = OFF_ACT, OFF_KVTOK = OFF_ACT + 64 * MiB, OFF_KVT = OFF_ACT + 129 * MiB, OFF_QB = OFF_ACT + 161 * MiB,
                 OFF_GATES = OFF_ACT + 225 * MiB, OFF_H1 = OFF_ACT + 229 * MiB, OFF_KCMP = OFF_ACT + 233 * MiB, OFF_VCMPT = OFF_ACT + 234 * MiB,
                 OFF_ATT = OFF_ACT + 235 * MiB, OFF_OACC = OFF_ACT + 299 * MiB;

struct Params {
    const float* x; const float* norm_mix; const float* norm_ffn; const float* ret_w_in; const float* ret_gn; const float* ret_w_out;
    const float* kv_gain; const float* w_kv; const float* pe_k; const float* w1_k; const float* w2_k; const float* pe_v; const float* w1_v;
    const float* w2_v; const float* w_q; const float* w_o; const float* ffn_w_in; const float* ffn_conv_w; const float* ffn_conv_b;
    const float* ffn_w_out; const float* final_gain; float* out; unsigned char* ws;
};

typedef const __attribute__((address_space(4))) Params* CP;
__device__ __forceinline__ int ltid() { int t = threadIdx.x; asm volatile("" : "+v"(t)); return t; }
__device__ __forceinline__ unsigned pk_bf16(float lo, float hi) { unsigned r; asm("v_cvt_pk_bf16_f32 %0, %1, %2" : "=v"(r) : "v"(lo), "v"(hi)); return r; }
__device__ __forceinline__ float bflo(unsigned v) { return __uint_as_float(v << 16); }
__device__ __forceinline__ float bfhi(unsigned v) { return __uint_as_float(v & 0xffff0000u); }
__device__ __forceinline__ float fexp2(float x) { return __builtin_amdgcn_exp2f(x); }
__device__ __forceinline__ float frcp(float x) { return __builtin_amdgcn_rcpf(x); }
__device__ __forceinline__ float log2gamma(int h) { return log2f(1.0f - exp2f(-5.0f - (float)h)); }
__device__ __forceinline__ float sigmoidf_(float x) { return frcp(1.0f + fexp2(-1.4426950408889634f * x)); }

__device__ __forceinline__ float shx(float v, int m, int lane) { return __int_as_float(__builtin_amdgcn_ds_bpermute((lane ^ m) << 2, __float_as_int(v))); }
__device__ __forceinline__ unsigned long long shx64(unsigned long long v, int m, int lane) {
    const unsigned lo = (unsigned)__builtin_amdgcn_ds_bpermute((lane ^ m) << 2, (int)(unsigned)v), hi = (unsigned)__builtin_amdgcn_ds_bpermute((lane ^ m) << 2, (int)(unsigned)(v >> 32));
    return ((unsigned long long)hi << 32) | lo; }
__device__ __forceinline__ float wave_sum(float v, int lane) {
#pragma unroll
    for (int o = 32; o >= 1; o >>= 1) v += shx(v, o, lane);
    return v;
}
constexpr int HTB = 128 * 64 * 2;
__device__ __forceinline__ int lds_byte(int r, int c) { const int st = (r >> 4) * 2 + (c >> 5), rr = r & 15, cc = c & 31, ob = rr * 64 + cc * 2; return st * 1024 + (ob ^ (((ob >> 9) & 1) << 5)); }
__device__ __forceinline__ void stage_rc(int b, int& R, int& C) { const int st = b / 1024, sb = b % 1024, swz = sb ^ (((sb >> 9) & 1) << 5); R = (st >> 1) * 16 + swz / 64; C = (st & 1) * 32 + (swz % 64) / 2; }
__device__ __forceinline__ void tile_order(int L, int nM, int nN, int& pm, int& pn) {
    const int nwg = nM * nN; int wgid = L;
    { const int q = nwg / 8, r = nwg % 8, xcd = wgid % 8, off = wgid / 8; wgid = (xcd < r ? xcd * (q + 1) : r * (q + 1) + (xcd - r) * q) + off; }
    const int nig = 8 * nN, gid = wgid / nig, fm = gid * 8, gsz = (nM - fm) < 8 ? (nM - fm) : 8;
    pm = fm + ((wgid % nig) % gsz); pn = (wgid % nig) / gsz;
}
struct UInfo { const char* a; const char* b; int r0, c0, x0, x1; };
typedef f32x4 AccT[2][2][4][2];

template <class P>
__device__ __forceinline__ void gemm_phase(LAS unsigned char* lds, const P& pb, int cofs = 0) {
    const int tid = ltid(), wid = __builtin_amdgcn_readfirstlane(tid >> 6), lane = tid & 63, wr = wid >> 2, wc = wid & 3, fr = lane & 15, fq = lane >> 4;
    const int nt = pb.nt, G = gridDim.x, c = (int)blockIdx.x - cofs; const long nun = pb.nunits();
    if (c < 0 || c >= nun) return;
    unsigned voffA[2], voffB[2];
#pragma unroll
    for (int i = 0; i < 2; ++i) { int R, C; stage_rc(tid * 16 + i * 8192, R, C); voffA[i] = pb.rowA(R) + (unsigned)C * 2u; const int rho = R & 31; const int Rb = P::PERM ? ((R & ~31) + 8 * ((rho & 15) >> 2) + 4 * (rho >> 4) + (rho & 3)) : R; voffB[i] = (unsigned)Rb * pb.ldb + (unsigned)C * 2u; }
    const size_t hsA = pb.rowA(128), hsB = (size_t)128 * pb.ldb;
    const unsigned ldsw = (unsigned)wid * 1024u;
    const int aoff = lds_byte(wr * 64 + fr, fq * 8), boff = lds_byte(wc * 32 + fr, fq * 8);
#define G_SA(b, h) (((b) * 2 + (h)) * HTB)
#define G_SB(b, h) ((4 + (b) * 2 + (h)) * HTB)
#define G_STAGE(bufoff, gbase, voff) do { _Pragma("unroll") for (int _i = 0; _i < 2; ++_i) \
        __builtin_amdgcn_global_load_lds((const unsigned*)((const char*)(gbase) + (voff)[_i]), (LAS unsigned*)(lds + (bufoff) + ldsw + _i * 8192), 16, 0, 0); } while (0)
#define G_LDA(dst, b, h) do { _Pragma("unroll") for (int m = 0; m < 4; ++m) _Pragma("unroll") for (int k = 0; k < 2; ++k) dst[m][k] = *(const LAS bf16x8*)(lds + G_SA(b, h) + aoff + m * 2048 + k * 1024); } while (0)
#define G_LDB(dst, b, h) do { _Pragma("unroll") for (int n = 0; n < 2; ++n) _Pragma("unroll") for (int k = 0; k < 2; ++k) dst[n][k] = *(const LAS bf16x8*)(lds + G_SB(b, h) + boff + n * 2048 + k * 1024); } while (0)
#define G_MMA(ai, bj, At, Bt) do { __builtin_amdgcn_s_setprio(1); _Pragma("unroll") for (int m = 0; m < 4; ++m) _Pragma("unroll") for (int n = 0; n < 2; ++n) _Pragma("unroll") for (int k = 0; k < 2; ++k) \
        acc[ai][bj][m][n] = __builtin_amdgcn_mfma_f32_16x16x32_bf16(Bt[n][k], At[m][k], acc[ai][bj][m][n], 0, 0, 0); __builtin_amdgcn_s_setprio(0); } while (0)
#define G_WAIT_V(n) asm volatile("s_waitcnt vmcnt(" #n ")" ::: "memory")
#define G_WAIT_L(n) asm volatile("s_waitcnt lgkmcnt(" #n ")" ::: "memory")
#define G_BAR __builtin_amdgcn_s_barrier()
#define G_SCHED __builtin_amdgcn_sched_barrier(0)
    UInfo cur, nxt; int ui = 0;
    pb.unit(c, cur);
    AccT acc;
#pragma unroll
    for (int a = 0; a < 2; ++a)
#pragma unroll
        for (int b = 0; b < 2; ++b)
#pragma unroll
            for (int m = 0; m < 4; ++m)
#pragma unroll
                for (int n = 0; n < 2; ++n) acc[a][b][m][n] = (f32x4){0.f, 0.f, 0.f, 0.f};
    bf16x8 At[4][2], B0[2][2], B1[2][2];
    const char* cA = cur.a; const char* cB = cur.b;
    G_STAGE(G_SB(0, 0), cB + pb.bK(0), voffB); G_STAGE(G_SA(0, 0), cA + pb.aK(0), voffA); G_STAGE(G_SB(0, 1), cB + hsB + pb.bK(0), voffB); G_STAGE(G_SA(0, 1), cA + hsA + pb.aK(0), voffA);
    if (wr == 1) G_BAR;
    G_WAIT_V(4); G_BAR;
    G_STAGE(G_SB(1, 0), cB + pb.bK(1), voffB); G_STAGE(G_SA(1, 0), cA + pb.aK(1), voffA); G_STAGE(G_SB(1, 1), cB + hsB + pb.bK(1), voffB);
    G_WAIT_V(6); G_BAR;
    for (;;) {
        const long Ln = (long)(ui + 1) * G + c; const bool has_next = Ln < nun;
        if (has_next) pb.unit(Ln, nxt);
        const char* nA = has_next ? nxt.a : cA; const char* nB = has_next ? nxt.b : cB;
        for (int t = 0; t < nt; t += 2) {
            const bool last = (t == nt - 2);
            const char* a1 = cA + pb.aK(t + 1);
            const char* a2 = last ? nA + pb.aK(0) : cA + pb.aK(t + 2); const char* b2 = last ? nB + pb.bK(0) : cB + pb.bK(t + 2);
            const char* a3 = last ? nA + pb.aK(1) : cA + pb.aK(t + 3); const char* b3 = last ? nB + pb.bK(1) : cB + pb.bK(t + 3);
            G_LDB(B0, 0, 0); G_SCHED; G_LDA(At, 0, 0); G_STAGE(G_SA(1, 1), a1 + hsA, voffA);
            G_WAIT_L(8); G_BAR; G_WAIT_L(0); G_MMA(0, 0, At, B0); G_BAR; G_SCHED;
            G_LDB(B1, 0, 1); G_STAGE(G_SB(0, 0), b2, voffB);
            G_BAR; G_WAIT_L(0); G_MMA(0, 1, At, B1); G_BAR;
            G_LDA(At, 0, 1); G_STAGE(G_SA(0, 0), a2, voffA);
            G_BAR; G_WAIT_L(0); G_MMA(1, 0, At, B0); G_BAR; G_SCHED;
            G_STAGE(G_SB(0, 1), b2 + hsB, voffB);
            G_WAIT_V(6); G_BAR; G_MMA(1, 1, At, B1); G_BAR;
            G_LDB(B0, 1, 0); G_SCHED; G_LDA(At, 1, 0); G_STAGE(G_SA(0, 1), a2 + hsA, voffA);
            G_WAIT_L(8); G_BAR; G_WAIT_L(0); G_MMA(0, 0, At, B0); G_BAR; G_SCHED;
            G_LDB(B1, 1, 1); G_STAGE(G_SB(1, 0), b3, voffB);
            G_BAR; G_WAIT_L(0); G_MMA(0, 1, At, B1); G_BAR;
            G_LDA(At, 1, 1); G_STAGE(G_SA(1, 0), a3, voffA);
            G_BAR; G_WAIT_L(0); G_MMA(1, 0, At, B0); G_BAR; G_SCHED;
            G_STAGE(G_SB(1, 1), b3 + hsB, voffB);
            G_WAIT_V(6); G_BAR; G_MMA(1, 1, At, B1); G_BAR;
        }
        { const int l2 = ltid() & 63; pb.epi(acc, cur, wr, wc, l2 & 15, l2 >> 4); }
        if (!has_next) break;
#pragma unroll
        for (int a = 0; a < 2; ++a)
#pragma unroll
            for (int b = 0; b < 2; ++b)
#pragma unroll
                for (int m = 0; m < 4; ++m)
#pragma unroll
                    for (int n = 0; n < 2; ++n) acc[a][b][m][n] = (f32x4){0.f, 0.f, 0.f, 0.f};
        cur = nxt; cA = nA; cB = nB; ++ui;
    }
    G_WAIT_V(0);
    if (wr == 0) G_BAR;
    G_BAR;
}

#define EPI_ROWS for (int ai = 0; ai < 2; ++ai) for (int m = 0; m < 4; ++m)
#define EPI_COLS for (int bj = 0; bj < 2; ++bj) for (int n = 0; n < 2; ++n)
#define EPI_ROW (128 * ai + 64 * wr + 16 * m + fr)
#define EPI_COL (128 * bj + 32 * wc + 16 * n + 4 * fq)

template <class Epi> struct Prob2D {
    static constexpr bool PERM = Epi::PERM;
    const char* A; const char* B; unsigned lda, ldb; int nt, nM, nN; Epi e;
    __device__ __forceinline__ long nunits() const { return (long)nM * nN; }
    __device__ __forceinline__ unsigned rowA(int R) const { return (unsigned)R * lda; }
    __device__ __forceinline__ void unit(long L, UInfo& u) const { int pm, pn; tile_order((int)L, nM, nN, pm, pn); u.a = A + (size_t)pm * 256 * lda; u.b = B + (size_t)pn * 256 * ldb; u.r0 = pm * 256; u.c0 = pn * 256; u.x0 = 0; u.x1 = 0; }
    __device__ __forceinline__ size_t aK(int kt) const { return (size_t)kt * 128; }
    __device__ __forceinline__ size_t bK(int kt) const { return (size_t)kt * 128; }
    __device__ __forceinline__ void epi(const AccT& acc, const UInfo& u, int wr, int wc, int fr, int fq) const { e(acc, u, wr, wc, fr, fq); }
};
struct EpiStore { static constexpr bool PERM = true; bf16_t* O; size_t ldc;
    __device__ __forceinline__ void operator()(const AccT& acc, const UInfo& u, int wr, int wc, int fr, int fq) const {
#pragma unroll
        EPI_ROWS { bf16_t* rp = O + (size_t)(u.r0 + EPI_ROW) * ldc + u.c0;
#pragma unroll
            for (int bj = 0; bj < 2; ++bj) { const f32x4 v = acc[ai][bj][m][0], v2 = acc[ai][bj][m][1]; *(u32x4*)(rp + 128 * bj + 32 * wc + 8 * fq) = (u32x4){pk_bf16(v[0], v[1]), pk_bf16(v[2], v[3]), pk_bf16(v2[0], v2[1]), pk_bf16(v2[2], v2[3])}; } }
    } };
struct EpiRes { static constexpr bool PERM = true; const float* R; float* O; bf16_t* HB; float* ss;
    __device__ __forceinline__ void operator()(const AccT& acc, const UInfo& u, int wr, int wc, int fr, int fq) const {
#pragma unroll
        EPI_ROWS { const size_t ro = (size_t)(u.r0 + EPI_ROW) * 2048 + u.c0; float sq = 0.f;
#pragma unroll
            for (int bj = 0; bj < 2; ++bj) { const size_t co = ro + 128 * bj + 32 * wc + 8 * fq;
                const f32x4 o0 = *(const f32x4*)(R + co) + acc[ai][bj][m][0], o1 = *(const f32x4*)(R + co + 4) + acc[ai][bj][m][1];
                *(f32x4*)(O + co) = o0; *(f32x4*)(O + co + 4) = o1;
                if (HB) { *(u32x4*)(HB + co) = (u32x4){pk_bf16(o0[0], o0[1]), pk_bf16(o0[2], o0[3]), pk_bf16(o1[0], o1[1]), pk_bf16(o1[2], o1[3])};
                    sq += o0[0] * o0[0] + o0[1] * o0[1] + o0[2] * o0[2] + o0[3] * o0[3] + o1[0] * o1[0] + o1[1] * o1[1] + o1[2] * o1[2] + o1[3] * o1[3]; } }
            if (HB) { const int lane = fq * 16 + fr; sq += shx(sq, 16, lane); sq += shx(sq, 32, lane); if (fq == 0) atomicAdd(ss + u.r0 + EPI_ROW, sq); } }
    } };
struct EpiStoreRS { static constexpr bool PERM = true; bf16_t* O; size_t ldc; const float* ss;
    __device__ __forceinline__ void operator()(const AccT& acc, const UInfo& u, int wr, int wc, int fr, int fq) const {
#pragma unroll
        EPI_ROWS { const int row = u.r0 + EPI_ROW; const float rs = rsqrtf(ss[row] * (1.0f / 2048.0f) + 1e-6f); bf16_t* rp = O + (size_t)row * ldc + u.c0;
#pragma unroll
            for (int bj = 0; bj < 2; ++bj) { const f32x4 v = acc[ai][bj][m][0] * rs, v2 = acc[ai][bj][m][1] * rs; *(u32x4*)(rp + 128 * bj + 32 * wc + 8 * fq) = (u32x4){pk_bf16(v[0], v[1]), pk_bf16(v[2], v[3]), pk_bf16(v2[0], v2[1]), pk_bf16(v2[2], v2[3])}; } }
    } };
struct EpiStoreCS { static constexpr bool PERM = true; bf16_t* O; size_t ldc; const float* ss;
    __device__ __forceinline__ void operator()(const AccT& acc, const UInfo& u, int wr, int wc, int fr, int fq) const {
        f32x4 rs[2][2];
#pragma unroll
        for (int bj = 0; bj < 2; ++bj)
#pragma unroll
            for (int n = 0; n < 2; ++n) { const f32x4 s4 = *(const f32x4*)(ss + u.c0 + 128 * bj + 32 * wc + 8 * fq + 4 * n);
#pragma unroll
                for (int j = 0; j < 4; ++j) rs[bj][n][j] = rsqrtf(s4[j] * (1.0f / 2048.0f) + 1e-6f); }
#pragma unroll
        EPI_ROWS { bf16_t* rp = O + (size_t)(u.r0 + EPI_ROW) * ldc + u.c0;
#pragma unroll
            for (int bj = 0; bj < 2; ++bj) { const f32x4 v = acc[ai][bj][m][0] * rs[bj][0], v2 = acc[ai][bj][m][1] * rs[bj][1]; *(u32x4*)(rp + 128 * bj + 32 * wc + 8 * fq) = (u32x4){pk_bf16(v[0], v[1]), pk_bf16(v[2], v[3]), pk_bf16(v2[0], v2[1]), pk_bf16(v2[2], v2[3])}; } }
    } };
struct EpiGate { static constexpr bool PERM = true; bf16_t* Y; const float2* gns; const float* gain;
    __device__ __forceinline__ void operator()(const AccT& acc, const UInfo& u, int wr, int wc, int fr, int fq) const {
        const int hh = u.c0 >> 9;
#pragma unroll
        EPI_ROWS { const int row = u.r0 + EPI_ROW; bf16_t* rp = Y + (size_t)row * 4096 + u.c0;
            const float2 sg = gns[(size_t)row * 8 + hh]; const float mu = sg.x, rs = sg.y;
#pragma unroll
            for (int bj = 0; bj < 2; ++bj) { const f32x4 g = acc[ai][bj][m][0], h = acc[ai][bj][m][1]; bf16_t* cp = rp + 128 * bj + 32 * wc + 8 * fq; const u32x4 y = *(const u32x4*)cp;
                const float* gp = gain + u.c0 + 128 * bj + 32 * wc + 8 * fq; const f32x4 g0 = *(const f32x4*)gp * rs, g1 = *(const f32x4*)(gp + 4) * rs;
                const float o0 = g[0] * sigmoidf_(g[0]) * (bflo(y[0]) - mu) * g0[0], o1 = g[1] * sigmoidf_(g[1]) * (bfhi(y[0]) - mu) * g0[1], o2 = g[2] * sigmoidf_(g[2]) * (bflo(y[1]) - mu) * g0[2], o3 = g[3] * sigmoidf_(g[3]) * (bfhi(y[1]) - mu) * g0[3];
                const float o4 = h[0] * sigmoidf_(h[0]) * (bflo(y[2]) - mu) * g1[0], o5 = h[1] * sigmoidf_(h[1]) * (bfhi(y[2]) - mu) * g1[1], o6 = h[2] * sigmoidf_(h[2]) * (bflo(y[3]) - mu) * g1[2], o7 = h[3] * sigmoidf_(h[3]) * (bfhi(y[3]) - mu) * g1[3];
                *(u32x4*)cp = (u32x4){pk_bf16(o0, o1), pk_bf16(o2, o3), pk_bf16(o4, o5), pk_bf16(o6, o7)}; } }
    } };
struct EpiQK { static constexpr bool PERM = false; bf16_t* Q; bf16_t* K; bf16_t* KTD; const float2* rope;
    __device__ __forceinline__ void operator()(const AccT& acc, const UInfo& u, int wr, int wc, int fr, int fq) const {
        const int hidx = u.c0 >> 8; const bool isk = hidx >= 8; const int hh = hidx & 7; const float l2g = log2gamma(hh);
        bf16_t* dst = (isk ? K : Q) + hh * 256; const float sc = isk ? 0.0625f : 1.0f;
#pragma unroll
        EPI_ROWS { const int t = u.r0 + EPI_ROW; const float kd = fexp2((float)(255 - (t & 255)) * l2g);
#pragma unroll
            for (int n = 0; n < 2; ++n) { const int dd = 32 * wc + 16 * n + 4 * fq;
                const f32x4 x1 = acc[ai][0][m][n], x2 = acc[ai][1][m][n]; const f32x4 cs0 = *(const f32x4*)(rope + (size_t)t * 128 + dd), cs1 = *(const f32x4*)(rope + (size_t)t * 128 + dd + 2);
                float y1[4], y2[4];
                y1[0] = (x1[0] * cs0[0] - x2[0] * cs0[1]) * sc; y2[0] = (x1[0] * cs0[1] + x2[0] * cs0[0]) * sc;
                y1[1] = (x1[1] * cs0[2] - x2[1] * cs0[3]) * sc; y2[1] = (x1[1] * cs0[3] + x2[1] * cs0[2]) * sc;
                y1[2] = (x1[2] * cs1[0] - x2[2] * cs1[1]) * sc; y2[2] = (x1[2] * cs1[1] + x2[2] * cs1[0]) * sc;
                y1[3] = (x1[3] * cs1[2] - x2[3] * cs1[3]) * sc; y2[3] = (x1[3] * cs1[3] + x2[3] * cs1[2]) * sc;
                *(u32x2*)(dst + (size_t)t * 2048 + dd) = (u32x2){pk_bf16(y1[0], y1[1]), pk_bf16(y1[2], y1[3])};
                *(u32x2*)(dst + (size_t)t * 2048 + 128 + dd) = (u32x2){pk_bf16(y2[0], y2[1]), pk_bf16(y2[2], y2[3])};
                if (isk) {
#pragma unroll
                    for (int j = 0; j < 4; ++j) { KTD[(size_t)(hh * 256 + dd + j) * S_ + t] = (bf16_t)(pk_bf16(y1[j] * kd, 0.f) & 0xffffu); KTD[(size_t)(hh * 256 + 128 + dd + j) * S_ + t] = (bf16_t)(pk_bf16(y2[j] * kd, 0.f) & 0xffffu); }
                } } }
    } };
struct EpiQproj { static constexpr bool PERM = false; bf16_t* QB; float* gates; const float* ss;
    __device__ __forceinline__ void operator()(const AccT& acc, const UInfo& u, int wr, int wc, int fr, int fq) const {
#pragma unroll
        EPI_ROWS { const int t = u.r0 + EPI_ROW; const float rs = rsqrtf(ss[t] * (1.0f / 2048.0f) + 1e-6f);
#pragma unroll
            EPI_COLS { const int col = u.c0 + EPI_COL; const f32x4 v = acc[ai][bj][m][n] * rs;
                if (col < 2048) *(u32x2*)(QB + (size_t)t * 2048 + col) = (u32x2){pk_bf16(v[0] * 0.08838834764831845f, v[1] * 0.08838834764831845f), pk_bf16(v[2] * 0.08838834764831845f, v[3] * 0.08838834764831845f)};
                else if (col < 2096) *(f32x4*)(gates + (size_t)t * 48 + (col - 2048)) = (f32x4){sigmoidf_(v[0]), sigmoidf_(v[1]), sigmoidf_(v[2]), sigmoidf_(v[3])}; } }
    } };
__device__ __forceinline__ float gelu_tanh(float x) { const float y = 0.7978845608028654f * (x + 0.044715f * x * x * x); const float e = fexp2(2.0f * 1.4426950408889634f * y); const float th = 1.0f - 2.0f * frcp(e + 1.0f); return 0.5f * x * (1.0f + th); }
struct EpiGelu { static constexpr bool PERM = false; bf16_t* H; const float* bias;
    __device__ __forceinline__ void operator()(const AccT& acc, const UInfo& u, int wr, int wc, int fr, int fq) const {
#pragma unroll
        EPI_ROWS { bf16_t* rp = H + (size_t)(u.r0 + EPI_ROW) * 256;
#pragma unroll
            EPI_COLS { const int col = EPI_COL; const f32x4 v = acc[ai][bj][m][n]; const f32x4 bb = *(const f32x4*)(bias + col);
                *(u32x2*)(rp + col) = (u32x2){pk_bf16(gelu_tanh(v[0] + bb[0]), gelu_tanh(v[1] + bb[1])), pk_bf16(gelu_tanh(v[2] + bb[2]), gelu_tanh(v[3] + bb[3]))}; } }
    } };
struct EpiKcmp { static constexpr bool PERM = false; bf16_t* KC;
    __device__ __forceinline__ void operator()(const AccT& acc, const UInfo& u, int wr, int wc, int fr, int fq) const {
#pragma unroll
        EPI_ROWS { const int r = u.r0 + EPI_ROW, i = r >> 2, h = r & 3;
#pragma unroll
            for (int n = 0; n < 2; ++n) { const int col = 32 * wc + 16 * n + 4 * fq; f32x4 v = acc[ai][0][m][n]; if (i == 1023) v = (f32x4){0.f, 0.f, 0.f, 0.f};
                *(u32x2*)(KC + ((size_t)h * 1024 + i) * 128 + col) = (u32x2){pk_bf16(v[0], v[1]), pk_bf16(v[2], v[3])}; } }
    } };
struct EpiVcmp { static constexpr bool PERM = false; bf16_t* VC;
    __device__ __forceinline__ void operator()(const AccT& acc, const UInfo& u, int wr, int wc, int fr, int fq) const {
#pragma unroll
        for (int m = 0; m < 4; ++m) { const int d = 64 * wr + 16 * m + fr;
#pragma unroll
            EPI_COLS { const int col = u.c0 + EPI_COL, i = col >> 2; f32x4 v = acc[0][bj][m][n]; if (i == 1023) v = (f32x4){0.f, 0.f, 0.f, 0.f};
#pragma unroll
                for (int h = 0; h < 4; ++h) VC[((size_t)h * 128 + d) * 1024 + i] = (bf16_t)(pk_bf16(v[h], 0.f) & 0xffffu); } }
    } };
struct ProbCmp1 {
    static constexpr bool PERM = false;
    const char* A; const char* B; unsigned ldb; int nt, nM; EpiGelu e;
    __device__ __forceinline__ long nunits() const { return nM; }
    __device__ __forceinline__ unsigned rowA(int R) const { return (unsigned)(R >> 2) * 65536u + (unsigned)(R & 3) * 256u; }
    __device__ __forceinline__ void unit(long L, UInfo& u) const { u.a = A + (size_t)L * 64 * 65536; u.b = B; u.r0 = (int)L * 256; u.c0 = 0; u.x0 = 0; u.x1 = 0; }
    __device__ __forceinline__ size_t aK(int kt) const { return (size_t)(kt >> 1) * 4096 + (size_t)(kt & 1) * 128; }
    __device__ __forceinline__ size_t bK(int kt) const { return (size_t)kt * 128; }
    __device__ __forceinline__ void epi(const AccT& acc, const UInfo& u, int wr, int wc, int fr, int fq) const { e(acc, u, wr, wc, fr, fq); }
};
struct ProbKV {
    static constexpr bool PERM = true;
    const char* VT; const char* KTD; bf16_t* ST; int nt;
    __device__ __forceinline__ long nunits() const { return 8 * 64 * 2; }
    __device__ __forceinline__ unsigned rowA(int R) const { return (unsigned)R * 32768u; }
    static constexpr unsigned ldb = 32768u;
    __device__ __forceinline__ void unit(long L, UInfo& u) const { const int pm = (int)L & 1, c = ((int)L >> 1) & 63, h = (int)L >> 7;
        u.a = VT + ((size_t)(h * 512 + pm * 256) * S_ + c * 256) * 2; u.b = KTD + ((size_t)(h * 256) * S_ + c * 256) * 2; u.r0 = h * 512 + pm * 256; u.c0 = c * 256; u.x0 = 0; u.x1 = 0; }
    __device__ __forceinline__ size_t aK(int kt) const { return (size_t)kt * 128; }
    __device__ __forceinline__ size_t bK(int kt) const { return (size_t)kt * 128; }
    __device__ __forceinline__ void epi(const AccT& acc, const UInfo& u, int wr, int wc, int fr, int fq) const { EpiStore e{ST, (size_t)S_}; e(acc, u, wr, wc, fr, fq); }
};
struct ProbS {
    static constexpr bool PERM = true;
    const char* Q; const char* K; bf16_t* SD; int nt;
    __device__ __forceinline__ long nunits() const { return 8 * 64; }
    __device__ __forceinline__ unsigned rowA(int R) const { return (unsigned)R * 4096u; }
    static constexpr unsigned ldb = 4096u;
    __device__ __forceinline__ void unit(long L, UInfo& u) const { const int c = (int)L & 63, h = (int)L >> 6; const size_t o = ((size_t)(c * 256) * 2048 + h * 256) * 2;
        u.a = Q + o; u.b = K + o; u.r0 = c * 256; u.c0 = h * 256; u.x0 = h; u.x1 = 0; }
    __device__ __forceinline__ size_t aK(int kt) const { return (size_t)kt * 128; }
    __device__ __forceinline__ size_t bK(int kt) const { return (size_t)kt * 128; }
    __device__ __forceinline__ void epi(const AccT& acc, const UInfo& u, int wr, int wc, int fr, int fq) const {
        const float l2g = log2gamma(u.x0);
#pragma unroll
        EPI_ROWS { const int i = EPI_ROW; bf16_t* rp = SD + (size_t)(u.r0 + i) * 2048 + u.c0;
#pragma unroll
            for (int bj = 0; bj < 2; ++bj) { const int s = 128 * bj + 32 * wc + 8 * fq; const f32x4 v = acc[ai][bj][m][0], v2 = acc[ai][bj][m][1]; float o[8];
#pragma unroll
                for (int j = 0; j < 4; ++j) { o[j] = (s + j <= i) ? v[j] * fexp2(-(float)(s + j + 1) * l2g) : 0.f; o[4 + j] = (s + 4 + j <= i) ? v2[j] * fexp2(-(float)(s + 4 + j + 1) * l2g) : 0.f; }
                *(u32x4*)(rp + s) = (u32x4){pk_bf16(o[0], o[1]), pk_bf16(o[2], o[3]), pk_bf16(o[4], o[5]), pk_bf16(o[6], o[7])}; } }
    }
};
struct ProbOut {
    static constexpr bool PERM = true;
    const char* Q; const char* ST; long dA, dB; bf16_t* Y; int nt;
    __device__ __forceinline__ long nunits() const { return 8 * 64 * 2; }
    __device__ __forceinline__ unsigned rowA(int R) const { return (unsigned)R * 4096u; }
    static constexpr unsigned ldb = 32768u;
    __device__ __forceinline__ void unit(long L, UInfo& u) const { const int pn = (int)L & 1, c = ((int)L >> 1) & 63, h = (int)L >> 7;
        u.a = Q + ((size_t)(c * 256) * 2048 + h * 256) * 2; u.b = ST + ((size_t)(h * 512 + pn * 256) * S_ + c * 256) * 2; u.r0 = c * 256; u.c0 = h * 512 + pn * 256; u.x0 = h; u.x1 = 0; }
    __device__ __forceinline__ size_t aK(int kt) const { return kt < 4 ? (size_t)kt * 128 : (size_t)(dA + (long)(kt - 4) * 128); }
    __device__ __forceinline__ size_t bK(int kt) const { return kt < 4 ? (size_t)kt * 128 : (size_t)(dB + (long)(kt - 4) * 128); }
    __device__ __forceinline__ void epi(const AccT& acc, const UInfo& u, int wr, int wc, int fr, int fq) const {
        const float l2g = log2gamma(u.x0);
#pragma unroll
        EPI_ROWS { const int i = EPI_ROW; const float qd = fexp2((float)(i + 1) * l2g); bf16_t* rp = Y + (size_t)(u.r0 + i) * 4096 + u.c0;
#pragma unroll
            for (int bj = 0; bj < 2; ++bj) { const f32x4 v = acc[ai][bj][m][0] * qd, v2 = acc[ai][bj][m][1] * qd; *(u32x4*)(rp + 128 * bj + 32 * wc + 8 * fq) = (u32x4){pk_bf16(v[0], v[1]), pk_bf16(v[2], v[3]), pk_bf16(v2[0], v2[1]), pk_bf16(v2[2], v2[3])}; } }
    }
};

__device__ __forceinline__ void transpose_job(const float* __restrict__ src, bf16_t* __restrict__ dst, int K, int N, int Npad, int kvperm, LAS float* tile, const float* gain = nullptr) {
    const int tk = K / 64, tn = Npad / 256, ntile = tk * tn; const int tid = ltid();
    for (int t = blockIdx.x; t < ntile; t += gridDim.x) {
        const int k0 = (t % tk) * 64, n0 = (t / tk) * 256;
        { const int r0 = tid >> 6, cc = tid & 63; float v[8][4];
#pragma unroll
          for (int i = 0; i < 8; ++i)
#pragma unroll
              for (int q = 0; q < 4; ++q) { const int n = n0 + cc + 64 * q; v[i][q] = (n < N) ? src[(size_t)(k0 + r0 + 8 * i) * N + n] : 0.f; }
#pragma unroll
          for (int i = 0; i < 8; ++i) { const float gk = gain ? gain[k0 + r0 + 8 * i] : 1.0f;
#pragma unroll
              for (int q = 0; q < 4; ++q) tile[(r0 + 8 * i) * 257 + cc + 64 * q] = v[i][q] * gk; } }
        __syncthreads();
        { const int rr = tid >> 1, c0 = (tid & 1) * 32;
          int n = n0 + rr; if (kvperm) { const int j = n >> 9; const int jp = (j == 3) ? 4 : ((j == 4) ? 3 : j); n = jp * 512 + (n & 511); }
          bf16_t* dp = dst + (size_t)n * K + k0 + c0;
#pragma unroll
          for (int g = 0; g < 4; ++g) { float x[8];
#pragma unroll
              for (int j = 0; j < 8; ++j) x[j] = tile[(c0 + 8 * g + j) * 257 + rr];
              *(u32x4*)(dp + 8 * g) = (u32x4){pk_bf16(x[0], x[1]), pk_bf16(x[2], x[3]), pk_bf16(x[4], x[5]), pk_bf16(x[6], x[7])}; } }
        __syncthreads();
    }
}
__device__ __forceinline__ void prep_phase(CP p, LAS unsigned char* lds) {
    LAS float* tile = (LAS float*)lds; unsigned char* ws = p->ws;
    transpose_job(p->ret_w_in, (bf16_t*)(ws + OFF_W_RIN), 2048, 12288, 12288, 0, tile);
    transpose_job(p->ret_w_out, (bf16_t*)(ws + OFF_W_ROUT), 4096, 2048, 2048, 0, tile);
    transpose_job(p->w_kv, (bf16_t*)(ws + OFF_W_KV), 2048, 3072, 3072, 1, tile, p->kv_gain);
    transpose_job(p->w1_k, (bf16_t*)(ws + OFF_W_C1K), 4096, 256, 256, 0, tile);
    transpose_job(p->w1_v, (bf16_t*)(ws + OFF_W_C1V), 4096, 256, 256, 0, tile);
    transpose_job(p->w2_k, (bf16_t*)(ws + OFF_W_C2K), 256, 128, 256, 0, tile);
    transpose_job(p->w2_v, (bf16_t*)(ws + OFF_W_C2V), 256, 128, 256, 0, tile);
    transpose_job(p->w_q, (bf16_t*)(ws + OFF_W_Q), 2048, 2096, 2304, 0, tile, p->norm_mix + 2048);
    transpose_job(p->w_o, (bf16_t*)(ws + OFF_W_O), 2048, 2048, 2048, 0, tile);
    transpose_job(p->ffn_w_in, (bf16_t*)(ws + OFF_W_FIN), 2048, 8192, 8192, 0, tile, p->norm_ffn);
    transpose_job(p->ffn_w_in + (size_t)2048 * 8192, (bf16_t*)(ws + OFF_W_FIN + 32 * MiB), 2048, 8192, 8192, 0, tile, p->norm_ffn + 2048);
    transpose_job(p->ffn_w_out, (bf16_t*)(ws + OFF_W_FOUT), 4096, 2048, 2048, 0, tile);
    transpose_job(p->ffn_w_out + (size_t)4096 * 2048, (bf16_t*)(ws + OFF_W_FOUT + 16 * MiB), 4096, 2048, 2048, 0, tile);
    { float* ss = (float*)(ws + OFF_SS); for (int i = blockIdx.x * 512 + ltid(); i < 8 * S_; i += gridDim.x * 512) ss[i] = 0.f; }
    { float2* rope = (float2*)(ws + OFF_ROPE); const int gsz = gridDim.x * 512;
      for (int i = blockIdx.x * 512 + ltid(); i < S_ * 128; i += gsz) { const int t = i >> 7, dd = i & 127;
          const float freq = exp2f(-(float)dd * (13.287712379549449f / 128.0f)); const double rev = (double)t * (double)freq * 0.15915494309189535;
          const float fx = (float)(rev - rint(rev)); rope[i] = make_float2(__builtin_amdgcn_cosf(fx), __builtin_amdgcn_sinf(fx)); } }
    if (blockIdx.x < 128) { const int kv = blockIdx.x >> 6, oc = blockIdx.x & 63; const float* pe = kv ? p->pe_v : p->pe_k; const float* w1 = kv ? p->w1_v : p->w1_k; float* peb = (float*)(ws + OFF_PEB) + kv * 256;
        const int tid = ltid(), g = tid >> 7, r = tid & 127, n = 4 * oc + g; float s = 0.f;
#pragma unroll 8
        for (int j = 0; j < 32; ++j) { const int k = r + 128 * j; s += pe[k] * w1[(size_t)k * 256 + n]; }
        s = wave_sum(s, tid & 63);
        __syncthreads(); if ((tid & 63) == 0) tile[tid >> 6] = s; __syncthreads();
        if (tid < 4) peb[4 * oc + tid] = tile[2 * tid] + tile[2 * tid + 1];
        __syncthreads(); }
}
__device__ __forceinline__ void rmsnorm_phase(const float* h, const float* g1, bf16_t* o1, const float* g2, bf16_t* o2) {
    const int w = ltid() >> 6, lane = ltid() & 63;
    for (int row = blockIdx.x * 8 + w; row < S_; row += gridDim.x * 8) {
        const f32x4* p = (const f32x4*)(h + (size_t)row * 2048); f32x4 v[8]; float ss = 0.f;
#pragma unroll
        for (int i = 0; i < 8; ++i) { v[i] = p[lane + 64 * i]; ss += v[i][0] * v[i][0] + v[i][1] * v[i][1] + v[i][2] * v[i][2] + v[i][3] * v[i][3]; }
        ss = wave_sum(ss, lane); const float r = rsqrtf(ss * (1.0f / 2048.0f) + 1e-6f);
#pragma unroll
        for (int i = 0; i < 8; ++i) { const int col = (lane + 64 * i) * 4; const f32x4 g = *(const f32x4*)(g1 + col);
            *(u32x2*)(o1 + (size_t)row * 2048 + col) = (u32x2){pk_bf16(v[i][0] * r * g[0], v[i][1] * r * g[1]), pk_bf16(v[i][2] * r * g[2], v[i][3] * r * g[3])};
            if (o2) { const f32x4 gg = *(const f32x4*)(g2 + col);
                *(u32x2*)(o2 + (size_t)row * 2048 + col) = (u32x2){pk_bf16(v[i][0] * r * gg[0], v[i][1] * r * gg[1]), pk_bf16(v[i][2] * r * gg[2], v[i][3] * r * gg[3])}; } }
    }
}
__device__ __forceinline__ void finalnorm_phase(float* h, const float* g1) {
    const int w = ltid() >> 6, lane = ltid() & 63;
    for (int row = blockIdx.x * 8 + w; row < S_; row += gridDim.x * 8) {
        f32x4* p = (f32x4*)(h + (size_t)row * 2048); f32x4 v[8]; float ss = 0.f;
#pragma unroll
        for (int i = 0; i < 8; ++i) { v[i] = p[lane + 64 * i]; ss += v[i][0] * v[i][0] + v[i][1] * v[i][1] + v[i][2] * v[i][2] + v[i][3] * v[i][3]; }
        ss = wave_sum(ss, lane); const float r = rsqrtf(ss * (1.0f / 2048.0f) + 1e-6f);
#pragma unroll
        for (int i = 0; i < 8; ++i) { const f32x4 g = *(const f32x4*)(g1 + (lane + 64 * i) * 4); p[lane + 64 * i] = v[i] * r * g; }
    }
}
__device__ __forceinline__ void scan_phase(bf16_t* ST) {
    for (int it = blockIdx.x * 512 + ltid(); it < 4096 * 32; it += gridDim.x * 512) {
        const int r = it >> 5, d8 = it & 31; const float cd = fexp2(256.0f * log2gamma(r >> 9));
        bf16_t* p = ST + (size_t)r * S_ + d8 * 8; float s[8];
#pragma unroll
        for (int j = 0; j < 8; ++j) s[j] = 0.f;
        for (int c = 0; c < 64; ++c) { const u32x4 v = *(const u32x4*)(p + c * 256);
            *(u32x4*)(p + c * 256) = (u32x4){pk_bf16(s[0], s[1]), pk_bf16(s[2], s[3]), pk_bf16(s[4], s[5]), pk_bf16(s[6], s[7])};
#pragma unroll
            for (int j = 0; j < 4; ++j) { s[2 * j] = s[2 * j] * cd + bflo(v[j]); s[2 * j + 1] = s[2 * j + 1] * cd + bfhi(v[j]); } }
    }
}
__device__ __forceinline__ void gn_phase(const bf16_t* Y, float2* gns) {
    const int w = ltid() >> 6, lane = ltid() & 63;
    for (int g = blockIdx.x * 8 + w; g < S_ * 8; g += gridDim.x * 8) {
        const u32x4 v = *(const u32x4*)(Y + (size_t)g * 512 + lane * 8); float x[8];
#pragma unroll
        for (int j = 0; j < 4; ++j) { x[2 * j] = bflo(v[j]); x[2 * j + 1] = bfhi(v[j]); }
        float s = 0.f;
#pragma unroll
        for (int j = 0; j < 8; ++j) s += x[j];
        const float mu = wave_sum(s, lane) * (1.0f / 512.0f); float q = 0.f;
#pragma unroll
        for (int j = 0; j < 8; ++j) { x[j] -= mu; q += x[j] * x[j]; }
        const float r = rsqrtf(wave_sum(q, lane) * (1.0f / 512.0f) + 1e-6f);
        if (lane == 0) gns[g] = make_float2(mu, r);
    }
}
__device__ __forceinline__ void conv_phase(const bf16_t* U, bf16_t* AB, const float* cw, const float* cb) {
    for (int it = blockIdx.x * 512 + ltid(); it < 512 * 512; it += gridDim.x * 512) {
        const int n8 = (it & 511) * 8, t0 = (it >> 9) * 32;
        float wa[3][8], wb[3][8], ba[8], bb[8];
#pragma unroll
        for (int tp = 0; tp < 3; ++tp)
#pragma unroll
            for (int j = 0; j < 8; ++j) { wa[tp][j] = cw[tp * 8192 + n8 + j]; wb[tp][j] = cw[tp * 8192 + 4096 + n8 + j]; }
#pragma unroll
        for (int j = 0; j < 8; ++j) { ba[j] = cb[n8 + j]; bb[j] = cb[4096 + n8 + j]; }
        float pa[2][8], pb[2][8];
#pragma unroll
        for (int k = 0; k < 2; ++k) { const int t = t0 - 2 + k; u32x4 va = (u32x4){0, 0, 0, 0}, vb = (u32x4){0, 0, 0, 0};
            if (t >= 0) { va = *(const u32x4*)(U + (size_t)t * 8192 + n8); vb = *(const u32x4*)(U + (size_t)t * 8192 + 4096 + n8); }
#pragma unroll
            for (int j = 0; j < 4; ++j) { pa[k][2 * j] = bflo(va[j]); pa[k][2 * j + 1] = bfhi(va[j]); pb[k][2 * j] = bflo(vb[j]); pb[k][2 * j + 1] = bfhi(vb[j]); } }
#pragma unroll 8
        for (int k = 0; k < 32; ++k) { const int t = t0 + k; const u32x4 va = *(const u32x4*)(U + (size_t)t * 8192 + n8), vb = *(const u32x4*)(U + (size_t)t * 8192 + 4096 + n8);
            float xa[8], xb[8], o[8];
#pragma unroll
            for (int j = 0; j < 4; ++j) { xa[2 * j] = bflo(va[j]); xa[2 * j + 1] = bfhi(va[j]); xb[2 * j] = bflo(vb[j]); xb[2 * j + 1] = bfhi(vb[j]); }
#pragma unroll
            for (int j = 0; j < 8; ++j) { const float a = ba[j] + wa[0][j] * pa[0][j] + wa[1][j] * pa[1][j] + wa[2][j] * xa[j]; const float b = bb[j] + wb[0][j] * pb[0][j] + wb[1][j] * pb[1][j] + wb[2][j] * xb[j];
                o[j] = a * sigmoidf_(a) * b; pa[0][j] = pa[1][j]; pa[1][j] = xa[j]; pb[0][j] = pb[1][j]; pb[1][j] = xb[j]; }
            *(u32x4*)(AB + (size_t)t * 4096 + n8) = (u32x4){pk_bf16(o[0], o[1]), pk_bf16(o[2], o[3]), pk_bf16(o[4], o[5]), pk_bf16(o[6], o[7])}; }
    }
}

constexpr int XCD_CTR_WORD = 3456;
constexpr int A_KT = 0, A_VT = 17408, A_BUFSZ = 34816, A_PSL = 69632, A_SEL = 4 * A_BUFSZ, LDS_ST = A_SEL + 2048;
constexpr float LOG2E = 1.4426950408889634f;
struct AttnState { f32x4 ot[8][2]; float m[2], l[2]; };

template <int MODE>
__device__ __forceinline__ void attn_compute(LAS unsigned char* lds, int boff, int tile, const bf16x8 (&qf)[2][4], AttnState& st, const int (&tpos)[2], int qb, int w, int lane,
                                             const float (&mfin)[2], const float (&linv)[2], bool rs0, bool rs1, bool masked, bool a0, bool a1) {
    const int l16 = lane & 15, g4 = lane >> 4;
    f32x4 s[4][2];
#pragma unroll
    for (int mt = 0; mt < 4; ++mt) { s[mt][0] = (f32x4){0.f, 0.f, 0.f, 0.f}; s[mt][1] = (f32x4){0.f, 0.f, 0.f, 0.f}; }
#pragma unroll
    for (int ks = 0; ks < 4; ++ks) {
        bf16x8 kf[4];
#pragma unroll
        for (int mt = 0; mt < 4; ++mt) kf[mt] = *(const LAS bf16x8*)(lds + boff + A_KT + (16 * mt + l16) * 272 + ks * 64 + g4 * 16);
        if (a0) {
#pragma unroll
            for (int mt = 0; mt < 4; ++mt) s[mt][0] = __builtin_amdgcn_mfma_f32_16x16x32_bf16(kf[mt], qf[0][ks], s[mt][0], 0, 0, 0);
        }
        if (a1) {
#pragma unroll
            for (int mt = 0; mt < 4; ++mt) s[mt][1] = __builtin_amdgcn_mfma_f32_16x16x32_bf16(kf[mt], qf[1][ks], s[mt][1], 0, 0, 0);
        }
    }
    if (masked) {
#pragma unroll
        for (int nt = 0; nt < 2; ++nt) { const int t = tpos[nt]; const int tl = w * 8 + nt * 4 + (l16 >> 2);
#pragma unroll
            for (int mt = 0; mt < 4; ++mt)
#pragma unroll
                for (int j = 0; j < 4; ++j) { const int kl = 16 * mt + 4 * g4 + j; const int key = tile * 64 + kl; bool v;
                    if (MODE == 0 || MODE == 1) v = key <= ((t - 31) >> 4);
                    else if (MODE == 2) v = (kl <= tl);
                    else v = (key <= t) && (key > t - 512);
                    s[mt][nt][j] = v ? s[mt][nt][j] : -__builtin_inff(); } }
    }
    bf16x8 pf[2][2];
#pragma unroll
    for (int nt = 0; nt < 2; ++nt) {
        if (nt ? a1 : a0) {
            const bool rowsel = nt ? rs1 : rs0;
            const float bias = (MODE == 2 && !rowsel) ? -__builtin_inff() : 0.f;
            float mx = -1e30f;
#pragma unroll
            for (int mt = 0; mt < 4; ++mt)
#pragma unroll
                for (int j = 0; j < 4; ++j) {
                    const float sv = s[mt][nt][j] * LOG2E + bias;
                    s[mt][nt][j] = sv; mx = fmaxf(mx, sv); }
            float mnew, alpha = 1.f;
            if (MODE == 1) mnew = mfin[nt];
            else { mx = fmaxf(mx, shx(mx, 16, lane)); mx = fmaxf(mx, shx(mx, 32, lane)); mnew = fmaxf(st.m[nt], mx); alpha = fexp2(st.m[nt] - mnew); st.m[nt] = mnew; }
            float ps = 0.f;
#pragma unroll
            for (int mt = 0; mt < 4; ++mt)
#pragma unroll
                for (int j = 0; j < 4; ++j) { float pv = fexp2(s[mt][nt][j] - mnew); if (MODE == 1) pv *= linv[nt]; s[mt][nt][j] = pv; ps += pv; }
            if (MODE != 1) st.l[nt] = st.l[nt] * alpha + ps;
            if (MODE == 2 || MODE == 3) {
#pragma unroll
                for (int md = 0; md < 8; ++md) st.ot[md][nt] = st.ot[md][nt] * alpha;
            }
            if (MODE == 1) {
#pragma unroll
                for (int mt = 0; mt < 4; ++mt) { float a = s[mt][nt][0] + s[mt][nt][1] + s[mt][nt][2] + s[mt][nt][3], lst = s[mt][nt][3];
                    a += shx(a, 1, lane); a += shx(a, 2, lane); lst += shx(lst, 1, lane); lst += shx(lst, 2, lane);
                    if ((l16 & 3) == 0) { const int jb = tile * 16 + 4 * mt + g4; LAS float* pp = (LAS float*)(lds + A_PSL) + (w * 8 + nt * 4 + (l16 >> 2)) * 256;
                        atomicAdd((float*)(pp + jb), a); if (jb + 1 < 256) atomicAdd((float*)(pp + jb + 1), lst); } }
            }
            if (MODE != 0) {
#pragma unroll
                for (int kk = 0; kk < 2; ++kk) { const u32x4 pk = (u32x4){pk_bf16(s[2 * kk][nt][0], s[2 * kk][nt][1]), pk_bf16(s[2 * kk][nt][2], s[2 * kk][nt][3]), pk_bf16(s[2 * kk + 1][nt][0], s[2 * kk + 1][nt][1]), pk_bf16(s[2 * kk + 1][nt][2], s[2 * kk + 1][nt][3])};
                    pf[nt][kk] = __builtin_bit_cast(bf16x8, pk); }
            }
        } else { pf[nt][0] = (bf16x8){0, 0, 0, 0, 0, 0, 0, 0}; pf[nt][1] = (bf16x8){0, 0, 0, 0, 0, 0, 0, 0}; }
    }
    if (MODE != 0) {
#pragma unroll
        for (int kk = 0; kk < 2; ++kk)
#pragma unroll
            for (int mg = 0; mg < 2; ++mg) {
                bf16x8 vf[4];
#pragma unroll
                for (int q = 0; q < 4; ++q) { const LAS unsigned char* vb = lds + boff + A_VT + (16 * (4 * mg + q) + l16) * 136 + kk * 64 + g4 * 8;
                    const u32x2 v0 = *(const LAS u32x2*)vb, v1 = *(const LAS u32x2*)(vb + 32); vf[q] = __builtin_bit_cast(bf16x8, ((u32x4){v0[0], v0[1], v1[0], v1[1]})); }
                if (a0) {
#pragma unroll
                    for (int q = 0; q < 4; ++q) st.ot[4 * mg + q][0] = __builtin_amdgcn_mfma_f32_16x16x32_bf16(vf[q], pf[0][kk], st.ot[4 * mg + q][0], 0, 0, 0);
                }
                if (a1) {
#pragma unroll
                    for (int q = 0; q < 4; ++q) st.ot[4 * mg + q][1] = __builtin_amdgcn_mfma_f32_16x16x32_bf16(vf[q], pf[1][kk], st.ot[4 * mg + q][1], 0, 0, 0);
                }
            }
    }
}
template <int MODE>
__device__ __forceinline__ void attn_tiles(LAS unsigned char* lds, const bf16_t* kp, size_t kstride, const bf16_t* vp, size_t vstride, int tile_lo, int tile_hi,
                                           const bf16x8 (&qf)[2][4], AttnState& st, const int (&tpos)[2], int qb, int w, int lane, const float (&mfin)[2], const float (&linv)[2]) {
    if (tile_lo >= tile_hi) return;
    int tid = w * 64 + lane; asm volatile("" : "+v"(tid)); const int l16 = lane & 15;
    const int krow = tid >> 3, kc = (tid & 7) * 16, vrow = tid >> 2, vc = (tid & 3) * 16;
    u32x4 kr0, kr1, vr0 = (u32x4){0, 0, 0, 0}, vr1 = (u32x4){0, 0, 0, 0};
#define A_LOAD(T) do { const bf16_t* kg = kp + (size_t)((T) * 64 + krow) * kstride + kc; kr0 = *(const u32x4*)kg; kr1 = *(const u32x4*)(kg + 8); \
        if (MODE != 0) { const bf16_t* vg = vp + (size_t)vrow * vstride + (T) * 64 + vc; vr0 = *(const u32x4*)vg; vr1 = *(const u32x4*)(vg + 8); } } while (0)
#define A_WRITE(BO) do { LAS unsigned char* kd = lds + (BO) + A_KT + krow * 272 + kc * 2; *(LAS u32x4*)kd = kr0; *(LAS u32x4*)(kd + 16) = kr1; \
        if (MODE != 0) { LAS unsigned char* vd = lds + (BO) + A_VT + vrow * 136 + vc * 2; *(LAS u32x2*)vd = (u32x2){vr0[0], vr0[1]}; *(LAS u32x2*)(vd + 8) = (u32x2){vr0[2], vr0[3]}; *(LAS u32x2*)(vd + 16) = (u32x2){vr1[0], vr1[1]}; *(LAS u32x2*)(vd + 24) = (u32x2){vr1[2], vr1[3]}; } } while (0)
    A_LOAD(tile_lo);
    __syncthreads();
    A_WRITE(0);
    if (tile_lo + 1 < tile_hi) A_LOAD(tile_lo + 1);
    __syncthreads();
    unsigned selw0 = 0u, selw1 = 0u;
    for (int tile = tile_lo; tile < tile_hi; ++tile) {
        const int boff = ((tile - tile_lo) & 1) * A_BUFSZ;
        if (MODE == 2 && (tile == tile_lo || (tile & 31) == 0)) { const int tw = tile >> 5;
            selw0 = *(const LAS unsigned*)(lds + A_SEL + ((w * 8 + (l16 >> 2)) * 8 + tw) * 4); selw1 = *(const LAS unsigned*)(lds + A_SEL + ((w * 8 + 4 + (l16 >> 2)) * 8 + tw) * 4); }
        if (tile + 1 < tile_hi) { A_WRITE(boff ^ A_BUFSZ); if (tile + 2 < tile_hi) A_LOAD(tile + 2); }
        bool rs0 = true, rs1 = true, active = true;
        if (MODE == 2) { const unsigned bit = 1u << (tile & 31);
            rs0 = (selw0 & bit) != 0u; rs1 = (selw1 & bit) != 0u; active = __ballot(rs0 || rs1) != 0ull; }
        if (active) {
            bool masked;
            if (MODE == 0 || MODE == 1) masked = (tile * 64 + 63 > 4 * qb - 2);
            else if (MODE == 2) masked = (tile == qb);
            else masked = (tile == qb) || (tile <= qb - 8);
            const bool a0 = (MODE != 2) || (__ballot(rs0) != 0ull), a1 = (MODE != 2) || (__ballot(rs1) != 0ull);
            attn_compute<MODE>(lds, boff, tile, qf, st, tpos, qb, w, lane, mfin, linv, rs0, rs1, masked, a0, a1);
        }
        __syncthreads();
    }
#undef A_LOAD
#undef A_WRITE
}
__device__ __forceinline__ void attn_tiles_slc2(LAS unsigned char* lds, const bf16_t* kp, size_t kstride, const bf16_t* vp, size_t vstride, int n,
                                                const bf16x8 (&qf)[2][4], AttnState& st, const int (&tpos)[2], int qb, int w, int lane, const float (&mfin)[2], const float (&linv)[2]) {
    int tid = w * 64 + lane; asm volatile("" : "+v"(tid)); const int l16 = lane & 15;
    const int krow = tid >> 3, kc = (tid & 7) * 16, vrow = tid >> 2, vc = (tid & 3) * 16;
    const int nst = (n + 1) >> 1; constexpr int STG = 2 * A_BUFSZ;
    u32x4 kX0, kX1, vX0, vX1, kY0 = (u32x4){0, 0, 0, 0}, kY1 = (u32x4){0, 0, 0, 0}, vY0 = (u32x4){0, 0, 0, 0}, vY1 = (u32x4){0, 0, 0, 0};
#define S_LOAD1(T, S) do { const bf16_t* kg = kp + (size_t)((T) * 64 + krow) * kstride + kc; k##S##0 = *(const u32x4*)kg; k##S##1 = *(const u32x4*)(kg + 8); \
        const bf16_t* vg = vp + (size_t)vrow * vstride + (T) * 64 + vc; v##S##0 = *(const u32x4*)vg; v##S##1 = *(const u32x4*)(vg + 8); } while (0)
#define S_WRITE1(BO, S) do { LAS unsigned char* kd = lds + (BO) + A_KT + krow * 272 + kc * 2; *(LAS u32x4*)kd = k##S##0; *(LAS u32x4*)(kd + 16) = k##S##1; \
        LAS unsigned char* vd = lds + (BO) + A_VT + vrow * 136 + vc * 2; *(LAS u32x2*)vd = (u32x2){v##S##0[0], v##S##0[1]}; *(LAS u32x2*)(vd + 8) = (u32x2){v##S##0[2], v##S##0[3]}; *(LAS u32x2*)(vd + 16) = (u32x2){v##S##1[0], v##S##1[1]}; *(LAS u32x2*)(vd + 24) = (u32x2){v##S##1[2], v##S##1[3]}; } while (0)
#define S_LOADS(SG) do { S_LOAD1(2 * (SG), X); if (2 * (SG) + 1 < n) S_LOAD1(2 * (SG) + 1, Y); } while (0)
#define S_WRITES(SG, BASE) do { S_WRITE1((BASE), X); if (2 * (SG) + 1 < n) S_WRITE1((BASE) + A_BUFSZ, Y); } while (0)
    S_LOADS(0);
    __syncthreads();
    S_WRITES(0, 0);
    if (nst > 1) S_LOADS(1);
    __syncthreads();
    unsigned selw0 = 0u, selw1 = 0u;
    for (int s = 0; s < nst; ++s) {
        const int base = (s & 1) * STG;
        if ((s & 15) == 0) { const int tw = s >> 4;
            selw0 = *(const LAS unsigned*)(lds + A_SEL + ((w * 8 + (l16 >> 2)) * 8 + tw) * 4); selw1 = *(const LAS unsigned*)(lds + A_SEL + ((w * 8 + 4 + (l16 >> 2)) * 8 + tw) * 4); }
        if (s + 1 < nst) { S_WRITES(s + 1, base ^ STG); if (s + 2 < nst) S_LOADS(s + 2); }
#pragma unroll
        for (int hf = 0; hf < 2; ++hf) {
            const int tile = 2 * s + hf;
            if (tile < n) {
                const unsigned bit = 1u << (tile & 31);
                const bool rs0 = (selw0 & bit) != 0u, rs1 = (selw1 & bit) != 0u;
                const bool a0 = __ballot(rs0) != 0ull, a1 = __ballot(rs1) != 0ull;
                if (a0 || a1) attn_compute<2>(lds, base + hf * A_BUFSZ, tile, qf, st, tpos, qb, w, lane, mfin, linv, rs0, rs1, tile == qb, a0, a1);
            }
        }
        asm volatile("s_waitcnt lgkmcnt(0)" ::: "memory"); __builtin_amdgcn_s_barrier(); asm volatile("" ::: "memory");
    }
    __syncthreads();
#undef S_LOAD1
#undef S_WRITE1
#undef S_LOADS
#undef S_WRITES
}
template <int BR>
__device__ __forceinline__ void attn_finish(AttnState& st, const float* gates, float* oacc, bf16_t* att, const int (&tpos)[2], int hkv, int lane) {
    const int l16 = lane & 15, g4 = lane >> 4, g = l16 & 3;
#pragma unroll
    for (int nt = 0; nt < 2; ++nt) {
        const int t = tpos[nt]; float sc = gates[(size_t)t * 48 + (hkv * 4 + g) * 3 + BR];
        if (BR != 0) { float l = st.l[nt]; l += shx(l, 16, lane); l += shx(l, 32, lane); sc = (l > 0.f) ? sc / l : 0.f; }
        const size_t base = (size_t)t * 2048 + (hkv * 4 + g) * 128 + 4 * g4;
#pragma unroll
        for (int md = 0; md < 8; ++md) { f32x4 v = st.ot[md][nt] * sc; float* op = oacc + base + 16 * md;
            if (BR == 0) *(f32x4*)op = v;
            else if (BR == 1) *(f32x4*)op = *(const f32x4*)op + v;
            else { v = v + *(const f32x4*)op; *(u32x2*)(att + base + 16 * md) = (u32x2){pk_bf16(v[0], v[1]), pk_bf16(v[2], v[3])}; } }
    }
}
__device__ __forceinline__ void attn_reset(AttnState& st) {
#pragma unroll
    for (int md = 0; md < 8; ++md) { st.ot[md][0] = (f32x4){0.f, 0.f, 0.f, 0.f}; st.ot[md][1] = (f32x4){0.f, 0.f, 0.f, 0.f}; }
    st.m[0] = st.m[1] = -1e30f; st.l[0] = st.l[1] = 0.f;
}
__device__ __forceinline__ void attn_item(unsigned char* ws, LAS unsigned char* lds, int hkv, int qb) {
    int tid = ltid(); asm volatile("" : "+v"(tid)); const int w = tid >> 6, lane = tid & 63, l16 = lane & 15, g4 = lane >> 4;
    const bf16_t* QB = (const bf16_t*)(ws + OFF_QB); const bf16_t* KVTOK = (const bf16_t*)(ws + OFF_KVTOK); const bf16_t* KVT = (const bf16_t*)(ws + OFF_KVT);
    const bf16_t* KC = (const bf16_t*)(ws + OFF_KCMP); const bf16_t* VC = (const bf16_t*)(ws + OFF_VCMPT);
    const float* gates = (const float*)(ws + OFF_GATES); float* oacc = (float*)(ws + OFF_OACC); bf16_t* att = (bf16_t*)(ws + OFF_ATT);
    int tpos[2]; bf16x8 qf[2][4];
#pragma unroll
    for (int nt = 0; nt < 2; ++nt) { tpos[nt] = qb * 64 + w * 8 + nt * 4 + (l16 >> 2); const bf16_t* qp = QB + (size_t)tpos[nt] * 2048 + (hkv * 4 + (l16 & 3)) * 128 + g4 * 8;
#pragma unroll
        for (int ks = 0; ks < 4; ++ks) qf[nt][ks] = *(const bf16x8*)(qp + ks * 32); }
    __syncthreads();
    { LAS float* pp = (LAS float*)(lds + A_PSL) + w * 2048;
#pragma unroll
      for (int i = 0; i < 32; ++i) pp[lane + 64 * i] = 0.f; }
    AttnState st; float mfin[2] = {0.f, 0.f}, linv[2] = {0.f, 0.f};
    const int ncmp_tiles = (4 * qb + 3 + 63) >> 6;
    attn_reset(st);
    attn_tiles<0>(lds, KC + (size_t)hkv * 1024 * 128, 128, VC, 1024, 0, ncmp_tiles, qf, st, tpos, qb, w, lane, mfin, linv);
#pragma unroll
    for (int nt = 0; nt < 2; ++nt) { float l = st.l[nt]; l += shx(l, 16, lane); l += shx(l, 32, lane); mfin[nt] = st.m[nt]; linv[nt] = (l > 0.f) ? 1.0f / l : 0.f; }
    attn_reset(st);
    attn_tiles<1>(lds, KC + (size_t)hkv * 1024 * 128, 128, VC + (size_t)hkv * 128 * 1024, 1024, 0, ncmp_tiles, qf, st, tpos, qb, w, lane, mfin, linv);
    attn_finish<0>(st, gates, oacc, att, tpos, hkv, lane);
    __syncthreads();
    {
        LAS unsigned* sel = (LAS unsigned*)(lds + A_SEL) + w * 64;
        if (qb < 16) {
            if (lane < 8) { for (int tk = 0; tk < 8; ++tk) { const int lo = lane * 32; unsigned wd = 0; if (qb >= lo + 31) wd = 0xffffffffu; else if (qb >= lo) wd = (2u << (qb - lo)) - 1u; sel[tk * 8 + lane] = wd; } }
        } else {
            for (int tk = 0; tk < 8; ++tk) {
                const LAS float* pp = (const LAS float*)(lds + A_PSL) + (w * 8 + tk) * 256;
                unsigned key[4]; bool forced[4];
#pragma unroll
                for (int i = 0; i < 4; ++i) { const int j = lane + 64 * i; const float sc = pp[j]; const bool elig = (j >= 1) && (j <= qb - 2);
                    forced[i] = (j == 0) || (j == qb) || (j == qb - 1); key[i] = elig ? (__float_as_uint(sc) + 1u) : 0u; }
                unsigned prefix = 0u;
                for (int bit = 30; bit >= 0; --bit) { const unsigned cand = prefix | (1u << bit); int cnt = 0;
#pragma unroll
                    for (int i = 0; i < 4; ++i) cnt += __popcll(__ballot(key[i] >= cand));
                    if (cnt >= 13) prefix = cand; }
                int cgt = 0;
#pragma unroll
                for (int i = 0; i < 4; ++i) cgt += __popcll(__ballot(key[i] > prefix));
                const int need = 13 - cgt; int base = 0;
#pragma unroll
                for (int i = 0; i < 4; ++i) { const unsigned long long eqm = __ballot(key[i] == prefix);
                    const int rank = base + (int)__builtin_amdgcn_mbcnt_hi((unsigned)(eqm >> 32), __builtin_amdgcn_mbcnt_lo((unsigned)eqm, 0u));
                    const bool taken = forced[i] || (key[i] > prefix) || (key[i] == prefix && rank < need);
                    const unsigned long long bal = __ballot(taken); if (lane == 0) { sel[tk * 8 + 2 * i] = (unsigned)bal; sel[tk * 8 + 2 * i + 1] = (unsigned)(bal >> 32); }
                    base += __popcll(eqm); }
            }
        }
    }
    __syncthreads();
    attn_reset(st);
    attn_tiles_slc2(lds, KVTOK + 2 * 512 + hkv * 128, 2048, KVT + (size_t)(hkv * 128) * S_, S_, qb + 1, qf, st, tpos, qb, w, lane, mfin, linv);
    attn_finish<1>(st, gates, oacc, att, tpos, hkv, lane);
    attn_reset(st);
    attn_tiles<3>(lds, KVTOK + 3 * 512 + hkv * 128, 2048, KVT + (size_t)(512 + hkv * 128) * S_, S_, (qb - 8) > 0 ? (qb - 8) : 0, qb + 1, qf, st, tpos, qb, w, lane, mfin, linv);
    attn_finish<2>(st, gates, oacc, att, tpos, hkv, lane);
}
__device__ __forceinline__ void attn_phase(unsigned char* ws, LAS unsigned char* lds, int b) {
    unsigned* ctr = (unsigned*)(ws + OFF_BAR) + XCD_CTR_WORD + 64 * b;
    volatile LAS int* slot = (volatile LAS int*)(lds + LDS_ST + 8);
#pragma nounroll
    for (;;) {
        __syncthreads();
        if (threadIdx.x == 0) *slot = (int)__hip_atomic_fetch_add(ctr, 1u, __ATOMIC_RELAXED, __HIP_MEMORY_SCOPE_AGENT);
        __syncthreads();
        const int it = *slot;
        if (it >= 1024) break;
        attn_item(ws, lds, it & 3, 255 - (it >> 2));
    }
}

#define XB_TMO      128
#define XB_XCNT(j)  (256  + 64 * (j))
#define XB_XSUB(j)  (1280 + 64 * (j))
#define XB_XGEN(j)  (2304 + 64 * (j))
#define XB_TOP      3328
#define XB_TOPGEN   3392
#define XCD_BAR_WORDS 3456
#define XB_SPIN_CAP (1u << 22)
__device__ __forceinline__ unsigned xb_ld(unsigned* p)              { return __hip_atomic_load(p, __ATOMIC_RELAXED, __HIP_MEMORY_SCOPE_AGENT); }
__device__ __forceinline__ unsigned xb_add(unsigned* p, unsigned v) { return __hip_atomic_fetch_add(p, v, __ATOMIC_RELAXED, __HIP_MEMORY_SCOPE_AGENT); }
__device__ __forceinline__ unsigned xb_xcc_id() { return (unsigned)__builtin_amdgcn_s_getreg((3 << 11) | 20) & 0xFu; }
#define XB_SPIN(cond, bar) do { unsigned _sp = 0; while (cond) { __builtin_amdgcn_s_sleep(1); \
    if ((++_sp & 255u) == 0u) { if (xb_ld(&(bar)[XB_TMO])) break; if (_sp > XB_SPIN_CAP) { atomicAdd(&(bar)[XB_TMO], 1u); break; } } } } while (0)
struct XcdBarrier { unsigned* bar; unsigned x; volatile LAS unsigned* st; };
__device__ __forceinline__ XcdBarrier xcd_barrier_post(unsigned* bar, volatile LAS unsigned* st) {
    XcdBarrier b; b.bar = bar; b.x = xb_xcc_id(); b.st = st;
    if (threadIdx.x == 0) (void)xb_add(&bar[XB_XCNT(b.x)], 1u);
    return b;
}
__device__ __forceinline__ void xcd_barrier_complete(unsigned* bar, unsigned x, unsigned& nloc, unsigned& nx) {
    const unsigned G = gridDim.x * gridDim.y * gridDim.z;
    unsigned sum, cnt, mine, sp = 0u;
    for (;;) {
        sum = 0u; cnt = 0u; mine = 0u;
#pragma unroll
        for (unsigned j = 0; j < 16; ++j) { const unsigned c = xb_ld(&bar[XB_XCNT(j)]); sum += c; cnt += (c > 0u) ? 1u : 0u; mine = (j == x) ? c : mine; }
        if (sum == G) break;
        __builtin_amdgcn_s_sleep(1);
        if ((++sp & 255u) == 0u) { if (xb_ld(&bar[XB_TMO])) break; if (sp > XB_SPIN_CAP) { atomicAdd(&bar[XB_TMO], 1u); break; } }
    }
    nloc = mine > 0u ? mine : 1u; nx = cnt > 0u ? cnt : 1u;
}
__device__ __forceinline__ void xcd_barrier(const XcdBarrier& b) {
    asm volatile("s_waitcnt vmcnt(0)" ::: "memory");
    __syncthreads();
    if (threadIdx.x == 0) {
        unsigned* bar = b.bar;
        __builtin_amdgcn_s_waitcnt(0);
        unsigned nloc = b.st[0], nx = b.st[1];
        if (nloc == 0u) { xcd_barrier_complete(bar, b.x, nloc, nx); b.st[0] = nloc; b.st[1] = nx; }
        const unsigned old = xb_add(&bar[XB_XSUB(b.x)], 1u);
        const unsigned gen = old / nloc;
        if (old + 1u == (gen + 1u) * nloc) {
            __builtin_amdgcn_fence(__ATOMIC_RELEASE, "agent");
            asm volatile("s_waitcnt vmcnt(0)" ::: "memory");
            const unsigned og = xb_add(&bar[XB_TOP], 1u);
            const unsigned tg = og / nx;
            if (og + 1u == (tg + 1u) * nx) xb_add(&bar[XB_TOPGEN], 1u);
            else XB_SPIN(xb_ld(&bar[XB_TOPGEN]) == tg, bar);
            __builtin_amdgcn_fence(__ATOMIC_ACQUIRE, "agent");
            xb_add(&bar[XB_XGEN(b.x)], 1u);
            asm volatile("s_waitcnt vmcnt(0)" ::: "memory");
        } else {
            XB_SPIN(xb_ld(&bar[XB_XGEN(b.x)]) == gen, bar);
            __builtin_amdgcn_fence(__ATOMIC_ACQUIRE, "agent");
            asm volatile("s_waitcnt vmcnt(0)" ::: "memory");
        }
    }
    __syncthreads();
}

constexpr int NPH = 23;
__device__ __forceinline__ void run_phase(CP p, int ph, int b, LAS unsigned char* lds) {
    asm volatile("" : "+s"(p));
    unsigned char* ws = p->ws;
    const float* xb = p->x + (size_t)b * S_ * D_; float* hb = p->out + (size_t)b * S_ * D_;
    bf16_t* XN = (bf16_t*)(ws + OFF_XN);
    const int layer = (ph >= 13) ? 1 : 0;
    switch (ph) {
    case 0: prep_phase(p, lds); break;
    case 1: rmsnorm_phase(xb, p->norm_mix, XN, nullptr, nullptr); break;
    case 2: {
        Prob2D<EpiQK> g1{(const char*)XN, (const char*)(ws + OFF_W_RIN), 4096u, 4096u, 32, 64, 16, EpiQK{(bf16_t*)(ws + OFF_Q), (bf16_t*)(ws + OFF_K), (bf16_t*)(ws + OFF_KTD), (const float2*)(ws + OFF_ROPE)}};
        gemm_phase(lds, g1);
        Prob2D<EpiStore> g2{(const char*)(ws + OFF_W_RIN) + (size_t)4096 * 4096, (const char*)XN, 4096u, 4096u, 32, 16, 64, EpiStore{(bf16_t*)(ws + OFF_VT), (size_t)S_}};
        gemm_phase(lds, g2);
    } break;
    case 3: {
        ProbKV g3{(const char*)(ws + OFF_VT), (const char*)(ws + OFF_KTD), (bf16_t*)(ws + OFF_ST), 4};
        gemm_phase(lds, g3);
        ProbS g4{(const char*)(ws + OFF_Q), (const char*)(ws + OFF_K), (bf16_t*)(ws + OFF_SD), 4};
        gemm_phase(lds, g4);
    } break;
    case 4: scan_phase((bf16_t*)(ws + OFF_ST)); break;
    case 5: {
        ProbOut g5{(const char*)(ws + OFF_Q), (const char*)(ws + OFF_ST), (long)OFF_SD - (long)OFF_Q, (long)OFF_VT - (long)OFF_ST, (bf16_t*)(ws + OFF_Y), 8};
        gemm_phase(lds, g5);
    } break;
    case 6: gn_phase((const bf16_t*)(ws + OFF_Y), (float2*)(ws + OFF_GNS)); break;
    case 7: {
        Prob2D<EpiGate> g6{(const char*)XN, (const char*)(ws + OFF_W_RIN) + (size_t)8192 * 4096, 4096u, 4096u, 32, 64, 16, EpiGate{(bf16_t*)(ws + OFF_Y), (const float2*)(ws + OFF_GNS), p->ret_gn}};
        gemm_phase(lds, g6);
    } break;
    case 8: {
        Prob2D<EpiRes> g7{(const char*)(ws + OFF_Y), (const char*)(ws + OFF_W_ROUT), 8192u, 8192u, 64, 64, 8, EpiRes{xb, hb, XN, (float*)(ws + OFF_SS) + (size_t)(b * 4 + 0) * S_}};
        gemm_phase(lds, g7);
    } break;
    case 10: case 20: {
        Prob2D<EpiStoreRS> g8{(const char*)XN, (const char*)(ws + OFF_W_FIN + (size_t)layer * 32 * MiB), 4096u, 4096u, 32, 64, 32, EpiStoreRS{(bf16_t*)(ws + OFF_U), (size_t)8192, (const float*)(ws + OFF_SS) + (size_t)(b * 4 + (layer ? 2 : 0)) * S_}};
        gemm_phase(lds, g8);
    } break;
    case 11: case 21: conv_phase((const bf16_t*)(ws + OFF_U), (bf16_t*)(ws + OFF_AB), p->ffn_conv_w + (size_t)layer * 3 * 8192, p->ffn_conv_b + (size_t)layer * 8192); break;
    case 12: case 22: {
        Prob2D<EpiRes> g9{(const char*)(ws + OFF_AB), (const char*)(ws + OFF_W_FOUT + (size_t)layer * 16 * MiB), 8192u, 8192u, 64, 64, 8, EpiRes{hb, hb, layer ? (bf16_t*)nullptr : XN, layer ? (float*)nullptr : (float*)(ws + OFF_SS) + (size_t)(b * 4 + 1) * S_}};
        gemm_phase(lds, g9);
    } break;
    case 14: {
        const float* ss1 = (const float*)(ws + OFF_SS) + (size_t)(b * 4 + 1) * S_;
        Prob2D<EpiStoreRS> g10{(const char*)XN, (const char*)(ws + OFF_W_KV), 4096u, 4096u, 32, 64, 8, EpiStoreRS{(bf16_t*)(ws + OFF_KVTOK), (size_t)2048, ss1}};
        gemm_phase(lds, g10);
        Prob2D<EpiStoreCS> g11{(const char*)(ws + OFF_W_KV) + (size_t)2048 * 4096, (const char*)XN, 4096u, 4096u, 32, 4, 64, EpiStoreCS{(bf16_t*)(ws + OFF_KVT), (size_t)S_, ss1}};
        gemm_phase(lds, g11);
    } break;
    case 15: {
        ProbCmp1 a{(const char*)(ws + OFF_KVTOK), (const char*)(ws + OFF_W_C1K), 8192u, 64, 16, EpiGelu{(bf16_t*)(ws + OFF_H1), (const float*)(ws + OFF_PEB)}};
        gemm_phase(lds, a, (int)gridDim.x - 32);
        ProbCmp1 v{(const char*)(ws + OFF_KVTOK) + 1024, (const char*)(ws + OFF_W_C1V), 8192u, 64, 16, EpiGelu{(bf16_t*)(ws + OFF_H1) + 4096 * 256, (const float*)(ws + OFF_PEB) + 256}};
        gemm_phase(lds, v, (int)gridDim.x - 16);
        Prob2D<EpiQproj> g12{(const char*)XN, (const char*)(ws + OFF_W_Q), 4096u, 4096u, 32, 64, 9, EpiQproj{(bf16_t*)(ws + OFF_QB), (float*)(ws + OFF_GATES), (const float*)(ws + OFF_SS) + (size_t)(b * 4 + 1) * S_}};
        gemm_phase(lds, g12);
    } break;
    case 16: {
        Prob2D<EpiKcmp> a{(const char*)(ws + OFF_H1), (const char*)(ws + OFF_W_C2K), 512u, 512u, 4, 16, 1, EpiKcmp{(bf16_t*)(ws + OFF_KCMP)}};
        gemm_phase(lds, a);
        Prob2D<EpiVcmp> v{(const char*)(ws + OFF_W_C2V), (const char*)(ws + OFF_H1) + (size_t)4096 * 256 * 2, 512u, 512u, 4, 1, 16, EpiVcmp{(bf16_t*)(ws + OFF_VCMPT)}};
        gemm_phase(lds, v);
    } break;
    case 17: attn_phase(ws, lds, b); break;
    case 18: {
        Prob2D<EpiRes> g{(const char*)(ws + OFF_ATT), (const char*)(ws + OFF_W_O), 4096u, 4096u, 32, 64, 8, EpiRes{hb, hb, XN, (float*)(ws + OFF_SS) + (size_t)(b * 4 + 2) * S_}};
        gemm_phase(lds, g);
    } break;
    case 23: finalnorm_phase(hb, p->final_gain); break;
    default: break;
    }
}

#if MULTI
__global__ void __launch_bounds__(512) phase_kernel(Params p, int ph, int b) {
    extern __shared__ __attribute__((aligned(16))) unsigned char shm[];
    run_phase((CP)__builtin_amdgcn_kernarg_segment_ptr(), ph, b, (LAS unsigned char*)shm);
}
#else
__global__ void __launch_bounds__(512) mega_kernel(Params p) {
    extern __shared__ __attribute__((aligned(16))) unsigned char shm[];
    cg::grid_group grid = cg::this_grid();
    CP cp = (CP)__builtin_amdgcn_kernarg_segment_ptr();
    volatile LAS unsigned* st = (volatile LAS unsigned*)((LAS unsigned char*)shm + LDS_ST);
    if (threadIdx.x == 0) { st[0] = 0u; st[1] = 0u; st[2] = 0u; st[3] = 0u; }
    __syncthreads();
    XcdBarrier xb = xcd_barrier_post((unsigned*)(cp->ws + OFF_BAR), st);
    run_phase(cp, 0, 0, (LAS unsigned char*)shm);
    grid.sync();
    for (int b = 0; b < 2; ++b)
        for (int ph = 1; ph <= NPH; ++ph) {
            if (ph == 9 || ph == 13 || ph == 19) continue;
#ifdef PROBE_PH
            const int reps = (ph == PROBE_PH || ph == PROBE_PH2) ? 2 : 1;
#else
            const int reps = 1;
#endif
            for (int rep = 0; rep < reps; ++rep) { run_phase(cp, ph, b, (LAS unsigned char*)shm); xcd_barrier(xb); } }
}
#endif

constexpr int LDS_BYTES = LDS_ST + 16;
extern "C" void kernel_launch(void* const* d_in, const int* in_sizes, int n_in, void* d_out, int out_size, void* d_ws, size_t ws_size, hipStream_t stream) {
    static int grid = 0;
    if (grid == 0) {
        if (n_in != 21 || out_size != 2 * S_ * D_ || ws_size < WS_NEED) { fprintf(stderr, "kernel_launch: unexpected shapes/ws (n_in %d out %d ws %zu need %zu)\n", n_in, out_size, ws_size, (size_t)WS_NEED); grid = -1; return; }
#if MULTI
        if (hipFuncSetAttribute((const void*)phase_kernel, hipFuncAttributeMaxDynamicSharedMemorySize, LDS_BYTES) != hipSuccess) { fprintf(stderr, "hipFuncSetAttribute failed\n"); grid = -1; return; }
#else
        if (hipFuncSetAttribute((const void*)mega_kernel, hipFuncAttributeMaxDynamicSharedMemorySize, LDS_BYTES) != hipSuccess) { fprintf(stderr, "hipFuncSetAttribute failed\n"); grid = -1; return; }
#endif
        int dev = 0, cus = 0; hipGetDevice(&dev); hipDeviceGetAttribute(&cus, hipDeviceAttributeMultiprocessorCount, dev);
        grid = cus > 0 ? cus : 256;
    }
    if (grid < 0) return;
    Params p{};
    const float** pp = (const float**)&p;
    for (int i = 0; i < 21; ++i) pp[i] = (const float*)d_in[i];
    p.out = (float*)d_out; p.ws = (unsigned char*)d_ws;
#if MULTI
    hipLaunchKernelGGL(phase_kernel, dim3(grid), dim3(512), LDS_BYTES, stream, p, 0, 0);
    for (int b = 0; b < 2; ++b)
        for (int ph = 1; ph <= NPH; ++ph) hipLaunchKernelGGL(phase_kernel, dim3(grid), dim3(512), LDS_BYTES, stream, p, ph, b);
#else
    if (hipMemsetAsync((unsigned char*)d_ws + OFF_BAR, 0, (XCD_BAR_WORDS + 128) * 4, stream) != hipSuccess) { fprintf(stderr, "memset failed\n"); return; }
    void* args[] = {&p};
    hipError_t e = hipLaunchCooperativeKernel((const void*)mega_kernel, dim3(grid), dim3(512), args, LDS_BYTES, stream);
    if (e != hipSuccess) fprintf(stderr, "cooperative launch failed: %s (grid %d)\n", hipGetErrorString(e), grid);
#endif
}
```

```cpp
#include <hip/hip_runtime.h>
#include <hip/hip_cooperative_groups.h>
#include <cstdio>
namespace cg = cooperative_groups;

#ifndef MULTI
#define MULTI 0
#endif

#define LAS __attribute__((address_space(3)))
typedef unsigned short bf16_t;
typedef short bf16x8 __attribute__((ext_vector_type(8)));
typedef float f32x4 __attribute__((ext_vector_type(4)));
typedef unsigned u32x2 __attribute__((ext_vector_type(2)));
typedef unsigned u32x4 __attribute__((ext_vector_type(4)));

constexpr int S_ = 16384, D_ = 2048;
constexpr size_t MiB = 1048576;
constexpr size_t OFF_W_RIN = 0, OFF_W_ROUT = 48 * MiB, OFF_W_KV = 64 * MiB, OFF_W_C1K = 76 * MiB, OFF_W_C1V = 78 * MiB,
                 OFF_W_C2K = 80 * MiB, OFF_W_C2V = 80 * MiB + 131072, OFF_W_Q = 81 * MiB, OFF_W_O = 90 * MiB,
                 OFF_W_FIN = 98 * MiB  , OFF_W_FOUT = 162 * MiB  , OFF_ROPE = 194 * MiB, OFF_PEB = 210 * MiB, OFF_BAR = 210 * MiB + 65536, OFF_SS = 210 * MiB + 131072  ,
                 OFF_XN = 211 * MiB, OFF_ACT = 275 * MiB;
constexpr size_t OFF_Q = OFF_ACT, OFF_K = OFF_ACT + 64 * MiB, OFF_KTD = OFF_ACT + 128 * MiB, OFF_VT = OFF_ACT + 192 * MiB,
                 OFF_ST = OFF_ACT + 320 * MiB, OFF_SD = OFF_ACT + 448 * MiB, OFF_Y = OFF_ACT + 512 * MiB, OFF_GNS = OFF_ACT + 640 * MiB  , WS_NEED = OFF_ACT + 641 * MiB;
constexpr size_t OFF_U = OFF_ACT, OFF_AB = OFF_ACT + 256 * MiB;
constexpr size_t OFF_HN = OFF_ACT, OFF_KVTOK = OFF_ACT + 64 * MiB, OFF_KVT = OFF_ACT + 129 * MiB, OFF_QB = OFF_ACT + 161 * MiB,
                 OFF_GATES = OFF_ACT + 225 * MiB, OFF_H1 = OFF_ACT + 229 * MiB, OFF_KCMP = OFF_ACT + 233 * MiB, OFF_VCMPT = OFF_ACT + 234 * MiB,
                 OFF_ATT = OFF_ACT + 235 * MiB, OFF_OACC = OFF_ACT + 299 * MiB;

struct Params {
    const float* x; const float* norm_mix; const float* norm_ffn; const float* ret_w_in; const float* ret_gn; const float* ret_w_out;
    const float* kv_gain; const float* w_kv; const float* pe_k; const float* w1_k; const float* w2_k; const float* pe_v; const float* w1_v;
    const float* w2_v; const float* w_q; const float* w_o; const float* ffn_w_in; const float* ffn_conv_w; const float* ffn_conv_b;
    const float* ffn_w_out; const float* final_gain; float* out; unsigned char* ws;
};

typedef const __attribute__((address_space(4))) Params* CP;
__device__ __forceinline__ int ltid() { int t = threadIdx.x; asm volatile("" : "+v"(t)); return t; }
__device__ __forceinline__ unsigned pk_bf16(float lo, float hi) { unsigned r; asm("v_cvt_pk_bf16_f32 %0, %1, %2" : "=v"(r) : "v"(lo), "v"(hi)); return r; }
__device__ __forceinline__ float bflo(unsigned v) { return __uint_as_float(v << 16); }
__device__ __forceinline__ float bfhi(unsigned v) { return __uint_as_float(v & 0xffff0000u); }
__device__ __forceinline__ float fexp2(float x) { return __builtin_amdgcn_exp2f(x); }
__device__ __forceinline__ float frcp(float x) { return __builtin_amdgcn_rcpf(x); }
__device__ __forceinline__ float log2gamma(int h) { return log2f(1.0f - exp2f(-5.0f - (float)h)); }
__device__ __forceinline__ float sigmoidf_(float x) { return frcp(1.0f + fexp2(-1.4426950408889634f * x)); }

__device__ __forceinline__ float shx(float v, int m, int lane) { return __int_as_float(__builtin_amdgcn_ds_bpermute((lane ^ m) << 2, __float_as_int(v))); }
__device__ __forceinline__ unsigned long long shx64(unsigned long long v, int m, int lane) {
    const unsigned lo = (unsigned)__builtin_amdgcn_ds_bpermute((lane ^ m) << 2, (int)(unsigned)v), hi = (unsigned)__builtin_amdgcn_ds_bpermute((lane ^ m) << 2, (int)(unsigned)(v >> 32));
    return ((unsigned long long)hi << 32) | lo; }
__device__ __forceinline__ float wave_sum(float v, int lane) {
#pragma unroll
    for (int o = 32; o >= 1; o >>= 1) v += shx(v, o, lane);
    return v;
}
constexpr int HTB = 128 * 64 * 2;
__device__ __forceinline__ int lds_byte(int r, int c) { const int st = (r >> 4) * 2 + (c >> 5), rr = r & 15, cc = c & 31, ob = rr * 64 + cc * 2; return st * 1024 + (ob ^ (((ob >> 9) & 1) << 5)); }
__device__ __forceinline__ void stage_rc(int b, int& R, int& C) { const int st = b / 1024, sb = b % 1024, swz = sb ^ (((sb >> 9) & 1) << 5); R = (st >> 1) * 16 + swz / 64; C = (st & 1) * 32 + (swz % 64) / 2; }
__device__ __forceinline__ void tile_order(int L, int nM, int nN, int& pm, int& pn) {
    const int nwg = nM * nN; int wgid = L;
    { const int q = nwg / 8, r = nwg % 8, xcd = wgid % 8, off = wgid / 8; wgid = (xcd < r ? xcd * (q + 1) : r * (q + 1) + (xcd - r) * q) + off; }
    const int nig = 8 * nN, gid = wgid / nig, fm = gid * 8, gsz = (nM - fm) < 8 ? (nM - fm) : 8;
    pm = fm + ((wgid % nig) % gsz); pn = (wgid % nig) / gsz;
}
struct UInfo { const char* a; const char* b; int r0, c0, x0, x1; };
typedef f32x4 AccT[2][2][4][2];

template <class P>
__device__ __forceinline__ void gemm_phase(LAS unsigned char* lds, const P& pb, int cofs = 0) {
    const int tid = ltid(), wid = __builtin_amdgcn_readfirstlane(tid >> 6), lane = tid & 63, wr = wid >> 2, wc = wid & 3, fr = lane & 15, fq = lane >> 4;
    const int nt = pb.nt, G = gridDim.x, c = (int)blockIdx.x - cofs; const long nun = pb.nunits();
    if (c < 0 || c >= nun) return;
    unsigned voffA[2], voffB[2];
#pragma unroll
    for (int i = 0; i < 2; ++i) { int R, C; stage_rc(tid * 16 + i * 8192, R, C); voffA[i] = pb.rowA(R) + (unsigned)C * 2u; const int rho = R & 31; const int Rb = P::PERM ? ((R & ~31) + 8 * ((rho & 15) >> 2) + 4 * (rho >> 4) + (rho & 3)) : R; voffB[i] = (unsigned)Rb * pb.ldb + (unsigned)C * 2u; }
    const size_t hsA = pb.rowA(128), hsB = (size_t)128 * pb.ldb;
    const unsigned ldsw = (unsigned)wid * 1024u;
    const int aoff = lds_byte(wr * 64 + fr, fq * 8), boff = lds_byte(wc * 32 + fr, fq * 8);
#define G_SA(b, h) (((b) * 2 + (h)) * HTB)
#define G_SB(b, h) ((4 + (b) * 2 + (h)) * HTB)
#define G_STAGE(bufoff, gbase, voff) do { _Pragma("unroll") for (int _i = 0; _i < 2; ++_i) \
        __builtin_amdgcn_global_load_lds((const unsigned*)((const char*)(gbase) + (voff)[_i]), (LAS unsigned*)(lds + (bufoff) + ldsw + _i * 8192), 16, 0, 0); } while (0)
#define G_LDA(dst, b, h) do { _Pragma("unroll") for (int m = 0; m < 4; ++m) _Pragma("unroll") for (int k = 0; k < 2; ++k) dst[m][k] = *(const LAS bf16x8*)(lds + G_SA(b, h) + aoff + m * 2048 + k * 1024); } while (0)
#define G_LDB(dst, b, h) do { _Pragma("unroll") for (int n = 0; n < 2; ++n) _Pragma("unroll") for (int k = 0; k < 2; ++k) dst[n][k] = *(const LAS bf16x8*)(lds + G_SB(b, h) + boff + n * 2048 + k * 1024); } while (0)
#define G_MMA(ai, bj, At, Bt) do { __builtin_amdgcn_s_setprio(1); _Pragma("unroll") for (int m = 0; m < 4; ++m) _Pragma("unroll") for (int n = 0; n < 2; ++n) _Pragma("unroll") for (int k = 0; k < 2; ++k) \
        acc[ai][bj][m][n] = __builtin_amdgcn_mfma_f32_16x16x32_bf16(Bt[n][k], At[m][k], acc[ai][bj][m][n], 0, 0, 0); __builtin_amdgcn_s_setprio(0); } while (0)
#define G_WAIT_V(n) asm volatile("s_waitcnt vmcnt(" #n ")" ::: "memory")
#define G_WAIT_L(n) asm volatile("s_waitcnt lgkmcnt(" #n ")" ::: "memory")
#define G_BAR __builtin_amdgcn_s_barrier()
#define G_SCHED __builtin_amdgcn_sched_barrier(0)
    UInfo cur, nxt; int ui = 0;
    pb.unit(c, cur);
    AccT acc;
#pragma unroll
    for (int a = 0; a < 2; ++a)
#pragma unroll
        for (int b = 0; b < 2; ++b)
#pragma unroll
            for (int m = 0; m < 4; ++m)
#pragma unroll
                for (int n = 0; n < 2; ++n) acc[a][b][m][n] = (f32x4){0.f, 0.f, 0.f, 0.f};
    bf16x8 At[4][2], B0[2][2], B1[2][2];
    const char* cA = cur.a; const char* cB = cur.b;
    G_STAGE(G_SB(0, 0), cB + pb.bK(0), voffB); G_STAGE(G_SA(0, 0), cA + pb.aK(0), voffA); G_STAGE(G_SB(0, 1), cB + hsB + pb.bK(0), voffB); G_STAGE(G_SA(0, 1), cA + hsA + pb.aK(0), voffA);
    if (wr == 1) G_BAR;
    G_WAIT_V(4); G_BAR;
    G_STAGE(G_SB(1, 0), cB + pb.bK(1), voffB); G_STAGE(G_SA(1, 0), cA + pb.aK(1), voffA); G_STAGE(G_SB(1, 1), cB + hsB + pb.bK(1), voffB);
    G_WAIT_V(6); G_BAR;
    for (;;) {
        const long Ln = (long)(ui + 1) * G + c; const bool has_next = Ln < nun;
        if (has_next) pb.unit(Ln, nxt);
        const char* nA = has_next ? nxt.a : cA; const char* nB = has_next ? nxt.b : cB;
        for (int t = 0; t < nt; t += 2) {
            const bool last = (t == nt - 2);
            const char* a1 = cA + pb.aK(t + 1);
            const char* a2 = last ? nA + pb.aK(0) : cA + pb.aK(t + 2); const char* b2 = last ? nB + pb.bK(0) : cB + pb.bK(t + 2);
            const char* a3 = last ? nA + pb.aK(1) : cA + pb.aK(t + 3); const char* b3 = last ? nB + pb.bK(1) : cB + pb.bK(t + 3);
            G_LDB(B0, 0, 0); G_SCHED; G_LDA(At, 0, 0); G_STAGE(G_SA(1, 1), a1 + hsA, voffA);
            G_WAIT_L(8); G_BAR; G_WAIT_L(0); G_MMA(0, 0, At, B0); G_BAR; G_SCHED;
            G_LDB(B1, 0, 1); G_STAGE(G_SB(0, 0), b2, voffB);
            G_BAR; G_WAIT_L(0); G_MMA(0, 1, At, B1); G_BAR;
            G_LDA(At, 0, 1); G_STAGE(G_SA(0, 0), a2, voffA);
            G_BAR; G_WAIT_L(0); G_MMA(1, 0, At, B0); G_BAR; G_SCHED;
            G_STAGE(G_SB(0, 1), b2 + hsB, voffB);
            G_WAIT_V(6); G_BAR; G_MMA(1, 1, At, B1); G_BAR;
            G_LDB(B0, 1, 0); G_SCHED; G_LDA(At, 1, 0); G_STAGE(G_SA(0, 1), a2 + hsA, voffA);
            G_WAIT_L(8); G_BAR; G_WAIT_L(0); G_MMA(0, 0, At, B0); G_BAR; G_SCHED;
            G_LDB(B1, 1, 1); G_STAGE(G_SB(1, 0), b3, voffB);
            G_BAR; G_WAIT_L(0); G_MMA(0, 1, At, B1); G_BAR;
            G_LDA(At, 1, 1); G_STAGE(G_SA(1, 0), a3, voffA);
            G_BAR; G_WAIT_L(0); G_MMA(1, 0, At, B0); G_BAR; G_SCHED;
            G_STAGE(G_SB(1, 1), b3 + hsB, voffB);
            G_WAIT_V(6); G_BAR; G_MMA(1, 1, At, B1); G_BAR;
        }
        { const int l2 = ltid() & 63; pb.epi(acc, cur, wr, wc, l2 & 15, l2 >> 4); }
        if (!has_next) break;
#pragma unroll
        for (int a = 0; a < 2; ++a)
#pragma unroll
            for (int b = 0; b < 2; ++b)
#pragma unroll
                for (int m = 0; m < 4; ++m)
#pragma unroll
                    for (int n = 0; n < 2; ++n) acc[a][b][m][n] = (f32x4){0.f, 0.f, 0.f, 0.f};
        cur = nxt; cA = nA; cB = nB; ++ui;
    }
    G_WAIT_V(0);
    if (wr == 0) G_BAR;
    G_BAR;
}

#define EPI_ROWS for (int ai = 0; ai < 2; ++ai) for (int m = 0; m < 4; ++m)
#define EPI_COLS for (int bj = 0; bj < 2; ++bj) for (int n = 0; n < 2; ++n)
#define EPI_ROW (128 * ai + 64 * wr + 16 * m + fr)
#define EPI_COL (128 * bj + 32 * wc + 16 * n + 4 * fq)

template <class Epi> struct Prob2D {
    static constexpr bool PERM = Epi::PERM;
    const char* A; const char* B; unsigned lda, ldb; int nt, nM, nN; Epi e;
    __device__ __forceinline__ long nunits() const { return (long)nM * nN; }
    __device__ __forceinline__ unsigned rowA(int R) const { return (unsigned)R * lda; }
    __device__ __forceinline__ void unit(long L, UInfo& u) const { int pm, pn; tile_order((int)L, nM, nN, pm, pn); u.a = A + (size_t)pm * 256 * lda; u.b = B + (size_t)pn * 256 * ldb; u.r0 = pm * 256; u.c0 = pn * 256; u.x0 = 0; u.x1 = 0; }
    __device__ __forceinline__ size_t aK(int kt) const { return (size_t)kt * 128; }
    __device__ __forceinline__ size_t bK(int kt) const { return (size_t)kt * 128; }
    __device__ __forceinline__ void epi(const AccT& acc, const UInfo& u, int wr, int wc, int fr, int fq) const { e(acc, u, wr, wc, fr, fq); }
};
struct EpiStore { static constexpr bool PERM = true; bf16_t* O; size_t ldc;
    __device__ __forceinline__ void operator()(const AccT& acc, const UInfo& u, int wr, int wc, int fr, int fq) const {
#pragma unroll
        EPI_ROWS { bf16_t* rp = O + (size_t)(u.r0 + EPI_ROW) * ldc + u.c0;
#pragma unroll
            for (int bj = 0; bj < 2; ++bj) { const f32x4 v = acc[ai][bj][m][0], v2 = acc[ai][bj][m][1]; *(u32x4*)(rp + 128 * bj + 32 * wc + 8 * fq) = (u32x4){pk_bf16(v[0], v[1]), pk_bf16(v[2], v[3]), pk_bf16(v2[0], v2[1]), pk_bf16(v2[2], v2[3])}; } }
    } };
struct EpiRes { static constexpr bool PERM = true; const float* R; float* O; bf16_t* HB; float* ss;
    __device__ __forceinline__ void operator()(const AccT& acc, const UInfo& u, int wr, int wc, int fr, int fq) const {
#pragma unroll
        EPI_ROWS { const size_t ro = (size_t)(u.r0 + EPI_ROW) * 2048 + u.c0; float sq = 0.f;
#pragma unroll
            for (int bj = 0; bj < 2; ++bj) { const size_t co = ro + 128 * bj + 32 * wc + 8 * fq;
                const f32x4 o0 = *(const f32x4*)(R + co) + acc[ai][bj][m][0], o1 = *(const f32x4*)(R + co + 4) + acc[ai][bj][m][1];
                *(f32x4*)(O + co) = o0; *(f32x4*)(O + co + 4) = o1;
                if (HB) { *(u32x4*)(HB + co) = (u32x4){pk_bf16(o0[0], o0[1]), pk_bf16(o0[2], o0[3]), pk_bf16(o1[0], o1[1]), pk_bf16(o1[2], o1[3])};
                    sq += o0[0] * o0[0] + o0[1] * o0[1] + o0[2] * o0[2] + o0[3] * o0[3] + o1[0] * o1[0] + o1[1] * o1[1] + o1[2] * o1[2] + o1[3] * o1[3]; } }
            if (HB) { const int lane = fq * 16 + fr; sq += shx(sq, 16, lane); sq += shx(sq, 32, lane); if (fq == 0) atomicAdd(ss + u.r0 + EPI_ROW, sq); } }
    } };
struct EpiStoreRS { static constexpr bool PERM = true; bf16_t* O; size_t ldc; const float* ss;
    __device__ __forceinline__ void operator()(const AccT& acc, const UInfo& u, int wr, int wc, int fr, int fq) const {
#pragma unroll
        EPI_ROWS { const int row = u.r0 + EPI_ROW; const float rs = rsqrtf(ss[row] * (1.0f / 2048.0f) + 1e-6f); bf16_t* rp = O + (size_t)row * ldc + u.c0;
#pragma unroll
            for (int bj = 0; bj < 2; ++bj) { const f32x4 v = acc[ai][bj][m][0] * rs, v2 = acc[ai][bj][m][1] * rs; *(u32x4*)(rp + 128 * bj + 32 * wc + 8 * fq) = (u32x4){pk_bf16(v[0], v[1]), pk_bf16(v[2], v[3]), pk_bf16(v2[0], v2[1]), pk_bf16(v2[2], v2[3])}; } }
    } };
struct EpiStoreCS { static constexpr bool PERM = true; bf16_t* O; size_t ldc; const float* ss;
    __device__ __forceinline__ void operator()(const AccT& acc, const UInfo& u, int wr, int wc, int fr, int fq) const {
        f32x4 rs[2][2];
#pragma unroll
        for (int bj = 0; bj < 2; ++bj)
#pragma unroll
            for (int n = 0; n < 2; ++n) { const f32x4 s4 = *(const f32x4*)(ss + u.c0 + 128 * bj + 32 * wc + 8 * fq + 4 * n);
#pragma unroll
                for (int j = 0; j < 4; ++j) rs[bj][n][j] = rsqrtf(s4[j] * (1.0f / 2048.0f) + 1e-6f); }
#pragma unroll
        EPI_ROWS { bf16_t* rp = O + (size_t)(u.r0 + EPI_ROW) * ldc + u.c0;
#pragma unroll
            for (int bj = 0; bj < 2; ++bj) { const f32x4 v = acc[ai][bj][m][0] * rs[bj][0], v2 = acc[ai][bj][m][1] * rs[bj][1]; *(u32x4*)(rp + 128 * bj + 32 * wc + 8 * fq) = (u32x4){pk_bf16(v[0], v[1]), pk_bf16(v[2], v[3]), pk_bf16(v2[0], v2[1]), pk_bf16(v2[2], v2[3])}; } }
    } };
struct EpiGate { static constexpr bool PERM = true; bf16_t* Y; const float2* gns; const float* gain;
    __device__ __forceinline__ void operator()(const AccT& acc, const UInfo& u, int wr, int wc, int fr, int fq) const {
        const int hh = u.c0 >> 9;
#pragma unroll
        EPI_ROWS { const int row = u.r0 + EPI_ROW; bf16_t* rp = Y + (size_t)row * 4096 + u.c0;
            const float2 sg = gns[(size_t)row * 8 + hh]; const float mu = sg.x, rs = sg.y;
#pragma unroll
            for (int bj = 0; bj < 2; ++bj) { const f32x4 g = acc[ai][bj][m][0], h = acc[ai][bj][m][1]; bf16_t* cp = rp + 128 * bj + 32 * wc + 8 * fq; const u32x4 y = *(const u32x4*)cp;
                const float* gp = gain + u.c0 + 128 * bj + 32 * wc + 8 * fq; const f32x4 g0 = *(const f32x4*)gp * rs, g1 = *(const f32x4*)(gp + 4) * rs;
                const float o0 = g[0] * sigmoidf_(g[0]) * (bflo(y[0]) - mu) * g0[0], o1 = g[1] * sigmoidf_(g[1]) * (bfhi(y[0]) - mu) * g0[1], o2 = g[2] * sigmoidf_(g[2]) * (bflo(y[1]) - mu) * g0[2], o3 = g[3] * sigmoidf_(g[3]) * (bfhi(y[1]) - mu) * g0[3];
                const float o4 = h[0] * sigmoidf_(h[0]) * (bflo(y[2]) - mu) * g1[0], o5 = h[1] * sigmoidf_(h[1]) * (bfhi(y[2]) - mu) * g1[1], o6 = h[2] * sigmoidf_(h[2]) * (bflo(y[3]) - mu) * g1[2], o7 = h[3] * sigmoidf_(h[3]) * (bfhi(y[3]) - mu) * g1[3];
                *(u32x4*)cp = (u32x4){pk_bf16(o0, o1), pk_bf16(o2, o3), pk_bf16(o4, o5), pk_bf16(o6, o7)}; } }
    } };
struct EpiQK { static constexpr bool PERM = true; bf16_t* Q; bf16_t* K; bf16_t* KTD; const float2* rope;
    __device__ __forceinline__ void operator()(const AccT& acc, const UInfo& u, int wr, int wc, int fr, int fq) const {
        const int hidx = u.c0 >> 8; const bool isk = hidx >= 8; const int hh = hidx & 7; const float l2g = log2gamma(hh);
        bf16_t* dst = (isk ? K : Q) + hh * 256; const float sc = isk ? 0.0625f : 1.0f;
#pragma unroll
        EPI_ROWS { const int t = u.r0 + EPI_ROW; const float kd = fexp2((float)(255 - (t & 255)) * l2g);
#pragma unroll
            for (int n = 0; n < 2; ++n) { const int dd = 32 * wc + 8 * fq + 4 * n;
                const f32x4 x1 = acc[ai][0][m][n], x2 = acc[ai][1][m][n]; const f32x4 cs0 = *(const f32x4*)(rope + (size_t)t * 128 + dd), cs1 = *(const f32x4*)(rope + (size_t)t * 128 + dd + 2);
                float y1[4], y2[4];
                y1[0] = (x1[0] * cs0[0] - x2[0] * cs0[1]) * sc; y2[0] = (x1[0] * cs0[1] + x2[0] * cs0[0]) * sc;
                y1[1] = (x1[1] * cs0[2] - x2[1] * cs0[3]) * sc; y2[1] = (x1[1] * cs0[3] + x2[1] * cs0[2]) * sc;
                y1[2] = (x1[2] * cs1[0] - x2[2] * cs1[1]) * sc; y2[2] = (x1[2] * cs1[1] + x2[2] * cs1[0]) * sc;
                y1[3] = (x1[3] * cs1[2] - x2[3] * cs1[3]) * sc; y2[3] = (x1[3] * cs1[3] + x2[3] * cs1[2]) * sc;
                *(u32x2*)(dst + (size_t)t * 2048 + dd) = (u32x2){pk_bf16(y1[0], y1[1]), pk_bf16(y1[2], y1[3])};
                *(u32x2*)(dst + (size_t)t * 2048 + 128 + dd) = (u32x2){pk_bf16(y2[0], y2[1]), pk_bf16(y2[2], y2[3])};
                if (isk) {
#pragma unroll
                    for (int j = 0; j < 4; ++j) { KTD[(size_t)(hh * 256 + dd + j) * S_ + t] = (bf16_t)(pk_bf16(y1[j] * kd, 0.f) & 0xffffu); KTD[(size_t)(hh * 256 + 128 + dd + j) * S_ + t] = (bf16_t)(pk_bf16(y2[j] * kd, 0.f) & 0xffffu); }
                } } }
    } };
struct EpiQproj { static constexpr bool PERM = false; bf16_t* QB; float* gates; const float* ss;
    __device__ __forceinline__ void operator()(const AccT& acc, const UInfo& u, int wr, int wc, int fr, int fq) const {
#pragma unroll
        EPI_ROWS { const int t = u.r0 + EPI_ROW; const float rs = rsqrtf(ss[t] * (1.0f / 2048.0f) + 1e-6f);
#pragma unroll
            EPI_COLS { const int col = u.c0 + EPI_COL; const f32x4 v = acc[ai][bj][m][n] * rs;
                if (col < 2048) *(u32x2*)(QB + (size_t)t * 2048 + col) = (u32x2){pk_bf16(v[0] * 0.08838834764831845f, v[1] * 0.08838834764831845f), pk_bf16(v[2] * 0.08838834764831845f, v[3] * 0.08838834764831845f)};
                else if (col < 2096) *(f32x4*)(gates + (size_t)t * 48 + (col - 2048)) = (f32x4){sigmoidf_(v[0]), sigmoidf_(v[1]), sigmoidf_(v[2]), sigmoidf_(v[3])}; } }
    } };
__device__ __forceinline__ float gelu_tanh(float x) { const float y = 0.7978845608028654f * (x + 0.044715f * x * x * x); const float e = fexp2(2.0f * 1.4426950408889634f * y); const float th = 1.0f - 2.0f * frcp(e + 1.0f); return 0.5f * x * (1.0f + th); }
struct EpiGelu { static constexpr bool PERM = false; bf16_t* H; const float* bias;
    __device__ __forceinline__ void operator()(const AccT& acc, const UInfo& u, int wr, int wc, int fr, int fq) const {
#pragma unroll
        EPI_ROWS { bf16_t* rp = H + (size_t)(u.r0 + EPI_ROW) * 256;
#pragma unroll
            EPI_COLS { const int col = EPI_COL; const f32x4 v = acc[ai][bj][m][n]; const f32x4 bb = *(const f32x4*)(bias + col);
                *(u32x2*)(rp + col) = (u32x2){pk_bf16(gelu_tanh(v[0] + bb[0]), gelu_tanh(v[1] + bb[1])), pk_bf16(gelu_tanh(v[2] + bb[2]), gelu_tanh(v[3] + bb[3]))}; } }
    } };
struct EpiKcmp { static constexpr bool PERM = false; bf16_t* KC;
    __device__ __forceinline__ void operator()(const AccT& acc, const UInfo& u, int wr, int wc, int fr, int fq) const {
#pragma unroll
        EPI_ROWS { const int r = u.r0 + EPI_ROW, i = r >> 2, h = r & 3;
#pragma unroll
            for (int n = 0; n < 2; ++n) { const int col = 32 * wc + 16 * n + 4 * fq; f32x4 v = acc[ai][0][m][n]; if (i == 1023) v = (f32x4){0.f, 0.f, 0.f, 0.f};
                *(u32x2*)(KC + ((size_t)h * 1024 + i) * 128 + col) = (u32x2){pk_bf16(v[0], v[1]), pk_bf16(v[2], v[3])}; } }
    } };
struct EpiVcmp { static constexpr bool PERM = false; bf16_t* VC;
    __device__ __forceinline__ void operator()(const AccT& acc, const UInfo& u, int wr, int wc, int fr, int fq) const {
#pragma unroll
        for (int m = 0; m < 4; ++m) { const int d = 64 * wr + 16 * m + fr;
#pragma unroll
            EPI_COLS { const int col = u.c0 + EPI_COL, i = col >> 2; f32x4 v = acc[0][bj][m][n]; if (i == 1023) v = (f32x4){0.f, 0.f, 0.f, 0.f};
#pragma unroll
                for (int h = 0; h < 4; ++h) VC[((size_t)h * 128 + d) * 1024 + i] = (bf16_t)(pk_bf16(v[h], 0.f) & 0xffffu); } }
    } };
struct ProbCmp1 {
    static constexpr bool PERM = false;
    const char* A; const char* B; unsigned ldb; int nt, nM; EpiGelu e;
    __device__ __forceinline__ long nunits() const { return nM; }
    __device__ __forceinline__ unsigned rowA(int R) const { return (unsigned)(R >> 2) * 65536u + (unsigned)(R & 3) * 256u; }
    __device__ __forceinline__ void unit(long L, UInfo& u) const { u.a = A + (size_t)L * 64 * 65536; u.b = B; u.r0 = (int)L * 256; u.c0 = 0; u.x0 = 0; u.x1 = 0; }
    __device__ __forceinline__ size_t aK(int kt) const { return (size_t)(kt >> 1) * 4096 + (size_t)(kt & 1) * 128; }
    __device__ __forceinline__ size_t bK(int kt) const { return (size_t)kt * 128; }
    __device__ __forceinline__ void epi(const AccT& acc, const UInfo& u, int wr, int wc, int fr, int fq) const { e(acc, u, wr, wc, fr, fq); }
};
struct ProbKV {
    static constexpr bool PERM = true;
    const char* VT; const char* KTD; bf16_t* ST; int nt;
    __device__ __forceinline__ long nunits() const { return 8 * 64 * 2; }
    __device__ __forceinline__ unsigned rowA(int R) const { return (unsigned)R * 32768u; }
    static constexpr unsigned ldb = 32768u;
    __device__ __forceinline__ void unit(long L, UInfo& u) const { const int pm = (int)L & 1, c = ((int)L >> 1) & 63, h = (int)L >> 7;
        u.a = VT + ((size_t)(h * 512 + pm * 256) * S_ + c * 256) * 2; u.b = KTD + ((size_t)(h * 256) * S_ + c * 256) * 2; u.r0 = h * 512 + pm * 256; u.c0 = c * 256; u.x0 = 0; u.x1 = 0; }
    __device__ __forceinline__ size_t aK(int kt) const { return (size_t)kt * 128; }
    __device__ __forceinline__ size_t bK(int kt) const { return (size_t)kt * 128; }
    __device__ __forceinline__ void epi(const AccT& acc, const UInfo& u, int wr, int wc, int fr, int fq) const { EpiStore e{ST, (size_t)S_}; e(acc, u, wr, wc, fr, fq); }
};
struct ProbS {
    static constexpr bool PERM = true;
    const char* Q; const char* K; bf16_t* SD; int nt;
    __device__ __forceinline__ long nunits() const { return 8 * 64; }
    __device__ __forceinline__ unsigned rowA(int R) const { return (unsigned)R * 4096u; }
    static constexpr unsigned ldb = 4096u;
    __device__ __forceinline__ void unit(long L, UInfo& u) const { const int c = (int)L & 63, h = (int)L >> 6; const size_t o = ((size_t)(c * 256) * 2048 + h * 256) * 2;
        u.a = Q + o; u.b = K + o; u.r0 = c * 256; u.c0 = h * 256; u.x0 = h; u.x1 = 0; }
    __device__ __forceinline__ size_t aK(int kt) const { return (size_t)kt * 128; }
    __device__ __forceinline__ size_t bK(int kt) const { return (size_t)kt * 128; }
    __device__ __forceinline__ void epi(const AccT& acc, const UInfo& u, int wr, int wc, int fr, int fq) const {
        const float l2g = log2gamma(u.x0);
#pragma unroll
        EPI_ROWS { const int i = EPI_ROW; bf16_t* rp = SD + (size_t)(u.r0 + i) * 2048 + u.c0;
#pragma unroll
            for (int bj = 0; bj < 2; ++bj) { const int s = 128 * bj + 32 * wc + 8 * fq; const f32x4 v = acc[ai][bj][m][0], v2 = acc[ai][bj][m][1]; float o[8];
#pragma unroll
                for (int j = 0; j < 4; ++j) { o[j] = (s + j <= i) ? v[j] * fexp2(-(float)(s + j + 1) * l2g) : 0.f; o[4 + j] = (s + 4 + j <= i) ? v2[j] * fexp2(-(float)(s + 4 + j + 1) * l2g) : 0.f; }
                *(u32x4*)(rp + s) = (u32x4){pk_bf16(o[0], o[1]), pk_bf16(o[2], o[3]), pk_bf16(o[4], o[5]), pk_bf16(o[6], o[7])}; } }
    }
};
struct ProbOut {
    static constexpr bool PERM = true;
    const char* Q; const char* ST; long dA, dB; bf16_t* Y; int nt;
    __device__ __forceinline__ long nunits() const { return 8 * 64 * 2; }
    __device__ __forceinline__ unsigned rowA(int R) const { return (unsigned)R * 4096u; }
    static constexpr unsigned ldb = 32768u;
    __device__ __forceinline__ void unit(long L, UInfo& u) const { const int pn = (int)L & 1, c = ((int)L >> 1) & 63, h = (int)L >> 7;
        u.a = Q + ((size_t)(c * 256) * 2048 + h * 256) * 2; u.b = ST + ((size_t)(h * 512 + pn * 256) * S_ + c * 256) * 2; u.r0 = c * 256; u.c0 = h * 512 + pn * 256; u.x0 = h; u.x1 = 0; }
    __device__ __forceinline__ size_t aK(int kt) const { return kt < 4 ? (size_t)kt * 128 : (size_t)(dA + (long)(kt - 4) * 128); }
    __device__ __forceinline__ size_t bK(int kt) const { return kt < 4 ? (size_t)kt * 128 : (size_t)(dB + (long)(kt - 4) * 128); }
    __device__ __forceinline__ void epi(const AccT& acc, const UInfo& u, int wr, int wc, int fr, int fq) const {
        const float l2g = log2gamma(u.x0);
#pragma unroll
        EPI_ROWS { const int i = EPI_ROW; const float qd = fexp2((float)(i + 1) * l2g); bf16_t* rp = Y + (size_t)(u.r0 + i) * 4096 + u.c0;
#pragma unroll
            for (int bj = 0; bj < 2; ++bj) { const f32x4 v = acc[ai][bj][m][0] * qd, v2 = acc[ai][bj][m][1] * qd; *(u32x4*)(rp + 128 * bj + 32 * wc + 8 * fq) = (u32x4){pk_bf16(v[0], v[1]), pk_bf16(v[2], v[3]), pk_bf16(v2[0], v2[1]), pk_bf16(v2[2], v2[3])}; } }
    }
};

__device__ __forceinline__ void transpose_job(const float* __restrict__ src, bf16_t* __restrict__ dst, int K, int N, int Npad, int kvperm, LAS float* tile, const float* gain = nullptr) {
    const int tk = K / 64, tn = Npad / 256, ntile = tk * tn; const int tid = ltid();
    for (int t = blockIdx.x; t < ntile; t += gridDim.x) {
        const int k0 = (t % tk) * 64, n0 = (t / tk) * 256;
        { const int r0 = tid >> 6, cc = tid & 63; float v[8][4];
#pragma unroll
          for (int i = 0; i < 8; ++i)
#pragma unroll
              for (int q = 0; q < 4; ++q) { const int n = n0 + cc + 64 * q; v[i][q] = (n < N) ? src[(size_t)(k0 + r0 + 8 * i) * N + n] : 0.f; }
#pragma unroll
          for (int i = 0; i < 8; ++i) { const float gk = gain ? gain[k0 + r0 + 8 * i] : 1.0f;
#pragma unroll
              for (int q = 0; q < 4; ++q) tile[(r0 + 8 * i) * 257 + cc + 64 * q] = v[i][q] * gk; } }
        __syncthreads();
        { const int rr = tid >> 1, c0 = (tid & 1) * 32;
          int n = n0 + rr; if (kvperm) { const int j = n >> 9; const int jp = (j == 3) ? 4 : ((j == 4) ? 3 : j); n = jp * 512 + (n & 511); }
          bf16_t* dp = dst + (size_t)n * K + k0 + c0;
#pragma unroll
          for (int g = 0; g < 4; ++g) { float x[8];
#pragma unroll
              for (int j = 0; j < 8; ++j) x[j] = tile[(c0 + 8 * g + j) * 257 + rr];
              *(u32x4*)(dp + 8 * g) = (u32x4){pk_bf16(x[0], x[1]), pk_bf16(x[2], x[3]), pk_bf16(x[4], x[5]), pk_bf16(x[6], x[7])}; } }
        __syncthreads();
    }
}
__device__ __forceinline__ void prep_phase(CP p, LAS unsigned char* lds) {
    LAS float* tile = (LAS float*)lds; unsigned char* ws = p->ws;
    transpose_job(p->ret_w_in, (bf16_t*)(ws + OFF_W_RIN), 2048, 12288, 12288, 0, tile);
    transpose_job(p->ret_w_out, (bf16_t*)(ws + OFF_W_ROUT), 4096, 2048, 2048, 0, tile);
    transpose_job(p->w_kv, (bf16_t*)(ws + OFF_W_KV), 2048, 3072, 3072, 1, tile, p->kv_gain);
    transpose_job(p->w1_k, (bf16_t*)(ws + OFF_W_C1K), 4096, 256, 256, 0, tile);
    transpose_job(p->w1_v, (bf16_t*)(ws + OFF_W_C1V), 4096, 256, 256, 0, tile);
    transpose_job(p->w2_k, (bf16_t*)(ws + OFF_W_C2K), 256, 128, 256, 0, tile);
    transpose_job(p->w2_v, (bf16_t*)(ws + OFF_W_C2V), 256, 128, 256, 0, tile);
    transpose_job(p->w_q, (bf16_t*)(ws + OFF_W_Q), 2048, 2096, 2304, 0, tile, p->norm_mix + 2048);
    transpose_job(p->w_o, (bf16_t*)(ws + OFF_W_O), 2048, 2048, 2048, 0, tile);
    transpose_job(p->ffn_w_in, (bf16_t*)(ws + OFF_W_FIN), 2048, 8192, 8192, 0, tile, p->norm_ffn);
    transpose_job(p->ffn_w_in + (size_t)2048 * 8192, (bf16_t*)(ws + OFF_W_FIN + 32 * MiB), 2048, 8192, 8192, 0, tile, p->norm_ffn + 2048);
    transpose_job(p->ffn_w_out, (bf16_t*)(ws + OFF_W_FOUT), 4096, 2048, 2048, 0, tile);
    transpose_job(p->ffn_w_out + (size_t)4096 * 2048, (bf16_t*)(ws + OFF_W_FOUT + 16 * MiB), 4096, 2048, 2048, 0, tile);
    { float* ss = (float*)(ws + OFF_SS); for (int i = blockIdx.x * 512 + ltid(); i < 8 * S_; i += gridDim.x * 512) ss[i] = 0.f; }
    { float2* rope = (float2*)(ws + OFF_ROPE); const int gsz = gridDim.x * 512;
      for (int i = blockIdx.x * 512 + ltid(); i < S_ * 128; i += gsz) { const int t = i >> 7, dd = i & 127;
          const float freq = exp2f(-(float)dd * (13.287712379549449f / 128.0f)); const double rev = (double)t * (double)freq * 0.15915494309189535;
          const float fx = (float)(rev - rint(rev)); rope[i] = make_float2(__builtin_amdgcn_cosf(fx), __builtin_amdgcn_sinf(fx)); } }
    if (blockIdx.x < 128) { const int kv = blockIdx.x >> 6, oc = blockIdx.x & 63; const float* pe = kv ? p->pe_v : p->pe_k; const float* w1 = kv ? p->w1_v : p->w1_k; float* peb = (float*)(ws + OFF_PEB) + kv * 256;
        const int tid = ltid(), g = tid >> 7, r = tid & 127, n = 4 * oc + g; float s = 0.f;
#pragma unroll 8
        for (int j = 0; j < 32; ++j) { const int k = r + 128 * j; s += pe[k] * w1[(size_t)k * 256 + n]; }
        s = wave_sum(s, tid & 63);
        __syncthreads(); if ((tid & 63) == 0) tile[tid >> 6] = s; __syncthreads();
        if (tid < 4) peb[4 * oc + tid] = tile[2 * tid] + tile[2 * tid + 1];
        __syncthreads(); }
}
__device__ __forceinline__ void rmsnorm_phase(const float* h, const float* g1, bf16_t* o1, const float* g2, bf16_t* o2) {
    const int w = ltid() >> 6, lane = ltid() & 63;
    for (int row = blockIdx.x * 8 + w; row < S_; row += gridDim.x * 8) {
        const f32x4* p = (const f32x4*)(h + (size_t)row * 2048); f32x4 v[8]; float ss = 0.f;
#pragma unroll
        for (int i = 0; i < 8; ++i) { v[i] = p[lane + 64 * i]; ss += v[i][0] * v[i][0] + v[i][1] * v[i][1] + v[i][2] * v[i][2] + v[i][3] * v[i][3]; }
        ss = wave_sum(ss, lane); const float r = rsqrtf(ss * (1.0f / 2048.0f) + 1e-6f);
#pragma unroll
        for (int i = 0; i < 8; ++i) { const int col = (lane + 64 * i) * 4; const f32x4 g = *(const f32x4*)(g1 + col);
            *(u32x2*)(o1 + (size_t)row * 2048 + col) = (u32x2){pk_bf16(v[i][0] * r * g[0], v[i][1] * r * g[1]), pk_bf16(v[i][2] * r * g[2], v[i][3] * r * g[3])};
            if (o2) { const f32x4 gg = *(const f32x4*)(g2 + col);
                *(u32x2*)(o2 + (size_t)row * 2048 + col) = (u32x2){pk_bf16(v[i][0] * r * gg[0], v[i][1] * r * gg[1]), pk_bf16(v[i][2] * r * gg[2], v[i][3] * r * gg[3])}; } }
    }
}
__device__ __forceinline__ void finalnorm_phase(float* h, const float* g1) {
    const int w = ltid() >> 6, lane = ltid() & 63;
    for (int row = blockIdx.x * 8 + w; row < S_; row += gridDim.x * 8) {
        f32x4* p = (f32x4*)(h + (size_t)row * 2048); f32x4 v[8]; float ss = 0.f;
#pragma unroll
        for (int i = 0; i < 8; ++i) { v[i] = p[lane + 64 * i]; ss += v[i][0] * v[i][0] + v[i][1] * v[i][1] + v[i][2] * v[i][2] + v[i][3] * v[i][3]; }
        ss = wave_sum(ss, lane); const float r = rsqrtf(ss * (1.0f / 2048.0f) + 1e-6f);
#pragma unroll
        for (int i = 0; i < 8; ++i) { const f32x4 g = *(const f32x4*)(g1 + (lane + 64 * i) * 4); p[lane + 64 * i] = v[i] * r * g; }
    }
}
__device__ __forceinline__ void scan_phase(bf16_t* ST) {
    for (int it = blockIdx.x * 512 + ltid(); it < 4096 * 32; it += gridDim.x * 512) {
        const int r = it >> 5, d8 = it & 31; const float cd = fexp2(256.0f * log2gamma(r >> 9));
        bf16_t* p = ST + (size_t)r * S_ + d8 * 8; float s[8];
#pragma unroll
        for (int j = 0; j < 8; ++j) s[j] = 0.f;
        for (int c = 0; c < 64; ++c) { const u32x4 v = *(const u32x4*)(p + c * 256);
            *(u32x4*)(p + c * 256) = (u32x4){pk_bf16(s[0], s[1]), pk_bf16(s[2], s[3]), pk_bf16(s[4], s[5]), pk_bf16(s[6], s[7])};
#pragma unroll
            for (int j = 0; j < 4; ++j) { s[2 * j] = s[2 * j] * cd + bflo(v[j]); s[2 * j + 1] = s[2 * j + 1] * cd + bfhi(v[j]); } }
    }
}
__device__ __forceinline__ void gn_phase(const bf16_t* Y, float2* gns) {
    const int w = ltid() >> 6, lane = ltid() & 63;
    for (int g = blockIdx.x * 8 + w; g < S_ * 8; g += gridDim.x * 8) {
        const u32x4 v = *(const u32x4*)(Y + (size_t)g * 512 + lane * 8); float x[8];
#pragma unroll
        for (int j = 0; j < 4; ++j) { x[2 * j] = bflo(v[j]); x[2 * j + 1] = bfhi(v[j]); }
        float s = 0.f;
#pragma unroll
        for (int j = 0; j < 8; ++j) s += x[j];
        const float mu = wave_sum(s, lane) * (1.0f / 512.0f); float q = 0.f;
#pragma unroll
        for (int j = 0; j < 8; ++j) { x[j] -= mu; q += x[j] * x[j]; }
        const float r = rsqrtf(wave_sum(q, lane) * (1.0f / 512.0f) + 1e-6f);
        if (lane == 0) gns[g] = make_float2(mu, r);
    }
}
__device__ __forceinline__ void conv_phase(const bf16_t* U, bf16_t* AB, const float* cw, const float* cb) {
    for (int it = blockIdx.x * 512 + ltid(); it < 512 * 512; it += gridDim.x * 512) {
        const int n8 = (it & 511) * 8, t0 = (it >> 9) * 32;
        float wa[3][8], wb[3][8], ba[8], bb[8];
#pragma unroll
        for (int tp = 0; tp < 3; ++tp)
#pragma unroll
            for (int j = 0; j < 8; ++j) { wa[tp][j] = cw[tp * 8192 + n8 + j]; wb[tp][j] = cw[tp * 8192 + 4096 + n8 + j]; }
#pragma unroll
        for (int j = 0; j < 8; ++j) { ba[j] = cb[n8 + j]; bb[j] = cb[4096 + n8 + j]; }
        float pa[2][8], pb[2][8];
#pragma unroll
        for (int k = 0; k < 2; ++k) { const int t = t0 - 2 + k; u32x4 va = (u32x4){0, 0, 0, 0}, vb = (u32x4){0, 0, 0, 0};
            if (t >= 0) { va = *(const u32x4*)(U + (size_t)t * 8192 + n8); vb = *(const u32x4*)(U + (size_t)t * 8192 + 4096 + n8); }
#pragma unroll
            for (int j = 0; j < 4; ++j) { pa[k][2 * j] = bflo(va[j]); pa[k][2 * j + 1] = bfhi(va[j]); pb[k][2 * j] = bflo(vb[j]); pb[k][2 * j + 1] = bfhi(vb[j]); } }
#pragma unroll 8
        for (int k = 0; k < 32; ++k) { const int t = t0 + k; const u32x4 va = *(const u32x4*)(U + (size_t)t * 8192 + n8), vb = *(const u32x4*)(U + (size_t)t * 8192 + 4096 + n8);
            float xa[8], xb[8], o[8];
#pragma unroll
            for (int j = 0; j < 4; ++j) { xa[2 * j] = bflo(va[j]); xa[2 * j + 1] = bfhi(va[j]); xb[2 * j] = bflo(vb[j]); xb[2 * j + 1] = bfhi(vb[j]); }
#pragma unroll
            for (int j = 0; j < 8; ++j) { const float a = ba[j] + wa[0][j] * pa[0][j] + wa[1][j] * pa[1][j] + wa[2][j] * xa[j]; const float b = bb[j] + wb[0][j] * pb[0][j] + wb[1][j] * pb[1][j] + wb[2][j] * xb[j];
                o[j] = a * sigmoidf_(a) * b; pa[0][j] = pa[1][j]; pa[1][j] = xa[j]; pb[0][j] = pb[1][j]; pb[1][j] = xb[j]; }
            *(u32x4*)(AB + (size_t)t * 4096 + n8) = (u32x4){pk_bf16(o[0], o[1]), pk_bf16(o[2], o[3]), pk_bf16(o[4], o[5]), pk_bf16(o[6], o[7])}; }
    }
}

constexpr int XCD_CTR_WORD = 3456;
constexpr int A_KT = 0, A_VT = 17408, A_BUFSZ = 34816, A_PSL = 69632, A_SEL = 4 * A_BUFSZ, LDS_ST = A_SEL + 2048;
constexpr float LOG2E = 1.4426950408889634f;
struct AttnState { f32x4 ot[8][2]; float m[2], l[2]; };

template <int MODE>
__device__ __forceinline__ void attn_compute(LAS unsigned char* lds, int boff, int tile, const bf16x8 (&qf)[2][4], AttnState& st, const int (&tpos)[2], int qb, int w, int lane,
                                             const float (&mfin)[2], const float (&linv)[2], bool rs0, bool rs1, bool masked, bool a0, bool a1) {
    const int l16 = lane & 15, g4 = lane >> 4;
    f32x4 s[4][2];
#pragma unroll
    for (int mt = 0; mt < 4; ++mt) { s[mt][0] = (f32x4){0.f, 0.f, 0.f, 0.f}; s[mt][1] = (f32x4){0.f, 0.f, 0.f, 0.f}; }
#pragma unroll
    for (int ks = 0; ks < 4; ++ks) {
        bf16x8 kf[4];
#pragma unroll
        for (int mt = 0; mt < 4; ++mt) kf[mt] = *(const LAS bf16x8*)(lds + boff + A_KT + (16 * mt + l16) * 272 + ks * 64 + g4 * 16);
        if (a0) {
#pragma unroll
            for (int mt = 0; mt < 4; ++mt) s[mt][0] = __builtin_amdgcn_mfma_f32_16x16x32_bf16(kf[mt], qf[0][ks], s[mt][0], 0, 0, 0);
        }
        if (a1) {
#pragma unroll
            for (int mt = 0; mt < 4; ++mt) s[mt][1] = __builtin_amdgcn_mfma_f32_16x16x32_bf16(kf[mt], qf[1][ks], s[mt][1], 0, 0, 0);
        }
    }
    if (masked) {
#pragma unroll
        for (int nt = 0; nt < 2; ++nt) { const int t = tpos[nt]; const int tl = w * 8 + nt * 4 + (l16 >> 2);
#pragma unroll
            for (int mt = 0; mt < 4; ++mt)
#pragma unroll
                for (int j = 0; j < 4; ++j) { const int kl = 16 * mt + 4 * g4 + j; const int key = tile * 64 + kl; bool v;
                    if (MODE == 0 || MODE == 1) v = key <= ((t - 31) >> 4);
                    else if (MODE == 2) v = (kl <= tl);
                    else v = (key <= t) && (key > t - 512);
                    s[mt][nt][j] = v ? s[mt][nt][j] : -__builtin_inff(); } }
    }
    bf16x8 pf[2][2];
#pragma unroll
    for (int nt = 0; nt < 2; ++nt) {
        if (nt ? a1 : a0) {
            const bool rowsel = nt ? rs1 : rs0;
            const float bias = (MODE == 2 && !rowsel) ? -__builtin_inff() : 0.f;
            float mx = -1e30f;
#pragma unroll
            for (int mt = 0; mt < 4; ++mt)
#pragma unroll
                for (int j = 0; j < 4; ++j) {
                    const float sv = s[mt][nt][j] * LOG2E + bias;
                    s[mt][nt][j] = sv; mx = fmaxf(mx, sv); }
            float mnew, alpha = 1.f;
            if (MODE == 1) mnew = mfin[nt];
            else { mx = fmaxf(mx, shx(mx, 16, lane)); mx = fmaxf(mx, shx(mx, 32, lane)); mnew = fmaxf(st.m[nt], mx); alpha = fexp2(st.m[nt] - mnew); st.m[nt] = mnew; }
            float ps = 0.f;
#pragma unroll
            for (int mt = 0; mt < 4; ++mt)
#pragma unroll
                for (int j = 0; j < 4; ++j) { float pv = fexp2(s[mt][nt][j] - mnew); if (MODE == 1) pv *= linv[nt]; s[mt][nt][j] = pv; ps += pv; }
            if (MODE != 1) st.l[nt] = st.l[nt] * alpha + ps;
            if (MODE == 2 || MODE == 3) {
#pragma unroll
                for (int md = 0; md < 8; ++md) st.ot[md][nt] = st.ot[md][nt] * alpha;
            }
            if (MODE == 1) {
#pragma unroll
                for (int mt = 0; mt < 4; ++mt) { float a = s[mt][nt][0] + s[mt][nt][1] + s[mt][nt][2] + s[mt][nt][3], lst = s[mt][nt][3];
                    a += shx(a, 1, lane); a += shx(a, 2, lane); lst += shx(lst, 1, lane); lst += shx(lst, 2, lane);
                    if ((l16 & 3) == 0) { const int jb = tile * 16 + 4 * mt + g4; LAS float* pp = (LAS float*)(lds + A_PSL) + (w * 8 + nt * 4 + (l16 >> 2)) * 256;
                        atomicAdd((float*)(pp + jb), a); if (jb + 1 < 256) atomicAdd((float*)(pp + jb + 1), lst); } }
            }
            if (MODE != 0) {
#pragma unroll
                for (int kk = 0; kk < 2; ++kk) { const u32x4 pk = (u32x4){pk_bf16(s[2 * kk][nt][0], s[2 * kk][nt][1]), pk_bf16(s[2 * kk][nt][2], s[2 * kk][nt][3]), pk_bf16(s[2 * kk + 1][nt][0], s[2 * kk + 1][nt][1]), pk_bf16(s[2 * kk + 1][nt][2], s[2 * kk + 1][nt][3])};
                    pf[nt][kk] = __builtin_bit_cast(bf16x8, pk); }
            }
        } else { pf[nt][0] = (bf16x8){0, 0, 0, 0, 0, 0, 0, 0}; pf[nt][1] = (bf16x8){0, 0, 0, 0, 0, 0, 0, 0}; }
    }
    if (MODE != 0) {
#pragma unroll
        for (int kk = 0; kk < 2; ++kk)
#pragma unroll
            for (int mg = 0; mg < 2; ++mg) {
                bf16x8 vf[4];
#pragma unroll
                for (int q = 0; q < 4; ++q) { const LAS unsigned char* vb = lds + boff + A_VT + (16 * (4 * mg + q) + l16) * 136 + kk * 64 + g4 * 8;
                    const u32x2 v0 = *(const LAS u32x2*)vb, v1 = *(const LAS u32x2*)(vb + 32); vf[q] = __builtin_bit_cast(bf16x8, ((u32x4){v0[0], v0[1], v1[0], v1[1]})); }
                if (a0) {
#pragma unroll
                    for (int q = 0; q < 4; ++q) st.ot[4 * mg + q][0] = __builtin_amdgcn_mfma_f32_16x16x32_bf16(vf[q], pf[0][kk], st.ot[4 * mg + q][0], 0, 0, 0);
                }
                if (a1) {
#pragma unroll
                    for (int q = 0; q < 4; ++q) st.ot[4 * mg + q][1] = __builtin_amdgcn_mfma_f32_16x16x32_bf16(vf[q], pf[1][kk], st.ot[4 * mg + q][1], 0, 0, 0);
                }
            }
    }
}
template <int MODE>
__device__ __forceinline__ void attn_tiles(LAS unsigned char* lds, const bf16_t* kp, size_t kstride, const bf16_t* vp, size_t vstride, int tile_lo, int tile_hi,
                                           const bf16x8 (&qf)[2][4], AttnState& st, const int (&tpos)[2], int qb, int w, int lane, const float (&mfin)[2], const float (&linv)[2]) {
    if (tile_lo >= tile_hi) return;
    int tid = w * 64 + lane; asm volatile("" : "+v"(tid)); const int l16 = lane & 15;
    const int krow = tid >> 3, kc = (tid & 7) * 16, vrow = tid >> 2, vc = (tid & 3) * 16;
    u32x4 kr0, kr1, vr0 = (u32x4){0, 0, 0, 0}, vr1 = (u32x4){0, 0, 0, 0};
#define A_LOAD(T) do { const bf16_t* kg = kp + (size_t)((T) * 64 + krow) * kstride + kc; kr0 = *(const u32x4*)kg; kr1 = *(const u32x4*)(kg + 8); \
        if (MODE != 0) { const bf16_t* vg = vp + (size_t)vrow * vstride + (T) * 64 + vc; vr0 = *(const u32x4*)vg; vr1 = *(const u32x4*)(vg + 8); } } while (0)
#define A_WRITE(BO) do { LAS unsigned char* kd = lds + (BO) + A_KT + krow * 272 + kc * 2; *(LAS u32x4*)kd = kr0; *(LAS u32x4*)(kd + 16) = kr1; \
        if (MODE != 0) { LAS unsigned char* vd = lds + (BO) + A_VT + vrow * 136 + vc * 2; *(LAS u32x2*)vd = (u32x2){vr0[0], vr0[1]}; *(LAS u32x2*)(vd + 8) = (u32x2){vr0[2], vr0[3]}; *(LAS u32x2*)(vd + 16) = (u32x2){vr1[0], vr1[1]}; *(LAS u32x2*)(vd + 24) = (u32x2){vr1[2], vr1[3]}; } } while (0)
    A_LOAD(tile_lo);
    __syncthreads();
    A_WRITE(0);
    if (tile_lo + 1 < tile_hi) A_LOAD(tile_lo + 1);
    __syncthreads();
    unsigned selw0 = 0u, selw1 = 0u;
    for (int tile = tile_lo; tile < tile_hi; ++tile) {
        const int boff = ((tile - tile_lo) & 1) * A_BUFSZ;
        if (MODE == 2 && (tile == tile_lo || (tile & 31) == 0)) { const int tw = tile >> 5;
            selw0 = *(const LAS unsigned*)(lds + A_SEL + ((w * 8 + (l16 >> 2)) * 8 + tw) * 4); selw1 = *(const LAS unsigned*)(lds + A_SEL + ((w * 8 + 4 + (l16 >> 2)) * 8 + tw) * 4); }
        if (tile + 1 < tile_hi) { A_WRITE(boff ^ A_BUFSZ); if (tile + 2 < tile_hi) A_LOAD(tile + 2); }
        bool rs0 = true, rs1 = true, active = true;
        if (MODE == 2) { const unsigned bit = 1u << (tile & 31);
            rs0 = (selw0 & bit) != 0u; rs1 = (selw1 & bit) != 0u; active = __ballot(rs0 || rs1) != 0ull; }
        if (active) {
            bool masked;
            if (MODE == 0 || MODE == 1) masked = (tile * 64 + 63 > 4 * qb - 2);
            else if (MODE == 2) masked = (tile == qb);
            else masked = (tile == qb) || (tile <= qb - 8);
            const bool a0 = (MODE != 2) || (__ballot(rs0) != 0ull), a1 = (MODE != 2) || (__ballot(rs1) != 0ull);
            attn_compute<MODE>(lds, boff, tile, qf, st, tpos, qb, w, lane, mfin, linv, rs0, rs1, masked, a0, a1);
        }
        __syncthreads();
    }
#undef A_LOAD
#undef A_WRITE
}
__device__ __forceinline__ void attn_tiles_slc2(LAS unsigned char* lds, const bf16_t* kp, size_t kstride, const bf16_t* vp, size_t vstride, int n,
                                                const bf16x8 (&qf)[2][4], AttnState& st, const int (&tpos)[2], int qb, int w, int lane, const float (&mfin)[2], const float (&linv)[2]) {
    int tid = w * 64 + lane; asm volatile("" : "+v"(tid)); const int l16 = lane & 15;
    const int krow = tid >> 3, kc = (tid & 7) * 16, vrow = tid >> 2, vc = (tid & 3) * 16;
    const int nst = (n + 1) >> 1; constexpr int STG = 2 * A_BUFSZ;
    u32x4 kX0, kX1, vX0, vX1, kY0 = (u32x4){0, 0, 0, 0}, kY1 = (u32x4){0, 0, 0, 0}, vY0 = (u32x4){0, 0, 0, 0}, vY1 = (u32x4){0, 0, 0, 0};
#define S_LOAD1(T, S) do { const bf16_t* kg = kp + (size_t)((T) * 64 + krow) * kstride + kc; k##S##0 = *(const u32x4*)kg; k##S##1 = *(const u32x4*)(kg + 8); \
        const bf16_t* vg = vp + (size_t)vrow * vstride + (T) * 64 + vc; v##S##0 = *(const u32x4*)vg; v##S##1 = *(const u32x4*)(vg + 8); } while (0)
#define S_WRITE1(BO, S) do { LAS unsigned char* kd = lds + (BO) + A_KT + krow * 272 + kc * 2; *(LAS u32x4*)kd = k##S##0; *(LAS u32x4*)(kd + 16) = k##S##1; \
        LAS unsigned char* vd = lds + (BO) + A_VT + vrow * 136 + vc * 2; *(LAS u32x2*)vd = (u32x2){v##S##0[0], v##S##0[1]}; *(LAS u32x2*)(vd + 8) = (u32x2){v##S##0[2], v##S##0[3]}; *(LAS u32x2*)(vd + 16) = (u32x2){v##S##1[0], v##S##1[1]}; *(LAS u32x2*)(vd + 24) = (u32x2){v##S##1[2], v##S##1[3]}; } while (0)
#define S_LOADS(SG) do { S_LOAD1(2 * (SG), X); if (2 * (SG) + 1 < n) S_LOAD1(2 * (SG) + 1, Y); } while (0)
#define S_WRITES(SG, BASE) do { S_WRITE1((BASE), X); if (2 * (SG) + 1 < n) S_WRITE1((BASE) + A_BUFSZ, Y); } while (0)
    S_LOADS(0);
    __syncthreads();
    S_WRITES(0, 0);
    if (nst > 1) S_LOADS(1);
    __syncthreads();
    unsigned selw0 = 0u, selw1 = 0u;
    for (int s = 0; s < nst; ++s) {
        const int base = (s & 1) * STG;
        if ((s & 15) == 0) { const int tw = s >> 4;
            selw0 = *(const LAS unsigned*)(lds + A_SEL + ((w * 8 + (l16 >> 2)) * 8 + tw) * 4); selw1 = *(const LAS unsigned*)(lds + A_SEL + ((w * 8 + 4 + (l16 >> 2)) * 8 + tw) * 4); }
        if (s + 1 < nst) { S_WRITES(s + 1, base ^ STG); if (s + 2 < nst) S_LOADS(s + 2); }
#pragma unroll
        for (int hf = 0; hf < 2; ++hf) {
            const int tile = 2 * s + hf;
            if (tile < n) {
                const unsigned bit = 1u << (tile & 31);
                const bool rs0 = (selw0 & bit) != 0u, rs1 = (selw1 & bit) != 0u;
                const bool a0 = __ballot(rs0) != 0ull, a1 = __ballot(rs1) != 0ull;
                if (a0 || a1) attn_compute<2>(lds, base + hf * A_BUFSZ, tile, qf, st, tpos, qb, w, lane, mfin, linv, rs0, rs1, tile == qb, a0, a1);
            }
        }
        asm volatile("s_waitcnt lgkmcnt(0)" ::: "memory"); __builtin_amdgcn_s_barrier(); asm volatile("" ::: "memory");
    }
    __syncthreads();
#undef S_LOAD1
#undef S_WRITE1
#undef S_LOADS
#undef S_WRITES
}
template <int BR>
__device__ __forceinline__ void attn_finish(AttnState& st, const float* gates, float* oacc, bf16_t* att, const int (&tpos)[2], int hkv, int lane) {
    const int l16 = lane & 15, g4 = lane >> 4, g = l16 & 3;
#pragma unroll
    for (int nt = 0; nt < 2; ++nt) {
        const int t = tpos[nt]; float sc = gates[(size_t)t * 48 + (hkv * 4 + g) * 3 + BR];
        if (BR != 0) { float l = st.l[nt]; l += shx(l, 16, lane); l += shx(l, 32, lane); sc = (l > 0.f) ? sc / l : 0.f; }
        const size_t base = (size_t)t * 2048 + (hkv * 4 + g) * 128 + 4 * g4;
#pragma unroll
        for (int md = 0; md < 8; ++md) { f32x4 v = st.ot[md][nt] * sc; float* op = oacc + base + 16 * md;
            if (BR == 0) *(f32x4*)op = v;
            else if (BR == 1) *(f32x4*)op = *(const f32x4*)op + v;
            else { v = v + *(const f32x4*)op; *(u32x2*)(att + base + 16 * md) = (u32x2){pk_bf16(v[0], v[1]), pk_bf16(v[2], v[3])}; } }
    }
}
__device__ __forceinline__ void attn_reset(AttnState& st) {
#pragma unroll
    for (int md = 0; md < 8; ++md) { st.ot[md][0] = (f32x4){0.f, 0.f, 0.f, 0.f}; st.ot[md][1] = (f32x4){0.f, 0.f, 0.f, 0.f}; }
    st.m[0] = st.m[1] = -1e30f; st.l[0] = st.l[1] = 0.f;
}
__device__ __forceinline__ void attn_item(unsigned char* ws, LAS unsigned char* lds, int hkv, int qb) {
    int tid = ltid(); asm volatile("" : "+v"(tid)); const int w = tid >> 6, lane = tid & 63, l16 = lane & 15, g4 = lane >> 4;
    const bf16_t* QB = (const bf16_t*)(ws + OFF_QB); const bf16_t* KVTOK = (const bf16_t*)(ws + OFF_KVTOK); const bf16_t* KVT = (const bf16_t*)(ws + OFF_KVT);
    const bf16_t* KC = (const bf16_t*)(ws + OFF_KCMP); const bf16_t* VC = (const bf16_t*)(ws + OFF_VCMPT);
    const float* gates = (const float*)(ws + OFF_GATES); float* oacc = (float*)(ws + OFF_OACC); bf16_t* att = (bf16_t*)(ws + OFF_ATT);
    int tpos[2]; bf16x8 qf[2][4];
#pragma unroll
    for (int nt = 0; nt < 2; ++nt) { tpos[nt] = qb * 64 + w * 8 + nt * 4 + (l16 >> 2); const bf16_t* qp = QB + (size_t)tpos[nt] * 2048 + (hkv * 4 + (l16 & 3)) * 128 + g4 * 8;
#pragma unroll
        for (int ks = 0; ks < 4; ++ks) qf[nt][ks] = *(const bf16x8*)(qp + ks * 32); }
    __syncthreads();
    { LAS float* pp = (LAS float*)(lds + A_PSL) + w * 2048;
#pragma unroll
      for (int i = 0; i < 32; ++i) pp[lane + 64 * i] = 0.f; }
    AttnState st; float mfin[2] = {0.f, 0.f}, linv[2] = {0.f, 0.f};
    const int ncmp_tiles = (4 * qb + 3 + 63) >> 6;
    attn_reset(st);
    attn_tiles<0>(lds, KC + (size_t)hkv * 1024 * 128, 128, VC, 1024, 0, ncmp_tiles, qf, st, tpos, qb, w, lane, mfin, linv);
#pragma unroll
    for (int nt = 0; nt < 2; ++nt) { float l = st.l[nt]; l += shx(l, 16, lane); l += shx(l, 32, lane); mfin[nt] = st.m[nt]; linv[nt] = (l > 0.f) ? 1.0f / l : 0.f; }
    attn_reset(st);
    attn_tiles<1>(lds, KC + (size_t)hkv * 1024 * 128, 128, VC + (size_t)hkv * 128 * 1024, 1024, 0, ncmp_tiles, qf, st, tpos, qb, w, lane, mfin, linv);
    attn_finish<0>(st, gates, oacc, att, tpos, hkv, lane);
    __syncthreads();
    {
        LAS unsigned* sel = (LAS unsigned*)(lds + A_SEL) + w * 64;
        if (qb < 16) {
            if (lane < 8) { for (int tk = 0; tk < 8; ++tk) { const int lo = lane * 32; unsigned wd = 0; if (qb >= lo + 31) wd = 0xffffffffu; else if (qb >= lo) wd = (2u << (qb - lo)) - 1u; sel[tk * 8 + lane] = wd; } }
        } else {
            for (int tk = 0; tk < 8; ++tk) {
                const LAS float* pp = (const LAS float*)(lds + A_PSL) + (w * 8 + tk) * 256;
                unsigned key[4]; bool forced[4];
#pragma unroll
                for (int i = 0; i < 4; ++i) { const int j = lane + 64 * i; const float sc = pp[j]; const bool elig = (j >= 1) && (j <= qb - 2);
                    forced[i] = (j == 0) || (j == qb) || (j == qb - 1); key[i] = elig ? (__float_as_uint(sc) + 1u) : 0u; }
                unsigned prefix = 0u;
                for (int bit = 30; bit >= 0; --bit) { const unsigned cand = prefix | (1u << bit); int cnt = 0;
#pragma unroll
                    for (int i = 0; i < 4; ++i) cnt += __popcll(__ballot(key[i] >= cand));
                    if (cnt >= 13) prefix = cand; }
                int cgt = 0;
#pragma unroll
                for (int i = 0; i < 4; ++i) cgt += __popcll(__ballot(key[i] > prefix));
                const int need = 13 - cgt; int base = 0;
#pragma unroll
                for (int i = 0; i < 4; ++i) { const unsigned long long eqm = __ballot(key[i] == prefix);
                    const int rank = base + (int)__builtin_amdgcn_mbcnt_hi((unsigned)(eqm >> 32), __builtin_amdgcn_mbcnt_lo((unsigned)eqm, 0u));
                    const bool taken = forced[i] || (key[i] > prefix) || (key[i] == prefix && rank < need);
                    const unsigned long long bal = __ballot(taken); if (lane == 0) { sel[tk * 8 + 2 * i] = (unsigned)bal; sel[tk * 8 + 2 * i + 1] = (unsigned)(bal >> 32); }
                    base += __popcll(eqm); }
            }
        }
    }
    __syncthreads();
    attn_reset(st);
    attn_tiles_slc2(lds, KVTOK + 2 * 512 + hkv * 128, 2048, KVT + (size_t)(hkv * 128) * S_, S_, qb + 1, qf, st, tpos, qb, w, lane, mfin, linv);
    attn_finish<1>(st, gates, oacc, att, tpos, hkv, lane);
    attn_reset(st);
    attn_tiles<3>(lds, KVTOK + 3 * 512 + hkv * 128, 2048, KVT + (size_t)(512 + hkv * 128) * S_, S_, (qb - 8) > 0 ? (qb - 8) : 0, qb + 1, qf, st, tpos, qb, w, lane, mfin, linv);
    attn_finish<2>(st, gates, oacc, att, tpos, hkv, lane);
}
__device__ __forceinline__ void attn_phase(unsigned char* ws, LAS unsigned char* lds, int b) {
    unsigned* ctr = (unsigned*)(ws + OFF_BAR) + XCD_CTR_WORD + 64 * b;
    volatile LAS int* slot = (volatile LAS int*)(lds + LDS_ST + 8);
#pragma nounroll
    for (;;) {
        __syncthreads();
        if (threadIdx.x == 0) *slot = (int)__hip_atomic_fetch_add(ctr, 1u, __ATOMIC_RELAXED, __HIP_MEMORY_SCOPE_AGENT);
        __syncthreads();
        const int it = *slot;
        if (it >= 1024) break;
        attn_item(ws, lds, it & 3, 255 - (it >> 2));
    }
}

#define XB_TMO      128
#define XB_XCNT(j)  (256  + 64 * (j))
#define XB_XSUB(j)  (1280 + 64 * (j))
#define XB_XGEN(j)  (2304 + 64 * (j))
#define XB_TOP      3328
#define XB_TOPGEN   3392
#define XCD_BAR_WORDS 3456
#define XB_SPIN_CAP (1u << 22)
__device__ __forceinline__ unsigned xb_ld(unsigned* p)              { return __hip_atomic_load(p, __ATOMIC_RELAXED, __HIP_MEMORY_SCOPE_AGENT); }
__device__ __forceinline__ unsigned xb_add(unsigned* p, unsigned v) { return __hip_atomic_fetch_add(p, v, __ATOMIC_RELAXED, __HIP_MEMORY_SCOPE_AGENT); }
__device__ __forceinline__ unsigned xb_xcc_id() { return (unsigned)__builtin_amdgcn_s_getreg((3 << 11) | 20) & 0xFu; }
#define XB_SPIN(cond, bar) do { unsigned _sp = 0; while (cond) { __builtin_amdgcn_s_sleep(1); \
    if ((++_sp & 255u) == 0u) { if (xb_ld(&(bar)[XB_TMO])) break; if (_sp > XB_SPIN_CAP) { atomicAdd(&(bar)[XB_TMO], 1u); break; } } } } while (0)
struct XcdBarrier { unsigned* bar; unsigned x; volatile LAS unsigned* st; };
__device__ __forceinline__ XcdBarrier xcd_barrier_post(unsigned* bar, volatile LAS unsigned* st) {
    XcdBarrier b; b.bar = bar; b.x = xb_xcc_id(); b.st = st;
    if (threadIdx.x == 0) (void)xb_add(&bar[XB_XCNT(b.x)], 1u);
    return b;
}
__device__ __forceinline__ void xcd_barrier_complete(unsigned* bar, unsigned x, unsigned& nloc, unsigned& nx) {
    const unsigned G = gridDim.x * gridDim.y * gridDim.z;
    unsigned sum, cnt, mine, sp = 0u;
    for (;;) {
        sum = 0u; cnt = 0u; mine = 0u;
#pragma unroll
        for (unsigned j = 0; j < 16; ++j) { const unsigned c = xb_ld(&bar[XB_XCNT(j)]); sum += c; cnt += (c > 0u) ? 1u : 0u; mine = (j == x) ? c : mine; }
        if (sum == G) break;
        __builtin_amdgcn_s_sleep(1);
        if ((++sp & 255u) == 0u) { if (xb_ld(&bar[XB_TMO])) break; if (sp > XB_SPIN_CAP) { atomicAdd(&bar[XB_TMO], 1u); break; } }
    }
    nloc = mine > 0u ? mine : 1u; nx = cnt > 0u ? cnt : 1u;
}
__device__ __forceinline__ void xcd_barrier(const XcdBarrier& b) {
    asm volatile("s_waitcnt vmcnt(0)" ::: "memory");
    __syncthreads();
    if (threadIdx.x == 0) {
        unsigned* bar = b.bar;
        __builtin_amdgcn_s_waitcnt(0);
        unsigned nloc = b.st[0], nx = b.st[1];
        if (nloc == 0u) { xcd_barrier_complete(bar, b.x, nloc, nx); b.st[0] = nloc; b.st[1] = nx; }
        const unsigned old = xb_add(&bar[XB_XSUB(b.x)], 1u);
        const unsigned gen = old / nloc;
        if (old + 1u == (gen + 1u) * nloc) {
            __builtin_amdgcn_fence(__ATOMIC_RELEASE, "agent");
            asm volatile("s_waitcnt vmcnt(0)" ::: "memory");
            const unsigned og = xb_add(&bar[XB_TOP], 1u);
            const unsigned tg = og / nx;
            if (og + 1u == (tg + 1u) * nx) xb_add(&bar[XB_TOPGEN], 1u);
            else XB_SPIN(xb_ld(&bar[XB_TOPGEN]) == tg, bar);
            __builtin_amdgcn_fence(__ATOMIC_ACQUIRE, "agent");
            xb_add(&bar[XB_XGEN(b.x)], 1u);
            asm volatile("s_waitcnt vmcnt(0)" ::: "memory");
        } else {
            XB_SPIN(xb_ld(&bar[XB_XGEN(b.x)]) == gen, bar);
            __builtin_amdgcn_fence(__ATOMIC_ACQUIRE, "agent");
            asm volatile("s_waitcnt vmcnt(0)" ::: "memory");
        }
    }
    __syncthreads();
}

constexpr int NPH = 23;
__device__ __forceinline__ void run_phase(CP p, int ph, int b, LAS unsigned char* lds) {
    asm volatile("" : "+s"(p));
    unsigned char* ws = p->ws;
    const float* xb = p->x + (size_t)b * S_ * D_; float* hb = p->out + (size_t)b * S_ * D_;
    bf16_t* XN = (bf16_t*)(ws + OFF_XN);
    const int layer = (ph >= 13) ? 1 : 0;
    switch (ph) {
    case 0: prep_phase(p, lds); break;
    case 1: rmsnorm_phase(xb, p->norm_mix, XN, nullptr, nullptr); break;
    case 2: {
        Prob2D<EpiQK> g1{(const char*)XN, (const char*)(ws + OFF_W_RIN), 4096u, 4096u, 32, 64, 16, EpiQK{(bf16_t*)(ws + OFF_Q), (bf16_t*)(ws + OFF_K), (bf16_t*)(ws + OFF_KTD), (const float2*)(ws + OFF_ROPE)}};
        gemm_phase(lds, g1);
        Prob2D<EpiStore> g2{(const char*)(ws + OFF_W_RIN) + (size_t)4096 * 4096, (const char*)XN, 4096u, 4096u, 32, 16, 64, EpiStore{(bf16_t*)(ws + OFF_VT), (size_t)S_}};
        gemm_phase(lds, g2);
    } break;
    case 3: {
        ProbKV g3{(const char*)(ws + OFF_VT), (const char*)(ws + OFF_KTD), (bf16_t*)(ws + OFF_ST), 4};
        gemm_phase(lds, g3);
        ProbS g4{(const char*)(ws + OFF_Q), (const char*)(ws + OFF_K), (bf16_t*)(ws + OFF_SD), 4};
        gemm_phase(lds, g4);
    } break;
    case 4: scan_phase((bf16_t*)(ws + OFF_ST)); break;
    case 5: {
        ProbOut g5{(const char*)(ws + OFF_Q), (const char*)(ws + OFF_ST), (long)OFF_SD - (long)OFF_Q, (long)OFF_VT - (long)OFF_ST, (bf16_t*)(ws + OFF_Y), 8};
        gemm_phase(lds, g5);
    } break;
    case 6: gn_phase((const bf16_t*)(ws + OFF_Y), (float2*)(ws + OFF_GNS)); break;
    case 7: {
        Prob2D<EpiGate> g6{(const char*)XN, (const char*)(ws + OFF_W_RIN) + (size_t)8192 * 4096, 4096u, 4096u, 32, 64, 16, EpiGate{(bf16_t*)(ws + OFF_Y), (const float2*)(ws + OFF_GNS), p->ret_gn}};
        gemm_phase(lds, g6);
    } break;
    case 8: {
        Prob2D<EpiRes> g7{(const char*)(ws + OFF_Y), (const char*)(ws + OFF_W_ROUT), 8192u, 8192u, 64, 64, 8, EpiRes{xb, hb, XN, (float*)(ws + OFF_SS) + (size_t)(b * 4 + 0) * S_}};
        gemm_phase(lds, g7);
    } break;
    case 10: case 20: {
        Prob2D<EpiStoreRS> g8{(const char*)XN, (const char*)(ws + OFF_W_FIN + (size_t)layer * 32 * MiB), 4096u, 4096u, 32, 64, 32, EpiStoreRS{(bf16_t*)(ws + OFF_U), (size_t)8192, (const float*)(ws + OFF_SS) + (size_t)(b * 4 + (layer ? 2 : 0)) * S_}};
        gemm_phase(lds, g8);
    } break;
    case 11: case 21: conv_phase((const bf16_t*)(ws + OFF_U), (bf16_t*)(ws + OFF_AB), p->ffn_conv_w + (size_t)layer * 3 * 8192, p->ffn_conv_b + (size_t)layer * 8192); break;
    case 12: case 22: {
        Prob2D<EpiRes> g9{(const char*)(ws + OFF_AB), (const char*)(ws + OFF_W_FOUT + (size_t)layer * 16 * MiB), 8192u, 8192u, 64, 64, 8, EpiRes{hb, hb, layer ? (bf16_t*)nullptr : XN, layer ? (float*)nullptr : (float*)(ws + OFF_SS) + (size_t)(b * 4 + 1) * S_}};
        gemm_phase(lds, g9);
    } break;
    case 14: {
        const float* ss1 = (const float*)(ws + OFF_SS) + (size_t)(b * 4 + 1) * S_;
        Prob2D<EpiStoreRS> g10{(const char*)XN, (const char*)(ws + OFF_W_KV), 4096u, 4096u, 32, 64, 8, EpiStoreRS{(bf16_t*)(ws + OFF_KVTOK), (size_t)2048, ss1}};
        gemm_phase(lds, g10);
        Prob2D<EpiStoreCS> g11{(const char*)(ws + OFF_W_KV) + (size_t)2048 * 4096, (const char*)XN, 4096u, 4096u, 32, 4, 64, EpiStoreCS{(bf16_t*)(ws + OFF_KVT), (size_t)S_, ss1}};
        gemm_phase(lds, g11);
    } break;
    case 15: {
        ProbCmp1 a{(const char*)(ws + OFF_KVTOK), (const char*)(ws + OFF_W_C1K), 8192u, 64, 16, EpiGelu{(bf16_t*)(ws + OFF_H1), (const float*)(ws + OFF_PEB)}};
        gemm_phase(lds, a, (int)gridDim.x - 32);
        ProbCmp1 v{(const char*)(ws + OFF_KVTOK) + 1024, (const char*)(ws + OFF_W_C1V), 8192u, 64, 16, EpiGelu{(bf16_t*)(ws + OFF_H1) + 4096 * 256, (const float*)(ws + OFF_PEB) + 256}};
        gemm_phase(lds, v, (int)gridDim.x - 16);
        Prob2D<EpiQproj> g12{(const char*)XN, (const char*)(ws + OFF_W_Q), 4096u, 4096u, 32, 64, 9, EpiQproj{(bf16_t*)(ws + OFF_QB), (float*)(ws + OFF_GATES), (const float*)(ws + OFF_SS) + (size_t)(b * 4 + 1) * S_}};
        gemm_phase(lds, g12);
    } break;
    case 16: {
        Prob2D<EpiKcmp> a{(const char*)(ws + OFF_H1), (const char*)(ws + OFF_W_C2K), 512u, 512u, 4, 16, 1, EpiKcmp{(bf16_t*)(ws + OFF_KCMP)}};
        gemm_phase(lds, a);
        Prob2D<EpiVcmp> v{(const char*)(ws + OFF_W_C2V), (const char*)(ws + OFF_H1) + (size_t)4096 * 256 * 2, 512u, 512u, 4, 1, 16, EpiVcmp{(bf16_t*)(ws + OFF_VCMPT)}};
        gemm_phase(lds, v);
    } break;
    case 17: attn_phase(ws, lds, b); break;
    case 18: {
        Prob2D<EpiRes> g{(const char*)(ws + OFF_ATT), (const char*)(ws + OFF_W_O), 4096u, 4096u, 32, 64, 8, EpiRes{hb, hb, XN, (float*)(ws + OFF_SS) + (size_t)(b * 4 + 2) * S_}};
        gemm_phase(lds, g);
    } break;
    case 23: finalnorm_phase(hb, p->final_gain); break;
    default: break;
    }
}

#if MULTI
__global__ void __launch_bounds__(512) phase_kernel(Params p, int ph, int b) {
    extern __shared__ __attribute__((aligned(16))) unsigned char shm[];
    run_phase((CP)__builtin_amdgcn_kernarg_segment_ptr(), ph, b, (LAS unsigned char*)shm);
}
#else
__global__ void __launch_bounds__(512) mega_kernel(Params p) {
    extern __shared__ __attribute__((aligned(16))) unsigned char shm[];
    cg::grid_group grid = cg::this_grid();
    CP cp = (CP)__builtin_amdgcn_kernarg_segment_ptr();
    volatile LAS unsigned* st = (volatile LAS unsigned*)((LAS unsigned char*)shm + LDS_ST);
    if (threadIdx.x == 0) { st[0] = 0u; st[1] = 0u; st[2] = 0u; st[3] = 0u; }
    __syncthreads();
    XcdBarrier xb = xcd_barrier_post((unsigned*)(cp->ws + OFF_BAR), st);
    run_phase(cp, 0, 0, (LAS unsigned char*)shm);
    grid.sync();
    for (int b = 0; b < 2; ++b)
        for (int ph = 1; ph <= NPH; ++ph) {
            if (ph == 9 || ph == 13 || ph == 19) continue;
#ifdef PROBE_PH
            const int reps = (ph == PROBE_PH || ph == PROBE_PH2) ? 2 : 1;
#else
            const int reps = 1;
#endif
            for (int rep = 0; rep < reps; ++rep) { run_phase(cp, ph, b, (LAS unsigned char*)shm); xcd_barrier(xb); } }
}
#endif

constexpr int LDS_BYTES = LDS_ST + 16;
extern "C" void kernel_launch(void* const* d_in, const int* in_sizes, int n_in, void* d_out, int out_size, void* d_ws, size_t ws_size, hipStream_t stream) {
    static int grid = 0;
    if (grid == 0) {
        if (n_in != 21 || out_size != 2 * S_ * D_ || ws_size < WS_NEED) { fprintf(stderr, "kernel_launch: unexpected shapes/ws (n_in %d out %d ws %zu need %zu)\n", n_in, out_size, ws_size, (size_t)WS_NEED); grid = -1; return; }
#if MULTI
        if (hipFuncSetAttribute((const void*)phase_kernel, hipFuncAttributeMaxDynamicSharedMemorySize, LDS_BYTES) != hipSuccess) { fprintf(stderr, "hipFuncSetAttribute failed\n"); grid = -1; return; }
#else
        if (hipFuncSetAttribute((const void*)mega_kernel, hipFuncAttributeMaxDynamicSharedMemorySize, LDS_BYTES) != hipSuccess) { fprintf(stderr, "hipFuncSetAttribute failed\n"); grid = -1; return; }
#endif
        int dev = 0, cus = 0; hipGetDevice(&dev); hipDeviceGetAttribute(&cus, hipDeviceAttributeMultiprocessorCount, dev);
        grid = cus > 0 ? cus : 256;
    }
    if (grid < 0) return;
    Params p{};
    const float** pp = (const float**)&p;
    for (int i = 0; i < 21; ++i) pp[i] = (const float*)d_in[i];
    p.out = (float*)d_out; p.ws = (unsigned char*)d_ws;
#if MULTI
    hipLaunchKernelGGL(phase_kernel, dim3(grid), dim3(512), LDS_BYTES, stream, p, 0, 0);
    for (int b = 0; b < 2; ++b)
        for (int ph = 1; ph <= NPH; ++ph) hipLaunchKernelGGL(phase_kernel, dim3(grid), dim3(512), LDS_BYTES, stream, p, ph, b);
#else
    if (hipMemsetAsync((unsigned char*)d_ws + OFF_BAR, 0, (XCD_BAR_WORDS + 128) * 4, stream) != hipSuccess) { fprintf(stderr, "memset failed\n"); return; }
    void* args[] = {&p};
    hipError_t e = hipLaunchCooperativeKernel((const void*)mega_kernel, dim3(grid), dim3(512), args, LDS_BYTES, stream);
    if (e != hipSuccess) fprintf(stderr, "cooperative launch failed: %s (grid %d)\n", hipGetErrorString(e), grid);
#endif
}
```
